# Optimizing an MI355X kernel written in HIP

```python
import jax, jax.numpy as jnp
from jax import lax
import numpy as np

D_MODEL = 2048
BATCH = 4
SEQ = 4096
DEPTH = 2

GRID_W = 64
CTX_LEN = 256
Q_BLOCK = 128
ROPE_THETA = 10000.0
LN_EPS = 1e-5
RMS_EPS = 1e-6
NEG_INF = -1e30

A_HEADS = 4
A_NOPE = 128
A_ROPE = 64
A_V = 128
A_Q_LORA = 384
A_KV_LORA = 128
B_HEADS = 8
B_KV_HEADS = 2
B_DIM = 64
B_WINDOW = 128
C_HEADS = 4
C_DIM = 128
NA_ROWS = 8
NA_COLS = 16
D_HEADS = 4
D_KV_HEADS = 2
D_DIM = 128
N_BRANCH = 4
BRANCH_W = 512
PEER_HEADS = 8
PEER_KEYS = 128
PEER_EXPERTS = PEER_KEYS * PEER_KEYS
PEER_QDIM = 256
PEER_TOPK = 16
PEER_TOK_BLOCK = 128

A_SCALE = (A_NOPE + A_ROPE) ** -0.5
B_SCALE = B_DIM ** -0.5
C_SCALE = C_DIM ** -0.5
D_SCALE = D_DIM ** -0.5
ALPHA = (2 * DEPTH) ** 0.25
BETA = (8 * DEPTH) ** -0.25

IN_SIZES = (A_Q_LORA, A_KV_LORA, A_ROPE,
            B_HEADS * B_DIM, B_KV_HEADS * B_DIM, B_KV_HEADS * B_DIM,
            C_HEADS * C_DIM, C_HEADS * C_DIM, C_HEADS * C_DIM,
            D_HEADS * D_DIM, D_KV_HEADS * D_DIM, D_KV_HEADS * D_DIM)
IN_WIDTH = sum(IN_SIZES)

kernel_name = "hybrid_parallel_mla_swa_natten_gqa_peer_block"


def layer_norm(x, g, b):
    xf = x.astype(jnp.float32)
    mu = jnp.mean(xf, axis=-1, keepdims=True)
    var = jnp.mean(jnp.square(xf - mu), axis=-1, keepdims=True)
    return ((xf - mu) * lax.rsqrt(var + LN_EPS)).astype(x.dtype) * g + b


def rms_norm(x, g):
    xf = x.astype(jnp.float32)
    ms = jnp.mean(jnp.square(xf), axis=-1, keepdims=True)
    return (xf * lax.rsqrt(ms + RMS_EPS)).astype(x.dtype) * g


def modulate(x, shift, scale):
    return x * (1 + scale) + shift


def heads(t, h):
    return t.reshape(t.shape[:-1] + (h, t.shape[-1] // h))


def flat_heads(t):
    return t.reshape(t.shape[:-2] + (t.shape[-2] * t.shape[-1],))


def split_cols(u):
    out, o = [], 0
    for n in IN_SIZES:
        out.append(u[..., o:o + n])
        o += n
    return out


def axial_angles(n, rot_dim):
    t = jnp.arange(n)
    rows = (t // GRID_W).astype(jnp.float32)
    cols = (t % GRID_W).astype(jnp.float32)
    nf = rot_dim // 4
    inv = ROPE_THETA ** (-jnp.arange(nf, dtype=jnp.float32) / nf)
    ang = jnp.concatenate([rows[:, None] * inv, cols[:, None] * inv], axis=-1)
    return jnp.cos(ang), jnp.sin(ang)


def apply_rope(x, cos, sin):
    half = x.shape[-1] // 2
    x1, x2 = x[..., :half], x[..., half:]
    c = cos[:, None, :].astype(x.dtype)
    sn = sin[:, None, :].astype(x.dtype)
    return jnp.concatenate([x1 * c - x2 * sn, x1 * sn + x2 * c], axis=-1)


def softmax_with_sink(s, sink):
    col = jnp.broadcast_to(sink.astype(jnp.float32), s.shape[:-1] + (1,))
    p = jax.nn.softmax(jnp.concatenate([s, col], axis=-1), axis=-1)
    return p[..., :-1]


def dense_attention(q, k, v, scale, sink=None):
    b, nq, hq, dk = q.shape
    hkv = k.shape[2]
    g = hq // hkv
    qg = q.reshape(b, nq, hkv, g, dk)
    s = jnp.einsum("bqhgd,bkhd->bhgqk", qg, k).astype(jnp.float32) * scale
    if sink is None:
        p = jax.nn.softmax(s, axis=-1)
    else:
        p = softmax_with_sink(s, sink.reshape(hkv, g)[None, :, :, None, None])
    o = jnp.einsum("bhgqk,bkhd->bqhgd", p.astype(v.dtype), v)
    return o.reshape(b, nq, hq, v.shape[-1])


def blocked_attention(q, k, v, scale):
    b, n, hq, dk = q.shape
    nb = n // Q_BLOCK
    qb = jnp.moveaxis(q.reshape(b, nb, Q_BLOCK, hq, dk), 1, 0)
    ob = lax.map(lambda qi: dense_attention(qi, k, v, scale), qb)
    return jnp.moveaxis(ob, 0, 1).reshape(b, n, hq, v.shape[-1])


def mla_qkv(cq, ckv, kr, q_norm, kv_norm, w_uq, w_ukv, rope):
    q = heads(rms_norm(cq, q_norm) @ w_uq, A_HEADS)
    kv = heads(rms_norm(ckv, kv_norm) @ w_ukv, A_HEADS)
    q_nope, q_rope = q[..., :A_NOPE], q[..., A_NOPE:]
    k_nope, v = kv[..., :A_NOPE], kv[..., A_NOPE:]
    k_rope = kr[..., None, :]
    if rope is not None:
        q_rope = apply_rope(q_rope, *rope)
        k_rope = apply_rope(k_rope, *rope)
    k_rope = jnp.broadcast_to(k_rope, k_nope.shape[:-1] + (A_ROPE,))
    return (jnp.concatenate([q_nope, q_rope], axis=-1), jnp.concatenate([k_nope, k_rope], axis=-1), v)


def band_sink_attention(q, k, v, k_ctx, v_ctx, sink):
    b, n, hq, d = q.shape
    hkv = k.shape[2]
    g = hq // hkv
    nb = n // Q_BLOCK
    nk = 3 * Q_BLOCK
    pad = ((0, 0), (Q_BLOCK, Q_BLOCK), (0, 0), (0, 0))

    def bands(t):
        tp = jnp.pad(t, pad)
        return jnp.concatenate(
            [tp[:, j * Q_BLOCK: j * Q_BLOCK + n].reshape(b, nb, Q_BLOCK, hkv, t.shape[-1]) for j in range(3)],
            axis=2)

    kb, vb = bands(k), bands(v)
    qb = q.reshape(b, nb, Q_BLOCK, hkv, g, d)
    s_win = jnp.einsum("bnqhgd,bnkhd->bnhgqk", qb, kb).astype(jnp.float32) * B_SCALE
    rel = jnp.arange(nk) - Q_BLOCK
    kabs = jnp.arange(nb)[:, None] * Q_BLOCK + rel[None, :]
    valid = (kabs >= 0) & (kabs < n)
    band = jnp.abs(rel[None, :] - jnp.arange(Q_BLOCK)[:, None]) <= B_WINDOW
    mask = band[None] & valid[:, None, :]
    s_win = jnp.where(mask[None, :, None, None], s_win, NEG_INF)
    s_ctx = jnp.einsum("bnqhgd,bchd->bnhgqc", qb, k_ctx).astype(jnp.float32) * B_SCALE
    p = softmax_with_sink(jnp.concatenate([s_win, s_ctx], axis=-1),
                          sink.reshape(hkv, g)[None, None, :, :, None, None]).astype(v.dtype)
    o = (jnp.einsum("bnhgqk,bnkhd->bnqhgd", p[..., :nk], vb)
         + jnp.einsum("bnhgqc,bchd->bnqhgd", p[..., nk:], v_ctx))
    return o.reshape(b, n, hq, v.shape[-1])


def neighbourhood_attention(q, k, v, k_ctx, v_ctx, rpb):
    b, n, h, d = q.shape
    rows = n // GRID_W
    kh = min(NA_ROWS, rows)
    kw = NA_COLS
    r = jnp.arange(rows)
    row_start = jnp.clip(r - kh // 2, 0, rows - kh)
    row_idx = row_start[:, None] + jnp.arange(kh)
    ci = jnp.arange(GRID_W)
    col_start = jnp.clip(ci - kw // 2, 0, GRID_W - kw)
    col_mask = (ci[None, :] >= col_start[:, None]) & (ci[None, :] < col_start[:, None] + kw)
    qg = q.reshape(b, rows, GRID_W, h, d)
    kg = k.reshape(b, rows, GRID_W, h, d)[:, row_idx].reshape(b, rows, kh * GRID_W, h, d)
    vg = v.reshape(b, rows, GRID_W, h, v.shape[-1])[:, row_idx].reshape(b, rows, kh * GRID_W, h, v.shape[-1])
    s_nb = jnp.einsum("brqhd,brkhd->brhqk", qg, kg).astype(jnp.float32) * C_SCALE
    row_off = row_idx - r[:, None] + (NA_ROWS - 1)
    col_off = jnp.clip(ci[None, :] - ci[:, None] + (NA_COLS - 1), 0, 2 * NA_COLS - 2)
    bias = rpb[:, row_off[:, None, :, None], col_off[None, :, None, :]]
    bias = jnp.transpose(bias, (1, 0, 2, 3, 4)).reshape(rows, h, GRID_W, kh * GRID_W)
    mask = jnp.tile(col_mask, (1, kh))
    s_nb = jnp.where(mask, s_nb + bias.astype(jnp.float32)[None], NEG_INF)
    s_ctx = jnp.einsum("brqhd,bchd->brhqc", qg, k_ctx).astype(jnp.float32) * C_SCALE
    p = jax.nn.softmax(jnp.concatenate([s_nb, s_ctx], axis=-1), axis=-1).astype(v.dtype)
    nk = kh * GRID_W
    o = (jnp.einsum("brhqk,brkhd->brqhd", p[..., :nk], vg)
         + jnp.einsum("brhqc,bchd->brqhd", p[..., nk:], v_ctx))
    return o.reshape(b, n, h, v.shape[-1])


def merge_branches(h, branches, w_branch, w_gate, b_gate, w_out):
    ys = [jax.nn.sigmoid(h @ w_gate[i] + b_gate[i]) * (o @ w_branch[i]) for i, o in enumerate(branches)]
    return (ys[0] + ys[1] + ys[2] + ys[3]) @ w_out


def token_mixers(h, hc, w_in, a_q_norm, a_kv_norm, a_w_uq, a_w_ukv, b_sink, c_rpb,
                 d_q_norm, d_k_norm, w_branch, w_gate, b_gate, w_out, rope_a, rope_b, rope_d, need_ctx):
    a_cq, a_ckv, a_kr, b_q, b_k, b_v, c_q, c_k, c_v, d_q, d_k, d_v = split_cols(h @ w_in)
    ac_cq, ac_ckv, ac_kr, bc_q, bc_k, bc_v, cc_q, cc_k, cc_v, dc_q, dc_k, dc_v = split_cols(hc @ w_in)
    cat = lambda u, w: jnp.concatenate([u, w], axis=1)

    qa, ka, va = mla_qkv(a_cq, a_ckv, a_kr, a_q_norm, a_kv_norm, a_w_uq, a_w_ukv, rope_a)
    qa_c, ka_c, va_c = mla_qkv(ac_cq, ac_ckv, ac_kr, a_q_norm, a_kv_norm, a_w_uq, a_w_ukv, None)
    oa = blocked_attention(qa, cat(ka, ka_c), cat(va, va_c), A_SCALE)

    qb = apply_rope(heads(b_q, B_HEADS), *rope_b)
    kb = apply_rope(heads(b_k, B_KV_HEADS), *rope_b)
    vb = heads(b_v, B_KV_HEADS)
    kb_c, vb_c = heads(bc_k, B_KV_HEADS), heads(bc_v, B_KV_HEADS)
    ob = band_sink_attention(qb, kb, vb, kb_c, vb_c, b_sink)

    qc_, kc_, vc_ = heads(c_q, C_HEADS), heads(c_k, C_HEADS), heads(c_v, C_HEADS)
    kc_c, vc_c = heads(cc_k, C_HEADS), heads(cc_v, C_HEADS)
    oc = neighbourhood_attention(qc_, kc_, vc_, kc_c, vc_c, c_rpb)

    qd = apply_rope(rms_norm(heads(d_q, D_HEADS), d_q_norm), *rope_d)
    kd = apply_rope(rms_norm(heads(d_k, D_KV_HEADS), d_k_norm), *rope_d)
    vd = heads(d_v, D_KV_HEADS)
    kd_c = rms_norm(heads(dc_k, D_KV_HEADS), d_k_norm)
    vd_c = heads(dc_v, D_KV_HEADS)
    od = blocked_attention(qd, cat(kd, kd_c), cat(vd, vd_c), D_SCALE)

    out = merge_branches(h, [flat_heads(oa), flat_heads(ob), flat_heads(oc), flat_heads(od)],
                         w_branch, w_gate, b_gate, w_out)
    if not need_ctx:
        return out, None
    oa_c = dense_attention(qa_c, ka_c, va_c, A_SCALE)
    ob_c = dense_attention(heads(bc_q, B_HEADS), kb_c, vb_c, B_SCALE, sink=b_sink)
    oc_c = dense_attention(heads(cc_q, C_HEADS), kc_c, vc_c, C_SCALE)
    od_c = dense_attention(rms_norm(heads(dc_q, D_HEADS), d_q_norm), kd_c, vd_c, D_SCALE)
    out_c = merge_branches(hc, [flat_heads(oa_c), flat_heads(ob_c), flat_heads(oc_c), flat_heads(od_c)],
                           w_branch, w_gate, b_gate, w_out)
    return out, out_c


def peer_ffn(h, w_q, sub_keys, u, v):
    b, n, d = h.shape
    t = b * n
    hf = h.reshape(t, d)
    q = (hf @ w_q).reshape(t, PEER_HEADS, 2, PEER_QDIM // 2)
    s = jnp.einsum("thpd,hpkd->thpk", q, sub_keys).astype(jnp.float32)
    s_top, i_top = lax.top_k(s, PEER_TOPK)
    cand = s_top[:, :, 0, :, None] + s_top[:, :, 1, None, :]
    cand_idx = i_top[:, :, 0, :, None] * PEER_KEYS + i_top[:, :, 1, None, :]
    best, pos = lax.top_k(cand.reshape(t, PEER_HEADS, PEER_TOPK * PEER_TOPK), PEER_TOPK)
    experts = jnp.take_along_axis(cand_idx.reshape(t, PEER_HEADS, PEER_TOPK * PEER_TOPK), pos, axis=-1)
    gates = jax.nn.softmax(best, axis=-1)
    nb = t // PEER_TOK_BLOCK

    def block(args):
        xb, eb, gb = args
        act = jax.nn.gelu(jnp.einsum("td,thkd->thk", xb, u[eb]), approximate=False)
        return jnp.einsum("thk,thkd->td", gb.astype(xb.dtype) * act, v[eb])

    out = lax.map(block, (hf.reshape(nb, PEER_TOK_BLOCK, d),
                          experts.reshape(nb, PEER_TOK_BLOCK, PEER_HEADS, PEER_TOPK),
                          gates.reshape(nb, PEER_TOK_BLOCK, PEER_HEADS, PEER_TOPK)))
    return out.reshape(b, n, d)


def setup_inputs(seed: int = 0) -> dict:
    key = jax.random.key(seed)
    ks = jax.random.split(key, 32)
    D, L = D_MODEL, DEPTH

    def nrm(k, shape, std):
        return std * jax.random.normal(k, shape, jnp.float32)

    def gain(k, shape):
        return 1.0 + nrm(k, shape, 0.02)

    return {
        "x": nrm(ks[0], (BATCH, SEQ, D), 1.0),
        "c": nrm(ks[1], (BATCH, D), 1.0),
        "ctx": nrm(ks[2], (BATCH, CTX_LEN, D), 1.0),
        "c_ctx": nrm(ks[3], (D,), 1.0),
        "w_ada": nrm(ks[4], (L, D, 6 * D), 0.5 * D ** -0.5),
        "b_ada": nrm(ks[5], (L, 6 * D), 0.01),
        "w_in": nrm(ks[6], (L, D, IN_WIDTH), D ** -0.5),
        "a_q_norm": gain(ks[7], (L, A_Q_LORA)),
        "a_kv_norm": gain(ks[8], (L, A_KV_LORA)),
        "a_w_uq": nrm(ks[9], (L, A_Q_LORA, A_HEADS * (A_NOPE + A_ROPE)), A_Q_LORA ** -0.5),
        "a_w_ukv": nrm(ks[10], (L, A_KV_LORA, A_HEADS * (A_NOPE + A_V)), A_KV_LORA ** -0.5),
        "b_sink": nrm(ks[11], (L, B_HEADS), 0.5),
        "c_rpb": nrm(ks[12], (L, C_HEADS, 2 * NA_ROWS - 1, 2 * NA_COLS - 1), 0.1),
        "d_q_norm": gain(ks[13], (L, D_DIM)),
        "d_k_norm": gain(ks[14], (L, D_DIM)),
        "w_branch": nrm(ks[15], (L, N_BRANCH, BRANCH_W, D), BETA * BRANCH_W ** -0.5),
        "w_gate": nrm(ks[16], (L, N_BRANCH, D, D), D ** -0.5),
        "b_gate": nrm(ks[17], (L, N_BRANCH, D), 0.01),
        "w_out": nrm(ks[18], (L, D, D), BETA * D ** -0.5),
        "ln1_g": gain(ks[19], (L, D)),
        "ln1_b": nrm(ks[20], (L, D), 0.01),
        "ln2_g": gain(ks[21], (L, D)),
        "ln2_b": nrm(ks[22], (L, D), 0.01),
        "peer_w_q": nrm(ks[23], (L, D, PEER_HEADS * PEER_QDIM), D ** -0.5),
        "peer_sub_keys": nrm(ks[24], (L, PEER_HEADS, 2, PEER_KEYS, PEER_QDIM // 2), (PEER_QDIM // 2) ** -0.5),
        "peer_u": nrm(ks[25], (L, PEER_EXPERTS, D), D ** -0.5),
        "peer_v": nrm(ks[26], (L, PEER_EXPERTS, D), BETA * PEER_HEADS ** -0.5),
    }


def reference(x, c, ctx, c_ctx, w_ada, b_ada, w_in, a_q_norm, a_kv_norm, a_w_uq, a_w_ukv, b_sink, c_rpb,
              d_q_norm, d_k_norm, w_branch, w_gate, b_gate, w_out, ln1_g, ln1_b, ln2_g, ln2_b,
              peer_w_q, peer_sub_keys, peer_u, peer_v):
    n = x.shape[1]
    rope_a = axial_angles(n, A_ROPE)
    rope_b = axial_angles(n, B_DIM)
    rope_d = axial_angles(n, D_DIM)
    xc = ctx
    for l in range(DEPTH):
        need_ctx = l < DEPTH - 1
        mod = jax.nn.silu(c) @ w_ada[l] + b_ada[l]
        mod_c = jax.nn.silu(c_ctx) @ w_ada[l] + b_ada[l]
        sh_a, sc_a, g_a, sh_f, sc_f, g_f = [m[:, None, :] for m in jnp.split(mod, 6, axis=-1)]
        shc_a, scc_a, gc_a, shc_f, scc_f, gc_f = jnp.split(mod_c, 6, axis=-1)
        h = modulate(x, sh_a, sc_a)
        hc = modulate(xc, shc_a, scc_a)
        mix, mix_c = token_mixers(h, hc, w_in[l], a_q_norm[l], a_kv_norm[l], a_w_uq[l], a_w_ukv[l], b_sink[l],
                                  c_rpb[l], d_q_norm[l], d_k_norm[l], w_branch[l], w_gate[l], b_gate[l], w_out[l],
                                  rope_a, rope_b, rope_d, need_ctx)
        x = layer_norm(ALPHA * x + g_a * mix, ln1_g[l], ln1_b[l])
        ffn = peer_ffn(modulate(x, sh_f, sc_f), peer_w_q[l], peer_sub_keys[l], peer_u[l], peer_v[l])
        x = layer_norm(ALPHA * x + g_f * ffn, ln2_g[l], ln2_b[l])
        if need_ctx:
            xc = layer_norm(ALPHA * xc + gc_a * mix_c, ln1_g[l], ln1_b[l])
            ffn_c = peer_ffn(modulate(xc, shc_f, scc_f), peer_w_q[l], peer_sub_keys[l], peer_u[l], peer_v[l])
            xc = layer_norm(ALPHA * xc + gc_f * ffn_c, ln2_g[l], ln2_b[l])
    return x
```

```cpp
#include <hip/hip_runtime.h>
#include <cstdio>
#include <cstdint>
#include <utility>

#define GAS __attribute__((address_space(1)))
#define LAS __attribute__((address_space(3)))
typedef unsigned short bf16;
typedef short bf16x8 __attribute__((ext_vector_type(8)));
typedef short s16x4 __attribute__((ext_vector_type(4)));
typedef float f32x2 __attribute__((ext_vector_type(2)));
typedef float f32x4 __attribute__((ext_vector_type(4)));
typedef float f32x16 __attribute__((ext_vector_type(16)));
typedef unsigned u32x2 __attribute__((ext_vector_type(2)));
typedef unsigned u32x4 __attribute__((ext_vector_type(4)));
typedef GAS unsigned gu32;

__device__ __forceinline__ unsigned cvt_pk_bf16(float lo, float hi) { unsigned r; asm volatile("v_cvt_pk_bf16_f32 %0, %1, %2" : "=v"(r) : "v"(lo), "v"(hi)); return r; }
__device__ __forceinline__ float bf2f(unsigned short b) { return __uint_as_float(((unsigned)b) << 16); }
__device__ __forceinline__ float bflo(unsigned w) { return __uint_as_float(w << 16); }
__device__ __forceinline__ float bfhi(unsigned w) { return __uint_as_float(w & 0xffff0000u); }
__device__ __forceinline__ unsigned short f2bf(float f) { return (unsigned short)(cvt_pk_bf16(f, 0.f) & 0xffffu); }

namespace pg8 {
constexpr int BM = 256, BK = 64, HALF = 128, HTB = HALF * BK * 2  , STAGE_BYTES = 8 * HTB, NXCD = 8, WGM = 8;
__host__ __device__ __forceinline__ int lds_byte(int r, int c) { const int st = (r >> 4) * 2 + (c >> 5), rr = r & 15, cc = c & 31, ob = rr * 64 + cc * 2; return st * 1024 + (ob ^ (((ob >> 9) & 1) << 5)); }
__host__ __device__ __forceinline__ void stage_rc(int b, int& R, int& C) { const int st = b / 1024, sb = b % 1024, swz = sb ^ (((sb >> 9) & 1) << 5); R = (st >> 1) * 16 + swz / 64; C = (st & 1) * 32 + (swz % 64) / 2; }
__host__ __device__ __forceinline__ int perm32(int rho) { const int n = rho >> 4, i = rho & 15; return 8 * (i >> 2) + 4 * n + (i & 3); }

struct Unit { int pm, pn, z; };

__device__ __forceinline__ void tile_of(int L, int nM, int nN, int& pm, int& pn) {
    const int nwg = nM * nN; int wgid = L;
    { const int q = nwg / NXCD, r = nwg % NXCD, xcd = wgid % NXCD, off = wgid / NXCD; wgid = (xcd < r ? xcd * (q + 1) : r * (q + 1) + (xcd - r) * q) + off; }
    const int nig = WGM * nN, gid = wgid / nig, fm = gid * WGM, gsz = (nM - fm) < WGM ? (nM - fm) : WGM;
    pm = fm + ((wgid % nig) % gsz); pn = (wgid % nig) / gsz;
}
struct PlainSched {
    const char* A; const char* B; int lda, ldb, K, nM, nN, G, c;
    __device__ __forceinline__ bool next(int i, Unit& u) const { const long L = (long)i * G + c; if (L >= (long)nM * nN) return false; tile_of((int)L, nM, nN, u.pm, u.pn); u.z = 0; return true; }
    __device__ __forceinline__ void ptrs(const Unit& u, const char*& a, const char*& b, int& nt) const { a = A + (size_t)u.pm * BM * lda * 2; b = B + (size_t)u.pn * BM * ldb * 2; nt = K / BK; }
};
struct MergeSched {
    const char* H; const char* O; const char* W; int nM, G, c;
    __device__ __forceinline__ bool next(int i, Unit& u) const { const long L = (long)(i >> 3) * G + c; if (L >= (long)nM * 8) return false; tile_of((int)L, nM, 8, u.pm, u.pn); u.z = i & 7; return true; }
    __device__ __forceinline__ void ptrs(const Unit& u, const char*& a, const char*& b, int& nt) const {
        const int z = u.z >> 1, kind = u.z & 1;
        a = (kind ? H : O + (size_t)z * 512 * 2) + (size_t)u.pm * BM * 2048 * 2;
        b = W + ((size_t)z * 2048 * 2560 + (size_t)u.pn * BM * 2560 + (kind ? 0 : 2048)) * 2;
        nt = kind ? 32 : 8;
    }
};

struct EpiBf16 {
    static constexpr bool PERM = true;
    bf16* O; int ldc;
    __device__ __forceinline__ void operator()(const f32x4 (&acc)[2][2][4][2], const Unit& u, int wr, int wc, int fr, int fq) const {
        const int row0 = u.pm * BM + wr * 64 + fr, col0 = u.pn * BM + wc * 32 + 8 * fq;
#pragma unroll
        for (int ai = 0; ai < 2; ++ai)
#pragma unroll
            for (int m = 0; m < 4; ++m) { bf16* rowp = O + (size_t)(row0 + ai * HALF + m * 16) * ldc + col0;
#pragma unroll
                for (int bj = 0; bj < 2; ++bj) { const f32x4 v0 = acc[ai][bj][m][0], v1 = acc[ai][bj][m][1];
                    u32x4 w; w.x = cvt_pk_bf16(v0[0], v0[1]); w.y = cvt_pk_bf16(v0[2], v0[3]); w.z = cvt_pk_bf16(v1[0], v1[1]); w.w = cvt_pk_bf16(v1[2], v1[3]);
                    *(u32x4*)(rowp + bj * HALF) = w; } }
    }
};
struct EpiMerge {
    static constexpr bool PERM = true;
    bf16* S; const float* bgate; char* stash; char* P; int tid;
    __device__ __forceinline__ void operator()(const f32x4 (&acc)[2][2][4][2], const Unit& u, int wr, int wc, int fr, int fq) const {
        const int z = u.z >> 1, kind = u.z & 1;
        GAS char* sp = (GAS char*)stash + (size_t)tid * 16;
        if (kind == 0) {
#pragma unroll
            for (int ai = 0; ai < 2; ++ai)
#pragma unroll
                for (int m = 0; m < 4; ++m)
#pragma unroll
                    for (int bj = 0; bj < 2; ++bj) { const f32x4 v0 = acc[ai][bj][m][0], v1 = acc[ai][bj][m][1];
                        u32x4 w; w.x = cvt_pk_bf16(v0[0], v0[1]); w.y = cvt_pk_bf16(v0[2], v0[3]); w.z = cvt_pk_bf16(v1[0], v1[1]); w.w = cvt_pk_bf16(v1[2], v1[3]);
                        *(GAS u32x4*)sp = w; sp += 8192; asm volatile("" : "+v"(sp)); }
            return;
        }
        GAS char* pq = (GAS char*)P + (size_t)tid * 16;
        const int row0 = u.pm * BM + wr * 64 + fr, col0 = u.pn * BM + wc * 32 + 8 * fq;
        const float* bz = bgate + z * 2048 + col0;
        f32x4 bv[2][2];
#pragma unroll
        for (int bj = 0; bj < 2; ++bj)
#pragma unroll
            for (int n = 0; n < 2; ++n) bv[bj][n] = *(const f32x4*)(bz + bj * HALF + 4 * n);
        GAS bf16* rowp = (GAS bf16*)S + (size_t)row0 * 2048 + col0;
#pragma unroll
        for (int ai = 0; ai < 2; ++ai)
#pragma unroll
            for (int m = 0; m < 4; ++m) {
#pragma unroll
                for (int bj = 0; bj < 2; ++bj) {
                    const u32x4 sw = *(const GAS u32x4*)sp; sp += 8192; asm volatile("" : "+v"(sp));
                    f32x4 v0 = acc[ai][bj][m][0] + bv[bj][0], v1 = acc[ai][bj][m][1] + bv[bj][1];
#pragma unroll
                    for (int j = 0; j < 4; ++j) { v0[j] = __builtin_amdgcn_rcpf(1.0f + __builtin_amdgcn_exp2f(-1.4426950408889634f * v0[j])); v1[j] = __builtin_amdgcn_rcpf(1.0f + __builtin_amdgcn_exp2f(-1.4426950408889634f * v1[j])); }
                    v0[0] *= bflo(sw.x); v0[1] *= bfhi(sw.x); v0[2] *= bflo(sw.y); v0[3] *= bfhi(sw.y);
                    v1[0] *= bflo(sw.z); v1[1] *= bfhi(sw.z); v1[2] *= bflo(sw.w); v1[3] *= bfhi(sw.w);
                    if (z > 0) { v0 += *(const GAS f32x4*)pq; v1 += *(const GAS f32x4*)(pq + 8192); }
                    if (z < 3) { *(GAS f32x4*)pq = v0; *(GAS f32x4*)(pq + 8192) = v1; }
                    else { u32x4 w; w.x = cvt_pk_bf16(v0[0], v0[1]); w.y = cvt_pk_bf16(v0[2], v0[3]); w.z = cvt_pk_bf16(v1[0], v1[1]); w.w = cvt_pk_bf16(v1[2], v1[3]);
                        *(GAS u32x4*)(rowp + bj * HALF) = w; }
                    pq += 16384; asm volatile("" : "+v"(pq));
                }
                rowp += (m == 3 ? (size_t)(HALF - 48) : (size_t)16) * 2048; asm volatile("" : "+v"(rowp));
                asm volatile("" ::: "memory"); }
    }
};
struct EpiOut {
    static constexpr bool PERM = false;
    float* Y; const float* xlat; const float* xctx; const float* mod_l; float alpha;
    __device__ __forceinline__ void operator()(const f32x4 (&acc)[2][2][4][2], const Unit& u, int wr, int wc, int fr, int fq) const {
        const int row0 = u.pm * BM + wr * 64 + fr, col0 = u.pn * BM + wc * 32 + 4 * fq;
        const float* xb = (u.pm < 64) ? xlat + (size_t)row0 * 2048 : xctx + (size_t)(row0 - 16384) * 2048;
        const float* ga = mod_l + (size_t)((u.pm < 64) ? (u.pm >> 4) : 4) * 12288 + 2 * 2048 + col0;
        f32x4 gv[2][2];
#pragma unroll
        for (int bj = 0; bj < 2; ++bj)
#pragma unroll
            for (int n = 0; n < 2; ++n) gv[bj][n] = *(const f32x4*)(ga + bj * HALF + n * 16);
#pragma unroll
        for (int ai = 0; ai < 2; ++ai)
#pragma unroll
            for (int m = 0; m < 4; ++m) { const size_t ro = (size_t)(ai * HALF + m * 16) * 2048 + col0; float* yp = Y + (size_t)row0 * 2048 + ro;
#pragma unroll
                for (int bj = 0; bj < 2; ++bj)
#pragma unroll
                    for (int n = 0; n < 2; ++n) { const f32x4 xv = *(const f32x4*)(xb + ro + bj * HALF + n * 16); *(f32x4*)(yp + bj * HALF + n * 16) = xv * alpha + gv[bj][n] * acc[ai][bj][m][n]; } }
    }
};

template <class Epi, class Sched>
__device__ __forceinline__ void gemm_phase(LAS unsigned char* lds, const Sched& S, const Epi& E, const int lda, const int ldb, const int tid) {
    const int wid = __builtin_amdgcn_readfirstlane(tid >> 6), lane = tid & 63, wr = wid >> 2, wc = wid & 3, fr = lane & 15, fq = lane >> 4;
    unsigned voffA[2], voffB[2];
#pragma unroll
    for (int i = 0; i < 2; ++i) { int R, C; stage_rc(tid * 16 + i * 8192, R, C); const int Rb = Epi::PERM ? ((R & ~31) + perm32(R & 31)) : R;
        voffA[i] = (unsigned)(R * lda + C) * 2u; voffB[i] = (unsigned)(Rb * ldb + C) * 2u; }
    const size_t kstep = (size_t)(BK * 2);
    const size_t hstepA = (size_t)HALF * lda * 2, hstepB = (size_t)HALF * ldb * 2;
    const unsigned ldsw = (unsigned)wid * 1024u;
    const int aoff = lds_byte(wr * 64 + fr, fq * 8), boff = lds_byte(wc * 32 + fr, fq * 8);
#define PG8_SA(b, h) (((b) * 2 + (h)) * HTB)
#define PG8_SB(b, h) ((4 + (b) * 2 + (h)) * HTB)
#define PG8_STAGE(bufoff, gbase, voff) do { _Pragma("unroll") for (int _i = 0; _i < 2; ++_i) \
        __builtin_amdgcn_global_load_lds((const unsigned*)((const char*)(gbase) + (voff)[_i]), (LAS unsigned*)(lds + (bufoff) + ldsw + _i * 8192), 16, 0, 0); } while (0)
#define PG8_LDA(dst, b, h) do { _Pragma("unroll") for (int m = 0; m < 4; ++m) _Pragma("unroll") for (int k = 0; k < 2; ++k) dst[m][k] = *(const LAS bf16x8*)(lds + PG8_SA(b, h) + aoff + m * 2048 + k * 1024); } while (0)
#define PG8_LDB(dst, b, h) do { _Pragma("unroll") for (int n = 0; n < 2; ++n) _Pragma("unroll") for (int k = 0; k < 2; ++k) dst[n][k] = *(const LAS bf16x8*)(lds + PG8_SB(b, h) + boff + n * 2048 + k * 1024); } while (0)
#define PG8_MMA(ai, bj, At, Bt) do { __builtin_amdgcn_s_setprio(1); _Pragma("unroll") for (int m = 0; m < 4; ++m) _Pragma("unroll") for (int n = 0; n < 2; ++n) _Pragma("unroll") for (int k = 0; k < 2; ++k) \
        acc[ai][bj][m][n] = __builtin_amdgcn_mfma_f32_16x16x32_bf16(Bt[n][k], At[m][k], acc[ai][bj][m][n], 0, 0, 0); __builtin_amdgcn_s_setprio(0); } while (0)
#define PG8_WAIT_V(n) asm volatile("s_waitcnt vmcnt(" #n ")" ::: "memory")
#define PG8_WAIT_L(n) asm volatile("s_waitcnt lgkmcnt(" #n ")" ::: "memory")
#define PG8_BAR __builtin_amdgcn_s_barrier()
#define PG8_SCHED __builtin_amdgcn_sched_barrier(0)
    Unit cur, nxt; int ui = 0;
    if (!S.next(0, cur)) return;
    f32x4 acc[2][2][4][2];
#pragma unroll
    for (int a = 0; a < 2; ++a)
#pragma unroll
        for (int b = 0; b < 2; ++b)
#pragma unroll
            for (int m = 0; m < 4; ++m)
#pragma unroll
                for (int n = 0; n < 2; ++n) acc[a][b][m][n] = (f32x4){0.f, 0.f, 0.f, 0.f};
    bf16x8 At[4][2], B0[2][2], B1[2][2];
    const char* cA; const char* cB; int nt; S.ptrs(cur, cA, cB, nt);
    PG8_STAGE(PG8_SB(0, 0), cB, voffB); PG8_STAGE(PG8_SB(0, 1), cB + hstepB, voffB); PG8_STAGE(PG8_SA(0, 0), cA, voffA); PG8_STAGE(PG8_SA(0, 1), cA + hstepA, voffA);
    if (wr == 1) PG8_BAR;
    PG8_WAIT_V(2); PG8_BAR;
    PG8_STAGE(PG8_SB(1, 0), cB + kstep, voffB); PG8_STAGE(PG8_SA(1, 0), cA + kstep, voffA); PG8_STAGE(PG8_SB(1, 1), cB + hstepB + kstep, voffB);
    PG8_WAIT_V(6); PG8_BAR;
    for (;;) {
        const bool has_next = S.next(ui + 1, nxt);
        const char* nA = cA; const char* nB = cB; int nnt = nt; if (has_next) S.ptrs(nxt, nA, nB, nnt);
        for (int t = 0; t < nt; t += 2) {
            const bool last = (t == nt - 2);
            const char* a1 = cA + (size_t)(t + 1) * kstep;
            const char* a2 = last ? nA : cA + (size_t)(t + 2) * kstep; const char* b2 = last ? nB : cB + (size_t)(t + 2) * kstep;
            const char* a3 = a2 + kstep; const char* b3 = b2 + kstep;
            PG8_LDB(B0, 0, 0); PG8_LDB(B1, 0, 1); PG8_SCHED; PG8_LDA(At, 0, 0); PG8_STAGE(PG8_SA(1, 1), a1 + hstepA, voffA);
            PG8_WAIT_V(8); PG8_WAIT_L(0); PG8_BAR; PG8_MMA(0, 0, At, B0); PG8_MMA(0, 1, At, B1); PG8_BAR; PG8_SCHED;
            PG8_LDA(At, 0, 1); PG8_STAGE(PG8_SB(0, 0), b2, voffB); PG8_STAGE(PG8_SB(0, 1), b2 + hstepB, voffB); PG8_STAGE(PG8_SA(0, 0), a2, voffA);
            PG8_WAIT_V(8); PG8_WAIT_L(0); PG8_BAR; PG8_MMA(1, 0, At, B0); PG8_MMA(1, 1, At, B1); PG8_BAR; PG8_SCHED;
            PG8_LDB(B0, 1, 0); PG8_LDB(B1, 1, 1); PG8_SCHED; PG8_LDA(At, 1, 0); PG8_STAGE(PG8_SA(0, 1), a2 + hstepA, voffA);
            PG8_WAIT_V(8); PG8_WAIT_L(0); PG8_BAR; PG8_MMA(0, 0, At, B0); PG8_MMA(0, 1, At, B1); PG8_BAR; PG8_SCHED;
            PG8_LDA(At, 1, 1); PG8_STAGE(PG8_SB(1, 0), b3, voffB); PG8_STAGE(PG8_SB(1, 1), b3 + hstepB, voffB); PG8_STAGE(PG8_SA(1, 0), a3, voffA);
            PG8_WAIT_V(8); PG8_WAIT_L(0); PG8_BAR; PG8_MMA(1, 0, At, B0); PG8_MMA(1, 1, At, B1); PG8_BAR; PG8_SCHED;
        }
        if (wr == 0) PG8_BAR;
        E(acc, cur, wr, wc, fr, fq);
        if (!has_next) break;
#pragma unroll
        for (int a = 0; a < 2; ++a)
#pragma unroll
            for (int b = 0; b < 2; ++b)
#pragma unroll
                for (int m = 0; m < 4; ++m)
#pragma unroll
                    for (int n = 0; n < 2; ++n) acc[a][b][m][n] = (f32x4){0.f, 0.f, 0.f, 0.f};
        cur = nxt; cA = nA; cB = nB; nt = nnt; ++ui;
        if (wr == 1) PG8_BAR;
    }
    PG8_WAIT_V(0);
    PG8_BAR;
#undef PG8_SA
#undef PG8_SB
#undef PG8_STAGE
#undef PG8_LDA
#undef PG8_LDB
#undef PG8_MMA
#undef PG8_WAIT_V
#undef PG8_WAIT_L
#undef PG8_BAR
#undef PG8_SCHED
}
}
namespace att {
constexpr int NW = 8, QBLK = 32, KVBLK = 64;
#define SBAR() __builtin_amdgcn_sched_barrier(0)
__device__ __forceinline__ int crow(int r, int hi) { return (r & 3) + 8 * (r >> 2) + 4 * hi; }
__device__ __forceinline__ unsigned cvtpk(float lo, float hi) { unsigned r; asm volatile("v_cvt_pk_bf16_f32 %0, %1, %2" : "=v"(r) : "v"(lo), "v"(hi)); return r; }

struct Args {
    const bf16* Q; int ldq;
    const bf16* KV; int ld;
    int kc0, kc1, vc;
    bf16* O; int ldo;
    int n0, n1, row0, row1;
    float C, thr;
    int qrope, qpos0;
    float sinkl2; int has_sink;
    int wpos0;
    const float* T; int r0, kr0;
};

__device__ __forceinline__ void partialSM(f32x16& p0, f32x16& p1, float& m_reg, float& mn, float& alpha, const float C, const float thr) {
    float pmax = p0[0];
#pragma unroll
    for (int r = 1; r < 16; ++r) pmax = fmaxf(pmax, p0[r]);
#pragma unroll
    for (int r = 0; r < 16; ++r) pmax = fmaxf(pmax, p1[r]);
    { auto rr = __builtin_amdgcn_permlane32_swap(__float_as_uint(pmax), __float_as_uint(pmax), false, false);
      pmax = fmaxf(__uint_as_float(rr[0]), __uint_as_float(rr[1])); }
    if (__builtin_expect(__all(pmax - m_reg <= thr), 1)) { mn = m_reg; alpha = 1.f; }
    else { mn = fmaxf(m_reg, pmax); alpha = __builtin_amdgcn_exp2f((m_reg - mn) * C); m_reg = mn; }
    const float mnC = -mn * C;
#pragma unroll
    for (int r = 0; r < 16; ++r) p0[r] = fmaf(p0[r], C, mnC);
#pragma unroll
    for (int r = 0; r < 16; ++r) p1[r] = fmaf(p1[r], C, mnC);
#pragma unroll
    for (int r = 0; r < 16; ++r) p0[r] = __builtin_amdgcn_exp2f(p0[r]);
}
__device__ __forceinline__ void finishSM(f32x16& p0, f32x16& p1, float alpha, float& l_reg, bf16x8& pa0, bf16x8& pa1, bf16x8& pa2, bf16x8& pa3) {
#pragma unroll
    for (int r = 0; r < 16; ++r) p1[r] = __builtin_amdgcn_exp2f(p1[r]);
    float ps = 0;
#pragma unroll
    for (int r = 0; r < 16; ++r) ps += p0[r];
#pragma unroll
    for (int r = 0; r < 16; ++r) ps += p1[r];
    { auto rr = __builtin_amdgcn_permlane32_swap(__float_as_uint(ps), __float_as_uint(ps), false, false);
      ps = __uint_as_float(rr[0]) + __uint_as_float(rr[1]); }
    l_reg = l_reg * alpha + ps;
#define PK4(P, BASE, OUT) do { unsigned a0 = cvtpk(P[BASE + 0], P[BASE + 1]), a1 = cvtpk(P[BASE + 2], P[BASE + 3]);   \
    unsigned b0 = cvtpk(P[BASE + 4], P[BASE + 5]), b1 = cvtpk(P[BASE + 6], P[BASE + 7]);                              \
    auto r0 = __builtin_amdgcn_permlane32_swap(a0, b0, false, false); auto r1 = __builtin_amdgcn_permlane32_swap(a1, b1, false, false); \
    u32x4 w = {r0[0], r1[0], r0[1], r1[1]}; OUT = *reinterpret_cast<bf16x8*>(&w); } while (0)
    PK4(p0, 0, pa0); PK4(p0, 8, pa1); PK4(p1, 0, pa2); PK4(p1, 8, pa3);
#undef PK4
}
template <int DK> __device__ __forceinline__ int kswz(int row, int ch) { return row * (DK * 2) + ((ch ^ (row & 7)) << 4); }
template <int DK, int QREG> __device__ __forceinline__ void qkt(f32x16& p0, f32x16& p1, const LAS char* Ks, const bf16x8* qr, const LAS char* qx, int r32, int hi) {
    p0 = f32x16{}; p1 = f32x16{};
#pragma unroll
    for (int d0 = 0; d0 < DK / 16; ++d0) { const int ch = d0 * 2 + hi;
        const bf16x8 b0 = *(const LAS bf16x8*)(Ks + kswz<DK>(r32, ch));
        const bf16x8 b1 = *(const LAS bf16x8*)(Ks + kswz<DK>(32 + r32, ch));
        bf16x8 q; if constexpr (true) { if (d0 < QREG) q = qr[d0 < QREG ? d0 : 0]; else q = *(const LAS bf16x8*)(qx + (d0 - QREG) * 1024); }
        p0 = __builtin_amdgcn_mfma_f32_32x32x16_bf16(b0, q, p0, 0, 0, 0);
        p1 = __builtin_amdgcn_mfma_f32_32x32x16_bf16(b1, q, p1, 0, 0, 0); }
}
template <int NCB> __device__ __forceinline__ int v_st(int k, int c) { const int kk = (k & ~0xC) | ((k & 4) << 1) | ((k & 8) >> 1); return ((kk >> 3) * NCB + (c >> 5)) * 512 + ((kk & 7) * 32 + (c & 31)) * 2; }
__device__ __forceinline__ int v_rd_base(int lane) { return ((lane & 3) << 3) | (((lane >> 2) & 3) << 6) | (((lane >> 4) & 1) << 5) | (((lane >> 5) & 1) << 8); }
template <int OFF> __device__ __forceinline__ s16x4 tr_read(int vb) { s16x4 r; asm volatile("ds_read_b64_tr_b16 %0, %1 offset:%2" : "=&v"(r) : "v"(vb), "i"(OFF) : "memory"); return r; }
template <int D0, int NCB> __device__ __forceinline__ void pv_one(f32x16& od, int vb, bf16x8 pa0, bf16x8 pa1, bf16x8 pa2, bf16x8 pa3) {
#define VOFF(ks, half) (D0 * 512 + (ks) * (2 * NCB * 512) + (half) * (NCB * 512))
    const s16x4 l0 = tr_read<VOFF(0, 0)>(vb), h0 = tr_read<VOFF(0, 1)>(vb), l1 = tr_read<VOFF(1, 0)>(vb), h1 = tr_read<VOFF(1, 1)>(vb);
    const s16x4 l2 = tr_read<VOFF(2, 0)>(vb), h2 = tr_read<VOFF(2, 1)>(vb), l3 = tr_read<VOFF(3, 0)>(vb), h3 = tr_read<VOFF(3, 1)>(vb);
#undef VOFF
    asm volatile("s_waitcnt lgkmcnt(0)" ::: "memory"); SBAR();
#define PK(L, H) (bf16x8){L[0], L[1], L[2], L[3], H[0], H[1], H[2], H[3]}
    od = __builtin_amdgcn_mfma_f32_32x32x16_bf16(pa0, PK(l0, h0), od, 0, 0, 0);
    od = __builtin_amdgcn_mfma_f32_32x32x16_bf16(pa1, PK(l1, h1), od, 0, 0, 0);
    od = __builtin_amdgcn_mfma_f32_32x32x16_bf16(pa2, PK(l2, h2), od, 0, 0, 0);
    od = __builtin_amdgcn_mfma_f32_32x32x16_bf16(pa3, PK(l3, h3), od, 0, 0, 0);
#undef PK
}
template <int NCB> __device__ __forceinline__ void pv_all(f32x16* o, int vb, bf16x8 pa0, bf16x8 pa1, bf16x8 pa2, bf16x8 pa3) {
    pv_one<0, NCB>(o[0], vb, pa0, pa1, pa2, pa3); pv_one<1, NCB>(o[1], vb, pa0, pa1, pa2, pa3);
    if constexpr (NCB == 4) { pv_one<2, NCB>(o[2], vb, pa0, pa1, pa2, pa3); pv_one<3, NCB>(o[3], vb, pa0, pa1, pa2, pa3); }
}

template <int MODE> __device__ __forceinline__ void apply_mask(f32x16& p0, f32x16& p1, const Args& a, int j, int wid, int r32, int hi) {
    if constexpr (MODE == 1) {
        if (j < a.n0) return;
        const int kp0 = a.wpos0 + 64 * (j - a.n0), qw0 = a.qpos0 + wid * 32;
        if (kp0 + 63 - qw0 <= 128 && qw0 + 31 - kp0 <= 128) return;
        const int dd0 = kp0 - (qw0 + r32) + 4 * hi + 128;
#pragma unroll
        for (int r = 0; r < 16; ++r) { const int dd = dd0 + (r & 3) + 8 * (r >> 2);
            p0[r] = ((unsigned)dd <= 256u) ? p0[r] : -1e30f; p1[r] = ((unsigned)(dd + 32) <= 256u) ? p1[r] : -1e30f; }
    } else if constexpr (MODE == 2) {
        if (j < a.n0) return;
        const int kr = a.kr0 + (j - a.n0), qr = a.r0 + (wid >> 1);
        int rs = qr - 4; rs = rs < 0 ? 0 : (rs > 56 ? 56 : rs);
        if (kr < rs || kr >= rs + 8) {
#pragma unroll
            for (int r = 0; r < 16; ++r) { p0[r] = -1e30f; p1[r] = -1e30f; }
            return; }
        const int dr = kr - qr + 7, qc = (wid & 1) * 32 + r32;
        const float* tb = a.T + ((size_t)(dr * 64 + qc)) * 64 + 4 * hi;
#pragma unroll
        for (int g = 0; g < 4; ++g) { const f32x4 t0 = *(const f32x4*)(tb + 8 * g), t1 = *(const f32x4*)(tb + 32 + 8 * g);
#pragma unroll
            for (int i = 0; i < 4; ++i) { p0[4 * g + i] += t0[i]; p1[4 * g + i] += t1[i]; }
            asm volatile("" ::: "memory"); }
    }
}

template <int DK, int DV, int MODE, int SDEPTH>
__device__ __forceinline__ void attn_unit(const Args& a, LAS char* lds, const int tid) {
    constexpr int NKC = DK / 8, NVC = DV / 8, KPT = DK / 64, VPT = DV / 64, NCB = DV / 32, ND0 = DK / 16, QREG = (ND0 > 8 ? 4 : ND0);
    constexpr int SHM_K = 64 * DK * 2, SHM_V = 64 * DV * 2;
    const int wid = __builtin_amdgcn_readfirstlane(tid >> 6), lane = tid & 63, r32 = lane & 31, hi = lane >> 5;
    LAS char* V_lds = lds; LAS char* K_lds = lds + 2 * SHM_V;
    LAS float* ws = (LAS float*)(lds + 2 * SHM_V + 2 * SHM_K) + wid * 64; LAS float* li_l = ws; LAS float* al_l = ws + 32;
    LAS char* qx = lds + 2 * SHM_V + 2 * SHM_K + NW * 256 + wid * ((ND0 - QREG) * 1024) + lane * 16;
    float m_reg = -1e30f, l_reg = 0; f32x16 o[NCB]; bf16x8 qr[ND0];
#pragma unroll
    for (int d = 0; d < NCB; ++d) o[d] = f32x16{};
    const bf16* Qw = a.Q + (long)(wid * QBLK + r32) * a.ldq + hi * 8;
#pragma unroll
    for (int d0 = 0; d0 < ND0; ++d0) qr[d0] = *(const bf16x8*)(Qw + d0 * 16);
    if constexpr (DK == 192) {
        if (a.qrope) {
            const int t = a.qpos0 + wid * QBLK + r32; const float prow = (float)(t >> 6), pcol = (float)(t & 63);
#pragma unroll
            for (int dd = 0; dd < 2; ++dd) {
                bf16x8 x1 = qr[8 + dd], x2 = qr[10 + dd]; const float pos = dd ? pcol : prow;
#pragma unroll
                for (int e = 0; e < 8; ++e) { const float inv = __builtin_amdgcn_exp2f(-(float)(hi * 8 + e) * (13.287712379549449f / 16.0f)); const float ang = pos * inv;
                    const float c = __cosf(ang), s = __sinf(ang); const float f1 = bf2f((unsigned short)x1[e]), f2 = bf2f((unsigned short)x2[e]);
                    x1[e] = (short)f2bf(f1 * c - f2 * s); x2[e] = (short)f2bf(f1 * s + f2 * c); }
                qr[8 + dd] = x1; qr[10 + dd] = x2; }
        }
#pragma unroll
        for (int d0 = QREG; d0 < ND0; ++d0) *(LAS bf16x8*)(qx + (d0 - QREG) * 1024) = qr[d0];
        asm volatile("s_waitcnt lgkmcnt(0)" ::: "memory");
    }
    int koff[KPT], klds[KPT], voff[VPT], vlds[VPT];
#pragma unroll
    for (int i = 0; i < KPT; ++i) { const int q = tid + 512 * i, row = q / NKC, ch = q % NKC; koff[i] = row * a.ld + (ch < 16 ? a.kc0 + 8 * ch : a.kc1 + 8 * (ch - 16)); klds[i] = kswz<DK>(row, ch); }
#pragma unroll
    for (int i = 0; i < VPT; ++i) { const int q = tid + 512 * i, row = q / NVC, ch = q % NVC; voff[i] = row * a.ld + a.vc + 8 * ch; vlds[i] = v_st<NCB>(row, 8 * ch); }
    const int vb0 = (int)(uintptr_t)V_lds + v_rd_base(lane);
    bf16x8 sk[SDEPTH][KPT], sv[SDEPTH][VPT];
    const int NT = a.n0 + a.n1;
#define TROW(j) ((j) < a.n0 ? a.row0 + 64 * (j) : a.row1 + 64 * ((j) - a.n0))
#define SLOAD(i, j) do { const bf16* _b = a.KV + (long)TROW(j) * a.ld; \
    _Pragma("unroll") for (int _k = 0; _k < VPT; ++_k) sv[i][_k] = *(const bf16x8*)(_b + voff[_k]); \
    _Pragma("unroll") for (int _k = 0; _k < KPT; ++_k) sk[i][_k] = *(const bf16x8*)(_b + koff[_k]); } while (0)
#define SWRITE(b, i) do { \
    _Pragma("unroll") for (int _k = 0; _k < VPT; ++_k) *(LAS bf16x8*)(V_lds + (b) * SHM_V + vlds[_k]) = sv[i][_k]; \
    _Pragma("unroll") for (int _k = 0; _k < KPT; ++_k) *(LAS bf16x8*)(K_lds + (b) * SHM_K + klds[_k]) = sk[i][_k]; } while (0)
#define SWAIT() do { if constexpr (SDEPTH == 2) asm volatile("s_waitcnt vmcnt(%0)" :: "n"(KPT + VPT) : "memory"); else asm volatile("s_waitcnt vmcnt(0)" ::: "memory"); } while (0)
#define RESC(al) do { if (__any((al) < 1.f)) { if (hi == 0) al_l[r32] = (al); asm volatile("s_waitcnt lgkmcnt(0)" ::: "memory"); \
    _Pragma("unroll") for (int d = 0; d < NCB; ++d) _Pragma("unroll") for (int r = 0; r < 16; ++r) o[d][r] *= al_l[crow(r, hi)]; } } while (0)
    f32x16 pA0, pA1, pB0, pB1; float mnA, mnB, alA, alB; bf16x8 pa0, pa1, pa2, pa3;
    constexpr int SE = 0, SO = SDEPTH - 1;
    SLOAD(SE, 0); asm volatile("s_waitcnt vmcnt(0)" ::: "memory"); SWRITE(0, SE); __syncthreads();
    qkt<DK, QREG>(pA0, pA1, K_lds, qr, qx, r32, hi); apply_mask<MODE>(pA0, pA1, a, 0, wid, r32, hi); partialSM(pA0, pA1, m_reg, mnA, alA, a.C, a.thr);
    SLOAD(SO, 1); if constexpr (SDEPTH == 2) { if (2 < NT) SLOAD(SE, 2); }
    SWAIT(); SWRITE(1, SO); __syncthreads();
    for (int j = 1; j + 1 < NT; j += 2) {
        SBAR(); qkt<DK, QREG>(pB0, pB1, K_lds + SHM_K, qr, qx, r32, hi);
        finishSM(pA0, pA1, alA, l_reg, pa0, pa1, pa2, pa3); SBAR();
        SLOAD(SO, j + SDEPTH); SBAR();
        pv_all<NCB>(o, vb0, pa0, pa1, pa2, pa3); if constexpr (MODE != 0) SBAR(); apply_mask<MODE>(pB0, pB1, a, j, wid, r32, hi); if constexpr (MODE != 0) SBAR(); partialSM(pB0, pB1, m_reg, mnB, alB, a.C, a.thr);
        __syncthreads(); SWAIT(); SWRITE(0, SE);
        RESC(alB); __syncthreads();
        SBAR(); qkt<DK, QREG>(pA0, pA1, K_lds, qr, qx, r32, hi);
        finishSM(pB0, pB1, alB, l_reg, pa0, pa1, pa2, pa3); SBAR();
        if (SDEPTH == 1 || j + 3 < NT) SLOAD(SE, j + 1 + SDEPTH); SBAR();
        pv_all<NCB>(o, vb0 + SHM_V, pa0, pa1, pa2, pa3); if constexpr (MODE != 0) SBAR(); apply_mask<MODE>(pA0, pA1, a, j + 1, wid, r32, hi); if constexpr (MODE != 0) SBAR(); partialSM(pA0, pA1, m_reg, mnA, alA, a.C, a.thr);
        __syncthreads(); SWAIT(); SWRITE(1, SO);
        RESC(alA); __syncthreads();
    }
    SBAR(); qkt<DK, QREG>(pB0, pB1, K_lds + SHM_K, qr, qx, r32, hi);
    finishSM(pA0, pA1, alA, l_reg, pa0, pa1, pa2, pa3); SBAR();
    pv_all<NCB>(o, vb0, pa0, pa1, pa2, pa3); if constexpr (MODE != 0) SBAR(); apply_mask<MODE>(pB0, pB1, a, NT - 1, wid, r32, hi); if constexpr (MODE != 0) SBAR(); partialSM(pB0, pB1, m_reg, mnB, alB, a.C, a.thr);
    __syncthreads(); RESC(alB);
    finishSM(pB0, pB1, alB, l_reg, pa0, pa1, pa2, pa3); SBAR();
    pv_all<NCB>(o, vb0 + SHM_V, pa0, pa1, pa2, pa3);
    if constexpr (MODE == 1) { if (a.has_sink) l_reg += __builtin_amdgcn_exp2f(a.sinkl2 - m_reg * a.C); }
    if (hi == 0) li_l[r32] = l_reg; asm volatile("s_waitcnt lgkmcnt(0)" ::: "memory");
    float rli[16];
#pragma unroll
    for (int r = 0; r < 16; ++r) rli[r] = __builtin_amdgcn_rcpf(li_l[crow(r, hi)]);
    bf16* Ow = a.O + (long)(wid * QBLK) * a.ldo;
#pragma unroll
    for (int r = 0; r < 16; ++r) { const int orow = crow(r, hi);
#pragma unroll
        for (int d0 = 0; d0 < NCB; ++d0) Ow[(long)orow * a.ldo + d0 * 32 + r32] = f2bf(o[d0][r] * rli[r]); }
    __syncthreads();
#undef TROW
#undef SLOAD
#undef SWRITE
#undef SWAIT
#undef RESC
}
#undef SBAR
}
constexpr int DM = 2048, NBATCH = 4, SEQ = 4096, NCTX = 256, DEPTH = 2;
constexpr int ML = NBATCH * SEQ, MC = NBATCH * NCTX, MT = ML + MC;
constexpr int INW = 3904, UW = 4096, QW = 1856;
constexpr int MODW = 6 * DM;
constexpr float LN_EPS = 1e-5f, RMS_EPS = 1e-6f;
constexpr float ALPHA = 1.4142135623730951f;
constexpr float LOG2E = 1.4426950408889634f;
constexpr float A_SCALE = 0.07216878364870323f, B_SCALE = 0.125f, C_SCALE = 0.08838834764831845f, D_SCALE = 0.08838834764831845f;
constexpr int U_CQ = 0, U_CKV = 384, U_KR = 512, U_BQ = 576, U_BK = 1088, U_BV = 1216, U_CQQ = 1344, U_CK = 1856, U_CV = 2368, U_DQ = 2880, U_DK = 3392, U_DV = 3648;
constexpr int QA_Q = 0, QA_KV = 768, QA_KR = 1792;

constexpr size_t MiB = 1u << 20;
constexpr size_t WS_CTL = 0, CTL_ZERO_BYTES = 1 * MiB;
constexpr size_t WS_MOD = 1 * MiB;
constexpr size_t WS_CTAB = 2 * MiB;
constexpr size_t WS_SUBK = 4 * MiB;
constexpr size_t WS_WUP = 5 * MiB;
constexpr size_t WS_WIN = 9 * MiB;
constexpr size_t WS_WC = 41 * MiB;
constexpr size_t WS_WO = 121 * MiB;
constexpr size_t WS_WPQ = 137 * MiB;
constexpr size_t WS_PU = 153 * MiB;
constexpr size_t WS_PV = 281 * MiB;
constexpr size_t WS_BUFA = 409 * MiB;
constexpr size_t WS_BUFB = 477 * MiB;
constexpr size_t WS_UREG = 545 * MiB;
constexpr size_t WS_QKVA = 681 * MiB;
constexpr size_t WS_OQP = 743 * MiB;
constexpr size_t WS_XRES = 811 * MiB;
constexpr size_t WS_EIDX = 947 * MiB;
constexpr size_t WS_EG = 956 * MiB;
constexpr size_t WS_MODP = 965 * MiB;
constexpr size_t WS_DBG = 973 * MiB;
constexpr size_t WS_END = 974 * MiB;
constexpr size_t STASH_WG = 131072, P_WG = 262144, WS_STASH = WS_UREG, WS_P = WS_UREG + 32 * MiB;
constexpr int CW_TMO = 0, CW_BAR = 4096;

constexpr int NWAVES = 8;
constexpr int RING_OFF = 0, RING_BYTES = 155648;
constexpr int LDSCTL_OFF = RING_BYTES, MISC_OFF = LDSCTL_OFF + 320;
constexpr int LDS_BYTES = 157696;

#define RLX_AGENT __ATOMIC_RELAXED, __HIP_MEMORY_SCOPE_AGENT
#define LDS_WAIT() asm volatile("s_waitcnt lgkmcnt(0)" ::: "memory")
#define VM_WAIT() asm volatile("s_waitcnt vmcnt(0)" ::: "memory")

#define XB_TMO      128
#define XB_XCNT(j)  (256  + 64 * (j))
#define XB_XSUB(j)  (1280 + 64 * (j))
#define XB_XGEN(j)  (2304 + 64 * (j))
#define XB_TOP      3328
#define XB_TOPGEN   3392
#define XCD_BAR_WORDS 3456
#define XB_SPIN_CAP (1u << 22)
__device__ __forceinline__ unsigned xb_ld(unsigned* p)              { return __hip_atomic_load(p, __ATOMIC_RELAXED, __HIP_MEMORY_SCOPE_AGENT); }
__device__ __forceinline__ unsigned xb_add(unsigned* p, unsigned v) { return __hip_atomic_fetch_add(p, v, __ATOMIC_RELAXED, __HIP_MEMORY_SCOPE_AGENT); }
__device__ __forceinline__ unsigned xb_xcc_id() { return (unsigned)__builtin_amdgcn_s_getreg((3 << 11) | 20) & 0xFu; }
#define XB_SPIN(cond, bar) do { unsigned _sp = 0; while (cond) { __builtin_amdgcn_s_sleep(1); \
    if ((++_sp & 255u) == 0u) { if (xb_ld(&(bar)[XB_TMO])) break; if (_sp > XB_SPIN_CAP) { atomicAdd(&(bar)[XB_TMO], 1u); break; } } } } while (0)
struct XcdBarrier { unsigned* bar; unsigned x; volatile LAS unsigned* st; };
__device__ __forceinline__ XcdBarrier xcd_barrier_post(unsigned* bar, volatile LAS unsigned* st) {
    XcdBarrier b; b.bar = bar; b.x = xb_xcc_id(); b.st = st;
    if (threadIdx.x == 0) (void)xb_add(&bar[XB_XCNT(b.x)], 1u);
    return b;
}
__device__ __forceinline__ void xcd_barrier_complete(unsigned* bar, unsigned x, unsigned& nloc, unsigned& nx) {
    const unsigned G = gridDim.x * gridDim.y * gridDim.z;
    unsigned sum, cnt, mine, sp = 0u;
    for (;;) {
        sum = 0u; cnt = 0u; mine = 0u;
#pragma unroll
        for (unsigned j = 0; j < 16; ++j) { const unsigned c = xb_ld(&bar[XB_XCNT(j)]); sum += c; cnt += (c > 0u) ? 1u : 0u; mine = (j == x) ? c : mine; }
        if (sum == G) break;
        __builtin_amdgcn_s_sleep(1);
        if ((++sp & 255u) == 0u) { if (xb_ld(&bar[XB_TMO])) break; if (sp > XB_SPIN_CAP) { atomicAdd(&bar[XB_TMO], 1u); break; } }
    }
    nloc = mine > 0u ? mine : 1u; nx = cnt > 0u ? cnt : 1u;
}
__device__ __forceinline__ void xcd_barrier(const XcdBarrier& b) {
    asm volatile("s_waitcnt vmcnt(0)" ::: "memory");
    __syncthreads();
    if (threadIdx.x == 0) {
        unsigned* bar = b.bar;
        __builtin_amdgcn_s_waitcnt(0);
        unsigned nloc = b.st[0], nx = b.st[1];
        if (nloc == 0u) { xcd_barrier_complete(bar, b.x, nloc, nx); b.st[0] = nloc; b.st[1] = nx; }
        const unsigned old = xb_add(&bar[XB_XSUB(b.x)], 1u);
        const unsigned gen = old / nloc;
        if (old + 1u == (gen + 1u) * nloc) {
            __builtin_amdgcn_fence(__ATOMIC_RELEASE, "agent");
            asm volatile("s_waitcnt vmcnt(0)" ::: "memory");
            const unsigned og = xb_add(&bar[XB_TOP], 1u);
            const unsigned tg = og / nx;
            if (og + 1u == (tg + 1u) * nx) xb_add(&bar[XB_TOPGEN], 1u);
            else XB_SPIN(xb_ld(&bar[XB_TOPGEN]) == tg, bar);
            __builtin_amdgcn_fence(__ATOMIC_ACQUIRE, "agent");
            xb_add(&bar[XB_XGEN(b.x)], 1u);
            asm volatile("s_waitcnt vmcnt(0)" ::: "memory");
        } else {
            XB_SPIN(xb_ld(&bar[XB_XGEN(b.x)]) == gen, bar);
            __builtin_amdgcn_fence(__ATOMIC_ACQUIRE, "agent");
            asm volatile("s_waitcnt vmcnt(0)" ::: "memory");
        }
    }
    __syncthreads();
}

struct In {
    const float *x, *c, *ctx, *c_ctx, *w_ada, *b_ada, *w_in, *a_q_norm, *a_kv_norm, *a_w_uq, *a_w_ukv, *b_sink, *c_rpb, *d_q_norm, *d_k_norm,
                *w_branch, *w_gate, *b_gate, *w_out, *ln1_g, *ln1_b, *ln2_g, *ln2_b, *peer_w_q, *peer_sub_keys, *peer_u, *peer_v;
};
struct Args { In in; float* out; unsigned char* ws; int ph_lo, ph_hi, li, pad; };
struct Frame { LAS unsigned char* lds; int tid, lane, wave, vcu, G; GAS unsigned char* ws; };
template <class T> __device__ __forceinline__ T* G(T* p) { return (T*)(GAS T*)p; }
typedef const __attribute__((address_space(4))) Args& KA;
typedef const __attribute__((address_space(4))) Args* KAP;
__device__ __forceinline__ KAP kargs() { KAP p = (KAP)__builtin_amdgcn_kernarg_segment_ptr(); asm volatile("" : "+s"(p)); return p; }

__device__ __forceinline__ float wave_sum(float v) {
#pragma unroll
    for (int o = 1; o < 64; o <<= 1) v += __shfl_xor(v, o);
    return v;
}
__device__ __forceinline__ unsigned pk2(float lo, float hi) { return cvt_pk_bf16(lo, hi); }
__device__ __forceinline__ float silu_f(float v) { return v / (1.0f + __expf(-v)); }

__device__ __forceinline__ void p0_transpose_item(const float* W, int ldw, int nblk, bf16* dst, int dpitch, int row_off, int col_off, const float* gain, LAS float* scr, int item, int lane) {
    const int kb = item / nblk, nb = item % nblk, k0 = 64 * kb, n0 = 32 * nb;
#pragma unroll 8
    for (int i = 0; i < 32; ++i) { const int kk = 2 * i + (lane >> 5); float v = W[(size_t)(k0 + kk) * ldw + n0 + (lane & 31)]; if (gain) v *= gain[k0 + kk]; scr[kk * 33 + (lane & 31)] = v; }
    LDS_WAIT(); asm volatile("" ::: "memory");
    const int c = lane & 7;
#pragma unroll
    for (int j = 0; j < 4; ++j) { const int n = (lane >> 3) + 8 * j; const LAS float* s = scr + (8 * c) * 33 + n;
        u32x4 o; o.x = pk2(s[0 * 33], s[1 * 33]); o.y = pk2(s[2 * 33], s[3 * 33]); o.z = pk2(s[4 * 33], s[5 * 33]); o.w = pk2(s[6 * 33], s[7 * 33]);
        *(GAS u32x4*)(dst + (size_t)(row_off + n0 + n) * dpitch + col_off + k0 + 8 * c) = o; }
    LDS_WAIT(); asm volatile("" ::: "memory");
}
struct TJob { const float* W; int K, N; bf16* dst; int dpitch, row_off, col_off; const float* gain; };
__device__ __forceinline__ int tjob_get(KA A, int job, TJob& t) {
    const int l = job / 13, j = job % 13; GAS unsigned char* ws = (GAS unsigned char*)A.ws; t.gain = nullptr; t.row_off = 0; t.col_off = 0;
    if (j == 0) { t.W = G(A.in.w_in) + (size_t)l * DM * INW; t.K = DM; t.N = INW; t.dst = (bf16*)(ws + WS_WIN) + (size_t)l * UW * DM; t.dpitch = DM; }
    else if (j <= 4) { const int z = j - 1; t.W = G(A.in.w_gate) + ((size_t)l * 4 + z) * DM * DM; t.K = DM; t.N = DM; t.dst = (bf16*)(ws + WS_WC) + ((size_t)l * 4 + z) * DM * 2560; t.dpitch = 2560; }
    else if (j <= 8) { const int z = j - 5; t.W = G(A.in.w_branch) + ((size_t)l * 4 + z) * 512 * DM; t.K = 512; t.N = DM; t.dst = (bf16*)(ws + WS_WC) + ((size_t)l * 4 + z) * DM * 2560; t.dpitch = 2560; t.col_off = 2048; }
    else if (j == 9) { t.W = G(A.in.w_out) + (size_t)l * DM * DM; t.K = DM; t.N = DM; t.dst = (bf16*)(ws + WS_WO) + (size_t)l * DM * DM; t.dpitch = DM; }
    else if (j == 10) { t.W = G(A.in.peer_w_q) + (size_t)l * DM * DM; t.K = DM; t.N = DM; t.dst = (bf16*)(ws + WS_WPQ) + (size_t)l * DM * DM; t.dpitch = DM; }
    else if (j == 11) { t.W = G(A.in.a_w_uq) + (size_t)l * 384 * 768; t.K = 384; t.N = 768; t.dst = (bf16*)(ws + WS_WUP) + (size_t)l * 1792 * 512; t.dpitch = 512; t.gain = G(A.in.a_q_norm) + l * 384; }
    else { t.W = G(A.in.a_w_ukv) + (size_t)l * 128 * 1024; t.K = 128; t.N = 1024; t.dst = (bf16*)(ws + WS_WUP) + (size_t)l * 1792 * 512; t.dpitch = 512; t.row_off = 768; t.col_off = 384; t.gain = G(A.in.a_kv_norm) + l * 128; }
    return (t.K / 64) * (t.N / 32);
}
__device__ __forceinline__ void p0_prologue(const Frame& F, KA A) {
    GAS unsigned char* ws = F.ws;
    const int gw = F.vcu * NWAVES + F.wave, NGW = F.G * NWAVES;
    const long gt = (long)gw * 64 + F.lane, NGT = (long)NGW * 64;
    {
        float* modp = (float*)(ws + WS_MODP);
        for (int it = gw; it < 2 * 16 * 48; it += NGW) {
            const int l = it / 768, ks = (it % 768) / 48, cg = it % 48, n = cg * 256 + F.lane * 4;
            const float* w = G(A.in.w_ada) + ((size_t)l * DM + ks * 128) * MODW + n;
            f32x4 acc[5];
#pragma unroll
            for (int r = 0; r < 5; ++r) acc[r] = (f32x4){0.f, 0.f, 0.f, 0.f};
#pragma unroll 8
            for (int k = 0; k < 128; ++k) {
                const f32x4 wv = *(const f32x4*)(w + (size_t)k * MODW);
                const int kk = ks * 128 + k;
#pragma unroll
                for (int r = 0; r < 5; ++r) { const float cv = (r < 4) ? G(A.in.c)[r * DM + kk] : G(A.in.c_ctx)[kk]; acc[r] += wv * silu_f(cv); }
            }
#pragma unroll
            for (int r = 0; r < 5; ++r) *(f32x4*)(modp + (((size_t)ks * 2 + l) * 5 + r) * MODW + n) = acc[r];
        }
    }
    {
        LAS float* scr = (LAS float*)(F.lds + RING_OFF + F.wave * 16384);
        int base = 0;
        for (int job = 0; job < 26; ++job) {
            TJob t; const int ni = tjob_get(A, job, t);
            int first = gw - (base % NGW); if (first < 0) first += NGW;
            for (int i = first; i < ni; i += NGW) p0_transpose_item(t.W, t.N, t.N / 32, t.dst, t.dpitch, t.row_off, t.col_off, t.gain, scr, i, F.lane);
            base += ni;
        }
    }
    for (long i = gt; i < 2L * 192 * 2048 / 8; i += NGT) { const int l = (int)(i / (192 * 256)), r = (int)(i % (192 * 256)); *(u32x4*)((bf16*)(ws + WS_WIN) + ((size_t)l * UW + 3904) * DM + (size_t)r * 8) = (u32x4){0u, 0u, 0u, 0u}; }
    for (long i = gt; i < 2L * 768 * 16; i += NGT) { const int l = (int)(i / (768 * 16)), r = (int)(i % (768 * 16)), row = r / 16, c8 = r % 16; *(u32x4*)((bf16*)(ws + WS_WUP) + ((size_t)l * 1792 + row) * 512 + 384 + c8 * 8) = (u32x4){0u, 0u, 0u, 0u}; }
    for (long i = gt; i < 2L * 1024 * 48; i += NGT) { const int l = (int)(i / (1024 * 48)), r = (int)(i % (1024 * 48)), row = r / 48, c8 = r % 48; *(u32x4*)((bf16*)(ws + WS_WUP) + ((size_t)l * 1792 + 768 + row) * 512 + c8 * 8) = (u32x4){0u, 0u, 0u, 0u}; }
    {
        const long n_sk = 2L * 8 * 2 * 128 * 128 / 8, n_pu = 2L * 16384 * 2048 / 8;
        for (long i = gt; i < n_sk + 2 * n_pu; i += NGT) {
            const float* src; bf16* dst; long j = i;
            if (j < n_sk) { src = G(A.in.peer_sub_keys); dst = (bf16*)(ws + WS_SUBK); }
            else if ((j -= n_sk) < n_pu) { src = G(A.in.peer_u); dst = (bf16*)(ws + WS_PU); }
            else { j -= n_pu; src = G(A.in.peer_v); dst = (bf16*)(ws + WS_PV); }
            const f32x4 a = __builtin_nontemporal_load((const f32x4*)(src + j * 8)), b = __builtin_nontemporal_load((const f32x4*)(src + j * 8 + 4));
            u32x4 o; o.x = pk2(a[0], a[1]); o.y = pk2(a[2], a[3]); o.z = pk2(b[0], b[1]); o.w = pk2(b[2], b[3]);
            *(u32x4*)(dst + j * 8) = o;
        }
    }
    {
        float* ct = (float*)(ws + WS_CTAB);
        for (long i = gt; i < 2L * 4 * 15 * 64 * 64; i += NGT) {
            const int kc = (int)(i & 63), qc = (int)((i >> 6) & 63), r = (int)(i >> 12), dr = r % 15, lh = r / 15;
            int cs = qc - 8; cs = cs < 0 ? 0 : (cs > 48 ? 48 : cs);
            int co = kc - qc + 15; co = co < 0 ? 0 : (co > 30 ? 30 : co);
            ct[i] = (kc >= cs && kc < cs + 16) ? G(A.in.c_rpb)[((size_t)lh * 15 + dr) * 31 + co] * (1.0f / C_SCALE) : -1e30f;
        }
    }
}
__device__ __forceinline__ void p1_modreduce(const Frame& F, KA A) {
    const long gt = ((long)F.vcu * NWAVES + F.wave) * 64 + F.lane, NGT = (long)F.G * NWAVES * 64;
    const float* modp = (const float*)(F.ws + WS_MODP); float* mod = (float*)(F.ws + WS_MOD);
    for (long i = gt; i < 2L * 5 * MODW; i += NGT) { const int n = (int)(i % MODW), l = (int)(i / (5 * MODW));
        float s = G(A.in.b_ada)[l * MODW + n];
#pragma unroll
        for (int ks = 0; ks < 16; ++ks) s += modp[(size_t)ks * 2 * 5 * MODW + i];
        mod[i] = s; }
}
__device__ __forceinline__ void p2_modulate0(const Frame& F, KA A) {
    const int gw = F.vcu * NWAVES + F.wave, NGW = F.G * NWAVES;
    const float* mod = (const float*)(F.ws + WS_MOD); bf16* H = (bf16*)(F.ws + WS_BUFA);
    for (int row = gw; row < MT; row += NGW) {
        const float* xr = row < ML ? G(A.in.x) + (size_t)row * DM : G(A.in.ctx) + (size_t)(row - ML) * DM;
        const float* mr = mod + (size_t)(row < ML ? (row >> 12) : 4) * MODW;
#pragma unroll
        for (int j = 0; j < 4; ++j) { const int c = j * 512 + F.lane * 8;
            const f32x4 a = *(const f32x4*)(xr + c), b = *(const f32x4*)(xr + c + 4);
            const f32x4 sh0 = *(const f32x4*)(mr + c), sh1 = *(const f32x4*)(mr + c + 4), sc0 = *(const f32x4*)(mr + DM + c), sc1 = *(const f32x4*)(mr + DM + c + 4);
            const f32x4 y0 = a * (sc0 + 1.0f) + sh0, y1 = b * (sc1 + 1.0f) + sh1;
            u32x4 o; o.x = pk2(y0[0], y0[1]); o.y = pk2(y0[2], y0[3]); o.z = pk2(y1[0], y1[1]); o.w = pk2(y1[2], y1[3]);
            *(u32x4*)(H + (size_t)row * DM + c) = o; }
    }
}
__device__ __forceinline__ void rope_pair(float& x1, float& x2, float ang) { const float c = __cosf(ang), s = __sinf(ang); const float y1 = x1 * c - x2 * s, y2 = x1 * s + x2 * c; x1 = y1; x2 = y2; }
__device__ __forceinline__ void enorm_phase(const Frame& F, KA A, int l) {
    const int gw = F.vcu * NWAVES + F.wave, NGW = F.G * NWAVES, lane = F.lane;
    bf16* U = (bf16*)(F.ws + WS_UREG); bf16* QK = (bf16*)(F.ws + WS_QKVA);
    const float* gq = G(A.in.d_q_norm) + l * 128; const float* gk = G(A.in.d_k_norm) + l * 128;
    const float L2T = 13.287712379549449f;
    for (int row = gw; row < MT; row += NGW) {
        bf16* u = U + (size_t)row * UW;
        const bool lat = row < ML; const int t = row & 4095;
        const float prow = lat ? (float)(t >> 6) : 0.f, pcol = lat ? (float)(t & 63) : 0.f;
        { unsigned w[3]; float ss = 0.f;
#pragma unroll
          for (int i = 0; i < 3; ++i) { w[i] = ((const unsigned*)(u + U_CQ))[lane + 64 * i]; const float a = bflo(w[i]), b = bfhi(w[i]); ss += a * a + b * b; }
          const float rstd = rsqrtf(wave_sum(ss) * (1.0f / 384.0f) + RMS_EPS);
#pragma unroll
          for (int i = 0; i < 3; ++i) ((unsigned*)(u + U_CQ))[lane + 64 * i] = pk2(bflo(w[i]) * rstd, bfhi(w[i]) * rstd); }
        { const unsigned w = ((const unsigned*)(u + U_CKV))[lane]; const float a = bflo(w), b = bfhi(w);
          const float rstd = rsqrtf(wave_sum(a * a + b * b) * (1.0f / 128.0f) + RMS_EPS);
          ((unsigned*)(u + U_CKV))[lane] = pk2(a * rstd, b * rstd); }
        const int j64 = lane & 31;
        const float ang64 = ((j64 < 16) ? prow : pcol) * __builtin_amdgcn_exp2f(-(float)(j64 & 15) * (L2T / 16.0f));
        if (lane < 32) { float x1 = bf2f(u[U_KR + lane]), x2 = bf2f(u[U_KR + 32 + lane]); rope_pair(x1, x2, ang64);
            bf16* o = QK + (size_t)row * QW + QA_KR; o[lane] = f2bf(x1); o[32 + lane] = f2bf(x2); }
#pragma unroll
        for (int i = 0; i < 4; ++i) { const int p = lane + 64 * i, hd = p >> 5; bf16* q = u + U_BQ + hd * 64;
            float x1 = bf2f(q[j64]), x2 = bf2f(q[32 + j64]); rope_pair(x1, x2, ang64); q[j64] = f2bf(x1); q[32 + j64] = f2bf(x2); }
        { const int hd = lane >> 5; bf16* q = u + U_BK + hd * 64;
          float x1 = bf2f(q[j64]), x2 = bf2f(q[32 + j64]); rope_pair(x1, x2, ang64); q[j64] = f2bf(x1); q[32 + j64] = f2bf(x2); }
        const float ang128 = ((lane < 32) ? prow : pcol) * __builtin_amdgcn_exp2f(-(float)(lane & 31) * (L2T / 32.0f));
        const float gq1 = gq[lane], gq2 = gq[64 + lane], gk1 = gk[lane], gk2 = gk[64 + lane];
#pragma unroll
        for (int hd = 0; hd < 4; ++hd) { bf16* q = u + U_DQ + hd * 128; float x1 = bf2f(q[lane]), x2 = bf2f(q[64 + lane]);
            const float rstd = rsqrtf(wave_sum(x1 * x1 + x2 * x2) * (1.0f / 128.0f) + RMS_EPS);
            x1 = x1 * rstd * gq1; x2 = x2 * rstd * gq2; rope_pair(x1, x2, ang128); q[lane] = f2bf(x1); q[64 + lane] = f2bf(x2); }
#pragma unroll
        for (int hd = 0; hd < 2; ++hd) { bf16* q = u + U_DK + hd * 128; float x1 = bf2f(q[lane]), x2 = bf2f(q[64 + lane]);
            const float rstd = rsqrtf(wave_sum(x1 * x1 + x2 * x2) * (1.0f / 128.0f) + RMS_EPS);
            x1 = x1 * rstd * gk1; x2 = x2 * rstd * gk2; rope_pair(x1, x2, ang128); q[lane] = f2bf(x1); q[64 + lane] = f2bf(x2); }
    }
}
__device__ __forceinline__ void ln1_phase(const Frame& F, KA A, int l, int nrows, bf16* HF) {
    const int gw = F.vcu * NWAVES + F.wave, NGW = F.G * NWAVES, lane = F.lane;
    float* Y = (float*)(F.ws + WS_UREG); const float* mod = (const float*)(F.ws + WS_MOD) + (size_t)l * 5 * MODW;
    const float* g = G(A.in.ln1_g) + l * DM; const float* b = G(A.in.ln1_b) + l * DM;
    for (int row = gw; row < nrows; row += NGW) {
        float* y = Y + (size_t)row * DM; const float* mr = mod + (size_t)(row < ML ? (row >> 12) : 4) * MODW;
        f32x4 v[8]; float s = 0.f;
#pragma unroll
        for (int j = 0; j < 4; ++j) { const int c = j * 512 + lane * 8; v[2 * j] = *(const f32x4*)(y + c); v[2 * j + 1] = *(const f32x4*)(y + c + 4); }
#pragma unroll
        for (int j = 0; j < 8; ++j) s += (v[j][0] + v[j][1]) + (v[j][2] + v[j][3]);
        const float mean = wave_sum(s) * (1.0f / DM); float q = 0.f;
#pragma unroll
        for (int j = 0; j < 8; ++j) { v[j] = v[j] - mean; q += (v[j][0] * v[j][0] + v[j][1] * v[j][1]) + (v[j][2] * v[j][2] + v[j][3] * v[j][3]); }
        const float rstd = rsqrtf(wave_sum(q) * (1.0f / DM) + LN_EPS);
#pragma unroll
        for (int j = 0; j < 4; ++j) { const int c = j * 512 + lane * 8;
            const f32x4 x0 = v[2 * j] * rstd * *(const f32x4*)(g + c) + *(const f32x4*)(b + c), x1 = v[2 * j + 1] * rstd * *(const f32x4*)(g + c + 4) + *(const f32x4*)(b + c + 4);
            *(f32x4*)(y + c) = x0; *(f32x4*)(y + c + 4) = x1;
            const f32x4 h0 = x0 * (*(const f32x4*)(mr + 4 * DM + c) + 1.0f) + *(const f32x4*)(mr + 3 * DM + c), h1 = x1 * (*(const f32x4*)(mr + 4 * DM + c + 4) + 1.0f) + *(const f32x4*)(mr + 3 * DM + c + 4);
            u32x4 o; o.x = pk2(h0[0], h0[1]); o.y = pk2(h0[2], h0[3]); o.z = pk2(h1[0], h1[1]); o.w = pk2(h1[2], h1[3]);
            *(u32x4*)(HF + (size_t)row * DM + c) = o; }
    }
}
namespace peer {
__device__ __forceinline__ unsigned okey(float f) { const unsigned u = __float_as_uint(f); return (u & 0x80000000u) ? ~u : (u | 0x80000000u); }
__device__ __forceinline__ float ikey(unsigned k) { const unsigned u = (k & 0x80000000u) ? (k & 0x7fffffffu) : ~k; return __uint_as_float(u); }
#define CE_DESC(a, b) do { const unsigned _mx = (a) > (b) ? (a) : (b), _mn = (a) > (b) ? (b) : (a); (a) = _mx; (b) = _mn; } while (0)
#define CE_ASC(a, b)  do { const unsigned _mx = (a) > (b) ? (a) : (b), _mn = (a) > (b) ? (b) : (a); (a) = _mn; (b) = _mx; } while (0)
__device__ __forceinline__ void sort16_desc(unsigned (&k)[16]) {
#pragma unroll
    for (int size = 2; size <= 16; size <<= 1)
#pragma unroll
        for (int stride = size >> 1; stride > 0; stride >>= 1)
#pragma unroll
            for (int i = 0; i < 16; ++i) { const int p = i ^ stride; if (p > i) { if ((i & size) == 0) CE_DESC(k[i], k[p]); else CE_ASC(k[i], k[p]); } }
}
__device__ __forceinline__ void merge16_desc(unsigned (&a)[16], const unsigned (&b)[16]) {
#pragma unroll
    for (int i = 0; i < 16; ++i) a[i] = a[i] > b[15 - i] ? a[i] : b[15 - i];
#pragma unroll
    for (int stride = 8; stride > 0; stride >>= 1)
#pragma unroll
        for (int i = 0; i < 16; ++i) { const int p = i ^ stride; if (p > i) CE_DESC(a[i], a[p]); }
}
constexpr int slot_x(int s) { int n = 0; for (int x = 0; x < 16; ++x) for (int y = 0; y < 16; ++y) if ((x + 1) * (y + 1) <= 16) { if (n == s) return x; ++n; } return -1; }
constexpr int slot_y(int s) { int n = 0; for (int x = 0; x < 16; ++x) for (int y = 0; y < 16; ++y) if ((x + 1) * (y + 1) <= 16) { if (n == s) return y; ++n; } return -1; }
template <int S> struct Slot { static constexpr int x = slot_x(S), y = slot_y(S); };
template <int S> __device__ __forceinline__ void cand_one(unsigned (&c)[64], const float (&v0)[16], const float (&v1)[16], const unsigned (&i0)[16], const unsigned (&i1)[16], LAS unsigned short* tbl) {
    if constexpr (Slot<S>::x >= 0) { c[S] = (okey(v0[Slot<S>::x] + v1[Slot<S>::y]) & ~63u) | (unsigned)(63 - S); tbl[S] = (unsigned short)(i0[Slot<S>::x] * 128u + i1[Slot<S>::y]); }
    else c[S] = 0u;
}
template <int... S> __device__ __forceinline__ void cand_all(unsigned (&c)[64], const float (&v0)[16], const float (&v1)[16], const unsigned (&i0)[16], const unsigned (&i1)[16], LAS unsigned short* tbl, std::integer_sequence<int, S...>) {
    (cand_one<S>(c, v0, v1, i0, i1, tbl), ...);
}
__device__ __forceinline__ void topk_item(const bf16* QP, const bf16* SK, int* EIDX, float* EG, int tok0, int h, LAS unsigned short* tblw, int lane) {
    const int r32 = lane & 31, hi = lane >> 5;
    const bf16* qrow = QP + (size_t)(tok0 + r32) * DM + h * 256 + hi * 8;
    unsigned L[2][16];
#pragma unroll
    for (int p = 0; p < 2; ++p) {
        f32x16 acc[4];
#pragma unroll
        for (int kb = 0; kb < 4; ++kb) acc[kb] = f32x16{};
        const bf16* skp = SK + ((size_t)(h * 2 + p) * 128 + r32) * 128 + hi * 8;
#pragma unroll 2
        for (int d0 = 0; d0 < 8; ++d0) { const bf16x8 bq = *(const bf16x8*)(qrow + p * 128 + d0 * 16);
#pragma unroll
            for (int kb = 0; kb < 4; ++kb) { const bf16x8 ak = *(const bf16x8*)(skp + (size_t)kb * 32 * 128 + d0 * 16); acc[kb] = __builtin_amdgcn_mfma_f32_32x32x16_bf16(ak, bq, acc[kb], 0, 0, 0); } }
        unsigned g[4][16];
#pragma unroll
        for (int kb = 0; kb < 4; ++kb) {
#pragma unroll
            for (int r = 0; r < 16; ++r) g[kb][r] = (okey(acc[kb][r]) & ~127u) | (unsigned)(127 - (32 * kb + (r & 3) + 8 * (r >> 2) + 4 * hi));
            sort16_desc(g[kb]); }
        merge16_desc(g[0], g[1]); merge16_desc(g[2], g[3]); merge16_desc(g[0], g[2]);
        unsigned o[16];
#pragma unroll
        for (int i = 0; i < 16; ++i) o[i] = (unsigned)__shfl_xor((int)g[0][i], 32);
        merge16_desc(g[0], o);
#pragma unroll
        for (int i = 0; i < 16; ++i) L[p][i] = g[0][i];
    }
    float v0[16], v1[16]; unsigned i0[16], i1[16];
#pragma unroll
    for (int i = 0; i < 16; ++i) { v0[i] = ikey(L[0][i] & ~127u); v1[i] = ikey(L[1][i] & ~127u); i0[i] = 127u - (L[0][i] & 127u); i1[i] = 127u - (L[1][i] & 127u); }
    LAS unsigned short* tbl = tblw + lane * 66;
    unsigned c[64];
    cand_all(c, v0, v1, i0, i1, tbl, std::make_integer_sequence<int, 64>{});
    unsigned c0[16], c1[16], c2[16], c3[16];
#pragma unroll
    for (int i = 0; i < 16; ++i) { c0[i] = c[i]; c1[i] = c[16 + i]; c2[i] = c[32 + i]; c3[i] = c[48 + i]; }
    sort16_desc(c0); sort16_desc(c1); sort16_desc(c2); sort16_desc(c3);
    merge16_desc(c0, c1); merge16_desc(c2, c3); merge16_desc(c0, c2);
    LDS_WAIT(); asm volatile("" ::: "memory");
    float best[16]; int eid[16]; float sum = 0.f;
    const float mx = ikey(c0[0] & ~63u);
#pragma unroll
    for (int i = 0; i < 16; ++i) { const unsigned s = 63u - (c0[i] & 63u); eid[i] = (int)tbl[s]; best[i] = __expf(ikey(c0[i] & ~63u) - mx); sum += best[i]; }
    const float inv = 1.0f / sum;
    if (hi == 0) {
        int* ep = EIDX + (size_t)(tok0 + r32) * 128 + h * 16; float* gp = EG + (size_t)(tok0 + r32) * 128 + h * 16;
#pragma unroll
        for (int i = 0; i < 16; ++i) { ep[i] = eid[i]; gp[i] = best[i] * inv; }
    }
    LDS_WAIT(); asm volatile("" ::: "memory");
}
}
__device__ __forceinline__ float gelu_exact(float v) { return 0.5f * v * (1.0f + erff(v * 0.70710678118654752f)); }
__device__ __forceinline__ float reduce16(float (&p)[16], int lane) {
    float q[8], r[4], s[2];
    { const bool up = lane & 1;
#pragma unroll
      for (int k = 0; k < 8; ++k) { const float send = up ? p[2 * k] : p[2 * k + 1], keep = up ? p[2 * k + 1] : p[2 * k]; q[k] = keep + __shfl_xor(send, 1); } }
    { const bool up = lane & 2;
#pragma unroll
      for (int k = 0; k < 4; ++k) { const float send = up ? q[2 * k] : q[2 * k + 1], keep = up ? q[2 * k + 1] : q[2 * k]; r[k] = keep + __shfl_xor(send, 2); } }
    { const bool up = lane & 4;
#pragma unroll
      for (int k = 0; k < 2; ++k) { const float send = up ? r[2 * k] : r[2 * k + 1], keep = up ? r[2 * k + 1] : r[2 * k]; s[k] = keep + __shfl_xor(send, 4); } }
    float t;
    { const bool up = lane & 8; const float send = up ? s[0] : s[1], keep = up ? s[1] : s[0]; t = keep + __shfl_xor(send, 8); }
    t += __shfl_xor(t, 16); t += __shfl_xor(t, 32);
    return t;
}
__device__ __forceinline__ void pexp_phase(const Frame& F, KA A, int l, int ntok, const bf16* HF, float* outp, bf16* Hnext) {
    const int gw = F.vcu * NWAVES + F.wave, NGW = F.G * NWAVES, lane = F.lane;
    const bf16* PU = (const bf16*)(F.ws + WS_PU) + (size_t)l * 16384 * DM; const bf16* PV = (const bf16*)(F.ws + WS_PV) + (size_t)l * 16384 * DM;
    const int* EIDX = (const int*)(F.ws + WS_EIDX); const float* EG = (const float*)(F.ws + WS_EG);
    const float* X1 = (const float*)(F.ws + WS_UREG); const float* mod = (const float*)(F.ws + WS_MOD);
    const float* g2 = G(A.in.ln2_g) + l * DM; const float* b2 = G(A.in.ln2_b) + l * DM;
    for (int tok = gw; tok < ntok; tok += NGW) {
        float h[32], acc[32];
#pragma unroll
        for (int j = 0; j < 4; ++j) { const bf16x8 v = *(const bf16x8*)(HF + (size_t)tok * DM + j * 512 + lane * 8);
#pragma unroll
            for (int e = 0; e < 8; ++e) { h[j * 8 + e] = bf2f((unsigned short)v[e]); acc[j * 8 + e] = 0.f; } }
#pragma unroll 1
        for (int sb = 0; sb < 32; ++sb) {
            const int my_e = EIDX[(size_t)tok * 128 + sb * 4 + (lane & 3)]; const float my_g = EG[(size_t)tok * 128 + sb * 4 + (lane & 3)];
            const int e0 = __builtin_amdgcn_readlane(my_e, 0), e1 = __builtin_amdgcn_readlane(my_e, 1), e2 = __builtin_amdgcn_readlane(my_e, 2), e3 = __builtin_amdgcn_readlane(my_e, 3);
            float part[4];
#pragma unroll
            for (int i = 0; i < 4; ++i) {
                const int e = i == 0 ? e0 : (i == 1 ? e1 : (i == 2 ? e2 : e3)); const bf16* ur = PU + (size_t)e * DM + lane * 8; float d = 0.f;
#pragma unroll
                for (int j = 0; j < 4; ++j) { const u32x4 w = *(const u32x4*)(ur + j * 512);
                    d += h[j * 8 + 0] * bflo(w.x) + h[j * 8 + 1] * bfhi(w.x) + h[j * 8 + 2] * bflo(w.y) + h[j * 8 + 3] * bfhi(w.y)
                       + h[j * 8 + 4] * bflo(w.z) + h[j * 8 + 5] * bfhi(w.z) + h[j * 8 + 6] * bflo(w.w) + h[j * 8 + 7] * bfhi(w.w); }
                part[i] = d;
            }
            float dot;
            { const bool u1 = lane & 1, u2 = lane & 2;
              const float q0 = (u1 ? part[1] : part[0]) + __shfl_xor(u1 ? part[0] : part[1], 1);
              const float q1 = (u1 ? part[3] : part[2]) + __shfl_xor(u1 ? part[2] : part[3], 1);
              dot = (u2 ? q1 : q0) + __shfl_xor(u2 ? q0 : q1, 2);
              dot += __shfl_xor(dot, 4); dot += __shfl_xor(dot, 8); dot += __shfl_xor(dot, 16); dot += __shfl_xor(dot, 32); }
            const float act = gelu_exact(dot) * my_g;
#pragma unroll
            for (int i = 0; i < 4; ++i) {
                const int e = i == 0 ? e0 : (i == 1 ? e1 : (i == 2 ? e2 : e3)); const float w = __uint_as_float(__builtin_amdgcn_readlane(__float_as_uint(act), i));
                const bf16* vr = PV + (size_t)e * DM + lane * 8;
#pragma unroll
                for (int j = 0; j < 4; ++j) { const u32x4 x = *(const u32x4*)(vr + j * 512);
                    acc[j * 8 + 0] += w * bflo(x.x); acc[j * 8 + 1] += w * bfhi(x.x); acc[j * 8 + 2] += w * bflo(x.y); acc[j * 8 + 3] += w * bfhi(x.y);
                    acc[j * 8 + 4] += w * bflo(x.z); acc[j * 8 + 5] += w * bfhi(x.z); acc[j * 8 + 6] += w * bflo(x.w); acc[j * 8 + 7] += w * bfhi(x.w); }
            }
        }
        const int bidx = tok < ML ? (tok >> 12) : 4;
        const float* mr = mod + ((size_t)l * 5 + bidx) * MODW; const float* x1 = X1 + (size_t)tok * DM;
        float s = 0.f;
#pragma unroll
        for (int j = 0; j < 4; ++j) { const int c = j * 512 + lane * 8;
            const f32x4 xa = *(const f32x4*)(x1 + c), xb = *(const f32x4*)(x1 + c + 4), ga = *(const f32x4*)(mr + 5 * DM + c), gb = *(const f32x4*)(mr + 5 * DM + c + 4);
#pragma unroll
            for (int e = 0; e < 4; ++e) { acc[j * 8 + e] = ALPHA * xa[e] + ga[e] * acc[j * 8 + e]; acc[j * 8 + 4 + e] = ALPHA * xb[e] + gb[e] * acc[j * 8 + 4 + e]; s += acc[j * 8 + e] + acc[j * 8 + 4 + e]; } }
        const float mean = wave_sum(s) * (1.0f / DM); float q = 0.f;
#pragma unroll
        for (int k = 0; k < 32; ++k) { acc[k] -= mean; q += acc[k] * acc[k]; }
        const float rstd = rsqrtf(wave_sum(q) * (1.0f / DM) + LN_EPS);
        const float* mn = mod + ((size_t)(l + 1 < DEPTH ? l + 1 : l) * 5 + bidx) * MODW;
#pragma unroll
        for (int j = 0; j < 4; ++j) { const int c = j * 512 + lane * 8;
            const f32x4 ga = *(const f32x4*)(g2 + c), gb = *(const f32x4*)(g2 + c + 4), ba = *(const f32x4*)(b2 + c), bb = *(const f32x4*)(b2 + c + 4);
            f32x4 ya, yb;
#pragma unroll
            for (int e = 0; e < 4; ++e) { ya[e] = acc[j * 8 + e] * rstd * ga[e] + ba[e]; yb[e] = acc[j * 8 + 4 + e] * rstd * gb[e] + bb[e]; }
            *(f32x4*)(outp + (size_t)tok * DM + c) = ya; *(f32x4*)(outp + (size_t)tok * DM + c + 4) = yb;
            if (Hnext) { const f32x4 sa = *(const f32x4*)(mn + DM + c), sb = *(const f32x4*)(mn + DM + c + 4), ha = *(const f32x4*)(mn + c), hb = *(const f32x4*)(mn + c + 4);
                const f32x4 za = ya * (sa + 1.0f) + ha, zb = yb * (sb + 1.0f) + hb;
                u32x4 o; o.x = pk2(za[0], za[1]); o.y = pk2(za[2], za[3]); o.z = pk2(zb[0], zb[1]); o.w = pk2(zb[2], zb[3]);
                *(u32x4*)(Hnext + (size_t)tok * DM + c) = o; }
        }
    }
}

#ifndef SD_A
#define SD_A 1
#endif
#ifndef SD_D
#define SD_D 1
#endif
#ifndef SD_B
#define SD_B 2
#endif
#ifndef SD_C
#define SD_C 1
#endif
#ifndef ATT_MASK
#define ATT_MASK 15
#endif
template <int TYPE> __device__ __forceinline__ att::Args make_att_args(const Frame& F, KA A, int l, int idx, bool ctxq) {
    const bf16* U = (const bf16*)(F.ws + WS_UREG); const bf16* QK = (const bf16*)(F.ws + WS_QKVA); bf16* O = (bf16*)(F.ws + WS_OQP);
    constexpr int NH = (TYPE == 2) ? 8 : 4;
    int b, h, qb;
    if (ctxq) { b = idx / NH; h = idx % NH; qb = 0; } else { b = idx / (NH * 16); h = (idx >> 4) % NH; qb = idx & 15; }
    const int row = ctxq ? ML + b * NCTX : b * SEQ + qb * 256;
    att::Args a{};
    a.ldo = DM; a.qpos0 = qb * 256;
    if (ctxq) { a.n0 = 4; a.row0 = ML + b * NCTX; a.n1 = 0; a.row1 = 0; }
    if constexpr (TYPE == 0) {
        a.Q = QK + (size_t)row * QW + QA_Q + h * 192; a.ldq = QW; a.KV = QK; a.ld = QW; a.kc0 = QA_KV + h * 256; a.kc1 = QA_KR; a.vc = QA_KV + h * 256 + 128;
        a.O = O + (size_t)row * DM + h * 128; a.C = A_SCALE * LOG2E; a.thr = 8.0f / A_SCALE; a.qrope = ctxq ? 0 : 1;
        if (!ctxq) { a.n0 = 64; a.row0 = b * SEQ; a.n1 = 4; a.row1 = ML + b * NCTX; }
    } else if constexpr (TYPE == 1) {
        const int kvh = h >> 1;
        a.Q = U + (size_t)row * UW + U_DQ + h * 128; a.ldq = UW; a.KV = U; a.ld = UW; a.kc0 = U_DK + kvh * 128; a.kc1 = 0; a.vc = U_DV + kvh * 128;
        a.O = O + (size_t)row * DM + 1536 + h * 128; a.C = D_SCALE * LOG2E; a.thr = 8.0f / D_SCALE;
        if (!ctxq) { a.n0 = 64; a.row0 = b * SEQ; a.n1 = 4; a.row1 = ML + b * NCTX; }
    } else if constexpr (TYPE == 2) {
        const int kvh = h >> 2;
        a.Q = U + (size_t)row * UW + U_BQ + h * 64; a.ldq = UW; a.KV = U; a.ld = UW; a.kc0 = U_BK + kvh * 64; a.kc1 = 0; a.vc = U_BV + kvh * 64;
        a.O = O + (size_t)row * DM + 512 + h * 64; a.C = B_SCALE * LOG2E; a.thr = 8.0f / B_SCALE; a.has_sink = 1; a.sinkl2 = G(A.in.b_sink)[l * 8 + h] * LOG2E;
        if (!ctxq) { int ws = qb * 256 - 128; ws = ws < 0 ? 0 : ws; int we = qb * 256 + 384; we = we > SEQ ? SEQ : we;
            a.n0 = 4; a.row0 = ML + b * NCTX; a.n1 = (we - ws) / 64; a.row1 = b * SEQ + ws; a.wpos0 = ws; }
    } else {
        a.Q = U + (size_t)row * UW + U_CQQ + h * 128; a.ldq = UW; a.KV = U; a.ld = UW; a.kc0 = U_CK + h * 128; a.kc1 = 0; a.vc = U_CV + h * 128;
        a.O = O + (size_t)row * DM + 1024 + h * 128; a.C = C_SCALE * LOG2E; a.thr = 8.0f / C_SCALE;
        a.T = (const float*)(F.ws + WS_CTAB) + (size_t)((l * 4 + h) * 15) * 4096;
        if (!ctxq) { const int r0 = qb * 4; int kr0 = r0 - 4; kr0 = kr0 < 0 ? 0 : (kr0 > 56 ? 56 : kr0); int ke = r0 + 3 - 4; ke = ke < 0 ? 0 : (ke > 56 ? 56 : ke); ke += 7; const int nr = ke - kr0 + 1;
            a.n0 = 4; a.row0 = ML + b * NCTX; a.n1 = nr + (nr & 1); a.row1 = b * SEQ + kr0 * 64; a.r0 = r0; a.kr0 = kr0; }
    }
    return a;
}
#define AF() Frame F = F0; asm volatile("" : "+v"(F.tid), "+v"(F.lane), "+s"(F.wave), "+s"(F.vcu), "+s"(F.G), "+s"(F.ws), "+s"(F.lds)); LAS char* lds = (LAS char*)(F.lds + RING_OFF); const int v = F.vcu
__device__ __forceinline__ void att_phase(const Frame& F0, int l) {
    if (F0.vcu >= 256) return;
    const bool cx = (l + 1 < DEPTH);
    if (ATT_MASK & 1) { AF(); KA A = *kargs(); const int n = 1 + ((cx && v < 16) ? 1 : 0);
        for (int k = 0; k < n; ++k) { const att::Args a = make_att_args<0>(F, A, l, k ? v : v, k != 0); att::attn_unit<192, 128, 0, SD_A>(a, lds, F.tid); } }
    if (ATT_MASK & 2) { AF(); KA A = *kargs(); const int n = 1 + ((cx && v >= 16 && v < 32) ? 1 : 0);
        for (int k = 0; k < n; ++k) { const att::Args a = make_att_args<1>(F, A, l, k ? v - 16 : v, k != 0); att::attn_unit<128, 128, 0, SD_D>(a, lds, F.tid); } }
    if (ATT_MASK & 4) { AF(); KA A = *kargs(); const int n = 2 + ((cx && v >= 48 && v < 80) ? 1 : 0);
        for (int k = 0; k < n; ++k) { const att::Args a = make_att_args<2>(F, A, l, k == 2 ? v - 48 : 2 * v + k, k == 2); att::attn_unit<64, 64, 1, SD_B>(a, lds, F.tid); } }
    if (ATT_MASK & 8) { AF(); KA A = *kargs(); const int n = 1 + ((cx && v >= 32 && v < 48) ? 1 : 0);
        for (int k = 0; k < n; ++k) { const att::Args a = make_att_args<3>(F, A, l, k ? v - 32 : v, k != 0); att::attn_unit<128, 128, 2, SD_C>(a, lds, F.tid); } }
}

constexpr int N_PHASES = 3 + 10 * DEPTH;
#ifndef MK_N_LAUNCHES
#define MK_N_LAUNCHES 23
#endif
__global__ void __launch_bounds__(NWAVES * 64, 2) mk_fwd(Args args) {
    extern __shared__ __attribute__((aligned(16))) unsigned char lds_raw[];
    Frame F;
    F.lds = (LAS unsigned char*)lds_raw; F.tid = threadIdx.x; F.lane = F.tid & 63; F.wave = __builtin_amdgcn_readfirstlane(F.tid >> 6);
    F.G = gridDim.x; { const int bx = blockIdx.x; F.vcu = (F.G % 8 == 0) ? (bx % 8) * (F.G / 8) + bx / 8 : bx; }
    GAS unsigned char* ws; int lo, hi, li;
    { KAP ap = kargs(); ws = (GAS unsigned char*)ap->ws; lo = ap->ph_lo; hi = ap->ph_hi; li = ap->li; }
    F.ws = ws;
    for (int u = F.tid; u < (LDS_BYTES - LDSCTL_OFF) / 4; u += NWAVES * 64) ((LAS unsigned*)(F.lds + LDSCTL_OFF))[u] = 0u;
    __syncthreads();
    volatile LAS unsigned* MISC = (volatile LAS unsigned*)(F.lds + MISC_OFF);
    XcdBarrier bar = xcd_barrier_post((unsigned*)(ws + WS_CTL) + CW_BAR + li * XCD_BAR_WORDS, MISC + 8);
#ifndef PHASE_MASK
#define PHASE_MASK 0x1fff
#endif
#define INR(k) (lo <= (k) && (k) < hi)
#define IN(k) ((((PHASE_MASK) >> ((k) < 3 ? (k) : 3 + ((k) - 3) % 10)) & 1) && INR(k))
#define SEAM(k) do { if (INR(k) && INR((k) + 1)) xcd_barrier(bar); } while (0)
#define PF() Frame Fp = F; int bx = blockIdx.x; asm volatile("" : "+v"(Fp.tid), "+v"(Fp.lane), "+s"(Fp.wave), "+s"(Fp.vcu), "+s"(Fp.G), "+s"(Fp.ws), "+s"(Fp.lds), "+s"(bx)); GAS unsigned char* ws = Fp.ws; (void)bx; (void)ws
    if (IN(0)) { PF(); p0_prologue(Fp, *kargs()); } SEAM(0);
    if (IN(1)) { PF(); p1_modreduce(Fp, *kargs()); } SEAM(1);
    if (IN(2)) { PF(); p2_modulate0(Fp, *kargs()); } SEAM(2);
    for (int l = 0; l < DEPTH; ++l) {
        const int pb = 3 + 10 * l; const bool last = (l + 1 == DEPTH);
        const size_t offH = (l & 1) ? WS_BUFB : WS_BUFA, offS = (l & 1) ? WS_BUFA : WS_BUFB;
        const int nPl = last ? 64 : 68, nrows = last ? ML : MT;
        if (IN(pb + 0)) {
            PF(); bf16* Hb = (bf16*)(ws + offH);
            pg8::PlainSched S{(const char*)Hb, (const char*)((bf16*)(ws + WS_WIN) + (size_t)l * UW * DM), DM, DM, DM, 68, 16, Fp.G, bx};
            pg8::EpiBf16 E{(bf16*)(ws + WS_UREG), UW};
            pg8::gemm_phase(Fp.lds + RING_OFF, S, E, DM, DM, Fp.tid);
        } SEAM(pb + 0);
        if (IN(pb + 1)) { PF(); enorm_phase(Fp, *kargs(), l); } SEAM(pb + 1);
        if (IN(pb + 2)) { PF();
            pg8::PlainSched S{(const char*)(ws + WS_UREG), (const char*)((bf16*)(ws + WS_WUP) + (size_t)l * 1792 * 512), UW, 512, 512, 68, 7, Fp.G, bx};
            pg8::EpiBf16 E{(bf16*)(ws + WS_QKVA), QW};
            pg8::gemm_phase(Fp.lds + RING_OFF, S, E, UW, 512, Fp.tid);
        } SEAM(pb + 2);
        if (IN(pb + 3)) { PF(); att_phase(Fp, l); } SEAM(pb + 3);
        if (IN(pb + 4)) { PF(); bf16* Hb = (bf16*)(ws + offH); bf16* Sb = (bf16*)(ws + offS);
            pg8::MergeSched S{(const char*)Hb, (const char*)(ws + WS_OQP), (const char*)((bf16*)(ws + WS_WC) + (size_t)l * 4 * DM * 2560), nPl, Fp.G, bx};
            pg8::EpiMerge E{Sb, G(kargs()->in.b_gate) + (size_t)l * 4 * DM, (char*)(ws + WS_STASH) + (size_t)bx * STASH_WG, (char*)(ws + WS_P) + (size_t)bx * P_WG, Fp.tid};
            pg8::gemm_phase(Fp.lds + RING_OFF, S, E, DM, 2560, Fp.tid);
        } SEAM(pb + 4);
        if (IN(pb + 5)) { PF(); bf16* Sb = (bf16*)(ws + offS);
            pg8::PlainSched S{(const char*)Sb, (const char*)((bf16*)(ws + WS_WO) + (size_t)l * DM * DM), DM, DM, DM, nPl, 8, Fp.G, bx};
            KAP ap = kargs();
            pg8::EpiOut E{(float*)(ws + WS_UREG), l == 0 ? G(ap->in.x) : (const float*)(ws + WS_XRES), l == 0 ? G(ap->in.ctx) : (const float*)(ws + WS_XRES) + (size_t)ML * DM,
                          (const float*)(ws + WS_MOD) + (size_t)l * 5 * MODW, ALPHA};
            pg8::gemm_phase(Fp.lds + RING_OFF, S, E, DM, DM, Fp.tid);
        } SEAM(pb + 5);
        if (IN(pb + 6)) { PF(); ln1_phase(Fp, *kargs(), l, nrows, (bf16*)(ws + offH)); } SEAM(pb + 6);
        if (IN(pb + 7)) { PF(); bf16* Hb = (bf16*)(ws + offH);
            pg8::PlainSched S{(const char*)Hb, (const char*)((bf16*)(ws + WS_WPQ) + (size_t)l * DM * DM), DM, DM, DM, nPl, 8, Fp.G, bx};
            pg8::EpiBf16 E{(bf16*)(ws + WS_OQP), DM};
            pg8::gemm_phase(Fp.lds + RING_OFF, S, E, DM, DM, Fp.tid);
        } SEAM(pb + 7);
        if (IN(pb + 8)) { PF();
            const int gw = Fp.vcu * NWAVES + Fp.wave, NGW = Fp.G * NWAVES;
            LAS unsigned short* tblw = (LAS unsigned short*)(Fp.lds + RING_OFF) + Fp.wave * (64 * 66);
            for (int it = gw; it < (nrows / 32) * 8; it += NGW)
                peer::topk_item((const bf16*)(ws + WS_OQP), (const bf16*)(ws + WS_SUBK) + (size_t)l * 8 * 2 * 128 * 128, (int*)(ws + WS_EIDX), (float*)(ws + WS_EG), (it >> 3) * 32, it & 7, tblw, Fp.lane);
        } SEAM(pb + 8);
        if (IN(pb + 9)) { PF(); pexp_phase(Fp, *kargs(), l, nrows, (bf16*)(ws + offH), last ? G(kargs()->out) : (float*)(ws + WS_XRES), last ? nullptr : (bf16*)(ws + offS)); } SEAM(pb + 9);
    }
#undef IN
#undef INR
#undef SEAM
}

extern "C" void kernel_launch(void* const* d_in, const int* in_sizes, int n_in, void* d_out, int out_size, void* d_ws, size_t ws_size, hipStream_t stream) {
    static int grid = 0;
    if (grid == 0) {
        if (n_in != 27 || out_size != ML * DM || ws_size < WS_END) { fprintf(stderr, "kernel_launch: unexpected shapes (n_in %d out %d ws %zu, need ws >= %zu)\n", n_in, out_size, ws_size, (size_t)WS_END); grid = -1; return; }
        int dev = 0, cus = 0, per_cu = 0;
        if (hipGetDevice(&dev) != hipSuccess || hipDeviceGetAttribute(&cus, hipDeviceAttributeMultiprocessorCount, dev) != hipSuccess) { grid = -1; return; }
        if (hipFuncSetAttribute((const void*)mk_fwd, hipFuncAttributeMaxDynamicSharedMemorySize, LDS_BYTES) != hipSuccess) { fprintf(stderr, "kernel_launch: hipFuncSetAttribute failed\n"); grid = -1; return; }
        if (hipOccupancyMaxActiveBlocksPerMultiprocessor(&per_cu, (const void*)mk_fwd, NWAVES * 64, LDS_BYTES) != hipSuccess || per_cu < 1) { fprintf(stderr, "kernel_launch: occupancy query says %d\n", per_cu); }
        (void)hipGetLastError();
        grid = cus < 256 ? cus : 256;
    }
    if (grid < 0) return;
    (void)hipMemsetAsync((char*)d_ws + WS_CTL, 0, CTL_ZERO_BYTES, stream);
    Args a{};
    const float** ip = (const float**)&a.in;
    for (int i = 0; i < 27; ++i) ip[i] = (const float*)d_in[i];
    a.out = (float*)d_out; a.ws = (unsigned char*)d_ws;
    for (int li = 0; li < MK_N_LAUNCHES; ++li) {
        a.ph_lo = (MK_N_LAUNCHES == 1) ? 0 : li; a.ph_hi = (MK_N_LAUNCHES == 1) ? N_PHASES : li + 1; a.li = li; a.pad = 0;
        hipLaunchKernelGGL(mk_fwd, dim3(grid), dim3(NWAVES * 64), LDS_BYTES, stream, a);
    }
}
```

```cpp
#include <hip/hip_runtime.h>
#include <cstdio>
#include <cstdint>
#include <utility>

#define GAS __attribute__((address_space(1)))
#define LAS __attribute__((address_space(3)))
typedef unsigned short bf16;
typedef short bf16x8 __attribute__((ext_vector_type(8)));
typedef short s16x4 __attribute__((ext_vector_type(4)));
typedef float f32x2 __attribute__((ext_vector_type(2)));
typedef float f32x4 __attribute__((ext_vector_type(4)));
typedef float f32x16 __attribute__((ext_vector_type(16)));
typedef unsigned u32x2 __attribute__((ext_vector_type(2)));
typedef unsigned u32x4 __attribute__((ext_vector_type(4)));
typedef GAS unsigned gu32;

__device__ __forceinline__ unsigned cvt_pk_bf16(float lo, float hi) { unsigned r; asm volatile("v_cvt_pk_bf16_f32 %0, %1, %2" : "=v"(r) : "v"(lo), "v"(hi)); return r; }
__device__ __forceinline__ float bf2f(unsigned short b) { return __uint_as_float(((unsigned)b) << 16); }
__device__ __forceinline__ float bflo(unsigned w) { return __uint_as_float(w << 16); }
__device__ __forceinline__ float bfhi(unsigned w) { return __uint_as_float(w & 0xffff0000u); }
__device__ __forceinline__ unsigned short f2bf(float f) { return (unsigned short)(cvt_pk_bf16(f, 0.f) & 0xffffu); }

namespace pg8 {
constexpr int BM = 256, BK = 64, HALF = 128, HTB = HALF * BK * 2  , STAGE_BYTES = 8 * HTB, NXCD = 8, WGM = 8;
__host__ __device__ __forceinline__ int lds_byte(int r, int c) { const int st = (r >> 4) * 2 + (c >> 5), rr = r & 15, cc = c & 31, ob = rr * 64 + cc * 2; return st * 1024 + (ob ^ (((ob >> 9) & 1) << 5)); }
__host__ __device__ __forceinline__ void stage_rc(int b, int& R, int& C) { const int st = b / 1024, sb = b % 1024, swz = sb ^ (((sb >> 9) & 1) << 5); R = (st >> 1) * 16 + swz / 64; C = (st & 1) * 32 + (swz % 64) / 2; }
__host__ __device__ __forceinline__ int perm32(int rho) { const int n = rho >> 4, i = rho & 15; return 8 * (i >> 2) + 4 * n + (i & 3); }

struct Unit { int pm, pn, z; };

__device__ __forceinline__ void tile_of(int L, int nM, int nN, int& pm, int& pn) {
    const int nwg = nM * nN; int wgid = L;
    { const int q = nwg / NXCD, r = nwg % NXCD, xcd = wgid % NXCD, off = wgid / NXCD; wgid = (xcd < r ? xcd * (q + 1) : r * (q + 1) + (xcd - r) * q) + off; }
    const int nig = WGM * nN, gid = wgid / nig, fm = gid * WGM, gsz = (nM - fm) < WGM ? (nM - fm) : WGM;
    pm = fm + ((wgid % nig) % gsz); pn = (wgid % nig) / gsz;
}
struct PlainSched {
    const char* A; const char* B; int lda, ldb, K, nM, nN, G, c;
    __device__ __forceinline__ bool next(int i, Unit& u) const { const long L = (long)i * G + c; if (L >= (long)nM * nN) return false; tile_of((int)L, nM, nN, u.pm, u.pn); u.z = 0; return true; }
    __device__ __forceinline__ void ptrs(const Unit& u, const char*& a, const char*& b, int& nt) const { a = A + (size_t)u.pm * BM * lda * 2; b = B + (size_t)u.pn * BM * ldb * 2; nt = K / BK; }
};
struct MergeSched {
    const char* H; const char* O; const char* W; int nM, G, c;
    __device__ __forceinline__ bool next(int i, Unit& u) const { const long L = (long)(i >> 3) * G + c; if (L >= (long)nM * 8) return false; tile_of((int)L, nM, 8, u.pm, u.pn); u.z = i & 7; return true; }
    __device__ __forceinline__ void ptrs(const Unit& u, const char*& a, const char*& b, int& nt) const {
        const int z = u.z >> 1, kind = u.z & 1;
        a = (kind ? H : O + (size_t)z * 512 * 2) + (size_t)u.pm * BM * 2048 * 2;
        b = W + ((size_t)z * 2048 * 2560 + (size_t)u.pn * BM * 2560 + (kind ? 0 : 2048)) * 2;
        nt = kind ? 32 : 8;
    }
};

struct EpiBf16 {
    static constexpr bool PERM = true;
    bf16* O; int ldc;
    __device__ __forceinline__ void operator()(const f32x4 (&acc)[2][2][4][2], const Unit& u, int wr, int wc, int fr, int fq) const {
        const int row0 = u.pm * BM + wr * 64 + fr, col0 = u.pn * BM + wc * 32 + 8 * fq;
#pragma unroll
        for (int ai = 0; ai < 2; ++ai)
#pragma unroll
            for (int m = 0; m < 4; ++m) { bf16* rowp = O + (size_t)(row0 + ai * HALF + m * 16) * ldc + col0;
#pragma unroll
                for (int bj = 0; bj < 2; ++bj) { const f32x4 v0 = acc[ai][bj][m][0], v1 = acc[ai][bj][m][1];
                    u32x4 w; w.x = cvt_pk_bf16(v0[0], v0[1]); w.y = cvt_pk_bf16(v0[2], v0[3]); w.z = cvt_pk_bf16(v1[0], v1[1]); w.w = cvt_pk_bf16(v1[2], v1[3]);
                    *(u32x4*)(rowp + bj * HALF) = w; } }
    }
};
struct EpiMerge {
    static constexpr bool PERM = true;
    bf16* S; const float* bgate; char* stash; char* P; int tid;
    __device__ __forceinline__ void operator()(const f32x4 (&acc)[2][2][4][2], const Unit& u, int wr, int wc, int fr, int fq) const {
        const int z = u.z >> 1, kind = u.z & 1;
        GAS char* sp = (GAS char*)stash + (size_t)tid * 16;
        if (kind == 0) {
#pragma unroll
            for (int ai = 0; ai < 2; ++ai)
#pragma unroll
                for (int m = 0; m < 4; ++m)
#pragma unroll
                    for (int bj = 0; bj < 2; ++bj) { const f32x4 v0 = acc[ai][bj][m][0], v1 = acc[ai][bj][m][1];
                        u32x4 w; w.x = cvt_pk_bf16(v0[0], v0[1]); w.y = cvt_pk_bf16(v0[2], v0[3]); w.z = cvt_pk_bf16(v1[0], v1[1]); w.w = cvt_pk_bf16(v1[2], v1[3]);
                        *(GAS u32x4*)sp = w; sp += 8192; asm volatile("" : "+v"(sp)); }
            return;
        }
        GAS char* pq = (GAS char*)P + (size_t)tid * 16;
        const int row0 = u.pm * BM + wr * 64 + fr, col0 = u.pn * BM + wc * 32 + 8 * fq;
        const float* bz = bgate + z * 2048 + col0;
        f32x4 bv[2][2];
#pragma unroll
        for (int bj = 0; bj < 2; ++bj)
#pragma unroll
            for (int n = 0; n < 2; ++n) bv[bj][n] = *(const f32x4*)(bz + bj * HALF + 4 * n);
        GAS bf16* rowp = (GAS bf16*)S + (size_t)row0 * 2048 + col0;
#pragma unroll
        for (int ai = 0; ai < 2; ++ai)
#pragma unroll
            for (int m = 0; m < 4; ++m) {
#pragma unroll
                for (int bj = 0; bj < 2; ++bj) {
                    const u32x4 sw = *(const GAS u32x4*)sp; sp += 8192; asm volatile("" : "+v"(sp));
                    f32x4 v0 = acc[ai][bj][m][0] + bv[bj][0], v1 = acc[ai][bj][m][1] + bv[bj][1];
#pragma unroll
                    for (int j = 0; j < 4; ++j) { v0[j] = __builtin_amdgcn_rcpf(1.0f + __builtin_amdgcn_exp2f(-1.4426950408889634f * v0[j])); v1[j] = __builtin_amdgcn_rcpf(1.0f + __builtin_amdgcn_exp2f(-1.4426950408889634f * v1[j])); }
                    v0[0] *= bflo(sw.x); v0[1] *= bfhi(sw.x); v0[2] *= bflo(sw.y); v0[3] *= bfhi(sw.y);
                    v1[0] *= bflo(sw.z); v1[1] *= bfhi(sw.z); v1[2] *= bflo(sw.w); v1[3] *= bfhi(sw.w);
                    if (z > 0) { v0 += *(const GAS f32x4*)pq; v1 += *(const GAS f32x4*)(pq + 8192); }
                    if (z < 3) { *(GAS f32x4*)pq = v0; *(GAS f32x4*)(pq + 8192) = v1; }
                    else { u32x4 w; w.x = cvt_pk_bf16(v0[0], v0[1]); w.y = cvt_pk_bf16(v0[2], v0[3]); w.z = cvt_pk_bf16(v1[0], v1[1]); w.w = cvt_pk_bf16(v1[2], v1[3]);
                        *(GAS u32x4*)(rowp + bj * HALF) = w; }
                    pq += 16384; asm volatile("" : "+v"(pq));
                }
                rowp += (m == 3 ? (size_t)(HALF - 48) : (size_t)16) * 2048; asm volatile("" : "+v"(rowp));
                asm volatile("" ::: "memory"); }
    }
};
struct EpiOut {
    static constexpr bool PERM = false;
    float* Y; const float* xlat; const float* xctx; const float* mod_l; float alpha;
    __device__ __forceinline__ void operator()(const f32x4 (&acc)[2][2][4][2], const Unit& u, int wr, int wc, int fr, int fq) const {
        const int row0 = u.pm * BM + wr * 64 + fr, col0 = u.pn * BM + wc * 32 + 4 * fq;
        const float* xb = (u.pm < 64) ? xlat + (size_t)row0 * 2048 : xctx + (size_t)(row0 - 16384) * 2048;
        const float* ga = mod_l + (size_t)((u.pm < 64) ? (u.pm >> 4) : 4) * 12288 + 2 * 2048 + col0;
        f32x4 gv[2][2];
#pragma unroll
        for (int bj = 0; bj < 2; ++bj)
#pragma unroll
            for (int n = 0; n < 2; ++n) gv[bj][n] = *(const f32x4*)(ga + bj * HALF + n * 16);
#pragma unroll
        for (int ai = 0; ai < 2; ++ai)
#pragma unroll
            for (int m = 0; m < 4; ++m) { const size_t ro = (size_t)(ai * HALF + m * 16) * 2048 + col0; float* yp = Y + (size_t)row0 * 2048 + ro;
#pragma unroll
                for (int bj = 0; bj < 2; ++bj)
#pragma unroll
                    for (int n = 0; n < 2; ++n) { const f32x4 xv = *(const f32x4*)(xb + ro + bj * HALF + n * 16); *(f32x4*)(yp + bj * HALF + n * 16) = xv * alpha + gv[bj][n] * acc[ai][bj][m][n]; } }
    }
};

template <class Epi, class Sched>
__device__ __forceinline__ void gemm_phase(LAS unsigned char* lds, const Sched& S, const Epi& E, const int lda, const int ldb, const int tid) {
    const int wid = __builtin_amdgcn_readfirstlane(tid >> 6), lane = tid & 63, wr = wid >> 2, wc = wid & 3, fr = lane & 15, fq = lane >> 4;
    unsigned voffA[2], voffB[2];
#pragma unroll
    for (int i = 0; i < 2; ++i) { int R, C; stage_rc(tid * 16 + i * 8192, R, C); const int Rb = Epi::PERM ? ((R & ~31) + perm32(R & 31)) : R;
        voffA[i] = (unsigned)(R * lda + C) * 2u; voffB[i] = (unsigned)(Rb * ldb + C) * 2u; }
    const size_t kstep = (size_t)(BK * 2);
    const size_t hstepA = (size_t)HALF * lda * 2, hstepB = (size_t)HALF * ldb * 2;
    const unsigned ldsw = (unsigned)wid * 1024u;
    const int aoff = lds_byte(wr * 64 + fr, fq * 8), boff = lds_byte(wc * 32 + fr, fq * 8);
#define PG8_SA(b, h) (((b) * 2 + (h)) * HTB)
#define PG8_SB(b, h) ((4 + (b) * 2 + (h)) * HTB)
#define PG8_STAGE(bufoff, gbase, voff) do { _Pragma("unroll") for (int _i = 0; _i < 2; ++_i) \
        __builtin_amdgcn_global_load_lds((const unsigned*)((const char*)(gbase) + (voff)[_i]), (LAS unsigned*)(lds + (bufoff) + ldsw + _i * 8192), 16, 0, 0); } while (0)
#define PG8_LDA(dst, b, h) do { _Pragma("unroll") for (int m = 0; m < 4; ++m) _Pragma("unroll") for (int k = 0; k < 2; ++k) dst[m][k] = *(const LAS bf16x8*)(lds + PG8_SA(b, h) + aoff + m * 2048 + k * 1024); } while (0)
#define PG8_LDB(dst, b, h) do { _Pragma("unroll") for (int n = 0; n < 2; ++n) _Pragma("unroll") for (int k = 0; k < 2; ++k) dst[n][k] = *(const LAS bf16x8*)(lds + PG8_SB(b, h) + boff + n * 2048 + k * 1024); } while (0)
#define PG8_MMA(ai, bj, At, Bt) do { __builtin_amdgcn_s_setprio(1); _Pragma("unroll") for (int m = 0; m < 4; ++m) _Pragma("unroll") for (int n = 0; n < 2; ++n) _Pragma("unroll") for (int k = 0; k < 2; ++k) \
        acc[ai][bj][m][n] = __builtin_amdgcn_mfma_f32_16x16x32_bf16(Bt[n][k], At[m][k], acc[ai][bj][m][n], 0, 0, 0); __builtin_amdgcn_s_setprio(0); } while (0)
#define PG8_WAIT_V(n) asm volatile("s_waitcnt vmcnt(" #n ")" ::: "memory")
#define PG8_WAIT_L(n) asm volatile("s_waitcnt lgkmcnt(" #n ")" ::: "memory")
#define PG8_BAR __builtin_amdgcn_s_barrier()
#define PG8_SCHED __builtin_amdgcn_sched_barrier(0)
    Unit cur, nxt; int ui = 0;
    if (!S.next(0, cur)) return;
    f32x4 acc[2][2][4][2];
#pragma unroll
    for (int a = 0; a < 2; ++a)
#pragma unroll
        for (int b = 0; b < 2; ++b)
#pragma unroll
            for (int m = 0; m < 4; ++m)
#pragma unroll
                for (int n = 0; n < 2; ++n) acc[a][b][m][n] = (f32x4){0.f, 0.f, 0.f, 0.f};
    bf16x8 At[4][2], B0[2][2], B1[2][2];
    const char* cA; const char* cB; int nt; S.ptrs(cur, cA, cB, nt);
    PG8_STAGE(PG8_SB(0, 0), cB, voffB); PG8_STAGE(PG8_SB(0, 1), cB + hstepB, voffB); PG8_STAGE(PG8_SA(0, 0), cA, voffA); PG8_STAGE(PG8_SA(0, 1), cA + hstepA, voffA);
    if (wr == 1) PG8_BAR;
    PG8_WAIT_V(2); PG8_BAR;
    PG8_STAGE(PG8_SB(1, 0), cB + kstep, voffB); PG8_STAGE(PG8_SA(1, 0), cA + kstep, voffA); PG8_STAGE(PG8_SB(1, 1), cB + hstepB + kstep, voffB);
    PG8_WAIT_V(6); PG8_BAR;
    for (;;) {
        const bool has_next = S.next(ui + 1, nxt);
        const char* nA = cA; const char* nB = cB; int nnt = nt; if (has_next) S.ptrs(nxt, nA, nB, nnt);
        for (int t = 0; t < nt; t += 2) {
            const bool last = (t == nt - 2);
            const char* a1 = cA + (size_t)(t + 1) * kstep;
            const char* a2 = last ? nA : cA + (size_t)(t + 2) * kstep; const char* b2 = last ? nB : cB + (size_t)(t + 2) * kstep;
            const char* a3 = a2 + kstep; const char* b3 = b2 + kstep;
            PG8_LDB(B0, 0, 0); PG8_LDB(B1, 0, 1); PG8_SCHED; PG8_LDA(At, 0, 0); PG8_STAGE(PG8_SA(1, 1), a1 + hstepA, voffA);
            PG8_WAIT_V(8); PG8_WAIT_L(0); PG8_BAR; PG8_MMA(0, 0, At, B0); PG8_MMA(0, 1, At, B1); PG8_BAR; PG8_SCHED;
            PG8_LDA(At, 0, 1); PG8_STAGE(PG8_SB(0, 0), b2, voffB); PG8_STAGE(PG8_SB(0, 1), b2 + hstepB, voffB); PG8_STAGE(PG8_SA(0, 0), a2, voffA);
            PG8_WAIT_V(8); PG8_WAIT_L(0); PG8_BAR; PG8_MMA(1, 0, At, B0); PG8_MMA(1, 1, At, B1); PG8_BAR; PG8_SCHED;
            PG8_LDB(B0, 1, 0); PG8_LDB(B1, 1, 1); PG8_SCHED; PG8_LDA(At, 1, 0); PG8_STAGE(PG8_SA(0, 1), a2 + hstepA, voffA);
            PG8_WAIT_V(8); PG8_WAIT_L(0); PG8_BAR; PG8_MMA(0, 0, At, B0); PG8_MMA(0, 1, At, B1); PG8_BAR; PG8_SCHED;
            PG8_LDA(At, 1, 1); PG8_STAGE(PG8_SB(1, 0), b3, voffB); PG8_STAGE(PG8_SB(1, 1), b3 + hstepB, voffB); PG8_STAGE(PG8_SA(1, 0), a3, voffA);
            PG8_WAIT_V(8); PG8_WAIT_L(0); PG8_BAR; PG8_MMA(1, 0, At, B0); PG8_MMA(1, 1, At, B1); PG8_BAR; PG8_SCHED;
        }
        if (wr == 0) PG8_BAR;
        E(acc, cur, wr, wc, fr, fq);
        if (!has_next) break;
#pragma unroll
        for (int a = 0; a < 2; ++a)
#pragma unroll
            for (int b = 0; b < 2; ++b)
#pragma unroll
                for (int m = 0; m < 4; ++m)
#pragma unroll
                    for (int n = 0; n < 2; ++n) acc[a][b][m][n] = (f32x4){0.f, 0.f, 0.f, 0.f};
        cur = nxt; cA = nA; cB = nB; nt = nnt; ++ui;
        if (wr == 1) PG8_BAR;
    }
    PG8_WAIT_V(0);
    PG8_BAR;
#undef PG8_SA
#undef PG8_SB
#undef PG8_STAGE
#undef PG8_LDA
#undef PG8_LDB
#undef PG8_MMA
#undef PG8_WAIT_V
#undef PG8_WAIT_L
#undef PG8_BAR
#undef PG8_SCHED
}
}
namespace att {
constexpr int NW = 8, QBLK = 32, KVBLK = 64;
#define SBAR() __builtin_amdgcn_sched_barrier(0)
__device__ __forceinline__ int crow(int r, int hi) { return (r & 3) + 8 * (r >> 2) + 4 * hi; }
__device__ __forceinline__ unsigned cvtpk(float lo, float hi) { unsigned r; asm volatile("v_cvt_pk_bf16_f32 %0, %1, %2" : "=v"(r) : "v"(lo), "v"(hi)); return r; }

struct Args {
    const bf16* Q; int ldq;
    const bf16* KV; int ld;
    int kc0, kc1, vc;
    bf16* O; int ldo;
    int n0, n1, row0, row1;
    float C, thr;
    int qrope, qpos0;
    float sinkl2; int has_sink;
    int wpos0;
    const float* T; int r0, kr0;
};

__device__ __forceinline__ void partialSM(f32x16& p0, f32x16& p1, float& m_reg, float& mn, float& alpha, const float C, const float thr) {
    float pmax = p0[0];
#pragma unroll
    for (int r = 1; r < 16; ++r) pmax = fmaxf(pmax, p0[r]);
#pragma unroll
    for (int r = 0; r < 16; ++r) pmax = fmaxf(pmax, p1[r]);
    { auto rr = __builtin_amdgcn_permlane32_swap(__float_as_uint(pmax), __float_as_uint(pmax), false, false);
      pmax = fmaxf(__uint_as_float(rr[0]), __uint_as_float(rr[1])); }
    if (__builtin_expect(__all(pmax - m_reg <= thr), 1)) { mn = m_reg; alpha = 1.f; }
    else { mn = fmaxf(m_reg, pmax); alpha = __builtin_amdgcn_exp2f((m_reg - mn) * C); m_reg = mn; }
    const float mnC = -mn * C;
#pragma unroll
    for (int r = 0; r < 16; ++r) p0[r] = fmaf(p0[r], C, mnC);
#pragma unroll
    for (int r = 0; r < 16; ++r) p1[r] = fmaf(p1[r], C, mnC);
#pragma unroll
    for (int r = 0; r < 16; ++r) p0[r] = __builtin_amdgcn_exp2f(p0[r]);
}
__device__ __forceinline__ void finishSM(f32x16& p0, f32x16& p1, float alpha, float& l_reg, bf16x8& pa0, bf16x8& pa1, bf16x8& pa2, bf16x8& pa3) {
#pragma unroll
    for (int r = 0; r < 16; ++r) p1[r] = __builtin_amdgcn_exp2f(p1[r]);
    float ps = 0;
#pragma unroll
    for (int r = 0; r < 16; ++r) ps += p0[r];
#pragma unroll
    for (int r = 0; r < 16; ++r) ps += p1[r];
    { auto rr = __builtin_amdgcn_permlane32_swap(__float_as_uint(ps), __float_as_uint(ps), false, false);
      ps = __uint_as_float(rr[0]) + __uint_as_float(rr[1]); }
    l_reg = l_reg * alpha + ps;
#define PK4(P, BASE, OUT) do { unsigned a0 = cvtpk(P[BASE + 0], P[BASE + 1]), a1 = cvtpk(P[BASE + 2], P[BASE + 3]);   \
    unsigned b0 = cvtpk(P[BASE + 4], P[BASE + 5]), b1 = cvtpk(P[BASE + 6], P[BASE + 7]);                              \
    auto r0 = __builtin_amdgcn_permlane32_swap(a0, b0, false, false); auto r1 = __builtin_amdgcn_permlane32_swap(a1, b1, false, false); \
    u32x4 w = {r0[0], r1[0], r0[1], r1[1]}; OUT = *reinterpret_cast<bf16x8*>(&w); } while (0)
    PK4(p0, 0, pa0); PK4(p0, 8, pa1); PK4(p1, 0, pa2); PK4(p1, 8, pa3);
#undef PK4
}
template <int DK> __device__ __forceinline__ int kswz(int row, int ch) { return row * (DK * 2) + ((ch ^ (row & 7)) << 4); }
template <int DK, int QREG> __device__ __forceinline__ void qkt(f32x16& p0, f32x16& p1, const LAS char* Ks, const bf16x8* qr, const LAS char* qx, int r32, int hi) {
    p0 = f32x16{}; p1 = f32x16{};
#pragma unroll
    for (int d0 = 0; d0 < DK / 16; ++d0) { const int ch = d0 * 2 + hi;
        const bf16x8 b0 = *(const LAS bf16x8*)(Ks + kswz<DK>(r32, ch));
        const bf16x8 b1 = *(const LAS bf16x8*)(Ks + kswz<DK>(32 + r32, ch));
        bf16x8 q; if constexpr (true) { if (d0 < QREG) q = qr[d0 < QREG ? d0 : 0]; else q = *(const LAS bf16x8*)(qx + (d0 - QREG) * 1024); }
        p0 = __builtin_amdgcn_mfma_f32_32x32x16_bf16(b0, q, p0, 0, 0, 0);
        p1 = __builtin_amdgcn_mfma_f32_32x32x16_bf16(b1, q, p1, 0, 0, 0); }
}
template <int NCB> __device__ __forceinline__ int v_st(int k, int c) { const int kk = (k & ~0xC) | ((k & 4) << 1) | ((k & 8) >> 1); return ((kk >> 3) * NCB + (c >> 5)) * 512 + ((kk & 7) * 32 + (c & 31)) * 2; }
__device__ __forceinline__ int v_rd_base(int lane) { return ((lane & 3) << 3) | (((lane >> 2) & 3) << 6) | (((lane >> 4) & 1) << 5) | (((lane >> 5) & 1) << 8); }
template <int OFF> __device__ __forceinline__ s16x4 tr_read(int vb) { s16x4 r; asm volatile("ds_read_b64_tr_b16 %0, %1 offset:%2" : "=&v"(r) : "v"(vb), "i"(OFF) : "memory"); return r; }
template <int D0, int NCB> __device__ __forceinline__ void pv_one(f32x16& od, int vb, bf16x8 pa0, bf16x8 pa1, bf16x8 pa2, bf16x8 pa3) {
#define VOFF(ks, half) (D0 * 512 + (ks) * (2 * NCB * 512) + (half) * (NCB * 512))
    const s16x4 l0 = tr_read<VOFF(0, 0)>(vb), h0 = tr_read<VOFF(0, 1)>(vb), l1 = tr_read<VOFF(1, 0)>(vb), h1 = tr_read<VOFF(1, 1)>(vb);
    const s16x4 l2 = tr_read<VOFF(2, 0)>(vb), h2 = tr_read<VOFF(2, 1)>(vb), l3 = tr_read<VOFF(3, 0)>(vb), h3 = tr_read<VOFF(3, 1)>(vb);
#undef VOFF
    asm volatile("s_waitcnt lgkmcnt(0)" ::: "memory"); SBAR();
#define PK(L, H) (bf16x8){L[0], L[1], L[2], L[3], H[0], H[1], H[2], H[3]}
    od = __builtin_amdgcn_mfma_f32_32x32x16_bf16(pa0, PK(l0, h0), od, 0, 0, 0);
    od = __builtin_amdgcn_mfma_f32_32x32x16_bf16(pa1, PK(l1, h1), od, 0, 0, 0);
    od = __builtin_amdgcn_mfma_f32_32x32x16_bf16(pa2, PK(l2, h2), od, 0, 0, 0);
    od = __builtin_amdgcn_mfma_f32_32x32x16_bf16(pa3, PK(l3, h3), od, 0, 0, 0);
#undef PK
}
template <int NCB> __device__ __forceinline__ void pv_all(f32x16* o, int vb, bf16x8 pa0, bf16x8 pa1, bf16x8 pa2, bf16x8 pa3) {
    pv_one<0, NCB>(o[0], vb, pa0, pa1, pa2, pa3); pv_one<1, NCB>(o[1], vb, pa0, pa1, pa2, pa3);
    if constexpr (NCB == 4) { pv_one<2, NCB>(o[2], vb, pa0, pa1, pa2, pa3); pv_one<3, NCB>(o[3], vb, pa0, pa1, pa2, pa3); }
}

template <int MODE> __device__ __forceinline__ void apply_mask(f32x16& p0, f32x16& p1, const Args& a, int j, int wid, int r32, int hi) {
    if constexpr (MODE == 1) {
        if (j < a.n0) return;
        const int kp0 = a.wpos0 + 64 * (j - a.n0), qw0 = a.qpos0 + wid * 32;
        if (kp0 + 63 - qw0 <= 128 && qw0 + 31 - kp0 <= 128) return;
        const int dd0 = kp0 - (qw0 + r32) + 4 * hi + 128;
#pragma unroll
        for (int r = 0; r < 16; ++r) { const int dd = dd0 + (r & 3) + 8 * (r >> 2);
            p0[r] = ((unsigned)dd <= 256u) ? p0[r] : -1e30f; p1[r] = ((unsigned)(dd + 32) <= 256u) ? p1[r] : -1e30f; }
    } else if constexpr (MODE == 2) {
        if (j < a.n0) return;
        const int kr = a.kr0 + (j - a.n0), qr = a.r0 + (wid >> 1);
        int rs = qr - 4; rs = rs < 0 ? 0 : (rs > 56 ? 56 : rs);
        if (kr < rs || kr >= rs + 8) {
#pragma unroll
            for (int r = 0; r < 16; ++r) { p0[r] = -1e30f; p1[r] = -1e30f; }
            return; }
        const int dr = kr - qr + 7, qc = (wid & 1) * 32 + r32;
        const float* tb = a.T + ((size_t)(dr * 64 + qc)) * 64 + 4 * hi;
#pragma unroll
        for (int g = 0; g < 4; ++g) { const f32x4 t0 = *(const f32x4*)(tb + 8 * g), t1 = *(const f32x4*)(tb + 32 + 8 * g);
#pragma unroll
            for (int i = 0; i < 4; ++i) { p0[4 * g + i] += t0[i]; p1[4 * g + i] += t1[i]; }
            asm volatile("" ::: "memory"); }
    }
}

template <int DK, int DV, int MODE, int SDEPTH>
__device__ __forceinline__ void attn_unit(const Args& a, LAS char* lds, const int tid) {
    constexpr int NKC = DK / 8, NVC = DV / 8, KPT = DK / 64, VPT = DV / 64, NCB = DV / 32, ND0 = DK / 16, QREG = (ND0 > 8 ? 4 : ND0);
    constexpr int SHM_K = 64 * DK * 2, SHM_V = 64 * DV * 2;
    const int wid = __builtin_amdgcn_readfirstlane(tid >> 6), lane = tid & 63, r32 = lane & 31, hi = lane >> 5;
    LAS char* V_lds = lds; LAS char* K_lds = lds + 2 * SHM_V;
    LAS float* ws = (LAS float*)(lds + 2 * SHM_V + 2 * SHM_K) + wid * 64; LAS float* li_l = ws; LAS float* al_l = ws + 32;
    LAS char* qx = lds + 2 * SHM_V + 2 * SHM_K + NW * 256 + wid * ((ND0 - QREG) * 1024) + lane * 16;
    float m_reg = -1e30f, l_reg = 0; f32x16 o[NCB]; bf16x8 qr[ND0];
#pragma unroll
    for (int d = 0; d < NCB; ++d) o[d] = f32x16{};
    const bf16* Qw = a.Q + (long)(wid * QBLK + r32) * a.ldq + hi * 8;
#pragma unroll
    for (int d0 = 0; d0 < ND0; ++d0) qr[d0] = *(const bf16x8*)(Qw + d0 * 16);
    if constexpr (DK == 192) {
        if (a.qrope) {
            const int t = a.qpos0 + wid * QBLK + r32; const float prow = (float)(t >> 6), pcol = (float)(t & 63);
#pragma unroll
            for (int dd = 0; dd < 2; ++dd) {
                bf16x8 x1 = qr[8 + dd], x2 = qr[10 + dd]; const float pos = dd ? pcol : prow;
#pragma unroll
                for (int e = 0; e < 8; ++e) { const float inv = __builtin_amdgcn_exp2f(-(float)(hi * 8 + e) * (13.287712379549449f / 16.0f)); const float ang = pos * inv;
                    const float c = __cosf(ang), s = __sinf(ang); const float f1 = bf2f((unsigned short)x1[e]), f2 = bf2f((unsigned short)x2[e]);
                    x1[e] = (short)f2bf(f1 * c - f2 * s); x2[e] = (short)f2bf(f1 * s + f2 * c); }
                qr[8 + dd] = x1; qr[10 + dd] = x2; }
        }
#pragma unroll
        for (int d0 = QREG; d0 < ND0; ++d0) *(LAS bf16x8*)(qx + (d0 - QREG) * 1024) = qr[d0];
        asm volatile("s_waitcnt lgkmcnt(0)" ::: "memory");
    }
    int koff[KPT], klds[KPT], voff[VPT], vlds[VPT];
#pragma unroll
    for (int i = 0; i < KPT; ++i) { const int q = tid + 512 * i, row = q / NKC, ch = q % NKC; koff[i] = row * a.ld + (ch < 16 ? a.kc0 + 8 * ch : a.kc1 + 8 * (ch - 16)); klds[i] = kswz<DK>(row, ch); }
#pragma unroll
    for (int i = 0; i < VPT; ++i) { const int q = tid + 512 * i, row = q / NVC, ch = q % NVC; voff[i] = row * a.ld + a.vc + 8 * ch; vlds[i] = v_st<NCB>(row, 8 * ch); }
    const int vb0 = (int)(uintptr_t)V_lds + v_rd_base(lane);
    bf16x8 sk[SDEPTH][KPT], sv[SDEPTH][VPT];
    const int NT = a.n0 + a.n1;
#define TROW(j) ((j) < a.n0 ? a.row0 + 64 * (j) : a.row1 + 64 * ((j) - a.n0))
#define SLOAD(i, j) do { const bf16* _b = a.KV + (long)TROW(j) * a.ld; \
    _Pragma("unroll") for (int _k = 0; _k < VPT; ++_k) sv[i][_k] = *(const bf16x8*)(_b + voff[_k]); \
    _Pragma("unroll") for (int _k = 0; _k < KPT; ++_k) sk[i][_k] = *(const bf16x8*)(_b + koff[_k]); } while (0)
#define SWRITE(b, i) do { \
    _Pragma("unroll") for (int _k = 0; _k < VPT; ++_k) *(LAS bf16x8*)(V_lds + (b) * SHM_V + vlds[_k]) = sv[i][_k]; \
    _Pragma("unroll") for (int _k = 0; _k < KPT; ++_k) *(LAS bf16x8*)(K_lds + (b) * SHM_K + klds[_k]) = sk[i][_k]; } while (0)
#define SWAIT() do { if constexpr (SDEPTH == 2) asm volatile("s_waitcnt vmcnt(%0)" :: "n"(KPT + VPT) : "memory"); else asm volatile("s_waitcnt vmcnt(0)" ::: "memory"); } while (0)
#define RESC(al) do { if (__any((al) < 1.f)) { if (hi == 0) al_l[r32] = (al); asm volatile("s_waitcnt lgkmcnt(0)" ::: "memory"); \
    _Pragma("unroll") for (int d = 0; d < NCB; ++d) _Pragma("unroll") for (int r = 0; r < 16; ++r) o[d][r] *= al_l[crow(r, hi)]; } } while (0)
    f32x16 pA0, pA1, pB0, pB1; float mnA, mnB, alA, alB; bf16x8 pa0, pa1, pa2, pa3;
    constexpr int SE = 0, SO = SDEPTH - 1;
    SLOAD(SE, 0); asm volatile("s_waitcnt vmcnt(0)" ::: "memory"); SWRITE(0, SE); __syncthreads();
    qkt<DK, QREG>(pA0, pA1, K_lds, qr, qx, r32, hi); apply_mask<MODE>(pA0, pA1, a, 0, wid, r32, hi); partialSM(pA0, pA1, m_reg, mnA, alA, a.C, a.thr);
    SLOAD(SO, 1); if constexpr (SDEPTH == 2) { if (2 < NT) SLOAD(SE, 2); }
    SWAIT(); SWRITE(1, SO); __syncthreads();
    for (int j = 1; j + 1 < NT; j += 2) {
        SBAR(); qkt<DK, QREG>(pB0, pB1, K_lds + SHM_K, qr, qx, r32, hi);
        finishSM(pA0, pA1, alA, l_reg, pa0, pa1, pa2, pa3); SBAR();
        SLOAD(SO, j + SDEPTH); SBAR();
        pv_all<NCB>(o, vb0, pa0, pa1, pa2, pa3); if constexpr (MODE != 0) SBAR(); apply_mask<MODE>(pB0, pB1, a, j, wid, r32, hi); if constexpr (MODE != 0) SBAR(); partialSM(pB0, pB1, m_reg, mnB, alB, a.C, a.thr);
        __syncthreads(); SWAIT(); SWRITE(0, SE);
        RESC(alB); __syncthreads();
        SBAR(); qkt<DK, QREG>(pA0, pA1, K_lds, qr, qx, r32, hi);
        finishSM(pB0, pB1, alB, l_reg, pa0, pa1, pa2, pa3); SBAR();
        if (SDEPTH == 1 || j + 3 < NT) SLOAD(SE, j + 1 + SDEPTH); SBAR();
        pv_all<NCB>(o, vb0 + SHM_V, pa0, pa1, pa2, pa3); if constexpr (MODE != 0) SBAR(); apply_mask<MODE>(pA0, pA1, a, j + 1, wid, r32, hi); if constexpr (MODE != 0) SBAR(); partialSM(pA0, pA1, m_reg, mnA, alA, a.C, a.thr);
        __syncthreads(); SWAIT(); SWRITE(1, SO);
        RESC(alA); __syncthreads();
    }
    SBAR(); qkt<DK, QREG>(pB0, pB1, K_lds + SHM_K, qr, qx, r32, hi);
    finishSM(pA0, pA1, alA, l_reg, pa0, pa1, pa2, pa3); SBAR();
    pv_all<NCB>(o, vb0, pa0, pa1, pa2, pa3); if constexpr (MODE != 0) SBAR(); apply_mask<MODE>(pB0, pB1, a, NT - 1, wid, r32, hi); if constexpr (MODE != 0) SBAR(); partialSM(pB0, pB1, m_reg, mnB, alB, a.C, a.thr);
    __syncthreads(); RESC(alB);
    finishSM(pB0, pB1, alB, l_reg, pa0, pa1, pa2, pa3); SBAR();
    pv_all<NCB>(o, vb0 + SHM_V, pa0, pa1, pa2, pa3);
    if constexpr (MODE == 1) { if (a.has_sink) l_reg += __builtin_amdgcn_exp2f(a.sinkl2 - m_reg * a.C); }
    if (hi == 0) li_l[r32] = l_reg; asm volatile("s_waitcnt lgkmcnt(0)" ::: "memory");
    float rli[16];
#pragma unroll
    for (int r = 0; r < 16; ++r) rli[r] = __builtin_amdgcn_rcpf(li_l[crow(r, hi)]);
    bf16* Ow = a.O + (long)(wid * QBLK) * a.ldo;
#pragma unroll
    for (int r = 0; r < 16; ++r) { const int orow = crow(r, hi);
#pragma unroll
        for (int d0 = 0; d0 < NCB; ++d0) Ow[(long)orow * a.ldo + d0 * 32 + r32] = f2bf(o[d0][r] * rli[r]); }
    __syncthreads();
#undef TROW
#undef SLOAD
#undef SWRITE
#undef SWAIT
#undef RESC
}
#undef SBAR
}
constexpr int DM = 2048, NBATCH = 4, SEQ = 4096, NCTX = 256, DEPTH = 2;
constexpr int ML = NBATCH * SEQ, MC = NBATCH * NCTX, MT = ML + MC;
constexpr int INW = 3904, UW = 4096, QW = 1856;
constexpr int MODW = 6 * DM;
constexpr float LN_EPS = 1e-5f, RMS_EPS = 1e-6f;
constexpr float ALPHA = 1.4142135623730951f;
constexpr float LOG2E = 1.4426950408889634f;
constexpr float A_SCALE = 0.07216878364870323f, B_SCALE = 0.125f, C_SCALE = 0.08838834764831845f, D_SCALE = 0.08838834764831845f;
constexpr int U_CQ = 0, U_CKV = 384, U_KR = 512, U_BQ = 576, U_BK = 1088, U_BV = 1216, U_CQQ = 1344, U_CK = 1856, U_CV = 2368, U_DQ = 2880, U_DK = 3392, U_DV = 3648;
constexpr int QA_Q = 0, QA_KV = 768, QA_KR = 1792;

constexpr size_t MiB = 1u << 20;
constexpr size_t WS_CTL = 0, CTL_ZERO_BYTES = 1 * MiB;
constexpr size_t WS_MOD = 1 * MiB;
constexpr size_t WS_CTAB = 2 * MiB;
constexpr size_t WS_SUBK = 4 * MiB;
constexpr size_t WS_WUP = 5 * MiB;
constexpr size_t WS_WIN = 9 * MiB;
constexpr size_t WS_WC = 41 * MiB;
constexpr size_t WS_WO = 121 * MiB;
constexpr size_t WS_WPQ = 137 * MiB;
constexpr size_t WS_PU = 153 * MiB;
constexpr size_t WS_PV = 281 * MiB;
constexpr size_t WS_BUFA = 409 * MiB;
constexpr size_t WS_BUFB = 477 * MiB;
constexpr size_t WS_UREG = 545 * MiB;
constexpr size_t WS_QKVA = 681 * MiB;
constexpr size_t WS_OQP = 743 * MiB;
constexpr size_t WS_XRES = 811 * MiB;
constexpr size_t WS_EIDX = 947 * MiB;
constexpr size_t WS_EG = 956 * MiB;
constexpr size_t WS_MODP = 965 * MiB;
constexpr size_t WS_DBG = 973 * MiB;
constexpr size_t WS_END = 974 * MiB;
constexpr size_t STASH_WG = 131072, P_WG = 262144, WS_STASH = WS_UREG, WS_P = WS_UREG + 32 * MiB;
constexpr int CW_TMO = 0, CW_BAR = 4096;

constexpr int NWAVES = 8;
constexpr int RING_OFF = 0, RING_BYTES = 155648;
constexpr int LDSCTL_OFF = RING_BYTES, MISC_OFF = LDSCTL_OFF + 320;
constexpr int LDS_BYTES = 157696;

#define RLX_AGENT __ATOMIC_RELAXED, __HIP_MEMORY_SCOPE_AGENT
#define LDS_WAIT() asm volatile("s_waitcnt lgkmcnt(0)" ::: "memory")
#define VM_WAIT() asm volatile("s_waitcnt vmcnt(0)" ::: "memory")

#define XB_TMO      128
#define XB_XCNT(j)  (256  + 64 * (j))
#define XB_XSUB(j)  (1280 + 64 * (j))
#define XB_XGEN(j)  (2304 + 64 * (j))
#define XB_TOP      3328
#define XB_TOPGEN   3392
#define XCD_BAR_WORDS 3456
#define XB_SPIN_CAP (1u << 22)
__device__ __forceinline__ unsigned xb_ld(unsigned* p)              { return __hip_atomic_load(p, __ATOMIC_RELAXED, __HIP_MEMORY_SCOPE_AGENT); }
__device__ __forceinline__ unsigned xb_add(unsigned* p, unsigned v) { return __hip_atomic_fetch_add(p, v, __ATOMIC_RELAXED, __HIP_MEMORY_SCOPE_AGENT); }
__device__ __forceinline__ unsigned xb_xcc_id() { return (unsigned)__builtin_amdgcn_s_getreg((3 << 11) | 20) & 0xFu; }
#define XB_SPIN(cond, bar) do { unsigned _sp = 0; while (cond) { __builtin_amdgcn_s_sleep(1); \
    if ((++_sp & 255u) == 0u) { if (xb_ld(&(bar)[XB_TMO])) break; if (_sp > XB_SPIN_CAP) { atomicAdd(&(bar)[XB_TMO], 1u); break; } } } } while (0)
struct XcdBarrier { unsigned* bar; unsigned x; volatile LAS unsigned* st; };
__device__ __forceinline__ XcdBarrier xcd_barrier_post(unsigned* bar, volatile LAS unsigned* st) {
    XcdBarrier b; b.bar = bar; b.x = xb_xcc_id(); b.st = st;
    if (threadIdx.x == 0) (void)xb_add(&bar[XB_XCNT(b.x)], 1u);
    return b;
}
__device__ __forceinline__ void xcd_barrier_complete(unsigned* bar, unsigned x, unsigned& nloc, unsigned& nx) {
    const unsigned G = gridDim.x * gridDim.y * gridDim.z;
    unsigned sum, cnt, mine, sp = 0u;
    for (;;) {
        sum = 0u; cnt = 0u; mine = 0u;
#pragma unroll
        for (unsigned j = 0; j < 16; ++j) { const unsigned c = xb_ld(&bar[XB_XCNT(j)]); sum += c; cnt += (c > 0u) ? 1u : 0u; mine = (j == x) ? c : mine; }
        if (sum == G) break;
        __builtin_amdgcn_s_sleep(1);
        if ((++sp & 255u) == 0u) { if (xb_ld(&bar[XB_TMO])) break; if (sp > XB_SPIN_CAP) { atomicAdd(&bar[XB_TMO], 1u); break; } }
    }
    nloc = mine > 0u ? mine : 1u; nx = cnt > 0u ? cnt : 1u;
}
__device__ __forceinline__ void xcd_barrier(const XcdBarrier& b) {
    asm volatile("s_waitcnt vmcnt(0)" ::: "memory");
    __syncthreads();
    if (threadIdx.x == 0) {
        unsigned* bar = b.bar;
        __builtin_amdgcn_s_waitcnt(0);
        unsigned nloc = b.st[0], nx = b.st[1];
        if (nloc == 0u) { xcd_barrier_complete(bar, b.x, nloc, nx); b.st[0] = nloc; b.st[1] = nx; }
        const unsigned old = xb_add(&bar[XB_XSUB(b.x)], 1u);
        const unsigned gen = old / nloc;
        if (old + 1u == (gen + 1u) * nloc) {
            __builtin_amdgcn_fence(__ATOMIC_RELEASE, "agent");
            asm volatile("s_waitcnt vmcnt(0)" ::: "memory");
            const unsigned og = xb_add(&bar[XB_TOP], 1u);
            const unsigned tg = og / nx;
            if (og + 1u == (tg + 1u) * nx) xb_add(&bar[XB_TOPGEN], 1u);
            else XB_SPIN(xb_ld(&bar[XB_TOPGEN]) == tg, bar);
            __builtin_amdgcn_fence(__ATOMIC_ACQUIRE, "agent");
            xb_add(&bar[XB_XGEN(b.x)], 1u);
            asm volatile("s_waitcnt vmcnt(0)" ::: "memory");
        } else {
            XB_SPIN(xb_ld(&bar[XB_XGEN(b.x)]) == gen, bar);
            __builtin_amdgcn_fence(__ATOMIC_ACQUIRE, "agent");
            asm volatile("s_waitcnt vmcnt(0)" ::: "memory");
        }
    }
    __syncthreads();
}

struct In {
    const float *x, *c, *ctx, *c_ctx, *w_ada, *b_ada, *w_in, *a_q_norm, *a_kv_norm, *a_w_uq, *a_w_ukv, *b_sink, *c_rpb, *d_q_norm, *d_k_norm,
                *w_branch, *w_gate, *b_gate, *w_out, *ln1_g, *ln1_b, *ln2_g, *ln2_b, *peer_w_q, *peer_sub_keys, *peer_u, *peer_v;
};
struct Args { In in; float* out; unsigned char* ws; int ph_lo, ph_hi, li, pad; };
struct Frame { LAS unsigned char* lds; int tid, lane, wave, vcu, G; GAS unsigned char* ws; };
template <class T> __device__ __forceinline__ T* G(T* p) { return (T*)(GAS T*)p; }
typedef const __attribute__((address_space(4))) Args& KA;
typedef const __attribute__((address_space(4))) Args* KAP;
__device__ __forceinline__ KAP kargs() { KAP p = (KAP)__builtin_amdgcn_kernarg_segment_ptr(); asm volatile("" : "+s"(p)); return p; }

__device__ __forceinline__ float wave_sum(float v) {
#pragma unroll
    for (int o = 1; o < 64; o <<= 1) v += __shfl_xor(v, o);
    return v;
}
__device__ __forceinline__ unsigned pk2(float lo, float hi) { return cvt_pk_bf16(lo, hi); }
__device__ __forceinline__ float silu_f(float v) { return v / (1.0f + __expf(-v)); }

__device__ __forceinline__ void p0_transpose_item(const float* W, int ldw, int nblk, bf16* dst, int dpitch, int row_off, int col_off, const float* gain, LAS float* scr, int item, int lane) {
    const int kb = item / nblk, nb = item % nblk, k0 = 64 * kb, n0 = 32 * nb;
#pragma unroll 8
    for (int i = 0; i < 32; ++i) { const int kk = 2 * i + (lane >> 5); float v = W[(size_t)(k0 + kk) * ldw + n0 + (lane & 31)]; if (gain) v *= gain[k0 + kk]; scr[kk * 33 + (lane & 31)] = v; }
    LDS_WAIT(); asm volatile("" ::: "memory");
    const int c = lane & 7;
#pragma unroll
    for (int j = 0; j < 4; ++j) { const int n = (lane >> 3) + 8 * j; const LAS float* s = scr + (8 * c) * 33 + n;
        u32x4 o; o.x = pk2(s[0 * 33], s[1 * 33]); o.y = pk2(s[2 * 33], s[3 * 33]); o.z = pk2(s[4 * 33], s[5 * 33]); o.w = pk2(s[6 * 33], s[7 * 33]);
        *(GAS u32x4*)(dst + (size_t)(row_off + n0 + n) * dpitch + col_off + k0 + 8 * c) = o; }
    LDS_WAIT(); asm volatile("" ::: "memory");
}
struct TJob { const float* W; int K, N; bf16* dst; int dpitch, row_off, col_off; const float* gain; };
__device__ __forceinline__ int tjob_get(KA A, int job, TJob& t) {
    const int l = job / 13, j = job % 13; GAS unsigned char* ws = (GAS unsigned char*)A.ws; t.gain = nullptr; t.row_off = 0; t.col_off = 0;
    if (j == 0) { t.W = G(A.in.w_in) + (size_t)l * DM * INW; t.K = DM; t.N = INW; t.dst = (bf16*)(ws + WS_WIN) + (size_t)l * UW * DM; t.dpitch = DM; }
    else if (j <= 4) { const int z = j - 1; t.W = G(A.in.w_gate) + ((size_t)l * 4 + z) * DM * DM; t.K = DM; t.N = DM; t.dst = (bf16*)(ws + WS_WC) + ((size_t)l * 4 + z) * DM * 2560; t.dpitch = 2560; }
    else if (j <= 8) { const int z = j - 5; t.W = G(A.in.w_branch) + ((size_t)l * 4 + z) * 512 * DM; t.K = 512; t.N = DM; t.dst = (bf16*)(ws + WS_WC) + ((size_t)l * 4 + z) * DM * 2560; t.dpitch = 2560; t.col_off = 2048; }
    else if (j == 9) { t.W = G(A.in.w_out) + (size_t)l * DM * DM; t.K = DM; t.N = DM; t.dst = (bf16*)(ws + WS_WO) + (size_t)l * DM * DM; t.dpitch = DM; }
    else if (j == 10) { t.W = G(A.in.peer_w_q) + (size_t)l * DM * DM; t.K = DM; t.N = DM; t.dst = (bf16*)(ws + WS_WPQ) + (size_t)l * DM * DM; t.dpitch = DM; }
    else if (j == 11) { t.W = G(A.in.a_w_uq) + (size_t)l * 384 * 768; t.K = 384; t.N = 768; t.dst = (bf16*)(ws + WS_WUP) + (size_t)l * 1792 * 512; t.dpitch = 512; t.gain = G(A.in.a_q_norm) + l * 384; }
    else { t.W = G(A.in.a_w_ukv) + (size_t)l * 128 * 1024; t.K = 128; t.N = 1024; t.dst = (bf16*)(ws + WS_WUP) + (size_t)l * 1792 * 512; t.dpitch = 512; t.row_off = 768; t.col_off = 384; t.gain = G(A.in.a_kv_norm) + l * 128; }
    return (t.K / 64) * (t.N / 32);
}
__device__ __forceinline__ void p0_prologue(const Frame& F, KA A) {
    GAS unsigned char* ws = F.ws;
    const int gw = F.vcu * NWAVES + F.wave, NGW = F.G * NWAVES;
    const long gt = (long)gw * 64 + F.lane, NGT = (long)NGW * 64;
    {
        float* modp = (float*)(ws + WS_MODP);
        for (int it = gw; it < 2 * 16 * 48; it += NGW) {
            const int l = it / 768, ks = (it % 768) / 48, cg = it % 48, n = cg * 256 + F.lane * 4;
            const float* w = G(A.in.w_ada) + ((size_t)l * DM + ks * 128) * MODW + n;
            f32x4 acc[5];
#pragma unroll
            for (int r = 0; r < 5; ++r) acc[r] = (f32x4){0.f, 0.f, 0.f, 0.f};
#pragma unroll 8
            for (int k = 0; k < 128; ++k) {
                const f32x4 wv = *(const f32x4*)(w + (size_t)k * MODW);
                const int kk = ks * 128 + k;
#pragma unroll
                for (int r = 0; r < 5; ++r) { const float cv = (r < 4) ? G(A.in.c)[r * DM + kk] : G(A.in.c_ctx)[kk]; acc[r] += wv * silu_f(cv); }
            }
#pragma unroll
            for (int r = 0; r < 5; ++r) *(f32x4*)(modp + (((size_t)ks * 2 + l) * 5 + r) * MODW + n) = acc[r];
        }
    }
    {
        LAS float* scr = (LAS float*)(F.lds + RING_OFF + F.wave * 16384);
        int base = 0;
        for (int job = 0; job < 26; ++job) {
            TJob t; const int ni = tjob_get(A, job, t);
            int first = gw - (base % NGW); if (first < 0) first += NGW;
            for (int i = first; i < ni; i += NGW) p0_transpose_item(t.W, t.N, t.N / 32, t.dst, t.dpitch, t.row_off, t.col_off, t.gain, scr, i, F.lane);
            base += ni;
        }
    }
    for (long i = gt; i < 2L * 192 * 2048 / 8; i += NGT) { const int l = (int)(i / (192 * 256)), r = (int)(i % (192 * 256)); *(u32x4*)((bf16*)(ws + WS_WIN) + ((size_t)l * UW + 3904) * DM + (size_t)r * 8) = (u32x4){0u, 0u, 0u, 0u}; }
    for (long i = gt; i < 2L * 768 * 16; i += NGT) { const int l = (int)(i / (768 * 16)), r = (int)(i % (768 * 16)), row = r / 16, c8 = r % 16; *(u32x4*)((bf16*)(ws + WS_WUP) + ((size_t)l * 1792 + row) * 512 + 384 + c8 * 8) = (u32x4){0u, 0u, 0u, 0u}; }
    for (long i = gt; i < 2L * 1024 * 48; i += NGT) { const int l = (int)(i / (1024 * 48)), r = (int)(i % (1024 * 48)), row = r / 48, c8 = r % 48; *(u32x4*)((bf16*)(ws + WS_WUP) + ((size_t)l * 1792 + 768 + row) * 512 + c8 * 8) = (u32x4){0u, 0u, 0u, 0u}; }
    {
        const long n_sk = 2L * 8 * 2 * 128 * 128 / 8, n_pu = 2L * 16384 * 2048 / 8;
        for (long i = gt; i < n_sk + 2 * n_pu; i += NGT) {
            const float* src; bf16* dst; long j = i;
            if (j < n_sk) { src = G(A.in.peer_sub_keys); dst = (bf16*)(ws + WS_SUBK); }
            else if ((j -= n_sk) < n_pu) { src = G(A.in.peer_u); dst = (bf16*)(ws + WS_PU); }
            else { j -= n_pu; src = G(A.in.peer_v); dst = (bf16*)(ws + WS_PV); }
            const f32x4 a = __builtin_nontemporal_load((const f32x4*)(src + j * 8)), b = __builtin_nontemporal_load((const f32x4*)(src + j * 8 + 4));
            u32x4 o; o.x = pk2(a[0], a[1]); o.y = pk2(a[2], a[3]); o.z = pk2(b[0], b[1]); o.w = pk2(b[2], b[3]);
            *(u32x4*)(dst + j * 8) = o;
        }
    }
    {
        float* ct = (float*)(ws + WS_CTAB);
        for (long i = gt; i < 2L * 4 * 15 * 64 * 64; i += NGT) {
            const int kc = (int)(i & 63), qc = (int)((i >> 6) & 63), r = (int)(i >> 12), dr = r % 15, lh = r / 15;
            int cs = qc - 8; cs = cs < 0 ? 0 : (cs > 48 ? 48 : cs);
            int co = kc - qc + 15; co = co < 0 ? 0 : (co > 30 ? 30 : co);
            ct[i] = (kc >= cs && kc < cs + 16) ? G(A.in.c_rpb)[((size_t)lh * 15 + dr) * 31 + co] * (1.0f / C_SCALE) : -1e30f;
        }
    }
}
__device__ __forceinline__ void p1_modreduce(const Frame& F, KA A) {
    const long gt = ((long)F.vcu * NWAVES + F.wave) * 64 + F.lane, NGT = (long)F.G * NWAVES * 64;
    const float* modp = (const float*)(F.ws + WS_MODP); float* mod = (float*)(F.ws + WS_MOD);
    for (long i = gt; i < 2L * 5 * MODW; i += NGT) { const int n = (int)(i % MODW), l = (int)(i / (5 * MODW));
        float s = G(A.in.b_ada)[l * MODW + n];
#pragma unroll
        for (int ks = 0; ks < 16; ++ks) s += modp[(size_t)ks * 2 * 5 * MODW + i];
        mod[i] = s; }
}
__device__ __forceinline__ void p2_modulate0(const Frame& F, KA A) {
    const int gw = F.vcu * NWAVES + F.wave, NGW = F.G * NWAVES;
    const float* mod = (const float*)(F.ws + WS_MOD); bf16* H = (bf16*)(F.ws + WS_BUFA);
    for (int row = gw; row < MT; row += NGW) {
        const float* xr = row < ML ? G(A.in.x) + (size_t)row * DM : G(A.in.ctx) + (size_t)(row - ML) * DM;
        const float* mr = mod + (size_t)(row < ML ? (row >> 12) : 4) * MODW;
#pragma unroll
        for (int j = 0; j < 4; ++j) { const int c = j * 512 + F.lane * 8;
            const f32x4 a = *(const f32x4*)(xr + c), b = *(const f32x4*)(xr + c + 4);
            const f32x4 sh0 = *(const f32x4*)(mr + c), sh1 = *(const f32x4*)(mr + c + 4), sc0 = *(const f32x4*)(mr + DM + c), sc1 = *(const f32x4*)(mr + DM + c + 4);
            const f32x4 y0 = a * (sc0 + 1.0f) + sh0, y1 = b * (sc1 + 1.0f) + sh1;
            u32x4 o; o.x = pk2(y0[0], y0[1]); o.y = pk2(y0[2], y0[3]); o.z = pk2(y1[0], y1[1]); o.w = pk2(y1[2], y1[3]);
            *(u32x4*)(H + (size_t)row * DM + c) = o; }
    }
}
__device__ __forceinline__ void rope_pair(float& x1, float& x2, float ang) { const float c = __cosf(ang), s = __sinf(ang); const float y1 = x1 * c - x2 * s, y2 = x1 * s + x2 * c; x1 = y1; x2 = y2; }
__device__ __forceinline__ void enorm_phase(const Frame& F, KA A, int l) {
    const int gw = F.vcu * NWAVES + F.wave, NGW = F.G * NWAVES, lane = F.lane;
    bf16* U = (bf16*)(F.ws + WS_UREG); bf16* QK = (bf16*)(F.ws + WS_QKVA);
    const float* gq = G(A.in.d_q_norm) + l * 128; const float* gk = G(A.in.d_k_norm) + l * 128;
    const float L2T = 13.287712379549449f;
    for (int row = gw; row < MT; row += NGW) {
        bf16* u = U + (size_t)row * UW;
        const bool lat = row < ML; const int t = row & 4095;
        const float prow = lat ? (float)(t >> 6) : 0.f, pcol = lat ? (float)(t & 63) : 0.f;
        { unsigned w[3]; float ss = 0.f;
#pragma unroll
          for (int i = 0; i < 3; ++i) { w[i] = ((const unsigned*)(u + U_CQ))[lane + 64 * i]; const float a = bflo(w[i]), b = bfhi(w[i]); ss += a * a + b * b; }
          const float rstd = rsqrtf(wave_sum(ss) * (1.0f / 384.0f) + RMS_EPS);
#pragma unroll
          for (int i = 0; i < 3; ++i) ((unsigned*)(u + U_CQ))[lane + 64 * i] = pk2(bflo(w[i]) * rstd, bfhi(w[i]) * rstd); }
        { const unsigned w = ((const unsigned*)(u + U_CKV))[lane]; const float a = bflo(w), b = bfhi(w);
          const float rstd = rsqrtf(wave_sum(a * a + b * b) * (1.0f / 128.0f) + RMS_EPS);
          ((unsigned*)(u + U_CKV))[lane] = pk2(a * rstd, b * rstd); }
        const int j64 = lane & 31;
        const float ang64 = ((j64 < 16) ? prow : pcol) * __builtin_amdgcn_exp2f(-(float)(j64 & 15) * (L2T / 16.0f));
        if (lane < 32) { float x1 = bf2f(u[U_KR + lane]), x2 = bf2f(u[U_KR + 32 + lane]); rope_pair(x1, x2, ang64);
            bf16* o = QK + (size_t)row * QW + QA_KR; o[lane] = f2bf(x1); o[32 + lane] = f2bf(x2); }
#pragma unroll
        for (int i = 0; i < 4; ++i) { const int p = lane + 64 * i, hd = p >> 5; bf16* q = u + U_BQ + hd * 64;
            float x1 = bf2f(q[j64]), x2 = bf2f(q[32 + j64]); rope_pair(x1, x2, ang64); q[j64] = f2bf(x1); q[32 + j64] = f2bf(x2); }
        { const int hd = lane >> 5; bf16* q = u + U_BK + hd * 64;
          float x1 = bf2f(q[j64]), x2 = bf2f(q[32 + j64]); rope_pair(x1, x2, ang64); q[j64] = f2bf(x1); q[32 + j64] = f2bf(x2); }
        const float ang128 = ((lane < 32) ? prow : pcol) * __builtin_amdgcn_exp2f(-(float)(lane & 31) * (L2T / 32.0f));
        const float gq1 = gq[lane], gq2 = gq[64 + lane], gk1 = gk[lane], gk2 = gk[64 + lane];
#pragma unroll
        for (int hd = 0; hd < 4; ++hd) { bf16* q = u + U_DQ + hd * 128; float x1 = bf2f(q[lane]), x2 = bf2f(q[64 + lane]);
            const float rstd = rsqrtf(wave_sum(x1 * x1 + x2 * x2) * (1.0f / 128.0f) + RMS_EPS);
            x1 = x1 * rstd * gq1; x2 = x2 * rstd * gq2; rope_pair(x1, x2, ang128); q[lane] = f2bf(x1); q[64 + lane] = f2bf(x2); }
#pragma unroll
        for (int hd = 0; hd < 2; ++hd) { bf16* q = u + U_DK + hd * 128; float x1 = bf2f(q[lane]), x2 = bf2f(q[64 + lane]);
            const float rstd = rsqrtf(wave_sum(x1 * x1 + x2 * x2) * (1.0f / 128.0f) + RMS_EPS);
            x1 = x1 * rstd * gk1; x2 = x2 * rstd * gk2; rope_pair(x1, x2, ang128); q[lane] = f2bf(x1); q[64 + lane] = f2bf(x2); }
    }
}
__device__ __forceinline__ void ln1_phase(const Frame& F, KA A, int l, int nrows, bf16* HF) {
    const int gw = F.vcu * NWAVES + F.wave, NGW = F.G * NWAVES, lane = F.lane;
    float* Y = (float*)(F.ws + WS_UREG); const float* mod = (const float*)(F.ws + WS_MOD) + (size_t)l * 5 * MODW;
    const float* g = G(A.in.ln1_g) + l * DM; const float* b = G(A.in.ln1_b) + l * DM;
    for (int row = gw; row < nrows; row += NGW) {
        float* y = Y + (size_t)row * DM; const float* mr = mod + (size_t)(row < ML ? (row >> 12) : 4) * MODW;
        f32x4 v[8]; float s = 0.f;
#pragma unroll
        for (int j = 0; j < 4; ++j) { const int c = j * 512 + lane * 8; v[2 * j] = *(const f32x4*)(y + c); v[2 * j + 1] = *(const f32x4*)(y + c + 4); }
#pragma unroll
        for (int j = 0; j < 8; ++j) s += (v[j][0] + v[j][1]) + (v[j][2] + v[j][3]);
        const float mean = wave_sum(s) * (1.0f / DM); float q = 0.f;
#pragma unroll
        for (int j = 0; j < 8; ++j) { v[j] = v[j] - mean; q += (v[j][0] * v[j][0] + v[j][1] * v[j][1]) + (v[j][2] * v[j][2] + v[j][3] * v[j][3]); }
        const float rstd = rsqrtf(wave_sum(q) * (1.0f / DM) + LN_EPS);
#pragma unroll
        for (int j = 0; j < 4; ++j) { const int c = j * 512 + lane * 8;
            const f32x4 x0 = v[2 * j] * rstd * *(const f32x4*)(g + c) + *(const f32x4*)(b + c), x1 = v[2 * j + 1] * rstd * *(const f32x4*)(g + c + 4) + *(const f32x4*)(b + c + 4);
            *(f32x4*)(y + c) = x0; *(f32x4*)(y + c + 4) = x1;
            const f32x4 h0 = x0 * (*(const f32x4*)(mr + 4 * DM + c) + 1.0f) + *(const f32x4*)(mr + 3 * DM + c), h1 = x1 * (*(const f32x4*)(mr + 4 * DM + c + 4) + 1.0f) + *(const f32x4*)(mr + 3 * DM + c + 4);
            u32x4 o; o.x = pk2(h0[0], h0[1]); o.y = pk2(h0[2], h0[3]); o.z = pk2(h1[0], h1[1]); o.w = pk2(h1[2], h1[3]);
            *(u32x4*)(HF + (size_t)row * DM + c) = o; }
    }
}
namespace peer {
__device__ __forceinline__ unsigned okey(float f) { const unsigned u = __float_as_uint(f); return (u & 0x80000000u) ? ~u : (u | 0x80000000u); }
__device__ __forceinline__ float ikey(unsigned k) { const unsigned u = (k & 0x80000000u) ? (k & 0x7fffffffu) : ~k; return __uint_as_float(u); }
#define CE_DESC(a, b) do { const unsigned _mx = (a) > (b) ? (a) : (b), _mn = (a) > (b) ? (b) : (a); (a) = _mx; (b) = _mn; } while (0)
#define CE_ASC(a, b)  do { const unsigned _mx = (a) > (b) ? (a) : (b), _mn = (a) > (b) ? (b) : (a); (a) = _mn; (b) = _mx; } while (0)
__device__ __forceinline__ void sort16_desc(unsigned (&k)[16]) {
#pragma unroll
    for (int size = 2; size <= 16; size <<= 1)
#pragma unroll
        for (int stride = size >> 1; stride > 0; stride >>= 1)
#pragma unroll
            for (int i = 0; i < 16; ++i) { const int p = i ^ stride; if (p > i) { if ((i & size) == 0) CE_DESC(k[i], k[p]); else CE_ASC(k[i], k[p]); } }
}
__device__ __forceinline__ void merge16_desc(unsigned (&a)[16], const unsigned (&b)[16]) {
#pragma unroll
    for (int i = 0; i < 16; ++i) a[i] = a[i] > b[15 - i] ? a[i] : b[15 - i];
#pragma unroll
    for (int stride = 8; stride > 0; stride >>= 1)
#pragma unroll
        for (int i = 0; i < 16; ++i) { const int p = i ^ stride; if (p > i) CE_DESC(a[i], a[p]); }
}
constexpr int slot_x(int s) { int n = 0; for (int x = 0; x < 16; ++x) for (int y = 0; y < 16; ++y) if ((x + 1) * (y + 1) <= 16) { if (n == s) return x; ++n; } return -1; }
constexpr int slot_y(int s) { int n = 0; for (int x = 0; x < 16; ++x) for (int y = 0; y < 16; ++y) if ((x + 1) * (y + 1) <= 16) { if (n == s) return y; ++n; } return -1; }
template <int S> struct Slot { static constexpr int x = slot_x(S), y = slot_y(S); };
template <int S> __device__ __forceinline__ void cand_one(unsigned (&c)[64], const float (&v0)[16], const float (&v1)[16], const unsigned (&i0)[16], const unsigned (&i1)[16], LAS unsigned short* tbl) {
    if constexpr (Slot<S>::x >= 0) { c[S] = (okey(v0[Slot<S>::x] + v1[Slot<S>::y]) & ~63u) | (unsigned)(63 - S); tbl[S] = (unsigned short)(i0[Slot<S>::x] * 128u + i1[Slot<S>::y]); }
    else c[S] = 0u;
}
template <int... S> __device__ __forceinline__ void cand_all(unsigned (&c)[64], const float (&v0)[16], const float (&v1)[16], const unsigned (&i0)[16], const unsigned (&i1)[16], LAS unsigned short* tbl, std::integer_sequence<int, S...>) {
    (cand_one<S>(c, v0, v1, i0, i1, tbl), ...);
}
__device__ __forceinline__ void topk_item(const bf16* QP, const bf16* SK, int* EIDX, float* EG, int tok0, int h, LAS unsigned short* tblw, int lane) {
    const int r32 = lane & 31, hi = lane >> 5;
    const bf16* qrow = QP + (size_t)(tok0 + r32) * DM + h * 256 + hi * 8;
    unsigned L[2][16];
#pragma unroll
    for (int p = 0; p < 2; ++p) {
        f32x16 acc[4];
#pragma unroll
        for (int kb = 0; kb < 4; ++kb) acc[kb] = f32x16{};
        const bf16* skp = SK + ((size_t)(h * 2 + p) * 128 + r32) * 128 + hi * 8;
#pragma unroll 2
        for (int d0 = 0; d0 < 8; ++d0) { const bf16x8 bq = *(const bf16x8*)(qrow + p * 128 + d0 * 16);
#pragma unroll
            for (int kb = 0; kb < 4; ++kb) { const bf16x8 ak = *(const bf16x8*)(skp + (size_t)kb * 32 * 128 + d0 * 16); acc[kb] = __builtin_amdgcn_mfma_f32_32x32x16_bf16(ak, bq, acc[kb], 0, 0, 0); } }
        unsigned g[4][16];
#pragma unroll
        for (int kb = 0; kb < 4; ++kb) {
#pragma unroll
            for (int r = 0; r < 16; ++r) g[kb][r] = (okey(acc[kb][r]) & ~127u) | (unsigned)(127 - (32 * kb + (r & 3) + 8 * (r >> 2) + 4 * hi));
            sort16_desc(g[kb]); }
        merge16_desc(g[0], g[1]); merge16_desc(g[2], g[3]); merge16_desc(g[0], g[2]);
        unsigned o[16];
#pragma unroll
        for (int i = 0; i < 16; ++i) o[i] = (unsigned)__shfl_xor((int)g[0][i], 32);
        merge16_desc(g[0], o);
#pragma unroll
        for (int i = 0; i < 16; ++i) L[p][i] = g[0][i];
    }
    float v0[16], v1[16]; unsigned i0[16], i1[16];
#pragma unroll
    for (int i = 0; i < 16; ++i) { v0[i] = ikey(L[0][i] & ~127u); v1[i] = ikey(L[1][i] & ~127u); i0[i] = 127u - (L[0][i] & 127u); i1[i] = 127u - (L[1][i] & 127u); }
    LAS unsigned short* tbl = tblw + lane * 66;
    unsigned c[64];
    cand_all(c, v0, v1, i0, i1, tbl, std::make_integer_sequence<int, 64>{});
    unsigned c0[16], c1[16], c2[16], c3[16];
#pragma unroll
    for (int i = 0; i < 16; ++i) { c0[i] = c[i]; c1[i] = c[16 + i]; c2[i] = c[32 + i]; c3[i] = c[48 + i]; }
    sort16_desc(c0); sort16_desc(c1); sort16_desc(c2); sort16_desc(c3);
    merge16_desc(c0, c1); merge16_desc(c2, c3); merge16_desc(c0, c2);
    LDS_WAIT(); asm volatile("" ::: "memory");
    float best[16]; int eid[16]; float sum = 0.f;
    const float mx = ikey(c0[0] & ~63u);
#pragma unroll
    for (int i = 0; i < 16; ++i) { const unsigned s = 63u - (c0[i] & 63u); eid[i] = (int)tbl[s]; best[i] = __expf(ikey(c0[i] & ~63u) - mx); sum += best[i]; }
    const float inv = 1.0f / sum;
    if (hi == 0) {
        int* ep = EIDX + (size_t)(tok0 + r32) * 128 + h * 16; float* gp = EG + (size_t)(tok0 + r32) * 128 + h * 16;
#pragma unroll
        for (int i = 0; i < 16; ++i) { ep[i] = eid[i]; gp[i] = best[i] * inv; }
    }
    LDS_WAIT(); asm volatile("" ::: "memory");
}
}
__device__ __forceinline__ float gelu_exact(float v) { return 0.5f * v * (1.0f + erff(v * 0.70710678118654752f)); }
__device__ __forceinline__ float reduce16(float (&p)[16], int lane) {
    float q[8], r[4], s[2];
    { const bool up = lane & 1;
#pragma unroll
      for (int k = 0; k < 8; ++k) { const float send = up ? p[2 * k] : p[2 * k + 1], keep = up ? p[2 * k + 1] : p[2 * k]; q[k] = keep + __shfl_xor(send, 1); } }
    { const bool up = lane & 2;
#pragma unroll
      for (int k = 0; k < 4; ++k) { const float send = up ? q[2 * k] : q[2 * k + 1], keep = up ? q[2 * k + 1] : q[2 * k]; r[k] = keep + __shfl_xor(send, 2); } }
    { const bool up = lane & 4;
#pragma unroll
      for (int k = 0; k < 2; ++k) { const float send = up ? r[2 * k] : r[2 * k + 1], keep = up ? r[2 * k + 1] : r[2 * k]; s[k] = keep + __shfl_xor(send, 4); } }
    float t;
    { const bool up = lane & 8; const float send = up ? s[0] : s[1], keep = up ? s[1] : s[0]; t = keep + __shfl_xor(send, 8); }
    t += __shfl_xor(t, 16); t += __shfl_xor(t, 32);
    return t;
}
__device__ __forceinline__ void pexp_phase(const Frame& F, KA A, int l, int ntok, const bf16* HF, float* outp, bf16* Hnext) {
    const int gw = F.vcu * NWAVES + F.wave, NGW = F.G * NWAVES, lane = F.lane;
    const bf16* PU = (const bf16*)(F.ws + WS_PU) + (size_t)l * 16384 * DM; const bf16* PV = (const bf16*)(F.ws + WS_PV) + (size_t)l * 16384 * DM;
    const int* EIDX = (const int*)(F.ws + WS_EIDX); const float* EG = (const float*)(F.ws + WS_EG);
    const float* X1 = (const float*)(F.ws + WS_UREG); const float* mod = (const float*)(F.ws + WS_MOD);
    const float* g2 = G(A.in.ln2_g) + l * DM; const float* b2 = G(A.in.ln2_b) + l * DM;
    for (int tok = gw; tok < ntok; tok += NGW) {
        float h[32], acc[32];
#pragma unroll
        for (int j = 0; j < 4; ++j) { const bf16x8 v = *(const bf16x8*)(HF + (size_t)tok * DM + j * 512 + lane * 8);
#pragma unroll
            for (int e = 0; e < 8; ++e) { h[j * 8 + e] = bf2f((unsigned short)v[e]); acc[j * 8 + e] = 0.f; } }
#pragma unroll 1
        for (int sb = 0; sb < 32; ++sb) {
            const int my_e = EIDX[(size_t)tok * 128 + sb * 4 + (lane & 3)]; const float my_g = EG[(size_t)tok * 128 + sb * 4 + (lane & 3)];
            const int e0 = __builtin_amdgcn_readlane(my_e, 0), e1 = __builtin_amdgcn_readlane(my_e, 1), e2 = __builtin_amdgcn_readlane(my_e, 2), e3 = __builtin_amdgcn_readlane(my_e, 3);
            float part[4];
#pragma unroll
            for (int i = 0; i < 4; ++i) {
                const int e = i == 0 ? e0 : (i == 1 ? e1 : (i == 2 ? e2 : e3)); const bf16* ur = PU + (size_t)e * DM + lane * 8; float d = 0.f;
#pragma unroll
                for (int j = 0; j < 4; ++j) { const u32x4 w = *(const u32x4*)(ur + j * 512);
                    d += h[j * 8 + 0] * bflo(w.x) + h[j * 8 + 1] * bfhi(w.x) + h[j * 8 + 2] * bflo(w.y) + h[j * 8 + 3] * bfhi(w.y)
                       + h[j * 8 + 4] * bflo(w.z) + h[j * 8 + 5] * bfhi(w.z) + h[j * 8 + 6] * bflo(w.w) + h[j * 8 + 7] * bfhi(w.w); }
                part[i] = d;
            }
            float dot;
            { const bool u1 = lane & 1, u2 = lane & 2;
              const float q0 = (u1 ? part[1] : part[0]) + __shfl_xor(u1 ? part[0] : part[1], 1);
              const float q1 = (u1 ? part[3] : part[2]) + __shfl_xor(u1 ? part[2] : part[3], 1);
              dot = (u2 ? q1 : q0) + __shfl_xor(u2 ? q0 : q1, 2);
              dot += __shfl_xor(dot, 4); dot += __shfl_xor(dot, 8); dot += __shfl_xor(dot, 16); dot += __shfl_xor(dot, 32); }
            const float act = gelu_exact(dot) * my_g;
#pragma unroll
            for (int i = 0; i < 4; ++i) {
                const int e = i == 0 ? e0 : (i == 1 ? e1 : (i == 2 ? e2 : e3)); const float w = __uint_as_float(__builtin_amdgcn_readlane(__float_as_uint(act), i));
                const bf16* vr = PV + (size_t)e * DM + lane * 8;
#pragma unroll
                for (int j = 0; j < 4; ++j) { const u32x4 x = *(const u32x4*)(vr + j * 512);
                    acc[j * 8 + 0] += w * bflo(x.x); acc[j * 8 + 1] += w * bfhi(x.x); acc[j * 8 + 2] += w * bflo(x.y); acc[j * 8 + 3] += w * bfhi(x.y);
                    acc[j * 8 + 4] += w * bflo(x.z); acc[j * 8 + 5] += w * bfhi(x.z); acc[j * 8 + 6] += w * bflo(x.w); acc[j * 8 + 7] += w * bfhi(x.w); }
            }
        }
        const int bidx = tok < ML ? (tok >> 12) : 4;
        const float* mr = mod + ((size_t)l * 5 + bidx) * MODW; const float* x1 = X1 + (size_t)tok * DM;
        float s = 0.f;
#pragma unroll
        for (int j = 0; j < 4; ++j) { const int c = j * 512 + lane * 8;
            const f32x4 xa = *(const f32x4*)(x1 + c), xb = *(const f32x4*)(x1 + c + 4), ga = *(const f32x4*)(mr + 5 * DM + c), gb = *(const f32x4*)(mr + 5 * DM + c + 4);
#pragma unroll
            for (int e = 0; e < 4; ++e) { acc[j * 8 + e] = ALPHA * xa[e] + ga[e] * acc[j * 8 + e]; acc[j * 8 + 4 + e] = ALPHA * xb[e] + gb[e] * acc[j * 8 + 4 + e]; s += acc[j * 8 + e] + acc[j * 8 + 4 + e]; } }
        const float mean = wave_sum(s) * (1.0f / DM); float q = 0.f;
#pragma unroll
        for (int k = 0; k < 32; ++k) { acc[k] -= mean; q += acc[k] * acc[k]; }
        const float rstd = rsqrtf(wave_sum(q) * (1.0f / DM) + LN_EPS);
        const float* mn = mod + ((size_t)(l + 1 < DEPTH ? l + 1 : l) * 5 + bidx) * MODW;
#pragma unroll
        for (int j = 0; j < 4; ++j) { const int c = j * 512 + lane * 8;
            const f32x4 ga = *(const f32x4*)(g2 + c), gb = *(const f32x4*)(g2 + c + 4), ba = *(const f32x4*)(b2 + c), bb = *(const f32x4*)(b2 + c + 4);
            f32x4 ya, yb;
#pragma unroll
            for (int e = 0; e < 4; ++e) { ya[e] = acc[j * 8 + e] * rstd * ga[e] + ba[e]; yb[e] = acc[j * 8 + 4 + e] * rstd * gb[e] + bb[e]; }
            *(f32x4*)(outp + (size_t)tok * DM + c) = ya; *(f32x4*)(outp + (size_t)tok * DM + c + 4) = yb;
            if (Hnext) { const f32x4 sa = *(const f32x4*)(mn + DM + c), sb = *(const f32x4*)(mn + DM + c + 4), ha = *(const f32x4*)(mn + c), hb = *(const f32x4*)(mn + c + 4);
                const f32x4 za = ya * (sa + 1.0f) + ha, zb = yb * (sb + 1.0f) + hb;
                u32x4 o; o.x = pk2(za[0], za[1]); o.y = pk2(za[2], za[3]); o.z = pk2(zb[0], zb[1]); o.w = pk2(zb[2], zb[3]);
                *(u32x4*)(Hnext + (size_t)tok * DM + c) = o; }
        }
    }
}

#ifndef SD_A
#define SD_A 1
#endif
#ifndef SD_D
#define SD_D 1
#endif
#ifndef SD_B
#define SD_B 2
#endif
#ifndef SD_C
#define SD_C 1
#endif
#ifndef ATT_MASK
#define ATT_MASK 15
#endif
template <int TYPE> __device__ __forceinline__ att::Args make_att_args(const Frame& F, KA A, int l, int idx, bool ctxq) {
    const bf16* U = (const bf16*)(F.ws + WS_UREG); const bf16* QK = (const bf16*)(F.ws + WS_QKVA); bf16* O = (bf16*)(F.ws + WS_OQP);
    constexpr int NH = (TYPE == 2) ? 8 : 4;
    int b, h, qb;
    if (ctxq) { b = idx / NH; h = idx % NH; qb = 0; } else { b = idx / (NH * 16); h = (idx >> 4) % NH; qb = idx & 15; }
    const int row = ctxq ? ML + b * NCTX : b * SEQ + qb * 256;
    att::Args a{};
    a.ldo = DM; a.qpos0 = qb * 256;
    if (ctxq) { a.n0 = 4; a.row0 = ML + b * NCTX; a.n1 = 0; a.row1 = 0; }
    if constexpr (TYPE == 0) {
        a.Q = QK + (size_t)row * QW + QA_Q + h * 192; a.ldq = QW; a.KV = QK; a.ld = QW; a.kc0 = QA_KV + h * 256; a.kc1 = QA_KR; a.vc = QA_KV + h * 256 + 128;
        a.O = O + (size_t)row * DM + h * 128; a.C = A_SCALE * LOG2E; a.thr = 8.0f / A_SCALE; a.qrope = ctxq ? 0 : 1;
        if (!ctxq) { a.n0 = 64; a.row0 = b * SEQ; a.n1 = 4; a.row1 = ML + b * NCTX; }
    } else if constexpr (TYPE == 1) {
        const int kvh = h >> 1;
        a.Q = U + (size_t)row * UW + U_DQ + h * 128; a.ldq = UW; a.KV = U; a.ld = UW; a.kc0 = U_DK + kvh * 128; a.kc1 = 0; a.vc = U_DV + kvh * 128;
        a.O = O + (size_t)row * DM + 1536 + h * 128; a.C = D_SCALE * LOG2E; a.thr = 8.0f / D_SCALE;
        if (!ctxq) { a.n0 = 64; a.row0 = b * SEQ; a.n1 = 4; a.row1 = ML + b * NCTX; }
    } else if constexpr (TYPE == 2) {
        const int kvh = h >> 2;
        a.Q = U + (size_t)row * UW + U_BQ + h * 64; a.ldq = UW; a.KV = U; a.ld = UW; a.kc0 = U_BK + kvh * 64; a.kc1 = 0; a.vc = U_BV + kvh * 64;
        a.O = O + (size_t)row * DM + 512 + h * 64; a.C = B_SCALE * LOG2E; a.thr = 8.0f / B_SCALE; a.has_sink = 1; a.sinkl2 = G(A.in.b_sink)[l * 8 + h] * LOG2E;
        if (!ctxq) { int ws = qb * 256 - 128; ws = ws < 0 ? 0 : ws; int we = qb * 256 + 384; we = we > SEQ ? SEQ : we;
            a.n0 = 4; a.row0 = ML + b * NCTX; a.n1 = (we - ws) / 64; a.row1 = b * SEQ + ws; a.wpos0 = ws; }
    } else {
        a.Q = U + (size_t)row * UW + U_CQQ + h * 128; a.ldq = UW; a.KV = U; a.ld = UW; a.kc0 = U_CK + h * 128; a.kc1 = 0; a.vc = U_CV + h * 128;
        a.O = O + (size_t)row * DM + 1024 + h * 128; a.C = C_SCALE * LOG2E; a.thr = 8.0f / C_SCALE;
        a.T = (const float*)(F.ws + WS_CTAB) + (size_t)((l * 4 + h) * 15) * 4096;
        if (!ctxq) { const int r0 = qb * 4; int kr0 = r0 - 4; kr0 = kr0 < 0 ? 0 : (kr0 > 56 ? 56 : kr0); int ke = r0 + 3 - 4; ke = ke < 0 ? 0 : (ke > 56 ? 56 : ke); ke += 7; const int nr = ke - kr0 + 1;
            a.n0 = 4; a.row0 = ML + b * NCTX; a.n1 = nr + (nr & 1); a.row1 = b * SEQ + kr0 * 64; a.r0 = r0; a.kr0 = kr0; }
    }
    return a;
}
#define AF() Frame F = F0; asm volatile("" : "+v"(F.tid), "+v"(F.lane), "+s"(F.wave), "+s"(F.vcu), "+s"(F.G), "+s"(F.ws), "+s"(F.lds)); LAS char* lds = (LAS char*)(F.lds + RING_OFF); const int v = F.vcu
__device__ __forceinline__ void att_phase(const Frame& F0, int l) {
    if (F0.vcu >= 256) return;
    const bool cx = (l + 1 < DEPTH);
    if (ATT_MASK & 1) { AF(); KA A = *kargs(); const int n = 1 + ((cx && v < 16) ? 1 : 0);
        for (int k = 0; k < n; ++k) { const att::Args a = make_att_args<0>(F, A, l, k ? v : v, k != 0); att::attn_unit<192, 128, 0, SD_A>(a, lds, F.tid); } }
    if (ATT_MASK & 2) { AF(); KA A = *kargs(); const int n = 1 + ((cx && v >= 16 && v < 32) ? 1 : 0);
        for (int k = 0; k < n; ++k) { const att::Args a = make_att_args<1>(F, A, l, k ? v - 16 : v, k != 0); att::attn_unit<128, 128, 0, SD_D>(a, lds, F.tid); } }
    if (ATT_MASK & 4) { AF(); KA A = *kargs(); const int n = 2 + ((cx && v >= 48 && v < 80) ? 1 : 0);
        for (int k = 0; k < n; ++k) { const att::Args a = make_att_args<2>(F, A, l, k == 2 ? v - 48 : 2 * v + k, k == 2); att::attn_unit<64, 64, 1, SD_B>(a, lds, F.tid); } }
    if (ATT_MASK & 8) { AF(); KA A = *kargs(); const int n = 1 + ((cx && v >= 32 && v < 48) ? 1 : 0);
        for (int k = 0; k < n; ++k) { const att::Args a = make_att_args<3>(F, A, l, k ? v - 32 : v, k != 0); att::attn_unit<128, 128, 2, SD_C>(a, lds, F.tid); } }
}

constexpr int N_PHASES = 3 + 10 * DEPTH;
#ifndef MK_N_LAUNCHES
#define MK_N_LAUNCHES 1
#endif
__global__ void __launch_bounds__(NWAVES * 64, 2) mk_fwd(Args args) {
    extern __shared__ __attribute__((aligned(16))) unsigned char lds_raw[];
    Frame F;
    F.lds = (LAS unsigned char*)lds_raw; F.tid = threadIdx.x; F.lane = F.tid & 63; F.wave = __builtin_amdgcn_readfirstlane(F.tid >> 6);
    F.G = gridDim.x; { const int bx = blockIdx.x; F.vcu = (F.G % 8 == 0) ? (bx % 8) * (F.G / 8) + bx / 8 : bx; }
    GAS unsigned char* ws; int lo, hi, li;
    { KAP ap = kargs(); ws = (GAS unsigned char*)ap->ws; lo = ap->ph_lo; hi = ap->ph_hi; li = ap->li; }
    F.ws = ws;
    for (int u = F.tid; u < (LDS_BYTES - LDSCTL_OFF) / 4; u += NWAVES * 64) ((LAS unsigned*)(F.lds + LDSCTL_OFF))[u] = 0u;
    __syncthreads();
    volatile LAS unsigned* MISC = (volatile LAS unsigned*)(F.lds + MISC_OFF);
    XcdBarrier bar = xcd_barrier_post((unsigned*)(ws + WS_CTL) + CW_BAR + li * XCD_BAR_WORDS, MISC + 8);
#ifndef PHASE_MASK
#define PHASE_MASK 0x1fff
#endif
#define INR(k) (lo <= (k) && (k) < hi)
#define IN(k) ((((PHASE_MASK) >> ((k) < 3 ? (k) : 3 + ((k) - 3) % 10)) & 1) && INR(k))
#define SEAM(k) do { if (INR(k) && INR((k) + 1)) xcd_barrier(bar); } while (0)
#define PF() Frame Fp = F; int bx = blockIdx.x; asm volatile("" : "+v"(Fp.tid), "+v"(Fp.lane), "+s"(Fp.wave), "+s"(Fp.vcu), "+s"(Fp.G), "+s"(Fp.ws), "+s"(Fp.lds), "+s"(bx)); GAS unsigned char* ws = Fp.ws; (void)bx; (void)ws
    if (IN(0)) { PF(); p0_prologue(Fp, *kargs()); } SEAM(0);
    if (IN(1)) { PF(); p1_modreduce(Fp, *kargs()); } SEAM(1);
    if (IN(2)) { PF(); p2_modulate0(Fp, *kargs()); } SEAM(2);
    for (int l = 0; l < DEPTH; ++l) {
        const int pb = 3 + 10 * l; const bool last = (l + 1 == DEPTH);
        const size_t offH = (l & 1) ? WS_BUFB : WS_BUFA, offS = (l & 1) ? WS_BUFA : WS_BUFB;
        const int nPl = last ? 64 : 68, nrows = last ? ML : MT;
        if (IN(pb + 0)) {
            PF(); bf16* Hb = (bf16*)(ws + offH);
            pg8::PlainSched S{(const char*)Hb, (const char*)((bf16*)(ws + WS_WIN) + (size_t)l * UW * DM), DM, DM, DM, 68, 16, Fp.G, bx};
            pg8::EpiBf16 E{(bf16*)(ws + WS_UREG), UW};
            pg8::gemm_phase(Fp.lds + RING_OFF, S, E, DM, DM, Fp.tid);
        } SEAM(pb + 0);
        if (IN(pb + 1)) { PF(); enorm_phase(Fp, *kargs(), l); } SEAM(pb + 1);
        if (IN(pb + 2)) { PF();
            pg8::PlainSched S{(const char*)(ws + WS_UREG), (const char*)((bf16*)(ws + WS_WUP) + (size_t)l * 1792 * 512), UW, 512, 512, 68, 7, Fp.G, bx};
            pg8::EpiBf16 E{(bf16*)(ws + WS_QKVA), QW};
            pg8::gemm_phase(Fp.lds + RING_OFF, S, E, UW, 512, Fp.tid);
        } SEAM(pb + 2);
        if (IN(pb + 3)) { PF(); att_phase(Fp, l); } SEAM(pb + 3);
        if (IN(pb + 4)) { PF(); bf16* Hb = (bf16*)(ws + offH); bf16* Sb = (bf16*)(ws + offS);
            pg8::MergeSched S{(const char*)Hb, (const char*)(ws + WS_OQP), (const char*)((bf16*)(ws + WS_WC) + (size_t)l * 4 * DM * 2560), nPl, Fp.G, bx};
            pg8::EpiMerge E{Sb, G(kargs()->in.b_gate) + (size_t)l * 4 * DM, (char*)(ws + WS_STASH) + (size_t)bx * STASH_WG, (char*)(ws + WS_P) + (size_t)bx * P_WG, Fp.tid};
            pg8::gemm_phase(Fp.lds + RING_OFF, S, E, DM, 2560, Fp.tid);
        } SEAM(pb + 4);
        if (IN(pb + 5)) { PF(); bf16* Sb = (bf16*)(ws + offS);
            pg8::PlainSched S{(const char*)Sb, (const char*)((bf16*)(ws + WS_WO) + (size_t)l * DM * DM), DM, DM, DM, nPl, 8, Fp.G, bx};
            KAP ap = kargs();
            pg8::EpiOut E{(float*)(ws + WS_UREG), l == 0 ? G(ap->in.x) : (const float*)(ws + WS_XRES), l == 0 ? G(ap->in.ctx) : (const float*)(ws + WS_XRES) + (size_t)ML * DM,
                          (const float*)(ws + WS_MOD) + (size_t)l * 5 * MODW, ALPHA};
            pg8::gemm_phase(Fp.lds + RING_OFF, S, E, DM, DM, Fp.tid);
        } SEAM(pb + 5);
        if (IN(pb + 6)) { PF(); ln1_phase(Fp, *kargs(), l, nrows, (bf16*)(ws + offH)); } SEAM(pb + 6);
        if (IN(pb + 7)) { PF(); bf16* Hb = (bf16*)(ws + offH);
            pg8::PlainSched S{(const char*)Hb, (const char*)((bf16*)(ws + WS_WPQ) + (size_t)l * DM * DM), DM, DM, DM, nPl, 8, Fp.G, bx};
            pg8::EpiBf16 E{(bf16*)(ws + WS_OQP), DM};
            pg8::gemm_phase(Fp.lds + RING_OFF, S, E, DM, DM, Fp.tid);
        } SEAM(pb + 7);
        if (IN(pb + 8)) { PF();
            const int gw = Fp.vcu * NWAVES + Fp.wave, NGW = Fp.G * NWAVES;
            LAS unsigned short* tblw = (LAS unsigned short*)(Fp.lds + RING_OFF) + Fp.wave * (64 * 66);
            for (int it = gw; it < (nrows / 32) * 8; it += NGW)
                peer::topk_item((const bf16*)(ws + WS_OQP), (const bf16*)(ws + WS_SUBK) + (size_t)l * 8 * 2 * 128 * 128, (int*)(ws + WS_EIDX), (float*)(ws + WS_EG), (it >> 3) * 32, it & 7, tblw, Fp.lane);
        } SEAM(pb + 8);
        if (IN(pb + 9)) { PF(); pexp_phase(Fp, *kargs(), l, nrows, (bf16*)(ws + offH), last ? G(kargs()->out) : (float*)(ws + WS_XRES), last ? nullptr : (bf16*)(ws + offS)); } SEAM(pb + 9);
    }
#undef IN
#undef INR
#undef SEAM
}

extern "C" void kernel_launch(void* const* d_in, const int* in_sizes, int n_in, void* d_out, int out_size, void* d_ws, size_t ws_size, hipStream_t stream) {
    static int grid = 0;
    if (grid == 0) {
        if (n_in != 27 || out_size != ML * DM || ws_size < WS_END) { fprintf(stderr, "kernel_launch: unexpected shapes (n_in %d out %d ws %zu, need ws >= %zu)\n", n_in, out_size, ws_size, (size_t)WS_END); grid = -1; return; }
        int dev = 0, cus = 0, per_cu = 0;
        if (hipGetDevice(&dev) != hipSuccess || hipDeviceGetAttribute(&cus, hipDeviceAttributeMultiprocessorCount, dev) != hipSuccess) { grid = -1; return; }
        if (hipFuncSetAttribute((const void*)mk_fwd, hipFuncAttributeMaxDynamicSharedMemorySize, LDS_BYTES) != hipSuccess) { fprintf(stderr, "kernel_launch: hipFuncSetAttribute failed\n"); grid = -1; return; }
        if (hipOccupancyMaxActiveBlocksPerMultiprocessor(&per_cu, (const void*)mk_fwd, NWAVES * 64, LDS_BYTES) != hipSuccess || per_cu < 1) { fprintf(stderr, "kernel_launch: occupancy query says %d\n", per_cu); }
        (void)hipGetLastError();
        grid = cus < 256 ? cus : 256;
    }
    if (grid < 0) return;
    (void)hipMemsetAsync((char*)d_ws + WS_CTL, 0, CTL_ZERO_BYTES, stream);
    Args a{};
    const float** ip = (const float**)&a.in;
    for (int i = 0; i < 27; ++i) ip[i] = (const float*)d_in[i];
    a.out = (float*)d_out; a.ws = (unsigned char*)d_ws;
    for (int li = 0; li < MK_N_LAUNCHES; ++li) {
        a.ph_lo = (MK_N_LAUNCHES == 1) ? 0 : li; a.ph_hi = (MK_N_LAUNCHES == 1) ? N_PHASES : li + 1; a.li = li; a.pad = 0;
        hipLaunchKernelGGL(mk_fwd, dim3(grid), dim3(NWAVES * 64), LDS_BYTES, stream, a);
    }
}
```

```cpp
#include <hip/hip_runtime.h>
#include <cstdio>
#include <cstdint>
#include <utility>

#define GAS __attribute__((address_space(1)))
#define LAS __attribute__((address_space(3)))
typedef unsigned short bf16;
typedef short bf16x8 __attribute__((ext_vector_type(8)));
typedef short s16x4 __attribute__((ext_vector_type(4)));
typedef float f32x2 __attribute__((ext_vector_type(2)));
typedef float f32x4 __attribute__((ext_vector_type(4)));
typedef float f32x16 __attribute__((ext_vector_type(16)));
typedef unsigned u32x2 __attribute__((ext_vector_type(2)));
typedef unsigned u32x4 __attribute__((ext_vector_type(4)));
typedef GAS unsigned gu32;

__device__ __forceinline__ unsigned cvt_pk_bf16(float lo, float hi) { unsigned r; asm volatile("v_cvt_pk_bf16_f32 %0, %1, %2" : "=v"(r) : "v"(lo), "v"(hi)); return r; }
__device__ __forceinline__ float bf2f(unsigned short b) { return __uint_as_float(((unsigned)b) << 16); }
__device__ __forceinline__ float bflo(unsigned w) { return __uint_as_float(w << 16); }
__device__ __forceinline__ float bfhi(unsigned w) { return __uint_as_float(w & 0xffff0000u); }
__device__ __forceinline__ unsigned short f2bf(float f) { return (unsigned short)(cvt_pk_bf16(f, 0.f) & 0xffffu); }

namespace pg8 {
constexpr int BM = 256, BK = 64, HALF = 128, HTB = HALF * BK * 2  , STAGE_BYTES = 8 * HTB, NXCD = 8, WGM = 8;
__host__ __device__ __forceinline__ int lds_byte(int r, int c) { const int st = (r >> 4) * 2 + (c >> 5), rr = r & 15, cc = c & 31, ob = rr * 64 + cc * 2; return st * 1024 + (ob ^ (((ob >> 9) & 1) << 5)); }
__host__ __device__ __forceinline__ void stage_rc(int b, int& R, int& C) { const int st = b / 1024, sb = b % 1024, swz = sb ^ (((sb >> 9) & 1) << 5); R = (st >> 1) * 16 + swz / 64; C = (st & 1) * 32 + (swz % 64) / 2; }
__host__ __device__ __forceinline__ int perm32(int rho) { const int n = rho >> 4, i = rho & 15; return 8 * (i >> 2) + 4 * n + (i & 3); }

struct Unit { int pm, pn, z; };

__device__ __forceinline__ void tile_of(int L, int nM, int nN, int& pm, int& pn) {
    const int nwg = nM * nN; int wgid = L;
    { const int q = nwg / NXCD, r = nwg % NXCD, xcd = wgid % NXCD, off = wgid / NXCD; wgid = (xcd < r ? xcd * (q + 1) : r * (q + 1) + (xcd - r) * q) + off; }
    const int nig = WGM * nN, gid = wgid / nig, fm = gid * WGM, gsz = (nM - fm) < WGM ? (nM - fm) : WGM;
    pm = fm + ((wgid % nig) % gsz); pn = (wgid % nig) / gsz;
}
struct PlainSched {
    const char* A; const char* B; int lda, ldb, K, nM, nN, G, c;
    __device__ __forceinline__ bool next(int i, Unit& u) const { const long L = (long)i * G + c; if (L >= (long)nM * nN) return false; tile_of((int)L, nM, nN, u.pm, u.pn); u.z = 0; return true; }
    __device__ __forceinline__ void ptrs(const Unit& u, const char*& a, const char*& b, int& nt) const { a = A + (size_t)u.pm * BM * lda * 2; b = B + (size_t)u.pn * BM * ldb * 2; nt = K / BK; }
};
struct MergeSched {
    const char* H; const char* O; const char* W; int nM, G, c;
    __device__ __forceinline__ bool next(int i, Unit& u) const { const long L = (long)(i >> 3) * G + c; if (L >= (long)nM * 8) return false; tile_of((int)L, nM, 8, u.pm, u.pn); u.z = i & 7; return true; }
    __device__ __forceinline__ void ptrs(const Unit& u, const char*& a, const char*& b, int& nt) const {
        const int z = u.z >> 1, kind = u.z & 1;
        a = (kind ? H : O + (size_t)z * 512 * 2) + (size_t)u.pm * BM * 2048 * 2;
        b = W + ((size_t)z * 2048 * 2560 + (size_t)u.pn * BM * 2560 + (kind ? 0 : 2048)) * 2;
        nt = kind ? 32 : 8;
    }
};

struct EpiBf16 {
    static constexpr bool PERM = true;
    bf16* O; int ldc;
    __device__ __forceinline__ void operator()(const f32x4 (&acc)[2][2][4][2], const Unit& u, int wr, int wc, int fr, int fq) const {
        const int row0 = u.pm * BM + wr * 64 + fr, col0 = u.pn * BM + wc * 32 + 8 * fq;
#pragma unroll
        for (int ai = 0; ai < 2; ++ai)
#pragma unroll
            for (int m = 0; m < 4; ++m) { bf16* rowp = O + (size_t)(row0 + ai * HALF + m * 16) * ldc + col0;
#pragma unroll
                for (int bj = 0; bj < 2; ++bj) { const f32x4 v0 = acc[ai][bj][m][0], v1 = acc[ai][bj][m][1];
                    u32x4 w; w.x = cvt_pk_bf16(v0[0], v0[1]); w.y = cvt_pk_bf16(v0[2], v0[3]); w.z = cvt_pk_bf16(v1[0], v1[1]); w.w = cvt_pk_bf16(v1[2], v1[3]);
                    *(u32x4*)(rowp + bj * HALF) = w; } }
    }
};
struct EpiMerge {
    static constexpr bool PERM = true;
    bf16* S; const float* bgate; char* stash; char* P; int tid;
    __device__ __forceinline__ void operator()(const f32x4 (&acc)[2][2][4][2], const Unit& u, int wr, int wc, int fr, int fq) const {
        const int z = u.z >> 1, kind = u.z & 1; int tl = tid; asm volatile("" : "+v"(tl));
        GAS char* sp = (GAS char*)stash + (size_t)tl * 16;
        if (kind == 0) {
#pragma unroll
            for (int ai = 0; ai < 2; ++ai)
#pragma unroll
                for (int m = 0; m < 4; ++m)
#pragma unroll
                    for (int bj = 0; bj < 2; ++bj) { const f32x4 v0 = acc[ai][bj][m][0], v1 = acc[ai][bj][m][1];
                        u32x4 w; w.x = cvt_pk_bf16(v0[0], v0[1]); w.y = cvt_pk_bf16(v0[2], v0[3]); w.z = cvt_pk_bf16(v1[0], v1[1]); w.w = cvt_pk_bf16(v1[2], v1[3]);
                        *(GAS u32x4*)sp = w; sp += 8192; asm volatile("" : "+v"(sp)); }
            return;
        }
        GAS char* pq = (GAS char*)P + (size_t)tl * 16;
        const int row0 = u.pm * BM + wr * 64 + fr, col0 = u.pn * BM + wc * 32 + 8 * fq;
        const float* bz = bgate + z * 2048 + col0;
        f32x4 bv[2][2];
#pragma unroll
        for (int bj = 0; bj < 2; ++bj)
#pragma unroll
            for (int n = 0; n < 2; ++n) bv[bj][n] = *(const f32x4*)(bz + bj * HALF + 4 * n);
        GAS bf16* rowp = (GAS bf16*)S + (size_t)row0 * 2048 + col0;
#pragma unroll
        for (int ai = 0; ai < 2; ++ai)
#pragma unroll
            for (int m = 0; m < 4; ++m) {
#pragma unroll
                for (int bj = 0; bj < 2; ++bj) {
                    const u32x4 sw = *(const GAS u32x4*)sp; sp += 8192; asm volatile("" : "+v"(sp));
                    f32x4 v0 = acc[ai][bj][m][0] + bv[bj][0], v1 = acc[ai][bj][m][1] + bv[bj][1];
#pragma unroll
                    for (int j = 0; j < 4; ++j) { v0[j] = __builtin_amdgcn_rcpf(1.0f + __builtin_amdgcn_exp2f(-1.4426950408889634f * v0[j])); v1[j] = __builtin_amdgcn_rcpf(1.0f + __builtin_amdgcn_exp2f(-1.4426950408889634f * v1[j])); }
                    v0[0] *= bflo(sw.x); v0[1] *= bfhi(sw.x); v0[2] *= bflo(sw.y); v0[3] *= bfhi(sw.y);
                    v1[0] *= bflo(sw.z); v1[1] *= bfhi(sw.z); v1[2] *= bflo(sw.w); v1[3] *= bfhi(sw.w);
                    if (z > 0) { v0 += *(const GAS f32x4*)pq; v1 += *(const GAS f32x4*)(pq + 8192); }
                    if (z < 3) { *(GAS f32x4*)pq = v0; *(GAS f32x4*)(pq + 8192) = v1; }
                    else { u32x4 w; w.x = cvt_pk_bf16(v0[0], v0[1]); w.y = cvt_pk_bf16(v0[2], v0[3]); w.z = cvt_pk_bf16(v1[0], v1[1]); w.w = cvt_pk_bf16(v1[2], v1[3]);
                        *(GAS u32x4*)(rowp + bj * HALF) = w; }
                    pq += 16384; asm volatile("" : "+v"(pq));
                }
                rowp += (m == 3 ? (size_t)(HALF - 48) : (size_t)16) * 2048; asm volatile("" : "+v"(rowp));
                asm volatile("" ::: "memory"); }
    }
};
struct EpiOut {
    static constexpr bool PERM = false;
    float* Y; const float* xlat; const float* xctx; const float* mod_l; float alpha;
    __device__ __forceinline__ void operator()(const f32x4 (&acc)[2][2][4][2], const Unit& u, int wr, int wc, int fr, int fq) const {
        const int row0 = u.pm * BM + wr * 64 + fr, col0 = u.pn * BM + wc * 32 + 4 * fq;
        const float* xb = (u.pm < 64) ? xlat + (size_t)row0 * 2048 : xctx + (size_t)(row0 - 16384) * 2048;
        const float* ga = mod_l + (size_t)((u.pm < 64) ? (u.pm >> 4) : 4) * 12288 + 2 * 2048 + col0;
        f32x4 gv[2][2];
#pragma unroll
        for (int bj = 0; bj < 2; ++bj)
#pragma unroll
            for (int n = 0; n < 2; ++n) gv[bj][n] = *(const f32x4*)(ga + bj * HALF + n * 16);
#pragma unroll
        for (int ai = 0; ai < 2; ++ai)
#pragma unroll
            for (int m = 0; m < 4; ++m) { const size_t ro = (size_t)(ai * HALF + m * 16) * 2048 + col0; float* yp = Y + (size_t)row0 * 2048 + ro;
#pragma unroll
                for (int bj = 0; bj < 2; ++bj)
#pragma unroll
                    for (int n = 0; n < 2; ++n) { const f32x4 xv = *(const f32x4*)(xb + ro + bj * HALF + n * 16); *(f32x4*)(yp + bj * HALF + n * 16) = xv * alpha + gv[bj][n] * acc[ai][bj][m][n]; } }
    }
};

template <class Epi, class Sched>
__device__ __forceinline__ void gemm_phase(LAS unsigned char* lds, const Sched& S, const Epi& E, const int lda, const int ldb, const int tid) {
    const int wid = __builtin_amdgcn_readfirstlane(tid >> 6), lane = tid & 63, wr = wid >> 2, wc = wid & 3, fr = lane & 15, fq = lane >> 4;
    unsigned voffA[2], voffB[2];
#pragma unroll
    for (int i = 0; i < 2; ++i) { int R, C; stage_rc(tid * 16 + i * 8192, R, C); const int Rb = Epi::PERM ? ((R & ~31) + perm32(R & 31)) : R;
        voffA[i] = (unsigned)(R * lda + C) * 2u; voffB[i] = (unsigned)(Rb * ldb + C) * 2u; }
    const size_t kstep = (size_t)(BK * 2);
    const size_t hstepA = (size_t)HALF * lda * 2, hstepB = (size_t)HALF * ldb * 2;
    const unsigned ldsw = (unsigned)wid * 1024u;
    const int aoff = lds_byte(wr * 64 + fr, fq * 8), boff = lds_byte(wc * 32 + fr, fq * 8);
#define PG8_SA(b, h) (((b) * 2 + (h)) * HTB)
#define PG8_SB(b, h) ((4 + (b) * 2 + (h)) * HTB)
#define PG8_STAGE(bufoff, gbase, voff) do { _Pragma("unroll") for (int _i = 0; _i < 2; ++_i) \
        __builtin_amdgcn_global_load_lds((const unsigned*)((const char*)(gbase) + (voff)[_i]), (LAS unsigned*)(lds + (bufoff) + ldsw + _i * 8192), 16, 0, 0); } while (0)
#define PG8_LDA(dst, b, h) do { _Pragma("unroll") for (int m = 0; m < 4; ++m) _Pragma("unroll") for (int k = 0; k < 2; ++k) dst[m][k] = *(const LAS bf16x8*)(lds + PG8_SA(b, h) + aoff + m * 2048 + k * 1024); } while (0)
#define PG8_LDB(dst, b, h) do { _Pragma("unroll") for (int n = 0; n < 2; ++n) _Pragma("unroll") for (int k = 0; k < 2; ++k) dst[n][k] = *(const LAS bf16x8*)(lds + PG8_SB(b, h) + boff + n * 2048 + k * 1024); } while (0)
#define PG8_MMA(ai, bj, At, Bt) do { __builtin_amdgcn_s_setprio(1); _Pragma("unroll") for (int m = 0; m < 4; ++m) _Pragma("unroll") for (int n = 0; n < 2; ++n) _Pragma("unroll") for (int k = 0; k < 2; ++k) \
        acc[ai][bj][m][n] = __builtin_amdgcn_mfma_f32_16x16x32_bf16(Bt[n][k], At[m][k], acc[ai][bj][m][n], 0, 0, 0); __builtin_amdgcn_s_setprio(0); } while (0)
#define PG8_WAIT_V(n) asm volatile("s_waitcnt vmcnt(" #n ")" ::: "memory")
#define PG8_WAIT_L(n) asm volatile("s_waitcnt lgkmcnt(" #n ")" ::: "memory")
#define PG8_BAR __builtin_amdgcn_s_barrier()
#define PG8_SCHED __builtin_amdgcn_sched_barrier(0)
    Unit cur, nxt; int ui = 0;
    if (!S.next(0, cur)) return;
    f32x4 acc[2][2][4][2];
#pragma unroll
    for (int a = 0; a < 2; ++a)
#pragma unroll
        for (int b = 0; b < 2; ++b)
#pragma unroll
            for (int m = 0; m < 4; ++m)
#pragma unroll
                for (int n = 0; n < 2; ++n) acc[a][b][m][n] = (f32x4){0.f, 0.f, 0.f, 0.f};
    bf16x8 At[4][2], B0[2][2], B1[2][2];
    const char* cA; const char* cB; int nt; S.ptrs(cur, cA, cB, nt);
    PG8_STAGE(PG8_SB(0, 0), cB, voffB); PG8_STAGE(PG8_SB(0, 1), cB + hstepB, voffB); PG8_STAGE(PG8_SA(0, 0), cA, voffA); PG8_STAGE(PG8_SA(0, 1), cA + hstepA, voffA);
    if (wr == 1) PG8_BAR;
    PG8_WAIT_V(2); PG8_BAR;
    PG8_STAGE(PG8_SB(1, 0), cB + kstep, voffB); PG8_STAGE(PG8_SA(1, 0), cA + kstep, voffA); PG8_STAGE(PG8_SB(1, 1), cB + hstepB + kstep, voffB);
    PG8_WAIT_V(6); PG8_BAR;
    for (;;) {
        const bool has_next = S.next(ui + 1, nxt);
        const char* nA = cA; const char* nB = cB; int nnt = nt; if (has_next) S.ptrs(nxt, nA, nB, nnt);
        for (int t = 0; t < nt; t += 2) {
            const bool last = (t == nt - 2);
            const char* a1 = cA + (size_t)(t + 1) * kstep;
            const char* a2 = last ? nA : cA + (size_t)(t + 2) * kstep; const char* b2 = last ? nB : cB + (size_t)(t + 2) * kstep;
            const char* a3 = a2 + kstep; const char* b3 = b2 + kstep;
            PG8_LDB(B0, 0, 0); PG8_LDB(B1, 0, 1); PG8_SCHED; PG8_LDA(At, 0, 0); PG8_STAGE(PG8_SA(1, 1), a1 + hstepA, voffA);
            PG8_WAIT_V(8); PG8_WAIT_L(0); PG8_BAR; PG8_MMA(0, 0, At, B0); PG8_MMA(0, 1, At, B1); PG8_BAR; PG8_SCHED;
            PG8_LDA(At, 0, 1); PG8_STAGE(PG8_SB(0, 0), b2, voffB); PG8_STAGE(PG8_SB(0, 1), b2 + hstepB, voffB); PG8_STAGE(PG8_SA(0, 0), a2, voffA);
            PG8_WAIT_V(8); PG8_WAIT_L(0); PG8_BAR; PG8_MMA(1, 0, At, B0); PG8_MMA(1, 1, At, B1); PG8_BAR; PG8_SCHED;
            PG8_LDB(B0, 1, 0); PG8_LDB(B1, 1, 1); PG8_SCHED; PG8_LDA(At, 1, 0); PG8_STAGE(PG8_SA(0, 1), a2 + hstepA, voffA);
            PG8_WAIT_V(8); PG8_WAIT_L(0); PG8_BAR; PG8_MMA(0, 0, At, B0); PG8_MMA(0, 1, At, B1); PG8_BAR; PG8_SCHED;
            PG8_LDA(At, 1, 1); PG8_STAGE(PG8_SB(1, 0), b3, voffB); PG8_STAGE(PG8_SB(1, 1), b3 + hstepB, voffB); PG8_STAGE(PG8_SA(1, 0), a3, voffA);
            PG8_WAIT_V(8); PG8_WAIT_L(0); PG8_BAR; PG8_MMA(1, 0, At, B0); PG8_MMA(1, 1, At, B1); PG8_BAR; PG8_SCHED;
        }
        if (wr == 0) PG8_BAR;
        E(acc, cur, wr, wc, fr, fq);
        if (!has_next) break;
#pragma unroll
        for (int a = 0; a < 2; ++a)
#pragma unroll
            for (int b = 0; b < 2; ++b)
#pragma unroll
                for (int m = 0; m < 4; ++m)
#pragma unroll
                    for (int n = 0; n < 2; ++n) acc[a][b][m][n] = (f32x4){0.f, 0.f, 0.f, 0.f};
        cur = nxt; cA = nA; cB = nB; nt = nnt; ++ui;
        if (wr == 1) PG8_BAR;
    }
    PG8_WAIT_V(0);
    PG8_BAR;
#undef PG8_SA
#undef PG8_SB
#undef PG8_STAGE
#undef PG8_LDA
#undef PG8_LDB
#undef PG8_MMA
#undef PG8_WAIT_V
#undef PG8_WAIT_L
#undef PG8_BAR
#undef PG8_SCHED
}
}
namespace att {
constexpr int NW = 8, QBLK = 32, KVBLK = 64;
#define SBAR() __builtin_amdgcn_sched_barrier(0)
__device__ __forceinline__ int crow(int r, int hi) { return (r & 3) + 8 * (r >> 2) + 4 * hi; }
__device__ __forceinline__ unsigned cvtpk(float lo, float hi) { unsigned r; asm volatile("v_cvt_pk_bf16_f32 %0, %1, %2" : "=v"(r) : "v"(lo), "v"(hi)); return r; }

struct Args {
    const bf16* Q; int ldq;
    const bf16* KV; int ld;
    int kc0, kc1, vc;
    bf16* O; int ldo;
    int n0, n1, row0, row1;
    float C, thr;
    int qrope, qpos0;
    float sinkl2; int has_sink;
    int wpos0;
    const float* T; int r0, kr0;
};

__device__ __forceinline__ void partialSM(f32x16& p0, f32x16& p1, float& m_reg, float& mn, float& alpha, const float C, const float thr) {
    float pmax = p0[0];
#pragma unroll
    for (int r = 1; r < 16; ++r) pmax = fmaxf(pmax, p0[r]);
#pragma unroll
    for (int r = 0; r < 16; ++r) pmax = fmaxf(pmax, p1[r]);
    { auto rr = __builtin_amdgcn_permlane32_swap(__float_as_uint(pmax), __float_as_uint(pmax), false, false);
      pmax = fmaxf(__uint_as_float(rr[0]), __uint_as_float(rr[1])); }
    if (__builtin_expect(__all(pmax - m_reg <= thr), 1)) { mn = m_reg; alpha = 1.f; }
    else { mn = fmaxf(m_reg, pmax); alpha = __builtin_amdgcn_exp2f((m_reg - mn) * C); m_reg = mn; }
    const float mnC = -mn * C;
#pragma unroll
    for (int r = 0; r < 16; ++r) p0[r] = fmaf(p0[r], C, mnC);
#pragma unroll
    for (int r = 0; r < 16; ++r) p1[r] = fmaf(p1[r], C, mnC);
#pragma unroll
    for (int r = 0; r < 16; ++r) p0[r] = __builtin_amdgcn_exp2f(p0[r]);
}
__device__ __forceinline__ void finishSM(f32x16& p0, f32x16& p1, float alpha, float& l_reg, bf16x8& pa0, bf16x8& pa1, bf16x8& pa2, bf16x8& pa3) {
#pragma unroll
    for (int r = 0; r < 16; ++r) p1[r] = __builtin_amdgcn_exp2f(p1[r]);
    float ps = 0;
#pragma unroll
    for (int r = 0; r < 16; ++r) ps += p0[r];
#pragma unroll
    for (int r = 0; r < 16; ++r) ps += p1[r];
    { auto rr = __builtin_amdgcn_permlane32_swap(__float_as_uint(ps), __float_as_uint(ps), false, false);
      ps = __uint_as_float(rr[0]) + __uint_as_float(rr[1]); }
    l_reg = l_reg * alpha + ps;
#define PK4(P, BASE, OUT) do { unsigned a0 = cvtpk(P[BASE + 0], P[BASE + 1]), a1 = cvtpk(P[BASE + 2], P[BASE + 3]);   \
    unsigned b0 = cvtpk(P[BASE + 4], P[BASE + 5]), b1 = cvtpk(P[BASE + 6], P[BASE + 7]);                              \
    auto r0 = __builtin_amdgcn_permlane32_swap(a0, b0, false, false); auto r1 = __builtin_amdgcn_permlane32_swap(a1, b1, false, false); \
    u32x4 w = {r0[0], r1[0], r0[1], r1[1]}; OUT = *reinterpret_cast<bf16x8*>(&w); } while (0)
    PK4(p0, 0, pa0); PK4(p0, 8, pa1); PK4(p1, 0, pa2); PK4(p1, 8, pa3);
#undef PK4
}
template <int DK> __device__ __forceinline__ int kswz(int row, int ch) { return row * (DK * 2) + ((ch ^ (row & 7)) << 4); }
template <int DK, int QREG> __device__ __forceinline__ void qkt(f32x16& p0, f32x16& p1, const LAS char* Ks, const bf16x8* qr, const LAS char* qx, int r32, int hi) {
    p0 = f32x16{}; p1 = f32x16{};
#pragma unroll
    for (int d0 = 0; d0 < DK / 16; ++d0) { const int ch = d0 * 2 + hi;
        const bf16x8 b0 = *(const LAS bf16x8*)(Ks + kswz<DK>(r32, ch));
        const bf16x8 b1 = *(const LAS bf16x8*)(Ks + kswz<DK>(32 + r32, ch));
        bf16x8 q; if constexpr (true) { if (d0 < QREG) q = qr[d0 < QREG ? d0 : 0]; else q = *(const LAS bf16x8*)(qx + (d0 - QREG) * 1024); }
        p0 = __builtin_amdgcn_mfma_f32_32x32x16_bf16(b0, q, p0, 0, 0, 0);
        p1 = __builtin_amdgcn_mfma_f32_32x32x16_bf16(b1, q, p1, 0, 0, 0); }
}
template <int NCB> __device__ __forceinline__ int v_st(int k, int c) { const int kk = (k & ~0xC) | ((k & 4) << 1) | ((k & 8) >> 1); return ((kk >> 3) * NCB + (c >> 5)) * 512 + ((kk & 7) * 32 + (c & 31)) * 2; }
__device__ __forceinline__ int v_rd_base(int lane) { return ((lane & 3) << 3) | (((lane >> 2) & 3) << 6) | (((lane >> 4) & 1) << 5) | (((lane >> 5) & 1) << 8); }
template <int OFF> __device__ __forceinline__ s16x4 tr_read(int vb) { s16x4 r; asm volatile("ds_read_b64_tr_b16 %0, %1 offset:%2" : "=&v"(r) : "v"(vb), "i"(OFF) : "memory"); return r; }
template <int D0, int NCB> __device__ __forceinline__ void pv_one(f32x16& od, int vb, bf16x8 pa0, bf16x8 pa1, bf16x8 pa2, bf16x8 pa3) {
#define VOFF(ks, half) (D0 * 512 + (ks) * (2 * NCB * 512) + (half) * (NCB * 512))
    const s16x4 l0 = tr_read<VOFF(0, 0)>(vb), h0 = tr_read<VOFF(0, 1)>(vb), l1 = tr_read<VOFF(1, 0)>(vb), h1 = tr_read<VOFF(1, 1)>(vb);
    const s16x4 l2 = tr_read<VOFF(2, 0)>(vb), h2 = tr_read<VOFF(2, 1)>(vb), l3 = tr_read<VOFF(3, 0)>(vb), h3 = tr_read<VOFF(3, 1)>(vb);
#undef VOFF
    asm volatile("s_waitcnt lgkmcnt(0)" ::: "memory"); SBAR();
#define PK(L, H) (bf16x8){L[0], L[1], L[2], L[3], H[0], H[1], H[2], H[3]}
    od = __builtin_amdgcn_mfma_f32_32x32x16_bf16(pa0, PK(l0, h0), od, 0, 0, 0);
    od = __builtin_amdgcn_mfma_f32_32x32x16_bf16(pa1, PK(l1, h1), od, 0, 0, 0);
    od = __builtin_amdgcn_mfma_f32_32x32x16_bf16(pa2, PK(l2, h2), od, 0, 0, 0);
    od = __builtin_amdgcn_mfma_f32_32x32x16_bf16(pa3, PK(l3, h3), od, 0, 0, 0);
#undef PK
}
template <int NCB> __device__ __forceinline__ void pv_all(f32x16* o, int vb, bf16x8 pa0, bf16x8 pa1, bf16x8 pa2, bf16x8 pa3) {
    pv_one<0, NCB>(o[0], vb, pa0, pa1, pa2, pa3); pv_one<1, NCB>(o[1], vb, pa0, pa1, pa2, pa3);
    if constexpr (NCB == 4) { pv_one<2, NCB>(o[2], vb, pa0, pa1, pa2, pa3); pv_one<3, NCB>(o[3], vb, pa0, pa1, pa2, pa3); }
}

template <int MODE> __device__ __forceinline__ void apply_mask(f32x16& p0, f32x16& p1, const Args& a, int j, int wid, int r32, int hi) {
    if constexpr (MODE == 1) {
        if (j < a.n0) return;
        const int kp0 = a.wpos0 + 64 * (j - a.n0), qw0 = a.qpos0 + wid * 32;
        if (kp0 + 63 - qw0 <= 128 && qw0 + 31 - kp0 <= 128) return;
        const int dd0 = kp0 - (qw0 + r32) + 4 * hi + 128;
#pragma unroll
        for (int r = 0; r < 16; ++r) { const int dd = dd0 + (r & 3) + 8 * (r >> 2);
            p0[r] = ((unsigned)dd <= 256u) ? p0[r] : -1e30f; p1[r] = ((unsigned)(dd + 32) <= 256u) ? p1[r] : -1e30f; }
    } else if constexpr (MODE == 2) {
        if (j < a.n0) return;
        const int kr = a.kr0 + (j - a.n0), qr = a.r0 + (wid >> 1);
        int rs = qr - 4; rs = rs < 0 ? 0 : (rs > 56 ? 56 : rs);
        if (kr < rs || kr >= rs + 8) {
#pragma unroll
            for (int r = 0; r < 16; ++r) { p0[r] = -1e30f; p1[r] = -1e30f; }
            return; }
        const int dr = kr - qr + 7, qc = (wid & 1) * 32 + r32;
        const float* tb = a.T + ((size_t)(dr * 64 + qc)) * 64 + 4 * hi;
#pragma unroll
        for (int g = 0; g < 4; ++g) { const f32x4 t0 = *(const f32x4*)(tb + 8 * g), t1 = *(const f32x4*)(tb + 32 + 8 * g);
#pragma unroll
            for (int i = 0; i < 4; ++i) { p0[4 * g + i] += t0[i]; p1[4 * g + i] += t1[i]; }
            asm volatile("" ::: "memory"); }
    }
}

template <int DK, int DV, int MODE, int SDEPTH>
__device__ __forceinline__ void attn_unit(const Args& a, LAS char* lds, const int tid) {
    constexpr int NKC = DK / 8, NVC = DV / 8, KPT = DK / 64, VPT = DV / 64, NCB = DV / 32, ND0 = DK / 16, QREG = (ND0 > 8 ? 4 : ND0);
    constexpr int SHM_K = 64 * DK * 2, SHM_V = 64 * DV * 2;
    const int wid = __builtin_amdgcn_readfirstlane(tid >> 6), lane = tid & 63, r32 = lane & 31, hi = lane >> 5;
    LAS char* V_lds = lds; LAS char* K_lds = lds + 2 * SHM_V;
    LAS float* ws = (LAS float*)(lds + 2 * SHM_V + 2 * SHM_K) + wid * 64; LAS float* li_l = ws; LAS float* al_l = ws + 32;
    LAS char* qx = lds + 2 * SHM_V + 2 * SHM_K + NW * 256 + wid * ((ND0 - QREG) * 1024) + lane * 16;
    float m_reg = -1e30f, l_reg = 0; f32x16 o[NCB]; bf16x8 qr[ND0];
#pragma unroll
    for (int d = 0; d < NCB; ++d) o[d] = f32x16{};
    const bf16* Qw = a.Q + (long)(wid * QBLK + r32) * a.ldq + hi * 8;
#pragma unroll
    for (int d0 = 0; d0 < ND0; ++d0) qr[d0] = *(const bf16x8*)(Qw + d0 * 16);
    if constexpr (DK == 192) {
        if (a.qrope) {
            const int t = a.qpos0 + wid * QBLK + r32; const float prow = (float)(t >> 6), pcol = (float)(t & 63);
#pragma unroll
            for (int dd = 0; dd < 2; ++dd) {
                bf16x8 x1 = qr[8 + dd], x2 = qr[10 + dd]; const float pos = dd ? pcol : prow;
#pragma unroll
                for (int e = 0; e < 8; ++e) { const float inv = __builtin_amdgcn_exp2f(-(float)(hi * 8 + e) * (13.287712379549449f / 16.0f)); const float ang = pos * inv;
                    const float c = __cosf(ang), s = __sinf(ang); const float f1 = bf2f((unsigned short)x1[e]), f2 = bf2f((unsigned short)x2[e]);
                    x1[e] = (short)f2bf(f1 * c - f2 * s); x2[e] = (short)f2bf(f1 * s + f2 * c); }
                qr[8 + dd] = x1; qr[10 + dd] = x2; }
        }
#pragma unroll
        for (int d0 = QREG; d0 < ND0; ++d0) *(LAS bf16x8*)(qx + (d0 - QREG) * 1024) = qr[d0];
        asm volatile("s_waitcnt lgkmcnt(0)" ::: "memory");
    }
    int koff[KPT], klds[KPT], voff[VPT], vlds[VPT];
#pragma unroll
    for (int i = 0; i < KPT; ++i) { const int q = tid + 512 * i, row = q / NKC, ch = q % NKC; koff[i] = row * a.ld + (ch < 16 ? a.kc0 + 8 * ch : a.kc1 + 8 * (ch - 16)); klds[i] = kswz<DK>(row, ch); }
#pragma unroll
    for (int i = 0; i < VPT; ++i) { const int q = tid + 512 * i, row = q / NVC, ch = q % NVC; voff[i] = row * a.ld + a.vc + 8 * ch; vlds[i] = v_st<NCB>(row, 8 * ch); }
    const int vb0 = (int)(uintptr_t)V_lds + v_rd_base(lane);
    bf16x8 sk[SDEPTH][KPT], sv[SDEPTH][VPT];
    const int NT = a.n0 + a.n1;
#define TROW(j) ((j) < a.n0 ? a.row0 + 64 * (j) : a.row1 + 64 * ((j) - a.n0))
#define SLOAD(i, j) do { const bf16* _b = a.KV + (long)TROW(j) * a.ld; \
    _Pragma("unroll") for (int _k = 0; _k < VPT; ++_k) sv[i][_k] = *(const bf16x8*)(_b + voff[_k]); \
    _Pragma("unroll") for (int _k = 0; _k < KPT; ++_k) sk[i][_k] = *(const bf16x8*)(_b + koff[_k]); } while (0)
#define SWRITE(b, i) do { \
    _Pragma("unroll") for (int _k = 0; _k < VPT; ++_k) *(LAS bf16x8*)(V_lds + (b) * SHM_V + vlds[_k]) = sv[i][_k]; \
    _Pragma("unroll") for (int _k = 0; _k < KPT; ++_k) *(LAS bf16x8*)(K_lds + (b) * SHM_K + klds[_k]) = sk[i][_k]; } while (0)
#define SWAIT() do { if constexpr (SDEPTH == 2) asm volatile("s_waitcnt vmcnt(%0)" :: "n"(KPT + VPT) : "memory"); else asm volatile("s_waitcnt vmcnt(0)" ::: "memory"); } while (0)
#define RESC(al) do { if (__any((al) < 1.f)) { if (hi == 0) al_l[r32] = (al); asm volatile("s_waitcnt lgkmcnt(0)" ::: "memory"); \
    _Pragma("unroll") for (int d = 0; d < NCB; ++d) _Pragma("unroll") for (int r = 0; r < 16; ++r) o[d][r] *= al_l[crow(r, hi)]; } } while (0)
    f32x16 pA0, pA1, pB0, pB1; float mnA, mnB, alA, alB; bf16x8 pa0, pa1, pa2, pa3;
    constexpr int SE = 0, SO = SDEPTH - 1;
    SLOAD(SE, 0); asm volatile("s_waitcnt vmcnt(0)" ::: "memory"); SWRITE(0, SE); __syncthreads();
    qkt<DK, QREG>(pA0, pA1, K_lds, qr, qx, r32, hi); apply_mask<MODE>(pA0, pA1, a, 0, wid, r32, hi); partialSM(pA0, pA1, m_reg, mnA, alA, a.C, a.thr);
    SLOAD(SO, 1); if constexpr (SDEPTH == 2) { if (2 < NT) SLOAD(SE, 2); }
    SWAIT(); SWRITE(1, SO); __syncthreads();
    for (int j = 1; j + 1 < NT; j += 2) {
        SBAR(); qkt<DK, QREG>(pB0, pB1, K_lds + SHM_K, qr, qx, r32, hi);
        finishSM(pA0, pA1, alA, l_reg, pa0, pa1, pa2, pa3); SBAR();
        SLOAD(SO, j + SDEPTH); SBAR();
        pv_all<NCB>(o, vb0, pa0, pa1, pa2, pa3); if constexpr (MODE != 0) SBAR(); apply_mask<MODE>(pB0, pB1, a, j, wid, r32, hi); if constexpr (MODE != 0) SBAR(); partialSM(pB0, pB1, m_reg, mnB, alB, a.C, a.thr);
        __syncthreads(); SWAIT(); SWRITE(0, SE);
        RESC(alB); __syncthreads();
        SBAR(); qkt<DK, QREG>(pA0, pA1, K_lds, qr, qx, r32, hi);
        finishSM(pB0, pB1, alB, l_reg, pa0, pa1, pa2, pa3); SBAR();
        if (SDEPTH == 1 || j + 3 < NT) SLOAD(SE, j + 1 + SDEPTH); SBAR();
        pv_all<NCB>(o, vb0 + SHM_V, pa0, pa1, pa2, pa3); if constexpr (MODE != 0) SBAR(); apply_mask<MODE>(pA0, pA1, a, j + 1, wid, r32, hi); if constexpr (MODE != 0) SBAR(); partialSM(pA0, pA1, m_reg, mnA, alA, a.C, a.thr);
        __syncthreads(); SWAIT(); SWRITE(1, SO);
        RESC(alA); __syncthreads();
    }
    SBAR(); qkt<DK, QREG>(pB0, pB1, K_lds + SHM_K, qr, qx, r32, hi);
    finishSM(pA0, pA1, alA, l_reg, pa0, pa1, pa2, pa3); SBAR();
    pv_all<NCB>(o, vb0, pa0, pa1, pa2, pa3); if constexpr (MODE != 0) SBAR(); apply_mask<MODE>(pB0, pB1, a, NT - 1, wid, r32, hi); if constexpr (MODE != 0) SBAR(); partialSM(pB0, pB1, m_reg, mnB, alB, a.C, a.thr);
    __syncthreads(); RESC(alB);
    finishSM(pB0, pB1, alB, l_reg, pa0, pa1, pa2, pa3); SBAR();
    pv_all<NCB>(o, vb0 + SHM_V, pa0, pa1, pa2, pa3);
    if constexpr (MODE == 1) { if (a.has_sink) l_reg += __builtin_amdgcn_exp2f(a.sinkl2 - m_reg * a.C); }
    if (hi == 0) li_l[r32] = l_reg; asm volatile("s_waitcnt lgkmcnt(0)" ::: "memory");
    float rli[16];
#pragma unroll
    for (int r = 0; r < 16; ++r) rli[r] = __builtin_amdgcn_rcpf(li_l[crow(r, hi)]);
    bf16* Ow = a.O + (long)(wid * QBLK) * a.ldo;
#pragma unroll
    for (int r = 0; r < 16; ++r) { const int orow = crow(r, hi);
#pragma unroll
        for (int d0 = 0; d0 < NCB; ++d0) Ow[(long)orow * a.ldo + d0 * 32 + r32] = f2bf(o[d0][r] * rli[r]); }
    __syncthreads();
#undef TROW
#undef SLOAD
#undef SWRITE
#undef SWAIT
#undef RESC
}
#undef SBAR
}
constexpr int DM = 2048, NBATCH = 4, SEQ = 4096, NCTX = 256, DEPTH = 2;
constexpr int ML = NBATCH * SEQ, MC = NBATCH * NCTX, MT = ML + MC;
constexpr int INW = 3904, UW = 4096, QW = 1856;
constexpr int MODW = 6 * DM;
constexpr float LN_EPS = 1e-5f, RMS_EPS = 1e-6f;
constexpr float ALPHA = 1.4142135623730951f;
constexpr float LOG2E = 1.4426950408889634f;
constexpr float A_SCALE = 0.07216878364870323f, B_SCALE = 0.125f, C_SCALE = 0.08838834764831845f, D_SCALE = 0.08838834764831845f;
constexpr int U_CQ = 0, U_CKV = 384, U_KR = 512, U_BQ = 576, U_BK = 1088, U_BV = 1216, U_CQQ = 1344, U_CK = 1856, U_CV = 2368, U_DQ = 2880, U_DK = 3392, U_DV = 3648;
constexpr int QA_Q = 0, QA_KV = 768, QA_KR = 1792;

constexpr size_t MiB = 1u << 20;
constexpr size_t WS_CTL = 0, CTL_ZERO_BYTES = 1 * MiB;
constexpr size_t WS_MOD = 1 * MiB;
constexpr size_t WS_CTAB = 2 * MiB;
constexpr size_t WS_SUBK = 4 * MiB;
constexpr size_t WS_WUP = 5 * MiB;
constexpr size_t WS_WIN = 9 * MiB;
constexpr size_t WS_WC = 41 * MiB;
constexpr size_t WS_WO = 121 * MiB;
constexpr size_t WS_WPQ = 137 * MiB;
constexpr size_t WS_PU = 153 * MiB;
constexpr size_t WS_PV = 281 * MiB;
constexpr size_t WS_BUFA = 409 * MiB;
constexpr size_t WS_BUFB = 477 * MiB;
constexpr size_t WS_UREG = 545 * MiB;
constexpr size_t WS_QKVA = 681 * MiB;
constexpr size_t WS_OQP = 743 * MiB;
constexpr size_t WS_XRES = 811 * MiB;
constexpr size_t WS_EIDX = 947 * MiB;
constexpr size_t WS_EG = 956 * MiB;
constexpr size_t WS_MODP = 965 * MiB;
constexpr size_t WS_DBG = 973 * MiB;
constexpr size_t WS_END = 974 * MiB;
constexpr size_t STASH_WG = 131072, P_WG = 262144, WS_STASH = WS_UREG, WS_P = WS_UREG + 32 * MiB;
constexpr int CW_TMO = 0, CW_BAR = 4096;

constexpr int NWAVES = 8;
constexpr int RING_OFF = 0, RING_BYTES = 155648;
constexpr int LDSCTL_OFF = RING_BYTES, MISC_OFF = LDSCTL_OFF + 320;
constexpr int LDS_BYTES = 157696;

#define RLX_AGENT __ATOMIC_RELAXED, __HIP_MEMORY_SCOPE_AGENT
#define LDS_WAIT() asm volatile("s_waitcnt lgkmcnt(0)" ::: "memory")
#define VM_WAIT() asm volatile("s_waitcnt vmcnt(0)" ::: "memory")

#define XB_TMO      128
#define XB_XCNT(j)  (256  + 64 * (j))
#define XB_XSUB(j)  (1280 + 64 * (j))
#define XB_XGEN(j)  (2304 + 64 * (j))
#define XB_TOP      3328
#define XB_TOPGEN   3392
#define XCD_BAR_WORDS 3456
#define XB_SPIN_CAP (1u << 22)
__device__ __forceinline__ unsigned xb_ld(unsigned* p)              { return __hip_atomic_load(p, __ATOMIC_RELAXED, __HIP_MEMORY_SCOPE_AGENT); }
__device__ __forceinline__ unsigned xb_add(unsigned* p, unsigned v) { return __hip_atomic_fetch_add(p, v, __ATOMIC_RELAXED, __HIP_MEMORY_SCOPE_AGENT); }
__device__ __forceinline__ unsigned xb_xcc_id() { return (unsigned)__builtin_amdgcn_s_getreg((3 << 11) | 20) & 0xFu; }
#define XB_SPIN(cond, bar) do { unsigned _sp = 0; while (cond) { __builtin_amdgcn_s_sleep(1); \
    if ((++_sp & 255u) == 0u) { if (xb_ld(&(bar)[XB_TMO])) break; if (_sp > XB_SPIN_CAP) { atomicAdd(&(bar)[XB_TMO], 1u); break; } } } } while (0)
struct XcdBarrier { unsigned* bar; unsigned x; volatile LAS unsigned* st; };
__device__ __forceinline__ XcdBarrier xcd_barrier_post(unsigned* bar, volatile LAS unsigned* st) {
    XcdBarrier b; b.bar = bar; b.x = xb_xcc_id(); b.st = st;
    if (threadIdx.x == 0) (void)xb_add(&bar[XB_XCNT(b.x)], 1u);
    return b;
}
__device__ __forceinline__ void xcd_barrier_complete(unsigned* bar, unsigned x, unsigned& nloc, unsigned& nx) {
    const unsigned G = gridDim.x * gridDim.y * gridDim.z;
    unsigned sum, cnt, mine, sp = 0u;
    for (;;) {
        sum = 0u; cnt = 0u; mine = 0u;
#pragma unroll
        for (unsigned j = 0; j < 16; ++j) { const unsigned c = xb_ld(&bar[XB_XCNT(j)]); sum += c; cnt += (c > 0u) ? 1u : 0u; mine = (j == x) ? c : mine; }
        if (sum == G) break;
        __builtin_amdgcn_s_sleep(1);
        if ((++sp & 255u) == 0u) { if (xb_ld(&bar[XB_TMO])) break; if (sp > XB_SPIN_CAP) { atomicAdd(&bar[XB_TMO], 1u); break; } }
    }
    nloc = mine > 0u ? mine : 1u; nx = cnt > 0u ? cnt : 1u;
}
__device__ __forceinline__ void xcd_barrier(const XcdBarrier& b) {
    asm volatile("s_waitcnt vmcnt(0)" ::: "memory");
    __syncthreads();
    if (threadIdx.x == 0) {
        unsigned* bar = b.bar;
        __builtin_amdgcn_s_waitcnt(0);
        unsigned nloc = b.st[0], nx = b.st[1];
        if (nloc == 0u) { xcd_barrier_complete(bar, b.x, nloc, nx); b.st[0] = nloc; b.st[1] = nx; }
        const unsigned old = xb_add(&bar[XB_XSUB(b.x)], 1u);
        const unsigned gen = old / nloc;
        if (old + 1u == (gen + 1u) * nloc) {
            __builtin_amdgcn_fence(__ATOMIC_RELEASE, "agent");
            asm volatile("s_waitcnt vmcnt(0)" ::: "memory");
            const unsigned og = xb_add(&bar[XB_TOP], 1u);
            const unsigned tg = og / nx;
            if (og + 1u == (tg + 1u) * nx) xb_add(&bar[XB_TOPGEN], 1u);
            else XB_SPIN(xb_ld(&bar[XB_TOPGEN]) == tg, bar);
            __builtin_amdgcn_fence(__ATOMIC_ACQUIRE, "agent");
            xb_add(&bar[XB_XGEN(b.x)], 1u);
            asm volatile("s_waitcnt vmcnt(0)" ::: "memory");
        } else {
            XB_SPIN(xb_ld(&bar[XB_XGEN(b.x)]) == gen, bar);
            __builtin_amdgcn_fence(__ATOMIC_ACQUIRE, "agent");
            asm volatile("s_waitcnt vmcnt(0)" ::: "memory");
        }
    }
    __syncthreads();
}

struct In {
    const float *x, *c, *ctx, *c_ctx, *w_ada, *b_ada, *w_in, *a_q_norm, *a_kv_norm, *a_w_uq, *a_w_ukv, *b_sink, *c_rpb, *d_q_norm, *d_k_norm,
                *w_branch, *w_gate, *b_gate, *w_out, *ln1_g, *ln1_b, *ln2_g, *ln2_b, *peer_w_q, *peer_sub_keys, *peer_u, *peer_v;
};
struct Args { In in; float* out; unsigned char* ws; int ph_lo, ph_hi, li, pad; };
struct Frame { LAS unsigned char* lds; int tid, lane, wave, vcu, G; GAS unsigned char* ws; };
template <class T> __device__ __forceinline__ T* G(T* p) { return (T*)(GAS T*)p; }
typedef const __attribute__((address_space(4))) Args& KA;
typedef const __attribute__((address_space(4))) Args* KAP;
__device__ __forceinline__ KAP kargs() { KAP p = (KAP)__builtin_amdgcn_kernarg_segment_ptr(); asm volatile("" : "+s"(p)); return p; }

__device__ __forceinline__ float wave_sum(float v) {
#pragma unroll
    for (int o = 1; o < 64; o <<= 1) v += __shfl_xor(v, o);
    return v;
}
__device__ __forceinline__ unsigned pk2(float lo, float hi) { return cvt_pk_bf16(lo, hi); }
__device__ __forceinline__ float silu_f(float v) { return v / (1.0f + __expf(-v)); }

__device__ __forceinline__ void p0_transpose_item(const float* W, int ldw, int nblk, bf16* dst, int dpitch, int row_off, int col_off, const float* gain, LAS float* scr, int item, int lane) {
    const int kb = item / nblk, nb = item % nblk, k0 = 64 * kb, n0 = 32 * nb;
#pragma unroll 8
    for (int i = 0; i < 32; ++i) { const int kk = 2 * i + (lane >> 5); float v = W[(size_t)(k0 + kk) * ldw + n0 + (lane & 31)]; if (gain) v *= gain[k0 + kk]; scr[kk * 33 + (lane & 31)] = v; }
    LDS_WAIT(); asm volatile("" ::: "memory");
    const int c = lane & 7;
#pragma unroll
    for (int j = 0; j < 4; ++j) { const int n = (lane >> 3) + 8 * j; const LAS float* s = scr + (8 * c) * 33 + n;
        u32x4 o; o.x = pk2(s[0 * 33], s[1 * 33]); o.y = pk2(s[2 * 33], s[3 * 33]); o.z = pk2(s[4 * 33], s[5 * 33]); o.w = pk2(s[6 * 33], s[7 * 33]);
        *(GAS u32x4*)(dst + (size_t)(row_off + n0 + n) * dpitch + col_off + k0 + 8 * c) = o; }
    LDS_WAIT(); asm volatile("" ::: "memory");
}
struct TJob { const float* W; int K, N; bf16* dst; int dpitch, row_off, col_off; const float* gain; };
__device__ __forceinline__ int tjob_get(KA A, int job, TJob& t) {
    const int l = job / 13, j = job % 13; GAS unsigned char* ws = (GAS unsigned char*)A.ws; t.gain = nullptr; t.row_off = 0; t.col_off = 0;
    if (j == 0) { t.W = G(A.in.w_in) + (size_t)l * DM * INW; t.K = DM; t.N = INW; t.dst = (bf16*)(ws + WS_WIN) + (size_t)l * UW * DM; t.dpitch = DM; }
    else if (j <= 4) { const int z = j - 1; t.W = G(A.in.w_gate) + ((size_t)l * 4 + z) * DM * DM; t.K = DM; t.N = DM; t.dst = (bf16*)(ws + WS_WC) + ((size_t)l * 4 + z) * DM * 2560; t.dpitch = 2560; }
    else if (j <= 8) { const int z = j - 5; t.W = G(A.in.w_branch) + ((size_t)l * 4 + z) * 512 * DM; t.K = 512; t.N = DM; t.dst = (bf16*)(ws + WS_WC) + ((size_t)l * 4 + z) * DM * 2560; t.dpitch = 2560; t.col_off = 2048; }
    else if (j == 9) { t.W = G(A.in.w_out) + (size_t)l * DM * DM; t.K = DM; t.N = DM; t.dst = (bf16*)(ws + WS_WO) + (size_t)l * DM * DM; t.dpitch = DM; }
    else if (j == 10) { t.W = G(A.in.peer_w_q) + (size_t)l * DM * DM; t.K = DM; t.N = DM; t.dst = (bf16*)(ws + WS_WPQ) + (size_t)l * DM * DM; t.dpitch = DM; }
    else if (j == 11) { t.W = G(A.in.a_w_uq) + (size_t)l * 384 * 768; t.K = 384; t.N = 768; t.dst = (bf16*)(ws + WS_WUP) + (size_t)l * 1792 * 512; t.dpitch = 512; t.gain = G(A.in.a_q_norm) + l * 384; }
    else { t.W = G(A.in.a_w_ukv) + (size_t)l * 128 * 1024; t.K = 128; t.N = 1024; t.dst = (bf16*)(ws + WS_WUP) + (size_t)l * 1792 * 512; t.dpitch = 512; t.row_off = 768; t.col_off = 384; t.gain = G(A.in.a_kv_norm) + l * 128; }
    return (t.K / 64) * (t.N / 32);
}
__device__ __forceinline__ void p0_prologue(const Frame& F, KA A) {
    GAS unsigned char* ws = F.ws;
    const int gw = F.vcu * NWAVES + F.wave, NGW = F.G * NWAVES;
    const long gt = (long)gw * 64 + F.lane, NGT = (long)NGW * 64;
    {
        float* modp = (float*)(ws + WS_MODP);
        for (int it = gw; it < 2 * 16 * 48; it += NGW) {
            const int l = it / 768, ks = (it % 768) / 48, cg = it % 48, n = cg * 256 + F.lane * 4;
            const float* w = G(A.in.w_ada) + ((size_t)l * DM + ks * 128) * MODW + n;
            f32x4 acc[5];
#pragma unroll
            for (int r = 0; r < 5; ++r) acc[r] = (f32x4){0.f, 0.f, 0.f, 0.f};
#pragma unroll 8
            for (int k = 0; k < 128; ++k) {
                const f32x4 wv = *(const f32x4*)(w + (size_t)k * MODW);
                const int kk = ks * 128 + k;
#pragma unroll
                for (int r = 0; r < 5; ++r) { const float cv = (r < 4) ? G(A.in.c)[r * DM + kk] : G(A.in.c_ctx)[kk]; acc[r] += wv * silu_f(cv); }
            }
#pragma unroll
            for (int r = 0; r < 5; ++r) *(f32x4*)(modp + (((size_t)ks * 2 + l) * 5 + r) * MODW + n) = acc[r];
        }
    }
    {
        LAS float* scr = (LAS float*)(F.lds + RING_OFF + F.wave * 16384);
        int base = 0;
        for (int job = 0; job < 26; ++job) {
            TJob t; const int ni = tjob_get(A, job, t);
            int first = gw - (base % NGW); if (first < 0) first += NGW;
            for (int i = first; i < ni; i += NGW) p0_transpose_item(t.W, t.N, t.N / 32, t.dst, t.dpitch, t.row_off, t.col_off, t.gain, scr, i, F.lane);
            base += ni;
        }
    }
    for (long i = gt; i < 2L * 192 * 2048 / 8; i += NGT) { const int l = (int)(i / (192 * 256)), r = (int)(i % (192 * 256)); *(u32x4*)((bf16*)(ws + WS_WIN) + ((size_t)l * UW + 3904) * DM + (size_t)r * 8) = (u32x4){0u, 0u, 0u, 0u}; }
    for (long i = gt; i < 2L * 768 * 16; i += NGT) { const int l = (int)(i / (768 * 16)), r = (int)(i % (768 * 16)), row = r / 16, c8 = r % 16; *(u32x4*)((bf16*)(ws + WS_WUP) + ((size_t)l * 1792 + row) * 512 + 384 + c8 * 8) = (u32x4){0u, 0u, 0u, 0u}; }
    for (long i = gt; i < 2L * 1024 * 48; i += NGT) { const int l = (int)(i / (1024 * 48)), r = (int)(i % (1024 * 48)), row = r / 48, c8 = r % 48; *(u32x4*)((bf16*)(ws + WS_WUP) + ((size_t)l * 1792 + 768 + row) * 512 + c8 * 8) = (u32x4){0u, 0u, 0u, 0u}; }
    {
        const long n_sk = 2L * 8 * 2 * 128 * 128 / 8;
        for (long i = gt; i < n_sk; i += NGT) {
            const float* src = G(A.in.peer_sub_keys); bf16* dst = (bf16*)(ws + WS_SUBK);
            const f32x4 a = *(const f32x4*)(src + i * 8), b = *(const f32x4*)(src + i * 8 + 4);
            u32x4 o; o.x = pk2(a[0], a[1]); o.y = pk2(a[2], a[3]); o.z = pk2(b[0], b[1]); o.w = pk2(b[2], b[3]);
            *(u32x4*)(dst + i * 8) = o;
        }
        const long n_pu = 2L * 16384 * 2048 / 16;
        for (long i = gt; i < 2 * n_pu; i += NGT) {
            const bool isu = i < n_pu; const long j = isu ? i : i - n_pu;
            const float* src = (isu ? G(A.in.peer_u) : G(A.in.peer_v)) + j * 16; unsigned char* dst = (unsigned char*)(ws + (isu ? WS_PU : WS_PV)) + j * 16; const float sc = isu ? 32.0f : 4.0f;
            u32x4 o;
#pragma unroll
            for (int q = 0; q < 4; ++q) { const f32x4 a = __builtin_nontemporal_load((const f32x4*)(src + q * 4)) * sc;
                int w = __builtin_amdgcn_cvt_pk_fp8_f32(a[0], a[1], 0, false); w = __builtin_amdgcn_cvt_pk_fp8_f32(a[2], a[3], w, true); o[q] = (unsigned)w; }
            *(u32x4*)dst = o;
        }
    }
    {
        float* ct = (float*)(ws + WS_CTAB);
        for (long i = gt; i < 2L * 4 * 15 * 64 * 64; i += NGT) {
            const int kc = (int)(i & 63), qc = (int)((i >> 6) & 63), r = (int)(i >> 12), dr = r % 15, lh = r / 15;
            int cs = qc - 8; cs = cs < 0 ? 0 : (cs > 48 ? 48 : cs);
            int co = kc - qc + 15; co = co < 0 ? 0 : (co > 30 ? 30 : co);
            ct[i] = (kc >= cs && kc < cs + 16) ? G(A.in.c_rpb)[((size_t)lh * 15 + dr) * 31 + co] * (1.0f / C_SCALE) : -1e30f;
        }
    }
}
__device__ __forceinline__ void p1_modreduce(const Frame& F, KA A) {
    const long gt = ((long)F.vcu * NWAVES + F.wave) * 64 + F.lane, NGT = (long)F.G * NWAVES * 64;
    const float* modp = (const float*)(F.ws + WS_MODP); float* mod = (float*)(F.ws + WS_MOD);
    for (long i = gt; i < 2L * 5 * MODW; i += NGT) { const int n = (int)(i % MODW), l = (int)(i / (5 * MODW));
        float s = G(A.in.b_ada)[l * MODW + n];
#pragma unroll
        for (int ks = 0; ks < 16; ++ks) s += modp[(size_t)ks * 2 * 5 * MODW + i];
        mod[i] = s; }
}
__device__ __forceinline__ void p2_modulate0(const Frame& F, KA A) {
    const int gw = F.vcu * NWAVES + F.wave, NGW = F.G * NWAVES;
    const float* mod = (const float*)(F.ws + WS_MOD); bf16* H = (bf16*)(F.ws + WS_BUFA);
    for (int row = gw; row < MT; row += NGW) {
        const float* xr = row < ML ? G(A.in.x) + (size_t)row * DM : G(A.in.ctx) + (size_t)(row - ML) * DM;
        const float* mr = mod + (size_t)(row < ML ? (row >> 12) : 4) * MODW;
#pragma unroll
        for (int j = 0; j < 4; ++j) { const int c = j * 512 + F.lane * 8;
            const f32x4 a = *(const f32x4*)(xr + c), b = *(const f32x4*)(xr + c + 4);
            const f32x4 sh0 = *(const f32x4*)(mr + c), sh1 = *(const f32x4*)(mr + c + 4), sc0 = *(const f32x4*)(mr + DM + c), sc1 = *(const f32x4*)(mr + DM + c + 4);
            const f32x4 y0 = a * (sc0 + 1.0f) + sh0, y1 = b * (sc1 + 1.0f) + sh1;
            u32x4 o; o.x = pk2(y0[0], y0[1]); o.y = pk2(y0[2], y0[3]); o.z = pk2(y1[0], y1[1]); o.w = pk2(y1[2], y1[3]);
            *(u32x4*)(H + (size_t)row * DM + c) = o; }
    }
}
__device__ __forceinline__ void rope_pair(float& x1, float& x2, float ang) { const float c = __cosf(ang), s = __sinf(ang); const float y1 = x1 * c - x2 * s, y2 = x1 * s + x2 * c; x1 = y1; x2 = y2; }
__device__ __forceinline__ void enorm_phase(const Frame& F, KA A, int l) {
    const int gw = F.vcu * NWAVES + F.wave, NGW = F.G * NWAVES, lane = F.lane;
    bf16* U = (bf16*)(F.ws + WS_UREG); bf16* QK = (bf16*)(F.ws + WS_QKVA);
    const float* gq = G(A.in.d_q_norm) + l * 128; const float* gk = G(A.in.d_k_norm) + l * 128;
    const float L2T = 13.287712379549449f;
    for (int row = gw; row < MT; row += NGW) {
        bf16* u = U + (size_t)row * UW;
        const bool lat = row < ML; const int t = row & 4095;
        const float prow = lat ? (float)(t >> 6) : 0.f, pcol = lat ? (float)(t & 63) : 0.f;
        { unsigned w[3]; float ss = 0.f;
#pragma unroll
          for (int i = 0; i < 3; ++i) { w[i] = ((const unsigned*)(u + U_CQ))[lane + 64 * i]; const float a = bflo(w[i]), b = bfhi(w[i]); ss += a * a + b * b; }
          const float rstd = rsqrtf(wave_sum(ss) * (1.0f / 384.0f) + RMS_EPS);
#pragma unroll
          for (int i = 0; i < 3; ++i) ((unsigned*)(u + U_CQ))[lane + 64 * i] = pk2(bflo(w[i]) * rstd, bfhi(w[i]) * rstd); }
        { const unsigned w = ((const unsigned*)(u + U_CKV))[lane]; const float a = bflo(w), b = bfhi(w);
          const float rstd = rsqrtf(wave_sum(a * a + b * b) * (1.0f / 128.0f) + RMS_EPS);
          ((unsigned*)(u + U_CKV))[lane] = pk2(a * rstd, b * rstd); }
        const int j64 = lane & 31;
        const float ang64 = ((j64 < 16) ? prow : pcol) * __builtin_amdgcn_exp2f(-(float)(j64 & 15) * (L2T / 16.0f));
        if (lane < 32) { float x1 = bf2f(u[U_KR + lane]), x2 = bf2f(u[U_KR + 32 + lane]); rope_pair(x1, x2, ang64);
            bf16* o = QK + (size_t)row * QW + QA_KR; o[lane] = f2bf(x1); o[32 + lane] = f2bf(x2); }
#pragma unroll
        for (int i = 0; i < 4; ++i) { const int p = lane + 64 * i, hd = p >> 5; bf16* q = u + U_BQ + hd * 64;
            float x1 = bf2f(q[j64]), x2 = bf2f(q[32 + j64]); rope_pair(x1, x2, ang64); q[j64] = f2bf(x1); q[32 + j64] = f2bf(x2); }
        { const int hd = lane >> 5; bf16* q = u + U_BK + hd * 64;
          float x1 = bf2f(q[j64]), x2 = bf2f(q[32 + j64]); rope_pair(x1, x2, ang64); q[j64] = f2bf(x1); q[32 + j64] = f2bf(x2); }
        const float ang128 = ((lane < 32) ? prow : pcol) * __builtin_amdgcn_exp2f(-(float)(lane & 31) * (L2T / 32.0f));
        const float gq1 = gq[lane], gq2 = gq[64 + lane], gk1 = gk[lane], gk2 = gk[64 + lane];
#pragma unroll
        for (int hd = 0; hd < 4; ++hd) { bf16* q = u + U_DQ + hd * 128; float x1 = bf2f(q[lane]), x2 = bf2f(q[64 + lane]);
            const float rstd = rsqrtf(wave_sum(x1 * x1 + x2 * x2) * (1.0f / 128.0f) + RMS_EPS);
            x1 = x1 * rstd * gq1; x2 = x2 * rstd * gq2; rope_pair(x1, x2, ang128); q[lane] = f2bf(x1); q[64 + lane] = f2bf(x2); }
#pragma unroll
        for (int hd = 0; hd < 2; ++hd) { bf16* q = u + U_DK + hd * 128; float x1 = bf2f(q[lane]), x2 = bf2f(q[64 + lane]);
            const float rstd = rsqrtf(wave_sum(x1 * x1 + x2 * x2) * (1.0f / 128.0f) + RMS_EPS);
            x1 = x1 * rstd * gk1; x2 = x2 * rstd * gk2; rope_pair(x1, x2, ang128); q[lane] = f2bf(x1); q[64 + lane] = f2bf(x2); }
    }
}
__device__ __forceinline__ void ln1_phase(const Frame& F, KA A, int l, int nrows, bf16* HF) {
    const int gw = F.vcu * NWAVES + F.wave, NGW = F.G * NWAVES, lane = F.lane;
    float* Y = (float*)(F.ws + WS_UREG); const float* mod = (const float*)(F.ws + WS_MOD) + (size_t)l * 5 * MODW;
    const float* g = G(A.in.ln1_g) + l * DM; const float* b = G(A.in.ln1_b) + l * DM;
    for (int row = gw; row < nrows; row += NGW) {
        float* y = Y + (size_t)row * DM; const float* mr = mod + (size_t)(row < ML ? (row >> 12) : 4) * MODW;
        f32x4 v[8]; float s = 0.f;
#pragma unroll
        for (int j = 0; j < 4; ++j) { const int c = j * 512 + lane * 8; v[2 * j] = *(const f32x4*)(y + c); v[2 * j + 1] = *(const f32x4*)(y + c + 4); }
#pragma unroll
        for (int j = 0; j < 8; ++j) s += (v[j][0] + v[j][1]) + (v[j][2] + v[j][3]);
        const float mean = wave_sum(s) * (1.0f / DM); float q = 0.f;
#pragma unroll
        for (int j = 0; j < 8; ++j) { v[j] = v[j] - mean; q += (v[j][0] * v[j][0] + v[j][1] * v[j][1]) + (v[j][2] * v[j][2] + v[j][3] * v[j][3]); }
        const float rstd = rsqrtf(wave_sum(q) * (1.0f / DM) + LN_EPS);
#pragma unroll
        for (int j = 0; j < 4; ++j) { const int c = j * 512 + lane * 8;
            const f32x4 x0 = v[2 * j] * rstd * *(const f32x4*)(g + c) + *(const f32x4*)(b + c), x1 = v[2 * j + 1] * rstd * *(const f32x4*)(g + c + 4) + *(const f32x4*)(b + c + 4);
            *(f32x4*)(y + c) = x0; *(f32x4*)(y + c + 4) = x1;
            const f32x4 h0 = x0 * (*(const f32x4*)(mr + 4 * DM + c) + 1.0f) + *(const f32x4*)(mr + 3 * DM + c), h1 = x1 * (*(const f32x4*)(mr + 4 * DM + c + 4) + 1.0f) + *(const f32x4*)(mr + 3 * DM + c + 4);
            u32x4 o; o.x = pk2(h0[0], h0[1]); o.y = pk2(h0[2], h0[3]); o.z = pk2(h1[0], h1[1]); o.w = pk2(h1[2], h1[3]);
            *(u32x4*)(HF + (size_t)row * DM + c) = o; }
    }
}
namespace peer {
__device__ __forceinline__ unsigned okey(float f) { const unsigned u = __float_as_uint(f); return (u & 0x80000000u) ? ~u : (u | 0x80000000u); }
__device__ __forceinline__ float ikey(unsigned k) { const unsigned u = (k & 0x80000000u) ? (k & 0x7fffffffu) : ~k; return __uint_as_float(u); }
#define CE_DESC(a, b) do { const unsigned _mx = (a) > (b) ? (a) : (b), _mn = (a) > (b) ? (b) : (a); (a) = _mx; (b) = _mn; } while (0)
#define CE_ASC(a, b)  do { const unsigned _mx = (a) > (b) ? (a) : (b), _mn = (a) > (b) ? (b) : (a); (a) = _mn; (b) = _mx; } while (0)
__device__ __forceinline__ void sort16_desc(unsigned (&k)[16]) {
#pragma unroll
    for (int size = 2; size <= 16; size <<= 1)
#pragma unroll
        for (int stride = size >> 1; stride > 0; stride >>= 1)
#pragma unroll
            for (int i = 0; i < 16; ++i) { const int p = i ^ stride; if (p > i) { if ((i & size) == 0) CE_DESC(k[i], k[p]); else CE_ASC(k[i], k[p]); } }
}
__device__ __forceinline__ void merge16_desc(unsigned (&a)[16], const unsigned (&b)[16]) {
#pragma unroll
    for (int i = 0; i < 16; ++i) a[i] = a[i] > b[15 - i] ? a[i] : b[15 - i];
#pragma unroll
    for (int stride = 8; stride > 0; stride >>= 1)
#pragma unroll
        for (int i = 0; i < 16; ++i) { const int p = i ^ stride; if (p > i) CE_DESC(a[i], a[p]); }
}
constexpr int slot_x(int s) { int n = 0; for (int x = 0; x < 16; ++x) for (int y = 0; y < 16; ++y) if ((x + 1) * (y + 1) <= 16) { if (n == s) return x; ++n; } return -1; }
constexpr int slot_y(int s) { int n = 0; for (int x = 0; x < 16; ++x) for (int y = 0; y < 16; ++y) if ((x + 1) * (y + 1) <= 16) { if (n == s) return y; ++n; } return -1; }
template <int S> struct Slot { static constexpr int x = slot_x(S), y = slot_y(S); };
template <int S> __device__ __forceinline__ void cand_one(unsigned (&c)[64], const float (&v0)[16], const float (&v1)[16], const unsigned (&i0)[16], const unsigned (&i1)[16], LAS unsigned short* tbl) {
    if constexpr (Slot<S>::x >= 0) { c[S] = (okey(v0[Slot<S>::x] + v1[Slot<S>::y]) & ~63u) | (unsigned)(63 - S); tbl[S] = (unsigned short)(i0[Slot<S>::x] * 128u + i1[Slot<S>::y]); }
    else c[S] = 0u;
}
template <int... S> __device__ __forceinline__ void cand_all(unsigned (&c)[64], const float (&v0)[16], const float (&v1)[16], const unsigned (&i0)[16], const unsigned (&i1)[16], LAS unsigned short* tbl, std::integer_sequence<int, S...>) {
    (cand_one<S>(c, v0, v1, i0, i1, tbl), ...);
}
__device__ __forceinline__ void topk_item(const bf16* QP, const bf16* SK, int* EIDX, float* EG, int tok0, int h, LAS unsigned short* tblw, int lane) {
    const int r32 = lane & 31, hi = lane >> 5;
    const bf16* qrow = QP + (size_t)(tok0 + r32) * DM + h * 256 + hi * 8;
    unsigned L[2][16];
#pragma unroll
    for (int p = 0; p < 2; ++p) {
        f32x16 acc[4];
#pragma unroll
        for (int kb = 0; kb < 4; ++kb) acc[kb] = f32x16{};
        const bf16* skp = SK + ((size_t)(h * 2 + p) * 128 + r32) * 128 + hi * 8;
#pragma unroll 2
        for (int d0 = 0; d0 < 8; ++d0) { const bf16x8 bq = *(const bf16x8*)(qrow + p * 128 + d0 * 16);
#pragma unroll
            for (int kb = 0; kb < 4; ++kb) { const bf16x8 ak = *(const bf16x8*)(skp + (size_t)kb * 32 * 128 + d0 * 16); acc[kb] = __builtin_amdgcn_mfma_f32_32x32x16_bf16(ak, bq, acc[kb], 0, 0, 0); } }
        unsigned g[4][16];
#pragma unroll
        for (int kb = 0; kb < 4; ++kb) {
#pragma unroll
            for (int r = 0; r < 16; ++r) g[kb][r] = (okey(acc[kb][r]) & ~127u) | (unsigned)(127 - (32 * kb + (r & 3) + 8 * (r >> 2) + 4 * hi));
            sort16_desc(g[kb]); }
        merge16_desc(g[0], g[1]); merge16_desc(g[2], g[3]); merge16_desc(g[0], g[2]);
        unsigned o[16];
#pragma unroll
        for (int i = 0; i < 16; ++i) o[i] = (unsigned)__shfl_xor((int)g[0][i], 32);
        merge16_desc(g[0], o);
#pragma unroll
        for (int i = 0; i < 16; ++i) L[p][i] = g[0][i];
    }
    float v0[16], v1[16]; unsigned i0[16], i1[16];
#pragma unroll
    for (int i = 0; i < 16; ++i) { v0[i] = ikey(L[0][i] & ~127u); v1[i] = ikey(L[1][i] & ~127u); i0[i] = 127u - (L[0][i] & 127u); i1[i] = 127u - (L[1][i] & 127u); }
    LAS unsigned short* tbl = tblw + lane * 66;
    unsigned c[64];
    cand_all(c, v0, v1, i0, i1, tbl, std::make_integer_sequence<int, 64>{});
    unsigned c0[16], c1[16], c2[16], c3[16];
#pragma unroll
    for (int i = 0; i < 16; ++i) { c0[i] = c[i]; c1[i] = c[16 + i]; c2[i] = c[32 + i]; c3[i] = c[48 + i]; }
    sort16_desc(c0); sort16_desc(c1); sort16_desc(c2); sort16_desc(c3);
    merge16_desc(c0, c1); merge16_desc(c2, c3); merge16_desc(c0, c2);
    LDS_WAIT(); asm volatile("" ::: "memory");
    float best[16]; int eid[16]; float sum = 0.f;
    const float mx = ikey(c0[0] & ~63u);
#pragma unroll
    for (int i = 0; i < 16; ++i) { const unsigned s = 63u - (c0[i] & 63u); eid[i] = (int)tbl[s]; best[i] = __expf(ikey(c0[i] & ~63u) - mx); sum += best[i]; }
    const float inv = 1.0f / sum;
    if (hi == 0) {
        int* ep = EIDX + (size_t)(tok0 + r32) * 128 + h * 16; float* gp = EG + (size_t)(tok0 + r32) * 128 + h * 16;
#pragma unroll
        for (int i = 0; i < 16; ++i) { ep[i] = eid[i]; gp[i] = best[i] * inv; }
    }
    LDS_WAIT(); asm volatile("" ::: "memory");
}
}
namespace px {
constexpr int TS = 4;
constexpr int NCH = 16, CHSH = 10;
constexpr float USCALE = 32.0f, VSCALE = 4.0f;
constexpr int L_SE = 0, L_SG = L_SE + TS * 128 * 2, L_ACT = L_SG + TS * 128 * 4, L_OFF = L_ACT + TS * 128 * 4, L_WAVE = ((L_OFF + TS * 20 * 4 + 255) / 256) * 256;
__device__ __forceinline__ float gelu_exact(float v) { return 0.5f * v * (1.0f + erff(v * 0.70710678118654752f)); }

__device__ __forceinline__ void sort_token(const int* EIDX, const float* EG, int tok, LAS unsigned short* se, LAS float* sg, LAS int* off, int lane) {
    unsigned k0 = ((unsigned)EIDX[(size_t)tok * 128 + lane] << 7) | (unsigned)lane, k1 = ((unsigned)EIDX[(size_t)tok * 128 + 64 + lane] << 7) | (unsigned)(64 + lane);
#pragma unroll
    for (int size = 2; size <= 128; size <<= 1)
#pragma unroll
        for (int stride = size >> 1; stride > 0; stride >>= 1) {
            if (stride == 64) { const unsigned lo = k0 < k1 ? k0 : k1, hi = k0 < k1 ? k1 : k0; k0 = lo; k1 = hi; }
            else {
                const unsigned p0 = (unsigned)__shfl_xor((int)k0, stride), p1 = (unsigned)__shfl_xor((int)k1, stride);
                const bool lower = (lane & stride) == 0;
                const bool up0 = (lane & size) == 0 || size == 128 || size == 64;
                const bool up1 = size == 128 ? true : (size == 64 ? false : (lane & size) == 0);
                k0 = (lower == up0) ? (k0 < p0 ? k0 : p0) : (k0 < p0 ? p0 : k0);
                k1 = (lower == up1) ? (k1 < p1 ? k1 : p1) : (k1 < p1 ? p1 : k1);
            }
        }
    const unsigned e0 = k0 >> 7, e1 = k1 >> 7;
    se[lane] = (unsigned short)e0; se[64 + lane] = (unsigned short)e1;
    sg[lane] = EG[(size_t)tok * 128 + (k0 & 127u)]; sg[64 + lane] = EG[(size_t)tok * 128 + (k1 & 127u)];
#pragma unroll
    for (int c = 0; c <= NCH; ++c) {
        const unsigned lim = (unsigned)c << CHSH;
        const int cnt = __builtin_popcountll(__ballot(e0 < lim)) + __builtin_popcountll(__ballot(e1 < lim));
        if (lane == 0) off[c] = cnt;
    }
}
__device__ __forceinline__ f32x2 cvt8(unsigned w, bool hi) { return hi ? __builtin_amdgcn_cvt_pk_f32_fp8((int)w, true) : __builtin_amdgcn_cvt_pk_f32_fp8((int)w, false); }
__device__ __forceinline__ float dot32(const f32x2 (&h)[16], const u32x4 r0, const u32x4 r1) {
    f32x2 a = {0.f, 0.f}, b = {0.f, 0.f};
#pragma unroll
    for (int q = 0; q < 4; ++q) { a = __builtin_elementwise_fma(h[2 * q], cvt8(r0[q], false), a); b = __builtin_elementwise_fma(h[2 * q + 1], cvt8(r0[q], true), b); }
#pragma unroll
    for (int q = 0; q < 4; ++q) { a = __builtin_elementwise_fma(h[8 + 2 * q], cvt8(r1[q], false), a); b = __builtin_elementwise_fma(h[8 + 2 * q + 1], cvt8(r1[q], true), b); }
    return (a.x + a.y) + (b.x + b.y);
}
__device__ __forceinline__ void axpy32(f32x2 (&acc)[16], const float w, const u32x4 r0, const u32x4 r1) {
    const f32x2 ww = {w, w};
#pragma unroll
    for (int q = 0; q < 4; ++q) { acc[2 * q] = __builtin_elementwise_fma(ww, cvt8(r0[q], false), acc[2 * q]); acc[2 * q + 1] = __builtin_elementwise_fma(ww, cvt8(r0[q], true), acc[2 * q + 1]); }
#pragma unroll
    for (int q = 0; q < 4; ++q) { acc[8 + 2 * q] = __builtin_elementwise_fma(ww, cvt8(r1[q], false), acc[8 + 2 * q]); acc[8 + 2 * q + 1] = __builtin_elementwise_fma(ww, cvt8(r1[q], true), acc[8 + 2 * q + 1]); }
}
__device__ __forceinline__ void useg(const f32x2 (&h)[16], const unsigned char* PU8, LAS const unsigned short* se, LAS const float* sg, LAS float* act, int i0, int i1, int lane) {
    for (int i = i0; i < i1; i += 4) {
        int ii = i + (lane & 3); ii = ii < i1 ? ii : i1 - 1;
        const int my_e = se[ii];
        const int e0 = __builtin_amdgcn_readlane(my_e, 0), e1 = __builtin_amdgcn_readlane(my_e, 1), e2 = __builtin_amdgcn_readlane(my_e, 2), e3 = __builtin_amdgcn_readlane(my_e, 3);
        const unsigned char* b0 = PU8 + (size_t)e0 * 2048 + lane * 16; const unsigned char* b1 = PU8 + (size_t)e1 * 2048 + lane * 16;
        const unsigned char* b2 = PU8 + (size_t)e2 * 2048 + lane * 16; const unsigned char* b3 = PU8 + (size_t)e3 * 2048 + lane * 16;
        const u32x4 r00 = *(const u32x4*)b0, r01 = *(const u32x4*)(b0 + 1024), r10 = *(const u32x4*)b1, r11 = *(const u32x4*)(b1 + 1024);
        const u32x4 r20 = *(const u32x4*)b2, r21 = *(const u32x4*)(b2 + 1024), r30 = *(const u32x4*)b3, r31 = *(const u32x4*)(b3 + 1024);
        const float p0 = dot32(h, r00, r01); __builtin_amdgcn_sched_barrier(0);
        const float p1 = dot32(h, r10, r11); __builtin_amdgcn_sched_barrier(0);
        const float p2 = dot32(h, r20, r21); __builtin_amdgcn_sched_barrier(0);
        const float p3 = dot32(h, r30, r31); __builtin_amdgcn_sched_barrier(0);
        float dot;
        { const bool u1 = lane & 1, u2 = lane & 2;
          const float q0 = (u1 ? p1 : p0) + __shfl_xor(u1 ? p0 : p1, 1);
          const float q1 = (u1 ? p3 : p2) + __shfl_xor(u1 ? p2 : p3, 1);
          dot = (u2 ? q1 : q0) + __shfl_xor(u2 ? q0 : q1, 2);
          dot += __shfl_xor(dot, 4); dot += __shfl_xor(dot, 8); dot += __shfl_xor(dot, 16); dot += __shfl_xor(dot, 32); }
        const float a = gelu_exact(dot * (1.0f / USCALE)) * sg[ii];
        if (lane < 4 && i + lane < i1) act[i + lane] = a * (1.0f / VSCALE);
    }
}
__device__ __forceinline__ void vseg(f32x2 (&acc)[16], const unsigned char* PV8, LAS const unsigned short* se, LAS const float* act, int i0, int i1, int lane) {
    for (int i = i0; i < i1; i += 4) {
        int ii = i + (lane & 3); const bool ok = ii < i1; ii = ok ? ii : i1 - 1;
        const int my_e = se[ii]; const float my_w = ok ? act[ii] : 0.f;
        const int e0 = __builtin_amdgcn_readlane(my_e, 0), e1 = __builtin_amdgcn_readlane(my_e, 1), e2 = __builtin_amdgcn_readlane(my_e, 2), e3 = __builtin_amdgcn_readlane(my_e, 3);
        const float w0 = __uint_as_float(__builtin_amdgcn_readlane(__float_as_uint(my_w), 0)), w1 = __uint_as_float(__builtin_amdgcn_readlane(__float_as_uint(my_w), 1));
        const float w2 = __uint_as_float(__builtin_amdgcn_readlane(__float_as_uint(my_w), 2)), w3 = __uint_as_float(__builtin_amdgcn_readlane(__float_as_uint(my_w), 3));
        const unsigned char* b0 = PV8 + (size_t)e0 * 2048 + lane * 16; const unsigned char* b1 = PV8 + (size_t)e1 * 2048 + lane * 16;
        const unsigned char* b2 = PV8 + (size_t)e2 * 2048 + lane * 16; const unsigned char* b3 = PV8 + (size_t)e3 * 2048 + lane * 16;
        const u32x4 r00 = *(const u32x4*)b0, r01 = *(const u32x4*)(b0 + 1024), r10 = *(const u32x4*)b1, r11 = *(const u32x4*)(b1 + 1024);
        const u32x4 r20 = *(const u32x4*)b2, r21 = *(const u32x4*)(b2 + 1024), r30 = *(const u32x4*)b3, r31 = *(const u32x4*)(b3 + 1024);
        axpy32(acc, w0, r00, r01); __builtin_amdgcn_sched_barrier(0); axpy32(acc, w1, r10, r11); __builtin_amdgcn_sched_barrier(0);
        axpy32(acc, w2, r20, r21); __builtin_amdgcn_sched_barrier(0); axpy32(acc, w3, r30, r31); __builtin_amdgcn_sched_barrier(0);
    }
}
__device__ __forceinline__ void load_h(f32x2 (&h)[16], const bf16* HF, int tok, int lane) {
#pragma unroll
    for (int j = 0; j < 2; ++j) { const u32x4 a = *(const u32x4*)(HF + (size_t)tok * DM + j * 1024 + lane * 16), b = *(const u32x4*)(HF + (size_t)tok * DM + j * 1024 + lane * 16 + 8);
#pragma unroll
        for (int q = 0; q < 4; ++q) { h[j * 8 + q] = (f32x2){bflo(a[q]), bfhi(a[q])}; h[j * 8 + 4 + q] = (f32x2){bflo(b[q]), bfhi(b[q])}; } }
}
__device__ __forceinline__ float ln2_stage_a(f32x2 (&acc)[16], int tok, float* X1, const float* mr, int lane) {
    float* x1 = X1 + (size_t)tok * DM; float s = 0.f;
#pragma unroll
    for (int j = 0; j < 2; ++j)
#pragma unroll
        for (int q = 0; q < 4; ++q) { const int c = j * 1024 + lane * 16 + q * 4; const f32x4 xa = *(const f32x4*)(x1 + c), ga = *(const f32x4*)(mr + 5 * DM + c);
            const f32x2 a0 = acc[j * 8 + 2 * q], a1 = acc[j * 8 + 2 * q + 1];
            const f32x4 v = (f32x4){ALPHA * xa[0] + ga[0] * a0.x, ALPHA * xa[1] + ga[1] * a0.y, ALPHA * xa[2] + ga[2] * a1.x, ALPHA * xa[3] + ga[3] * a1.y};
            s += (v[0] + v[1]) + (v[2] + v[3]); *(f32x4*)(x1 + c) = v; asm volatile("" ::: "memory"); }
    return wave_sum(s) * (1.0f / DM);
}
__device__ __forceinline__ void ln2_stage_b(int tok, float mean, const float* X1, const float* mn, const float* g2, const float* b2, float* outp, bf16* Hnext, int lane) {
    const float* x1 = X1 + (size_t)tok * DM; f32x4 v[8]; float q2 = 0.f;
#pragma unroll
    for (int j = 0; j < 2; ++j)
#pragma unroll
        for (int q = 0; q < 4; ++q) { v[j * 4 + q] = *(const f32x4*)(x1 + j * 1024 + lane * 16 + q * 4) - mean; const f32x4 d = v[j * 4 + q]; q2 += (d[0] * d[0] + d[1] * d[1]) + (d[2] * d[2] + d[3] * d[3]); }
    const float rstd = rsqrtf(wave_sum(q2) * (1.0f / DM) + LN_EPS);
#pragma unroll
    for (int j = 0; j < 2; ++j)
#pragma unroll
        for (int q = 0; q < 4; ++q) { const int c = j * 1024 + lane * 16 + q * 4; const f32x4 y = v[j * 4 + q] * rstd * *(const f32x4*)(g2 + c) + *(const f32x4*)(b2 + c);
            *(f32x4*)(outp + (size_t)tok * DM + c) = y;
            if (Hnext) { const f32x4 z = y * (*(const f32x4*)(mn + DM + c) + 1.0f) + *(const f32x4*)(mn + c);
                u32x2 o; o.x = pk2(z[0], z[1]); o.y = pk2(z[2], z[3]); *(u32x2*)(Hnext + (size_t)tok * DM + c) = o; }
            asm volatile("" ::: "memory"); }
}
}

__device__ __forceinline__ void pexp8_phase(const Frame& F, KA A, int l, int ntok, const bf16* HF, float* outp, bf16* Hnext) {
    using namespace px;
    const int lane = F.lane;
    const unsigned char* PU8 = (const unsigned char*)(F.ws + WS_PU) + (size_t)l * 16384 * DM; const unsigned char* PV8 = (const unsigned char*)(F.ws + WS_PV) + (size_t)l * 16384 * DM;
    const int* EIDX = (const int*)(F.ws + WS_EIDX); const float* EG = (const float*)(F.ws + WS_EG);
    float* X1 = (float*)(F.ws + WS_UREG); const float* mod = (const float*)(F.ws + WS_MOD);
    const float* g2 = G(A.in.ln2_g) + l * DM; const float* b2 = G(A.in.ln2_b) + l * DM;
    LAS unsigned char* wl = F.lds + RING_OFF + F.wave * L_WAVE;
    const int NXD = (F.G % 8 == 0) ? 8 : 1, WPX = (F.G / NXD) * NWAVES, xcd = F.vcu / (F.G / NXD), wv = (F.vcu % (F.G / NXD)) * NWAVES + F.wave;
    const int TPX = ntok / NXD, npass = (TPX + WPX * TS - 1) / (WPX * TS), TPP = (TPX + npass - 1) / npass;
    for (int pass = 0; pass < npass; ++pass) {
        const int pbase = xcd * TPX + pass * TPP, pend = (pbase + TPP < (xcd + 1) * TPX) ? pbase + TPP : (xcd + 1) * TPX;
        int tok[TS];
#pragma unroll
        for (int s = 0; s < TS; ++s) { const int t = pbase + s * WPX + wv; tok[s] = t < pend ? t : -1; }
#pragma unroll
        for (int s = 0; s < TS; ++s) {
            LAS int* off = (LAS int*)(wl + L_OFF) + s * 20;
#ifndef NO_SORT
            if (tok[s] >= 0) sort_token(EIDX, EG, tok[s], (LAS unsigned short*)(wl + L_SE) + s * 128, (LAS float*)(wl + L_SG) + s * 128, off, lane);
            else
#endif
            if (lane <= NCH) off[lane] = 0;
        }
        LDS_WAIT(); asm volatile("" ::: "memory");
#ifndef NO_US
        {
            f32x2 h[TS][16];
#pragma unroll
            for (int s = 0; s < TS; ++s) { if (tok[s] >= 0) load_h(h[s], HF, tok[s], lane); else {
#pragma unroll
                for (int k = 0; k < 16; ++k) h[s][k] = (f32x2){0.f, 0.f}; } }
            for (int c = 0; c < NCH; ++c) {
#pragma unroll
                for (int s = 0; s < TS; ++s) { LAS const int* off = (LAS const int*)(wl + L_OFF) + s * 20;
                    const int i0 = __builtin_amdgcn_readfirstlane(off[c]), i1 = __builtin_amdgcn_readfirstlane(off[c + 1]);
                    useg(h[s], PU8, (LAS const unsigned short*)(wl + L_SE) + s * 128, (LAS const float*)(wl + L_SG) + s * 128, (LAS float*)(wl + L_ACT) + s * 128, i0, i1, lane); }
            }
        }
#endif
        LDS_WAIT(); asm volatile("" ::: "memory");
        {
            f32x2 acc[TS][16];
#pragma unroll
            for (int s = 0; s < TS; ++s)
#pragma unroll
                for (int k = 0; k < 16; ++k) acc[s][k] = (f32x2){0.f, 0.f};
            for (int c = 0; c < NCH; ++c) {
#pragma unroll
                for (int s = 0; s < TS; ++s) { LAS const int* off = (LAS const int*)(wl + L_OFF) + s * 20;
                    const int i0 = __builtin_amdgcn_readfirstlane(off[c]), i1 = __builtin_amdgcn_readfirstlane(off[c + 1]);
                    vseg(acc[s], PV8, (LAS const unsigned short*)(wl + L_SE) + s * 128, (LAS const float*)(wl + L_ACT) + s * 128, i0, i1, lane); }
            }
            float mean[TS];
#pragma unroll
            for (int s = 0; s < TS; ++s) { mean[s] = 0.f; if (tok[s] >= 0) { const int bidx = tok[s] < ML ? (tok[s] >> 12) : 4;
                mean[s] = ln2_stage_a(acc[s], tok[s], X1, mod + ((size_t)l * 5 + bidx) * MODW, lane); } }
            asm volatile("s_waitcnt vmcnt(0)" ::: "memory");
#pragma unroll 1
            for (int s = 0; s < TS; ++s) { const int t = s == 0 ? tok[0] : (s == 1 ? tok[1] : (s == 2 ? tok[2] : tok[TS - 1])); const float mu = s == 0 ? mean[0] : (s == 1 ? mean[1] : (s == 2 ? mean[2] : mean[TS - 1]));
                if (t >= 0) { const int bidx = t < ML ? (t >> 12) : 4;
                    ln2_stage_b(t, mu, X1, mod + ((size_t)(l + 1 < DEPTH ? l + 1 : l) * 5 + bidx) * MODW, g2, b2, outp, Hnext, lane); } }
        }
        LDS_WAIT(); asm volatile("" ::: "memory");
    }
}
__device__ __forceinline__ float gelu_exact(float v) { return 0.5f * v * (1.0f + erff(v * 0.70710678118654752f)); }
__device__ __forceinline__ float reduce16(float (&p)[16], int lane) {
    float q[8], r[4], s[2];
    { const bool up = lane & 1;
#pragma unroll
      for (int k = 0; k < 8; ++k) { const float send = up ? p[2 * k] : p[2 * k + 1], keep = up ? p[2 * k + 1] : p[2 * k]; q[k] = keep + __shfl_xor(send, 1); } }
    { const bool up = lane & 2;
#pragma unroll
      for (int k = 0; k < 4; ++k) { const float send = up ? q[2 * k] : q[2 * k + 1], keep = up ? q[2 * k + 1] : q[2 * k]; r[k] = keep + __shfl_xor(send, 2); } }
    { const bool up = lane & 4;
#pragma unroll
      for (int k = 0; k < 2; ++k) { const float send = up ? r[2 * k] : r[2 * k + 1], keep = up ? r[2 * k + 1] : r[2 * k]; s[k] = keep + __shfl_xor(send, 4); } }
    float t;
    { const bool up = lane & 8; const float send = up ? s[0] : s[1], keep = up ? s[1] : s[0]; t = keep + __shfl_xor(send, 8); }
    t += __shfl_xor(t, 16); t += __shfl_xor(t, 32);
    return t;
}
__device__ __forceinline__ void pexp_phase(const Frame& F, KA A, int l, int ntok, const bf16* HF, float* outp, bf16* Hnext) {
    const int gw = F.vcu * NWAVES + F.wave, NGW = F.G * NWAVES, lane = F.lane;
    const bf16* PU = (const bf16*)(F.ws + WS_PU) + (size_t)l * 16384 * DM; const bf16* PV = (const bf16*)(F.ws + WS_PV) + (size_t)l * 16384 * DM;
    const int* EIDX = (const int*)(F.ws + WS_EIDX); const float* EG = (const float*)(F.ws + WS_EG);
    const float* X1 = (const float*)(F.ws + WS_UREG); const float* mod = (const float*)(F.ws + WS_MOD);
    const float* g2 = G(A.in.ln2_g) + l * DM; const float* b2 = G(A.in.ln2_b) + l * DM;
    for (int tok = gw; tok < ntok; tok += NGW) {
        float h[32], acc[32];
#pragma unroll
        for (int j = 0; j < 4; ++j) { const bf16x8 v = *(const bf16x8*)(HF + (size_t)tok * DM + j * 512 + lane * 8);
#pragma unroll
            for (int e = 0; e < 8; ++e) { h[j * 8 + e] = bf2f((unsigned short)v[e]); acc[j * 8 + e] = 0.f; } }
#pragma unroll 1
        for (int sb = 0; sb < 32; ++sb) {
            const int my_e = EIDX[(size_t)tok * 128 + sb * 4 + (lane & 3)]; const float my_g = EG[(size_t)tok * 128 + sb * 4 + (lane & 3)];
            const int e0 = __builtin_amdgcn_readlane(my_e, 0), e1 = __builtin_amdgcn_readlane(my_e, 1), e2 = __builtin_amdgcn_readlane(my_e, 2), e3 = __builtin_amdgcn_readlane(my_e, 3);
            float part[4];
#pragma unroll
            for (int i = 0; i < 4; ++i) {
                const int e = i == 0 ? e0 : (i == 1 ? e1 : (i == 2 ? e2 : e3)); const bf16* ur = PU + (size_t)e * DM + lane * 8; float d = 0.f;
#pragma unroll
                for (int j = 0; j < 4; ++j) { const u32x4 w = *(const u32x4*)(ur + j * 512);
                    d += h[j * 8 + 0] * bflo(w.x) + h[j * 8 + 1] * bfhi(w.x) + h[j * 8 + 2] * bflo(w.y) + h[j * 8 + 3] * bfhi(w.y)
                       + h[j * 8 + 4] * bflo(w.z) + h[j * 8 + 5] * bfhi(w.z) + h[j * 8 + 6] * bflo(w.w) + h[j * 8 + 7] * bfhi(w.w); }
                part[i] = d;
            }
            float dot;
            { const bool u1 = lane & 1, u2 = lane & 2;
              const float q0 = (u1 ? part[1] : part[0]) + __shfl_xor(u1 ? part[0] : part[1], 1);
              const float q1 = (u1 ? part[3] : part[2]) + __shfl_xor(u1 ? part[2] : part[3], 1);
              dot = (u2 ? q1 : q0) + __shfl_xor(u2 ? q0 : q1, 2);
              dot += __shfl_xor(dot, 4); dot += __shfl_xor(dot, 8); dot += __shfl_xor(dot, 16); dot += __shfl_xor(dot, 32); }
            const float act = gelu_exact(dot) * my_g;
#pragma unroll
            for (int i = 0; i < 4; ++i) {
                const int e = i == 0 ? e0 : (i == 1 ? e1 : (i == 2 ? e2 : e3)); const float w = __uint_as_float(__builtin_amdgcn_readlane(__float_as_uint(act), i));
                const bf16* vr = PV + (size_t)e * DM + lane * 8;
#pragma unroll
                for (int j = 0; j < 4; ++j) { const u32x4 x = *(const u32x4*)(vr + j * 512);
                    acc[j * 8 + 0] += w * bflo(x.x); acc[j * 8 + 1] += w * bfhi(x.x); acc[j * 8 + 2] += w * bflo(x.y); acc[j * 8 + 3] += w * bfhi(x.y);
                    acc[j * 8 + 4] += w * bflo(x.z); acc[j * 8 + 5] += w * bfhi(x.z); acc[j * 8 + 6] += w * bflo(x.w); acc[j * 8 + 7] += w * bfhi(x.w); }
            }
        }
        const int bidx = tok < ML ? (tok >> 12) : 4;
        const float* mr = mod + ((size_t)l * 5 + bidx) * MODW; const float* x1 = X1 + (size_t)tok * DM;
        float s = 0.f;
#pragma unroll
        for (int j = 0; j < 4; ++j) { const int c = j * 512 + lane * 8;
            const f32x4 xa = *(const f32x4*)(x1 + c), xb = *(const f32x4*)(x1 + c + 4), ga = *(const f32x4*)(mr + 5 * DM + c), gb = *(const f32x4*)(mr + 5 * DM + c + 4);
#pragma unroll
            for (int e = 0; e < 4; ++e) { acc[j * 8 + e] = ALPHA * xa[e] + ga[e] * acc[j * 8 + e]; acc[j * 8 + 4 + e] = ALPHA * xb[e] + gb[e] * acc[j * 8 + 4 + e]; s += acc[j * 8 + e] + acc[j * 8 + 4 + e]; } }
        const float mean = wave_sum(s) * (1.0f / DM); float q = 0.f;
#pragma unroll
        for (int k = 0; k < 32; ++k) { acc[k] -= mean; q += acc[k] * acc[k]; }
        const float rstd = rsqrtf(wave_sum(q) * (1.0f / DM) + LN_EPS);
        const float* mn = mod + ((size_t)(l + 1 < DEPTH ? l + 1 : l) * 5 + bidx) * MODW;
#pragma unroll
        for (int j = 0; j < 4; ++j) { const int c = j * 512 + lane * 8;
            const f32x4 ga = *(const f32x4*)(g2 + c), gb = *(const f32x4*)(g2 + c + 4), ba = *(const f32x4*)(b2 + c), bb = *(const f32x4*)(b2 + c + 4);
            f32x4 ya, yb;
#pragma unroll
            for (int e = 0; e < 4; ++e) { ya[e] = acc[j * 8 + e] * rstd * ga[e] + ba[e]; yb[e] = acc[j * 8 + 4 + e] * rstd * gb[e] + bb[e]; }
            *(f32x4*)(outp + (size_t)tok * DM + c) = ya; *(f32x4*)(outp + (size_t)tok * DM + c + 4) = yb;
            if (Hnext) { const f32x4 sa = *(const f32x4*)(mn + DM + c), sb = *(const f32x4*)(mn + DM + c + 4), ha = *(const f32x4*)(mn + c), hb = *(const f32x4*)(mn + c + 4);
                const f32x4 za = ya * (sa + 1.0f) + ha, zb = yb * (sb + 1.0f) + hb;
                u32x4 o; o.x = pk2(za[0], za[1]); o.y = pk2(za[2], za[3]); o.z = pk2(zb[0], zb[1]); o.w = pk2(zb[2], zb[3]);
                *(u32x4*)(Hnext + (size_t)tok * DM + c) = o; }
        }
    }
}

#ifndef SD_A
#define SD_A 1
#endif
#ifndef SD_D
#define SD_D 1
#endif
#ifndef SD_B
#define SD_B 2
#endif
#ifndef SD_C
#define SD_C 1
#endif
#ifndef ATT_MASK
#define ATT_MASK 15
#endif
template <int TYPE> __device__ __forceinline__ att::Args make_att_args(const Frame& F, KA A, int l, int idx, bool ctxq) {
    const bf16* U = (const bf16*)(F.ws + WS_UREG); const bf16* QK = (const bf16*)(F.ws + WS_QKVA); bf16* O = (bf16*)(F.ws + WS_OQP);
    constexpr int NH = (TYPE == 2) ? 8 : 4;
    int b, h, qb;
    if (ctxq) { b = idx / NH; h = idx % NH; qb = 0; } else { b = idx / (NH * 16); h = (idx >> 4) % NH; qb = idx & 15; }
    const int row = ctxq ? ML + b * NCTX : b * SEQ + qb * 256;
    att::Args a{};
    a.ldo = DM; a.qpos0 = qb * 256;
    if (ctxq) { a.n0 = 4; a.row0 = ML + b * NCTX; a.n1 = 0; a.row1 = 0; }
    if constexpr (TYPE == 0) {
        a.Q = QK + (size_t)row * QW + QA_Q + h * 192; a.ldq = QW; a.KV = QK; a.ld = QW; a.kc0 = QA_KV + h * 256; a.kc1 = QA_KR; a.vc = QA_KV + h * 256 + 128;
        a.O = O + (size_t)row * DM + h * 128; a.C = A_SCALE * LOG2E; a.thr = 8.0f / A_SCALE; a.qrope = ctxq ? 0 : 1;
        if (!ctxq) { a.n0 = 64; a.row0 = b * SEQ; a.n1 = 4; a.row1 = ML + b * NCTX; }
    } else if constexpr (TYPE == 1) {
        const int kvh = h >> 1;
        a.Q = U + (size_t)row * UW + U_DQ + h * 128; a.ldq = UW; a.KV = U; a.ld = UW; a.kc0 = U_DK + kvh * 128; a.kc1 = 0; a.vc = U_DV + kvh * 128;
        a.O = O + (size_t)row * DM + 1536 + h * 128; a.C = D_SCALE * LOG2E; a.thr = 8.0f / D_SCALE;
        if (!ctxq) { a.n0 = 64; a.row0 = b * SEQ; a.n1 = 4; a.row1 = ML + b * NCTX; }
    } else if constexpr (TYPE == 2) {
        const int kvh = h >> 2;
        a.Q = U + (size_t)row * UW + U_BQ + h * 64; a.ldq = UW; a.KV = U; a.ld = UW; a.kc0 = U_BK + kvh * 64; a.kc1 = 0; a.vc = U_BV + kvh * 64;
        a.O = O + (size_t)row * DM + 512 + h * 64; a.C = B_SCALE * LOG2E; a.thr = 8.0f / B_SCALE; a.has_sink = 1; a.sinkl2 = G(A.in.b_sink)[l * 8 + h] * LOG2E;
        if (!ctxq) { int ws = qb * 256 - 128; ws = ws < 0 ? 0 : ws; int we = qb * 256 + 384; we = we > SEQ ? SEQ : we;
            a.n0 = 4; a.row0 = ML + b * NCTX; a.n1 = (we - ws) / 64; a.row1 = b * SEQ + ws; a.wpos0 = ws; }
    } else {
        a.Q = U + (size_t)row * UW + U_CQQ + h * 128; a.ldq = UW; a.KV = U; a.ld = UW; a.kc0 = U_CK + h * 128; a.kc1 = 0; a.vc = U_CV + h * 128;
        a.O = O + (size_t)row * DM + 1024 + h * 128; a.C = C_SCALE * LOG2E; a.thr = 8.0f / C_SCALE;
        a.T = (const float*)(F.ws + WS_CTAB) + (size_t)((l * 4 + h) * 15) * 4096;
        if (!ctxq) { const int r0 = qb * 4; int kr0 = r0 - 4; kr0 = kr0 < 0 ? 0 : (kr0 > 56 ? 56 : kr0); int ke = r0 + 3 - 4; ke = ke < 0 ? 0 : (ke > 56 ? 56 : ke); ke += 7; const int nr = ke - kr0 + 1;
            a.n0 = 4; a.row0 = ML + b * NCTX; a.n1 = nr + (nr & 1); a.row1 = b * SEQ + kr0 * 64; a.r0 = r0; a.kr0 = kr0; }
    }
    return a;
}
#define AF() Frame F = F0; asm volatile("" : "+v"(F.tid), "+v"(F.lane), "+s"(F.wave), "+s"(F.vcu), "+s"(F.G), "+s"(F.ws), "+s"(F.lds)); LAS char* lds = (LAS char*)(F.lds + RING_OFF); const int v = F.vcu
__device__ __forceinline__ void att_phase(const Frame& F0, int l) {
    if (F0.vcu >= 256) return;
    const bool cx = (l + 1 < DEPTH);
    if (ATT_MASK & 1) { AF(); KA A = *kargs(); const int n = 1 + ((cx && v < 16) ? 1 : 0);
        for (int k = 0; k < n; ++k) { const att::Args a = make_att_args<0>(F, A, l, k ? v : v, k != 0); att::attn_unit<192, 128, 0, SD_A>(a, lds, F.tid); } }
    if (ATT_MASK & 2) { AF(); KA A = *kargs(); const int n = 1 + ((cx && v >= 16 && v < 32) ? 1 : 0);
        for (int k = 0; k < n; ++k) { const att::Args a = make_att_args<1>(F, A, l, k ? v - 16 : v, k != 0); att::attn_unit<128, 128, 0, SD_D>(a, lds, F.tid); } }
    if (ATT_MASK & 4) { AF(); KA A = *kargs(); const int n = 2 + ((cx && v >= 48 && v < 80) ? 1 : 0);
        for (int k = 0; k < n; ++k) { const att::Args a = make_att_args<2>(F, A, l, k == 2 ? v - 48 : 2 * v + k, k == 2); att::attn_unit<64, 64, 1, SD_B>(a, lds, F.tid); } }
    if (ATT_MASK & 8) { AF(); KA A = *kargs(); const int n = 1 + ((cx && v >= 32 && v < 48) ? 1 : 0);
        for (int k = 0; k < n; ++k) { const att::Args a = make_att_args<3>(F, A, l, k ? v - 32 : v, k != 0); att::attn_unit<128, 128, 2, SD_C>(a, lds, F.tid); } }
}

constexpr int N_PHASES = 3 + 10 * DEPTH;
#ifndef MK_N_LAUNCHES
#define MK_N_LAUNCHES 1
#endif
__global__ void __launch_bounds__(NWAVES * 64, 2) mk_fwd(Args args) {
    extern __shared__ __attribute__((aligned(16))) unsigned char lds_raw[];
    Frame F;
    F.lds = (LAS unsigned char*)lds_raw; F.tid = threadIdx.x; F.lane = F.tid & 63; F.wave = __builtin_amdgcn_readfirstlane(F.tid >> 6);
    F.G = gridDim.x; { const int bx = blockIdx.x; F.vcu = (F.G % 8 == 0) ? (bx % 8) * (F.G / 8) + bx / 8 : bx; }
    GAS unsigned char* ws; int lo, hi, li;
    { KAP ap = kargs(); ws = (GAS unsigned char*)ap->ws; lo = ap->ph_lo; hi = ap->ph_hi; li = ap->li; }
    F.ws = ws;
    for (int u = F.tid; u < (LDS_BYTES - LDSCTL_OFF) / 4; u += NWAVES * 64) ((LAS unsigned*)(F.lds + LDSCTL_OFF))[u] = 0u;
    __syncthreads();
    volatile LAS unsigned* MISC = (volatile LAS unsigned*)(F.lds + MISC_OFF);
    XcdBarrier bar = xcd_barrier_post((unsigned*)(ws + WS_CTL) + CW_BAR + li * XCD_BAR_WORDS, MISC + 8);
#ifndef PHASE_MASK
#define PHASE_MASK 0x1fff
#endif
#define INR(k) (lo <= (k) && (k) < hi)
#define IN(k) ((((PHASE_MASK) >> ((k) < 3 ? (k) : 3 + ((k) - 3) % 10)) & 1) && INR(k))
#define SEAM(k) do { if (INR(k) && INR((k) + 1)) xcd_barrier(bar); } while (0)
#define PF() Frame Fp = F; int bx = blockIdx.x; asm volatile("" : "+v"(Fp.tid), "+v"(Fp.lane), "+s"(Fp.wave), "+s"(Fp.vcu), "+s"(Fp.G), "+s"(Fp.ws), "+s"(Fp.lds), "+s"(bx)); GAS unsigned char* ws = Fp.ws; (void)bx; (void)ws
    if (IN(0)) { PF(); p0_prologue(Fp, *kargs()); } SEAM(0);
    if (IN(1)) { PF(); p1_modreduce(Fp, *kargs()); } SEAM(1);
    if (IN(2)) { PF(); p2_modulate0(Fp, *kargs()); } SEAM(2);
    for (int l = 0; l < DEPTH; ++l) {
        const int pb = 3 + 10 * l; const bool last = (l + 1 == DEPTH);
        const size_t offH = (l & 1) ? WS_BUFB : WS_BUFA, offS = (l & 1) ? WS_BUFA : WS_BUFB;
        const int nPl = last ? 64 : 68, nrows = last ? ML : MT;
        if (IN(pb + 0)) {
            PF(); bf16* Hb = (bf16*)(ws + offH);
            pg8::PlainSched S{(const char*)Hb, (const char*)((bf16*)(ws + WS_WIN) + (size_t)l * UW * DM), DM, DM, DM, 68, 16, Fp.G, bx};
            pg8::EpiBf16 E{(bf16*)(ws + WS_UREG), UW};
            pg8::gemm_phase(Fp.lds + RING_OFF, S, E, DM, DM, Fp.tid);
        } SEAM(pb + 0);
        if (IN(pb + 1)) { PF(); enorm_phase(Fp, *kargs(), l); } SEAM(pb + 1);
        if (IN(pb + 2)) { PF();
            pg8::PlainSched S{(const char*)(ws + WS_UREG), (const char*)((bf16*)(ws + WS_WUP) + (size_t)l * 1792 * 512), UW, 512, 512, 68, 7, Fp.G, bx};
            pg8::EpiBf16 E{(bf16*)(ws + WS_QKVA), QW};
            pg8::gemm_phase(Fp.lds + RING_OFF, S, E, UW, 512, Fp.tid);
        } SEAM(pb + 2);
        if (IN(pb + 3)) { PF(); att_phase(Fp, l); } SEAM(pb + 3);
        if (IN(pb + 4)) { PF(); bf16* Hb = (bf16*)(ws + offH); bf16* Sb = (bf16*)(ws + offS);
            pg8::MergeSched S{(const char*)Hb, (const char*)(ws + WS_OQP), (const char*)((bf16*)(ws + WS_WC) + (size_t)l * 4 * DM * 2560), nPl, Fp.G, bx};
            pg8::EpiMerge E{Sb, G(kargs()->in.b_gate) + (size_t)l * 4 * DM, (char*)(ws + WS_STASH) + (size_t)bx * STASH_WG, (char*)(ws + WS_P) + (size_t)bx * P_WG, Fp.tid};
            pg8::gemm_phase(Fp.lds + RING_OFF, S, E, DM, 2560, Fp.tid);
        } SEAM(pb + 4);
        if (IN(pb + 5)) { PF(); bf16* Sb = (bf16*)(ws + offS);
            pg8::PlainSched S{(const char*)Sb, (const char*)((bf16*)(ws + WS_WO) + (size_t)l * DM * DM), DM, DM, DM, nPl, 8, Fp.G, bx};
            KAP ap = kargs();
            pg8::EpiOut E{(float*)(ws + WS_UREG), l == 0 ? G(ap->in.x) : (const float*)(ws + WS_XRES), l == 0 ? G(ap->in.ctx) : (const float*)(ws + WS_XRES) + (size_t)ML * DM,
                          (const float*)(ws + WS_MOD) + (size_t)l * 5 * MODW, ALPHA};
            pg8::gemm_phase(Fp.lds + RING_OFF, S, E, DM, DM, Fp.tid);
        } SEAM(pb + 5);
        if (IN(pb + 6)) { PF(); ln1_phase(Fp, *kargs(), l, nrows, (bf16*)(ws + offH)); } SEAM(pb + 6);
        if (IN(pb + 7)) { PF(); bf16* Hb = (bf16*)(ws + offH);
            pg8::PlainSched S{(const char*)Hb, (const char*)((bf16*)(ws + WS_WPQ) + (size_t)l * DM * DM), DM, DM, DM, nPl, 8, Fp.G, bx};
            pg8::EpiBf16 E{(bf16*)(ws + WS_OQP), DM};
            pg8::gemm_phase(Fp.lds + RING_OFF, S, E, DM, DM, Fp.tid);
        } SEAM(pb + 7);
        if (IN(pb + 8)) { PF();
            const int gw = Fp.vcu * NWAVES + Fp.wave, NGW = Fp.G * NWAVES;
            LAS unsigned short* tblw = (LAS unsigned short*)(Fp.lds + RING_OFF) + Fp.wave * (64 * 66);
            for (int it = gw; it < (nrows / 32) * 8; it += NGW)
                peer::topk_item((const bf16*)(ws + WS_OQP), (const bf16*)(ws + WS_SUBK) + (size_t)l * 8 * 2 * 128 * 128, (int*)(ws + WS_EIDX), (float*)(ws + WS_EG), (it >> 3) * 32, it & 7, tblw, Fp.lane);
        } SEAM(pb + 8);
        if (IN(pb + 9)) { PF(); pexp8_phase(Fp, *kargs(), l, nrows, (bf16*)(ws + offH), last ? G(kargs()->out) : (float*)(ws + WS_XRES), last ? nullptr : (bf16*)(ws + offS)); } SEAM(pb + 9);
    }
#undef IN
#undef INR
#undef SEAM
}

extern "C" void kernel_launch(void* const* d_in, const int* in_sizes, int n_in, void* d_out, int out_size, void* d_ws, size_t ws_size, hipStream_t stream) {
    static int grid = 0;
    if (grid == 0) {
        if (n_in != 27 || out_size != ML * DM || ws_size < WS_END) { fprintf(stderr, "kernel_launch: unexpected shapes (n_in %d out %d ws %zu, need ws >= %zu)\n", n_in, out_size, ws_size, (size_t)WS_END); grid = -1; return; }
        int dev = 0, cus = 0, per_cu = 0;
        if (hipGetDevice(&dev) != hipSuccess || hipDeviceGetAttribute(&cus, hipDeviceAttributeMultiprocessorCount, dev) != hipSuccess) { grid = -1; return; }
        if (hipFuncSetAttribute((const void*)mk_fwd, hipFuncAttributeMaxDynamicSharedMemorySize, LDS_BYTES) != hipSuccess) { fprintf(stderr, "kernel_launch: hipFuncSetAttribute failed\n"); grid = -1; return; }
        if (hipOccupancyMaxActiveBlocksPerMultiprocessor(&per_cu, (const void*)mk_fwd, NWAVES * 64, LDS_BYTES) != hipSuccess || per_cu < 1) { fprintf(stderr, "kernel_launch: occupancy query says %d\n", per_cu); }
        (void)hipGetLastError();
        grid = cus < 256 ? cus : 256;
    }
    if (grid < 0) return;
    (void)hipMemsetAsync((char*)d_ws + WS_CTL, 0, CTL_ZERO_BYTES, stream);
    Args a{};
    const float** ip = (const float**)&a.in;
    for (int i = 0; i < 27; ++i) ip[i] = (const float*)d_in[i];
    a.out = (float*)d_out; a.ws = (unsigned char*)d_ws;
    for (int li = 0; li < MK_N_LAUNCHES; ++li) {
        a.ph_lo = (MK_N_LAUNCHES == 1) ? 0 : li; a.ph_hi = (MK_N_LAUNCHES == 1) ? N_PHASES : li + 1; a.li = li; a.pad = 0;
        hipLaunchKernelGGL(mk_fwd, dim3(grid), dim3(NWAVES * 64), LDS_BYTES, stream, a);
    }
}
```

```cpp
#include <hip/hip_runtime.h>
#include <cstdio>
#include <cstdint>
#include <utility>

#define GAS __attribute__((address_space(1)))
#define LAS __attribute__((address_space(3)))
typedef unsigned short bf16;
typedef short bf16x8 __attribute__((ext_vector_type(8)));
typedef short s16x4 __attribute__((ext_vector_type(4)));
typedef float f32x2 __attribute__((ext_vector_type(2)));
typedef float f32x4 __attribute__((ext_vector_type(4)));
typedef float f32x16 __attribute__((ext_vector_type(16)));
typedef unsigned u32x2 __attribute__((ext_vector_type(2)));
typedef unsigned u32x4 __attribute__((ext_vector_type(4)));
typedef GAS unsigned gu32;

__device__ __forceinline__ unsigned cvt_pk_bf16(float lo, float hi) { unsigned r; asm volatile("v_cvt_pk_bf16_f32 %0, %1, %2" : "=v"(r) : "v"(lo), "v"(hi)); return r; }
__device__ __forceinline__ float bf2f(unsigned short b) { return __uint_as_float(((unsigned)b) << 16); }
__device__ __forceinline__ float bflo(unsigned w) { return __uint_as_float(w << 16); }
__device__ __forceinline__ float bfhi(unsigned w) { return __uint_as_float(w & 0xffff0000u); }
__device__ __forceinline__ unsigned short f2bf(float f) { return (unsigned short)(cvt_pk_bf16(f, 0.f) & 0xffffu); }

namespace pg8 {
constexpr int BM = 256, BK = 64, HALF = 128, HTB = HALF * BK * 2  , STAGE_BYTES = 8 * HTB, NXCD = 8, WGM = 8;
__host__ __device__ __forceinline__ int lds_byte(int r, int c) { const int st = (r >> 4) * 2 + (c >> 5), rr = r & 15, cc = c & 31, ob = rr * 64 + cc * 2; return st * 1024 + (ob ^ (((ob >> 9) & 1) << 5)); }
__host__ __device__ __forceinline__ void stage_rc(int b, int& R, int& C) { const int st = b / 1024, sb = b % 1024, swz = sb ^ (((sb >> 9) & 1) << 5); R = (st >> 1) * 16 + swz / 64; C = (st & 1) * 32 + (swz % 64) / 2; }
__host__ __device__ __forceinline__ int perm32(int rho) { const int n = rho >> 4, i = rho & 15; return 8 * (i >> 2) + 4 * n + (i & 3); }

struct Unit { int pm, pn, z; };

__device__ __forceinline__ void tile_of(int L, int nM, int nN, int& pm, int& pn) {
    const int nwg = nM * nN; int wgid = L;
    { const int q = nwg / NXCD, r = nwg % NXCD, xcd = wgid % NXCD, off = wgid / NXCD; wgid = (xcd < r ? xcd * (q + 1) : r * (q + 1) + (xcd - r) * q) + off; }
    const int nig = WGM * nN, gid = wgid / nig, fm = gid * WGM, gsz = (nM - fm) < WGM ? (nM - fm) : WGM;
    pm = fm + ((wgid % nig) % gsz); pn = (wgid % nig) / gsz;
}
struct PlainSched {
    const char* A; const char* B; int lda, ldb, K, nM, nN, G, c;
    __device__ __forceinline__ bool next(int i, Unit& u) const { const long L = (long)i * G + c; if (L >= (long)nM * nN) return false; tile_of((int)L, nM, nN, u.pm, u.pn); u.z = 0; return true; }
    __device__ __forceinline__ void ptrs(const Unit& u, const char*& a, const char*& b, int& nt) const { a = A + (size_t)u.pm * BM * lda * 2; b = B + (size_t)u.pn * BM * ldb * 2; nt = K / BK; }
};
struct MergeSched {
    const char* H; const char* O; const char* W; int nM, G, c;
    __device__ __forceinline__ bool next(int i, Unit& u) const { const long L = (long)(i >> 3) * G + c; if (L >= (long)nM * 8) return false; tile_of((int)L, nM, 8, u.pm, u.pn); u.z = i & 7; return true; }
    __device__ __forceinline__ void ptrs(const Unit& u, const char*& a, const char*& b, int& nt) const {
        const int z = u.z >> 1, kind = u.z & 1;
        a = (kind ? H : O + (size_t)z * 512 * 2) + (size_t)u.pm * BM * 2048 * 2;
        b = W + ((size_t)z * 2048 * 2560 + (size_t)u.pn * BM * 2560 + (kind ? 0 : 2048)) * 2;
        nt = kind ? 32 : 8;
    }
};

struct EpiBf16 {
    static constexpr bool PERM = true;
    bf16* O; int ldc;
    __device__ __forceinline__ void operator()(const f32x4 (&acc)[2][2][4][2], const Unit& u, int wr, int wc, int fr, int fq) const {
        const int row0 = u.pm * BM + wr * 64 + fr, col0 = u.pn * BM + wc * 32 + 8 * fq;
#pragma unroll
        for (int ai = 0; ai < 2; ++ai)
#pragma unroll
            for (int m = 0; m < 4; ++m) { bf16* rowp = O + (size_t)(row0 + ai * HALF + m * 16) * ldc + col0;
#pragma unroll
                for (int bj = 0; bj < 2; ++bj) { const f32x4 v0 = acc[ai][bj][m][0], v1 = acc[ai][bj][m][1];
                    u32x4 w; w.x = cvt_pk_bf16(v0[0], v0[1]); w.y = cvt_pk_bf16(v0[2], v0[3]); w.z = cvt_pk_bf16(v1[0], v1[1]); w.w = cvt_pk_bf16(v1[2], v1[3]);
                    *(u32x4*)(rowp + bj * HALF) = w; } }
    }
};
struct EpiMerge {
    static constexpr bool PERM = true;
    bf16* S; const float* bgate; char* stash; char* P; int tid;
    __device__ __forceinline__ void operator()(const f32x4 (&acc)[2][2][4][2], const Unit& u, int wr, int wc, int fr, int fq) const {
        const int z = u.z >> 1, kind = u.z & 1; int tl = tid; asm volatile("" : "+v"(tl));
        GAS char* sp = (GAS char*)stash + (size_t)tl * 16;
        if (kind == 0) {
#pragma unroll
            for (int ai = 0; ai < 2; ++ai)
#pragma unroll
                for (int m = 0; m < 4; ++m)
#pragma unroll
                    for (int bj = 0; bj < 2; ++bj) { const f32x4 v0 = acc[ai][bj][m][0], v1 = acc[ai][bj][m][1];
                        u32x4 w; w.x = cvt_pk_bf16(v0[0], v0[1]); w.y = cvt_pk_bf16(v0[2], v0[3]); w.z = cvt_pk_bf16(v1[0], v1[1]); w.w = cvt_pk_bf16(v1[2], v1[3]);
                        *(GAS u32x4*)sp = w; sp += 8192; asm volatile("" : "+v"(sp)); }
            return;
        }
        GAS char* pq = (GAS char*)P + (size_t)tl * 16;
        const int row0 = u.pm * BM + wr * 64 + fr, col0 = u.pn * BM + wc * 32 + 8 * fq;
        const float* bz = bgate + z * 2048 + col0;
        f32x4 bv[2][2];
#pragma unroll
        for (int bj = 0; bj < 2; ++bj)
#pragma unroll
            for (int n = 0; n < 2; ++n) bv[bj][n] = *(const f32x4*)(bz + bj * HALF + 4 * n);
        GAS bf16* rowp = (GAS bf16*)S + (size_t)row0 * 2048 + col0;
#pragma unroll
        for (int ai = 0; ai < 2; ++ai)
#pragma unroll
            for (int m = 0; m < 4; ++m) {
#pragma unroll
                for (int bj = 0; bj < 2; ++bj) {
                    const u32x4 sw = *(const GAS u32x4*)sp; sp += 8192; asm volatile("" : "+v"(sp));
                    f32x4 v0 = acc[ai][bj][m][0] + bv[bj][0], v1 = acc[ai][bj][m][1] + bv[bj][1];
#pragma unroll
                    for (int j = 0; j < 4; ++j) { v0[j] = __builtin_amdgcn_rcpf(1.0f + __builtin_amdgcn_exp2f(-1.4426950408889634f * v0[j])); v1[j] = __builtin_amdgcn_rcpf(1.0f + __builtin_amdgcn_exp2f(-1.4426950408889634f * v1[j])); }
                    v0[0] *= bflo(sw.x); v0[1] *= bfhi(sw.x); v0[2] *= bflo(sw.y); v0[3] *= bfhi(sw.y);
                    v1[0] *= bflo(sw.z); v1[1] *= bfhi(sw.z); v1[2] *= bflo(sw.w); v1[3] *= bfhi(sw.w);
                    if (z > 0) { v0 += *(const GAS f32x4*)pq; v1 += *(const GAS f32x4*)(pq + 8192); }
                    if (z < 3) { *(GAS f32x4*)pq = v0; *(GAS f32x4*)(pq + 8192) = v1; }
                    else { u32x4 w; w.x = cvt_pk_bf16(v0[0], v0[1]); w.y = cvt_pk_bf16(v0[2], v0[3]); w.z = cvt_pk_bf16(v1[0], v1[1]); w.w = cvt_pk_bf16(v1[2], v1[3]);
                        *(GAS u32x4*)(rowp + bj * HALF) = w; }
                    pq += 16384; asm volatile("" : "+v"(pq));
                }
                rowp += (m == 3 ? (size_t)(HALF - 48) : (size_t)16) * 2048; asm volatile("" : "+v"(rowp));
                asm volatile("" ::: "memory"); }
    }
};
struct EpiOut {
    static constexpr bool PERM = false;
    float* Y; const float* xlat; const float* xctx; const float* mod_l; float alpha;
    __device__ __forceinline__ void operator()(const f32x4 (&acc)[2][2][4][2], const Unit& u, int wr, int wc, int fr, int fq) const {
        const int row0 = u.pm * BM + wr * 64 + fr, col0 = u.pn * BM + wc * 32 + 4 * fq;
        const float* xb = (u.pm < 64) ? xlat + (size_t)row0 * 2048 : xctx + (size_t)(row0 - 16384) * 2048;
        const float* ga = mod_l + (size_t)((u.pm < 64) ? (u.pm >> 4) : 4) * 12288 + 2 * 2048 + col0;
        f32x4 gv[2][2];
#pragma unroll
        for (int bj = 0; bj < 2; ++bj)
#pragma unroll
            for (int n = 0; n < 2; ++n) gv[bj][n] = *(const f32x4*)(ga + bj * HALF + n * 16);
#pragma unroll
        for (int ai = 0; ai < 2; ++ai)
#pragma unroll
            for (int m = 0; m < 4; ++m) { const size_t ro = (size_t)(ai * HALF + m * 16) * 2048 + col0; float* yp = Y + (size_t)row0 * 2048 + ro;
#pragma unroll
                for (int bj = 0; bj < 2; ++bj)
#pragma unroll
                    for (int n = 0; n < 2; ++n) { const f32x4 xv = *(const f32x4*)(xb + ro + bj * HALF + n * 16); *(f32x4*)(yp + bj * HALF + n * 16) = xv * alpha + gv[bj][n] * acc[ai][bj][m][n]; } }
    }
};

template <class Epi, class Sched>
__device__ __forceinline__ void gemm_phase(LAS unsigned char* lds, const Sched& S, const Epi& E, const int lda, const int ldb, const int tid) {
    const int wid = __builtin_amdgcn_readfirstlane(tid >> 6), lane = tid & 63, wr = wid >> 2, wc = wid & 3, fr = lane & 15, fq = lane >> 4;
    unsigned voffA[2], voffB[2];
#pragma unroll
    for (int i = 0; i < 2; ++i) { int R, C; stage_rc(tid * 16 + i * 8192, R, C); const int Rb = Epi::PERM ? ((R & ~31) + perm32(R & 31)) : R;
        voffA[i] = (unsigned)(R * lda + C) * 2u; voffB[i] = (unsigned)(Rb * ldb + C) * 2u; }
    const size_t kstep = (size_t)(BK * 2);
    const size_t hstepA = (size_t)HALF * lda * 2, hstepB = (size_t)HALF * ldb * 2;
    const unsigned ldsw = (unsigned)wid * 1024u;
    const int aoff = lds_byte(wr * 64 + fr, fq * 8), boff = lds_byte(wc * 32 + fr, fq * 8);
#define PG8_SA(b, h) (((b) * 2 + (h)) * HTB)
#define PG8_SB(b, h) ((4 + (b) * 2 + (h)) * HTB)
#define PG8_STAGE(bufoff, gbase, voff) do { _Pragma("unroll") for (int _i = 0; _i < 2; ++_i) \
        __builtin_amdgcn_global_load_lds((const unsigned*)((const char*)(gbase) + (voff)[_i]), (LAS unsigned*)(lds + (bufoff) + ldsw + _i * 8192), 16, 0, 0); } while (0)
#define PG8_LDA(dst, b, h) do { _Pragma("unroll") for (int m = 0; m < 4; ++m) _Pragma("unroll") for (int k = 0; k < 2; ++k) dst[m][k] = *(const LAS bf16x8*)(lds + PG8_SA(b, h) + aoff + m * 2048 + k * 1024); } while (0)
#define PG8_LDB(dst, b, h) do { _Pragma("unroll") for (int n = 0; n < 2; ++n) _Pragma("unroll") for (int k = 0; k < 2; ++k) dst[n][k] = *(const LAS bf16x8*)(lds + PG8_SB(b, h) + boff + n * 2048 + k * 1024); } while (0)
#define PG8_MMA(ai, bj, At, Bt) do { __builtin_amdgcn_s_setprio(1); _Pragma("unroll") for (int m = 0; m < 4; ++m) _Pragma("unroll") for (int n = 0; n < 2; ++n) _Pragma("unroll") for (int k = 0; k < 2; ++k) \
        acc[ai][bj][m][n] = __builtin_amdgcn_mfma_f32_16x16x32_bf16(Bt[n][k], At[m][k], acc[ai][bj][m][n], 0, 0, 0); __builtin_amdgcn_s_setprio(0); } while (0)
#define PG8_WAIT_V(n) asm volatile("s_waitcnt vmcnt(" #n ")" ::: "memory")
#define PG8_WAIT_L(n) asm volatile("s_waitcnt lgkmcnt(" #n ")" ::: "memory")
#define PG8_BAR __builtin_amdgcn_s_barrier()
#define PG8_SCHED __builtin_amdgcn_sched_barrier(0)
    Unit cur, nxt; int ui = 0;
    if (!S.next(0, cur)) return;
    f32x4 acc[2][2][4][2];
#pragma unroll
    for (int a = 0; a < 2; ++a)
#pragma unroll
        for (int b = 0; b < 2; ++b)
#pragma unroll
            for (int m = 0; m < 4; ++m)
#pragma unroll
                for (int n = 0; n < 2; ++n) acc[a][b][m][n] = (f32x4){0.f, 0.f, 0.f, 0.f};
    bf16x8 At[4][2], B0[2][2], B1[2][2];
    const char* cA; const char* cB; int nt; S.ptrs(cur, cA, cB, nt);
    PG8_STAGE(PG8_SB(0, 0), cB, voffB); PG8_STAGE(PG8_SB(0, 1), cB + hstepB, voffB); PG8_STAGE(PG8_SA(0, 0), cA, voffA); PG8_STAGE(PG8_SA(0, 1), cA + hstepA, voffA);
    if (wr == 1) PG8_BAR;
    PG8_WAIT_V(2); PG8_BAR;
    PG8_STAGE(PG8_SB(1, 0), cB + kstep, voffB); PG8_STAGE(PG8_SA(1, 0), cA + kstep, voffA); PG8_STAGE(PG8_SB(1, 1), cB + hstepB + kstep, voffB);
    PG8_WAIT_V(6); PG8_BAR;
    for (;;) {
        const bool has_next = S.next(ui + 1, nxt);
        const char* nA = cA; const char* nB = cB; int nnt = nt; if (has_next) S.ptrs(nxt, nA, nB, nnt);
        for (int t = 0; t < nt; t += 2) {
            const bool last = (t == nt - 2);
            const char* a1 = cA + (size_t)(t + 1) * kstep;
            const char* a2 = last ? nA : cA + (size_t)(t + 2) * kstep; const char* b2 = last ? nB : cB + (size_t)(t + 2) * kstep;
            const char* a3 = a2 + kstep; const char* b3 = b2 + kstep;
            PG8_LDB(B0, 0, 0); PG8_LDB(B1, 0, 1); PG8_SCHED; PG8_LDA(At, 0, 0); PG8_STAGE(PG8_SA(1, 1), a1 + hstepA, voffA);
            PG8_WAIT_V(8); PG8_WAIT_L(0); PG8_BAR; PG8_MMA(0, 0, At, B0); PG8_MMA(0, 1, At, B1); PG8_BAR; PG8_SCHED;
            PG8_LDA(At, 0, 1); PG8_STAGE(PG8_SB(0, 0), b2, voffB); PG8_STAGE(PG8_SB(0, 1), b2 + hstepB, voffB); PG8_STAGE(PG8_SA(0, 0), a2, voffA);
            PG8_WAIT_V(8); PG8_WAIT_L(0); PG8_BAR; PG8_MMA(1, 0, At, B0); PG8_MMA(1, 1, At, B1); PG8_BAR; PG8_SCHED;
            PG8_LDB(B0, 1, 0); PG8_LDB(B1, 1, 1); PG8_SCHED; PG8_LDA(At, 1, 0); PG8_STAGE(PG8_SA(0, 1), a2 + hstepA, voffA);
            PG8_WAIT_V(8); PG8_WAIT_L(0); PG8_BAR; PG8_MMA(0, 0, At, B0); PG8_MMA(0, 1, At, B1); PG8_BAR; PG8_SCHED;
            PG8_LDA(At, 1, 1); PG8_STAGE(PG8_SB(1, 0), b3, voffB); PG8_STAGE(PG8_SB(1, 1), b3 + hstepB, voffB); PG8_STAGE(PG8_SA(1, 0), a3, voffA);
            PG8_WAIT_V(8); PG8_WAIT_L(0); PG8_BAR; PG8_MMA(1, 0, At, B0); PG8_MMA(1, 1, At, B1); PG8_BAR; PG8_SCHED;
        }
        if (wr == 0) PG8_BAR;
        E(acc, cur, wr, wc, fr, fq);
        if (!has_next) break;
#pragma unroll
        for (int a = 0; a < 2; ++a)
#pragma unroll
            for (int b = 0; b < 2; ++b)
#pragma unroll
                for (int m = 0; m < 4; ++m)
#pragma unroll
                    for (int n = 0; n < 2; ++n) acc[a][b][m][n] = (f32x4){0.f, 0.f, 0.f, 0.f};
        cur = nxt; cA = nA; cB = nB; nt = nnt; ++ui;
        if (wr == 1) PG8_BAR;
    }
    PG8_WAIT_V(0);
    PG8_BAR;
#undef PG8_SA
#undef PG8_SB
#undef PG8_STAGE
#undef PG8_LDA
#undef PG8_LDB
#undef PG8_MMA
#undef PG8_WAIT_V
#undef PG8_WAIT_L
#undef PG8_BAR
#undef PG8_SCHED
}
}
namespace att {
constexpr int NW = 8, QBLK = 32, KVBLK = 64;
#define SBAR() __builtin_amdgcn_sched_barrier(0)
__device__ __forceinline__ int crow(int r, int hi) { return (r & 3) + 8 * (r >> 2) + 4 * hi; }
__device__ __forceinline__ unsigned cvtpk(float lo, float hi) { unsigned r; asm volatile("v_cvt_pk_bf16_f32 %0, %1, %2" : "=v"(r) : "v"(lo), "v"(hi)); return r; }

struct Args {
    const bf16* Q; int ldq;
    const bf16* KV; int ld;
    int kc0, kc1, vc;
    bf16* O; int ldo;
    int n0, n1, row0, row1;
    float C, thr;
    int qrope, qpos0;
    float sinkl2; int has_sink;
    int wpos0;
    const float* T; int r0, kr0;
};

__device__ __forceinline__ void partialSM(f32x16& p0, f32x16& p1, float& m_reg, float& mn, float& alpha, const float C, const float thr) {
    float pmax = p0[0];
#pragma unroll
    for (int r = 1; r < 16; ++r) pmax = fmaxf(pmax, p0[r]);
#pragma unroll
    for (int r = 0; r < 16; ++r) pmax = fmaxf(pmax, p1[r]);
    { auto rr = __builtin_amdgcn_permlane32_swap(__float_as_uint(pmax), __float_as_uint(pmax), false, false);
      pmax = fmaxf(__uint_as_float(rr[0]), __uint_as_float(rr[1])); }
    if (__builtin_expect(__all(pmax - m_reg <= thr), 1)) { mn = m_reg; alpha = 1.f; }
    else { mn = fmaxf(m_reg, pmax); alpha = __builtin_amdgcn_exp2f((m_reg - mn) * C); m_reg = mn; }
    const float mnC = -mn * C;
#pragma unroll
    for (int r = 0; r < 16; ++r) p0[r] = fmaf(p0[r], C, mnC);
#pragma unroll
    for (int r = 0; r < 16; ++r) p1[r] = fmaf(p1[r], C, mnC);
#pragma unroll
    for (int r = 0; r < 16; ++r) p0[r] = __builtin_amdgcn_exp2f(p0[r]);
}
__device__ __forceinline__ void finishSM(f32x16& p0, f32x16& p1, float alpha, float& l_reg, bf16x8& pa0, bf16x8& pa1, bf16x8& pa2, bf16x8& pa3) {
#pragma unroll
    for (int r = 0; r < 16; ++r) p1[r] = __builtin_amdgcn_exp2f(p1[r]);
    float ps = 0;
#pragma unroll
    for (int r = 0; r < 16; ++r) ps += p0[r];
#pragma unroll
    for (int r = 0; r < 16; ++r) ps += p1[r];
    { auto rr = __builtin_amdgcn_permlane32_swap(__float_as_uint(ps), __float_as_uint(ps), false, false);
      ps = __uint_as_float(rr[0]) + __uint_as_float(rr[1]); }
    l_reg = l_reg * alpha + ps;
#define PK4(P, BASE, OUT) do { unsigned a0 = cvtpk(P[BASE + 0], P[BASE + 1]), a1 = cvtpk(P[BASE + 2], P[BASE + 3]);   \
    unsigned b0 = cvtpk(P[BASE + 4], P[BASE + 5]), b1 = cvtpk(P[BASE + 6], P[BASE + 7]);                              \
    auto r0 = __builtin_amdgcn_permlane32_swap(a0, b0, false, false); auto r1 = __builtin_amdgcn_permlane32_swap(a1, b1, false, false); \
    u32x4 w = {r0[0], r1[0], r0[1], r1[1]}; OUT = *reinterpret_cast<bf16x8*>(&w); } while (0)
    PK4(p0, 0, pa0); PK4(p0, 8, pa1); PK4(p1, 0, pa2); PK4(p1, 8, pa3);
#undef PK4
}
template <int DK> __device__ __forceinline__ int kswz(int row, int ch) { return row * (DK * 2) + ((ch ^ (row & 7)) << 4); }
template <int DK, int QREG> __device__ __forceinline__ void qkt(f32x16& p0, f32x16& p1, const LAS char* Ks, const bf16x8* qr, const LAS char* qx, int r32, int hi) {
    p0 = f32x16{}; p1 = f32x16{};
#pragma unroll
    for (int d0 = 0; d0 < DK / 16; ++d0) { const int ch = d0 * 2 + hi;
        const bf16x8 b0 = *(const LAS bf16x8*)(Ks + kswz<DK>(r32, ch));
        const bf16x8 b1 = *(const LAS bf16x8*)(Ks + kswz<DK>(32 + r32, ch));
        bf16x8 q; if constexpr (true) { if (d0 < QREG) q = qr[d0 < QREG ? d0 : 0]; else q = *(const LAS bf16x8*)(qx + (d0 - QREG) * 1024); }
        p0 = __builtin_amdgcn_mfma_f32_32x32x16_bf16(b0, q, p0, 0, 0, 0);
        p1 = __builtin_amdgcn_mfma_f32_32x32x16_bf16(b1, q, p1, 0, 0, 0); }
}
template <int NCB> __device__ __forceinline__ int v_st(int k, int c) { const int kk = (k & ~0xC) | ((k & 4) << 1) | ((k & 8) >> 1); return ((kk >> 3) * NCB + (c >> 5)) * 512 + ((kk & 7) * 32 + (c & 31)) * 2; }
__device__ __forceinline__ int v_rd_base(int lane) { return ((lane & 3) << 3) | (((lane >> 2) & 3) << 6) | (((lane >> 4) & 1) << 5) | (((lane >> 5) & 1) << 8); }
template <int OFF> __device__ __forceinline__ s16x4 tr_read(int vb) { s16x4 r; asm volatile("ds_read_b64_tr_b16 %0, %1 offset:%2" : "=&v"(r) : "v"(vb), "i"(OFF) : "memory"); return r; }
template <int D0, int NCB> __device__ __forceinline__ void pv_one(f32x16& od, int vb, bf16x8 pa0, bf16x8 pa1, bf16x8 pa2, bf16x8 pa3) {
#define VOFF(ks, half) (D0 * 512 + (ks) * (2 * NCB * 512) + (half) * (NCB * 512))
    const s16x4 l0 = tr_read<VOFF(0, 0)>(vb), h0 = tr_read<VOFF(0, 1)>(vb), l1 = tr_read<VOFF(1, 0)>(vb), h1 = tr_read<VOFF(1, 1)>(vb);
    const s16x4 l2 = tr_read<VOFF(2, 0)>(vb), h2 = tr_read<VOFF(2, 1)>(vb), l3 = tr_read<VOFF(3, 0)>(vb), h3 = tr_read<VOFF(3, 1)>(vb);
#undef VOFF
    asm volatile("s_waitcnt lgkmcnt(0)" ::: "memory"); SBAR();
#define PK(L, H) (bf16x8){L[0], L[1], L[2], L[3], H[0], H[1], H[2], H[3]}
    od = __builtin_amdgcn_mfma_f32_32x32x16_bf16(pa0, PK(l0, h0), od, 0, 0, 0);
    od = __builtin_amdgcn_mfma_f32_32x32x16_bf16(pa1, PK(l1, h1), od, 0, 0, 0);
    od = __builtin_amdgcn_mfma_f32_32x32x16_bf16(pa2, PK(l2, h2), od, 0, 0, 0);
    od = __builtin_amdgcn_mfma_f32_32x32x16_bf16(pa3, PK(l3, h3), od, 0, 0, 0);
#undef PK
}
template <int NCB> __device__ __forceinline__ void pv_all(f32x16* o, int vb, bf16x8 pa0, bf16x8 pa1, bf16x8 pa2, bf16x8 pa3) {
    pv_one<0, NCB>(o[0], vb, pa0, pa1, pa2, pa3); pv_one<1, NCB>(o[1], vb, pa0, pa1, pa2, pa3);
    if constexpr (NCB == 4) { pv_one<2, NCB>(o[2], vb, pa0, pa1, pa2, pa3); pv_one<3, NCB>(o[3], vb, pa0, pa1, pa2, pa3); }
}

template <int MODE> __device__ __forceinline__ void apply_mask(f32x16& p0, f32x16& p1, const Args& a, int j, int wid, int r32, int hi) {
    if constexpr (MODE == 1) {
        if (j < a.n0) return;
        const int kp0 = a.wpos0 + 64 * (j - a.n0), qw0 = a.qpos0 + wid * 32;
        if (kp0 + 63 - qw0 <= 128 && qw0 + 31 - kp0 <= 128) return;
        const int dd0 = kp0 - (qw0 + r32) + 4 * hi + 128;
#pragma unroll
        for (int r = 0; r < 16; ++r) { const int dd = dd0 + (r & 3) + 8 * (r >> 2);
            p0[r] = ((unsigned)dd <= 256u) ? p0[r] : -1e30f; p1[r] = ((unsigned)(dd + 32) <= 256u) ? p1[r] : -1e30f; }
    } else if constexpr (MODE == 2) {
        if (j < a.n0) return;
        const int kr = a.kr0 + (j - a.n0), qr = a.r0 + (wid >> 1);
        int rs = qr - 4; rs = rs < 0 ? 0 : (rs > 56 ? 56 : rs);
        if (kr < rs || kr >= rs + 8) {
#pragma unroll
            for (int r = 0; r < 16; ++r) { p0[r] = -1e30f; p1[r] = -1e30f; }
            return; }
        const int dr = kr - qr + 7, qc = (wid & 1) * 32 + r32;
        const float* tb = a.T + ((size_t)(dr * 64 + qc)) * 64 + 4 * hi;
#pragma unroll
        for (int g = 0; g < 4; ++g) { const f32x4 t0 = *(const f32x4*)(tb + 8 * g), t1 = *(const f32x4*)(tb + 32 + 8 * g);
#pragma unroll
            for (int i = 0; i < 4; ++i) { p0[4 * g + i] += t0[i]; p1[4 * g + i] += t1[i]; }
            asm volatile("" ::: "memory"); }
    }
}

template <int DK, int DV, int MODE, int SDEPTH>
__device__ __forceinline__ void attn_unit(const Args& a, LAS char* lds, const int tid) {
    constexpr int NKC = DK / 8, NVC = DV / 8, KPT = DK / 64, VPT = DV / 64, NCB = DV / 32, ND0 = DK / 16, QREG = (ND0 > 8 ? 4 : ND0);
    constexpr int SHM_K = 64 * DK * 2, SHM_V = 64 * DV * 2;
    const int wid = __builtin_amdgcn_readfirstlane(tid >> 6), lane = tid & 63, r32 = lane & 31, hi = lane >> 5;
    LAS char* V_lds = lds; LAS char* K_lds = lds + 2 * SHM_V;
    LAS float* ws = (LAS float*)(lds + 2 * SHM_V + 2 * SHM_K) + wid * 64; LAS float* li_l = ws; LAS float* al_l = ws + 32;
    LAS char* qx = lds + 2 * SHM_V + 2 * SHM_K + NW * 256 + wid * ((ND0 - QREG) * 1024) + lane * 16;
    float m_reg = -1e30f, l_reg = 0; f32x16 o[NCB]; bf16x8 qr[ND0];
#pragma unroll
    for (int d = 0; d < NCB; ++d) o[d] = f32x16{};
    const bf16* Qw = a.Q + (long)(wid * QBLK + r32) * a.ldq + hi * 8;
#pragma unroll
    for (int d0 = 0; d0 < ND0; ++d0) qr[d0] = *(const bf16x8*)(Qw + d0 * 16);
    if constexpr (DK == 192) {
        if (a.qrope) {
            const int t = a.qpos0 + wid * QBLK + r32; const float prow = (float)(t >> 6), pcol = (float)(t & 63);
#pragma unroll
            for (int dd = 0; dd < 2; ++dd) {
                bf16x8 x1 = qr[8 + dd], x2 = qr[10 + dd]; const float pos = dd ? pcol : prow;
#pragma unroll
                for (int e = 0; e < 8; ++e) { const float inv = __builtin_amdgcn_exp2f(-(float)(hi * 8 + e) * (13.287712379549449f / 16.0f)); const float ang = pos * inv;
                    const float c = __cosf(ang), s = __sinf(ang); const float f1 = bf2f((unsigned short)x1[e]), f2 = bf2f((unsigned short)x2[e]);
                    x1[e] = (short)f2bf(f1 * c - f2 * s); x2[e] = (short)f2bf(f1 * s + f2 * c); }
                qr[8 + dd] = x1; qr[10 + dd] = x2; }
        }
#pragma unroll
        for (int d0 = QREG; d0 < ND0; ++d0) *(LAS bf16x8*)(qx + (d0 - QREG) * 1024) = qr[d0];
        asm volatile("s_waitcnt lgkmcnt(0)" ::: "memory");
    }
    int koff[KPT], klds[KPT], voff[VPT], vlds[VPT];
#pragma unroll
    for (int i = 0; i < KPT; ++i) { const int q = tid + 512 * i, row = q / NKC, ch = q % NKC; koff[i] = row * a.ld + (ch < 16 ? a.kc0 + 8 * ch : a.kc1 + 8 * (ch - 16)); klds[i] = kswz<DK>(row, ch); }
#pragma unroll
    for (int i = 0; i < VPT; ++i) { const int q = tid + 512 * i, row = q / NVC, ch = q % NVC; voff[i] = row * a.ld + a.vc + 8 * ch; vlds[i] = v_st<NCB>(row, 8 * ch); }
    const int vb0 = (int)(uintptr_t)V_lds + v_rd_base(lane);
    bf16x8 sk[SDEPTH][KPT], sv[SDEPTH][VPT];
    const int NT = a.n0 + a.n1;
#define TROW(j) ((j) < a.n0 ? a.row0 + 64 * (j) : a.row1 + 64 * ((j) - a.n0))
#define SLOAD(i, j) do { const bf16* _b = a.KV + (long)TROW(j) * a.ld; \
    _Pragma("unroll") for (int _k = 0; _k < VPT; ++_k) sv[i][_k] = *(const bf16x8*)(_b + voff[_k]); \
    _Pragma("unroll") for (int _k = 0; _k < KPT; ++_k) sk[i][_k] = *(const bf16x8*)(_b + koff[_k]); } while (0)
#define SWRITE(b, i) do { \
    _Pragma("unroll") for (int _k = 0; _k < VPT; ++_k) *(LAS bf16x8*)(V_lds + (b) * SHM_V + vlds[_k]) = sv[i][_k]; \
    _Pragma("unroll") for (int _k = 0; _k < KPT; ++_k) *(LAS bf16x8*)(K_lds + (b) * SHM_K + klds[_k]) = sk[i][_k]; } while (0)
#define SWAIT() do { if constexpr (SDEPTH == 2) asm volatile("s_waitcnt vmcnt(%0)" :: "n"(KPT + VPT) : "memory"); else asm volatile("s_waitcnt vmcnt(0)" ::: "memory"); } while (0)
#define RESC(al) do { if (__any((al) < 1.f)) { if (hi == 0) al_l[r32] = (al); asm volatile("s_waitcnt lgkmcnt(0)" ::: "memory"); \
    _Pragma("unroll") for (int d = 0; d < NCB; ++d) _Pragma("unroll") for (int r = 0; r < 16; ++r) o[d][r] *= al_l[crow(r, hi)]; } } while (0)
    f32x16 pA0, pA1, pB0, pB1; float mnA, mnB, alA, alB; bf16x8 pa0, pa1, pa2, pa3;
    constexpr int SE = 0, SO = SDEPTH - 1;
    SLOAD(SE, 0); asm volatile("s_waitcnt vmcnt(0)" ::: "memory"); SWRITE(0, SE); __syncthreads();
    qkt<DK, QREG>(pA0, pA1, K_lds, qr, qx, r32, hi); apply_mask<MODE>(pA0, pA1, a, 0, wid, r32, hi); partialSM(pA0, pA1, m_reg, mnA, alA, a.C, a.thr);
    SLOAD(SO, 1); if constexpr (SDEPTH == 2) { if (2 < NT) SLOAD(SE, 2); }
    SWAIT(); SWRITE(1, SO); __syncthreads();
    for (int j = 1; j + 1 < NT; j += 2) {
        SBAR(); qkt<DK, QREG>(pB0, pB1, K_lds + SHM_K, qr, qx, r32, hi);
        finishSM(pA0, pA1, alA, l_reg, pa0, pa1, pa2, pa3); SBAR();
        SLOAD(SO, j + SDEPTH); SBAR();
        pv_all<NCB>(o, vb0, pa0, pa1, pa2, pa3); if constexpr (MODE != 0) SBAR(); apply_mask<MODE>(pB0, pB1, a, j, wid, r32, hi); if constexpr (MODE != 0) SBAR(); partialSM(pB0, pB1, m_reg, mnB, alB, a.C, a.thr);
        __syncthreads(); SWAIT(); SWRITE(0, SE);
        RESC(alB); __syncthreads();
        SBAR(); qkt<DK, QREG>(pA0, pA1, K_lds, qr, qx, r32, hi);
        finishSM(pB0, pB1, alB, l_reg, pa0, pa1, pa2, pa3); SBAR();
        if (SDEPTH == 1 || j + 3 < NT) SLOAD(SE, j + 1 + SDEPTH); SBAR();
        pv_all<NCB>(o, vb0 + SHM_V, pa0, pa1, pa2, pa3); if constexpr (MODE != 0) SBAR(); apply_mask<MODE>(pA0, pA1, a, j + 1, wid, r32, hi); if constexpr (MODE != 0) SBAR(); partialSM(pA0, pA1, m_reg, mnA, alA, a.C, a.thr);
        __syncthreads(); SWAIT(); SWRITE(1, SO);
        RESC(alA); __syncthreads();
    }
    SBAR(); qkt<DK, QREG>(pB0, pB1, K_lds + SHM_K, qr, qx, r32, hi);
    finishSM(pA0, pA1, alA, l_reg, pa0, pa1, pa2, pa3); SBAR();
    pv_all<NCB>(o, vb0, pa0, pa1, pa2, pa3); if constexpr (MODE != 0) SBAR(); apply_mask<MODE>(pB0, pB1, a, NT - 1, wid, r32, hi); if constexpr (MODE != 0) SBAR(); partialSM(pB0, pB1, m_reg, mnB, alB, a.C, a.thr);
    __syncthreads(); RESC(alB);
    finishSM(pB0, pB1, alB, l_reg, pa0, pa1, pa2, pa3); SBAR();
    pv_all<NCB>(o, vb0 + SHM_V, pa0, pa1, pa2, pa3);
    if constexpr (MODE == 1) { if (a.has_sink) l_reg += __builtin_amdgcn_exp2f(a.sinkl2 - m_reg * a.C); }
    if (hi == 0) li_l[r32] = l_reg; asm volatile("s_waitcnt lgkmcnt(0)" ::: "memory");
    float rli[16];
#pragma unroll
    for (int r = 0; r < 16; ++r) rli[r] = __builtin_amdgcn_rcpf(li_l[crow(r, hi)]);
    bf16* Ow = a.O + (long)(wid * QBLK) * a.ldo;
#pragma unroll
    for (int r = 0; r < 16; ++r) { const int orow = crow(r, hi);
#pragma unroll
        for (int d0 = 0; d0 < NCB; ++d0) Ow[(long)orow * a.ldo + d0 * 32 + r32] = f2bf(o[d0][r] * rli[r]); }
    __syncthreads();
#undef TROW
#undef SLOAD
#undef SWRITE
#undef SWAIT
#undef RESC
}
#undef SBAR
}
constexpr int DM = 2048, NBATCH = 4, SEQ = 4096, NCTX = 256, DEPTH = 2;
constexpr int ML = NBATCH * SEQ, MC = NBATCH * NCTX, MT = ML + MC;
constexpr int INW = 3904, UW = 4096, QW = 1856;
constexpr int MODW = 6 * DM;
constexpr float LN_EPS = 1e-5f, RMS_EPS = 1e-6f;
constexpr float ALPHA = 1.4142135623730951f;
constexpr float LOG2E = 1.4426950408889634f;
constexpr float A_SCALE = 0.07216878364870323f, B_SCALE = 0.125f, C_SCALE = 0.08838834764831845f, D_SCALE = 0.08838834764831845f;
constexpr int U_CQ = 0, U_CKV = 384, U_KR = 512, U_BQ = 576, U_BK = 1088, U_BV = 1216, U_CQQ = 1344, U_CK = 1856, U_CV = 2368, U_DQ = 2880, U_DK = 3392, U_DV = 3648;
constexpr int QA_Q = 0, QA_KV = 768, QA_KR = 1792;

constexpr size_t MiB = 1u << 20;
constexpr size_t WS_CTL = 0, CTL_ZERO_BYTES = 1 * MiB;
constexpr size_t WS_MOD = 1 * MiB;
constexpr size_t WS_CTAB = 2 * MiB;
constexpr size_t WS_SUBK = 4 * MiB;
constexpr size_t WS_WUP = 5 * MiB;
constexpr size_t WS_WIN = 9 * MiB;
constexpr size_t WS_WC = 41 * MiB;
constexpr size_t WS_WO = 121 * MiB;
constexpr size_t WS_WPQ = 137 * MiB;
constexpr size_t WS_PU = 153 * MiB;
constexpr size_t WS_PV = 281 * MiB;
constexpr size_t WS_BUFA = 409 * MiB;
constexpr size_t WS_BUFB = 477 * MiB;
constexpr size_t WS_UREG = 545 * MiB;
constexpr size_t WS_QKVA = 681 * MiB;
constexpr size_t WS_OQP = 743 * MiB;
constexpr size_t WS_XRES = 811 * MiB;
constexpr size_t WS_EIDX = 947 * MiB;
constexpr size_t WS_EG = 956 * MiB;
constexpr size_t WS_MODP = 965 * MiB;
constexpr size_t WS_DBG = 973 * MiB;
constexpr size_t WS_END = 974 * MiB;
constexpr size_t STASH_WG = 131072, P_WG = 262144, WS_STASH = WS_UREG, WS_P = WS_UREG + 32 * MiB;
constexpr int CW_TMO = 0, CW_BAR = 4096;

constexpr int NWAVES = 8;
constexpr int RING_OFF = 0, RING_BYTES = 155648;
constexpr int LDSCTL_OFF = RING_BYTES, MISC_OFF = LDSCTL_OFF + 320;
constexpr int LDS_BYTES = 157696;

#define RLX_AGENT __ATOMIC_RELAXED, __HIP_MEMORY_SCOPE_AGENT
#define LDS_WAIT() asm volatile("s_waitcnt lgkmcnt(0)" ::: "memory")
#define VM_WAIT() asm volatile("s_waitcnt vmcnt(0)" ::: "memory")

#define XB_TMO      128
#define XB_XCNT(j)  (256  + 64 * (j))
#define XB_XSUB(j)  (1280 + 64 * (j))
#define XB_XGEN(j)  (2304 + 64 * (j))
#define XB_TOP      3328
#define XB_TOPGEN   3392
#define XCD_BAR_WORDS 3456
#define XB_SPIN_CAP (1u << 22)
__device__ __forceinline__ unsigned xb_ld(unsigned* p)              { return __hip_atomic_load(p, __ATOMIC_RELAXED, __HIP_MEMORY_SCOPE_AGENT); }
__device__ __forceinline__ unsigned xb_add(unsigned* p, unsigned v) { return __hip_atomic_fetch_add(p, v, __ATOMIC_RELAXED, __HIP_MEMORY_SCOPE_AGENT); }
__device__ __forceinline__ unsigned xb_xcc_id() { return (unsigned)__builtin_amdgcn_s_getreg((3 << 11) | 20) & 0xFu; }
#define XB_SPIN(cond, bar) do { unsigned _sp = 0; while (cond) { __builtin_amdgcn_s_sleep(1); \
    if ((++_sp & 255u) == 0u) { if (xb_ld(&(bar)[XB_TMO])) break; if (_sp > XB_SPIN_CAP) { atomicAdd(&(bar)[XB_TMO], 1u); break; } } } } while (0)
struct XcdBarrier { unsigned* bar; unsigned x; volatile LAS unsigned* st; };
__device__ __forceinline__ XcdBarrier xcd_barrier_post(unsigned* bar, volatile LAS unsigned* st) {
    XcdBarrier b; b.bar = bar; b.x = xb_xcc_id(); b.st = st;
    if (threadIdx.x == 0) (void)xb_add(&bar[XB_XCNT(b.x)], 1u);
    return b;
}
__device__ __forceinline__ void xcd_barrier_complete(unsigned* bar, unsigned x, unsigned& nloc, unsigned& nx) {
    const unsigned G = gridDim.x * gridDim.y * gridDim.z;
    unsigned sum, cnt, mine, sp = 0u;
    for (;;) {
        sum = 0u; cnt = 0u; mine = 0u;
#pragma unroll
        for (unsigned j = 0; j < 16; ++j) { const unsigned c = xb_ld(&bar[XB_XCNT(j)]); sum += c; cnt += (c > 0u) ? 1u : 0u; mine = (j == x) ? c : mine; }
        if (sum == G) break;
        __builtin_amdgcn_s_sleep(1);
        if ((++sp & 255u) == 0u) { if (xb_ld(&bar[XB_TMO])) break; if (sp > XB_SPIN_CAP) { atomicAdd(&bar[XB_TMO], 1u); break; } }
    }
    nloc = mine > 0u ? mine : 1u; nx = cnt > 0u ? cnt : 1u;
}
__device__ __forceinline__ void xcd_barrier(const XcdBarrier& b) {
    asm volatile("s_waitcnt vmcnt(0)" ::: "memory");
    __syncthreads();
    if (threadIdx.x == 0) {
        unsigned* bar = b.bar;
        __builtin_amdgcn_s_waitcnt(0);
        unsigned nloc = b.st[0], nx = b.st[1];
        if (nloc == 0u) { xcd_barrier_complete(bar, b.x, nloc, nx); b.st[0] = nloc; b.st[1] = nx; }
        const unsigned old = xb_add(&bar[XB_XSUB(b.x)], 1u);
        const unsigned gen = old / nloc;
        if (old + 1u == (gen + 1u) * nloc) {
            __builtin_amdgcn_fence(__ATOMIC_RELEASE, "agent");
            asm volatile("s_waitcnt vmcnt(0)" ::: "memory");
            const unsigned og = xb_add(&bar[XB_TOP], 1u);
            const unsigned tg = og / nx;
            if (og + 1u == (tg + 1u) * nx) xb_add(&bar[XB_TOPGEN], 1u);
            else XB_SPIN(xb_ld(&bar[XB_TOPGEN]) == tg, bar);
            __builtin_amdgcn_fence(__ATOMIC_ACQUIRE, "agent");
            xb_add(&bar[XB_XGEN(b.x)], 1u);
            asm volatile("s_waitcnt vmcnt(0)" ::: "memory");
        } else {
            XB_SPIN(xb_ld(&bar[XB_XGEN(b.x)]) == gen, bar);
            __builtin_amdgcn_fence(__ATOMIC_ACQUIRE, "agent");
            asm volatile("s_waitcnt vmcnt(0)" ::: "memory");
        }
    }
    __syncthreads();
}

struct In {
    const float *x, *c, *ctx, *c_ctx, *w_ada, *b_ada, *w_in, *a_q_norm, *a_kv_norm, *a_w_uq, *a_w_ukv, *b_sink, *c_rpb, *d_q_norm, *d_k_norm,
                *w_branch, *w_gate, *b_gate, *w_out, *ln1_g, *ln1_b, *ln2_g, *ln2_b, *peer_w_q, *peer_sub_keys, *peer_u, *peer_v;
};
struct Args { In in; float* out; unsigned char* ws; int ph_lo, ph_hi, li, pad; };
struct Frame { LAS unsigned char* lds; int tid, lane, wave, vcu, G; GAS unsigned char* ws; };
template <class T> __device__ __forceinline__ T* G(T* p) { return (T*)(GAS T*)p; }
typedef const __attribute__((address_space(4))) Args& KA;
typedef const __attribute__((address_space(4))) Args* KAP;
__device__ __forceinline__ KAP kargs() { KAP p = (KAP)__builtin_amdgcn_kernarg_segment_ptr(); asm volatile("" : "+s"(p)); return p; }

__device__ __forceinline__ float wave_sum(float v) {
#pragma unroll
    for (int o = 1; o < 64; o <<= 1) v += __shfl_xor(v, o);
    return v;
}
__device__ __forceinline__ unsigned pk2(float lo, float hi) { return cvt_pk_bf16(lo, hi); }
__device__ __forceinline__ float silu_f(float v) { return v / (1.0f + __expf(-v)); }

__device__ __forceinline__ void p0_transpose_item(const float* W, int ldw, int nblk, bf16* dst, int dpitch, int row_off, int col_off, const float* gain, LAS float* scr, int item, int lane) {
    const int kb = item / nblk, nb = item % nblk, k0 = 64 * kb, n0 = 32 * nb;
#pragma unroll 8
    for (int i = 0; i < 32; ++i) { const int kk = 2 * i + (lane >> 5); float v = W[(size_t)(k0 + kk) * ldw + n0 + (lane & 31)]; if (gain) v *= gain[k0 + kk]; scr[kk * 33 + (lane & 31)] = v; }
    LDS_WAIT(); asm volatile("" ::: "memory");
    const int c = lane & 7;
#pragma unroll
    for (int j = 0; j < 4; ++j) { const int n = (lane >> 3) + 8 * j; const LAS float* s = scr + (8 * c) * 33 + n;
        u32x4 o; o.x = pk2(s[0 * 33], s[1 * 33]); o.y = pk2(s[2 * 33], s[3 * 33]); o.z = pk2(s[4 * 33], s[5 * 33]); o.w = pk2(s[6 * 33], s[7 * 33]);
        *(GAS u32x4*)(dst + (size_t)(row_off + n0 + n) * dpitch + col_off + k0 + 8 * c) = o; }
    LDS_WAIT(); asm volatile("" ::: "memory");
}
struct TJob { const float* W; int K, N; bf16* dst; int dpitch, row_off, col_off; const float* gain; };
__device__ __forceinline__ int tjob_get(KA A, int job, TJob& t) {
    const int l = job / 13, j = job % 13; GAS unsigned char* ws = (GAS unsigned char*)A.ws; t.gain = nullptr; t.row_off = 0; t.col_off = 0;
    if (j == 0) { t.W = G(A.in.w_in) + (size_t)l * DM * INW; t.K = DM; t.N = INW; t.dst = (bf16*)(ws + WS_WIN) + (size_t)l * UW * DM; t.dpitch = DM; }
    else if (j <= 4) { const int z = j - 1; t.W = G(A.in.w_gate) + ((size_t)l * 4 + z) * DM * DM; t.K = DM; t.N = DM; t.dst = (bf16*)(ws + WS_WC) + ((size_t)l * 4 + z) * DM * 2560; t.dpitch = 2560; }
    else if (j <= 8) { const int z = j - 5; t.W = G(A.in.w_branch) + ((size_t)l * 4 + z) * 512 * DM; t.K = 512; t.N = DM; t.dst = (bf16*)(ws + WS_WC) + ((size_t)l * 4 + z) * DM * 2560; t.dpitch = 2560; t.col_off = 2048; }
    else if (j == 9) { t.W = G(A.in.w_out) + (size_t)l * DM * DM; t.K = DM; t.N = DM; t.dst = (bf16*)(ws + WS_WO) + (size_t)l * DM * DM; t.dpitch = DM; }
    else if (j == 10) { t.W = G(A.in.peer_w_q) + (size_t)l * DM * DM; t.K = DM; t.N = DM; t.dst = (bf16*)(ws + WS_WPQ) + (size_t)l * DM * DM; t.dpitch = DM; }
    else if (j == 11) { t.W = G(A.in.a_w_uq) + (size_t)l * 384 * 768; t.K = 384; t.N = 768; t.dst = (bf16*)(ws + WS_WUP) + (size_t)l * 1792 * 512; t.dpitch = 512; t.gain = G(A.in.a_q_norm) + l * 384; }
    else { t.W = G(A.in.a_w_ukv) + (size_t)l * 128 * 1024; t.K = 128; t.N = 1024; t.dst = (bf16*)(ws + WS_WUP) + (size_t)l * 1792 * 512; t.dpitch = 512; t.row_off = 768; t.col_off = 384; t.gain = G(A.in.a_kv_norm) + l * 128; }
    return (t.K / 64) * (t.N / 32);
}
__device__ __forceinline__ void p0_prologue(const Frame& F, KA A) {
    GAS unsigned char* ws = F.ws;
    const int gw = F.vcu * NWAVES + F.wave, NGW = F.G * NWAVES;
    const long gt = (long)gw * 64 + F.lane, NGT = (long)NGW * 64;
    {
        float* modp = (float*)(ws + WS_MODP);
        for (int it = gw; it < 2 * 16 * 48; it += NGW) {
            const int l = it / 768, ks = (it % 768) / 48, cg = it % 48, n = cg * 256 + F.lane * 4;
            const float* w = G(A.in.w_ada) + ((size_t)l * DM + ks * 128) * MODW + n;
            f32x4 acc[5];
#pragma unroll
            for (int r = 0; r < 5; ++r) acc[r] = (f32x4){0.f, 0.f, 0.f, 0.f};
#pragma unroll 8
            for (int k = 0; k < 128; ++k) {
                const f32x4 wv = *(const f32x4*)(w + (size_t)k * MODW);
                const int kk = ks * 128 + k;
#pragma unroll
                for (int r = 0; r < 5; ++r) { const float cv = (r < 4) ? G(A.in.c)[r * DM + kk] : G(A.in.c_ctx)[kk]; acc[r] += wv * silu_f(cv); }
            }
#pragma unroll
            for (int r = 0; r < 5; ++r) *(f32x4*)(modp + (((size_t)ks * 2 + l) * 5 + r) * MODW + n) = acc[r];
        }
    }
    {
        LAS float* scr = (LAS float*)(F.lds + RING_OFF + F.wave * 16384);
        int base = 0;
        for (int job = 0; job < 26; ++job) {
            TJob t; const int ni = tjob_get(A, job, t);
            int first = gw - (base % NGW); if (first < 0) first += NGW;
            for (int i = first; i < ni; i += NGW) p0_transpose_item(t.W, t.N, t.N / 32, t.dst, t.dpitch, t.row_off, t.col_off, t.gain, scr, i, F.lane);
            base += ni;
        }
    }
    for (long i = gt; i < 2L * 192 * 2048 / 8; i += NGT) { const int l = (int)(i / (192 * 256)), r = (int)(i % (192 * 256)); *(u32x4*)((bf16*)(ws + WS_WIN) + ((size_t)l * UW + 3904) * DM + (size_t)r * 8) = (u32x4){0u, 0u, 0u, 0u}; }
    for (long i = gt; i < 2L * 768 * 16; i += NGT) { const int l = (int)(i / (768 * 16)), r = (int)(i % (768 * 16)), row = r / 16, c8 = r % 16; *(u32x4*)((bf16*)(ws + WS_WUP) + ((size_t)l * 1792 + row) * 512 + 384 + c8 * 8) = (u32x4){0u, 0u, 0u, 0u}; }
    for (long i = gt; i < 2L * 1024 * 48; i += NGT) { const int l = (int)(i / (1024 * 48)), r = (int)(i % (1024 * 48)), row = r / 48, c8 = r % 48; *(u32x4*)((bf16*)(ws + WS_WUP) + ((size_t)l * 1792 + 768 + row) * 512 + c8 * 8) = (u32x4){0u, 0u, 0u, 0u}; }
    {
        const long n_sk = 2L * 8 * 2 * 128 * 128 / 8;
        for (long i = gt; i < n_sk; i += NGT) {
            const float* src = G(A.in.peer_sub_keys); bf16* dst = (bf16*)(ws + WS_SUBK);
            const f32x4 a = *(const f32x4*)(src + i * 8), b = *(const f32x4*)(src + i * 8 + 4);
            u32x4 o; o.x = pk2(a[0], a[1]); o.y = pk2(a[2], a[3]); o.z = pk2(b[0], b[1]); o.w = pk2(b[2], b[3]);
            *(u32x4*)(dst + i * 8) = o;
        }
        const long n_pu = 2L * 16384 * 2048 / 16;
        for (long i = gt; i < 2 * n_pu; i += NGT) {
            const bool isu = i < n_pu; const long j = isu ? i : i - n_pu;
            const float* src = (isu ? G(A.in.peer_u) : G(A.in.peer_v)) + j * 16; unsigned char* dst = (unsigned char*)(ws + (isu ? WS_PU : WS_PV)) + j * 16; const float sc = isu ? 32.0f : 4.0f;
            u32x4 o;
#pragma unroll
            for (int q = 0; q < 4; ++q) { const f32x4 a = __builtin_nontemporal_load((const f32x4*)(src + q * 4)) * sc;
                int w = __builtin_amdgcn_cvt_pk_fp8_f32(a[0], a[1], 0, false); w = __builtin_amdgcn_cvt_pk_fp8_f32(a[2], a[3], w, true); o[q] = (unsigned)w; }
            *(u32x4*)dst = o;
        }
    }
    {
        float* ct = (float*)(ws + WS_CTAB);
        for (long i = gt; i < 2L * 4 * 15 * 64 * 64; i += NGT) {
            const int kc = (int)(i & 63), qc = (int)((i >> 6) & 63), r = (int)(i >> 12), dr = r % 15, lh = r / 15;
            int cs = qc - 8; cs = cs < 0 ? 0 : (cs > 48 ? 48 : cs);
            int co = kc - qc + 15; co = co < 0 ? 0 : (co > 30 ? 30 : co);
            ct[i] = (kc >= cs && kc < cs + 16) ? G(A.in.c_rpb)[((size_t)lh * 15 + dr) * 31 + co] * (1.0f / C_SCALE) : -1e30f;
        }
    }
}
__device__ __forceinline__ void p1_modreduce(const Frame& F, KA A) {
    const long gt = ((long)F.vcu * NWAVES + F.wave) * 64 + F.lane, NGT = (long)F.G * NWAVES * 64;
    const float* modp = (const float*)(F.ws + WS_MODP); float* mod = (float*)(F.ws + WS_MOD);
    for (long i = gt; i < 2L * 5 * MODW; i += NGT) { const int n = (int)(i % MODW), l = (int)(i / (5 * MODW));
        float s = G(A.in.b_ada)[l * MODW + n];
#pragma unroll
        for (int ks = 0; ks < 16; ++ks) s += modp[(size_t)ks * 2 * 5 * MODW + i];
        mod[i] = s; }
}
__device__ __forceinline__ void p2_modulate0(const Frame& F, KA A) {
    const int gw = F.vcu * NWAVES + F.wave, NGW = F.G * NWAVES;
    const float* mod = (const float*)(F.ws + WS_MOD); bf16* H = (bf16*)(F.ws + WS_BUFA);
    for (int row = gw; row < MT; row += NGW) {
        const float* xr = row < ML ? G(A.in.x) + (size_t)row * DM : G(A.in.ctx) + (size_t)(row - ML) * DM;
        const float* mr = mod + (size_t)(row < ML ? (row >> 12) : 4) * MODW;
#pragma unroll
        for (int j = 0; j < 4; ++j) { const int c = j * 512 + F.lane * 8;
            const f32x4 a = *(const f32x4*)(xr + c), b = *(const f32x4*)(xr + c + 4);
            const f32x4 sh0 = *(const f32x4*)(mr + c), sh1 = *(const f32x4*)(mr + c + 4), sc0 = *(const f32x4*)(mr + DM + c), sc1 = *(const f32x4*)(mr + DM + c + 4);
            const f32x4 y0 = a * (sc0 + 1.0f) + sh0, y1 = b * (sc1 + 1.0f) + sh1;
            u32x4 o; o.x = pk2(y0[0], y0[1]); o.y = pk2(y0[2], y0[3]); o.z = pk2(y1[0], y1[1]); o.w = pk2(y1[2], y1[3]);
            *(u32x4*)(H + (size_t)row * DM + c) = o; }
    }
}
__device__ __forceinline__ void rope_pair(float& x1, float& x2, float ang) { const float c = __cosf(ang), s = __sinf(ang); const float y1 = x1 * c - x2 * s, y2 = x1 * s + x2 * c; x1 = y1; x2 = y2; }
__device__ __forceinline__ void enorm_phase(const Frame& F, KA A, int l) {
    const int gw = F.vcu * NWAVES + F.wave, NGW = F.G * NWAVES, lane = F.lane;
    bf16* U = (bf16*)(F.ws + WS_UREG); bf16* QK = (bf16*)(F.ws + WS_QKVA);
    const float* gq = G(A.in.d_q_norm) + l * 128; const float* gk = G(A.in.d_k_norm) + l * 128;
    const float L2T = 13.287712379549449f;
    for (int row = gw; row < MT; row += NGW) {
        bf16* u = U + (size_t)row * UW;
        const bool lat = row < ML; const int t = row & 4095;
        const float prow = lat ? (float)(t >> 6) : 0.f, pcol = lat ? (float)(t & 63) : 0.f;
        { unsigned w[3]; float ss = 0.f;
#pragma unroll
          for (int i = 0; i < 3; ++i) { w[i] = ((const unsigned*)(u + U_CQ))[lane + 64 * i]; const float a = bflo(w[i]), b = bfhi(w[i]); ss += a * a + b * b; }
          const float rstd = rsqrtf(wave_sum(ss) * (1.0f / 384.0f) + RMS_EPS);
#pragma unroll
          for (int i = 0; i < 3; ++i) ((unsigned*)(u + U_CQ))[lane + 64 * i] = pk2(bflo(w[i]) * rstd, bfhi(w[i]) * rstd); }
        { const unsigned w = ((const unsigned*)(u + U_CKV))[lane]; const float a = bflo(w), b = bfhi(w);
          const float rstd = rsqrtf(wave_sum(a * a + b * b) * (1.0f / 128.0f) + RMS_EPS);
          ((unsigned*)(u + U_CKV))[lane] = pk2(a * rstd, b * rstd); }
        const int j64 = lane & 31;
        const float ang64 = ((j64 < 16) ? prow : pcol) * __builtin_amdgcn_exp2f(-(float)(j64 & 15) * (L2T / 16.0f));
        if (lane < 32) { float x1 = bf2f(u[U_KR + lane]), x2 = bf2f(u[U_KR + 32 + lane]); rope_pair(x1, x2, ang64);
            bf16* o = QK + (size_t)row * QW + QA_KR; o[lane] = f2bf(x1); o[32 + lane] = f2bf(x2); }
#pragma unroll
        for (int i = 0; i < 4; ++i) { const int p = lane + 64 * i, hd = p >> 5; bf16* q = u + U_BQ + hd * 64;
            float x1 = bf2f(q[j64]), x2 = bf2f(q[32 + j64]); rope_pair(x1, x2, ang64); q[j64] = f2bf(x1); q[32 + j64] = f2bf(x2); }
        { const int hd = lane >> 5; bf16* q = u + U_BK + hd * 64;
          float x1 = bf2f(q[j64]), x2 = bf2f(q[32 + j64]); rope_pair(x1, x2, ang64); q[j64] = f2bf(x1); q[32 + j64] = f2bf(x2); }
        const float ang128 = ((lane < 32) ? prow : pcol) * __builtin_amdgcn_exp2f(-(float)(lane & 31) * (L2T / 32.0f));
        const float gq1 = gq[lane], gq2 = gq[64 + lane], gk1 = gk[lane], gk2 = gk[64 + lane];
#pragma unroll
        for (int hd = 0; hd < 4; ++hd) { bf16* q = u + U_DQ + hd * 128; float x1 = bf2f(q[lane]), x2 = bf2f(q[64 + lane]);
            const float rstd = rsqrtf(wave_sum(x1 * x1 + x2 * x2) * (1.0f / 128.0f) + RMS_EPS);
            x1 = x1 * rstd * gq1; x2 = x2 * rstd * gq2; rope_pair(x1, x2, ang128); q[lane] = f2bf(x1); q[64 + lane] = f2bf(x2); }
#pragma unroll
        for (int hd = 0; hd < 2; ++hd) { bf16* q = u + U_DK + hd * 128; float x1 = bf2f(q[lane]), x2 = bf2f(q[64 + lane]);
            const float rstd = rsqrtf(wave_sum(x1 * x1 + x2 * x2) * (1.0f / 128.0f) + RMS_EPS);
            x1 = x1 * rstd * gk1; x2 = x2 * rstd * gk2; rope_pair(x1, x2, ang128); q[lane] = f2bf(x1); q[64 + lane] = f2bf(x2); }
    }
}
__device__ __forceinline__ void ln1_phase(const Frame& F, KA A, int l, int nrows, bf16* HF) {
    const int gw = F.vcu * NWAVES + F.wave, NGW = F.G * NWAVES, lane = F.lane;
    float* Y = (float*)(F.ws + WS_UREG); const float* mod = (const float*)(F.ws + WS_MOD) + (size_t)l * 5 * MODW;
    const float* g = G(A.in.ln1_g) + l * DM; const float* b = G(A.in.ln1_b) + l * DM;
    for (int row = gw; row < nrows; row += NGW) {
        float* y = Y + (size_t)row * DM; const float* mr = mod + (size_t)(row < ML ? (row >> 12) : 4) * MODW;
        f32x4 v[8]; float s = 0.f;
#pragma unroll
        for (int j = 0; j < 4; ++j) { const int c = j * 512 + lane * 8; v[2 * j] = *(const f32x4*)(y + c); v[2 * j + 1] = *(const f32x4*)(y + c + 4); }
#pragma unroll
        for (int j = 0; j < 8; ++j) s += (v[j][0] + v[j][1]) + (v[j][2] + v[j][3]);
        const float mean = wave_sum(s) * (1.0f / DM); float q = 0.f;
#pragma unroll
        for (int j = 0; j < 8; ++j) { v[j] = v[j] - mean; q += (v[j][0] * v[j][0] + v[j][1] * v[j][1]) + (v[j][2] * v[j][2] + v[j][3] * v[j][3]); }
        const float rstd = rsqrtf(wave_sum(q) * (1.0f / DM) + LN_EPS);
#pragma unroll
        for (int j = 0; j < 4; ++j) { const int c = j * 512 + lane * 8;
            const f32x4 x0 = v[2 * j] * rstd * *(const f32x4*)(g + c) + *(const f32x4*)(b + c), x1 = v[2 * j + 1] * rstd * *(const f32x4*)(g + c + 4) + *(const f32x4*)(b + c + 4);
            *(f32x4*)(y + c) = x0; *(f32x4*)(y + c + 4) = x1;
            const f32x4 h0 = x0 * (*(const f32x4*)(mr + 4 * DM + c) + 1.0f) + *(const f32x4*)(mr + 3 * DM + c), h1 = x1 * (*(const f32x4*)(mr + 4 * DM + c + 4) + 1.0f) + *(const f32x4*)(mr + 3 * DM + c + 4);
            u32x4 o; o.x = pk2(h0[0], h0[1]); o.y = pk2(h0[2], h0[3]); o.z = pk2(h1[0], h1[1]); o.w = pk2(h1[2], h1[3]);
            *(u32x4*)(HF + (size_t)row * DM + c) = o; }
    }
}
namespace peer {
__device__ __forceinline__ unsigned okey(float f) { const unsigned u = __float_as_uint(f); return (u & 0x80000000u) ? ~u : (u | 0x80000000u); }
__device__ __forceinline__ float ikey(unsigned k) { const unsigned u = (k & 0x80000000u) ? (k & 0x7fffffffu) : ~k; return __uint_as_float(u); }
#define CE_DESC(a, b) do { const unsigned _mx = (a) > (b) ? (a) : (b), _mn = (a) > (b) ? (b) : (a); (a) = _mx; (b) = _mn; } while (0)
#define CE_ASC(a, b)  do { const unsigned _mx = (a) > (b) ? (a) : (b), _mn = (a) > (b) ? (b) : (a); (a) = _mn; (b) = _mx; } while (0)
__device__ __forceinline__ void sort16_desc(unsigned (&k)[16]) {
#pragma unroll
    for (int size = 2; size <= 16; size <<= 1)
#pragma unroll
        for (int stride = size >> 1; stride > 0; stride >>= 1)
#pragma unroll
            for (int i = 0; i < 16; ++i) { const int p = i ^ stride; if (p > i) { if ((i & size) == 0) CE_DESC(k[i], k[p]); else CE_ASC(k[i], k[p]); } }
}
__device__ __forceinline__ void merge16_desc(unsigned (&a)[16], const unsigned (&b)[16]) {
#pragma unroll
    for (int i = 0; i < 16; ++i) a[i] = a[i] > b[15 - i] ? a[i] : b[15 - i];
#pragma unroll
    for (int stride = 8; stride > 0; stride >>= 1)
#pragma unroll
        for (int i = 0; i < 16; ++i) { const int p = i ^ stride; if (p > i) CE_DESC(a[i], a[p]); }
}
constexpr int slot_x(int s) { int n = 0; for (int x = 0; x < 16; ++x) for (int y = 0; y < 16; ++y) if ((x + 1) * (y + 1) <= 16) { if (n == s) return x; ++n; } return -1; }
constexpr int slot_y(int s) { int n = 0; for (int x = 0; x < 16; ++x) for (int y = 0; y < 16; ++y) if ((x + 1) * (y + 1) <= 16) { if (n == s) return y; ++n; } return -1; }
template <int S> struct Slot { static constexpr int x = slot_x(S), y = slot_y(S); };
template <int S> __device__ __forceinline__ void cand_one(unsigned (&c)[64], const float (&v0)[16], const float (&v1)[16], const unsigned (&i0)[16], const unsigned (&i1)[16], LAS unsigned short* tbl) {
    if constexpr (Slot<S>::x >= 0) { c[S] = (okey(v0[Slot<S>::x] + v1[Slot<S>::y]) & ~63u) | (unsigned)(63 - S); tbl[S] = (unsigned short)(i0[Slot<S>::x] * 128u + i1[Slot<S>::y]); }
    else c[S] = 0u;
}
template <int... S> __device__ __forceinline__ void cand_all(unsigned (&c)[64], const float (&v0)[16], const float (&v1)[16], const unsigned (&i0)[16], const unsigned (&i1)[16], LAS unsigned short* tbl, std::integer_sequence<int, S...>) {
    (cand_one<S>(c, v0, v1, i0, i1, tbl), ...);
}
__device__ __forceinline__ void topk_item(const bf16* QP, const bf16* SK, int* EIDX, float* EG, int tok0, int h, LAS unsigned short* tblw, int lane) {
    const int r32 = lane & 31, hi = lane >> 5;
    const bf16* qrow = QP + (size_t)(tok0 + r32) * DM + h * 256 + hi * 8;
    unsigned L[2][16];
#pragma unroll
    for (int p = 0; p < 2; ++p) {
        f32x16 acc[4];
#pragma unroll
        for (int kb = 0; kb < 4; ++kb) acc[kb] = f32x16{};
        const bf16* skp = SK + ((size_t)(h * 2 + p) * 128 + r32) * 128 + hi * 8;
#pragma unroll 2
        for (int d0 = 0; d0 < 8; ++d0) { const bf16x8 bq = *(const bf16x8*)(qrow + p * 128 + d0 * 16);
#pragma unroll
            for (int kb = 0; kb < 4; ++kb) { const bf16x8 ak = *(const bf16x8*)(skp + (size_t)kb * 32 * 128 + d0 * 16); acc[kb] = __builtin_amdgcn_mfma_f32_32x32x16_bf16(ak, bq, acc[kb], 0, 0, 0); } }
        unsigned g[4][16];
#pragma unroll
        for (int kb = 0; kb < 4; ++kb) {
#pragma unroll
            for (int r = 0; r < 16; ++r) g[kb][r] = (okey(acc[kb][r]) & ~127u) | (unsigned)(127 - (32 * kb + (r & 3) + 8 * (r >> 2) + 4 * hi));
            sort16_desc(g[kb]); }
        merge16_desc(g[0], g[1]); merge16_desc(g[2], g[3]); merge16_desc(g[0], g[2]);
        unsigned o[16];
#pragma unroll
        for (int i = 0; i < 16; ++i) o[i] = (unsigned)__shfl_xor((int)g[0][i], 32);
        merge16_desc(g[0], o);
#pragma unroll
        for (int i = 0; i < 16; ++i) L[p][i] = g[0][i];
    }
    float v0[16], v1[16]; unsigned i0[16], i1[16];
#pragma unroll
    for (int i = 0; i < 16; ++i) { v0[i] = ikey(L[0][i] & ~127u); v1[i] = ikey(L[1][i] & ~127u); i0[i] = 127u - (L[0][i] & 127u); i1[i] = 127u - (L[1][i] & 127u); }
    LAS unsigned short* tbl = tblw + lane * 66;
    unsigned c[64];
    cand_all(c, v0, v1, i0, i1, tbl, std::make_integer_sequence<int, 64>{});
    unsigned c0[16], c1[16], c2[16], c3[16];
#pragma unroll
    for (int i = 0; i < 16; ++i) { c0[i] = c[i]; c1[i] = c[16 + i]; c2[i] = c[32 + i]; c3[i] = c[48 + i]; }
    sort16_desc(c0); sort16_desc(c1); sort16_desc(c2); sort16_desc(c3);
    merge16_desc(c0, c1); merge16_desc(c2, c3); merge16_desc(c0, c2);
    LDS_WAIT(); asm volatile("" ::: "memory");
    float best[16]; int eid[16]; float sum = 0.f;
    const float mx = ikey(c0[0] & ~63u);
#pragma unroll
    for (int i = 0; i < 16; ++i) { const unsigned s = 63u - (c0[i] & 63u); eid[i] = (int)tbl[s]; best[i] = __expf(ikey(c0[i] & ~63u) - mx); sum += best[i]; }
    const float inv = 1.0f / sum;
    if (hi == 0) {
        int* ep = EIDX + (size_t)(tok0 + r32) * 128 + h * 16; float* gp = EG + (size_t)(tok0 + r32) * 128 + h * 16;
#pragma unroll
        for (int i = 0; i < 16; ++i) { ep[i] = eid[i]; gp[i] = best[i] * inv; }
    }
    LDS_WAIT(); asm volatile("" ::: "memory");
}
}
namespace px {
constexpr int TS = 4;
constexpr int NCH = 16, CHSH = 10;
constexpr float USCALE = 32.0f, VSCALE = 4.0f;
constexpr int RING = 6;
constexpr int L_SE = 0, L_SG = L_SE + TS * 128 * 2, L_OFF = L_SG + TS * 128 * 4, L_ORD = L_OFF + TS * 20 * 4, L_EORD = L_ORD + TS * 128 * 2, L_RING = ((L_EORD + TS * 128 * 2 + 1023) / 1024) * 1024,
              L_WAVE = L_RING + RING * 2048;
static_assert(L_WAVE * NWAVES <= RING_BYTES, "PEER scratch exceeds the LDS ring region");
__device__ __forceinline__ float gelu_as(float v) {
    const float av = __builtin_fabsf(v), t = __builtin_amdgcn_rcpf(av * 0.2316418882f + 1.0f);
    float q = t * 0.5307027145f + (-0.7265760135f); q = q * t + 0.7107068705f; q = q * t + (-0.142248368f); q = q * t + 0.127414796f; q = q * t;
    const float e = __builtin_amdgcn_exp2f((v * v) * (-0.72134752044f)); const float m = v * (q * e); return v < 0.f ? m : v - m;
}
__device__ __forceinline__ float gelu_exact(float v) { return 0.5f * v * (1.0f + erff(v * 0.70710678118654752f)); }

__device__ __forceinline__ void sort_token(const int* EIDX, const float* EG, int tok, LAS unsigned short* se, LAS float* sg, LAS int* off, int lane) {
    unsigned k0 = ((unsigned)EIDX[(size_t)tok * 128 + lane] << 7) | (unsigned)lane, k1 = ((unsigned)EIDX[(size_t)tok * 128 + 64 + lane] << 7) | (unsigned)(64 + lane);
#pragma unroll
    for (int size = 2; size <= 128; size <<= 1)
#pragma unroll
        for (int stride = size >> 1; stride > 0; stride >>= 1) {
            if (stride == 64) { const unsigned lo = k0 < k1 ? k0 : k1, hi = k0 < k1 ? k1 : k0; k0 = lo; k1 = hi; }
            else {
                const unsigned p0 = (unsigned)__shfl_xor((int)k0, stride), p1 = (unsigned)__shfl_xor((int)k1, stride);
                const bool lower = (lane & stride) == 0;
                const bool up0 = (lane & size) == 0 || size == 128 || size == 64;
                const bool up1 = size == 128 ? true : (size == 64 ? false : (lane & size) == 0);
                k0 = (lower == up0) ? (k0 < p0 ? k0 : p0) : (k0 < p0 ? p0 : k0);
                k1 = (lower == up1) ? (k1 < p1 ? k1 : p1) : (k1 < p1 ? p1 : k1);
            }
        }
    const unsigned e0 = k0 >> 7, e1 = k1 >> 7;
    se[lane] = (unsigned short)e0; se[64 + lane] = (unsigned short)e1;
    sg[lane] = EG[(size_t)tok * 128 + (k0 & 127u)]; sg[64 + lane] = EG[(size_t)tok * 128 + (k1 & 127u)];
#pragma unroll
    for (int c = 0; c <= NCH; ++c) {
        const unsigned lim = (unsigned)c << CHSH;
        const int cnt = __builtin_popcountll(__ballot(e0 < lim)) + __builtin_popcountll(__ballot(e1 < lim));
        if (lane == 0) off[c] = cnt;
    }
}
__device__ __forceinline__ f32x2 cvt8(unsigned w, bool hi) { return hi ? __builtin_amdgcn_cvt_pk_f32_fp8((int)w, true) : __builtin_amdgcn_cvt_pk_f32_fp8((int)w, false); }
__device__ __forceinline__ float dot32(const f32x2 (&h)[16], const u32x4 r0, const u32x4 r1) {
    f32x2 a = {0.f, 0.f}, b = {0.f, 0.f};
#pragma unroll
    for (int q = 0; q < 4; ++q) { a = __builtin_elementwise_fma(h[2 * q], cvt8(r0[q], false), a); b = __builtin_elementwise_fma(h[2 * q + 1], cvt8(r0[q], true), b); }
#pragma unroll
    for (int q = 0; q < 4; ++q) { a = __builtin_elementwise_fma(h[8 + 2 * q], cvt8(r1[q], false), a); b = __builtin_elementwise_fma(h[8 + 2 * q + 1], cvt8(r1[q], true), b); }
    return (a.x + a.y) + (b.x + b.y);
}
__device__ __forceinline__ void axpy32(f32x2 (&acc)[16], const float w, const u32x4 r0, const u32x4 r1) {
    const f32x2 ww = {w, w};
#pragma unroll
    for (int q = 0; q < 4; ++q) { acc[2 * q] = __builtin_elementwise_fma(ww, cvt8(r0[q], false), acc[2 * q]); acc[2 * q + 1] = __builtin_elementwise_fma(ww, cvt8(r0[q], true), acc[2 * q + 1]); }
#pragma unroll
    for (int q = 0; q < 4; ++q) { acc[8 + 2 * q] = __builtin_elementwise_fma(ww, cvt8(r1[q], false), acc[8 + 2 * q]); acc[8 + 2 * q + 1] = __builtin_elementwise_fma(ww, cvt8(r1[q], true), acc[8 + 2 * q + 1]); }
}
__device__ __forceinline__ void dma_row(const unsigned char* TAB, int e, LAS unsigned char* slot, int lane) {
    const unsigned char* g = TAB + (size_t)e * 2048 + lane * 16;
    __builtin_amdgcn_global_load_lds((const unsigned*)g, (LAS unsigned*)slot, 16, 0, 0);
    __builtin_amdgcn_global_load_lds((const unsigned*)(g + 1024), (LAS unsigned*)(slot + 1024), 16, 0, 0);
}
struct RowPipe {
    const unsigned char* TAB; LAS unsigned char* ring; LAS const unsigned short* eord; int lane, N, m, cs; u32x4 c0, c1; int ev;
    __device__ __forceinline__ int e_at(int r) const { return __builtin_amdgcn_readlane(ev, r & 63); }
    __device__ __forceinline__ void start() {
        m = 0; cs = 0; ev = (int)eord[lane];
        if (N == 0) return;
#pragma unroll
        for (int r = 0; r < RING; ++r) dma_row(TAB, e_at(r), ring + r * 2048, lane);
        asm volatile("s_waitcnt vmcnt(%0)" :: "n"(2 * (RING - 1)) : "memory");
        c0 = *(LAS const u32x4*)(ring + lane * 16); c1 = *(LAS const u32x4*)(ring + 1024 + lane * 16);
    }
    __device__ __forceinline__ void next(u32x4& r0, u32x4& r1) {
        r0 = c0; r1 = c1;
        asm volatile("s_waitcnt lgkmcnt(0)" ::: "memory");
        const int nx = m + RING; const int ns = (cs + 1 == RING) ? 0 : cs + 1;
        if (nx < N) { if ((nx & 63) == 0) ev = (int)eord[nx + lane]; dma_row(TAB, e_at(nx), ring + cs * 2048, lane); asm volatile("s_waitcnt vmcnt(%0)" :: "n"(2 * (RING - 1)) : "memory"); }
        else asm volatile("s_waitcnt vmcnt(0)" ::: "memory");
        LAS const unsigned char* sl = ring + ns * 2048 + lane * 16; c0 = *(LAS const u32x4*)sl; c1 = *(LAS const u32x4*)(sl + 1024);
        ++m; cs = ns;
    }
};
__device__ __forceinline__ float dpp_f(float v, const int ctrl_sel) {
    const int x = __float_as_int(v); int r;
    if (ctrl_sel == 0) r = __builtin_amdgcn_update_dpp(x, x, 0xB1, 0xF, 0xF, false);
    else if (ctrl_sel == 1) r = __builtin_amdgcn_update_dpp(x, x, 0x4E, 0xF, 0xF, false);
    else if (ctrl_sel == 2) r = __builtin_amdgcn_update_dpp(x, x, 0x124, 0xF, 0xF, false);
    else r = __builtin_amdgcn_update_dpp(x, x, 0x128, 0xF, 0xF, false);
    return __int_as_float(r);
}
__device__ __forceinline__ float reduce4(float p0, float p1, float p2, float p3, int lane) {
    const bool u1 = lane & 1, u2 = lane & 2;
    const float q0 = (u1 ? p1 : p0) + dpp_f(u1 ? p0 : p1, 0);
    const float q1 = (u1 ? p3 : p2) + dpp_f(u1 ? p2 : p3, 0);
    float d = (u2 ? q1 : q0) + dpp_f(u2 ? q0 : q1, 1);
    d += dpp_f(d, 2); d += dpp_f(d, 3);
    { auto rr = __builtin_amdgcn_permlane16_swap(__float_as_uint(d), __float_as_uint(d), false, false); d = __uint_as_float(rr[0]) + __uint_as_float(rr[1]); }
    { auto rr = __builtin_amdgcn_permlane32_swap(__float_as_uint(d), __float_as_uint(d), false, false); d = __uint_as_float(rr[0]) + __uint_as_float(rr[1]); }
    return d;
}
__device__ __forceinline__ void useg(const f32x2 (&h)[16], RowPipe& P, LAS float* sga, int i0, int i1, int lane) {
    for (int i = i0; i < i1; i += 4) {
        const int cnt = i1 - i; int ii = i + (lane & 3); ii = ii < i1 ? ii : i1 - 1; const float gate = sga[ii];
        u32x4 r0, r1; float p0, p1 = 0.f, p2 = 0.f, p3 = 0.f;
        P.next(r0, r1); p0 = dot32(h, r0, r1);
        if (cnt > 1) { P.next(r0, r1); p1 = dot32(h, r0, r1); }
        if (cnt > 2) { P.next(r0, r1); p2 = dot32(h, r0, r1); }
        if (cnt > 3) { P.next(r0, r1); p3 = dot32(h, r0, r1); }
        const float dot = reduce4(p0, p1, p2, p3, lane);
        if (lane < 4 && lane < cnt) sga[i + lane] = gelu_as(dot * (1.0f / USCALE)) * gate * (1.0f / VSCALE);
    }
}
__device__ __forceinline__ void vseg(f32x2 (&acc)[16], RowPipe& P, LAS const float* sga, int i0, int i1, int lane) {
    for (int i = i0; i < i1; i += 4) {
        const int cnt = i1 - i; int ii = i + (lane & 3); ii = ii < i1 ? ii : i1 - 1; const float my_w = sga[ii];
        const float w0 = __uint_as_float(__builtin_amdgcn_readlane(__float_as_uint(my_w), 0)), w1 = __uint_as_float(__builtin_amdgcn_readlane(__float_as_uint(my_w), 1));
        const float w2 = __uint_as_float(__builtin_amdgcn_readlane(__float_as_uint(my_w), 2)), w3 = __uint_as_float(__builtin_amdgcn_readlane(__float_as_uint(my_w), 3));
        u32x4 r0, r1;
        P.next(r0, r1); axpy32(acc, w0, r0, r1);
        if (cnt > 1) { P.next(r0, r1); axpy32(acc, w1, r0, r1); }
        if (cnt > 2) { P.next(r0, r1); axpy32(acc, w2, r0, r1); }
        if (cnt > 3) { P.next(r0, r1); axpy32(acc, w3, r0, r1); }
    }
}
__device__ __forceinline__ void load_h(f32x2 (&h)[16], const bf16* HF, int tok, int lane) {
#pragma unroll
    for (int j = 0; j < 2; ++j) { const u32x4 a = *(const u32x4*)(HF + (size_t)tok * DM + j * 1024 + lane * 16), b = *(const u32x4*)(HF + (size_t)tok * DM + j * 1024 + lane * 16 + 8);
#pragma unroll
        for (int q = 0; q < 4; ++q) { h[j * 8 + q] = (f32x2){bflo(a[q]), bfhi(a[q])}; h[j * 8 + 4 + q] = (f32x2){bflo(b[q]), bfhi(b[q])}; } }
}
__device__ __forceinline__ float ln2_stage_a(f32x2 (&acc)[16], int tok, float* X1, const float* mr, int lane) {
    float* x1 = X1 + (size_t)tok * DM; float s = 0.f;
#pragma unroll
    for (int j = 0; j < 2; ++j)
#pragma unroll
        for (int q = 0; q < 4; ++q) { const int c = j * 1024 + lane * 16 + q * 4; const f32x4 xa = *(const f32x4*)(x1 + c), ga = *(const f32x4*)(mr + 5 * DM + c);
            const f32x2 a0 = acc[j * 8 + 2 * q], a1 = acc[j * 8 + 2 * q + 1];
            const f32x4 v = (f32x4){ALPHA * xa[0] + ga[0] * a0.x, ALPHA * xa[1] + ga[1] * a0.y, ALPHA * xa[2] + ga[2] * a1.x, ALPHA * xa[3] + ga[3] * a1.y};
            s += (v[0] + v[1]) + (v[2] + v[3]); *(f32x4*)(x1 + c) = v; asm volatile("" ::: "memory"); }
    return wave_sum(s) * (1.0f / DM);
}
__device__ __forceinline__ void ln2_stage_b(int tok, float mean, const float* X1, const float* mn, const float* g2, const float* b2, float* outp, bf16* Hnext, int lane) {
    const float* x1 = X1 + (size_t)tok * DM; f32x4 v[8]; float q2 = 0.f;
#pragma unroll
    for (int j = 0; j < 2; ++j)
#pragma unroll
        for (int q = 0; q < 4; ++q) { v[j * 4 + q] = *(const f32x4*)(x1 + j * 1024 + lane * 16 + q * 4) - mean; const f32x4 d = v[j * 4 + q]; q2 += (d[0] * d[0] + d[1] * d[1]) + (d[2] * d[2] + d[3] * d[3]); }
    const float rstd = rsqrtf(wave_sum(q2) * (1.0f / DM) + LN_EPS);
#pragma unroll
    for (int j = 0; j < 2; ++j)
#pragma unroll
        for (int q = 0; q < 4; ++q) { const int c = j * 1024 + lane * 16 + q * 4; const f32x4 y = v[j * 4 + q] * rstd * *(const f32x4*)(g2 + c) + *(const f32x4*)(b2 + c);
            *(f32x4*)(outp + (size_t)tok * DM + c) = y;
            if (Hnext) { const f32x4 z = y * (*(const f32x4*)(mn + DM + c) + 1.0f) + *(const f32x4*)(mn + c);
                u32x2 o; o.x = pk2(z[0], z[1]); o.y = pk2(z[2], z[3]); *(u32x2*)(Hnext + (size_t)tok * DM + c) = o; }
            asm volatile("" ::: "memory"); }
}
}

__device__ __forceinline__ void pexp8_phase(const Frame& F, KA A, int l, int ntok, const bf16* HF, float* outp, bf16* Hnext) {
    using namespace px;
    const int lane = F.lane;
    const unsigned char* PU8 = (const unsigned char*)(F.ws + WS_PU) + (size_t)l * 16384 * DM; const unsigned char* PV8 = (const unsigned char*)(F.ws + WS_PV) + (size_t)l * 16384 * DM;
    const int* EIDX = (const int*)(F.ws + WS_EIDX); const float* EG = (const float*)(F.ws + WS_EG);
    float* X1 = (float*)(F.ws + WS_UREG); const float* mod = (const float*)(F.ws + WS_MOD);
    const float* g2 = G(A.in.ln2_g) + l * DM; const float* b2 = G(A.in.ln2_b) + l * DM;
    LAS unsigned char* wl = F.lds + RING_OFF + F.wave * L_WAVE;
    const int NXD = (F.G % 8 == 0) ? 8 : 1, WPX = (F.G / NXD) * NWAVES, xcd = F.vcu / (F.G / NXD), wv = (F.vcu % (F.G / NXD)) * NWAVES + F.wave;
    const int TPX = ntok / NXD, npass = (TPX + WPX * TS - 1) / (WPX * TS), TPP = (TPX + npass - 1) / npass;
    for (int pass = 0; pass < npass; ++pass) {
        const int pbase = xcd * TPX + pass * TPP, pend = (pbase + TPP < (xcd + 1) * TPX) ? pbase + TPP : (xcd + 1) * TPX;
        int tok[TS];
#pragma unroll
        for (int s = 0; s < TS; ++s) { const int t = pbase + s * WPX + wv; tok[s] = t < pend ? t : -1; }
#pragma unroll
        for (int s = 0; s < TS; ++s) {
            LAS int* off = (LAS int*)(wl + L_OFF) + s * 20;
#ifndef NO_SORT
            if (tok[s] >= 0) sort_token(EIDX, EG, tok[s], (LAS unsigned short*)(wl + L_SE) + s * 128, (LAS float*)(wl + L_SG) + s * 128, off, lane);
            else
#endif
            if (lane <= NCH) off[lane] = 0;
        }
        LDS_WAIT(); asm volatile("" ::: "memory");
        LAS unsigned short* eord = (LAS unsigned short*)(wl + L_EORD); LAS unsigned char* ring = wl + L_RING;
        int N = 0;
        for (int c = 0; c < NCH; ++c) {
#pragma unroll
            for (int s = 0; s < TS; ++s) { LAS const int* off = (LAS const int*)(wl + L_OFF) + s * 20; LAS const unsigned short* se = (LAS const unsigned short*)(wl + L_SE) + s * 128;
                const int i0 = __builtin_amdgcn_readfirstlane(off[c]), len = __builtin_amdgcn_readfirstlane(off[c + 1]) - i0;
                for (int k = lane; k < len; k += 64) eord[N + k] = se[i0 + k];
                N += len; }
        }
        LDS_WAIT(); asm volatile("s_waitcnt vmcnt(0)" ::: "memory");
        LAS float* sga = (LAS float*)(wl + L_SG);
#ifndef NO_US
        {
            f32x2 h[TS][16];
#pragma unroll
            for (int s = 0; s < TS; ++s) { if (tok[s] >= 0) load_h(h[s], HF, tok[s], lane); else {
#pragma unroll
                for (int k = 0; k < 16; ++k) h[s][k] = (f32x2){0.f, 0.f}; } }
            asm volatile("s_waitcnt vmcnt(0)" ::: "memory");
            RowPipe P; P.TAB = PU8; P.ring = ring; P.eord = eord; P.lane = lane; P.N = N; P.start();
            for (int c = 0; c < NCH; ++c) {
#pragma unroll
                for (int s = 0; s < TS; ++s) { LAS const int* off = (LAS const int*)(wl + L_OFF) + s * 20;
                    const int i0 = __builtin_amdgcn_readfirstlane(off[c]), i1 = __builtin_amdgcn_readfirstlane(off[c + 1]);
                    useg(h[s], P, sga + s * 128, i0, i1, lane); }
            }
        }
#endif
        LDS_WAIT(); asm volatile("s_waitcnt vmcnt(0)" ::: "memory");
        {
            f32x2 acc[TS][16];
#pragma unroll
            for (int s = 0; s < TS; ++s)
#pragma unroll
                for (int k = 0; k < 16; ++k) acc[s][k] = (f32x2){0.f, 0.f};
            RowPipe P; P.TAB = PV8; P.ring = ring; P.eord = eord; P.lane = lane; P.N = N; P.start();
            for (int c = 0; c < NCH; ++c) {
#pragma unroll
                for (int s = 0; s < TS; ++s) { LAS const int* off = (LAS const int*)(wl + L_OFF) + s * 20;
                    const int i0 = __builtin_amdgcn_readfirstlane(off[c]), i1 = __builtin_amdgcn_readfirstlane(off[c + 1]);
                    vseg(acc[s], P, sga + s * 128, i0, i1, lane); }
            }
            asm volatile("s_waitcnt vmcnt(0)" ::: "memory");
            float mean[TS];
#pragma unroll
            for (int s = 0; s < TS; ++s) { mean[s] = 0.f; if (tok[s] >= 0) { const int bidx = tok[s] < ML ? (tok[s] >> 12) : 4;
                mean[s] = ln2_stage_a(acc[s], tok[s], X1, mod + ((size_t)l * 5 + bidx) * MODW, lane); } }
            asm volatile("s_waitcnt vmcnt(0)" ::: "memory");
#pragma unroll 1
            for (int s = 0; s < TS; ++s) { const int t = s == 0 ? tok[0] : (s == 1 ? tok[1] : (s == 2 ? tok[2] : tok[TS - 1])); const float mu = s == 0 ? mean[0] : (s == 1 ? mean[1] : (s == 2 ? mean[2] : mean[TS - 1]));
                if (t >= 0) { const int bidx = t < ML ? (t >> 12) : 4;
                    ln2_stage_b(t, mu, X1, mod + ((size_t)(l + 1 < DEPTH ? l + 1 : l) * 5 + bidx) * MODW, g2, b2, outp, Hnext, lane); } }
        }
        LDS_WAIT(); asm volatile("" ::: "memory");
    }
}
__device__ __forceinline__ float gelu_exact(float v) { return 0.5f * v * (1.0f + erff(v * 0.70710678118654752f)); }
__device__ __forceinline__ float reduce16(float (&p)[16], int lane) {
    float q[8], r[4], s[2];
    { const bool up = lane & 1;
#pragma unroll
      for (int k = 0; k < 8; ++k) { const float send = up ? p[2 * k] : p[2 * k + 1], keep = up ? p[2 * k + 1] : p[2 * k]; q[k] = keep + __shfl_xor(send, 1); } }
    { const bool up = lane & 2;
#pragma unroll
      for (int k = 0; k < 4; ++k) { const float send = up ? q[2 * k] : q[2 * k + 1], keep = up ? q[2 * k + 1] : q[2 * k]; r[k] = keep + __shfl_xor(send, 2); } }
    { const bool up = lane & 4;
#pragma unroll
      for (int k = 0; k < 2; ++k) { const float send = up ? r[2 * k] : r[2 * k + 1], keep = up ? r[2 * k + 1] : r[2 * k]; s[k] = keep + __shfl_xor(send, 4); } }
    float t;
    { const bool up = lane & 8; const float send = up ? s[0] : s[1], keep = up ? s[1] : s[0]; t = keep + __shfl_xor(send, 8); }
    t += __shfl_xor(t, 16); t += __shfl_xor(t, 32);
    return t;
}
__device__ __forceinline__ void pexp_phase(const Frame& F, KA A, int l, int ntok, const bf16* HF, float* outp, bf16* Hnext) {
    const int gw = F.vcu * NWAVES + F.wave, NGW = F.G * NWAVES, lane = F.lane;
    const bf16* PU = (const bf16*)(F.ws + WS_PU) + (size_t)l * 16384 * DM; const bf16* PV = (const bf16*)(F.ws + WS_PV) + (size_t)l * 16384 * DM;
    const int* EIDX = (const int*)(F.ws + WS_EIDX); const float* EG = (const float*)(F.ws + WS_EG);
    const float* X1 = (const float*)(F.ws + WS_UREG); const float* mod = (const float*)(F.ws + WS_MOD);
    const float* g2 = G(A.in.ln2_g) + l * DM; const float* b2 = G(A.in.ln2_b) + l * DM;
    for (int tok = gw; tok < ntok; tok += NGW) {
        float h[32], acc[32];
#pragma unroll
        for (int j = 0; j < 4; ++j) { const bf16x8 v = *(const bf16x8*)(HF + (size_t)tok * DM + j * 512 + lane * 8);
#pragma unroll
            for (int e = 0; e < 8; ++e) { h[j * 8 + e] = bf2f((unsigned short)v[e]); acc[j * 8 + e] = 0.f; } }
#pragma unroll 1
        for (int sb = 0; sb < 32; ++sb) {
            const int my_e = EIDX[(size_t)tok * 128 + sb * 4 + (lane & 3)]; const float my_g = EG[(size_t)tok * 128 + sb * 4 + (lane & 3)];
            const int e0 = __builtin_amdgcn_readlane(my_e, 0), e1 = __builtin_amdgcn_readlane(my_e, 1), e2 = __builtin_amdgcn_readlane(my_e, 2), e3 = __builtin_amdgcn_readlane(my_e, 3);
            float part[4];
#pragma unroll
            for (int i = 0; i < 4; ++i) {
                const int e = i == 0 ? e0 : (i == 1 ? e1 : (i == 2 ? e2 : e3)); const bf16* ur = PU + (size_t)e * DM + lane * 8; float d = 0.f;
#pragma unroll
                for (int j = 0; j < 4; ++j) { const u32x4 w = *(const u32x4*)(ur + j * 512);
                    d += h[j * 8 + 0] * bflo(w.x) + h[j * 8 + 1] * bfhi(w.x) + h[j * 8 + 2] * bflo(w.y) + h[j * 8 + 3] * bfhi(w.y)
                       + h[j * 8 + 4] * bflo(w.z) + h[j * 8 + 5] * bfhi(w.z) + h[j * 8 + 6] * bflo(w.w) + h[j * 8 + 7] * bfhi(w.w); }
                part[i] = d;
            }
            float dot;
            { const bool u1 = lane & 1, u2 = lane & 2;
              const float q0 = (u1 ? part[1] : part[0]) + __shfl_xor(u1 ? part[0] : part[1], 1);
              const float q1 = (u1 ? part[3] : part[2]) + __shfl_xor(u1 ? part[2] : part[3], 1);
              dot = (u2 ? q1 : q0) + __shfl_xor(u2 ? q0 : q1, 2);
              dot += __shfl_xor(dot, 4); dot += __shfl_xor(dot, 8); dot += __shfl_xor(dot, 16); dot += __shfl_xor(dot, 32); }
            const float act = gelu_exact(dot) * my_g;
#pragma unroll
            for (int i = 0; i < 4; ++i) {
                const int e = i == 0 ? e0 : (i == 1 ? e1 : (i == 2 ? e2 : e3)); const float w = __uint_as_float(__builtin_amdgcn_readlane(__float_as_uint(act), i));
                const bf16* vr = PV + (size_t)e * DM + lane * 8;
#pragma unroll
                for (int j = 0; j < 4; ++j) { const u32x4 x = *(const u32x4*)(vr + j * 512);
                    acc[j * 8 + 0] += w * bflo(x.x); acc[j * 8 + 1] += w * bfhi(x.x); acc[j * 8 + 2] += w * bflo(x.y); acc[j * 8 + 3] += w * bfhi(x.y);
                    acc[j * 8 + 4] += w * bflo(x.z); acc[j * 8 + 5] += w * bfhi(x.z); acc[j * 8 + 6] += w * bflo(x.w); acc[j * 8 + 7] += w * bfhi(x.w); }
            }
        }
        const int bidx = tok < ML ? (tok >> 12) : 4;
        const float* mr = mod + ((size_t)l * 5 + bidx) * MODW; const float* x1 = X1 + (size_t)tok * DM;
        float s = 0.f;
#pragma unroll
        for (int j = 0; j < 4; ++j) { const int c = j * 512 + lane * 8;
            const f32x4 xa = *(const f32x4*)(x1 + c), xb = *(const f32x4*)(x1 + c + 4), ga = *(const f32x4*)(mr + 5 * DM + c), gb = *(const f32x4*)(mr + 5 * DM + c + 4);
#pragma unroll
            for (int e = 0; e < 4; ++e) { acc[j * 8 + e] = ALPHA * xa[e] + ga[e] * acc[j * 8 + e]; acc[j * 8 + 4 + e] = ALPHA * xb[e] + gb[e] * acc[j * 8 + 4 + e]; s += acc[j * 8 + e] + acc[j * 8 + 4 + e]; } }
        const float mean = wave_sum(s) * (1.0f / DM); float q = 0.f;
#pragma unroll
        for (int k = 0; k < 32; ++k) { acc[k] -= mean; q += acc[k] * acc[k]; }
        const float rstd = rsqrtf(wave_sum(q) * (1.0f / DM) + LN_EPS);
        const float* mn = mod + ((size_t)(l + 1 < DEPTH ? l + 1 : l) * 5 + bidx) * MODW;
#pragma unroll
        for (int j = 0; j < 4; ++j) { const int c = j * 512 + lane * 8;
            const f32x4 ga = *(const f32x4*)(g2 + c), gb = *(const f32x4*)(g2 + c + 4), ba = *(const f32x4*)(b2 + c), bb = *(const f32x4*)(b2 + c + 4);
            f32x4 ya, yb;
#pragma unroll
            for (int e = 0; e < 4; ++e) { ya[e] = acc[j * 8 + e] * rstd * ga[e] + ba[e]; yb[e] = acc[j * 8 + 4 + e] * rstd * gb[e] + bb[e]; }
            *(f32x4*)(outp + (size_t)tok * DM + c) = ya; *(f32x4*)(outp + (size_t)tok * DM + c + 4) = yb;
            if (Hnext) { const f32x4 sa = *(const f32x4*)(mn + DM + c), sb = *(const f32x4*)(mn + DM + c + 4), ha = *(const f32x4*)(mn + c), hb = *(const f32x4*)(mn + c + 4);
                const f32x4 za = ya * (sa + 1.0f) + ha, zb = yb * (sb + 1.0f) + hb;
                u32x4 o; o.x = pk2(za[0], za[1]); o.y = pk2(za[2], za[3]); o.z = pk2(zb[0], zb[1]); o.w = pk2(zb[2], zb[3]);
                *(u32x4*)(Hnext + (size_t)tok * DM + c) = o; }
        }
    }
}

#ifndef SD_A
#define SD_A 1
#endif
#ifndef SD_D
#define SD_D 1
#endif
#ifndef SD_B
#define SD_B 2
#endif
#ifndef SD_C
#define SD_C 1
#endif
#ifndef ATT_MASK
#define ATT_MASK 15
#endif
template <int TYPE> __device__ __forceinline__ att::Args make_att_args(const Frame& F, KA A, int l, int idx, bool ctxq) {
    const bf16* U = (const bf16*)(F.ws + WS_UREG); const bf16* QK = (const bf16*)(F.ws + WS_QKVA); bf16* O = (bf16*)(F.ws + WS_OQP);
    constexpr int NH = (TYPE == 2) ? 8 : 4;
    int b, h, qb;
    if (ctxq) { b = idx / NH; h = idx % NH; qb = 0; } else { b = idx / (NH * 16); h = (idx >> 4) % NH; qb = idx & 15; }
    const int row = ctxq ? ML + b * NCTX : b * SEQ + qb * 256;
    att::Args a{};
    a.ldo = DM; a.qpos0 = qb * 256;
    if (ctxq) { a.n0 = 4; a.row0 = ML + b * NCTX; a.n1 = 0; a.row1 = 0; }
    if constexpr (TYPE == 0) {
        a.Q = QK + (size_t)row * QW + QA_Q + h * 192; a.ldq = QW; a.KV = QK; a.ld = QW; a.kc0 = QA_KV + h * 256; a.kc1 = QA_KR; a.vc = QA_KV + h * 256 + 128;
        a.O = O + (size_t)row * DM + h * 128; a.C = A_SCALE * LOG2E; a.thr = 8.0f / A_SCALE; a.qrope = ctxq ? 0 : 1;
        if (!ctxq) { a.n0 = 64; a.row0 = b * SEQ; a.n1 = 4; a.row1 = ML + b * NCTX; }
    } else if constexpr (TYPE == 1) {
        const int kvh = h >> 1;
        a.Q = U + (size_t)row * UW + U_DQ + h * 128; a.ldq = UW; a.KV = U; a.ld = UW; a.kc0 = U_DK + kvh * 128; a.kc1 = 0; a.vc = U_DV + kvh * 128;
        a.O = O + (size_t)row * DM + 1536 + h * 128; a.C = D_SCALE * LOG2E; a.thr = 8.0f / D_SCALE;
        if (!ctxq) { a.n0 = 64; a.row0 = b * SEQ; a.n1 = 4; a.row1 = ML + b * NCTX; }
    } else if constexpr (TYPE == 2) {
        const int kvh = h >> 2;
        a.Q = U + (size_t)row * UW + U_BQ + h * 64; a.ldq = UW; a.KV = U; a.ld = UW; a.kc0 = U_BK + kvh * 64; a.kc1 = 0; a.vc = U_BV + kvh * 64;
        a.O = O + (size_t)row * DM + 512 + h * 64; a.C = B_SCALE * LOG2E; a.thr = 8.0f / B_SCALE; a.has_sink = 1; a.sinkl2 = G(A.in.b_sink)[l * 8 + h] * LOG2E;
        if (!ctxq) { int ws = qb * 256 - 128; ws = ws < 0 ? 0 : ws; int we = qb * 256 + 384; we = we > SEQ ? SEQ : we;
            a.n0 = 4; a.row0 = ML + b * NCTX; a.n1 = (we - ws) / 64; a.row1 = b * SEQ + ws; a.wpos0 = ws; }
    } else {
        a.Q = U + (size_t)row * UW + U_CQQ + h * 128; a.ldq = UW; a.KV = U; a.ld = UW; a.kc0 = U_CK + h * 128; a.kc1 = 0; a.vc = U_CV + h * 128;
        a.O = O + (size_t)row * DM + 1024 + h * 128; a.C = C_SCALE * LOG2E; a.thr = 8.0f / C_SCALE;
        a.T = (const float*)(F.ws + WS_CTAB) + (size_t)((l * 4 + h) * 15) * 4096;
        if (!ctxq) { const int r0 = qb * 4; int kr0 = r0 - 4; kr0 = kr0 < 0 ? 0 : (kr0 > 56 ? 56 : kr0); int ke = r0 + 3 - 4; ke = ke < 0 ? 0 : (ke > 56 ? 56 : ke); ke += 7; const int nr = ke - kr0 + 1;
            a.n0 = 4; a.row0 = ML + b * NCTX; a.n1 = nr + (nr & 1); a.row1 = b * SEQ + kr0 * 64; a.r0 = r0; a.kr0 = kr0; }
    }
    return a;
}
#define AF() Frame F = F0; asm volatile("" : "+v"(F.tid), "+v"(F.lane), "+s"(F.wave), "+s"(F.vcu), "+s"(F.G), "+s"(F.ws), "+s"(F.lds)); LAS char* lds = (LAS char*)(F.lds + RING_OFF); const int v = F.vcu
__device__ __forceinline__ void att_phase(const Frame& F0, int l) {
    if (F0.vcu >= 256) return;
    const bool cx = (l + 1 < DEPTH);
    if (ATT_MASK & 1) { AF(); KA A = *kargs(); const int n = 1 + ((cx && v < 16) ? 1 : 0);
        for (int k = 0; k < n; ++k) { const att::Args a = make_att_args<0>(F, A, l, k ? v : v, k != 0); att::attn_unit<192, 128, 0, SD_A>(a, lds, F.tid); } }
    if (ATT_MASK & 2) { AF(); KA A = *kargs(); const int n = 1 + ((cx && v >= 16 && v < 32) ? 1 : 0);
        for (int k = 0; k < n; ++k) { const att::Args a = make_att_args<1>(F, A, l, k ? v - 16 : v, k != 0); att::attn_unit<128, 128, 0, SD_D>(a, lds, F.tid); } }
    if (ATT_MASK & 4) { AF(); KA A = *kargs(); const int n = 2 + ((cx && v >= 48 && v < 80) ? 1 : 0);
        for (int k = 0; k < n; ++k) { const att::Args a = make_att_args<2>(F, A, l, k == 2 ? v - 48 : 2 * v + k, k == 2); att::attn_unit<64, 64, 1, SD_B>(a, lds, F.tid); } }
    if (ATT_MASK & 8) { AF(); KA A = *kargs(); const int n = 1 + ((cx && v >= 32 && v < 48) ? 1 : 0);
        for (int k = 0; k < n; ++k) { const att::Args a = make_att_args<3>(F, A, l, k ? v - 32 : v, k != 0); att::attn_unit<128, 128, 2, SD_C>(a, lds, F.tid); } }
}

constexpr int N_PHASES = 3 + 10 * DEPTH;
#ifndef MK_N_LAUNCHES
#define MK_N_LAUNCHES 1
#endif
__global__ void __launch_bounds__(NWAVES * 64, 2) mk_fwd(Args args) {
    extern __shared__ __attribute__((aligned(16))) unsigned char lds_raw[];
    Frame F;
    F.lds = (LAS unsigned char*)lds_raw; F.tid = threadIdx.x; F.lane = F.tid & 63; F.wave = __builtin_amdgcn_readfirstlane(F.tid >> 6);
    F.G = gridDim.x; { const int bx = blockIdx.x; F.vcu = (F.G % 8 == 0) ? (bx % 8) * (F.G / 8) + bx / 8 : bx; }
    GAS unsigned char* ws; int lo, hi, li;
    { KAP ap = kargs(); ws = (GAS unsigned char*)ap->ws; lo = ap->ph_lo; hi = ap->ph_hi; li = ap->li; }
    F.ws = ws;
    for (int u = F.tid; u < (LDS_BYTES - LDSCTL_OFF) / 4; u += NWAVES * 64) ((LAS unsigned*)(F.lds + LDSCTL_OFF))[u] = 0u;
    __syncthreads();
    volatile LAS unsigned* MISC = (volatile LAS unsigned*)(F.lds + MISC_OFF);
    XcdBarrier bar = xcd_barrier_post((unsigned*)(ws + WS_CTL) + CW_BAR + li * XCD_BAR_WORDS, MISC + 8);
#ifndef PHASE_MASK
#define PHASE_MASK 0x1fff
#endif
#define INR(k) (lo <= (k) && (k) < hi)
#define IN(k) ((((PHASE_MASK) >> ((k) < 3 ? (k) : 3 + ((k) - 3) % 10)) & 1) && INR(k))
#define SEAM(k) do { if (INR(k) && INR((k) + 1)) xcd_barrier(bar); } while (0)
#ifndef PROBE_DUP
#define PROBE_DUP 0
#endif
#ifndef PROBE_REP
#define PROBE_REP 1
#endif
#define KIND(k) ((k) < 3 ? (k) : 3 + ((k) - 3) % 10)
#define REP(k) for (int rep_ = 0, nrep_ = 1 + ((((PROBE_DUP) >> KIND(k)) & 1) ? PROBE_REP : 0); rep_ < nrep_; ++rep_, (rep_ < nrep_ ? xcd_barrier(bar) : (void)0))
#define PF() Frame Fp = F; int bx = blockIdx.x; asm volatile("" : "+v"(Fp.tid), "+v"(Fp.lane), "+s"(Fp.wave), "+s"(Fp.vcu), "+s"(Fp.G), "+s"(Fp.ws), "+s"(Fp.lds), "+s"(bx)); GAS unsigned char* ws = Fp.ws; (void)bx; (void)ws
    if (IN(0)) REP(0) { PF(); p0_prologue(Fp, *kargs()); } SEAM(0);
    if (IN(1)) REP(1) { PF(); p1_modreduce(Fp, *kargs()); } SEAM(1);
    if (IN(2)) REP(2) { PF(); p2_modulate0(Fp, *kargs()); } SEAM(2);
    for (int l = 0; l < DEPTH; ++l) {
        const int pb = 3 + 10 * l; const bool last = (l + 1 == DEPTH);
        const size_t offH = (l & 1) ? WS_BUFB : WS_BUFA, offS = (l & 1) ? WS_BUFA : WS_BUFB;
        const int nPl = last ? 64 : 68, nrows = last ? ML : MT;
        if (IN(pb + 0)) REP(pb + 0) {
            PF(); bf16* Hb = (bf16*)(ws + offH);
            pg8::PlainSched S{(const char*)Hb, (const char*)((bf16*)(ws + WS_WIN) + (size_t)l * UW * DM), DM, DM, DM, 68, 16, Fp.G, bx};
            pg8::EpiBf16 E{(bf16*)(ws + WS_UREG), UW};
            pg8::gemm_phase(Fp.lds + RING_OFF, S, E, DM, DM, Fp.tid);
        } SEAM(pb + 0);
        if (IN(pb + 1)) REP(pb + 1) { PF(); enorm_phase(Fp, *kargs(), l); } SEAM(pb + 1);
        if (IN(pb + 2)) REP(pb + 2) { PF();
            pg8::PlainSched S{(const char*)(ws + WS_UREG), (const char*)((bf16*)(ws + WS_WUP) + (size_t)l * 1792 * 512), UW, 512, 512, 68, 7, Fp.G, bx};
            pg8::EpiBf16 E{(bf16*)(ws + WS_QKVA), QW};
            pg8::gemm_phase(Fp.lds + RING_OFF, S, E, UW, 512, Fp.tid);
        } SEAM(pb + 2);
        if (IN(pb + 3)) REP(pb + 3) { PF(); att_phase(Fp, l); } SEAM(pb + 3);
        if (IN(pb + 4)) REP(pb + 4) { PF(); bf16* Hb = (bf16*)(ws + offH); bf16* Sb = (bf16*)(ws + offS);
            pg8::MergeSched S{(const char*)Hb, (const char*)(ws + WS_OQP), (const char*)((bf16*)(ws + WS_WC) + (size_t)l * 4 * DM * 2560), nPl, Fp.G, bx};
            pg8::EpiMerge E{Sb, G(kargs()->in.b_gate) + (size_t)l * 4 * DM, (char*)(ws + WS_STASH) + (size_t)bx * STASH_WG, (char*)(ws + WS_P) + (size_t)bx * P_WG, Fp.tid};
            pg8::gemm_phase(Fp.lds + RING_OFF, S, E, DM, 2560, Fp.tid);
        } SEAM(pb + 4);
        if (IN(pb + 5)) REP(pb + 5) { PF(); bf16* Sb = (bf16*)(ws + offS);
            pg8::PlainSched S{(const char*)Sb, (const char*)((bf16*)(ws + WS_WO) + (size_t)l * DM * DM), DM, DM, DM, nPl, 8, Fp.G, bx};
            KAP ap = kargs();
            pg8::EpiOut E{(float*)(ws + WS_UREG), l == 0 ? G(ap->in.x) : (const float*)(ws + WS_XRES), l == 0 ? G(ap->in.ctx) : (const float*)(ws + WS_XRES) + (size_t)ML * DM,
                          (const float*)(ws + WS_MOD) + (size_t)l * 5 * MODW, ALPHA};
            pg8::gemm_phase(Fp.lds + RING_OFF, S, E, DM, DM, Fp.tid);
        } SEAM(pb + 5);
        if (IN(pb + 6)) REP(pb + 6) { PF(); ln1_phase(Fp, *kargs(), l, nrows, (bf16*)(ws + offH)); } SEAM(pb + 6);
        if (IN(pb + 7)) REP(pb + 7) { PF(); bf16* Hb = (bf16*)(ws + offH);
            pg8::PlainSched S{(const char*)Hb, (const char*)((bf16*)(ws + WS_WPQ) + (size_t)l * DM * DM), DM, DM, DM, nPl, 8, Fp.G, bx};
            pg8::EpiBf16 E{(bf16*)(ws + WS_OQP), DM};
            pg8::gemm_phase(Fp.lds + RING_OFF, S, E, DM, DM, Fp.tid);
        } SEAM(pb + 7);
        if (IN(pb + 8)) REP(pb + 8) { PF();
            const int gw = Fp.vcu * NWAVES + Fp.wave, NGW = Fp.G * NWAVES;
            LAS unsigned short* tblw = (LAS unsigned short*)(Fp.lds + RING_OFF) + Fp.wave * (64 * 66);
            for (int it = gw; it < (nrows / 32) * 8; it += NGW)
                peer::topk_item((const bf16*)(ws + WS_OQP), (const bf16*)(ws + WS_SUBK) + (size_t)l * 8 * 2 * 128 * 128, (int*)(ws + WS_EIDX), (float*)(ws + WS_EG), (it >> 3) * 32, it & 7, tblw, Fp.lane);
        } SEAM(pb + 8);
        if (IN(pb + 9)) REP(pb + 9) { PF(); pexp8_phase(Fp, *kargs(), l, nrows, (bf16*)(ws + offH), last ? G(kargs()->out) : (float*)(ws + WS_XRES), last ? nullptr : (bf16*)(ws + offS)); } SEAM(pb + 9);
    }
#undef IN
#undef INR
#undef SEAM
}

extern "C" void kernel_launch(void* const* d_in, const int* in_sizes, int n_in, void* d_out, int out_size, void* d_ws, size_t ws_size, hipStream_t stream) {
    static int grid = 0;
    if (grid == 0) {
        if (n_in != 27 || out_size != ML * DM || ws_size < WS_END) { fprintf(stderr, "kernel_launch: unexpected shapes (n_in %d out %d ws %zu, need ws >= %zu)\n", n_in, out_size, ws_size, (size_t)WS_END); grid = -1; return; }
        int dev = 0, cus = 0, per_cu = 0;
        if (hipGetDevice(&dev) != hipSuccess || hipDeviceGetAttribute(&cus, hipDeviceAttributeMultiprocessorCount, dev) != hipSuccess) { grid = -1; return; }
        if (hipFuncSetAttribute((const void*)mk_fwd, hipFuncAttributeMaxDynamicSharedMemorySize, LDS_BYTES) != hipSuccess) { fprintf(stderr, "kernel_launch: hipFuncSetAttribute failed\n"); grid = -1; return; }
        if (hipOccupancyMaxActiveBlocksPerMultiprocessor(&per_cu, (const void*)mk_fwd, NWAVES * 64, LDS_BYTES) != hipSuccess || per_cu < 1) { fprintf(stderr, "kernel_launch: occupancy query says %d\n", per_cu); }
        (void)hipGetLastError();
        grid = cus < 256 ? cus : 256;
    }
    if (grid < 0) return;
    (void)hipMemsetAsync((char*)d_ws + WS_CTL, 0, CTL_ZERO_BYTES, stream);
    Args a{};
    const float** ip = (const float**)&a.in;
    for (int i = 0; i < 27; ++i) ip[i] = (const float*)d_in[i];
    a.out = (float*)d_out; a.ws = (unsigned char*)d_ws;
    for (int li = 0; li < MK_N_LAUNCHES; ++li) {
        a.ph_lo = (MK_N_LAUNCHES == 1) ? 0 : li; a.ph_hi = (MK_N_LAUNCHES == 1) ? N_PHASES : li + 1; a.li = li; a.pad = 0;
        hipLaunchKernelGGL(mk_fwd, dim3(grid), dim3(NWAVES * 64), LDS_BYTES, stream, a);
    }
}
```

```cpp
#include <hip/hip_runtime.h>
#include <cstdio>
#include <cstdint>
#include <utility>

#define GAS __attribute__((address_space(1)))
#define LAS __attribute__((address_space(3)))
typedef unsigned short bf16;
typedef short bf16x8 __attribute__((ext_vector_type(8)));
typedef short s16x4 __attribute__((ext_vector_type(4)));
typedef float f32x2 __attribute__((ext_vector_type(2)));
typedef float f32x4 __attribute__((ext_vector_type(4)));
typedef float f32x16 __attribute__((ext_vector_type(16)));
typedef unsigned u32x2 __attribute__((ext_vector_type(2)));
typedef unsigned u32x4 __attribute__((ext_vector_type(4)));
typedef GAS unsigned gu32;

__device__ __forceinline__ unsigned cvt_pk_bf16(float lo, float hi) { unsigned r; asm volatile("v_cvt_pk_bf16_f32 %0, %1, %2" : "=v"(r) : "v"(lo), "v"(hi)); return r; }
__device__ __forceinline__ float bf2f(unsigned short b) { return __uint_as_float(((unsigned)b) << 16); }
__device__ __forceinline__ float bflo(unsigned w) { return __uint_as_float(w << 16); }
__device__ __forceinline__ float bfhi(unsigned w) { return __uint_as_float(w & 0xffff0000u); }
__device__ __forceinline__ unsigned short f2bf(float f) { return (unsigned short)(cvt_pk_bf16(f, 0.f) & 0xffffu); }

namespace pg8 {
constexpr int BM = 256, BK = 64, HALF = 128, HTB = HALF * BK * 2  , STAGE_BYTES = 8 * HTB, NXCD = 8, WGM = 8;
__host__ __device__ __forceinline__ int lds_byte(int r, int c) { const int st = (r >> 4) * 2 + (c >> 5), rr = r & 15, cc = c & 31, ob = rr * 64 + cc * 2; return st * 1024 + (ob ^ (((ob >> 9) & 1) << 5)); }
__host__ __device__ __forceinline__ void stage_rc(int b, int& R, int& C) { const int st = b / 1024, sb = b % 1024, swz = sb ^ (((sb >> 9) & 1) << 5); R = (st >> 1) * 16 + swz / 64; C = (st & 1) * 32 + (swz % 64) / 2; }
__host__ __device__ __forceinline__ int perm32(int rho) { const int n = rho >> 4, i = rho & 15; return 8 * (i >> 2) + 4 * n + (i & 3); }

struct Unit { int pm, pn, z; };

__device__ __forceinline__ void tile_of(int L, int nM, int nN, int& pm, int& pn) {
    const int nwg = nM * nN; int wgid = L;
    { const int q = nwg / NXCD, r = nwg % NXCD, xcd = wgid % NXCD, off = wgid / NXCD; wgid = (xcd < r ? xcd * (q + 1) : r * (q + 1) + (xcd - r) * q) + off; }
    const int nig = WGM * nN, gid = wgid / nig, fm = gid * WGM, gsz = (nM - fm) < WGM ? (nM - fm) : WGM;
    pm = fm + ((wgid % nig) % gsz); pn = (wgid % nig) / gsz;
}
struct PlainSched {
    const char* A; const char* B; int lda, ldb, K, nM, nN, G, c;
    __device__ __forceinline__ bool next(int i, Unit& u) const { const long L = (long)i * G + c; if (L >= (long)nM * nN) return false; tile_of((int)L, nM, nN, u.pm, u.pn); u.z = 0; return true; }
    __device__ __forceinline__ void ptrs(const Unit& u, const char*& a, const char*& b, int& nt) const { a = A + (size_t)u.pm * BM * lda * 2; b = B + (size_t)u.pn * BM * ldb * 2; nt = K / BK; }
};
struct MergeSched {
    const char* H; const char* O; const char* W; int nM, G, c;
    __device__ __forceinline__ bool next(int i, Unit& u) const { const long L = (long)(i >> 3) * G + c; if (L >= (long)nM * 8) return false; tile_of((int)L, nM, 8, u.pm, u.pn); u.z = i & 7; return true; }
    __device__ __forceinline__ void ptrs(const Unit& u, const char*& a, const char*& b, int& nt) const {
        const int z = u.z >> 1, kind = u.z & 1;
        a = (kind ? H : O + (size_t)z * 512 * 2) + (size_t)u.pm * BM * 2048 * 2;
        b = W + ((size_t)z * 2048 * 2560 + (size_t)u.pn * BM * 2560 + (kind ? 0 : 2048)) * 2;
        nt = kind ? 32 : 8;
    }
};

struct EpiBf16 {
    static constexpr bool PERM = true;
    bf16* O; int ldc;
    __device__ __forceinline__ void operator()(const f32x4 (&acc)[2][2][4][2], const Unit& u, int wr, int wc, int fr, int fq) const {
        const int row0 = u.pm * BM + wr * 64 + fr, col0 = u.pn * BM + wc * 32 + 8 * fq;
#pragma unroll
        for (int ai = 0; ai < 2; ++ai)
#pragma unroll
            for (int m = 0; m < 4; ++m) { bf16* rowp = O + (size_t)(row0 + ai * HALF + m * 16) * ldc + col0;
#pragma unroll
                for (int bj = 0; bj < 2; ++bj) { const f32x4 v0 = acc[ai][bj][m][0], v1 = acc[ai][bj][m][1];
                    u32x4 w; w.x = cvt_pk_bf16(v0[0], v0[1]); w.y = cvt_pk_bf16(v0[2], v0[3]); w.z = cvt_pk_bf16(v1[0], v1[1]); w.w = cvt_pk_bf16(v1[2], v1[3]);
                    *(u32x4*)(rowp + bj * HALF) = w; } }
    }
};
struct EpiMerge {
    static constexpr bool PERM = true;
    bf16* S; const float* bgate; char* stash; char* P; int tid;
    __device__ __forceinline__ void operator()(const f32x4 (&acc)[2][2][4][2], const Unit& u, int wr, int wc, int fr, int fq) const {
        const int z = u.z >> 1, kind = u.z & 1; int tl = tid; asm volatile("" : "+v"(tl));
        GAS char* sp = (GAS char*)stash + (size_t)tl * 16;
        if (kind == 0) {
#pragma unroll
            for (int ai = 0; ai < 2; ++ai)
#pragma unroll
                for (int m = 0; m < 4; ++m)
#pragma unroll
                    for (int bj = 0; bj < 2; ++bj) { const f32x4 v0 = acc[ai][bj][m][0], v1 = acc[ai][bj][m][1];
                        u32x4 w; w.x = cvt_pk_bf16(v0[0], v0[1]); w.y = cvt_pk_bf16(v0[2], v0[3]); w.z = cvt_pk_bf16(v1[0], v1[1]); w.w = cvt_pk_bf16(v1[2], v1[3]);
                        *(GAS u32x4*)sp = w; sp += 8192; asm volatile("" : "+v"(sp)); }
            return;
        }
        GAS char* pq = (GAS char*)P + (size_t)tl * 16;
        const int row0 = u.pm * BM + wr * 64 + fr, col0 = u.pn * BM + wc * 32 + 8 * fq;
        const float* bz = bgate + z * 2048 + col0;
        f32x4 bv[2][2];
#pragma unroll
        for (int bj = 0; bj < 2; ++bj)
#pragma unroll
            for (int n = 0; n < 2; ++n) bv[bj][n] = *(const f32x4*)(bz + bj * HALF + 4 * n);
        GAS bf16* rowp = (GAS bf16*)S + (size_t)row0 * 2048 + col0;
#pragma unroll
        for (int ai = 0; ai < 2; ++ai)
#pragma unroll
            for (int m = 0; m < 4; ++m) {
#pragma unroll
                for (int bj = 0; bj < 2; ++bj) {
                    const u32x4 sw = *(const GAS u32x4*)sp; sp += 8192; asm volatile("" : "+v"(sp));
                    f32x4 v0 = acc[ai][bj][m][0] + bv[bj][0], v1 = acc[ai][bj][m][1] + bv[bj][1];
#pragma unroll
                    for (int j = 0; j < 4; ++j) { v0[j] = __builtin_amdgcn_rcpf(1.0f + __builtin_amdgcn_exp2f(-1.4426950408889634f * v0[j])); v1[j] = __builtin_amdgcn_rcpf(1.0f + __builtin_amdgcn_exp2f(-1.4426950408889634f * v1[j])); }
                    v0[0] *= bflo(sw.x); v0[1] *= bfhi(sw.x); v0[2] *= bflo(sw.y); v0[3] *= bfhi(sw.y);
                    v1[0] *= bflo(sw.z); v1[1] *= bfhi(sw.z); v1[2] *= bflo(sw.w); v1[3] *= bfhi(sw.w);
                    if (z > 0) { v0 += *(const GAS f32x4*)pq; v1 += *(const GAS f32x4*)(pq + 8192); }
                    if (z < 3) { *(GAS f32x4*)pq = v0; *(GAS f32x4*)(pq + 8192) = v1; }
                    else { u32x4 w; w.x = cvt_pk_bf16(v0[0], v0[1]); w.y = cvt_pk_bf16(v0[2], v0[3]); w.z = cvt_pk_bf16(v1[0], v1[1]); w.w = cvt_pk_bf16(v1[2], v1[3]);
                        *(GAS u32x4*)(rowp + bj * HALF) = w; }
                    pq += 16384; asm volatile("" : "+v"(pq));
                }
                rowp += (m == 3 ? (size_t)(HALF - 48) : (size_t)16) * 2048; asm volatile("" : "+v"(rowp));
                asm volatile("" ::: "memory"); }
    }
};
struct EpiOut {
    static constexpr bool PERM = false;
    float* Y; const float* xlat; const float* xctx; const float* mod_l; float alpha;
    __device__ __forceinline__ void operator()(const f32x4 (&acc)[2][2][4][2], const Unit& u, int wr, int wc, int fr, int fq) const {
        const int row0 = u.pm * BM + wr * 64 + fr, col0 = u.pn * BM + wc * 32 + 4 * fq;
        const float* xb = (u.pm < 64) ? xlat + (size_t)row0 * 2048 : xctx + (size_t)(row0 - 16384) * 2048;
        const float* ga = mod_l + (size_t)((u.pm < 64) ? (u.pm >> 4) : 4) * 12288 + 2 * 2048 + col0;
        f32x4 gv[2][2];
#pragma unroll
        for (int bj = 0; bj < 2; ++bj)
#pragma unroll
            for (int n = 0; n < 2; ++n) gv[bj][n] = *(const f32x4*)(ga + bj * HALF + n * 16);
#pragma unroll
        for (int ai = 0; ai < 2; ++ai)
#pragma unroll
            for (int m = 0; m < 4; ++m) { const size_t ro = (size_t)(ai * HALF + m * 16) * 2048 + col0; float* yp = Y + (size_t)row0 * 2048 + ro;
#pragma unroll
                for (int bj = 0; bj < 2; ++bj)
#pragma unroll
                    for (int n = 0; n < 2; ++n) { const f32x4 xv = *(const f32x4*)(xb + ro + bj * HALF + n * 16); *(f32x4*)(yp + bj * HALF + n * 16) = xv * alpha + gv[bj][n] * acc[ai][bj][m][n]; } }
    }
};

template <class Epi, class Sched>
__device__ __forceinline__ void gemm_phase(LAS unsigned char* lds, const Sched& S, const Epi& E, const int lda, const int ldb, const int tid) {
    const int wid = __builtin_amdgcn_readfirstlane(tid >> 6), lane = tid & 63, wr = wid >> 2, wc = wid & 3, fr = lane & 15, fq = lane >> 4;
    unsigned voffA[2], voffB[2];
#pragma unroll
    for (int i = 0; i < 2; ++i) { int R, C; stage_rc(tid * 16 + i * 8192, R, C); const int Rb = Epi::PERM ? ((R & ~31) + perm32(R & 31)) : R;
        voffA[i] = (unsigned)(R * lda + C) * 2u; voffB[i] = (unsigned)(Rb * ldb + C) * 2u; }
    const size_t kstep = (size_t)(BK * 2);
    const size_t hstepA = (size_t)HALF * lda * 2, hstepB = (size_t)HALF * ldb * 2;
    const unsigned ldsw = (unsigned)wid * 1024u;
    const int aoff = lds_byte(wr * 64 + fr, fq * 8), boff = lds_byte(wc * 32 + fr, fq * 8);
#define PG8_SA(b, h) (((b) * 2 + (h)) * HTB)
#define PG8_SB(b, h) ((4 + (b) * 2 + (h)) * HTB)
#define PG8_STAGE(bufoff, gbase, voff) do { _Pragma("unroll") for (int _i = 0; _i < 2; ++_i) \
        __builtin_amdgcn_global_load_lds((const unsigned*)((const char*)(gbase) + (voff)[_i]), (LAS unsigned*)(lds + (bufoff) + ldsw + _i * 8192), 16, 0, 0); } while (0)
#define PG8_LDA(dst, b, h) do { _Pragma("unroll") for (int m = 0; m < 4; ++m) _Pragma("unroll") for (int k = 0; k < 2; ++k) dst[m][k] = *(const LAS bf16x8*)(lds + PG8_SA(b, h) + aoff + m * 2048 + k * 1024); } while (0)
#define PG8_LDB(dst, b, h) do { _Pragma("unroll") for (int n = 0; n < 2; ++n) _Pragma("unroll") for (int k = 0; k < 2; ++k) dst[n][k] = *(const LAS bf16x8*)(lds + PG8_SB(b, h) + boff + n * 2048 + k * 1024); } while (0)
#define PG8_MMA(ai, bj, At, Bt) do { __builtin_amdgcn_s_setprio(1); _Pragma("unroll") for (int m = 0; m < 4; ++m) _Pragma("unroll") for (int n = 0; n < 2; ++n) _Pragma("unroll") for (int k = 0; k < 2; ++k) \
        acc[ai][bj][m][n] = __builtin_amdgcn_mfma_f32_16x16x32_bf16(Bt[n][k], At[m][k], acc[ai][bj][m][n], 0, 0, 0); __builtin_amdgcn_s_setprio(0); } while (0)
#define PG8_WAIT_V(n) asm volatile("s_waitcnt vmcnt(" #n ")" ::: "memory")
#define PG8_WAIT_L(n) asm volatile("s_waitcnt lgkmcnt(" #n ")" ::: "memory")
#define PG8_BAR __builtin_amdgcn_s_barrier()
#define PG8_SCHED __builtin_amdgcn_sched_barrier(0)
    Unit cur, nxt; int ui = 0;
    if (!S.next(0, cur)) return;
    f32x4 acc[2][2][4][2];
#pragma unroll
    for (int a = 0; a < 2; ++a)
#pragma unroll
        for (int b = 0; b < 2; ++b)
#pragma unroll
            for (int m = 0; m < 4; ++m)
#pragma unroll
                for (int n = 0; n < 2; ++n) acc[a][b][m][n] = (f32x4){0.f, 0.f, 0.f, 0.f};
    bf16x8 At[4][2], B0[2][2], B1[2][2];
    const char* cA; const char* cB; int nt; S.ptrs(cur, cA, cB, nt);
    PG8_STAGE(PG8_SB(0, 0), cB, voffB); PG8_STAGE(PG8_SB(0, 1), cB + hstepB, voffB); PG8_STAGE(PG8_SA(0, 0), cA, voffA); PG8_STAGE(PG8_SA(0, 1), cA + hstepA, voffA);
    if (wr == 1) PG8_BAR;
    PG8_WAIT_V(2); PG8_BAR;
    PG8_STAGE(PG8_SB(1, 0), cB + kstep, voffB); PG8_STAGE(PG8_SA(1, 0), cA + kstep, voffA); PG8_STAGE(PG8_SB(1, 1), cB + hstepB + kstep, voffB);
    PG8_WAIT_V(6); PG8_BAR;
    for (;;) {
        const bool has_next = S.next(ui + 1, nxt);
        const char* nA = cA; const char* nB = cB; int nnt = nt; if (has_next) S.ptrs(nxt, nA, nB, nnt);
        for (int t = 0; t < nt; t += 2) {
            const bool last = (t == nt - 2);
            const char* a1 = cA + (size_t)(t + 1) * kstep;
            const char* a2 = last ? nA : cA + (size_t)(t + 2) * kstep; const char* b2 = last ? nB : cB + (size_t)(t + 2) * kstep;
            const char* a3 = a2 + kstep; const char* b3 = b2 + kstep;
            PG8_LDB(B0, 0, 0); PG8_LDB(B1, 0, 1); PG8_SCHED; PG8_LDA(At, 0, 0); PG8_STAGE(PG8_SA(1, 1), a1 + hstepA, voffA);
            PG8_WAIT_V(8); PG8_WAIT_L(0); PG8_BAR; PG8_MMA(0, 0, At, B0); PG8_MMA(0, 1, At, B1); PG8_BAR; PG8_SCHED;
            PG8_LDA(At, 0, 1); PG8_STAGE(PG8_SB(0, 0), b2, voffB); PG8_STAGE(PG8_SB(0, 1), b2 + hstepB, voffB); PG8_STAGE(PG8_SA(0, 0), a2, voffA);
            PG8_WAIT_V(8); PG8_WAIT_L(0); PG8_BAR; PG8_MMA(1, 0, At, B0); PG8_MMA(1, 1, At, B1); PG8_BAR; PG8_SCHED;
            PG8_LDB(B0, 1, 0); PG8_LDB(B1, 1, 1); PG8_SCHED; PG8_LDA(At, 1, 0); PG8_STAGE(PG8_SA(0, 1), a2 + hstepA, voffA);
            PG8_WAIT_V(8); PG8_WAIT_L(0); PG8_BAR; PG8_MMA(0, 0, At, B0); PG8_MMA(0, 1, At, B1); PG8_BAR; PG8_SCHED;
            PG8_LDA(At, 1, 1); PG8_STAGE(PG8_SB(1, 0), b3, voffB); PG8_STAGE(PG8_SB(1, 1), b3 + hstepB, voffB); PG8_STAGE(PG8_SA(1, 0), a3, voffA);
            PG8_WAIT_V(8); PG8_WAIT_L(0); PG8_BAR; PG8_MMA(1, 0, At, B0); PG8_MMA(1, 1, At, B1); PG8_BAR; PG8_SCHED;
        }
        if (wr == 0) PG8_BAR;
        E(acc, cur, wr, wc, fr, fq);
        if (!has_next) break;
#pragma unroll
        for (int a = 0; a < 2; ++a)
#pragma unroll
            for (int b = 0; b < 2; ++b)
#pragma unroll
                for (int m = 0; m < 4; ++m)
#pragma unroll
                    for (int n = 0; n < 2; ++n) acc[a][b][m][n] = (f32x4){0.f, 0.f, 0.f, 0.f};
        cur = nxt; cA = nA; cB = nB; nt = nnt; ++ui;
        if (wr == 1) PG8_BAR;
    }
    PG8_WAIT_V(0);
    PG8_BAR;
#undef PG8_SA
#undef PG8_SB
#undef PG8_STAGE
#undef PG8_LDA
#undef PG8_LDB
#undef PG8_MMA
#undef PG8_WAIT_V
#undef PG8_WAIT_L
#undef PG8_BAR
#undef PG8_SCHED
}
}
namespace att {
constexpr int NW = 8, QBLK = 32, KVBLK = 64;
#define SBAR() __builtin_amdgcn_sched_barrier(0)
__device__ __forceinline__ int crow(int r, int hi) { return (r & 3) + 8 * (r >> 2) + 4 * hi; }
__device__ __forceinline__ unsigned cvtpk(float lo, float hi) { unsigned r; asm volatile("v_cvt_pk_bf16_f32 %0, %1, %2" : "=v"(r) : "v"(lo), "v"(hi)); return r; }

struct Args {
    const bf16* Q; int ldq;
    const bf16* KV; int ld;
    int kc0, kc1, vc;
    bf16* O; int ldo;
    int n0, n1, row0, row1;
    float C, thr;
    int qrope, qpos0;
    float sinkl2; int has_sink;
    int wpos0;
    const float* T; int r0, kr0;
};

__device__ __forceinline__ void partialSM(f32x16& p0, f32x16& p1, float& m_reg, float& mn, float& alpha, const float C, const float thr) {
    float pmax = p0[0];
#pragma unroll
    for (int r = 1; r < 16; ++r) pmax = fmaxf(pmax, p0[r]);
#pragma unroll
    for (int r = 0; r < 16; ++r) pmax = fmaxf(pmax, p1[r]);
    { auto rr = __builtin_amdgcn_permlane32_swap(__float_as_uint(pmax), __float_as_uint(pmax), false, false);
      pmax = fmaxf(__uint_as_float(rr[0]), __uint_as_float(rr[1])); }
    if (__builtin_expect(__all(pmax - m_reg <= thr), 1)) { mn = m_reg; alpha = 1.f; }
    else { mn = fmaxf(m_reg, pmax); alpha = __builtin_amdgcn_exp2f((m_reg - mn) * C); m_reg = mn; }
    const float mnC = -mn * C;
#pragma unroll
    for (int r = 0; r < 16; ++r) p0[r] = fmaf(p0[r], C, mnC);
#pragma unroll
    for (int r = 0; r < 16; ++r) p1[r] = fmaf(p1[r], C, mnC);
#pragma unroll
    for (int r = 0; r < 16; ++r) p0[r] = __builtin_amdgcn_exp2f(p0[r]);
}
__device__ __forceinline__ void finishSM(f32x16& p0, f32x16& p1, float alpha, float& l_reg, bf16x8& pa0, bf16x8& pa1, bf16x8& pa2, bf16x8& pa3) {
#pragma unroll
    for (int r = 0; r < 16; ++r) p1[r] = __builtin_amdgcn_exp2f(p1[r]);
    float ps = 0;
#pragma unroll
    for (int r = 0; r < 16; ++r) ps += p0[r];
#pragma unroll
    for (int r = 0; r < 16; ++r) ps += p1[r];
    { auto rr = __builtin_amdgcn_permlane32_swap(__float_as_uint(ps), __float_as_uint(ps), false, false);
      ps = __uint_as_float(rr[0]) + __uint_as_float(rr[1]); }
    l_reg = l_reg * alpha + ps;
#define PK4(P, BASE, OUT) do { unsigned a0 = cvtpk(P[BASE + 0], P[BASE + 1]), a1 = cvtpk(P[BASE + 2], P[BASE + 3]);   \
    unsigned b0 = cvtpk(P[BASE + 4], P[BASE + 5]), b1 = cvtpk(P[BASE + 6], P[BASE + 7]);                              \
    auto r0 = __builtin_amdgcn_permlane32_swap(a0, b0, false, false); auto r1 = __builtin_amdgcn_permlane32_swap(a1, b1, false, false); \
    u32x4 w = {r0[0], r1[0], r0[1], r1[1]}; OUT = *reinterpret_cast<bf16x8*>(&w); } while (0)
    PK4(p0, 0, pa0); PK4(p0, 8, pa1); PK4(p1, 0, pa2); PK4(p1, 8, pa3);
#undef PK4
}
template <int DK> __device__ __forceinline__ int kswz(int row, int ch) { return row * (DK * 2) + ((ch ^ (row & 7)) << 4); }
template <int DK, int QREG> __device__ __forceinline__ void qkt(f32x16& p0, f32x16& p1, const LAS char* Ks, const bf16x8* qr, const LAS char* qx, int r32, int hi) {
    p0 = f32x16{}; p1 = f32x16{};
#pragma unroll
    for (int d0 = 0; d0 < DK / 16; ++d0) { const int ch = d0 * 2 + hi;
        const bf16x8 b0 = *(const LAS bf16x8*)(Ks + kswz<DK>(r32, ch));
        const bf16x8 b1 = *(const LAS bf16x8*)(Ks + kswz<DK>(32 + r32, ch));
        bf16x8 q; if constexpr (true) { if (d0 < QREG) q = qr[d0 < QREG ? d0 : 0]; else q = *(const LAS bf16x8*)(qx + (d0 - QREG) * 1024); }
        p0 = __builtin_amdgcn_mfma_f32_32x32x16_bf16(b0, q, p0, 0, 0, 0);
        p1 = __builtin_amdgcn_mfma_f32_32x32x16_bf16(b1, q, p1, 0, 0, 0); }
}
template <int NCB> __device__ __forceinline__ int v_st(int k, int c) { const int kk = (k & ~0xC) | ((k & 4) << 1) | ((k & 8) >> 1); return ((kk >> 3) * NCB + (c >> 5)) * 512 + ((kk & 7) * 32 + (c & 31)) * 2; }
__device__ __forceinline__ int v_rd_base(int lane) { return ((lane & 3) << 3) | (((lane >> 2) & 3) << 6) | (((lane >> 4) & 1) << 5) | (((lane >> 5) & 1) << 8); }
template <int OFF> __device__ __forceinline__ s16x4 tr_read(int vb) { s16x4 r; asm volatile("ds_read_b64_tr_b16 %0, %1 offset:%2" : "=&v"(r) : "v"(vb), "i"(OFF) : "memory"); return r; }
template <int D0, int NCB> __device__ __forceinline__ void pv_one(f32x16& od, int vb, bf16x8 pa0, bf16x8 pa1, bf16x8 pa2, bf16x8 pa3) {
#define VOFF(ks, half) (D0 * 512 + (ks) * (2 * NCB * 512) + (half) * (NCB * 512))
    const s16x4 l0 = tr_read<VOFF(0, 0)>(vb), h0 = tr_read<VOFF(0, 1)>(vb), l1 = tr_read<VOFF(1, 0)>(vb), h1 = tr_read<VOFF(1, 1)>(vb);
    const s16x4 l2 = tr_read<VOFF(2, 0)>(vb), h2 = tr_read<VOFF(2, 1)>(vb), l3 = tr_read<VOFF(3, 0)>(vb), h3 = tr_read<VOFF(3, 1)>(vb);
#undef VOFF
    asm volatile("s_waitcnt lgkmcnt(0)" ::: "memory"); SBAR();
#define PK(L, H) (bf16x8){L[0], L[1], L[2], L[3], H[0], H[1], H[2], H[3]}
    od = __builtin_amdgcn_mfma_f32_32x32x16_bf16(pa0, PK(l0, h0), od, 0, 0, 0);
    od = __builtin_amdgcn_mfma_f32_32x32x16_bf16(pa1, PK(l1, h1), od, 0, 0, 0);
    od = __builtin_amdgcn_mfma_f32_32x32x16_bf16(pa2, PK(l2, h2), od, 0, 0, 0);
    od = __builtin_amdgcn_mfma_f32_32x32x16_bf16(pa3, PK(l3, h3), od, 0, 0, 0);
#undef PK
}
template <int NCB> __device__ __forceinline__ void pv_all(f32x16* o, int vb, bf16x8 pa0, bf16x8 pa1, bf16x8 pa2, bf16x8 pa3) {
    pv_one<0, NCB>(o[0], vb, pa0, pa1, pa2, pa3); pv_one<1, NCB>(o[1], vb, pa0, pa1, pa2, pa3);
    if constexpr (NCB == 4) { pv_one<2, NCB>(o[2], vb, pa0, pa1, pa2, pa3); pv_one<3, NCB>(o[3], vb, pa0, pa1, pa2, pa3); }
}

template <int MODE> __device__ __forceinline__ void apply_mask(f32x16& p0, f32x16& p1, const Args& a, int j, int wid, int r32, int hi) {
    if constexpr (MODE == 1) {
        if (j < a.n0) return;
        const int kp0 = a.wpos0 + 64 * (j - a.n0), qw0 = a.qpos0 + wid * 32;
        if (kp0 + 63 - qw0 <= 128 && qw0 + 31 - kp0 <= 128) return;
        const int dd0 = kp0 - (qw0 + r32) + 4 * hi + 128;
#pragma unroll
        for (int r = 0; r < 16; ++r) { const int dd = dd0 + (r & 3) + 8 * (r >> 2);
            p0[r] = ((unsigned)dd <= 256u) ? p0[r] : -1e30f; p1[r] = ((unsigned)(dd + 32) <= 256u) ? p1[r] : -1e30f; }
    } else if constexpr (MODE == 2) {
        if (j < a.n0) return;
        const int kr = a.kr0 + (j - a.n0), qr = a.r0 + (wid >> 1);
        int rs = qr - 4; rs = rs < 0 ? 0 : (rs > 56 ? 56 : rs);
        if (kr < rs || kr >= rs + 8) {
#pragma unroll
            for (int r = 0; r < 16; ++r) { p0[r] = -1e30f; p1[r] = -1e30f; }
            return; }
        const int dr = kr - qr + 7, qc = (wid & 1) * 32 + r32;
        const float* tb = a.T + ((size_t)(dr * 64 + qc)) * 64 + 4 * hi;
#pragma unroll
        for (int g = 0; g < 4; ++g) { const f32x4 t0 = *(const f32x4*)(tb + 8 * g), t1 = *(const f32x4*)(tb + 32 + 8 * g);
#pragma unroll
            for (int i = 0; i < 4; ++i) { p0[4 * g + i] += t0[i]; p1[4 * g + i] += t1[i]; }
            asm volatile("" ::: "memory"); }
    }
}

template <int DK, int DV, int MODE, int SDEPTH>
__device__ __forceinline__ void attn_unit(const Args& a, LAS char* lds, const int tid) {
    constexpr int NKC = DK / 8, NVC = DV / 8, KPT = DK / 64, VPT = DV / 64, NCB = DV / 32, ND0 = DK / 16, QREG = (ND0 > 8 ? 4 : ND0);
    constexpr int SHM_K = 64 * DK * 2, SHM_V = 64 * DV * 2;
    const int wid = __builtin_amdgcn_readfirstlane(tid >> 6), lane = tid & 63, r32 = lane & 31, hi = lane >> 5;
    LAS char* V_lds = lds; LAS char* K_lds = lds + 2 * SHM_V;
    LAS float* ws = (LAS float*)(lds + 2 * SHM_V + 2 * SHM_K) + wid * 64; LAS float* li_l = ws; LAS float* al_l = ws + 32;
    LAS char* qx = lds + 2 * SHM_V + 2 * SHM_K + NW * 256 + wid * ((ND0 - QREG) * 1024) + lane * 16;
    float m_reg = -1e30f, l_reg = 0; f32x16 o[NCB]; bf16x8 qr[ND0];
#pragma unroll
    for (int d = 0; d < NCB; ++d) o[d] = f32x16{};
    const bf16* Qw = a.Q + (long)(wid * QBLK + r32) * a.ldq + hi * 8;
#pragma unroll
    for (int d0 = 0; d0 < ND0; ++d0) qr[d0] = *(const bf16x8*)(Qw + d0 * 16);
    if constexpr (DK == 192) {
        if (a.qrope) {
            const int t = a.qpos0 + wid * QBLK + r32; const float prow = (float)(t >> 6), pcol = (float)(t & 63);
#pragma unroll
            for (int dd = 0; dd < 2; ++dd) {
                bf16x8 x1 = qr[8 + dd], x2 = qr[10 + dd]; const float pos = dd ? pcol : prow;
#pragma unroll
                for (int e = 0; e < 8; ++e) { const float inv = __builtin_amdgcn_exp2f(-(float)(hi * 8 + e) * (13.287712379549449f / 16.0f)); const float ang = pos * inv;
                    const float c = __cosf(ang), s = __sinf(ang); const float f1 = bf2f((unsigned short)x1[e]), f2 = bf2f((unsigned short)x2[e]);
                    x1[e] = (short)f2bf(f1 * c - f2 * s); x2[e] = (short)f2bf(f1 * s + f2 * c); }
                qr[8 + dd] = x1; qr[10 + dd] = x2; }
        }
#pragma unroll
        for (int d0 = QREG; d0 < ND0; ++d0) *(LAS bf16x8*)(qx + (d0 - QREG) * 1024) = qr[d0];
        asm volatile("s_waitcnt lgkmcnt(0)" ::: "memory");
    }
    int koff[KPT], klds[KPT], voff[VPT], vlds[VPT];
#pragma unroll
    for (int i = 0; i < KPT; ++i) { const int q = tid + 512 * i, row = q / NKC, ch = q % NKC; koff[i] = row * a.ld + (ch < 16 ? a.kc0 + 8 * ch : a.kc1 + 8 * (ch - 16)); klds[i] = kswz<DK>(row, ch); }
#pragma unroll
    for (int i = 0; i < VPT; ++i) { const int q = tid + 512 * i, row = q / NVC, ch = q % NVC; voff[i] = row * a.ld + a.vc + 8 * ch; vlds[i] = v_st<NCB>(row, 8 * ch); }
    const int vb0 = (int)(uintptr_t)V_lds + v_rd_base(lane);
    bf16x8 sk[SDEPTH][KPT], sv[SDEPTH][VPT];
    const int NT = a.n0 + a.n1;
#define TROW(j) ((j) < a.n0 ? a.row0 + 64 * (j) : a.row1 + 64 * ((j) - a.n0))
#define SLOAD(i, j) do { const bf16* _b = a.KV + (long)TROW(j) * a.ld; \
    _Pragma("unroll") for (int _k = 0; _k < VPT; ++_k) sv[i][_k] = *(const bf16x8*)(_b + voff[_k]); \
    _Pragma("unroll") for (int _k = 0; _k < KPT; ++_k) sk[i][_k] = *(const bf16x8*)(_b + koff[_k]); } while (0)
#define SWRITE(b, i) do { \
    _Pragma("unroll") for (int _k = 0; _k < VPT; ++_k) *(LAS bf16x8*)(V_lds + (b) * SHM_V + vlds[_k]) = sv[i][_k]; \
    _Pragma("unroll") for (int _k = 0; _k < KPT; ++_k) *(LAS bf16x8*)(K_lds + (b) * SHM_K + klds[_k]) = sk[i][_k]; } while (0)
#define SWAIT() do { if constexpr (SDEPTH == 2) asm volatile("s_waitcnt vmcnt(%0)" :: "n"(KPT + VPT) : "memory"); else asm volatile("s_waitcnt vmcnt(0)" ::: "memory"); } while (0)
#define RESC(al) do { if (__any((al) < 1.f)) { if (hi == 0) al_l[r32] = (al); asm volatile("s_waitcnt lgkmcnt(0)" ::: "memory"); \
    _Pragma("unroll") for (int d = 0; d < NCB; ++d) _Pragma("unroll") for (int r = 0; r < 16; ++r) o[d][r] *= al_l[crow(r, hi)]; } } while (0)
    f32x16 pA0, pA1, pB0, pB1; float mnA, mnB, alA, alB; bf16x8 pa0, pa1, pa2, pa3;
    constexpr int SE = 0, SO = SDEPTH - 1;
    SLOAD(SE, 0); asm volatile("s_waitcnt vmcnt(0)" ::: "memory"); SWRITE(0, SE); __syncthreads();
    qkt<DK, QREG>(pA0, pA1, K_lds, qr, qx, r32, hi); apply_mask<MODE>(pA0, pA1, a, 0, wid, r32, hi); partialSM(pA0, pA1, m_reg, mnA, alA, a.C, a.thr);
    SLOAD(SO, 1); if constexpr (SDEPTH == 2) { if (2 < NT) SLOAD(SE, 2); }
    SWAIT(); SWRITE(1, SO); __syncthreads();
    for (int j = 1; j + 1 < NT; j += 2) {
        SBAR(); qkt<DK, QREG>(pB0, pB1, K_lds + SHM_K, qr, qx, r32, hi);
        finishSM(pA0, pA1, alA, l_reg, pa0, pa1, pa2, pa3); SBAR();
        SLOAD(SO, j + SDEPTH); SBAR();
        pv_all<NCB>(o, vb0, pa0, pa1, pa2, pa3); if constexpr (MODE != 0) SBAR(); apply_mask<MODE>(pB0, pB1, a, j, wid, r32, hi); if constexpr (MODE != 0) SBAR(); partialSM(pB0, pB1, m_reg, mnB, alB, a.C, a.thr);
        __syncthreads(); SWAIT(); SWRITE(0, SE);
        RESC(alB); __syncthreads();
        SBAR(); qkt<DK, QREG>(pA0, pA1, K_lds, qr, qx, r32, hi);
        finishSM(pB0, pB1, alB, l_reg, pa0, pa1, pa2, pa3); SBAR();
        if (SDEPTH == 1 || j + 3 < NT) SLOAD(SE, j + 1 + SDEPTH); SBAR();
        pv_all<NCB>(o, vb0 + SHM_V, pa0, pa1, pa2, pa3); if constexpr (MODE != 0) SBAR(); apply_mask<MODE>(pA0, pA1, a, j + 1, wid, r32, hi); if constexpr (MODE != 0) SBAR(); partialSM(pA0, pA1, m_reg, mnA, alA, a.C, a.thr);
        __syncthreads(); SWAIT(); SWRITE(1, SO);
        RESC(alA); __syncthreads();
    }
    SBAR(); qkt<DK, QREG>(pB0, pB1, K_lds + SHM_K, qr, qx, r32, hi);
    finishSM(pA0, pA1, alA, l_reg, pa0, pa1, pa2, pa3); SBAR();
    pv_all<NCB>(o, vb0, pa0, pa1, pa2, pa3); if constexpr (MODE != 0) SBAR(); apply_mask<MODE>(pB0, pB1, a, NT - 1, wid, r32, hi); if constexpr (MODE != 0) SBAR(); partialSM(pB0, pB1, m_reg, mnB, alB, a.C, a.thr);
    __syncthreads(); RESC(alB);
    finishSM(pB0, pB1, alB, l_reg, pa0, pa1, pa2, pa3); SBAR();
    pv_all<NCB>(o, vb0 + SHM_V, pa0, pa1, pa2, pa3);
    if constexpr (MODE == 1) { if (a.has_sink) l_reg += __builtin_amdgcn_exp2f(a.sinkl2 - m_reg * a.C); }
    if (hi == 0) li_l[r32] = l_reg; asm volatile("s_waitcnt lgkmcnt(0)" ::: "memory");
    float rli[16];
#pragma unroll
    for (int r = 0; r < 16; ++r) rli[r] = __builtin_amdgcn_rcpf(li_l[crow(r, hi)]);
    bf16* Ow = a.O + (long)(wid * QBLK) * a.ldo;
#pragma unroll
    for (int r = 0; r < 16; ++r) { const int orow = crow(r, hi);
#pragma unroll
        for (int d0 = 0; d0 < NCB; ++d0) Ow[(long)orow * a.ldo + d0 * 32 + r32] = f2bf(o[d0][r] * rli[r]); }
    __syncthreads();
#undef TROW
#undef SLOAD
#undef SWRITE
#undef SWAIT
#undef RESC
}
#undef SBAR
}
constexpr int DM = 2048, NBATCH = 4, SEQ = 4096, NCTX = 256, DEPTH = 2;
constexpr int ML = NBATCH * SEQ, MC = NBATCH * NCTX, MT = ML + MC;
constexpr int INW = 3904, UW = 4096, QW = 1856;
constexpr int MODW = 6 * DM;
constexpr float LN_EPS = 1e-5f, RMS_EPS = 1e-6f;
constexpr float ALPHA = 1.4142135623730951f;
constexpr float LOG2E = 1.4426950408889634f;
constexpr float A_SCALE = 0.07216878364870323f, B_SCALE = 0.125f, C_SCALE = 0.08838834764831845f, D_SCALE = 0.08838834764831845f;
constexpr int U_CQ = 0, U_CKV = 384, U_KR = 512, U_BQ = 576, U_BK = 1088, U_BV = 1216, U_CQQ = 1344, U_CK = 1856, U_CV = 2368, U_DQ = 2880, U_DK = 3392, U_DV = 3648;
constexpr int QA_Q = 0, QA_KV = 768, QA_KR = 1792;

constexpr size_t MiB = 1u << 20;
constexpr size_t WS_CTL = 0, CTL_ZERO_BYTES = 1 * MiB;
constexpr size_t WS_MOD = 1 * MiB;
constexpr size_t WS_CTAB = 2 * MiB;
constexpr size_t WS_SUBK = 4 * MiB;
constexpr size_t WS_WUP = 5 * MiB;
constexpr size_t WS_WIN = 9 * MiB;
constexpr size_t WS_WC = 41 * MiB;
constexpr size_t WS_WO = 121 * MiB;
constexpr size_t WS_WPQ = 137 * MiB;
constexpr size_t WS_PU = 153 * MiB;
constexpr size_t WS_PV = 281 * MiB;
constexpr size_t WS_BUFA = 409 * MiB;
constexpr size_t WS_BUFB = 477 * MiB;
constexpr size_t WS_UREG = 545 * MiB;
constexpr size_t WS_QKVA = 681 * MiB;
constexpr size_t WS_OQP = 743 * MiB;
constexpr size_t WS_XRES = 811 * MiB;
constexpr size_t WS_EIDX = 947 * MiB;
constexpr size_t WS_EG = 956 * MiB;
constexpr size_t WS_MODP = 965 * MiB;
constexpr size_t WS_SCU = 973 * MiB, WS_SCV = WS_SCU + 2 * 16384 * 4;
constexpr size_t WS_DBG = 973 * MiB + 512 * 1024;
constexpr size_t WS_END = 974 * MiB;
constexpr size_t STASH_WG = 131072, P_WG = 262144, WS_STASH = WS_UREG, WS_P = WS_UREG + 32 * MiB;
constexpr int CW_TMO = 0, CW_BAR = 4096;

constexpr int NWAVES = 8;
constexpr int RING_OFF = 0, RING_BYTES = 155648;
constexpr int LDSCTL_OFF = RING_BYTES, MISC_OFF = LDSCTL_OFF + 320;
constexpr int LDS_BYTES = 157696;

#define RLX_AGENT __ATOMIC_RELAXED, __HIP_MEMORY_SCOPE_AGENT
#define LDS_WAIT() asm volatile("s_waitcnt lgkmcnt(0)" ::: "memory")
#define VM_WAIT() asm volatile("s_waitcnt vmcnt(0)" ::: "memory")

#define XB_TMO      128
#define XB_XCNT(j)  (256  + 64 * (j))
#define XB_XSUB(j)  (1280 + 64 * (j))
#define XB_XGEN(j)  (2304 + 64 * (j))
#define XB_TOP      3328
#define XB_TOPGEN   3392
#define XCD_BAR_WORDS 3456
#define XB_SPIN_CAP (1u << 22)
__device__ __forceinline__ unsigned xb_ld(unsigned* p)              { return __hip_atomic_load(p, __ATOMIC_RELAXED, __HIP_MEMORY_SCOPE_AGENT); }
__device__ __forceinline__ unsigned xb_add(unsigned* p, unsigned v) { return __hip_atomic_fetch_add(p, v, __ATOMIC_RELAXED, __HIP_MEMORY_SCOPE_AGENT); }
__device__ __forceinline__ unsigned xb_xcc_id() { return (unsigned)__builtin_amdgcn_s_getreg((3 << 11) | 20) & 0xFu; }
#define XB_SPIN(cond, bar) do { unsigned _sp = 0; while (cond) { __builtin_amdgcn_s_sleep(1); \
    if ((++_sp & 255u) == 0u) { if (xb_ld(&(bar)[XB_TMO])) break; if (_sp > XB_SPIN_CAP) { atomicAdd(&(bar)[XB_TMO], 1u); break; } } } } while (0)
struct XcdBarrier { unsigned* bar; unsigned x; volatile LAS unsigned* st; };
__device__ __forceinline__ XcdBarrier xcd_barrier_post(unsigned* bar, volatile LAS unsigned* st) {
    XcdBarrier b; b.bar = bar; b.x = xb_xcc_id(); b.st = st;
    if (threadIdx.x == 0) (void)xb_add(&bar[XB_XCNT(b.x)], 1u);
    return b;
}
__device__ __forceinline__ void xcd_barrier_complete(unsigned* bar, unsigned x, unsigned& nloc, unsigned& nx) {
    const unsigned G = gridDim.x * gridDim.y * gridDim.z;
    unsigned sum, cnt, mine, sp = 0u;
    for (;;) {
        sum = 0u; cnt = 0u; mine = 0u;
#pragma unroll
        for (unsigned j = 0; j < 16; ++j) { const unsigned c = xb_ld(&bar[XB_XCNT(j)]); sum += c; cnt += (c > 0u) ? 1u : 0u; mine = (j == x) ? c : mine; }
        if (sum == G) break;
        __builtin_amdgcn_s_sleep(1);
        if ((++sp & 255u) == 0u) { if (xb_ld(&bar[XB_TMO])) break; if (sp > XB_SPIN_CAP) { atomicAdd(&bar[XB_TMO], 1u); break; } }
    }
    nloc = mine > 0u ? mine : 1u; nx = cnt > 0u ? cnt : 1u;
}
__device__ __forceinline__ void xcd_barrier(const XcdBarrier& b) {
    asm volatile("s_waitcnt vmcnt(0)" ::: "memory");
    __syncthreads();
    if (threadIdx.x == 0) {
        unsigned* bar = b.bar;
        __builtin_amdgcn_s_waitcnt(0);
        unsigned nloc = b.st[0], nx = b.st[1];
        if (nloc == 0u) { xcd_barrier_complete(bar, b.x, nloc, nx); b.st[0] = nloc; b.st[1] = nx; }
        const unsigned old = xb_add(&bar[XB_XSUB(b.x)], 1u);
        const unsigned gen = old / nloc;
        if (old + 1u == (gen + 1u) * nloc) {
            __builtin_amdgcn_fence(__ATOMIC_RELEASE, "agent");
            asm volatile("s_waitcnt vmcnt(0)" ::: "memory");
            const unsigned og = xb_add(&bar[XB_TOP], 1u);
            const unsigned tg = og / nx;
            if (og + 1u == (tg + 1u) * nx) xb_add(&bar[XB_TOPGEN], 1u);
            else XB_SPIN(xb_ld(&bar[XB_TOPGEN]) == tg, bar);
            __builtin_amdgcn_fence(__ATOMIC_ACQUIRE, "agent");
            xb_add(&bar[XB_XGEN(b.x)], 1u);
            asm volatile("s_waitcnt vmcnt(0)" ::: "memory");
        } else {
            XB_SPIN(xb_ld(&bar[XB_XGEN(b.x)]) == gen, bar);
            __builtin_amdgcn_fence(__ATOMIC_ACQUIRE, "agent");
            asm volatile("s_waitcnt vmcnt(0)" ::: "memory");
        }
    }
    __syncthreads();
}

struct In {
    const float *x, *c, *ctx, *c_ctx, *w_ada, *b_ada, *w_in, *a_q_norm, *a_kv_norm, *a_w_uq, *a_w_ukv, *b_sink, *c_rpb, *d_q_norm, *d_k_norm,
                *w_branch, *w_gate, *b_gate, *w_out, *ln1_g, *ln1_b, *ln2_g, *ln2_b, *peer_w_q, *peer_sub_keys, *peer_u, *peer_v;
};
struct Args { In in; float* out; unsigned char* ws; int ph_lo, ph_hi, li, pad; };
struct Frame { LAS unsigned char* lds; int tid, lane, wave, vcu, G; GAS unsigned char* ws; };
template <class T> __device__ __forceinline__ T* G(T* p) { return (T*)(GAS T*)p; }
typedef const __attribute__((address_space(4))) Args& KA;
typedef const __attribute__((address_space(4))) Args* KAP;
__device__ __forceinline__ KAP kargs() { KAP p = (KAP)__builtin_amdgcn_kernarg_segment_ptr(); asm volatile("" : "+s"(p)); return p; }

__device__ __forceinline__ float wave_sum(float v) {
#pragma unroll
    for (int o = 1; o < 64; o <<= 1) v += __shfl_xor(v, o);
    return v;
}
__device__ __forceinline__ unsigned pk2(float lo, float hi) { return cvt_pk_bf16(lo, hi); }
__device__ __forceinline__ float silu_f(float v) { return v / (1.0f + __expf(-v)); }

__device__ __forceinline__ void p0_transpose_item(const float* W, int ldw, int nblk, bf16* dst, int dpitch, int row_off, int col_off, const float* gain, LAS float* scr, int item, int lane) {
    const int kb = item / nblk, nb = item % nblk, k0 = 64 * kb, n0 = 32 * nb;
#pragma unroll 8
    for (int i = 0; i < 32; ++i) { const int kk = 2 * i + (lane >> 5); float v = W[(size_t)(k0 + kk) * ldw + n0 + (lane & 31)]; if (gain) v *= gain[k0 + kk]; scr[kk * 33 + (lane & 31)] = v; }
    LDS_WAIT(); asm volatile("" ::: "memory");
    const int c = lane & 7;
#pragma unroll
    for (int j = 0; j < 4; ++j) { const int n = (lane >> 3) + 8 * j; const LAS float* s = scr + (8 * c) * 33 + n;
        u32x4 o; o.x = pk2(s[0 * 33], s[1 * 33]); o.y = pk2(s[2 * 33], s[3 * 33]); o.z = pk2(s[4 * 33], s[5 * 33]); o.w = pk2(s[6 * 33], s[7 * 33]);
        *(GAS u32x4*)(dst + (size_t)(row_off + n0 + n) * dpitch + col_off + k0 + 8 * c) = o; }
    LDS_WAIT(); asm volatile("" ::: "memory");
}
struct TJob { const float* W; int K, N; bf16* dst; int dpitch, row_off, col_off; const float* gain; };
__device__ __forceinline__ int tjob_get(KA A, int job, TJob& t) {
    const int l = job / 13, j = job % 13; GAS unsigned char* ws = (GAS unsigned char*)A.ws; t.gain = nullptr; t.row_off = 0; t.col_off = 0;
    if (j == 0) { t.W = G(A.in.w_in) + (size_t)l * DM * INW; t.K = DM; t.N = INW; t.dst = (bf16*)(ws + WS_WIN) + (size_t)l * UW * DM; t.dpitch = DM; }
    else if (j <= 4) { const int z = j - 1; t.W = G(A.in.w_gate) + ((size_t)l * 4 + z) * DM * DM; t.K = DM; t.N = DM; t.dst = (bf16*)(ws + WS_WC) + ((size_t)l * 4 + z) * DM * 2560; t.dpitch = 2560; }
    else if (j <= 8) { const int z = j - 5; t.W = G(A.in.w_branch) + ((size_t)l * 4 + z) * 512 * DM; t.K = 512; t.N = DM; t.dst = (bf16*)(ws + WS_WC) + ((size_t)l * 4 + z) * DM * 2560; t.dpitch = 2560; t.col_off = 2048; }
    else if (j == 9) { t.W = G(A.in.w_out) + (size_t)l * DM * DM; t.K = DM; t.N = DM; t.dst = (bf16*)(ws + WS_WO) + (size_t)l * DM * DM; t.dpitch = DM; }
    else if (j == 10) { t.W = G(A.in.peer_w_q) + (size_t)l * DM * DM; t.K = DM; t.N = DM; t.dst = (bf16*)(ws + WS_WPQ) + (size_t)l * DM * DM; t.dpitch = DM; }
    else if (j == 11) { t.W = G(A.in.a_w_uq) + (size_t)l * 384 * 768; t.K = 384; t.N = 768; t.dst = (bf16*)(ws + WS_WUP) + (size_t)l * 1792 * 512; t.dpitch = 512; t.gain = G(A.in.a_q_norm) + l * 384; }
    else { t.W = G(A.in.a_w_ukv) + (size_t)l * 128 * 1024; t.K = 128; t.N = 1024; t.dst = (bf16*)(ws + WS_WUP) + (size_t)l * 1792 * 512; t.dpitch = 512; t.row_off = 768; t.col_off = 384; t.gain = G(A.in.a_kv_norm) + l * 128; }
    return (t.K / 64) * (t.N / 32);
}
__device__ __forceinline__ void p0_prologue(const Frame& F, KA A) {
    GAS unsigned char* ws = F.ws;
    const int gw = F.vcu * NWAVES + F.wave, NGW = F.G * NWAVES;
    const long gt = (long)gw * 64 + F.lane, NGT = (long)NGW * 64;
    {
        float* modp = (float*)(ws + WS_MODP);
        for (int it = gw; it < 2 * 16 * 48; it += NGW) {
            const int l = it / 768, ks = (it % 768) / 48, cg = it % 48, n = cg * 256 + F.lane * 4;
            const float* w = G(A.in.w_ada) + ((size_t)l * DM + ks * 128) * MODW + n;
            f32x4 acc[5];
#pragma unroll
            for (int r = 0; r < 5; ++r) acc[r] = (f32x4){0.f, 0.f, 0.f, 0.f};
#pragma unroll 8
            for (int k = 0; k < 128; ++k) {
                const f32x4 wv = *(const f32x4*)(w + (size_t)k * MODW);
                const int kk = ks * 128 + k;
#pragma unroll
                for (int r = 0; r < 5; ++r) { const float cv = (r < 4) ? G(A.in.c)[r * DM + kk] : G(A.in.c_ctx)[kk]; acc[r] += wv * silu_f(cv); }
            }
#pragma unroll
            for (int r = 0; r < 5; ++r) *(f32x4*)(modp + (((size_t)ks * 2 + l) * 5 + r) * MODW + n) = acc[r];
        }
    }
    {
        LAS float* scr = (LAS float*)(F.lds + RING_OFF + F.wave * 16384);
        int base = 0;
        for (int job = 0; job < 26; ++job) {
            TJob t; const int ni = tjob_get(A, job, t);
            int first = gw - (base % NGW); if (first < 0) first += NGW;
            for (int i = first; i < ni; i += NGW) p0_transpose_item(t.W, t.N, t.N / 32, t.dst, t.dpitch, t.row_off, t.col_off, t.gain, scr, i, F.lane);
            base += ni;
        }
    }
    for (long i = gt; i < 2L * 192 * 2048 / 8; i += NGT) { const int l = (int)(i / (192 * 256)), r = (int)(i % (192 * 256)); *(u32x4*)((bf16*)(ws + WS_WIN) + ((size_t)l * UW + 3904) * DM + (size_t)r * 8) = (u32x4){0u, 0u, 0u, 0u}; }
    for (long i = gt; i < 2L * 768 * 16; i += NGT) { const int l = (int)(i / (768 * 16)), r = (int)(i % (768 * 16)), row = r / 16, c8 = r % 16; *(u32x4*)((bf16*)(ws + WS_WUP) + ((size_t)l * 1792 + row) * 512 + 384 + c8 * 8) = (u32x4){0u, 0u, 0u, 0u}; }
    for (long i = gt; i < 2L * 1024 * 48; i += NGT) { const int l = (int)(i / (1024 * 48)), r = (int)(i % (1024 * 48)), row = r / 48, c8 = r % 48; *(u32x4*)((bf16*)(ws + WS_WUP) + ((size_t)l * 1792 + 768 + row) * 512 + c8 * 8) = (u32x4){0u, 0u, 0u, 0u}; }
    {
        const long n_sk = 2L * 8 * 2 * 128 * 128 / 8;
        for (long i = gt; i < n_sk; i += NGT) {
            const float* src = G(A.in.peer_sub_keys); bf16* dst = (bf16*)(ws + WS_SUBK);
            const f32x4 a = *(const f32x4*)(src + i * 8), b = *(const f32x4*)(src + i * 8 + 4);
            u32x4 o; o.x = pk2(a[0], a[1]); o.y = pk2(a[2], a[3]); o.z = pk2(b[0], b[1]); o.w = pk2(b[2], b[3]);
            *(u32x4*)(dst + i * 8) = o;
        }
        for (int r = gw; r < 4 * 16384; r += NGW) {
            const bool isu = r < 2 * 16384; const int row = isu ? r : r - 2 * 16384;
            const float* src = (isu ? G(A.in.peer_u) : G(A.in.peer_v)) + (size_t)row * 2048 + F.lane * 4;
            f32x4 v[8]; float am = 0.f;
#pragma unroll
            for (int q = 0; q < 8; ++q) { v[q] = __builtin_nontemporal_load((const f32x4*)(src + q * 256));
                am = fmaxf(am, fmaxf(fmaxf(__builtin_fabsf(v[q][0]), __builtin_fabsf(v[q][1])), fmaxf(__builtin_fabsf(v[q][2]), __builtin_fabsf(v[q][3])))); }
#pragma unroll
            for (int o = 1; o < 64; o <<= 1) am = fmaxf(am, __shfl_xor(am, o));
            const float S = am > 0.f ? 6.0f / am : 1.0f;
            unsigned short* dst = (unsigned short*)(ws + (isu ? WS_PU : WS_PV)) + (size_t)row * 512 + F.lane;
#pragma unroll
            for (int q = 0; q < 8; ++q) { const f32x4 a = v[q] * S;
                unsigned w = __builtin_amdgcn_cvt_scalef32_pk_fp4_f32(0u, a[0], a[1], 1.0f, 0); w = __builtin_amdgcn_cvt_scalef32_pk_fp4_f32(w, a[2], a[3], 1.0f, 1);
                dst[q * 64] = (unsigned short)(w & 0xffffu); }
            if (F.lane == 0) ((float*)(ws + (isu ? WS_SCU : WS_SCV)))[row] = am > 0.f ? am * (1.0f / 6.0f) : 1.0f;
        }
    }
    {
        float* ct = (float*)(ws + WS_CTAB);
        for (long i = gt; i < 2L * 4 * 15 * 64 * 64; i += NGT) {
            const int kc = (int)(i & 63), qc = (int)((i >> 6) & 63), r = (int)(i >> 12), dr = r % 15, lh = r / 15;
            int cs = qc - 8; cs = cs < 0 ? 0 : (cs > 48 ? 48 : cs);
            int co = kc - qc + 15; co = co < 0 ? 0 : (co > 30 ? 30 : co);
            ct[i] = (kc >= cs && kc < cs + 16) ? G(A.in.c_rpb)[((size_t)lh * 15 + dr) * 31 + co] * (1.0f / C_SCALE) : -1e30f;
        }
    }
}
__device__ __forceinline__ void p1_modreduce(const Frame& F, KA A) {
    const long gt = ((long)F.vcu * NWAVES + F.wave) * 64 + F.lane, NGT = (long)F.G * NWAVES * 64;
    const float* modp = (const float*)(F.ws + WS_MODP); float* mod = (float*)(F.ws + WS_MOD);
    for (long i = gt; i < 2L * 5 * MODW; i += NGT) { const int n = (int)(i % MODW), l = (int)(i / (5 * MODW));
        float s = G(A.in.b_ada)[l * MODW + n];
#pragma unroll
        for (int ks = 0; ks < 16; ++ks) s += modp[(size_t)ks * 2 * 5 * MODW + i];
        mod[i] = s; }
}
__device__ __forceinline__ void p2_modulate0(const Frame& F, KA A) {
    const int gw = F.vcu * NWAVES + F.wave, NGW = F.G * NWAVES;
    const float* mod = (const float*)(F.ws + WS_MOD); bf16* H = (bf16*)(F.ws + WS_BUFA);
    for (int row = gw; row < MT; row += NGW) {
        const float* xr = row < ML ? G(A.in.x) + (size_t)row * DM : G(A.in.ctx) + (size_t)(row - ML) * DM;
        const float* mr = mod + (size_t)(row < ML ? (row >> 12) : 4) * MODW;
#pragma unroll
        for (int j = 0; j < 4; ++j) { const int c = j * 512 + F.lane * 8;
            const f32x4 a = *(const f32x4*)(xr + c), b = *(const f32x4*)(xr + c + 4);
            const f32x4 sh0 = *(const f32x4*)(mr + c), sh1 = *(const f32x4*)(mr + c + 4), sc0 = *(const f32x4*)(mr + DM + c), sc1 = *(const f32x4*)(mr + DM + c + 4);
            const f32x4 y0 = a * (sc0 + 1.0f) + sh0, y1 = b * (sc1 + 1.0f) + sh1;
            u32x4 o; o.x = pk2(y0[0], y0[1]); o.y = pk2(y0[2], y0[3]); o.z = pk2(y1[0], y1[1]); o.w = pk2(y1[2], y1[3]);
            *(u32x4*)(H + (size_t)row * DM + c) = o; }
    }
}
__device__ __forceinline__ void rope_pair(float& x1, float& x2, float ang) { const float c = __cosf(ang), s = __sinf(ang); const float y1 = x1 * c - x2 * s, y2 = x1 * s + x2 * c; x1 = y1; x2 = y2; }
__device__ __forceinline__ void enorm_phase(const Frame& F, KA A, int l) {
    const int gw = F.vcu * NWAVES + F.wave, NGW = F.G * NWAVES, lane = F.lane;
    bf16* U = (bf16*)(F.ws + WS_UREG); bf16* QK = (bf16*)(F.ws + WS_QKVA);
    const float* gq = G(A.in.d_q_norm) + l * 128; const float* gk = G(A.in.d_k_norm) + l * 128;
    const float L2T = 13.287712379549449f;
    for (int row = gw; row < MT; row += NGW) {
        bf16* u = U + (size_t)row * UW;
        const bool lat = row < ML; const int t = row & 4095;
        const float prow = lat ? (float)(t >> 6) : 0.f, pcol = lat ? (float)(t & 63) : 0.f;
        { unsigned w[3]; float ss = 0.f;
#pragma unroll
          for (int i = 0; i < 3; ++i) { w[i] = ((const unsigned*)(u + U_CQ))[lane + 64 * i]; const float a = bflo(w[i]), b = bfhi(w[i]); ss += a * a + b * b; }
          const float rstd = rsqrtf(wave_sum(ss) * (1.0f / 384.0f) + RMS_EPS);
#pragma unroll
          for (int i = 0; i < 3; ++i) ((unsigned*)(u + U_CQ))[lane + 64 * i] = pk2(bflo(w[i]) * rstd, bfhi(w[i]) * rstd); }
        { const unsigned w = ((const unsigned*)(u + U_CKV))[lane]; const float a = bflo(w), b = bfhi(w);
          const float rstd = rsqrtf(wave_sum(a * a + b * b) * (1.0f / 128.0f) + RMS_EPS);
          ((unsigned*)(u + U_CKV))[lane] = pk2(a * rstd, b * rstd); }
        const int j64 = lane & 31;
        const float ang64 = ((j64 < 16) ? prow : pcol) * __builtin_amdgcn_exp2f(-(float)(j64 & 15) * (L2T / 16.0f));
        if (lane < 32) { float x1 = bf2f(u[U_KR + lane]), x2 = bf2f(u[U_KR + 32 + lane]); rope_pair(x1, x2, ang64);
            bf16* o = QK + (size_t)row * QW + QA_KR; o[lane] = f2bf(x1); o[32 + lane] = f2bf(x2); }
#pragma unroll
        for (int i = 0; i < 4; ++i) { const int p = lane + 64 * i, hd = p >> 5; bf16* q = u + U_BQ + hd * 64;
            float x1 = bf2f(q[j64]), x2 = bf2f(q[32 + j64]); rope_pair(x1, x2, ang64); q[j64] = f2bf(x1); q[32 + j64] = f2bf(x2); }
        { const int hd = lane >> 5; bf16* q = u + U_BK + hd * 64;
          float x1 = bf2f(q[j64]), x2 = bf2f(q[32 + j64]); rope_pair(x1, x2, ang64); q[j64] = f2bf(x1); q[32 + j64] = f2bf(x2); }
        const float ang128 = ((lane < 32) ? prow : pcol) * __builtin_amdgcn_exp2f(-(float)(lane & 31) * (L2T / 32.0f));
        const float gq1 = gq[lane], gq2 = gq[64 + lane], gk1 = gk[lane], gk2 = gk[64 + lane];
#pragma unroll
        for (int hd = 0; hd < 4; ++hd) { bf16* q = u + U_DQ + hd * 128; float x1 = bf2f(q[lane]), x2 = bf2f(q[64 + lane]);
            const float rstd = rsqrtf(wave_sum(x1 * x1 + x2 * x2) * (1.0f / 128.0f) + RMS_EPS);
            x1 = x1 * rstd * gq1; x2 = x2 * rstd * gq2; rope_pair(x1, x2, ang128); q[lane] = f2bf(x1); q[64 + lane] = f2bf(x2); }
#pragma unroll
        for (int hd = 0; hd < 2; ++hd) { bf16* q = u + U_DK + hd * 128; float x1 = bf2f(q[lane]), x2 = bf2f(q[64 + lane]);
            const float rstd = rsqrtf(wave_sum(x1 * x1 + x2 * x2) * (1.0f / 128.0f) + RMS_EPS);
            x1 = x1 * rstd * gk1; x2 = x2 * rstd * gk2; rope_pair(x1, x2, ang128); q[lane] = f2bf(x1); q[64 + lane] = f2bf(x2); }
    }
}
__device__ __forceinline__ void ln1_phase(const Frame& F, KA A, int l, int nrows, bf16* HF) {
    const int gw = F.vcu * NWAVES + F.wave, NGW = F.G * NWAVES, lane = F.lane;
    float* Y = (float*)(F.ws + WS_UREG); const float* mod = (const float*)(F.ws + WS_MOD) + (size_t)l * 5 * MODW;
    const float* g = G(A.in.ln1_g) + l * DM; const float* b = G(A.in.ln1_b) + l * DM;
    for (int row = gw; row < nrows; row += NGW) {
        float* y = Y + (size_t)row * DM; const float* mr = mod + (size_t)(row < ML ? (row >> 12) : 4) * MODW;
        f32x4 v[8]; float s = 0.f;
#pragma unroll
        for (int j = 0; j < 4; ++j) { const int c = j * 512 + lane * 8; v[2 * j] = *(const f32x4*)(y + c); v[2 * j + 1] = *(const f32x4*)(y + c + 4); }
#pragma unroll
        for (int j = 0; j < 8; ++j) s += (v[j][0] + v[j][1]) + (v[j][2] + v[j][3]);
        const float mean = wave_sum(s) * (1.0f / DM); float q = 0.f;
#pragma unroll
        for (int j = 0; j < 8; ++j) { v[j] = v[j] - mean; q += (v[j][0] * v[j][0] + v[j][1] * v[j][1]) + (v[j][2] * v[j][2] + v[j][3] * v[j][3]); }
        const float rstd = rsqrtf(wave_sum(q) * (1.0f / DM) + LN_EPS);
#pragma unroll
        for (int j = 0; j < 4; ++j) { const int c = j * 512 + lane * 8;
            const f32x4 x0 = v[2 * j] * rstd * *(const f32x4*)(g + c) + *(const f32x4*)(b + c), x1 = v[2 * j + 1] * rstd * *(const f32x4*)(g + c + 4) + *(const f32x4*)(b + c + 4);
            *(f32x4*)(y + c) = x0; *(f32x4*)(y + c + 4) = x1;
            const f32x4 h0 = x0 * (*(const f32x4*)(mr + 4 * DM + c) + 1.0f) + *(const f32x4*)(mr + 3 * DM + c), h1 = x1 * (*(const f32x4*)(mr + 4 * DM + c + 4) + 1.0f) + *(const f32x4*)(mr + 3 * DM + c + 4);
            u32x4 o; o.x = pk2(h0[0], h0[1]); o.y = pk2(h0[2], h0[3]); o.z = pk2(h1[0], h1[1]); o.w = pk2(h1[2], h1[3]);
            *(u32x4*)(HF + (size_t)row * DM + c) = o; }
    }
}
namespace peer {
__device__ __forceinline__ unsigned okey(float f) { const unsigned u = __float_as_uint(f); return (u & 0x80000000u) ? ~u : (u | 0x80000000u); }
__device__ __forceinline__ float ikey(unsigned k) { const unsigned u = (k & 0x80000000u) ? (k & 0x7fffffffu) : ~k; return __uint_as_float(u); }
#define CE_DESC(a, b) do { const unsigned _mx = (a) > (b) ? (a) : (b), _mn = (a) > (b) ? (b) : (a); (a) = _mx; (b) = _mn; } while (0)
#define CE_ASC(a, b)  do { const unsigned _mx = (a) > (b) ? (a) : (b), _mn = (a) > (b) ? (b) : (a); (a) = _mn; (b) = _mx; } while (0)
__device__ __forceinline__ void sort16_desc(unsigned (&k)[16]) {
#pragma unroll
    for (int size = 2; size <= 16; size <<= 1)
#pragma unroll
        for (int stride = size >> 1; stride > 0; stride >>= 1)
#pragma unroll
            for (int i = 0; i < 16; ++i) { const int p = i ^ stride; if (p > i) { if ((i & size) == 0) CE_DESC(k[i], k[p]); else CE_ASC(k[i], k[p]); } }
}
__device__ __forceinline__ void merge16_desc(unsigned (&a)[16], const unsigned (&b)[16]) {
#pragma unroll
    for (int i = 0; i < 16; ++i) a[i] = a[i] > b[15 - i] ? a[i] : b[15 - i];
#pragma unroll
    for (int stride = 8; stride > 0; stride >>= 1)
#pragma unroll
        for (int i = 0; i < 16; ++i) { const int p = i ^ stride; if (p > i) CE_DESC(a[i], a[p]); }
}
constexpr int slot_x(int s) { int n = 0; for (int x = 0; x < 16; ++x) for (int y = 0; y < 16; ++y) if ((x + 1) * (y + 1) <= 16) { if (n == s) return x; ++n; } return -1; }
constexpr int slot_y(int s) { int n = 0; for (int x = 0; x < 16; ++x) for (int y = 0; y < 16; ++y) if ((x + 1) * (y + 1) <= 16) { if (n == s) return y; ++n; } return -1; }
template <int S> struct Slot { static constexpr int x = slot_x(S), y = slot_y(S); };
template <int S> __device__ __forceinline__ void cand_one(unsigned (&c)[64], const float (&v0)[16], const float (&v1)[16], const unsigned (&i0)[16], const unsigned (&i1)[16], LAS unsigned short* tbl) {
    if constexpr (Slot<S>::x >= 0) { c[S] = (okey(v0[Slot<S>::x] + v1[Slot<S>::y]) & ~63u) | (unsigned)(63 - S); tbl[S] = (unsigned short)(i0[Slot<S>::x] * 128u + i1[Slot<S>::y]); }
    else c[S] = 0u;
}
template <int... S> __device__ __forceinline__ void cand_all(unsigned (&c)[64], const float (&v0)[16], const float (&v1)[16], const unsigned (&i0)[16], const unsigned (&i1)[16], LAS unsigned short* tbl, std::integer_sequence<int, S...>) {
    (cand_one<S>(c, v0, v1, i0, i1, tbl), ...);
}
__device__ __forceinline__ void topk_item(const bf16* QP, const bf16* SK, int* EIDX, float* EG, int tok0, int h, LAS unsigned short* tblw, int lane) {
    const int r32 = lane & 31, hi = lane >> 5;
    const bf16* qrow = QP + (size_t)(tok0 + r32) * DM + h * 256 + hi * 8;
    unsigned L[2][16];
#pragma unroll
    for (int p = 0; p < 2; ++p) {
        f32x16 acc[4];
#pragma unroll
        for (int kb = 0; kb < 4; ++kb) acc[kb] = f32x16{};
        const bf16* skp = SK + ((size_t)(h * 2 + p) * 128 + r32) * 128 + hi * 8;
#pragma unroll 2
        for (int d0 = 0; d0 < 8; ++d0) { const bf16x8 bq = *(const bf16x8*)(qrow + p * 128 + d0 * 16);
#pragma unroll
            for (int kb = 0; kb < 4; ++kb) { const bf16x8 ak = *(const bf16x8*)(skp + (size_t)kb * 32 * 128 + d0 * 16); acc[kb] = __builtin_amdgcn_mfma_f32_32x32x16_bf16(ak, bq, acc[kb], 0, 0, 0); } }
        unsigned g[4][16];
#pragma unroll
        for (int kb = 0; kb < 4; ++kb) {
#pragma unroll
            for (int r = 0; r < 16; ++r) g[kb][r] = (okey(acc[kb][r]) & ~127u) | (unsigned)(127 - (32 * kb + (r & 3) + 8 * (r >> 2) + 4 * hi));
            sort16_desc(g[kb]); }
        merge16_desc(g[0], g[1]); merge16_desc(g[2], g[3]); merge16_desc(g[0], g[2]);
        unsigned o[16];
#pragma unroll
        for (int i = 0; i < 16; ++i) o[i] = (unsigned)__shfl_xor((int)g[0][i], 32);
        merge16_desc(g[0], o);
#pragma unroll
        for (int i = 0; i < 16; ++i) L[p][i] = g[0][i];
    }
    float v0[16], v1[16]; unsigned i0[16], i1[16];
#pragma unroll
    for (int i = 0; i < 16; ++i) { v0[i] = ikey(L[0][i] & ~127u); v1[i] = ikey(L[1][i] & ~127u); i0[i] = 127u - (L[0][i] & 127u); i1[i] = 127u - (L[1][i] & 127u); }
    LAS unsigned short* tbl = tblw + lane * 66;
    unsigned c[64];
    cand_all(c, v0, v1, i0, i1, tbl, std::make_integer_sequence<int, 64>{});
    unsigned c0[16], c1[16], c2[16], c3[16];
#pragma unroll
    for (int i = 0; i < 16; ++i) { c0[i] = c[i]; c1[i] = c[16 + i]; c2[i] = c[32 + i]; c3[i] = c[48 + i]; }
    sort16_desc(c0); sort16_desc(c1); sort16_desc(c2); sort16_desc(c3);
    merge16_desc(c0, c1); merge16_desc(c2, c3); merge16_desc(c0, c2);
    LDS_WAIT(); asm volatile("" ::: "memory");
    float best[16]; int eid[16]; float sum = 0.f;
    const float mx = ikey(c0[0] & ~63u);
#pragma unroll
    for (int i = 0; i < 16; ++i) { const unsigned s = 63u - (c0[i] & 63u); eid[i] = (int)tbl[s]; best[i] = __expf(ikey(c0[i] & ~63u) - mx); sum += best[i]; }
    const float inv = 1.0f / sum;
    if (hi == 0) {
        int* ep = EIDX + (size_t)(tok0 + r32) * 128 + h * 16; float* gp = EG + (size_t)(tok0 + r32) * 128 + h * 16;
#pragma unroll
        for (int i = 0; i < 16; ++i) { ep[i] = eid[i]; gp[i] = best[i] * inv; }
    }
    LDS_WAIT(); asm volatile("" ::: "memory");
}
}
namespace p4 {
constexpr int L_SE = 0, L_SG = 4 * 128 * 2, L_WAVE = L_SG + 4 * 128 * 4;
__device__ __forceinline__ float rowsum16(float d) {
    d += __int_as_float(__builtin_amdgcn_update_dpp(__float_as_int(d), __float_as_int(d), 0x128, 0xF, 0xF, false));
    d += __int_as_float(__builtin_amdgcn_update_dpp(__float_as_int(d), __float_as_int(d), 0x124, 0xF, 0xF, false));
    d += __int_as_float(__builtin_amdgcn_update_dpp(__float_as_int(d), __float_as_int(d), 0x122, 0xF, 0xF, false));
    d += __int_as_float(__builtin_amdgcn_update_dpp(__float_as_int(d), __float_as_int(d), 0x121, 0xF, 0xF, false));
    return d;
}
__device__ __forceinline__ f32x2 cvt4(unsigned w, int t) {
    return t == 0 ? __builtin_amdgcn_cvt_scalef32_pk_f32_fp4(w, 1.0f, 0) : (t == 1 ? __builtin_amdgcn_cvt_scalef32_pk_f32_fp4(w, 1.0f, 1) : (t == 2 ? __builtin_amdgcn_cvt_scalef32_pk_f32_fp4(w, 1.0f, 2) : __builtin_amdgcn_cvt_scalef32_pk_f32_fp4(w, 1.0f, 3)));
}
struct Row { u32x4 p[4]; float sc; };
__device__ __forceinline__ void load_row(Row& r, const unsigned char* tab_l, const float* sct, int e) {
    __builtin_amdgcn_sched_barrier(0);
    const unsigned char* g = tab_l + (size_t)(unsigned)e * 1024;
#pragma unroll
    for (int j = 0; j < 4; ++j) r.p[j] = *(const u32x4*)(g + j * 256);
    r.sc = sct[e];
    __builtin_amdgcn_sched_barrier(0);
}
__device__ __forceinline__ float dot128(const f32x2 (&h)[64], const Row& r) {
    f32x2 a = {0.f, 0.f}, b = {0.f, 0.f};
#pragma unroll
    for (int j = 0; j < 4; ++j)
#pragma unroll
        for (int q = 0; q < 4; ++q) { const unsigned w = r.p[j][q];
            a = __builtin_elementwise_fma(h[(j * 4 + q) * 4 + 0], cvt4(w, 0), a); b = __builtin_elementwise_fma(h[(j * 4 + q) * 4 + 1], cvt4(w, 1), b);
            a = __builtin_elementwise_fma(h[(j * 4 + q) * 4 + 2], cvt4(w, 2), a); b = __builtin_elementwise_fma(h[(j * 4 + q) * 4 + 3], cvt4(w, 3), b); }
    return (a.x + a.y) + (b.x + b.y);
}
__device__ __forceinline__ void axpy128(f32x2 (&acc)[64], const float w, const Row& r) {
    const f32x2 ww = {w, w};
#pragma unroll
    for (int j = 0; j < 4; ++j)
#pragma unroll
        for (int q = 0; q < 4; ++q) { const unsigned x = r.p[j][q];
#pragma unroll
            for (int t = 0; t < 4; ++t) acc[(j * 4 + q) * 4 + t] = __builtin_elementwise_fma(ww, cvt4(x, t), acc[(j * 4 + q) * 4 + t]); }
}
__device__ __forceinline__ float gelu_as(float v) {
    const float av = __builtin_fabsf(v), t = __builtin_amdgcn_rcpf(av * 0.2316418882f + 1.0f);
    float q = t * 0.5307027145f + (-0.7265760135f); q = q * t + 0.7107068705f; q = q * t + (-0.142248368f); q = q * t + 0.127414796f; q = q * t;
    const float e = __builtin_amdgcn_exp2f((v * v) * (-0.72134752044f)); const float m = v * (q * e); return v < 0.f ? m : v - m;
}
}

__device__ __forceinline__ void pexp4_phase(const Frame& F, KA A, int l, int ntok, const bf16* HF, float* outp, bf16* Hnext) {
    using namespace p4;
    const unsigned char* PU8 = (const unsigned char*)(F.ws + WS_PU) + (size_t)l * 16384 * 1024; const unsigned char* PV8 = (const unsigned char*)(F.ws + WS_PV) + (size_t)l * 16384 * 1024;
    const float* SCU = (const float*)(F.ws + WS_SCU) + l * 16384; const float* SCV = (const float*)(F.ws + WS_SCV) + l * 16384;
    const int* EIDX = (const int*)(F.ws + WS_EIDX); const float* EG = (const float*)(F.ws + WS_EG);
    float* X1 = (float*)(F.ws + WS_UREG); const float* mod = (const float*)(F.ws + WS_MOD);
    const float* g2 = G(A.in.ln2_g) + l * DM; const float* b2 = G(A.in.ln2_b) + l * DM;
    LAS unsigned char* wl = F.lds + RING_OFF + F.wave * L_WAVE;
    LAS unsigned short* se = (LAS unsigned short*)(wl + L_SE); LAS float* sg = (LAS float*)(wl + L_SG);
    const int gw = F.vcu * NWAVES + F.wave, NW = F.G * NWAVES;
    const int nfull = ntok / (NW * 4), nrem = ntok - nfull * NW * 4, nsplit = (nrem + NW - 1) / NW;
    for (int pass = 0; pass < nfull + nsplit; ++pass) {
        int lane = F.lane; asm volatile("" : "+v"(lane));
        const int qd = lane >> 4, l16 = lane & 15;
        const bool split = pass >= nfull;
        int tokw[4];
#pragma unroll
        for (int k = 0; k < 4; ++k) tokw[k] = split ? ((k == 0 && (pass - nfull) * NW + gw < nrem) ? nfull * NW * 4 + (pass - nfull) * NW + gw : -1) : pass * NW * 4 + gw * 4 + k;
        if (split && tokw[0] < 0) continue;
#pragma unroll
        for (int k = 0; k < 4; ++k) if (tokw[k] >= 0) {
            unsigned k0 = ((unsigned)EIDX[(size_t)tokw[k] * 128 + lane] << 7) | (unsigned)lane, k1 = ((unsigned)EIDX[(size_t)tokw[k] * 128 + 64 + lane] << 7) | (unsigned)(64 + lane);
#pragma unroll
            for (int size = 2; size <= 128; size <<= 1)
#pragma unroll
                for (int stride = size >> 1; stride > 0; stride >>= 1) {
                    if (stride == 64) { const unsigned lo = k0 < k1 ? k0 : k1, hi = k0 < k1 ? k1 : k0; k0 = lo; k1 = hi; }
                    else {
                        const unsigned p0 = (unsigned)__shfl_xor((int)k0, stride), p1 = (unsigned)__shfl_xor((int)k1, stride);
                        const bool lower = (lane & stride) == 0;
                        const bool up0 = (lane & size) == 0 || size == 128 || size == 64;
                        const bool up1 = size == 128 ? true : (size == 64 ? false : (lane & size) == 0);
                        k0 = (lower == up0) ? (k0 < p0 ? k0 : p0) : (k0 < p0 ? p0 : k0);
                        k1 = (lower == up1) ? (k1 < p1 ? k1 : p1) : (k1 < p1 ? p1 : k1);
                    }
                }
            se[k * 128 + lane] = (unsigned short)(k0 >> 7); se[k * 128 + 64 + lane] = (unsigned short)(k1 >> 7);
            sg[k * 128 + lane] = EG[(size_t)tokw[k] * 128 + (k0 & 127u)]; sg[k * 128 + 64 + lane] = EG[(size_t)tokw[k] * 128 + (k1 & 127u)];
        }
        LDS_WAIT(); asm volatile("s_waitcnt vmcnt(0)" ::: "memory");
        const int tok = split ? tokw[0] : (qd == 0 ? tokw[0] : (qd == 1 ? tokw[1] : (qd == 2 ? tokw[2] : tokw[3])));
        const int lbase = split ? 32 * qd : 128 * qd;
        const int nsteps = split ? 32 : 128;
        LAS const unsigned short* seq = se + lbase; LAS float* sgq = sg + lbase;
#ifndef P4_NO_U
        {
            f32x2 h[64];
#pragma unroll
            for (int j = 0; j < 4; ++j) { const bf16* hp = HF + (size_t)tok * DM + j * 512 + l16 * 32;
#pragma unroll
                for (int q = 0; q < 4; ++q) { const u32x4 a = *(const u32x4*)(hp + q * 8);
#pragma unroll
                    for (int t = 0; t < 4; ++t) h[(j * 4 + q) * 4 + t] = (f32x2){bflo(a[t]), bfhi(a[t])}; } }
            const unsigned char* tab_l = PU8 + l16 * 16;
            p4::Row ra, rb;
            int ea = seq[0], eb = seq[1];
            p4::load_row(ra, tab_l, SCU, ea);
            for (int i = 0; i < nsteps; i += 2) {
                p4::load_row(rb, tab_l, SCU, eb);
                const float sva = SCV[ea]; ea = seq[i + 2 < nsteps ? i + 2 : nsteps - 1];
                { const float gate = sgq[i]; const float d = p4::rowsum16(p4::dot128(h, ra)) * ra.sc; sgq[i] = p4::gelu_as(d) * gate * sva; }
                p4::load_row(ra, tab_l, SCU, ea);
                const float svb = SCV[eb]; eb = seq[i + 3 < nsteps ? i + 3 : nsteps - 1];
                { const float gate = sgq[i + 1]; const float d = p4::rowsum16(p4::dot128(h, rb)) * rb.sc; sgq[i + 1] = p4::gelu_as(d) * gate * svb; }
            }
        }
#endif
        LDS_WAIT(); asm volatile("s_waitcnt vmcnt(0)" ::: "memory");
#ifndef P4_NO_V
        {
            f32x2 acc[64];
#pragma unroll
            for (int k = 0; k < 64; ++k) acc[k] = (f32x2){0.f, 0.f};
            const unsigned char* tab_l = PV8 + l16 * 16;
            p4::Row ra, rb;
            int ea = seq[0], eb = seq[1];
            p4::load_row(ra, tab_l, SCV, ea);
            for (int i = 0; i < nsteps; i += 2) {
                p4::load_row(rb, tab_l, SCV, eb);
                ea = seq[i + 2 < nsteps ? i + 2 : nsteps - 1];
                p4::axpy128(acc, sgq[i], ra);
                p4::load_row(ra, tab_l, SCV, ea);
                eb = seq[i + 3 < nsteps ? i + 3 : nsteps - 1];
                p4::axpy128(acc, sgq[i + 1], rb);
            }
            asm volatile("s_waitcnt vmcnt(0)" ::: "memory");
#ifndef P4_NO_SPLITC
            if (split) {
#pragma unroll
                for (int k = 0; k < 64; ++k) {
                    { auto r0 = __builtin_amdgcn_permlane16_swap(__float_as_uint(acc[k].x), __float_as_uint(acc[k].x), false, false); acc[k].x = __uint_as_float(r0[0]) + __uint_as_float(r0[1]);
                      auto r1 = __builtin_amdgcn_permlane16_swap(__float_as_uint(acc[k].y), __float_as_uint(acc[k].y), false, false); acc[k].y = __uint_as_float(r1[0]) + __uint_as_float(r1[1]); }
                    { auto r0 = __builtin_amdgcn_permlane32_swap(__float_as_uint(acc[k].x), __float_as_uint(acc[k].x), false, false); acc[k].x = __uint_as_float(r0[0]) + __uint_as_float(r0[1]);
                      auto r1 = __builtin_amdgcn_permlane32_swap(__float_as_uint(acc[k].y), __float_as_uint(acc[k].y), false, false); acc[k].y = __uint_as_float(r1[0]) + __uint_as_float(r1[1]); }
                }
            }
#endif
#ifdef P4_NO_LN2
            for (int k = 0; k < 64; ++k) *(f32x2*)(outp + (size_t)tok * DM + k * 32 + l16 * 2) = acc[k];
#else
            const int bidx = tok < ML ? (tok >> 12) : 4;
            const float* mr = mod + ((size_t)l * 5 + bidx) * MODW; const float* mn = mod + ((size_t)(l + 1 < DEPTH ? l + 1 : l) * 5 + bidx) * MODW; float* x1 = X1 + (size_t)tok * DM;
            if (!split || qd == 0) {
                float s1 = 0.f, s2 = 0.f; int lq = l16; asm volatile("" : "+v"(lq));
                GAS float* px = (GAS float*)x1 + lq * 32; const GAS float* pg = (const GAS float*)mr + 5 * DM + lq * 32;
#pragma unroll
                for (int j = 0; j < 4; ++j) {
#pragma unroll
                    for (int k = 0; k < 8; ++k) { const f32x4 xa = *(const GAS f32x4*)(px + k * 4), ga = *(const GAS f32x4*)(pg + k * 4);
                        const f32x2 a0 = acc[(j * 4 + (k >> 1)) * 4 + (k & 1) * 2], a1 = acc[(j * 4 + (k >> 1)) * 4 + (k & 1) * 2 + 1];
                        const f32x4 v = (f32x4){ALPHA * xa[0] + ga[0] * a0.x, ALPHA * xa[1] + ga[1] * a0.y, ALPHA * xa[2] + ga[2] * a1.x, ALPHA * xa[3] + ga[3] * a1.y};
                        s1 += (v[0] + v[1]) + (v[2] + v[3]); s2 += (v[0] * v[0] + v[1] * v[1]) + (v[2] * v[2] + v[3] * v[3]);
                        *(GAS f32x4*)(px + k * 4) = v; asm volatile("" : "+v"(s1), "+v"(s2) :: "memory"); }
                    px += 512; pg += 512; asm volatile("" : "+v"(px), "+v"(pg)); }
                const float mean = p4::rowsum16(s1) * (1.0f / DM); const float var = p4::rowsum16(s2) * (1.0f / DM) - mean * mean;
                const float rstd = rsqrtf((var > 0.f ? var : 0.f) + LN_EPS);
                asm volatile("s_waitcnt vmcnt(0)" ::: "memory");
                const int co = lq * 32;
#pragma unroll 1
                for (int jj = 0; jj < 8; ++jj) {
                    u32x4 o0, o1; const int cj = (jj >> 1) * 512 + co + (jj & 1) * 16;
#pragma unroll
                    for (int q = 0; q < 4; ++q) { const int c = cj + q * 4; const f32x4 v = *(const f32x4*)(x1 + c), ga = *(const f32x4*)(g2 + c), ba = *(const f32x4*)(b2 + c);
                        const f32x4 y = (v - mean) * rstd * ga + ba;
                        *(f32x4*)(outp + (size_t)tok * DM + c) = y;
                        if (Hnext) { const f32x4 z = y * (*(const f32x4*)(mn + DM + c) + 1.0f) + *(const f32x4*)(mn + c); const unsigned w0 = pk2(z[0], z[1]), w1 = pk2(z[2], z[3]);
                            if (q == 0) { o0.x = w0; o0.y = w1; } else if (q == 1) { o0.z = w0; o0.w = w1; } else if (q == 2) { o1.x = w0; o1.y = w1; } else { o1.z = w0; o1.w = w1; } } }
                    if (Hnext) { bf16* hp = Hnext + (size_t)tok * DM + cj; *(u32x4*)hp = o0; *(u32x4*)(hp + 8) = o1; }
                }
            }
#endif
        }
#endif
        LDS_WAIT(); asm volatile("s_waitcnt vmcnt(0)" ::: "memory");
    }
}
__device__ __forceinline__ float gelu_exact(float v) { return 0.5f * v * (1.0f + erff(v * 0.70710678118654752f)); }
__device__ __forceinline__ float reduce16(float (&p)[16], int lane) {
    float q[8], r[4], s[2];
    { const bool up = lane & 1;
#pragma unroll
      for (int k = 0; k < 8; ++k) { const float send = up ? p[2 * k] : p[2 * k + 1], keep = up ? p[2 * k + 1] : p[2 * k]; q[k] = keep + __shfl_xor(send, 1); } }
    { const bool up = lane & 2;
#pragma unroll
      for (int k = 0; k < 4; ++k) { const float send = up ? q[2 * k] : q[2 * k + 1], keep = up ? q[2 * k + 1] : q[2 * k]; r[k] = keep + __shfl_xor(send, 2); } }
    { const bool up = lane & 4;
#pragma unroll
      for (int k = 0; k < 2; ++k) { const float send = up ? r[2 * k] : r[2 * k + 1], keep = up ? r[2 * k + 1] : r[2 * k]; s[k] = keep + __shfl_xor(send, 4); } }
    float t;
    { const bool up = lane & 8; const float send = up ? s[0] : s[1], keep = up ? s[1] : s[0]; t = keep + __shfl_xor(send, 8); }
    t += __shfl_xor(t, 16); t += __shfl_xor(t, 32);
    return t;
}
__device__ __forceinline__ void pexp_phase(const Frame& F, KA A, int l, int ntok, const bf16* HF, float* outp, bf16* Hnext) {
    const int gw = F.vcu * NWAVES + F.wave, NGW = F.G * NWAVES, lane = F.lane;
    const bf16* PU = (const bf16*)(F.ws + WS_PU) + (size_t)l * 16384 * DM; const bf16* PV = (const bf16*)(F.ws + WS_PV) + (size_t)l * 16384 * DM;
    const int* EIDX = (const int*)(F.ws + WS_EIDX); const float* EG = (const float*)(F.ws + WS_EG);
    const float* X1 = (const float*)(F.ws + WS_UREG); const float* mod = (const float*)(F.ws + WS_MOD);
    const float* g2 = G(A.in.ln2_g) + l * DM; const float* b2 = G(A.in.ln2_b) + l * DM;
    for (int tok = gw; tok < ntok; tok += NGW) {
        float h[32], acc[32];
#pragma unroll
        for (int j = 0; j < 4; ++j) { const bf16x8 v = *(const bf16x8*)(HF + (size_t)tok * DM + j * 512 + lane * 8);
#pragma unroll
            for (int e = 0; e < 8; ++e) { h[j * 8 + e] = bf2f((unsigned short)v[e]); acc[j * 8 + e] = 0.f; } }
#pragma unroll 1
        for (int sb = 0; sb < 32; ++sb) {
            const int my_e = EIDX[(size_t)tok * 128 + sb * 4 + (lane & 3)]; const float my_g = EG[(size_t)tok * 128 + sb * 4 + (lane & 3)];
            const int e0 = __builtin_amdgcn_readlane(my_e, 0), e1 = __builtin_amdgcn_readlane(my_e, 1), e2 = __builtin_amdgcn_readlane(my_e, 2), e3 = __builtin_amdgcn_readlane(my_e, 3);
            float part[4];
#pragma unroll
            for (int i = 0; i < 4; ++i) {
                const int e = i == 0 ? e0 : (i == 1 ? e1 : (i == 2 ? e2 : e3)); const bf16* ur = PU + (size_t)e * DM + lane * 8; float d = 0.f;
#pragma unroll
                for (int j = 0; j < 4; ++j) { const u32x4 w = *(const u32x4*)(ur + j * 512);
                    d += h[j * 8 + 0] * bflo(w.x) + h[j * 8 + 1] * bfhi(w.x) + h[j * 8 + 2] * bflo(w.y) + h[j * 8 + 3] * bfhi(w.y)
                       + h[j * 8 + 4] * bflo(w.z) + h[j * 8 + 5] * bfhi(w.z) + h[j * 8 + 6] * bflo(w.w) + h[j * 8 + 7] * bfhi(w.w); }
                part[i] = d;
            }
            float dot;
            { const bool u1 = lane & 1, u2 = lane & 2;
              const float q0 = (u1 ? part[1] : part[0]) + __shfl_xor(u1 ? part[0] : part[1], 1);
              const float q1 = (u1 ? part[3] : part[2]) + __shfl_xor(u1 ? part[2] : part[3], 1);
              dot = (u2 ? q1 : q0) + __shfl_xor(u2 ? q0 : q1, 2);
              dot += __shfl_xor(dot, 4); dot += __shfl_xor(dot, 8); dot += __shfl_xor(dot, 16); dot += __shfl_xor(dot, 32); }
            const float act = gelu_exact(dot) * my_g;
#pragma unroll
            for (int i = 0; i < 4; ++i) {
                const int e = i == 0 ? e0 : (i == 1 ? e1 : (i == 2 ? e2 : e3)); const float w = __uint_as_float(__builtin_amdgcn_readlane(__float_as_uint(act), i));
                const bf16* vr = PV + (size_t)e * DM + lane * 8;
#pragma unroll
                for (int j = 0; j < 4; ++j) { const u32x4 x = *(const u32x4*)(vr + j * 512);
                    acc[j * 8 + 0] += w * bflo(x.x); acc[j * 8 + 1] += w * bfhi(x.x); acc[j * 8 + 2] += w * bflo(x.y); acc[j * 8 + 3] += w * bfhi(x.y);
                    acc[j * 8 + 4] += w * bflo(x.z); acc[j * 8 + 5] += w * bfhi(x.z); acc[j * 8 + 6] += w * bflo(x.w); acc[j * 8 + 7] += w * bfhi(x.w); }
            }
        }
        const int bidx = tok < ML ? (tok >> 12) : 4;
        const float* mr = mod + ((size_t)l * 5 + bidx) * MODW; const float* x1 = X1 + (size_t)tok * DM;
        float s = 0.f;
#pragma unroll
        for (int j = 0; j < 4; ++j) { const int c = j * 512 + lane * 8;
            const f32x4 xa = *(const f32x4*)(x1 + c), xb = *(const f32x4*)(x1 + c + 4), ga = *(const f32x4*)(mr + 5 * DM + c), gb = *(const f32x4*)(mr + 5 * DM + c + 4);
#pragma unroll
            for (int e = 0; e < 4; ++e) { acc[j * 8 + e] = ALPHA * xa[e] + ga[e] * acc[j * 8 + e]; acc[j * 8 + 4 + e] = ALPHA * xb[e] + gb[e] * acc[j * 8 + 4 + e]; s += acc[j * 8 + e] + acc[j * 8 + 4 + e]; } }
        const float mean = wave_sum(s) * (1.0f / DM); float q = 0.f;
#pragma unroll
        for (int k = 0; k < 32; ++k) { acc[k] -= mean; q += acc[k] * acc[k]; }
        const float rstd = rsqrtf(wave_sum(q) * (1.0f / DM) + LN_EPS);
        const float* mn = mod + ((size_t)(l + 1 < DEPTH ? l + 1 : l) * 5 + bidx) * MODW;
#pragma unroll
        for (int j = 0; j < 4; ++j) { const int c = j * 512 + lane * 8;
            const f32x4 ga = *(const f32x4*)(g2 + c), gb = *(const f32x4*)(g2 + c + 4), ba = *(const f32x4*)(b2 + c), bb = *(const f32x4*)(b2 + c + 4);
            f32x4 ya, yb;
#pragma unroll
            for (int e = 0; e < 4; ++e) { ya[e] = acc[j * 8 + e] * rstd * ga[e] + ba[e]; yb[e] = acc[j * 8 + 4 + e] * rstd * gb[e] + bb[e]; }
            *(f32x4*)(outp + (size_t)tok * DM + c) = ya; *(f32x4*)(outp + (size_t)tok * DM + c + 4) = yb;
            if (Hnext) { const f32x4 sa = *(const f32x4*)(mn + DM + c), sb = *(const f32x4*)(mn + DM + c + 4), ha = *(const f32x4*)(mn + c), hb = *(const f32x4*)(mn + c + 4);
                const f32x4 za = ya * (sa + 1.0f) + ha, zb = yb * (sb + 1.0f) + hb;
                u32x4 o; o.x = pk2(za[0], za[1]); o.y = pk2(za[2], za[3]); o.z = pk2(zb[0], zb[1]); o.w = pk2(zb[2], zb[3]);
                *(u32x4*)(Hnext + (size_t)tok * DM + c) = o; }
        }
    }
}

#ifndef SD_A
#define SD_A 1
#endif
#ifndef SD_D
#define SD_D 1
#endif
#ifndef SD_B
#define SD_B 2
#endif
#ifndef SD_C
#define SD_C 1
#endif
#ifndef ATT_MASK
#define ATT_MASK 15
#endif
template <int TYPE> __device__ __forceinline__ att::Args make_att_args(const Frame& F, KA A, int l, int idx, bool ctxq) {
    const bf16* U = (const bf16*)(F.ws + WS_UREG); const bf16* QK = (const bf16*)(F.ws + WS_QKVA); bf16* O = (bf16*)(F.ws + WS_OQP);
    constexpr int NH = (TYPE == 2) ? 8 : 4;
    int b, h, qb;
    if (ctxq) { b = idx / NH; h = idx % NH; qb = 0; } else { b = idx / (NH * 16); h = (idx >> 4) % NH; qb = idx & 15; }
    const int row = ctxq ? ML + b * NCTX : b * SEQ + qb * 256;
    att::Args a{};
    a.ldo = DM; a.qpos0 = qb * 256;
    if (ctxq) { a.n0 = 4; a.row0 = ML + b * NCTX; a.n1 = 0; a.row1 = 0; }
    if constexpr (TYPE == 0) {
        a.Q = QK + (size_t)row * QW + QA_Q + h * 192; a.ldq = QW; a.KV = QK; a.ld = QW; a.kc0 = QA_KV + h * 256; a.kc1 = QA_KR; a.vc = QA_KV + h * 256 + 128;
        a.O = O + (size_t)row * DM + h * 128; a.C = A_SCALE * LOG2E; a.thr = 8.0f / A_SCALE; a.qrope = ctxq ? 0 : 1;
        if (!ctxq) { a.n0 = 64; a.row0 = b * SEQ; a.n1 = 4; a.row1 = ML + b * NCTX; }
    } else if constexpr (TYPE == 1) {
        const int kvh = h >> 1;
        a.Q = U + (size_t)row * UW + U_DQ + h * 128; a.ldq = UW; a.KV = U; a.ld = UW; a.kc0 = U_DK + kvh * 128; a.kc1 = 0; a.vc = U_DV + kvh * 128;
        a.O = O + (size_t)row * DM + 1536 + h * 128; a.C = D_SCALE * LOG2E; a.thr = 8.0f / D_SCALE;
        if (!ctxq) { a.n0 = 64; a.row0 = b * SEQ; a.n1 = 4; a.row1 = ML + b * NCTX; }
    } else if constexpr (TYPE == 2) {
        const int kvh = h >> 2;
        a.Q = U + (size_t)row * UW + U_BQ + h * 64; a.ldq = UW; a.KV = U; a.ld = UW; a.kc0 = U_BK + kvh * 64; a.kc1 = 0; a.vc = U_BV + kvh * 64;
        a.O = O + (size_t)row * DM + 512 + h * 64; a.C = B_SCALE * LOG2E; a.thr = 8.0f / B_SCALE; a.has_sink = 1; a.sinkl2 = G(A.in.b_sink)[l * 8 + h] * LOG2E;
        if (!ctxq) { int ws = qb * 256 - 128; ws = ws < 0 ? 0 : ws; int we = qb * 256 + 384; we = we > SEQ ? SEQ : we;
            a.n0 = 4; a.row0 = ML + b * NCTX; a.n1 = (we - ws) / 64; a.row1 = b * SEQ + ws; a.wpos0 = ws; }
    } else {
        a.Q = U + (size_t)row * UW + U_CQQ + h * 128; a.ldq = UW; a.KV = U; a.ld = UW; a.kc0 = U_CK + h * 128; a.kc1 = 0; a.vc = U_CV + h * 128;
        a.O = O + (size_t)row * DM + 1024 + h * 128; a.C = C_SCALE * LOG2E; a.thr = 8.0f / C_SCALE;
        a.T = (const float*)(F.ws + WS_CTAB) + (size_t)((l * 4 + h) * 15) * 4096;
        if (!ctxq) { const int r0 = qb * 4; int kr0 = r0 - 4; kr0 = kr0 < 0 ? 0 : (kr0 > 56 ? 56 : kr0); int ke = r0 + 3 - 4; ke = ke < 0 ? 0 : (ke > 56 ? 56 : ke); ke += 7; const int nr = ke - kr0 + 1;
            a.n0 = 4; a.row0 = ML + b * NCTX; a.n1 = nr + (nr & 1); a.row1 = b * SEQ + kr0 * 64; a.r0 = r0; a.kr0 = kr0; }
    }
    return a;
}
#define AF() Frame F = F0; asm volatile("" : "+v"(F.tid), "+v"(F.lane), "+s"(F.wave), "+s"(F.vcu), "+s"(F.G), "+s"(F.ws), "+s"(F.lds)); LAS char* lds = (LAS char*)(F.lds + RING_OFF); const int v = F.vcu
__device__ __forceinline__ void att_phase(const Frame& F0, int l) {
    if (F0.vcu >= 256) return;
    const bool cx = (l + 1 < DEPTH);
    if (ATT_MASK & 1) { AF(); KA A = *kargs(); const int n = 1 + ((cx && v < 16) ? 1 : 0);
        for (int k = 0; k < n; ++k) { const att::Args a = make_att_args<0>(F, A, l, k ? v : v, k != 0); att::attn_unit<192, 128, 0, SD_A>(a, lds, F.tid); } }
    if (ATT_MASK & 2) { AF(); KA A = *kargs(); const int n = 1 + ((cx && v >= 16 && v < 32) ? 1 : 0);
        for (int k = 0; k < n; ++k) { const att::Args a = make_att_args<1>(F, A, l, k ? v - 16 : v, k != 0); att::attn_unit<128, 128, 0, SD_D>(a, lds, F.tid); } }
    if (ATT_MASK & 4) { AF(); KA A = *kargs(); const int n = 2 + ((cx && v >= 48 && v < 80) ? 1 : 0);
        for (int k = 0; k < n; ++k) { const att::Args a = make_att_args<2>(F, A, l, k == 2 ? v - 48 : 2 * v + k, k == 2); att::attn_unit<64, 64, 1, SD_B>(a, lds, F.tid); } }
    if (ATT_MASK & 8) { AF(); KA A = *kargs(); const int n = 1 + ((cx && v >= 32 && v < 48) ? 1 : 0);
        for (int k = 0; k < n; ++k) { const att::Args a = make_att_args<3>(F, A, l, k ? v - 32 : v, k != 0); att::attn_unit<128, 128, 2, SD_C>(a, lds, F.tid); } }
}

constexpr int N_PHASES = 3 + 10 * DEPTH;
#ifndef MK_N_LAUNCHES
#define MK_N_LAUNCHES 1
#endif
__global__ void __launch_bounds__(NWAVES * 64, 2) mk_fwd(Args args) {
    extern __shared__ __attribute__((aligned(16))) unsigned char lds_raw[];
    Frame F;
    F.lds = (LAS unsigned char*)lds_raw; F.tid = threadIdx.x; F.lane = F.tid & 63; F.wave = __builtin_amdgcn_readfirstlane(F.tid >> 6);
    F.G = gridDim.x; { const int bx = blockIdx.x; F.vcu = (F.G % 8 == 0) ? (bx % 8) * (F.G / 8) + bx / 8 : bx; }
    GAS unsigned char* ws; int lo, hi, li;
    { KAP ap = kargs(); ws = (GAS unsigned char*)ap->ws; lo = ap->ph_lo; hi = ap->ph_hi; li = ap->li; }
    F.ws = ws;
    for (int u = F.tid; u < (LDS_BYTES - LDSCTL_OFF) / 4; u += NWAVES * 64) ((LAS unsigned*)(F.lds + LDSCTL_OFF))[u] = 0u;
    __syncthreads();
    volatile LAS unsigned* MISC = (volatile LAS unsigned*)(F.lds + MISC_OFF);
    XcdBarrier bar = xcd_barrier_post((unsigned*)(ws + WS_CTL) + CW_BAR + li * XCD_BAR_WORDS, MISC + 8);
#ifndef PHASE_MASK
#define PHASE_MASK 0x1fff
#endif
#define INR(k) (lo <= (k) && (k) < hi)
#define IN(k) ((((PHASE_MASK) >> ((k) < 3 ? (k) : 3 + ((k) - 3) % 10)) & 1) && INR(k))
#define SEAM(k) do { if (INR(k) && INR((k) + 1)) xcd_barrier(bar); } while (0)
#ifndef PROBE_DUP
#define PROBE_DUP 0
#endif
#ifndef PROBE_REP
#define PROBE_REP 1
#endif
#define KIND(k) ((k) < 3 ? (k) : 3 + ((k) - 3) % 10)
#define REP(k) for (int rep_ = 0, nrep_ = 1 + ((((PROBE_DUP) >> KIND(k)) & 1) ? PROBE_REP : 0); rep_ < nrep_; ++rep_, (rep_ < nrep_ ? xcd_barrier(bar) : (void)0))
#define PF() Frame Fp = F; int bx = blockIdx.x; asm volatile("" : "+v"(Fp.tid), "+v"(Fp.lane), "+s"(Fp.wave), "+s"(Fp.vcu), "+s"(Fp.G), "+s"(Fp.ws), "+s"(Fp.lds), "+s"(bx)); GAS unsigned char* ws = Fp.ws; (void)bx; (void)ws
    if (IN(0)) REP(0) { PF(); p0_prologue(Fp, *kargs()); } SEAM(0);
    if (IN(1)) REP(1) { PF(); p1_modreduce(Fp, *kargs()); } SEAM(1);
    if (IN(2)) REP(2) { PF(); p2_modulate0(Fp, *kargs()); } SEAM(2);
    for (int l = 0; l < DEPTH; ++l) {
        const int pb = 3 + 10 * l; const bool last = (l + 1 == DEPTH);
        const size_t offH = (l & 1) ? WS_BUFB : WS_BUFA, offS = (l & 1) ? WS_BUFA : WS_BUFB;
        const int nPl = last ? 64 : 68, nrows = last ? ML : MT;
        if (IN(pb + 0)) REP(pb + 0) {
            PF(); bf16* Hb = (bf16*)(ws + offH);
            pg8::PlainSched S{(const char*)Hb, (const char*)((bf16*)(ws + WS_WIN) + (size_t)l * UW * DM), DM, DM, DM, 68, 16, Fp.G, bx};
            pg8::EpiBf16 E{(bf16*)(ws + WS_UREG), UW};
            pg8::gemm_phase(Fp.lds + RING_OFF, S, E, DM, DM, Fp.tid);
        } SEAM(pb + 0);
        if (IN(pb + 1)) REP(pb + 1) { PF(); enorm_phase(Fp, *kargs(), l); } SEAM(pb + 1);
        if (IN(pb + 2)) REP(pb + 2) { PF();
            pg8::PlainSched S{(const char*)(ws + WS_UREG), (const char*)((bf16*)(ws + WS_WUP) + (size_t)l * 1792 * 512), UW, 512, 512, 68, 7, Fp.G, bx};
            pg8::EpiBf16 E{(bf16*)(ws + WS_QKVA), QW};
            pg8::gemm_phase(Fp.lds + RING_OFF, S, E, UW, 512, Fp.tid);
        } SEAM(pb + 2);
        if (IN(pb + 3)) REP(pb + 3) { PF(); att_phase(Fp, l); } SEAM(pb + 3);
        if (IN(pb + 4)) REP(pb + 4) { PF(); bf16* Hb = (bf16*)(ws + offH); bf16* Sb = (bf16*)(ws + offS);
            pg8::MergeSched S{(const char*)Hb, (const char*)(ws + WS_OQP), (const char*)((bf16*)(ws + WS_WC) + (size_t)l * 4 * DM * 2560), nPl, Fp.G, bx};
            pg8::EpiMerge E{Sb, G(kargs()->in.b_gate) + (size_t)l * 4 * DM, (char*)(ws + WS_STASH) + (size_t)bx * STASH_WG, (char*)(ws + WS_P) + (size_t)bx * P_WG, Fp.tid};
            pg8::gemm_phase(Fp.lds + RING_OFF, S, E, DM, 2560, Fp.tid);
        } SEAM(pb + 4);
        if (IN(pb + 5)) REP(pb + 5) { PF(); bf16* Sb = (bf16*)(ws + offS);
            pg8::PlainSched S{(const char*)Sb, (const char*)((bf16*)(ws + WS_WO) + (size_t)l * DM * DM), DM, DM, DM, nPl, 8, Fp.G, bx};
            KAP ap = kargs();
            pg8::EpiOut E{(float*)(ws + WS_UREG), l == 0 ? G(ap->in.x) : (const float*)(ws + WS_XRES), l == 0 ? G(ap->in.ctx) : (const float*)(ws + WS_XRES) + (size_t)ML * DM,
                          (const float*)(ws + WS_MOD) + (size_t)l * 5 * MODW, ALPHA};
            pg8::gemm_phase(Fp.lds + RING_OFF, S, E, DM, DM, Fp.tid);
        } SEAM(pb + 5);
        if (IN(pb + 6)) REP(pb + 6) { PF(); ln1_phase(Fp, *kargs(), l, nrows, (bf16*)(ws + offH)); } SEAM(pb + 6);
        if (IN(pb + 7)) REP(pb + 7) { PF(); bf16* Hb = (bf16*)(ws + offH);
            pg8::PlainSched S{(const char*)Hb, (const char*)((bf16*)(ws + WS_WPQ) + (size_t)l * DM * DM), DM, DM, DM, nPl, 8, Fp.G, bx};
            pg8::EpiBf16 E{(bf16*)(ws + WS_OQP), DM};
            pg8::gemm_phase(Fp.lds + RING_OFF, S, E, DM, DM, Fp.tid);
        } SEAM(pb + 7);
        if (IN(pb + 8)) REP(pb + 8) { PF();
            const int gw = Fp.vcu * NWAVES + Fp.wave, NGW = Fp.G * NWAVES;
            LAS unsigned short* tblw = (LAS unsigned short*)(Fp.lds + RING_OFF) + Fp.wave * (64 * 66);
            for (int it = gw; it < (nrows / 32) * 8; it += NGW)
                peer::topk_item((const bf16*)(ws + WS_OQP), (const bf16*)(ws + WS_SUBK) + (size_t)l * 8 * 2 * 128 * 128, (int*)(ws + WS_EIDX), (float*)(ws + WS_EG), (it >> 3) * 32, it & 7, tblw, Fp.lane);
        } SEAM(pb + 8);
        if (IN(pb + 9)) REP(pb + 9) { PF(); pexp4_phase(Fp, *kargs(), l, nrows, (bf16*)(ws + offH), last ? G(kargs()->out) : (float*)(ws + WS_XRES), last ? nullptr : (bf16*)(ws + offS)); } SEAM(pb + 9);
    }
#undef IN
#undef INR
#undef SEAM
}

extern "C" void kernel_launch(void* const* d_in, const int* in_sizes, int n_in, void* d_out, int out_size, void* d_ws, size_t ws_size, hipStream_t stream) {
    static int grid = 0;
    if (grid == 0) {
        if (n_in != 27 || out_size != ML * DM || ws_size < WS_END) { fprintf(stderr, "kernel_launch: unexpected shapes (n_in %d out %d ws %zu, need ws >= %zu)\n", n_in, out_size, ws_size, (size_t)WS_END); grid = -1; return; }
        int dev = 0, cus = 0, per_cu = 0;
        if (hipGetDevice(&dev) != hipSuccess || hipDeviceGetAttribute(&cus, hipDeviceAttributeMultiprocessorCount, dev) != hipSuccess) { grid = -1; return; }
        if (hipFuncSetAttribute((const void*)mk_fwd, hipFuncAttributeMaxDynamicSharedMemorySize, LDS_BYTES) != hipSuccess) { fprintf(stderr, "kernel_launch: hipFuncSetAttribute failed\n"); grid = -1; return; }
        if (hipOccupancyMaxActiveBlocksPerMultiprocessor(&per_cu, (const void*)mk_fwd, NWAVES * 64, LDS_BYTES) != hipSuccess || per_cu < 1) { fprintf(stderr, "kernel_launch: occupancy query says %d\n", per_cu); }
        (void)hipGetLastError();
        grid = cus < 256 ? cus : 256;
    }
    if (grid < 0) return;
    (void)hipMemsetAsync((char*)d_ws + WS_CTL, 0, CTL_ZERO_BYTES, stream);
    Args a{};
    const float** ip = (const float**)&a.in;
    for (int i = 0; i < 27; ++i) ip[i] = (const float*)d_in[i];
    a.out = (float*)d_out; a.ws = (unsigned char*)d_ws;
    for (int li = 0; li < MK_N_LAUNCHES; ++li) {
        a.ph_lo = (MK_N_LAUNCHES == 1) ? 0 : li; a.ph_hi = (MK_N_LAUNCHES == 1) ? N_PHASES : li + 1; a.li = li; a.pad = 0;
        hipLaunchKernelGGL(mk_fwd, dim3(grid), dim3(NWAVES * 64), LDS_BYTES, stream, a);
    }
}
```

```cpp
#include <hip/hip_runtime.h>
#include <cstdio>
#include <cstdint>
#include <utility>

#define GAS __attribute__((address_space(1)))
#define LAS __attribute__((address_space(3)))
typedef unsigned short bf16;
typedef short bf16x8 __attribute__((ext_vector_type(8)));
typedef short s16x4 __attribute__((ext_vector_type(4)));
typedef float f32x2 __attribute__((ext_vector_type(2)));
typedef float f32x4 __attribute__((ext_vector_type(4)));
typedef float f32x16 __attribute__((ext_vector_type(16)));
typedef unsigned u32x2 __attribute__((ext_vector_type(2)));
typedef unsigned u32x4 __attribute__((ext_vector_type(4)));
typedef GAS unsigned gu32;

__device__ __forceinline__ unsigned cvt_pk_bf16(float lo, float hi) { unsigned r; asm volatile("v_cvt_pk_bf16_f32 %0, %1, %2" : "=v"(r) : "v"(lo), "v"(hi)); return r; }
__device__ __forceinline__ float bf2f(unsigned short b) { return __uint_as_float(((unsigned)b) << 16); }
__device__ __forceinline__ float bflo(unsigned w) { return __uint_as_float(w << 16); }
__device__ __forceinline__ float bfhi(unsigned w) { return __uint_as_float(w & 0xffff0000u); }
__device__ __forceinline__ unsigned short f2bf(float f) { return (unsigned short)(cvt_pk_bf16(f, 0.f) & 0xffffu); }

namespace pg8 {
constexpr int BM = 256, BK = 64, HALF = 128, HTB = HALF * BK * 2  , STAGE_BYTES = 8 * HTB, NXCD = 8, WGM = 8;
__host__ __device__ __forceinline__ int lds_byte(int r, int c) { const int st = (r >> 4) * 2 + (c >> 5), rr = r & 15, cc = c & 31, ob = rr * 64 + cc * 2; return st * 1024 + (ob ^ (((ob >> 9) & 1) << 5)); }
__host__ __device__ __forceinline__ void stage_rc(int b, int& R, int& C) { const int st = b / 1024, sb = b % 1024, swz = sb ^ (((sb >> 9) & 1) << 5); R = (st >> 1) * 16 + swz / 64; C = (st & 1) * 32 + (swz % 64) / 2; }
__host__ __device__ __forceinline__ int perm32(int rho) { const int n = rho >> 4, i = rho & 15; return 8 * (i >> 2) + 4 * n + (i & 3); }

struct Unit { int pm, pn, z, aux; };

__device__ __forceinline__ void tile_of(int L, int nM, int nN, int& pm, int& pn) {
    const int nwg = nM * nN; int wgid = L;
    { const int q = nwg / NXCD, r = nwg % NXCD, xcd = wgid % NXCD, off = wgid / NXCD; wgid = (xcd < r ? xcd * (q + 1) : r * (q + 1) + (xcd - r) * q) + off; }
    const int nig = WGM * nN, gid = wgid / nig, fm = gid * WGM, gsz = (nM - fm) < WGM ? (nM - fm) : WGM;
    pm = fm + ((wgid % nig) % gsz); pn = (wgid % nig) / gsz;
}
struct PlainSched {
    const char* A; const char* B; int lda, ldb, K, nM, nN, G, c;
    __device__ __forceinline__ bool next(int i, Unit& u) const { const long L = (long)i * G + c; if (L >= (long)nM * nN) return false; tile_of((int)L, nM, nN, u.pm, u.pn); u.z = 0; u.aux = 0; return true; }
    __device__ __forceinline__ void ptrs(const Unit& u, const char*& a, const char*& b, int& nt) const { a = A + (size_t)u.pm * BM * lda * 2; b = B + (size_t)u.pn * BM * ldb * 2; nt = K / BK; }
};
struct MergeSched {
    const char* H; const char* O; const char* W; int nM, G, c;
    __device__ __forceinline__ bool next(int i, Unit& u) const {
        const int ngl = (512 - c + G - 1) / G;
        if (i < 8 * ngl) { tile_of((i >> 3) * G + c, 64, 8, u.pm, u.pn); u.z = i & 7; u.aux = 0; return true; }
        if (nM <= 64) return false;
        const int t = i - 8 * ngl, j = c + (t >> 1) * G; if (j >= 128) return false;
        const int T = j >> 2; u.pm = 64 + (T >> 3); u.pn = T & 7; u.z = 8 + (j & 3) * 2 + (t & 1); u.aux = j; return true;
    }
    __device__ __forceinline__ void ptrs(const Unit& u, const char*& a, const char*& b, int& nt) const {
        const int z = (u.z & 7) >> 1, kind = u.z & 1;
        a = (kind ? H : O + (size_t)z * 512 * 2) + (size_t)u.pm * BM * 2048 * 2;
        b = W + ((size_t)z * 2048 * 2560 + (size_t)u.pn * BM * 2560 + (kind ? 0 : 2048)) * 2;
        nt = kind ? 32 : 8;
    }
};

struct EpiBf16 {
    static constexpr bool PERM = true;
    bf16* O; int ldc;
    __device__ __forceinline__ void operator()(const f32x4 (&acc)[2][2][4][2], const Unit& u, int wr, int wc, int fr, int fq) const {
        const int row0 = u.pm * BM + wr * 64 + fr, col0 = u.pn * BM + wc * 32 + 8 * fq;
#pragma unroll
        for (int ai = 0; ai < 2; ++ai)
#pragma unroll
            for (int m = 0; m < 4; ++m) { bf16* rowp = O + (size_t)(row0 + ai * HALF + m * 16) * ldc + col0;
#pragma unroll
                for (int bj = 0; bj < 2; ++bj) { const f32x4 v0 = acc[ai][bj][m][0], v1 = acc[ai][bj][m][1];
                    u32x4 w; w.x = cvt_pk_bf16(v0[0], v0[1]); w.y = cvt_pk_bf16(v0[2], v0[3]); w.z = cvt_pk_bf16(v1[0], v1[1]); w.w = cvt_pk_bf16(v1[2], v1[3]);
                    *(u32x4*)(rowp + bj * HALF) = w; } }
    }
};
struct EpiMerge {
    static constexpr bool PERM = true;
    bf16* S; const float* bgate; char* stash; char* P; char* CP; int tid;
    __device__ __forceinline__ void operator()(const f32x4 (&acc)[2][2][4][2], const Unit& u, int wr, int wc, int fr, int fq) const {
        const int z = (u.z & 7) >> 1, kind = u.z & 1; const bool cx = u.z >= 8; int tl = tid; asm volatile("" : "+v"(tl));
        GAS char* sp = (GAS char*)stash + (size_t)tl * 16;
        if (kind == 0) {
#pragma unroll
            for (int ai = 0; ai < 2; ++ai)
#pragma unroll
                for (int m = 0; m < 4; ++m)
#pragma unroll
                    for (int bj = 0; bj < 2; ++bj) { const f32x4 v0 = acc[ai][bj][m][0], v1 = acc[ai][bj][m][1];
                        u32x4 w; w.x = cvt_pk_bf16(v0[0], v0[1]); w.y = cvt_pk_bf16(v0[2], v0[3]); w.z = cvt_pk_bf16(v1[0], v1[1]); w.w = cvt_pk_bf16(v1[2], v1[3]);
                        *(GAS u32x4*)sp = w; sp += 8192; asm volatile("" : "+v"(sp)); }
            return;
        }
        GAS char* pq = (cx ? (GAS char*)CP + (size_t)u.aux * 262144 : (GAS char*)P) + (size_t)tl * 16;
        const int row0 = u.pm * BM + wr * 64 + fr, col0 = u.pn * BM + wc * 32 + 8 * fq;
        const float* bz = bgate + z * 2048 + col0;
        f32x4 bv[2][2];
#pragma unroll
        for (int bj = 0; bj < 2; ++bj)
#pragma unroll
            for (int n = 0; n < 2; ++n) bv[bj][n] = *(const f32x4*)(bz + bj * HALF + 4 * n);
        GAS bf16* rowp = (GAS bf16*)S + (size_t)row0 * 2048 + col0;
#pragma unroll
        for (int ai = 0; ai < 2; ++ai)
#pragma unroll
            for (int m = 0; m < 4; ++m) {
#pragma unroll
                for (int bj = 0; bj < 2; ++bj) {
                    const u32x4 sw = *(const GAS u32x4*)sp; sp += 8192; asm volatile("" : "+v"(sp));
                    f32x4 v0 = acc[ai][bj][m][0] + bv[bj][0], v1 = acc[ai][bj][m][1] + bv[bj][1];
#pragma unroll
                    for (int j = 0; j < 4; ++j) { v0[j] = __builtin_amdgcn_rcpf(1.0f + __builtin_amdgcn_exp2f(-1.4426950408889634f * v0[j])); v1[j] = __builtin_amdgcn_rcpf(1.0f + __builtin_amdgcn_exp2f(-1.4426950408889634f * v1[j])); }
                    v0[0] *= bflo(sw.x); v0[1] *= bfhi(sw.x); v0[2] *= bflo(sw.y); v0[3] *= bfhi(sw.y);
                    v1[0] *= bflo(sw.z); v1[1] *= bfhi(sw.z); v1[2] *= bflo(sw.w); v1[3] *= bfhi(sw.w);
                    if (z > 0 && !cx) { v0 += *(const GAS f32x4*)pq; v1 += *(const GAS f32x4*)(pq + 8192); }
                    if (z < 3 || cx) { *(GAS f32x4*)pq = v0; *(GAS f32x4*)(pq + 8192) = v1; }
                    else { u32x4 w; w.x = cvt_pk_bf16(v0[0], v0[1]); w.y = cvt_pk_bf16(v0[2], v0[3]); w.z = cvt_pk_bf16(v1[0], v1[1]); w.w = cvt_pk_bf16(v1[2], v1[3]);
                        *(GAS u32x4*)(rowp + bj * HALF) = w; }
                    pq += 16384; asm volatile("" : "+v"(pq));
                }
                rowp += (m == 3 ? (size_t)(HALF - 48) : (size_t)16) * 2048; asm volatile("" : "+v"(rowp));
                asm volatile("" ::: "memory"); }
    }
};
struct EpiOut {
    static constexpr bool PERM = false;
    float* Y; const float* xlat; const float* xctx; const float* mod_l; float alpha;
    __device__ __forceinline__ void operator()(const f32x4 (&acc)[2][2][4][2], const Unit& u, int wr, int wc, int fr, int fq) const {
        const int row0 = u.pm * BM + wr * 64 + fr, col0 = u.pn * BM + wc * 32 + 4 * fq;
        const float* xb = (u.pm < 64) ? xlat + (size_t)row0 * 2048 : xctx + (size_t)(row0 - 16384) * 2048;
        const float* ga = mod_l + (size_t)((u.pm < 64) ? (u.pm >> 4) : 4) * 12288 + 2 * 2048 + col0;
        f32x4 gv[2][2];
#pragma unroll
        for (int bj = 0; bj < 2; ++bj)
#pragma unroll
            for (int n = 0; n < 2; ++n) gv[bj][n] = *(const f32x4*)(ga + bj * HALF + n * 16);
#pragma unroll
        for (int ai = 0; ai < 2; ++ai)
#pragma unroll
            for (int m = 0; m < 4; ++m) { const size_t ro = (size_t)(ai * HALF + m * 16) * 2048 + col0; float* yp = Y + (size_t)row0 * 2048 + ro;
#pragma unroll
                for (int bj = 0; bj < 2; ++bj)
#pragma unroll
                    for (int n = 0; n < 2; ++n) { const f32x4 xv = *(const f32x4*)(xb + ro + bj * HALF + n * 16); *(f32x4*)(yp + bj * HALF + n * 16) = xv * alpha + gv[bj][n] * acc[ai][bj][m][n]; } }
    }
};

template <class Epi, class Sched>
__device__ __forceinline__ void gemm_phase(LAS unsigned char* lds, const Sched& S, const Epi& E, const int lda, const int ldb, const int tid) {
    const int wid = __builtin_amdgcn_readfirstlane(tid >> 6), lane = tid & 63, wr = wid >> 2, wc = wid & 3, fr = lane & 15, fq = lane >> 4;
    unsigned voffA[2], voffB[2];
#pragma unroll
    for (int i = 0; i < 2; ++i) { int R, C; stage_rc(tid * 16 + i * 8192, R, C); const int Rb = Epi::PERM ? ((R & ~31) + perm32(R & 31)) : R;
        voffA[i] = (unsigned)(R * lda + C) * 2u; voffB[i] = (unsigned)(Rb * ldb + C) * 2u; }
    const size_t kstep = (size_t)(BK * 2);
    const size_t hstepA = (size_t)HALF * lda * 2, hstepB = (size_t)HALF * ldb * 2;
    const unsigned ldsw = (unsigned)wid * 1024u;
    const int aoff = lds_byte(wr * 64 + fr, fq * 8), boff = lds_byte(wc * 32 + fr, fq * 8);
#define PG8_SA(b, h) (((b) * 2 + (h)) * HTB)
#define PG8_SB(b, h) ((4 + (b) * 2 + (h)) * HTB)
#define PG8_STAGE(bufoff, gbase, voff) do { _Pragma("unroll") for (int _i = 0; _i < 2; ++_i) \
        __builtin_amdgcn_global_load_lds((const unsigned*)((const char*)(gbase) + (voff)[_i]), (LAS unsigned*)(lds + (bufoff) + ldsw + _i * 8192), 16, 0, 0); } while (0)
#define PG8_LDA(dst, b, h) do { _Pragma("unroll") for (int m = 0; m < 4; ++m) _Pragma("unroll") for (int k = 0; k < 2; ++k) dst[m][k] = *(const LAS bf16x8*)(lds + PG8_SA(b, h) + aoff + m * 2048 + k * 1024); } while (0)
#define PG8_LDB(dst, b, h) do { _Pragma("unroll") for (int n = 0; n < 2; ++n) _Pragma("unroll") for (int k = 0; k < 2; ++k) dst[n][k] = *(const LAS bf16x8*)(lds + PG8_SB(b, h) + boff + n * 2048 + k * 1024); } while (0)
#define PG8_MMA(ai, bj, At, Bt) do { __builtin_amdgcn_s_setprio(1); _Pragma("unroll") for (int m = 0; m < 4; ++m) _Pragma("unroll") for (int n = 0; n < 2; ++n) _Pragma("unroll") for (int k = 0; k < 2; ++k) \
        acc[ai][bj][m][n] = __builtin_amdgcn_mfma_f32_16x16x32_bf16(Bt[n][k], At[m][k], acc[ai][bj][m][n], 0, 0, 0); __builtin_amdgcn_s_setprio(0); } while (0)
#define PG8_WAIT_V(n) asm volatile("s_waitcnt vmcnt(" #n ")" ::: "memory")
#define PG8_WAIT_L(n) asm volatile("s_waitcnt lgkmcnt(" #n ")" ::: "memory")
#define PG8_BAR __builtin_amdgcn_s_barrier()
#define PG8_SCHED __builtin_amdgcn_sched_barrier(0)
    Unit cur, nxt; int ui = 0;
    if (!S.next(0, cur)) return;
    f32x4 acc[2][2][4][2];
#pragma unroll
    for (int a = 0; a < 2; ++a)
#pragma unroll
        for (int b = 0; b < 2; ++b)
#pragma unroll
            for (int m = 0; m < 4; ++m)
#pragma unroll
                for (int n = 0; n < 2; ++n) acc[a][b][m][n] = (f32x4){0.f, 0.f, 0.f, 0.f};
    bf16x8 At[4][2], B0[2][2], B1[2][2];
    const char* cA; const char* cB; int nt; S.ptrs(cur, cA, cB, nt);
    PG8_STAGE(PG8_SB(0, 0), cB, voffB); PG8_STAGE(PG8_SB(0, 1), cB + hstepB, voffB); PG8_STAGE(PG8_SA(0, 0), cA, voffA); PG8_STAGE(PG8_SA(0, 1), cA + hstepA, voffA);
    if (wr == 1) PG8_BAR;
    PG8_WAIT_V(2); PG8_BAR;
    PG8_STAGE(PG8_SB(1, 0), cB + kstep, voffB); PG8_STAGE(PG8_SA(1, 0), cA + kstep, voffA); PG8_STAGE(PG8_SB(1, 1), cB + hstepB + kstep, voffB);
    PG8_WAIT_V(6); PG8_BAR;
    for (;;) {
        const bool has_next = S.next(ui + 1, nxt);
        const char* nA = cA; const char* nB = cB; int nnt = nt; if (has_next) S.ptrs(nxt, nA, nB, nnt);
        for (int t = 0; t < nt; t += 2) {
            const bool last = (t == nt - 2);
            const char* a1 = cA + (size_t)(t + 1) * kstep;
            const char* a2 = last ? nA : cA + (size_t)(t + 2) * kstep; const char* b2 = last ? nB : cB + (size_t)(t + 2) * kstep;
            const char* a3 = a2 + kstep; const char* b3 = b2 + kstep;
            PG8_LDB(B0, 0, 0); PG8_LDB(B1, 0, 1); PG8_SCHED; PG8_LDA(At, 0, 0); PG8_STAGE(PG8_SA(1, 1), a1 + hstepA, voffA);
            PG8_WAIT_V(8); PG8_WAIT_L(0); PG8_BAR; PG8_MMA(0, 0, At, B0); PG8_MMA(0, 1, At, B1); PG8_BAR; PG8_SCHED;
            PG8_LDA(At, 0, 1); PG8_STAGE(PG8_SB(0, 0), b2, voffB); PG8_STAGE(PG8_SB(0, 1), b2 + hstepB, voffB); PG8_STAGE(PG8_SA(0, 0), a2, voffA);
            PG8_WAIT_V(8); PG8_WAIT_L(0); PG8_BAR; PG8_MMA(1, 0, At, B0); PG8_MMA(1, 1, At, B1); PG8_BAR; PG8_SCHED;
            PG8_LDB(B0, 1, 0); PG8_LDB(B1, 1, 1); PG8_SCHED; PG8_LDA(At, 1, 0); PG8_STAGE(PG8_SA(0, 1), a2 + hstepA, voffA);
            PG8_WAIT_V(8); PG8_WAIT_L(0); PG8_BAR; PG8_MMA(0, 0, At, B0); PG8_MMA(0, 1, At, B1); PG8_BAR; PG8_SCHED;
            PG8_LDA(At, 1, 1); PG8_STAGE(PG8_SB(1, 0), b3, voffB); PG8_STAGE(PG8_SB(1, 1), b3 + hstepB, voffB); PG8_STAGE(PG8_SA(1, 0), a3, voffA);
            PG8_WAIT_V(8); PG8_WAIT_L(0); PG8_BAR; PG8_MMA(1, 0, At, B0); PG8_MMA(1, 1, At, B1); PG8_BAR; PG8_SCHED;
        }
        if (wr == 0) PG8_BAR;
        E(acc, cur, wr, wc, fr, fq);
        if (!has_next) break;
#pragma unroll
        for (int a = 0; a < 2; ++a)
#pragma unroll
            for (int b = 0; b < 2; ++b)
#pragma unroll
                for (int m = 0; m < 4; ++m)
#pragma unroll
                    for (int n = 0; n < 2; ++n) acc[a][b][m][n] = (f32x4){0.f, 0.f, 0.f, 0.f};
        cur = nxt; cA = nA; cB = nB; nt = nnt; ++ui;
        if (wr == 1) PG8_BAR;
    }
    PG8_WAIT_V(0);
    PG8_BAR;
#undef PG8_SA
#undef PG8_SB
#undef PG8_STAGE
#undef PG8_LDA
#undef PG8_LDB
#undef PG8_MMA
#undef PG8_WAIT_V
#undef PG8_WAIT_L
#undef PG8_BAR
#undef PG8_SCHED
}
}
namespace att {
constexpr int NW = 8, QBLK = 32, KVBLK = 64;
#define SBAR() __builtin_amdgcn_sched_barrier(0)
__device__ __forceinline__ int crow(int r, int hi) { return (r & 3) + 8 * (r >> 2) + 4 * hi; }
__device__ __forceinline__ unsigned cvtpk(float lo, float hi) { unsigned r; asm volatile("v_cvt_pk_bf16_f32 %0, %1, %2" : "=v"(r) : "v"(lo), "v"(hi)); return r; }

struct Args {
    const bf16* Q; int ldq;
    const bf16* KV; int ld;
    int kc0, kc1, vc;
    bf16* O; int ldo;
    int n0, n1, row0, row1;
    float C, thr;
    int qrope, qpos0;
    float sinkl2; int has_sink;
    int wpos0;
    const float* T; int r0, kr0;
};

__device__ __forceinline__ void partialSM(f32x16& p0, f32x16& p1, float& m_reg, float& mn, float& alpha, const float C, const float thr) {
    float pmax = p0[0];
#pragma unroll
    for (int r = 1; r < 16; ++r) pmax = fmaxf(pmax, p0[r]);
#pragma unroll
    for (int r = 0; r < 16; ++r) pmax = fmaxf(pmax, p1[r]);
    { auto rr = __builtin_amdgcn_permlane32_swap(__float_as_uint(pmax), __float_as_uint(pmax), false, false);
      pmax = fmaxf(__uint_as_float(rr[0]), __uint_as_float(rr[1])); }
    if (__builtin_expect(__all(pmax - m_reg <= thr), 1)) { mn = m_reg; alpha = 1.f; }
    else { mn = fmaxf(m_reg, pmax); alpha = __builtin_amdgcn_exp2f((m_reg - mn) * C); m_reg = mn; }
    const float mnC = -mn * C;
#pragma unroll
    for (int r = 0; r < 16; ++r) p0[r] = fmaf(p0[r], C, mnC);
#pragma unroll
    for (int r = 0; r < 16; ++r) p1[r] = fmaf(p1[r], C, mnC);
#pragma unroll
    for (int r = 0; r < 16; ++r) p0[r] = __builtin_amdgcn_exp2f(p0[r]);
}
__device__ __forceinline__ void finishSM(f32x16& p0, f32x16& p1, float alpha, float& l_reg, bf16x8& pa0, bf16x8& pa1, bf16x8& pa2, bf16x8& pa3) {
#pragma unroll
    for (int r = 0; r < 16; ++r) p1[r] = __builtin_amdgcn_exp2f(p1[r]);
    float ps = 0;
#pragma unroll
    for (int r = 0; r < 16; ++r) ps += p0[r];
#pragma unroll
    for (int r = 0; r < 16; ++r) ps += p1[r];
    { auto rr = __builtin_amdgcn_permlane32_swap(__float_as_uint(ps), __float_as_uint(ps), false, false);
      ps = __uint_as_float(rr[0]) + __uint_as_float(rr[1]); }
    l_reg = l_reg * alpha + ps;
#define PK4(P, BASE, OUT) do { unsigned a0 = cvtpk(P[BASE + 0], P[BASE + 1]), a1 = cvtpk(P[BASE + 2], P[BASE + 3]);   \
    unsigned b0 = cvtpk(P[BASE + 4], P[BASE + 5]), b1 = cvtpk(P[BASE + 6], P[BASE + 7]);                              \
    auto r0 = __builtin_amdgcn_permlane32_swap(a0, b0, false, false); auto r1 = __builtin_amdgcn_permlane32_swap(a1, b1, false, false); \
    u32x4 w = {r0[0], r1[0], r0[1], r1[1]}; OUT = *reinterpret_cast<bf16x8*>(&w); } while (0)
    PK4(p0, 0, pa0); PK4(p0, 8, pa1); PK4(p1, 0, pa2); PK4(p1, 8, pa3);
#undef PK4
}
template <int DK> __device__ __forceinline__ int kswz(int row, int ch) { return row * (DK * 2) + ((ch ^ (row & 7)) << 4); }
template <int DK, int QREG> __device__ __forceinline__ void qkt(f32x16& p0, f32x16& p1, const LAS char* Ks, const bf16x8* qr, const LAS char* qx, int r32, int hi) {
    p0 = f32x16{}; p1 = f32x16{};
#pragma unroll
    for (int d0 = 0; d0 < DK / 16; ++d0) { const int ch = d0 * 2 + hi;
        const bf16x8 b0 = *(const LAS bf16x8*)(Ks + kswz<DK>(r32, ch));
        const bf16x8 b1 = *(const LAS bf16x8*)(Ks + kswz<DK>(32 + r32, ch));
        bf16x8 q; if constexpr (true) { if (d0 < QREG) q = qr[d0 < QREG ? d0 : 0]; else q = *(const LAS bf16x8*)(qx + (d0 - QREG) * 1024); }
        p0 = __builtin_amdgcn_mfma_f32_32x32x16_bf16(b0, q, p0, 0, 0, 0);
        p1 = __builtin_amdgcn_mfma_f32_32x32x16_bf16(b1, q, p1, 0, 0, 0); }
}
template <int NCB> __device__ __forceinline__ int v_st(int k, int c) { const int kk = (k & ~0xC) | ((k & 4) << 1) | ((k & 8) >> 1); return ((kk >> 3) * NCB + (c >> 5)) * 512 + ((kk & 7) * 32 + (c & 31)) * 2; }
__device__ __forceinline__ int v_rd_base(int lane) { return ((lane & 3) << 3) | (((lane >> 2) & 3) << 6) | (((lane >> 4) & 1) << 5) | (((lane >> 5) & 1) << 8); }
template <int OFF> __device__ __forceinline__ s16x4 tr_read(int vb) { s16x4 r; asm volatile("ds_read_b64_tr_b16 %0, %1 offset:%2" : "=&v"(r) : "v"(vb), "i"(OFF) : "memory"); return r; }
template <int D0, int NCB> __device__ __forceinline__ void pv_one(f32x16& od, int vb, bf16x8 pa0, bf16x8 pa1, bf16x8 pa2, bf16x8 pa3) {
#define VOFF(ks, half) (D0 * 512 + (ks) * (2 * NCB * 512) + (half) * (NCB * 512))
    const s16x4 l0 = tr_read<VOFF(0, 0)>(vb), h0 = tr_read<VOFF(0, 1)>(vb), l1 = tr_read<VOFF(1, 0)>(vb), h1 = tr_read<VOFF(1, 1)>(vb);
    const s16x4 l2 = tr_read<VOFF(2, 0)>(vb), h2 = tr_read<VOFF(2, 1)>(vb), l3 = tr_read<VOFF(3, 0)>(vb), h3 = tr_read<VOFF(3, 1)>(vb);
#undef VOFF
    asm volatile("s_waitcnt lgkmcnt(0)" ::: "memory"); SBAR();
#define PK(L, H) (bf16x8){L[0], L[1], L[2], L[3], H[0], H[1], H[2], H[3]}
    od = __builtin_amdgcn_mfma_f32_32x32x16_bf16(pa0, PK(l0, h0), od, 0, 0, 0);
    od = __builtin_amdgcn_mfma_f32_32x32x16_bf16(pa1, PK(l1, h1), od, 0, 0, 0);
    od = __builtin_amdgcn_mfma_f32_32x32x16_bf16(pa2, PK(l2, h2), od, 0, 0, 0);
    od = __builtin_amdgcn_mfma_f32_32x32x16_bf16(pa3, PK(l3, h3), od, 0, 0, 0);
#undef PK
}
template <int NCB> __device__ __forceinline__ void pv_all(f32x16* o, int vb, bf16x8 pa0, bf16x8 pa1, bf16x8 pa2, bf16x8 pa3) {
    pv_one<0, NCB>(o[0], vb, pa0, pa1, pa2, pa3); pv_one<1, NCB>(o[1], vb, pa0, pa1, pa2, pa3);
    if constexpr (NCB == 4) { pv_one<2, NCB>(o[2], vb, pa0, pa1, pa2, pa3); pv_one<3, NCB>(o[3], vb, pa0, pa1, pa2, pa3); }
}

template <int MODE> __device__ __forceinline__ void apply_mask(f32x16& p0, f32x16& p1, const Args& a, int j, int wid, int r32, int hi) {
    if constexpr (MODE == 1) {
        if (j < a.n0) return;
        const int kp0 = a.wpos0 + 64 * (j - a.n0), qw0 = a.qpos0 + wid * 32;
        if (kp0 + 63 - qw0 <= 128 && qw0 + 31 - kp0 <= 128) return;
        const int dd0 = kp0 - (qw0 + r32) + 4 * hi + 128;
#pragma unroll
        for (int r = 0; r < 16; ++r) { const int dd = dd0 + (r & 3) + 8 * (r >> 2);
            p0[r] = ((unsigned)dd <= 256u) ? p0[r] : -1e30f; p1[r] = ((unsigned)(dd + 32) <= 256u) ? p1[r] : -1e30f; }
    } else if constexpr (MODE == 2) {
        if (j < a.n0) return;
        const int kr = a.kr0 + (j - a.n0), qr = a.r0 + (wid >> 1);
        int rs = qr - 4; rs = rs < 0 ? 0 : (rs > 56 ? 56 : rs);
        if (kr < rs || kr >= rs + 8) {
#pragma unroll
            for (int r = 0; r < 16; ++r) { p0[r] = -1e30f; p1[r] = -1e30f; }
            return; }
        const int dr = kr - qr + 7, qc = (wid & 1) * 32 + r32;
        const float* tb = a.T + ((size_t)(dr * 64 + qc)) * 64 + 4 * hi;
#pragma unroll
        for (int g = 0; g < 4; ++g) { const f32x4 t0 = *(const f32x4*)(tb + 8 * g), t1 = *(const f32x4*)(tb + 32 + 8 * g);
#pragma unroll
            for (int i = 0; i < 4; ++i) { p0[4 * g + i] += t0[i]; p1[4 * g + i] += t1[i]; }
            asm volatile("" ::: "memory"); }
    }
}

template <int DK, int DV, int MODE, int SDEPTH>
__device__ __forceinline__ void attn_unit(const Args& a, LAS char* lds, const int tid) {
    constexpr int NKC = DK / 8, NVC = DV / 8, KPT = DK / 64, VPT = DV / 64, NCB = DV / 32, ND0 = DK / 16, QREG = (ND0 > 8 ? 4 : ND0);
    constexpr int SHM_K = 64 * DK * 2, SHM_V = 64 * DV * 2;
    const int wid = __builtin_amdgcn_readfirstlane(tid >> 6), lane = tid & 63, r32 = lane & 31, hi = lane >> 5;
    LAS char* V_lds = lds; LAS char* K_lds = lds + 2 * SHM_V;
    LAS float* ws = (LAS float*)(lds + 2 * SHM_V + 2 * SHM_K) + wid * 64; LAS float* li_l = ws; LAS float* al_l = ws + 32;
    LAS char* qx = lds + 2 * SHM_V + 2 * SHM_K + NW * 256 + wid * ((ND0 - QREG) * 1024) + lane * 16;
    float m_reg = -1e30f, l_reg = 0; f32x16 o[NCB]; bf16x8 qr[ND0];
#pragma unroll
    for (int d = 0; d < NCB; ++d) o[d] = f32x16{};
    const bf16* Qw = a.Q + (long)(wid * QBLK + r32) * a.ldq + hi * 8;
#pragma unroll
    for (int d0 = 0; d0 < ND0; ++d0) qr[d0] = *(const bf16x8*)(Qw + d0 * 16);
    if constexpr (DK == 192) {
        if (a.qrope) {
            const int t = a.qpos0 + wid * QBLK + r32; const float prow = (float)(t >> 6), pcol = (float)(t & 63);
#pragma unroll
            for (int dd = 0; dd < 2; ++dd) {
                bf16x8 x1 = qr[8 + dd], x2 = qr[10 + dd]; const float pos = dd ? pcol : prow;
#pragma unroll
                for (int e = 0; e < 8; ++e) { const float inv = __builtin_amdgcn_exp2f(-(float)(hi * 8 + e) * (13.287712379549449f / 16.0f)); const float ang = pos * inv;
                    const float c = __cosf(ang), s = __sinf(ang); const float f1 = bf2f((unsigned short)x1[e]), f2 = bf2f((unsigned short)x2[e]);
                    x1[e] = (short)f2bf(f1 * c - f2 * s); x2[e] = (short)f2bf(f1 * s + f2 * c); }
                qr[8 + dd] = x1; qr[10 + dd] = x2; }
        }
#pragma unroll
        for (int d0 = QREG; d0 < ND0; ++d0) *(LAS bf16x8*)(qx + (d0 - QREG) * 1024) = qr[d0];
        asm volatile("s_waitcnt lgkmcnt(0)" ::: "memory");
    }
    int koff[KPT], klds[KPT], voff[VPT], vlds[VPT];
#pragma unroll
    for (int i = 0; i < KPT; ++i) { const int q = tid + 512 * i, row = q / NKC, ch = q % NKC; koff[i] = row * a.ld + (ch < 16 ? a.kc0 + 8 * ch : a.kc1 + 8 * (ch - 16)); klds[i] = kswz<DK>(row, ch); }
#pragma unroll
    for (int i = 0; i < VPT; ++i) { const int q = tid + 512 * i, row = q / NVC, ch = q % NVC; voff[i] = row * a.ld + a.vc + 8 * ch; vlds[i] = v_st<NCB>(row, 8 * ch); }
    const int vb0 = (int)(uintptr_t)V_lds + v_rd_base(lane);
    bf16x8 sk[SDEPTH][KPT], sv[SDEPTH][VPT];
    const int NT = a.n0 + a.n1;
#define TROW(j) ((j) < a.n0 ? a.row0 + 64 * (j) : a.row1 + 64 * ((j) - a.n0))
#define SLOAD(i, j) do { const bf16* _b = a.KV + (long)TROW(j) * a.ld; \
    _Pragma("unroll") for (int _k = 0; _k < VPT; ++_k) sv[i][_k] = *(const bf16x8*)(_b + voff[_k]); \
    _Pragma("unroll") for (int _k = 0; _k < KPT; ++_k) sk[i][_k] = *(const bf16x8*)(_b + koff[_k]); } while (0)
#define SWRITE(b, i) do { \
    _Pragma("unroll") for (int _k = 0; _k < VPT; ++_k) *(LAS bf16x8*)(V_lds + (b) * SHM_V + vlds[_k]) = sv[i][_k]; \
    _Pragma("unroll") for (int _k = 0; _k < KPT; ++_k) *(LAS bf16x8*)(K_lds + (b) * SHM_K + klds[_k]) = sk[i][_k]; } while (0)
#define SWAIT() do { if constexpr (SDEPTH == 2) asm volatile("s_waitcnt vmcnt(%0)" :: "n"(KPT + VPT) : "memory"); else asm volatile("s_waitcnt vmcnt(0)" ::: "memory"); } while (0)
#define RESC(al) do { if (__any((al) < 1.f)) { if (hi == 0) al_l[r32] = (al); asm volatile("s_waitcnt lgkmcnt(0)" ::: "memory"); \
    _Pragma("unroll") for (int d = 0; d < NCB; ++d) _Pragma("unroll") for (int r = 0; r < 16; ++r) o[d][r] *= al_l[crow(r, hi)]; } } while (0)
    f32x16 pA0, pA1, pB0, pB1; float mnA, mnB, alA, alB; bf16x8 pa0, pa1, pa2, pa3;
    constexpr int SE = 0, SO = SDEPTH - 1;
    SLOAD(SE, 0); asm volatile("s_waitcnt vmcnt(0)" ::: "memory"); SWRITE(0, SE); __syncthreads();
    qkt<DK, QREG>(pA0, pA1, K_lds, qr, qx, r32, hi); apply_mask<MODE>(pA0, pA1, a, 0, wid, r32, hi); partialSM(pA0, pA1, m_reg, mnA, alA, a.C, a.thr);
    SLOAD(SO, 1); if constexpr (SDEPTH == 2) { if (2 < NT) SLOAD(SE, 2); }
    SWAIT(); SWRITE(1, SO); __syncthreads();
    for (int j = 1; j + 1 < NT; j += 2) {
        SBAR(); qkt<DK, QREG>(pB0, pB1, K_lds + SHM_K, qr, qx, r32, hi);
        finishSM(pA0, pA1, alA, l_reg, pa0, pa1, pa2, pa3); SBAR();
        SLOAD(SO, j + SDEPTH); SBAR();
        pv_all<NCB>(o, vb0, pa0, pa1, pa2, pa3); if constexpr (MODE != 0) SBAR(); apply_mask<MODE>(pB0, pB1, a, j, wid, r32, hi); if constexpr (MODE != 0) SBAR(); partialSM(pB0, pB1, m_reg, mnB, alB, a.C, a.thr);
        __syncthreads(); SWAIT(); SWRITE(0, SE);
        RESC(alB); __syncthreads();
        SBAR(); qkt<DK, QREG>(pA0, pA1, K_lds, qr, qx, r32, hi);
        finishSM(pB0, pB1, alB, l_reg, pa0, pa1, pa2, pa3); SBAR();
        if (SDEPTH == 1 || j + 3 < NT) SLOAD(SE, j + 1 + SDEPTH); SBAR();
        pv_all<NCB>(o, vb0 + SHM_V, pa0, pa1, pa2, pa3); if constexpr (MODE != 0) SBAR(); apply_mask<MODE>(pA0, pA1, a, j + 1, wid, r32, hi); if constexpr (MODE != 0) SBAR(); partialSM(pA0, pA1, m_reg, mnA, alA, a.C, a.thr);
        __syncthreads(); SWAIT(); SWRITE(1, SO);
        RESC(alA); __syncthreads();
    }
    SBAR(); qkt<DK, QREG>(pB0, pB1, K_lds + SHM_K, qr, qx, r32, hi);
    finishSM(pA0, pA1, alA, l_reg, pa0, pa1, pa2, pa3); SBAR();
    pv_all<NCB>(o, vb0, pa0, pa1, pa2, pa3); if constexpr (MODE != 0) SBAR(); apply_mask<MODE>(pB0, pB1, a, NT - 1, wid, r32, hi); if constexpr (MODE != 0) SBAR(); partialSM(pB0, pB1, m_reg, mnB, alB, a.C, a.thr);
    __syncthreads(); RESC(alB);
    finishSM(pB0, pB1, alB, l_reg, pa0, pa1, pa2, pa3); SBAR();
    pv_all<NCB>(o, vb0 + SHM_V, pa0, pa1, pa2, pa3);
    if constexpr (MODE == 1) { if (a.has_sink) l_reg += __builtin_amdgcn_exp2f(a.sinkl2 - m_reg * a.C); }
    if (hi == 0) li_l[r32] = l_reg; asm volatile("s_waitcnt lgkmcnt(0)" ::: "memory");
    float rli[16];
#pragma unroll
    for (int r = 0; r < 16; ++r) rli[r] = __builtin_amdgcn_rcpf(li_l[crow(r, hi)]);
    bf16* Ow = a.O + (long)(wid * QBLK) * a.ldo;
#pragma unroll
    for (int r = 0; r < 16; ++r) { const int orow = crow(r, hi);
#pragma unroll
        for (int d0 = 0; d0 < NCB; ++d0) Ow[(long)orow * a.ldo + d0 * 32 + r32] = f2bf(o[d0][r] * rli[r]); }
    __syncthreads();
#undef TROW
#undef SLOAD
#undef SWRITE
#undef SWAIT
#undef RESC
}
#undef SBAR
}
constexpr int DM = 2048, NBATCH = 4, SEQ = 4096, NCTX = 256, DEPTH = 2;
constexpr int ML = NBATCH * SEQ, MC = NBATCH * NCTX, MT = ML + MC;
constexpr int INW = 3904, UW = 4096, QW = 1856;
constexpr int MODW = 6 * DM;
constexpr float LN_EPS = 1e-5f, RMS_EPS = 1e-6f;
constexpr float ALPHA = 1.4142135623730951f;
constexpr float LOG2E = 1.4426950408889634f;
constexpr float A_SCALE = 0.07216878364870323f, B_SCALE = 0.125f, C_SCALE = 0.08838834764831845f, D_SCALE = 0.08838834764831845f;
constexpr int U_CQ = 0, U_CKV = 384, U_KR = 512, U_BQ = 576, U_BK = 1088, U_BV = 1216, U_CQQ = 1344, U_CK = 1856, U_CV = 2368, U_DQ = 2880, U_DK = 3392, U_DV = 3648;
constexpr int QA_Q = 0, QA_KV = 768, QA_KR = 1792;

constexpr size_t MiB = 1u << 20;
constexpr size_t WS_CTL = 0, CTL_ZERO_BYTES = 1 * MiB;
constexpr size_t WS_MOD = 1 * MiB;
constexpr size_t WS_CTAB = 2 * MiB;
constexpr size_t WS_SUBK = 4 * MiB;
constexpr size_t WS_WUP = 5 * MiB;
constexpr size_t WS_WIN = 9 * MiB;
constexpr size_t WS_WC = 41 * MiB;
constexpr size_t WS_WO = 121 * MiB;
constexpr size_t WS_WPQ = 137 * MiB;
constexpr size_t WS_PU = 153 * MiB;
constexpr size_t WS_PV = 281 * MiB;
constexpr size_t WS_BUFA = 409 * MiB;
constexpr size_t WS_BUFB = 477 * MiB;
constexpr size_t WS_UREG = 545 * MiB;
constexpr size_t WS_QKVA = 681 * MiB;
constexpr size_t WS_OQP = 743 * MiB;
constexpr size_t WS_XRES = 811 * MiB;
constexpr size_t WS_EIDX = 947 * MiB;
constexpr size_t WS_EG = 956 * MiB;
constexpr size_t WS_MODP = 965 * MiB;
constexpr size_t WS_SCU = 973 * MiB, WS_SCV = WS_SCU + 2 * 16384 * 4;
constexpr size_t WS_DBG = 973 * MiB + 512 * 1024;
constexpr size_t WS_END = 974 * MiB;
constexpr size_t STASH_WG = 131072, P_WG = 262144, WS_STASH = WS_UREG, WS_P = WS_UREG + 32 * MiB, WS_CP = WS_UREG + 96 * MiB;
constexpr int CW_TMO = 0, CW_BAR = 4096;

constexpr int NWAVES = 8;
constexpr int RING_OFF = 0, RING_BYTES = 155648;
constexpr int LDSCTL_OFF = RING_BYTES, MISC_OFF = LDSCTL_OFF + 320;
constexpr int LDS_BYTES = 157696;

#define RLX_AGENT __ATOMIC_RELAXED, __HIP_MEMORY_SCOPE_AGENT
#define LDS_WAIT() asm volatile("s_waitcnt lgkmcnt(0)" ::: "memory")
#define VM_WAIT() asm volatile("s_waitcnt vmcnt(0)" ::: "memory")

#define XB_TMO      128
#define XB_XCNT(j)  (256  + 64 * (j))
#define XB_XSUB(j)  (1280 + 64 * (j))
#define XB_XGEN(j)  (2304 + 64 * (j))
#define XB_TOP      3328
#define XB_TOPGEN   3392
#define XCD_BAR_WORDS 3456
#define XB_SPIN_CAP (1u << 22)
__device__ __forceinline__ unsigned xb_ld(unsigned* p)              { return __hip_atomic_load(p, __ATOMIC_RELAXED, __HIP_MEMORY_SCOPE_AGENT); }
__device__ __forceinline__ unsigned xb_add(unsigned* p, unsigned v) { return __hip_atomic_fetch_add(p, v, __ATOMIC_RELAXED, __HIP_MEMORY_SCOPE_AGENT); }
__device__ __forceinline__ unsigned xb_xcc_id() { return (unsigned)__builtin_amdgcn_s_getreg((3 << 11) | 20) & 0xFu; }
#define XB_SPIN(cond, bar) do { unsigned _sp = 0; while (cond) { __builtin_amdgcn_s_sleep(1); \
    if ((++_sp & 255u) == 0u) { if (xb_ld(&(bar)[XB_TMO])) break; if (_sp > XB_SPIN_CAP) { atomicAdd(&(bar)[XB_TMO], 1u); break; } } } } while (0)
struct XcdBarrier { unsigned* bar; unsigned x; volatile LAS unsigned* st; };
__device__ __forceinline__ XcdBarrier xcd_barrier_post(unsigned* bar, volatile LAS unsigned* st) {
    XcdBarrier b; b.bar = bar; b.x = xb_xcc_id(); b.st = st;
    if (threadIdx.x == 0) (void)xb_add(&bar[XB_XCNT(b.x)], 1u);
    return b;
}
__device__ __forceinline__ void xcd_barrier_complete(unsigned* bar, unsigned x, unsigned& nloc, unsigned& nx) {
    const unsigned G = gridDim.x * gridDim.y * gridDim.z;
    unsigned sum, cnt, mine, sp = 0u;
    for (;;) {
        sum = 0u; cnt = 0u; mine = 0u;
#pragma unroll
        for (unsigned j = 0; j < 16; ++j) { const unsigned c = xb_ld(&bar[XB_XCNT(j)]); sum += c; cnt += (c > 0u) ? 1u : 0u; mine = (j == x) ? c : mine; }
        if (sum == G) break;
        __builtin_amdgcn_s_sleep(1);
        if ((++sp & 255u) == 0u) { if (xb_ld(&bar[XB_TMO])) break; if (sp > XB_SPIN_CAP) { atomicAdd(&bar[XB_TMO], 1u); break; } }
    }
    nloc = mine > 0u ? mine : 1u; nx = cnt > 0u ? cnt : 1u;
}
__device__ __forceinline__ void xcd_barrier(const XcdBarrier& b) {
    asm volatile("s_waitcnt vmcnt(0)" ::: "memory");
    __syncthreads();
    if (threadIdx.x == 0) {
        unsigned* bar = b.bar;
        __builtin_amdgcn_s_waitcnt(0);
        unsigned nloc = b.st[0], nx = b.st[1];
        if (nloc == 0u) { xcd_barrier_complete(bar, b.x, nloc, nx); b.st[0] = nloc; b.st[1] = nx; }
        const unsigned old = xb_add(&bar[XB_XSUB(b.x)], 1u);
        const unsigned gen = old / nloc;
        if (old + 1u == (gen + 1u) * nloc) {
            __builtin_amdgcn_fence(__ATOMIC_RELEASE, "agent");
            asm volatile("s_waitcnt vmcnt(0)" ::: "memory");
            const unsigned og = xb_add(&bar[XB_TOP], 1u);
            const unsigned tg = og / nx;
            if (og + 1u == (tg + 1u) * nx) xb_add(&bar[XB_TOPGEN], 1u);
            else XB_SPIN(xb_ld(&bar[XB_TOPGEN]) == tg, bar);
            __builtin_amdgcn_fence(__ATOMIC_ACQUIRE, "agent");
            xb_add(&bar[XB_XGEN(b.x)], 1u);
            asm volatile("s_waitcnt vmcnt(0)" ::: "memory");
        } else {
            XB_SPIN(xb_ld(&bar[XB_XGEN(b.x)]) == gen, bar);
            __builtin_amdgcn_fence(__ATOMIC_ACQUIRE, "agent");
            asm volatile("s_waitcnt vmcnt(0)" ::: "memory");
        }
    }
    __syncthreads();
}

struct In {
    const float *x, *c, *ctx, *c_ctx, *w_ada, *b_ada, *w_in, *a_q_norm, *a_kv_norm, *a_w_uq, *a_w_ukv, *b_sink, *c_rpb, *d_q_norm, *d_k_norm,
                *w_branch, *w_gate, *b_gate, *w_out, *ln1_g, *ln1_b, *ln2_g, *ln2_b, *peer_w_q, *peer_sub_keys, *peer_u, *peer_v;
};
struct Args { In in; float* out; unsigned char* ws; int ph_lo, ph_hi, li, pad; };
struct Frame { LAS unsigned char* lds; int tid, lane, wave, vcu, G; GAS unsigned char* ws; };
template <class T> __device__ __forceinline__ T* G(T* p) { return (T*)(GAS T*)p; }
typedef const __attribute__((address_space(4))) Args& KA;
typedef const __attribute__((address_space(4))) Args* KAP;
__device__ __forceinline__ KAP kargs() { KAP p = (KAP)__builtin_amdgcn_kernarg_segment_ptr(); asm volatile("" : "+s"(p)); return p; }

__device__ __forceinline__ float wave_sum(float v) {
#pragma unroll
    for (int o = 1; o < 64; o <<= 1) v += __shfl_xor(v, o);
    return v;
}
__device__ __forceinline__ unsigned pk2(float lo, float hi) { return cvt_pk_bf16(lo, hi); }
__device__ __forceinline__ float silu_f(float v) { return v / (1.0f + __expf(-v)); }

__device__ __forceinline__ void p0_transpose_item(const float* W, int ldw, int nblk, bf16* dst, int dpitch, int row_off, int col_off, const float* gain, LAS float* scr, int item, int lane) {
    const int kb = item / nblk, nb = item % nblk, k0 = 64 * kb, n0 = 32 * nb;
#pragma unroll 8
    for (int i = 0; i < 32; ++i) { const int kk = 2 * i + (lane >> 5); float v = W[(size_t)(k0 + kk) * ldw + n0 + (lane & 31)]; if (gain) v *= gain[k0 + kk]; scr[kk * 33 + (lane & 31)] = v; }
    LDS_WAIT(); asm volatile("" ::: "memory");
    const int c = lane & 7;
#pragma unroll
    for (int j = 0; j < 4; ++j) { const int n = (lane >> 3) + 8 * j; const LAS float* s = scr + (8 * c) * 33 + n;
        u32x4 o; o.x = pk2(s[0 * 33], s[1 * 33]); o.y = pk2(s[2 * 33], s[3 * 33]); o.z = pk2(s[4 * 33], s[5 * 33]); o.w = pk2(s[6 * 33], s[7 * 33]);
        *(GAS u32x4*)(dst + (size_t)(row_off + n0 + n) * dpitch + col_off + k0 + 8 * c) = o; }
    LDS_WAIT(); asm volatile("" ::: "memory");
}
struct TJob { const float* W; int K, N; bf16* dst; int dpitch, row_off, col_off; const float* gain; };
__device__ __forceinline__ int tjob_get(KA A, int job, TJob& t) {
    const int l = job / 13, j = job % 13; GAS unsigned char* ws = (GAS unsigned char*)A.ws; t.gain = nullptr; t.row_off = 0; t.col_off = 0;
    if (j == 0) { t.W = G(A.in.w_in) + (size_t)l * DM * INW; t.K = DM; t.N = INW; t.dst = (bf16*)(ws + WS_WIN) + (size_t)l * UW * DM; t.dpitch = DM; }
    else if (j <= 4) { const int z = j - 1; t.W = G(A.in.w_gate) + ((size_t)l * 4 + z) * DM * DM; t.K = DM; t.N = DM; t.dst = (bf16*)(ws + WS_WC) + ((size_t)l * 4 + z) * DM * 2560; t.dpitch = 2560; }
    else if (j <= 8) { const int z = j - 5; t.W = G(A.in.w_branch) + ((size_t)l * 4 + z) * 512 * DM; t.K = 512; t.N = DM; t.dst = (bf16*)(ws + WS_WC) + ((size_t)l * 4 + z) * DM * 2560; t.dpitch = 2560; t.col_off = 2048; }
    else if (j == 9) { t.W = G(A.in.w_out) + (size_t)l * DM * DM; t.K = DM; t.N = DM; t.dst = (bf16*)(ws + WS_WO) + (size_t)l * DM * DM; t.dpitch = DM; }
    else if (j == 10) { t.W = G(A.in.peer_w_q) + (size_t)l * DM * DM; t.K = DM; t.N = DM; t.dst = (bf16*)(ws + WS_WPQ) + (size_t)l * DM * DM; t.dpitch = DM; }
    else if (j == 11) { t.W = G(A.in.a_w_uq) + (size_t)l * 384 * 768; t.K = 384; t.N = 768; t.dst = (bf16*)(ws + WS_WUP) + (size_t)l * 1792 * 512; t.dpitch = 512; t.gain = G(A.in.a_q_norm) + l * 384; }
    else { t.W = G(A.in.a_w_ukv) + (size_t)l * 128 * 1024; t.K = 128; t.N = 1024; t.dst = (bf16*)(ws + WS_WUP) + (size_t)l * 1792 * 512; t.dpitch = 512; t.row_off = 768; t.col_off = 384; t.gain = G(A.in.a_kv_norm) + l * 128; }
    return (t.K / 64) * (t.N / 32);
}
__device__ __forceinline__ void p0_prologue(const Frame& F, KA A) {
    GAS unsigned char* ws = F.ws;
    const int gw = F.vcu * NWAVES + F.wave, NGW = F.G * NWAVES;
    const long gt = (long)gw * 64 + F.lane, NGT = (long)NGW * 64;
    {
        float* modp = (float*)(ws + WS_MODP);
        for (int it = gw; it < 2 * 16 * 48; it += NGW) {
            const int l = it / 768, ks = (it % 768) / 48, cg = it % 48, n = cg * 256 + F.lane * 4;
            const float* w = G(A.in.w_ada) + ((size_t)l * DM + ks * 128) * MODW + n;
            f32x4 acc[5];
#pragma unroll
            for (int r = 0; r < 5; ++r) acc[r] = (f32x4){0.f, 0.f, 0.f, 0.f};
#pragma unroll 8
            for (int k = 0; k < 128; ++k) {
                const f32x4 wv = *(const f32x4*)(w + (size_t)k * MODW);
                const int kk = ks * 128 + k;
#pragma unroll
                for (int r = 0; r < 5; ++r) { const float cv = (r < 4) ? G(A.in.c)[r * DM + kk] : G(A.in.c_ctx)[kk]; acc[r] += wv * silu_f(cv); }
            }
#pragma unroll
            for (int r = 0; r < 5; ++r) *(f32x4*)(modp + (((size_t)ks * 2 + l) * 5 + r) * MODW + n) = acc[r];
        }
    }
    {
        LAS float* scr = (LAS float*)(F.lds + RING_OFF + F.wave * 16384);
        int base = 0;
        for (int job = 0; job < 26; ++job) {
            TJob t; const int ni = tjob_get(A, job, t);
            int first = gw - (base % NGW); if (first < 0) first += NGW;
            for (int i = first; i < ni; i += NGW) p0_transpose_item(t.W, t.N, t.N / 32, t.dst, t.dpitch, t.row_off, t.col_off, t.gain, scr, i, F.lane);
            base += ni;
        }
    }
    for (long i = gt; i < 2L * 192 * 2048 / 8; i += NGT) { const int l = (int)(i / (192 * 256)), r = (int)(i % (192 * 256)); *(u32x4*)((bf16*)(ws + WS_WIN) + ((size_t)l * UW + 3904) * DM + (size_t)r * 8) = (u32x4){0u, 0u, 0u, 0u}; }
    for (long i = gt; i < 2L * 768 * 16; i += NGT) { const int l = (int)(i / (768 * 16)), r = (int)(i % (768 * 16)), row = r / 16, c8 = r % 16; *(u32x4*)((bf16*)(ws + WS_WUP) + ((size_t)l * 1792 + row) * 512 + 384 + c8 * 8) = (u32x4){0u, 0u, 0u, 0u}; }
    for (long i = gt; i < 2L * 1024 * 48; i += NGT) { const int l = (int)(i / (1024 * 48)), r = (int)(i % (1024 * 48)), row = r / 48, c8 = r % 48; *(u32x4*)((bf16*)(ws + WS_WUP) + ((size_t)l * 1792 + 768 + row) * 512 + c8 * 8) = (u32x4){0u, 0u, 0u, 0u}; }
    {
        const long n_sk = 2L * 8 * 2 * 128 * 128 / 8;
        for (long i = gt; i < n_sk; i += NGT) {
            const float* src = G(A.in.peer_sub_keys); bf16* dst = (bf16*)(ws + WS_SUBK);
            const f32x4 a = *(const f32x4*)(src + i * 8), b = *(const f32x4*)(src + i * 8 + 4);
            u32x4 o; o.x = pk2(a[0], a[1]); o.y = pk2(a[2], a[3]); o.z = pk2(b[0], b[1]); o.w = pk2(b[2], b[3]);
            *(u32x4*)(dst + i * 8) = o;
        }
        for (int r = gw; r < 4 * 16384; r += NGW) {
            const bool isu = r < 2 * 16384; const int row = isu ? r : r - 2 * 16384;
            const float* src = (isu ? G(A.in.peer_u) : G(A.in.peer_v)) + (size_t)row * 2048 + F.lane * 4;
            f32x4 v[8]; float am = 0.f;
#pragma unroll
            for (int q = 0; q < 8; ++q) { v[q] = __builtin_nontemporal_load((const f32x4*)(src + q * 256));
                am = fmaxf(am, fmaxf(fmaxf(__builtin_fabsf(v[q][0]), __builtin_fabsf(v[q][1])), fmaxf(__builtin_fabsf(v[q][2]), __builtin_fabsf(v[q][3])))); }
#pragma unroll
            for (int o = 1; o < 64; o <<= 1) am = fmaxf(am, __shfl_xor(am, o));
            const float S = am > 0.f ? 6.0f / am : 1.0f;
            unsigned short* dst = (unsigned short*)(ws + (isu ? WS_PU : WS_PV)) + (size_t)row * 512 + F.lane;
#pragma unroll
            for (int q = 0; q < 8; ++q) { const f32x4 a = v[q] * S;
                unsigned w = __builtin_amdgcn_cvt_scalef32_pk_fp4_f32(0u, a[0], a[1], 1.0f, 0); w = __builtin_amdgcn_cvt_scalef32_pk_fp4_f32(w, a[2], a[3], 1.0f, 1);
                dst[q * 64] = (unsigned short)(w & 0xffffu); }
            if (F.lane == 0) ((float*)(ws + (isu ? WS_SCU : WS_SCV)))[row] = am > 0.f ? am * (1.0f / 6.0f) : 1.0f;
        }
    }
    {
        float* ct = (float*)(ws + WS_CTAB);
        for (long i = gt; i < 2L * 4 * 15 * 64 * 64; i += NGT) {
            const int kc = (int)(i & 63), qc = (int)((i >> 6) & 63), r = (int)(i >> 12), dr = r % 15, lh = r / 15;
            int cs = qc - 8; cs = cs < 0 ? 0 : (cs > 48 ? 48 : cs);
            int co = kc - qc + 15; co = co < 0 ? 0 : (co > 30 ? 30 : co);
            ct[i] = (kc >= cs && kc < cs + 16) ? G(A.in.c_rpb)[((size_t)lh * 15 + dr) * 31 + co] * (1.0f / C_SCALE) : -1e30f;
        }
    }
}
__device__ __forceinline__ void p1_modreduce(const Frame& F, KA A) {
    const long gt = ((long)F.vcu * NWAVES + F.wave) * 64 + F.lane, NGT = (long)F.G * NWAVES * 64;
    const float* modp = (const float*)(F.ws + WS_MODP); float* mod = (float*)(F.ws + WS_MOD);
    for (long i = gt; i < 2L * 5 * MODW; i += NGT) { const int n = (int)(i % MODW), l = (int)(i / (5 * MODW));
        float s = G(A.in.b_ada)[l * MODW + n];
#pragma unroll
        for (int ks = 0; ks < 16; ++ks) s += modp[(size_t)ks * 2 * 5 * MODW + i];
        mod[i] = s; }
}
__device__ __forceinline__ void p2_modulate0(const Frame& F, KA A) {
    const int gw = F.vcu * NWAVES + F.wave, NGW = F.G * NWAVES;
    const float* mod = (const float*)(F.ws + WS_MOD); bf16* H = (bf16*)(F.ws + WS_BUFA);
    for (int row = gw; row < MT; row += NGW) {
        const float* xr = row < ML ? G(A.in.x) + (size_t)row * DM : G(A.in.ctx) + (size_t)(row - ML) * DM;
        const float* mr = mod + (size_t)(row < ML ? (row >> 12) : 4) * MODW;
#pragma unroll
        for (int j = 0; j < 4; ++j) { const int c = j * 512 + F.lane * 8;
            const f32x4 a = *(const f32x4*)(xr + c), b = *(const f32x4*)(xr + c + 4);
            const f32x4 sh0 = *(const f32x4*)(mr + c), sh1 = *(const f32x4*)(mr + c + 4), sc0 = *(const f32x4*)(mr + DM + c), sc1 = *(const f32x4*)(mr + DM + c + 4);
            const f32x4 y0 = a * (sc0 + 1.0f) + sh0, y1 = b * (sc1 + 1.0f) + sh1;
            u32x4 o; o.x = pk2(y0[0], y0[1]); o.y = pk2(y0[2], y0[3]); o.z = pk2(y1[0], y1[1]); o.w = pk2(y1[2], y1[3]);
            *(u32x4*)(H + (size_t)row * DM + c) = o; }
    }
}
__device__ __forceinline__ void rope_pair(float& x1, float& x2, float ang) { const float c = __cosf(ang), s = __sinf(ang); const float y1 = x1 * c - x2 * s, y2 = x1 * s + x2 * c; x1 = y1; x2 = y2; }
__device__ __forceinline__ void enorm_phase(const Frame& F, KA A, int l) {
    const int gw = F.vcu * NWAVES + F.wave, NGW = F.G * NWAVES, lane = F.lane;
    bf16* U = (bf16*)(F.ws + WS_UREG); bf16* QK = (bf16*)(F.ws + WS_QKVA);
    const float* gq = G(A.in.d_q_norm) + l * 128; const float* gk = G(A.in.d_k_norm) + l * 128;
    const float L2T = 13.287712379549449f;
    for (int row = gw; row < MT; row += NGW) {
        bf16* u = U + (size_t)row * UW;
        const bool lat = row < ML; const int t = row & 4095;
        const float prow = lat ? (float)(t >> 6) : 0.f, pcol = lat ? (float)(t & 63) : 0.f;
        { unsigned w[3]; float ss = 0.f;
#pragma unroll
          for (int i = 0; i < 3; ++i) { w[i] = ((const unsigned*)(u + U_CQ))[lane + 64 * i]; const float a = bflo(w[i]), b = bfhi(w[i]); ss += a * a + b * b; }
          const float rstd = rsqrtf(wave_sum(ss) * (1.0f / 384.0f) + RMS_EPS);
#pragma unroll
          for (int i = 0; i < 3; ++i) ((unsigned*)(u + U_CQ))[lane + 64 * i] = pk2(bflo(w[i]) * rstd, bfhi(w[i]) * rstd); }
        { const unsigned w = ((const unsigned*)(u + U_CKV))[lane]; const float a = bflo(w), b = bfhi(w);
          const float rstd = rsqrtf(wave_sum(a * a + b * b) * (1.0f / 128.0f) + RMS_EPS);
          ((unsigned*)(u + U_CKV))[lane] = pk2(a * rstd, b * rstd); }
        const int j64 = lane & 31;
        const float ang64 = ((j64 < 16) ? prow : pcol) * __builtin_amdgcn_exp2f(-(float)(j64 & 15) * (L2T / 16.0f));
        if (lane < 32) { float x1 = bf2f(u[U_KR + lane]), x2 = bf2f(u[U_KR + 32 + lane]); rope_pair(x1, x2, ang64);
            bf16* o = QK + (size_t)row * QW + QA_KR; o[lane] = f2bf(x1); o[32 + lane] = f2bf(x2); }
#pragma unroll
        for (int i = 0; i < 4; ++i) { const int p = lane + 64 * i, hd = p >> 5; bf16* q = u + U_BQ + hd * 64;
            float x1 = bf2f(q[j64]), x2 = bf2f(q[32 + j64]); rope_pair(x1, x2, ang64); q[j64] = f2bf(x1); q[32 + j64] = f2bf(x2); }
        { const int hd = lane >> 5; bf16* q = u + U_BK + hd * 64;
          float x1 = bf2f(q[j64]), x2 = bf2f(q[32 + j64]); rope_pair(x1, x2, ang64); q[j64] = f2bf(x1); q[32 + j64] = f2bf(x2); }
        const float ang128 = ((lane < 32) ? prow : pcol) * __builtin_amdgcn_exp2f(-(float)(lane & 31) * (L2T / 32.0f));
        const float gq1 = gq[lane], gq2 = gq[64 + lane], gk1 = gk[lane], gk2 = gk[64 + lane];
#pragma unroll
        for (int hd = 0; hd < 4; ++hd) { bf16* q = u + U_DQ + hd * 128; float x1 = bf2f(q[lane]), x2 = bf2f(q[64 + lane]);
            const float rstd = rsqrtf(wave_sum(x1 * x1 + x2 * x2) * (1.0f / 128.0f) + RMS_EPS);
            x1 = x1 * rstd * gq1; x2 = x2 * rstd * gq2; rope_pair(x1, x2, ang128); q[lane] = f2bf(x1); q[64 + lane] = f2bf(x2); }
#pragma unroll
        for (int hd = 0; hd < 2; ++hd) { bf16* q = u + U_DK + hd * 128; float x1 = bf2f(q[lane]), x2 = bf2f(q[64 + lane]);
            const float rstd = rsqrtf(wave_sum(x1 * x1 + x2 * x2) * (1.0f / 128.0f) + RMS_EPS);
            x1 = x1 * rstd * gk1; x2 = x2 * rstd * gk2; rope_pair(x1, x2, ang128); q[lane] = f2bf(x1); q[64 + lane] = f2bf(x2); }
    }
}
__device__ __forceinline__ void ln1_phase(const Frame& F, KA A, int l, int nrows, bf16* HF) {
    const int gw = F.vcu * NWAVES + F.wave, NGW = F.G * NWAVES, lane = F.lane;
    float* Y = (float*)(F.ws + WS_UREG); const float* mod = (const float*)(F.ws + WS_MOD) + (size_t)l * 5 * MODW;
    const float* g = G(A.in.ln1_g) + l * DM; const float* b = G(A.in.ln1_b) + l * DM;
    for (int row = gw; row < nrows; row += NGW) {
        float* y = Y + (size_t)row * DM; const float* mr = mod + (size_t)(row < ML ? (row >> 12) : 4) * MODW;
        f32x4 v[8]; float s = 0.f;
#pragma unroll
        for (int j = 0; j < 4; ++j) { const int c = j * 512 + lane * 8; v[2 * j] = *(const f32x4*)(y + c); v[2 * j + 1] = *(const f32x4*)(y + c + 4); }
#pragma unroll
        for (int j = 0; j < 8; ++j) s += (v[j][0] + v[j][1]) + (v[j][2] + v[j][3]);
        const float mean = wave_sum(s) * (1.0f / DM); float q = 0.f;
#pragma unroll
        for (int j = 0; j < 8; ++j) { v[j] = v[j] - mean; q += (v[j][0] * v[j][0] + v[j][1] * v[j][1]) + (v[j][2] * v[j][2] + v[j][3] * v[j][3]); }
        const float rstd = rsqrtf(wave_sum(q) * (1.0f / DM) + LN_EPS);
#pragma unroll
        for (int j = 0; j < 4; ++j) { const int c = j * 512 + lane * 8;
            const f32x4 x0 = v[2 * j] * rstd * *(const f32x4*)(g + c) + *(const f32x4*)(b + c), x1 = v[2 * j + 1] * rstd * *(const f32x4*)(g + c + 4) + *(const f32x4*)(b + c + 4);
            *(f32x4*)(y + c) = x0; *(f32x4*)(y + c + 4) = x1;
            const f32x4 h0 = x0 * (*(const f32x4*)(mr + 4 * DM + c) + 1.0f) + *(const f32x4*)(mr + 3 * DM + c), h1 = x1 * (*(const f32x4*)(mr + 4 * DM + c + 4) + 1.0f) + *(const f32x4*)(mr + 3 * DM + c + 4);
            u32x4 o; o.x = pk2(h0[0], h0[1]); o.y = pk2(h0[2], h0[3]); o.z = pk2(h1[0], h1[1]); o.w = pk2(h1[2], h1[3]);
            *(u32x4*)(HF + (size_t)row * DM + c) = o; }
    }
}
namespace peer {
__device__ __forceinline__ unsigned okey(float f) { const unsigned u = __float_as_uint(f); return (u & 0x80000000u) ? ~u : (u | 0x80000000u); }
__device__ __forceinline__ float ikey(unsigned k) { const unsigned u = (k & 0x80000000u) ? (k & 0x7fffffffu) : ~k; return __uint_as_float(u); }
#define CE_DESC(a, b) do { const unsigned _mx = (a) > (b) ? (a) : (b), _mn = (a) > (b) ? (b) : (a); (a) = _mx; (b) = _mn; } while (0)
#define CE_ASC(a, b)  do { const unsigned _mx = (a) > (b) ? (a) : (b), _mn = (a) > (b) ? (b) : (a); (a) = _mn; (b) = _mx; } while (0)
__device__ __forceinline__ void sort16_desc(unsigned (&k)[16]) {
#pragma unroll
    for (int size = 2; size <= 16; size <<= 1)
#pragma unroll
        for (int stride = size >> 1; stride > 0; stride >>= 1)
#pragma unroll
            for (int i = 0; i < 16; ++i) { const int p = i ^ stride; if (p > i) { if ((i & size) == 0) CE_DESC(k[i], k[p]); else CE_ASC(k[i], k[p]); } }
}
__device__ __forceinline__ void merge16_desc(unsigned (&a)[16], const unsigned (&b)[16]) {
#pragma unroll
    for (int i = 0; i < 16; ++i) a[i] = a[i] > b[15 - i] ? a[i] : b[15 - i];
#pragma unroll
    for (int stride = 8; stride > 0; stride >>= 1)
#pragma unroll
        for (int i = 0; i < 16; ++i) { const int p = i ^ stride; if (p > i) CE_DESC(a[i], a[p]); }
}
constexpr int slot_x(int s) { int n = 0; for (int x = 0; x < 16; ++x) for (int y = 0; y < 16; ++y) if ((x + 1) * (y + 1) <= 16) { if (n == s) return x; ++n; } return -1; }
constexpr int slot_y(int s) { int n = 0; for (int x = 0; x < 16; ++x) for (int y = 0; y < 16; ++y) if ((x + 1) * (y + 1) <= 16) { if (n == s) return y; ++n; } return -1; }
template <int S> struct Slot { static constexpr int x = slot_x(S), y = slot_y(S); };
template <int S> __device__ __forceinline__ void cand_one(unsigned (&c)[64], const float (&v0)[16], const float (&v1)[16], const unsigned (&i0)[16], const unsigned (&i1)[16], LAS unsigned short* tbl) {
    if constexpr (Slot<S>::x >= 0) { c[S] = (okey(v0[Slot<S>::x] + v1[Slot<S>::y]) & ~63u) | (unsigned)(63 - S); tbl[S] = (unsigned short)(i0[Slot<S>::x] * 128u + i1[Slot<S>::y]); }
    else c[S] = 0u;
}
template <int... S> __device__ __forceinline__ void cand_all(unsigned (&c)[64], const float (&v0)[16], const float (&v1)[16], const unsigned (&i0)[16], const unsigned (&i1)[16], LAS unsigned short* tbl, std::integer_sequence<int, S...>) {
    (cand_one<S>(c, v0, v1, i0, i1, tbl), ...);
}
__device__ __forceinline__ void topk_item(const bf16* QP, const bf16* SK, int* EIDX, float* EG, int tok0, int h, LAS unsigned short* tblw, int lane) {
    const int r32 = lane & 31, hi = lane >> 5;
    const bf16* qrow = QP + (size_t)(tok0 + r32) * DM + h * 256 + hi * 8;
    unsigned L[2][16];
#pragma unroll
    for (int p = 0; p < 2; ++p) {
        f32x16 acc[4];
#pragma unroll
        for (int kb = 0; kb < 4; ++kb) acc[kb] = f32x16{};
        const bf16* skp = SK + ((size_t)(h * 2 + p) * 128 + r32) * 128 + hi * 8;
#pragma unroll 2
        for (int d0 = 0; d0 < 8; ++d0) { const bf16x8 bq = *(const bf16x8*)(qrow + p * 128 + d0 * 16);
#pragma unroll
            for (int kb = 0; kb < 4; ++kb) { const bf16x8 ak = *(const bf16x8*)(skp + (size_t)kb * 32 * 128 + d0 * 16); acc[kb] = __builtin_amdgcn_mfma_f32_32x32x16_bf16(ak, bq, acc[kb], 0, 0, 0); } }
        unsigned g[4][16];
#pragma unroll
        for (int kb = 0; kb < 4; ++kb) {
#pragma unroll
            for (int r = 0; r < 16; ++r) g[kb][r] = (okey(acc[kb][r]) & ~127u) | (unsigned)(127 - (32 * kb + (r & 3) + 8 * (r >> 2) + 4 * hi));
            sort16_desc(g[kb]); }
        merge16_desc(g[0], g[1]); merge16_desc(g[2], g[3]); merge16_desc(g[0], g[2]);
        unsigned o[16];
#pragma unroll
        for (int i = 0; i < 16; ++i) o[i] = (unsigned)__shfl_xor((int)g[0][i], 32);
        merge16_desc(g[0], o);
#pragma unroll
        for (int i = 0; i < 16; ++i) L[p][i] = g[0][i];
    }
    float v0[16], v1[16]; unsigned i0[16], i1[16];
#pragma unroll
    for (int i = 0; i < 16; ++i) { v0[i] = ikey(L[0][i] & ~127u); v1[i] = ikey(L[1][i] & ~127u); i0[i] = 127u - (L[0][i] & 127u); i1[i] = 127u - (L[1][i] & 127u); }
    LAS unsigned short* tbl = tblw + lane * 66;
    unsigned c[64];
    cand_all(c, v0, v1, i0, i1, tbl, std::make_integer_sequence<int, 64>{});
    unsigned c0[16], c1[16], c2[16], c3[16];
#pragma unroll
    for (int i = 0; i < 16; ++i) { c0[i] = c[i]; c1[i] = c[16 + i]; c2[i] = c[32 + i]; c3[i] = c[48 + i]; }
    sort16_desc(c0); sort16_desc(c1); sort16_desc(c2); sort16_desc(c3);
    merge16_desc(c0, c1); merge16_desc(c2, c3); merge16_desc(c0, c2);
    LDS_WAIT(); asm volatile("" ::: "memory");
    float best[16]; int eid[16]; float sum = 0.f;
    const float mx = ikey(c0[0] & ~63u);
#pragma unroll
    for (int i = 0; i < 16; ++i) { const unsigned s = 63u - (c0[i] & 63u); eid[i] = (int)tbl[s]; best[i] = __expf(ikey(c0[i] & ~63u) - mx); sum += best[i]; }
    const float inv = 1.0f / sum;
    if (hi == 0) {
        int* ep = EIDX + (size_t)(tok0 + r32) * 128 + h * 16; float* gp = EG + (size_t)(tok0 + r32) * 128 + h * 16;
#pragma unroll
        for (int i = 0; i < 16; ++i) { ep[i] = eid[i]; gp[i] = best[i] * inv; }
    }
    LDS_WAIT(); asm volatile("" ::: "memory");
}
}
namespace p4 {
constexpr int L_SE = 0, L_SG = 4 * 128 * 2, L_WAVE = L_SG + 4 * 128 * 4;
__device__ __forceinline__ float rowsum16(float d) {
    d += __int_as_float(__builtin_amdgcn_update_dpp(__float_as_int(d), __float_as_int(d), 0x128, 0xF, 0xF, false));
    d += __int_as_float(__builtin_amdgcn_update_dpp(__float_as_int(d), __float_as_int(d), 0x124, 0xF, 0xF, false));
    d += __int_as_float(__builtin_amdgcn_update_dpp(__float_as_int(d), __float_as_int(d), 0x122, 0xF, 0xF, false));
    d += __int_as_float(__builtin_amdgcn_update_dpp(__float_as_int(d), __float_as_int(d), 0x121, 0xF, 0xF, false));
    return d;
}
__device__ __forceinline__ f32x2 cvt4(unsigned w, int t) {
    return t == 0 ? __builtin_amdgcn_cvt_scalef32_pk_f32_fp4(w, 1.0f, 0) : (t == 1 ? __builtin_amdgcn_cvt_scalef32_pk_f32_fp4(w, 1.0f, 1) : (t == 2 ? __builtin_amdgcn_cvt_scalef32_pk_f32_fp4(w, 1.0f, 2) : __builtin_amdgcn_cvt_scalef32_pk_f32_fp4(w, 1.0f, 3)));
}
struct Row { u32x4 p[4]; float sc; };
__device__ __forceinline__ void load_row(Row& r, const unsigned char* tab_l, const float* sct, int e) {
    __builtin_amdgcn_sched_barrier(0);
    const unsigned char* g = tab_l + (size_t)(unsigned)e * 1024;
#pragma unroll
    for (int j = 0; j < 4; ++j) r.p[j] = *(const u32x4*)(g + j * 256);
    r.sc = sct[e];
    __builtin_amdgcn_sched_barrier(0);
}
__device__ __forceinline__ float dot128(const f32x2 (&h)[64], const Row& r) {
    f32x2 a = {0.f, 0.f}, b = {0.f, 0.f};
#pragma unroll
    for (int j = 0; j < 4; ++j)
#pragma unroll
        for (int q = 0; q < 4; ++q) { const unsigned w = r.p[j][q];
            a = __builtin_elementwise_fma(h[(j * 4 + q) * 4 + 0], cvt4(w, 0), a); b = __builtin_elementwise_fma(h[(j * 4 + q) * 4 + 1], cvt4(w, 1), b);
            a = __builtin_elementwise_fma(h[(j * 4 + q) * 4 + 2], cvt4(w, 2), a); b = __builtin_elementwise_fma(h[(j * 4 + q) * 4 + 3], cvt4(w, 3), b); }
    return (a.x + a.y) + (b.x + b.y);
}
__device__ __forceinline__ void axpy128(f32x2 (&acc)[64], const float w, const Row& r) {
    const f32x2 ww = {w, w};
#pragma unroll
    for (int j = 0; j < 4; ++j)
#pragma unroll
        for (int q = 0; q < 4; ++q) { const unsigned x = r.p[j][q];
#pragma unroll
            for (int t = 0; t < 4; ++t) acc[(j * 4 + q) * 4 + t] = __builtin_elementwise_fma(ww, cvt4(x, t), acc[(j * 4 + q) * 4 + t]); }
}
__device__ __forceinline__ float gelu_as(float v) {
    const float av = __builtin_fabsf(v), t = __builtin_amdgcn_rcpf(av * 0.2316418882f + 1.0f);
    float q = t * 0.5307027145f + (-0.7265760135f); q = q * t + 0.7107068705f; q = q * t + (-0.142248368f); q = q * t + 0.127414796f; q = q * t;
    const float e = __builtin_amdgcn_exp2f((v * v) * (-0.72134752044f)); const float m = v * (q * e); return v < 0.f ? m : v - m;
}
}

__device__ __forceinline__ void pexp4_phase(const Frame& F, KA A, int l, int ntok, const bf16* HF, float* outp, bf16* Hnext) {
    using namespace p4;
    const unsigned char* PU8 = (const unsigned char*)(F.ws + WS_PU) + (size_t)l * 16384 * 1024; const unsigned char* PV8 = (const unsigned char*)(F.ws + WS_PV) + (size_t)l * 16384 * 1024;
    const float* SCU = (const float*)(F.ws + WS_SCU) + l * 16384; const float* SCV = (const float*)(F.ws + WS_SCV) + l * 16384;
    const int* EIDX = (const int*)(F.ws + WS_EIDX); const float* EG = (const float*)(F.ws + WS_EG);
    float* X1 = (float*)(F.ws + WS_UREG); const float* mod = (const float*)(F.ws + WS_MOD);
    const float* g2 = G(A.in.ln2_g) + l * DM; const float* b2 = G(A.in.ln2_b) + l * DM;
    LAS unsigned char* wl = F.lds + RING_OFF + F.wave * L_WAVE;
    LAS unsigned short* se = (LAS unsigned short*)(wl + L_SE); LAS float* sg = (LAS float*)(wl + L_SG);
    const int gw = F.vcu * NWAVES + F.wave, NW = F.G * NWAVES;
    const int nfull = ntok / (NW * 4), nrem = ntok - nfull * NW * 4, nsplit = (nrem + NW - 1) / NW;
    for (int pass = 0; pass < nfull + nsplit; ++pass) {
        int lane = F.lane; asm volatile("" : "+v"(lane));
        const int qd = lane >> 4, l16 = lane & 15;
        const bool split = pass >= nfull;
        int tokw[4];
#pragma unroll
        for (int k = 0; k < 4; ++k) tokw[k] = split ? ((k == 0 && (pass - nfull) * NW + gw < nrem) ? nfull * NW * 4 + (pass - nfull) * NW + gw : -1) : pass * NW * 4 + gw * 4 + k;
        if (split && tokw[0] < 0) continue;
#pragma unroll
        for (int k = 0; k < 4; ++k) if (tokw[k] >= 0) {
            unsigned k0 = ((unsigned)EIDX[(size_t)tokw[k] * 128 + lane] << 7) | (unsigned)lane, k1 = ((unsigned)EIDX[(size_t)tokw[k] * 128 + 64 + lane] << 7) | (unsigned)(64 + lane);
#pragma unroll
            for (int size = 2; size <= 128; size <<= 1)
#pragma unroll
                for (int stride = size >> 1; stride > 0; stride >>= 1) {
                    if (stride == 64) { const unsigned lo = k0 < k1 ? k0 : k1, hi = k0 < k1 ? k1 : k0; k0 = lo; k1 = hi; }
                    else {
                        const unsigned p0 = (unsigned)__shfl_xor((int)k0, stride), p1 = (unsigned)__shfl_xor((int)k1, stride);
                        const bool lower = (lane & stride) == 0;
                        const bool up0 = (lane & size) == 0 || size == 128 || size == 64;
                        const bool up1 = size == 128 ? true : (size == 64 ? false : (lane & size) == 0);
                        k0 = (lower == up0) ? (k0 < p0 ? k0 : p0) : (k0 < p0 ? p0 : k0);
                        k1 = (lower == up1) ? (k1 < p1 ? k1 : p1) : (k1 < p1 ? p1 : k1);
                    }
                }
            se[k * 128 + lane] = (unsigned short)(k0 >> 7); se[k * 128 + 64 + lane] = (unsigned short)(k1 >> 7);
            sg[k * 128 + lane] = EG[(size_t)tokw[k] * 128 + (k0 & 127u)]; sg[k * 128 + 64 + lane] = EG[(size_t)tokw[k] * 128 + (k1 & 127u)];
        }
        LDS_WAIT(); asm volatile("s_waitcnt vmcnt(0)" ::: "memory");
        const int tok = split ? tokw[0] : (qd == 0 ? tokw[0] : (qd == 1 ? tokw[1] : (qd == 2 ? tokw[2] : tokw[3])));
        const int lbase = split ? 32 * qd : 128 * qd;
        const int nsteps = split ? 32 : 128;
        LAS const unsigned short* seq = se + lbase; LAS float* sgq = sg + lbase;
#ifndef P4_NO_U
        {
            f32x2 h[64];
#pragma unroll
            for (int j = 0; j < 4; ++j) { const bf16* hp = HF + (size_t)tok * DM + j * 512 + l16 * 32;
#pragma unroll
                for (int q = 0; q < 4; ++q) { const u32x4 a = *(const u32x4*)(hp + q * 8);
#pragma unroll
                    for (int t = 0; t < 4; ++t) h[(j * 4 + q) * 4 + t] = (f32x2){bflo(a[t]), bfhi(a[t])}; } }
            const unsigned char* tab_l = PU8 + l16 * 16;
            p4::Row ra, rb;
            int ea = seq[0], eb = seq[1];
            p4::load_row(ra, tab_l, SCU, ea);
            for (int i = 0; i < nsteps; i += 2) {
                p4::load_row(rb, tab_l, SCU, eb);
                const float sva = SCV[ea]; ea = seq[i + 2 < nsteps ? i + 2 : nsteps - 1];
                { const float gate = sgq[i]; const float d = p4::rowsum16(p4::dot128(h, ra)) * ra.sc; sgq[i] = p4::gelu_as(d) * gate * sva; }
                p4::load_row(ra, tab_l, SCU, ea);
                const float svb = SCV[eb]; eb = seq[i + 3 < nsteps ? i + 3 : nsteps - 1];
                { const float gate = sgq[i + 1]; const float d = p4::rowsum16(p4::dot128(h, rb)) * rb.sc; sgq[i + 1] = p4::gelu_as(d) * gate * svb; }
            }
        }
#endif
        LDS_WAIT(); asm volatile("s_waitcnt vmcnt(0)" ::: "memory");
#ifndef P4_NO_V
        {
            f32x2 acc[64];
#pragma unroll
            for (int k = 0; k < 64; ++k) acc[k] = (f32x2){0.f, 0.f};
            const unsigned char* tab_l = PV8 + l16 * 16;
            p4::Row ra, rb;
            int ea = seq[0], eb = seq[1];
            p4::load_row(ra, tab_l, SCV, ea);
            for (int i = 0; i < nsteps; i += 2) {
                p4::load_row(rb, tab_l, SCV, eb);
                ea = seq[i + 2 < nsteps ? i + 2 : nsteps - 1];
                p4::axpy128(acc, sgq[i], ra);
                p4::load_row(ra, tab_l, SCV, ea);
                eb = seq[i + 3 < nsteps ? i + 3 : nsteps - 1];
                p4::axpy128(acc, sgq[i + 1], rb);
            }
            asm volatile("s_waitcnt vmcnt(0)" ::: "memory");
#ifndef P4_NO_SPLITC
            if (split) {
#pragma unroll
                for (int k = 0; k < 64; ++k) {
                    { auto r0 = __builtin_amdgcn_permlane16_swap(__float_as_uint(acc[k].x), __float_as_uint(acc[k].x), false, false); acc[k].x = __uint_as_float(r0[0]) + __uint_as_float(r0[1]);
                      auto r1 = __builtin_amdgcn_permlane16_swap(__float_as_uint(acc[k].y), __float_as_uint(acc[k].y), false, false); acc[k].y = __uint_as_float(r1[0]) + __uint_as_float(r1[1]); }
                    { auto r0 = __builtin_amdgcn_permlane32_swap(__float_as_uint(acc[k].x), __float_as_uint(acc[k].x), false, false); acc[k].x = __uint_as_float(r0[0]) + __uint_as_float(r0[1]);
                      auto r1 = __builtin_amdgcn_permlane32_swap(__float_as_uint(acc[k].y), __float_as_uint(acc[k].y), false, false); acc[k].y = __uint_as_float(r1[0]) + __uint_as_float(r1[1]); }
                }
            }
#endif
#ifdef P4_NO_LN2
            for (int k = 0; k < 64; ++k) *(f32x2*)(outp + (size_t)tok * DM + k * 32 + l16 * 2) = acc[k];
#else
            const int bidx = tok < ML ? (tok >> 12) : 4;
            const float* mr = mod + ((size_t)l * 5 + bidx) * MODW; const float* mn = mod + ((size_t)(l + 1 < DEPTH ? l + 1 : l) * 5 + bidx) * MODW; float* x1 = X1 + (size_t)tok * DM;
            if (!split || qd == 0) {
                float s1 = 0.f, s2 = 0.f; int lq = l16; asm volatile("" : "+v"(lq));
                GAS float* px = (GAS float*)x1 + lq * 32; const GAS float* pg = (const GAS float*)mr + 5 * DM + lq * 32;
#pragma unroll
                for (int j = 0; j < 4; ++j) {
#pragma unroll
                    for (int k = 0; k < 8; ++k) { const f32x4 xa = *(const GAS f32x4*)(px + k * 4), ga = *(const GAS f32x4*)(pg + k * 4);
                        const f32x2 a0 = acc[(j * 4 + (k >> 1)) * 4 + (k & 1) * 2], a1 = acc[(j * 4 + (k >> 1)) * 4 + (k & 1) * 2 + 1];
                        const f32x4 v = (f32x4){ALPHA * xa[0] + ga[0] * a0.x, ALPHA * xa[1] + ga[1] * a0.y, ALPHA * xa[2] + ga[2] * a1.x, ALPHA * xa[3] + ga[3] * a1.y};
                        s1 += (v[0] + v[1]) + (v[2] + v[3]); s2 += (v[0] * v[0] + v[1] * v[1]) + (v[2] * v[2] + v[3] * v[3]);
                        *(GAS f32x4*)(px + k * 4) = v; asm volatile("" : "+v"(s1), "+v"(s2) :: "memory"); }
                    px += 512; pg += 512; asm volatile("" : "+v"(px), "+v"(pg)); }
                const float mean = p4::rowsum16(s1) * (1.0f / DM); const float var = p4::rowsum16(s2) * (1.0f / DM) - mean * mean;
                const float rstd = rsqrtf((var > 0.f ? var : 0.f) + LN_EPS);
                asm volatile("s_waitcnt vmcnt(0)" ::: "memory");
                const int co = lq * 32;
#pragma unroll 1
                for (int jj = 0; jj < 8; ++jj) {
                    u32x4 o0, o1; const int cj = (jj >> 1) * 512 + co + (jj & 1) * 16;
#pragma unroll
                    for (int q = 0; q < 4; ++q) { const int c = cj + q * 4; const f32x4 v = *(const f32x4*)(x1 + c), ga = *(const f32x4*)(g2 + c), ba = *(const f32x4*)(b2 + c);
                        const f32x4 y = (v - mean) * rstd * ga + ba;
                        *(f32x4*)(outp + (size_t)tok * DM + c) = y;
                        if (Hnext) { const f32x4 z = y * (*(const f32x4*)(mn + DM + c) + 1.0f) + *(const f32x4*)(mn + c); const unsigned w0 = pk2(z[0], z[1]), w1 = pk2(z[2], z[3]);
                            if (q == 0) { o0.x = w0; o0.y = w1; } else if (q == 1) { o0.z = w0; o0.w = w1; } else if (q == 2) { o1.x = w0; o1.y = w1; } else { o1.z = w0; o1.w = w1; } } }
                    if (Hnext) { bf16* hp = Hnext + (size_t)tok * DM + cj; *(u32x4*)hp = o0; *(u32x4*)(hp + 8) = o1; }
                }
            }
#endif
        }
#endif
        LDS_WAIT(); asm volatile("s_waitcnt vmcnt(0)" ::: "memory");
    }
}
__device__ __forceinline__ float gelu_exact(float v) { return 0.5f * v * (1.0f + erff(v * 0.70710678118654752f)); }
__device__ __forceinline__ float reduce16(float (&p)[16], int lane) {
    float q[8], r[4], s[2];
    { const bool up = lane & 1;
#pragma unroll
      for (int k = 0; k < 8; ++k) { const float send = up ? p[2 * k] : p[2 * k + 1], keep = up ? p[2 * k + 1] : p[2 * k]; q[k] = keep + __shfl_xor(send, 1); } }
    { const bool up = lane & 2;
#pragma unroll
      for (int k = 0; k < 4; ++k) { const float send = up ? q[2 * k] : q[2 * k + 1], keep = up ? q[2 * k + 1] : q[2 * k]; r[k] = keep + __shfl_xor(send, 2); } }
    { const bool up = lane & 4;
#pragma unroll
      for (int k = 0; k < 2; ++k) { const float send = up ? r[2 * k] : r[2 * k + 1], keep = up ? r[2 * k + 1] : r[2 * k]; s[k] = keep + __shfl_xor(send, 4); } }
    float t;
    { const bool up = lane & 8; const float send = up ? s[0] : s[1], keep = up ? s[1] : s[0]; t = keep + __shfl_xor(send, 8); }
    t += __shfl_xor(t, 16); t += __shfl_xor(t, 32);
    return t;
}
__device__ __forceinline__ void pexp_phase(const Frame& F, KA A, int l, int ntok, const bf16* HF, float* outp, bf16* Hnext) {
    const int gw = F.vcu * NWAVES + F.wave, NGW = F.G * NWAVES, lane = F.lane;
    const bf16* PU = (const bf16*)(F.ws + WS_PU) + (size_t)l * 16384 * DM; const bf16* PV = (const bf16*)(F.ws + WS_PV) + (size_t)l * 16384 * DM;
    const int* EIDX = (const int*)(F.ws + WS_EIDX); const float* EG = (const float*)(F.ws + WS_EG);
    const float* X1 = (const float*)(F.ws + WS_UREG); const float* mod = (const float*)(F.ws + WS_MOD);
    const float* g2 = G(A.in.ln2_g) + l * DM; const float* b2 = G(A.in.ln2_b) + l * DM;
    for (int tok = gw; tok < ntok; tok += NGW) {
        float h[32], acc[32];
#pragma unroll
        for (int j = 0; j < 4; ++j) { const bf16x8 v = *(const bf16x8*)(HF + (size_t)tok * DM + j * 512 + lane * 8);
#pragma unroll
            for (int e = 0; e < 8; ++e) { h[j * 8 + e] = bf2f((unsigned short)v[e]); acc[j * 8 + e] = 0.f; } }
#pragma unroll 1
        for (int sb = 0; sb < 32; ++sb) {
            const int my_e = EIDX[(size_t)tok * 128 + sb * 4 + (lane & 3)]; const float my_g = EG[(size_t)tok * 128 + sb * 4 + (lane & 3)];
            const int e0 = __builtin_amdgcn_readlane(my_e, 0), e1 = __builtin_amdgcn_readlane(my_e, 1), e2 = __builtin_amdgcn_readlane(my_e, 2), e3 = __builtin_amdgcn_readlane(my_e, 3);
            float part[4];
#pragma unroll
            for (int i = 0; i < 4; ++i) {
                const int e = i == 0 ? e0 : (i == 1 ? e1 : (i == 2 ? e2 : e3)); const bf16* ur = PU + (size_t)e * DM + lane * 8; float d = 0.f;
#pragma unroll
                for (int j = 0; j < 4; ++j) { const u32x4 w = *(const u32x4*)(ur + j * 512);
                    d += h[j * 8 + 0] * bflo(w.x) + h[j * 8 + 1] * bfhi(w.x) + h[j * 8 + 2] * bflo(w.y) + h[j * 8 + 3] * bfhi(w.y)
                       + h[j * 8 + 4] * bflo(w.z) + h[j * 8 + 5] * bfhi(w.z) + h[j * 8 + 6] * bflo(w.w) + h[j * 8 + 7] * bfhi(w.w); }
                part[i] = d;
            }
            float dot;
            { const bool u1 = lane & 1, u2 = lane & 2;
              const float q0 = (u1 ? part[1] : part[0]) + __shfl_xor(u1 ? part[0] : part[1], 1);
              const float q1 = (u1 ? part[3] : part[2]) + __shfl_xor(u1 ? part[2] : part[3], 1);
              dot = (u2 ? q1 : q0) + __shfl_xor(u2 ? q0 : q1, 2);
              dot += __shfl_xor(dot, 4); dot += __shfl_xor(dot, 8); dot += __shfl_xor(dot, 16); dot += __shfl_xor(dot, 32); }
            const float act = gelu_exact(dot) * my_g;
#pragma unroll
            for (int i = 0; i < 4; ++i) {
                const int e = i == 0 ? e0 : (i == 1 ? e1 : (i == 2 ? e2 : e3)); const float w = __uint_as_float(__builtin_amdgcn_readlane(__float_as_uint(act), i));
                const bf16* vr = PV + (size_t)e * DM + lane * 8;
#pragma unroll
                for (int j = 0; j < 4; ++j) { const u32x4 x = *(const u32x4*)(vr + j * 512);
                    acc[j * 8 + 0] += w * bflo(x.x); acc[j * 8 + 1] += w * bfhi(x.x); acc[j * 8 + 2] += w * bflo(x.y); acc[j * 8 + 3] += w * bfhi(x.y);
                    acc[j * 8 + 4] += w * bflo(x.z); acc[j * 8 + 5] += w * bfhi(x.z); acc[j * 8 + 6] += w * bflo(x.w); acc[j * 8 + 7] += w * bfhi(x.w); }
            }
        }
        const int bidx = tok < ML ? (tok >> 12) : 4;
        const float* mr = mod + ((size_t)l * 5 + bidx) * MODW; const float* x1 = X1 + (size_t)tok * DM;
        float s = 0.f;
#pragma unroll
        for (int j = 0; j < 4; ++j) { const int c = j * 512 + lane * 8;
            const f32x4 xa = *(const f32x4*)(x1 + c), xb = *(const f32x4*)(x1 + c + 4), ga = *(const f32x4*)(mr + 5 * DM + c), gb = *(const f32x4*)(mr + 5 * DM + c + 4);
#pragma unroll
            for (int e = 0; e < 4; ++e) { acc[j * 8 + e] = ALPHA * xa[e] + ga[e] * acc[j * 8 + e]; acc[j * 8 + 4 + e] = ALPHA * xb[e] + gb[e] * acc[j * 8 + 4 + e]; s += acc[j * 8 + e] + acc[j * 8 + 4 + e]; } }
        const float mean = wave_sum(s) * (1.0f / DM); float q = 0.f;
#pragma unroll
        for (int k = 0; k < 32; ++k) { acc[k] -= mean; q += acc[k] * acc[k]; }
        const float rstd = rsqrtf(wave_sum(q) * (1.0f / DM) + LN_EPS);
        const float* mn = mod + ((size_t)(l + 1 < DEPTH ? l + 1 : l) * 5 + bidx) * MODW;
#pragma unroll
        for (int j = 0; j < 4; ++j) { const int c = j * 512 + lane * 8;
            const f32x4 ga = *(const f32x4*)(g2 + c), gb = *(const f32x4*)(g2 + c + 4), ba = *(const f32x4*)(b2 + c), bb = *(const f32x4*)(b2 + c + 4);
            f32x4 ya, yb;
#pragma unroll
            for (int e = 0; e < 4; ++e) { ya[e] = acc[j * 8 + e] * rstd * ga[e] + ba[e]; yb[e] = acc[j * 8 + 4 + e] * rstd * gb[e] + bb[e]; }
            *(f32x4*)(outp + (size_t)tok * DM + c) = ya; *(f32x4*)(outp + (size_t)tok * DM + c + 4) = yb;
            if (Hnext) { const f32x4 sa = *(const f32x4*)(mn + DM + c), sb = *(const f32x4*)(mn + DM + c + 4), ha = *(const f32x4*)(mn + c), hb = *(const f32x4*)(mn + c + 4);
                const f32x4 za = ya * (sa + 1.0f) + ha, zb = yb * (sb + 1.0f) + hb;
                u32x4 o; o.x = pk2(za[0], za[1]); o.y = pk2(za[2], za[3]); o.z = pk2(zb[0], zb[1]); o.w = pk2(zb[2], zb[3]);
                *(u32x4*)(Hnext + (size_t)tok * DM + c) = o; }
        }
    }
}

#ifndef SD_A
#define SD_A 1
#endif
#ifndef SD_D
#define SD_D 1
#endif
#ifndef SD_B
#define SD_B 2
#endif
#ifndef SD_C
#define SD_C 1
#endif
#ifndef ATT_MASK
#define ATT_MASK 15
#endif
template <int TYPE> __device__ __forceinline__ att::Args make_att_args(const Frame& F, KA A, int l, int idx, bool ctxq) {
    const bf16* U = (const bf16*)(F.ws + WS_UREG); const bf16* QK = (const bf16*)(F.ws + WS_QKVA); bf16* O = (bf16*)(F.ws + WS_OQP);
    constexpr int NH = (TYPE == 2) ? 8 : 4;
    int b, h, qb;
    if (ctxq) { b = idx / NH; h = idx % NH; qb = 0; } else { b = idx / (NH * 16); h = (idx >> 4) % NH; qb = idx & 15; }
    const int row = ctxq ? ML + b * NCTX : b * SEQ + qb * 256;
    att::Args a{};
    a.ldo = DM; a.qpos0 = qb * 256;
    if (ctxq) { a.n0 = 4; a.row0 = ML + b * NCTX; a.n1 = 0; a.row1 = 0; }
    if constexpr (TYPE == 0) {
        a.Q = QK + (size_t)row * QW + QA_Q + h * 192; a.ldq = QW; a.KV = QK; a.ld = QW; a.kc0 = QA_KV + h * 256; a.kc1 = QA_KR; a.vc = QA_KV + h * 256 + 128;
        a.O = O + (size_t)row * DM + h * 128; a.C = A_SCALE * LOG2E; a.thr = 8.0f / A_SCALE; a.qrope = ctxq ? 0 : 1;
        if (!ctxq) { a.n0 = 64; a.row0 = b * SEQ; a.n1 = 4; a.row1 = ML + b * NCTX; }
    } else if constexpr (TYPE == 1) {
        const int kvh = h >> 1;
        a.Q = U + (size_t)row * UW + U_DQ + h * 128; a.ldq = UW; a.KV = U; a.ld = UW; a.kc0 = U_DK + kvh * 128; a.kc1 = 0; a.vc = U_DV + kvh * 128;
        a.O = O + (size_t)row * DM + 1536 + h * 128; a.C = D_SCALE * LOG2E; a.thr = 8.0f / D_SCALE;
        if (!ctxq) { a.n0 = 64; a.row0 = b * SEQ; a.n1 = 4; a.row1 = ML + b * NCTX; }
    } else if constexpr (TYPE == 2) {
        const int kvh = h >> 2;
        a.Q = U + (size_t)row * UW + U_BQ + h * 64; a.ldq = UW; a.KV = U; a.ld = UW; a.kc0 = U_BK + kvh * 64; a.kc1 = 0; a.vc = U_BV + kvh * 64;
        a.O = O + (size_t)row * DM + 512 + h * 64; a.C = B_SCALE * LOG2E; a.thr = 8.0f / B_SCALE; a.has_sink = 1; a.sinkl2 = G(A.in.b_sink)[l * 8 + h] * LOG2E;
        if (!ctxq) { int ws = qb * 256 - 128; ws = ws < 0 ? 0 : ws; int we = qb * 256 + 384; we = we > SEQ ? SEQ : we;
            a.n0 = 4; a.row0 = ML + b * NCTX; a.n1 = (we - ws) / 64; a.row1 = b * SEQ + ws; a.wpos0 = ws; }
    } else {
        a.Q = U + (size_t)row * UW + U_CQQ + h * 128; a.ldq = UW; a.KV = U; a.ld = UW; a.kc0 = U_CK + h * 128; a.kc1 = 0; a.vc = U_CV + h * 128;
        a.O = O + (size_t)row * DM + 1024 + h * 128; a.C = C_SCALE * LOG2E; a.thr = 8.0f / C_SCALE;
        a.T = (const float*)(F.ws + WS_CTAB) + (size_t)((l * 4 + h) * 15) * 4096;
        if (!ctxq) { const int r0 = qb * 4; int kr0 = r0 - 4; kr0 = kr0 < 0 ? 0 : (kr0 > 56 ? 56 : kr0); int ke = r0 + 3 - 4; ke = ke < 0 ? 0 : (ke > 56 ? 56 : ke); ke += 7; const int nr = ke - kr0 + 1;
            a.n0 = 4; a.row0 = ML + b * NCTX; a.n1 = nr + (nr & 1); a.row1 = b * SEQ + kr0 * 64; a.r0 = r0; a.kr0 = kr0; }
    }
    return a;
}
#define AF() Frame F = F0; asm volatile("" : "+v"(F.tid), "+v"(F.lane), "+s"(F.wave), "+s"(F.vcu), "+s"(F.G), "+s"(F.ws), "+s"(F.lds)); LAS char* lds = (LAS char*)(F.lds + RING_OFF); const int v = F.vcu
__device__ __forceinline__ void att_phase(const Frame& F0, int l) {
    if (F0.vcu >= 256) return;
    const bool cx = (l + 1 < DEPTH);
    if (ATT_MASK & 1) { AF(); KA A = *kargs(); const int n = 1 + ((cx && v < 16) ? 1 : 0);
        for (int k = 0; k < n; ++k) { const att::Args a = make_att_args<0>(F, A, l, k ? v : v, k != 0); att::attn_unit<192, 128, 0, SD_A>(a, lds, F.tid); } }
    if (ATT_MASK & 2) { AF(); KA A = *kargs(); const int n = 1 + ((cx && v >= 16 && v < 32) ? 1 : 0);
        for (int k = 0; k < n; ++k) { const att::Args a = make_att_args<1>(F, A, l, k ? v - 16 : v, k != 0); att::attn_unit<128, 128, 0, SD_D>(a, lds, F.tid); } }
    if (ATT_MASK & 4) { AF(); KA A = *kargs(); const int n = 2 + ((cx && v >= 48 && v < 80) ? 1 : 0);
        for (int k = 0; k < n; ++k) { const att::Args a = make_att_args<2>(F, A, l, k == 2 ? v - 48 : 2 * v + k, k == 2); att::attn_unit<64, 64, 1, SD_B>(a, lds, F.tid); } }
    if (ATT_MASK & 8) { AF(); KA A = *kargs(); const int n = 1 + ((cx && v >= 32 && v < 48) ? 1 : 0);
        for (int k = 0; k < n; ++k) { const att::Args a = make_att_args<3>(F, A, l, k ? v - 32 : v, k != 0); att::attn_unit<128, 128, 2, SD_C>(a, lds, F.tid); } }
}

__device__ __forceinline__ void merge_ctx_reduce(const Frame& F, bf16* S, const char* CP) {
    const int T = F.vcu; if (T >= 32) return;
    const int tid = F.tid, wid = tid >> 6, lane = tid & 63, wr = wid >> 2, wc = wid & 3, fr = lane & 15, fq = lane >> 4;
    const int pm = 64 + (T >> 3), pn = T & 7; const int row0 = pm * 256 + wr * 64 + fr, col0 = pn * 256 + wc * 32 + 8 * fq;
    for (int si = 0; si < 16; ++si) {
        f32x4 v0 = {0.f, 0.f, 0.f, 0.f}, v1 = v0;
#pragma unroll
        for (int z = 0; z < 4; ++z) { const char* p = CP + (size_t)(T * 4 + z) * 262144 + ((size_t)(si * 2) * 512 + tid) * 16; v0 += *(const f32x4*)p; v1 += *(const f32x4*)(p + 8192); }
        const int ai = si >> 3, m = (si >> 1) & 3, bj = si & 1;
        u32x4 w; w.x = cvt_pk_bf16(v0[0], v0[1]); w.y = cvt_pk_bf16(v0[2], v0[3]); w.z = cvt_pk_bf16(v1[0], v1[1]); w.w = cvt_pk_bf16(v1[2], v1[3]);
        *(u32x4*)(S + (size_t)(row0 + ai * 128 + m * 16) * 2048 + col0 + bj * 128) = w;
    }
}

constexpr int N_PHASES = 3 + 10 * DEPTH;
#ifndef MK_N_LAUNCHES
#define MK_N_LAUNCHES 1
#endif
static_assert(MK_N_LAUNCHES == 1, "the merge phase carries a grid barrier of its own (context tiles): single-launch builds only");
__global__ void __launch_bounds__(NWAVES * 64, 2) mk_fwd(Args args) {
    extern __shared__ __attribute__((aligned(16))) unsigned char lds_raw[];
    Frame F;
    F.lds = (LAS unsigned char*)lds_raw; F.tid = threadIdx.x; F.lane = F.tid & 63; F.wave = __builtin_amdgcn_readfirstlane(F.tid >> 6);
    F.G = gridDim.x; { const int bx = blockIdx.x; F.vcu = (F.G % 8 == 0) ? (bx % 8) * (F.G / 8) + bx / 8 : bx; }
    GAS unsigned char* ws; int lo, hi, li;
    { KAP ap = kargs(); ws = (GAS unsigned char*)ap->ws; lo = ap->ph_lo; hi = ap->ph_hi; li = ap->li; }
    F.ws = ws;
    for (int u = F.tid; u < (LDS_BYTES - LDSCTL_OFF) / 4; u += NWAVES * 64) ((LAS unsigned*)(F.lds + LDSCTL_OFF))[u] = 0u;
    __syncthreads();
    volatile LAS unsigned* MISC = (volatile LAS unsigned*)(F.lds + MISC_OFF);
    XcdBarrier bar = xcd_barrier_post((unsigned*)(ws + WS_CTL) + CW_BAR + li * XCD_BAR_WORDS, MISC + 8);
#ifndef PHASE_MASK
#define PHASE_MASK 0x1fff
#endif
#define INR(k) (lo <= (k) && (k) < hi)
#define IN(k) ((((PHASE_MASK) >> ((k) < 3 ? (k) : 3 + ((k) - 3) % 10)) & 1) && INR(k))
#define SEAM(k) do { if (INR(k) && INR((k) + 1)) xcd_barrier(bar); } while (0)
#ifndef PROBE_DUP
#define PROBE_DUP 0
#endif
#ifndef PROBE_REP
#define PROBE_REP 1
#endif
#define KIND(k) ((k) < 3 ? (k) : 3 + ((k) - 3) % 10)
#define REP(k) for (int rep_ = 0, nrep_ = 1 + ((((PROBE_DUP) >> KIND(k)) & 1) ? PROBE_REP : 0); rep_ < nrep_; ++rep_, (rep_ < nrep_ ? xcd_barrier(bar) : (void)0))
#define PF() Frame Fp = F; int bx = blockIdx.x; asm volatile("" : "+v"(Fp.tid), "+v"(Fp.lane), "+s"(Fp.wave), "+s"(Fp.vcu), "+s"(Fp.G), "+s"(Fp.ws), "+s"(Fp.lds), "+s"(bx)); GAS unsigned char* ws = Fp.ws; (void)bx; (void)ws
    if (IN(0)) REP(0) { PF(); p0_prologue(Fp, *kargs()); } SEAM(0);
    if (IN(1)) REP(1) { PF(); p1_modreduce(Fp, *kargs()); } SEAM(1);
    if (IN(2)) REP(2) { PF(); p2_modulate0(Fp, *kargs()); } SEAM(2);
    for (int l = 0; l < DEPTH; ++l) {
        const int pb = 3 + 10 * l; const bool last = (l + 1 == DEPTH);
        const size_t offH = (l & 1) ? WS_BUFB : WS_BUFA, offS = (l & 1) ? WS_BUFA : WS_BUFB;
        const int nPl = last ? 64 : 68, nrows = last ? ML : MT;
        if (IN(pb + 0)) REP(pb + 0) {
            PF(); bf16* Hb = (bf16*)(ws + offH);
            pg8::PlainSched S{(const char*)Hb, (const char*)((bf16*)(ws + WS_WIN) + (size_t)l * UW * DM), DM, DM, DM, 68, 16, Fp.G, bx};
            pg8::EpiBf16 E{(bf16*)(ws + WS_UREG), UW};
            pg8::gemm_phase(Fp.lds + RING_OFF, S, E, DM, DM, Fp.tid);
        } SEAM(pb + 0);
        if (IN(pb + 1)) REP(pb + 1) { PF(); enorm_phase(Fp, *kargs(), l); } SEAM(pb + 1);
        if (IN(pb + 2)) REP(pb + 2) { PF();
            pg8::PlainSched S{(const char*)(ws + WS_UREG), (const char*)((bf16*)(ws + WS_WUP) + (size_t)l * 1792 * 512), UW, 512, 512, 68, 7, Fp.G, bx};
            pg8::EpiBf16 E{(bf16*)(ws + WS_QKVA), QW};
            pg8::gemm_phase(Fp.lds + RING_OFF, S, E, UW, 512, Fp.tid);
        } SEAM(pb + 2);
        if (IN(pb + 3)) REP(pb + 3) { PF(); att_phase(Fp, l); } SEAM(pb + 3);
        if (IN(pb + 4)) REP(pb + 4) { PF(); bf16* Hb = (bf16*)(ws + offH); bf16* Sb = (bf16*)(ws + offS);
            pg8::MergeSched S{(const char*)Hb, (const char*)(ws + WS_OQP), (const char*)((bf16*)(ws + WS_WC) + (size_t)l * 4 * DM * 2560), nPl, Fp.G, bx};
            pg8::EpiMerge E{Sb, G(kargs()->in.b_gate) + (size_t)l * 4 * DM, (char*)(ws + WS_STASH) + (size_t)bx * STASH_WG, (char*)(ws + WS_P) + (size_t)bx * P_WG, (char*)(ws + WS_CP), Fp.tid};
            pg8::gemm_phase(Fp.lds + RING_OFF, S, E, DM, 2560, Fp.tid);
            if (nPl > 64) { xcd_barrier(bar); merge_ctx_reduce(Fp, Sb, (const char*)(ws + WS_CP)); }
        } SEAM(pb + 4);
        if (IN(pb + 5)) REP(pb + 5) { PF(); bf16* Sb = (bf16*)(ws + offS);
            pg8::PlainSched S{(const char*)Sb, (const char*)((bf16*)(ws + WS_WO) + (size_t)l * DM * DM), DM, DM, DM, nPl, 8, Fp.G, bx};
            KAP ap = kargs();
            pg8::EpiOut E{(float*)(ws + WS_UREG), l == 0 ? G(ap->in.x) : (const float*)(ws + WS_XRES), l == 0 ? G(ap->in.ctx) : (const float*)(ws + WS_XRES) + (size_t)ML * DM,
                          (const float*)(ws + WS_MOD) + (size_t)l * 5 * MODW, ALPHA};
            pg8::gemm_phase(Fp.lds + RING_OFF, S, E, DM, DM, Fp.tid);
        } SEAM(pb + 5);
        if (IN(pb + 6)) REP(pb + 6) { PF(); ln1_phase(Fp, *kargs(), l, nrows, (bf16*)(ws + offH)); } SEAM(pb + 6);
        if (IN(pb + 7)) REP(pb + 7) { PF(); bf16* Hb = (bf16*)(ws + offH);
            pg8::PlainSched S{(const char*)Hb, (const char*)((bf16*)(ws + WS_WPQ) + (size_t)l * DM * DM), DM, DM, DM, nPl, 8, Fp.G, bx};
            pg8::EpiBf16 E{(bf16*)(ws + WS_OQP), DM};
            pg8::gemm_phase(Fp.lds + RING_OFF, S, E, DM, DM, Fp.tid);
        } SEAM(pb + 7);
        if (IN(pb + 8)) REP(pb + 8) { PF();
            const int gw = Fp.vcu * NWAVES + Fp.wave, NGW = Fp.G * NWAVES;
            LAS unsigned short* tblw = (LAS unsigned short*)(Fp.lds + RING_OFF) + Fp.wave * (64 * 66);
            for (int it = gw; it < (nrows / 32) * 8; it += NGW)
                peer::topk_item((const bf16*)(ws + WS_OQP), (const bf16*)(ws + WS_SUBK) + (size_t)l * 8 * 2 * 128 * 128, (int*)(ws + WS_EIDX), (float*)(ws + WS_EG), (it >> 3) * 32, it & 7, tblw, Fp.lane);
        } SEAM(pb + 8);
        if (IN(pb + 9)) REP(pb + 9) { PF(); pexp4_phase(Fp, *kargs(), l, nrows, (bf16*)(ws + offH), last ? G(kargs()->out) : (float*)(ws + WS_XRES), last ? nullptr : (bf16*)(ws + offS)); } SEAM(pb + 9);
    }
#undef IN
#undef INR
#undef SEAM
}

extern "C" void kernel_launch(void* const* d_in, const int* in_sizes, int n_in, void* d_out, int out_size, void* d_ws, size_t ws_size, hipStream_t stream) {
    static int grid = 0;
    if (grid == 0) {
        if (n_in != 27 || out_size != ML * DM || ws_size < WS_END) { fprintf(stderr, "kernel_launch: unexpected shapes (n_in %d out %d ws %zu, need ws >= %zu)\n", n_in, out_size, ws_size, (size_t)WS_END); grid = -1; return; }
        int dev = 0, cus = 0, per_cu = 0;
        if (hipGetDevice(&dev) != hipSuccess || hipDeviceGetAttribute(&cus, hipDeviceAttributeMultiprocessorCount, dev) != hipSuccess) { grid = -1; return; }
        if (hipFuncSetAttribute((const void*)mk_fwd, hipFuncAttributeMaxDynamicSharedMemorySize, LDS_BYTES) != hipSuccess) { fprintf(stderr, "kernel_launch: hipFuncSetAttribute failed\n"); grid = -1; return; }
        if (hipOccupancyMaxActiveBlocksPerMultiprocessor(&per_cu, (const void*)mk_fwd, NWAVES * 64, LDS_BYTES) != hipSuccess || per_cu < 1) { fprintf(stderr, "kernel_launch: occupancy query says %d\n", per_cu); }
        (void)hipGetLastError();
        grid = cus < 256 ? cus : 256;
    }
    if (grid < 0) return;
    (void)hipMemsetAsync((char*)d_ws + WS_CTL, 0, CTL_ZERO_BYTES, stream);
    Args a{};
    const float** ip = (const float**)&a.in;
    for (int i = 0; i < 27; ++i) ip[i] = (const float*)d_in[i];
    a.out = (float*)d_out; a.ws = (unsigned char*)d_ws;
    for (int li = 0; li < MK_N_LAUNCHES; ++li) {
        a.ph_lo = (MK_N_LAUNCHES == 1) ? 0 : li; a.ph_hi = (MK_N_LAUNCHES == 1) ? N_PHASES : li + 1; a.li = li; a.pad = 0;
        hipLaunchKernelGGL(mk_fwd, dim3(grid), dim3(NWAVES * 64), LDS_BYTES, stream, a);
    }
}
```

```cpp
#include <hip/hip_runtime.h>
#include <cstdio>
#include <cstdint>
#include <utility>

#define GAS __attribute__((address_space(1)))
#define LAS __attribute__((address_space(3)))
typedef unsigned short bf16;
typedef short bf16x8 __attribute__((ext_vector_type(8)));
typedef short s16x4 __attribute__((ext_vector_type(4)));
typedef float f32x2 __attribute__((ext_vector_type(2)));
typedef float f32x4 __attribute__((ext_vector_type(4)));
typedef float f32x16 __attribute__((ext_vector_type(16)));
typedef unsigned u32x2 __attribute__((ext_vector_type(2)));
typedef unsigned u32x4 __attribute__((ext_vector_type(4)));
typedef GAS unsigned gu32;

__device__ __forceinline__ unsigned cvt_pk_bf16(float lo, float hi) { unsigned r; asm volatile("v_cvt_pk_bf16_f32 %0, %1, %2" : "=v"(r) : "v"(lo), "v"(hi)); return r; }
__device__ __forceinline__ float bf2f(unsigned short b) { return __uint_as_float(((unsigned)b) << 16); }
__device__ __forceinline__ float bflo(unsigned w) { return __uint_as_float(w << 16); }
__device__ __forceinline__ float bfhi(unsigned w) { return __uint_as_float(w & 0xffff0000u); }
__device__ __forceinline__ unsigned short f2bf(float f) { return (unsigned short)(cvt_pk_bf16(f, 0.f) & 0xffffu); }

namespace pg8 {
constexpr int BM = 256, BK = 64, HALF = 128, HTB = HALF * BK * 2  , STAGE_BYTES = 8 * HTB, NXCD = 8, WGM = 8;
__host__ __device__ __forceinline__ int lds_byte(int r, int c) { const int st = (r >> 4) * 2 + (c >> 5), rr = r & 15, cc = c & 31, ob = rr * 64 + cc * 2; return st * 1024 + (ob ^ (((ob >> 9) & 1) << 5)); }
__host__ __device__ __forceinline__ void stage_rc(int b, int& R, int& C) { const int st = b / 1024, sb = b % 1024, swz = sb ^ (((sb >> 9) & 1) << 5); R = (st >> 1) * 16 + swz / 64; C = (st & 1) * 32 + (swz % 64) / 2; }
__host__ __device__ __forceinline__ int perm32(int rho) { const int n = rho >> 4, i = rho & 15; return 8 * (i >> 2) + 4 * n + (i & 3); }

struct Unit { int pm, pn, z, aux; };

__device__ __forceinline__ void tile_of(int L, int nM, int nN, int& pm, int& pn) {
    const int nwg = nM * nN; int wgid = L;
    { const int q = nwg / NXCD, r = nwg % NXCD, xcd = wgid % NXCD, off = wgid / NXCD; wgid = (xcd < r ? xcd * (q + 1) : r * (q + 1) + (xcd - r) * q) + off; }
    const int nig = WGM * nN, gid = wgid / nig, fm = gid * WGM, gsz = (nM - fm) < WGM ? (nM - fm) : WGM;
    pm = fm + ((wgid % nig) % gsz); pn = (wgid % nig) / gsz;
}
struct PlainSched {
    const char* A; const char* B; int lda, ldb, K, nM, nN, G, c, esz;
    __device__ __forceinline__ bool next(int i, Unit& u) const { const long L = (long)i * G + c; if (L >= (long)nM * nN) return false; tile_of((int)L, nM, nN, u.pm, u.pn); u.z = 0; u.aux = 0; return true; }
    __device__ __forceinline__ void ptrs(const Unit& u, const char*& a, const char*& b, int& nt) const { a = A + (size_t)u.pm * BM * lda * esz; b = B + (size_t)u.pn * BM * ldb * esz; nt = K * esz / 128; }
};
struct MergeSched {
    const char* H; const char* O; const char* W; int nM, G, c, esz;
    __device__ __forceinline__ bool next(int i, Unit& u) const {
        const int ngl = (512 - c + G - 1) / G;
        if (i < 8 * ngl) { tile_of((i >> 3) * G + c, 64, 8, u.pm, u.pn); u.z = i & 7; u.aux = 0; return true; }
        if (nM <= 64) return false;
        const int t = i - 8 * ngl, j = c + (t >> 1) * G; if (j >= 128) return false;
        const int T = j >> 2; u.pm = 64 + (T >> 3); u.pn = T & 7; u.z = 8 + (j & 3) * 2 + (t & 1); u.aux = j; return true;
    }
    __device__ __forceinline__ void ptrs(const Unit& u, const char*& a, const char*& b, int& nt) const {
        const int z = (u.z & 7) >> 1, kind = u.z & 1;
        a = (kind ? H : O + (size_t)z * 512 * esz) + (size_t)u.pm * BM * 2048 * esz;
        b = W + ((size_t)z * 2048 * 2560 + (size_t)u.pn * BM * 2560 + (kind ? 0 : 2048)) * esz;
        nt = (kind ? 2048 : 512) * esz / 128;
    }
};

struct EpiBf16 {
    static constexpr bool PERM = true;
    bf16* O; int ldc;
    __device__ __forceinline__ void operator()(const f32x4 (&acc)[2][2][4][2], const Unit& u, int wr, int wc, int fr, int fq) const {
        const int row0 = u.pm * BM + wr * 64 + fr, col0 = u.pn * BM + wc * 32 + 8 * fq;
#pragma unroll
        for (int ai = 0; ai < 2; ++ai)
#pragma unroll
            for (int m = 0; m < 4; ++m) { bf16* rowp = O + (size_t)(row0 + ai * HALF + m * 16) * ldc + col0;
#pragma unroll
                for (int bj = 0; bj < 2; ++bj) { const f32x4 v0 = acc[ai][bj][m][0], v1 = acc[ai][bj][m][1];
                    u32x4 w; w.x = cvt_pk_bf16(v0[0], v0[1]); w.y = cvt_pk_bf16(v0[2], v0[3]); w.z = cvt_pk_bf16(v1[0], v1[1]); w.w = cvt_pk_bf16(v1[2], v1[3]);
                    *(u32x4*)(rowp + bj * HALF) = w; } }
    }
};
struct EpiMerge {
    static constexpr bool PERM = true;
    bf16* S; const float* bgate; char* stash; char* P; char* CP; int tid; int s8;
    __device__ __forceinline__ void operator()(const f32x4 (&acc)[2][2][4][2], const Unit& u, int wr, int wc, int fr, int fq) const {
        const int z = (u.z & 7) >> 1, kind = u.z & 1; const bool cx = u.z >= 8; int tl = tid; asm volatile("" : "+v"(tl));
        GAS char* sp = (GAS char*)stash + (size_t)tl * 16;
        if (kind == 0) {
#pragma unroll
            for (int ai = 0; ai < 2; ++ai)
#pragma unroll
                for (int m = 0; m < 4; ++m)
#pragma unroll
                    for (int bj = 0; bj < 2; ++bj) { const f32x4 v0 = acc[ai][bj][m][0], v1 = acc[ai][bj][m][1];
                        u32x4 w; w.x = cvt_pk_bf16(v0[0], v0[1]); w.y = cvt_pk_bf16(v0[2], v0[3]); w.z = cvt_pk_bf16(v1[0], v1[1]); w.w = cvt_pk_bf16(v1[2], v1[3]);
                        *(GAS u32x4*)sp = w; sp += 8192; asm volatile("" : "+v"(sp)); }
            return;
        }
        GAS char* pq = (cx ? (GAS char*)CP + (size_t)u.aux * 262144 : (GAS char*)P) + (size_t)tl * 16;
        const int row0 = u.pm * BM + wr * 64 + fr, col0 = u.pn * BM + wc * 32 + 8 * fq;
        const float* bz = bgate + z * 2048 + col0;
        f32x4 bv[2][2];
#pragma unroll
        for (int bj = 0; bj < 2; ++bj)
#pragma unroll
            for (int n = 0; n < 2; ++n) bv[bj][n] = *(const f32x4*)(bz + bj * HALF + 4 * n);
        GAS bf16* rowp = (GAS bf16*)S + (size_t)row0 * 2048 + col0; GAS unsigned char* rowp8 = (GAS unsigned char*)S + (size_t)row0 * 2048 + col0;
#pragma unroll
        for (int ai = 0; ai < 2; ++ai)
#pragma unroll
            for (int m = 0; m < 4; ++m) {
#pragma unroll
                for (int bj = 0; bj < 2; ++bj) {
                    const u32x4 sw = *(const GAS u32x4*)sp; sp += 8192; asm volatile("" : "+v"(sp));
                    f32x4 v0 = acc[ai][bj][m][0] + bv[bj][0], v1 = acc[ai][bj][m][1] + bv[bj][1];
#pragma unroll
                    for (int j = 0; j < 4; ++j) { v0[j] = __builtin_amdgcn_rcpf(1.0f + __builtin_amdgcn_exp2f(-1.4426950408889634f * v0[j])); v1[j] = __builtin_amdgcn_rcpf(1.0f + __builtin_amdgcn_exp2f(-1.4426950408889634f * v1[j])); }
                    v0[0] *= bflo(sw.x); v0[1] *= bfhi(sw.x); v0[2] *= bflo(sw.y); v0[3] *= bfhi(sw.y);
                    v1[0] *= bflo(sw.z); v1[1] *= bfhi(sw.z); v1[2] *= bflo(sw.w); v1[3] *= bfhi(sw.w);
                    if (z > 0 && !cx) { v0 += *(const GAS f32x4*)pq; v1 += *(const GAS f32x4*)(pq + 8192); }
                    if (z < 3 || cx) { *(GAS f32x4*)pq = v0; *(GAS f32x4*)(pq + 8192) = v1; }
                    else if (s8) { int w0 = __builtin_amdgcn_cvt_pk_fp8_f32(v0[0], v0[1], 0, false); w0 = __builtin_amdgcn_cvt_pk_fp8_f32(v0[2], v0[3], w0, true);
                        int w1 = __builtin_amdgcn_cvt_pk_fp8_f32(v1[0], v1[1], 0, false); w1 = __builtin_amdgcn_cvt_pk_fp8_f32(v1[2], v1[3], w1, true);
                        *(GAS u32x2*)(rowp8 + bj * HALF) = (u32x2){(unsigned)w0, (unsigned)w1}; }
                    else { u32x4 w; w.x = cvt_pk_bf16(v0[0], v0[1]); w.y = cvt_pk_bf16(v0[2], v0[3]); w.z = cvt_pk_bf16(v1[0], v1[1]); w.w = cvt_pk_bf16(v1[2], v1[3]);
                        *(GAS u32x4*)(rowp + bj * HALF) = w; }
                    pq += 16384; asm volatile("" : "+v"(pq));
                }
                rowp += (m == 3 ? (size_t)(HALF - 48) : (size_t)16) * 2048; rowp8 += (m == 3 ? (size_t)(HALF - 48) : (size_t)16) * 2048; asm volatile("" : "+v"(rowp), "+v"(rowp8));
                asm volatile("" ::: "memory"); }
    }
};
struct EpiOut {
    static constexpr bool PERM = false;
    float* Y; const float* xlat; const float* xctx; const float* mod_l; float alpha;
    __device__ __forceinline__ void operator()(const f32x4 (&acc)[2][2][4][2], const Unit& u, int wr, int wc, int fr, int fq) const {
        asm volatile("" : "+v"(fr), "+v"(fq));
        const int row0 = u.pm * BM + wr * 64 + fr, col0 = u.pn * BM + wc * 32 + 4 * fq;
        const float* xb = (u.pm < 64) ? xlat + (size_t)row0 * 2048 : xctx + (size_t)(row0 - 16384) * 2048;
        const float* ga = mod_l + (size_t)((u.pm < 64) ? (u.pm >> 4) : 4) * 12288 + 2 * 2048 + col0;
        f32x4 gv[2][2];
#pragma unroll
        for (int bj = 0; bj < 2; ++bj)
#pragma unroll
            for (int n = 0; n < 2; ++n) gv[bj][n] = *(const f32x4*)(ga + bj * HALF + n * 16);
#pragma unroll
        for (int ai = 0; ai < 2; ++ai)
#pragma unroll
            for (int m = 0; m < 4; ++m) { const size_t ro = (size_t)(ai * HALF + m * 16) * 2048 + col0; float* yp = Y + (size_t)row0 * 2048 + ro;
#pragma unroll
                for (int bj = 0; bj < 2; ++bj)
#pragma unroll
                    for (int n = 0; n < 2; ++n) { const f32x4 xv = *(const f32x4*)(xb + ro + bj * HALF + n * 16); *(f32x4*)(yp + bj * HALF + n * 16) = xv * alpha + gv[bj][n] * acc[ai][bj][m][n]; } }
    }
};

typedef int v8i_t __attribute__((ext_vector_type(8)));
typedef int v4i_t __attribute__((ext_vector_type(4)));
template <class Epi, class Sched, bool F8 = false>
__device__ __forceinline__ void gemm_phase(LAS unsigned char* lds, const Sched& S, const Epi& E, const int lda, const int ldb, const int tid) {
    constexpr int ESZ = F8 ? 1 : 2;
    int f8scale = 0x7c7c7c7c; asm volatile("" : "+v"(f8scale));
    const int wid = __builtin_amdgcn_readfirstlane(tid >> 6), lane = tid & 63, wr = wid >> 2, wc = wid & 3, fr = lane & 15, fq = lane >> 4;
    unsigned voffA[2], voffB[2];
#pragma unroll
    for (int i = 0; i < 2; ++i) { int R, C; stage_rc(tid * 16 + i * 8192, R, C); const int Rb = Epi::PERM ? ((R & ~31) + perm32(R & 31)) : R;
        voffA[i] = (unsigned)(R * lda * ESZ + C * 2); voffB[i] = (unsigned)(Rb * ldb * ESZ + C * 2); }
    const size_t kstep = (size_t)(BK * 2);
    const size_t hstepA = (size_t)HALF * lda * ESZ, hstepB = (size_t)HALF * ldb * ESZ;
    const unsigned ldsw = (unsigned)wid * 1024u;
    const int aoff = lds_byte(wr * 64 + fr, fq * 8), boff = lds_byte(wc * 32 + fr, fq * 8);
#define PG8_SA(b, h) (((b) * 2 + (h)) * HTB)
#define PG8_SB(b, h) ((4 + (b) * 2 + (h)) * HTB)
#define PG8_STAGE(bufoff, gbase, voff) do { _Pragma("unroll") for (int _i = 0; _i < 2; ++_i) \
        __builtin_amdgcn_global_load_lds((const unsigned*)((const char*)(gbase) + (voff)[_i]), (LAS unsigned*)(lds + (bufoff) + ldsw + _i * 8192), 16, 0, 0); } while (0)
#define PG8_LDA(dst, b, h) do { _Pragma("unroll") for (int m = 0; m < 4; ++m) _Pragma("unroll") for (int k = 0; k < 2; ++k) dst[m][k] = *(const LAS bf16x8*)(lds + PG8_SA(b, h) + aoff + m * 2048 + k * 1024); } while (0)
#define PG8_LDB(dst, b, h) do { _Pragma("unroll") for (int n = 0; n < 2; ++n) _Pragma("unroll") for (int k = 0; k < 2; ++k) dst[n][k] = *(const LAS bf16x8*)(lds + PG8_SB(b, h) + boff + n * 2048 + k * 1024); } while (0)
#define PG8_MMA(ai, bj, At, Bt) do { __builtin_amdgcn_s_setprio(1); _Pragma("unroll") for (int m = 0; m < 4; ++m) _Pragma("unroll") for (int n = 0; n < 2; ++n) { \
        if constexpr (F8) { const v8i_t wa_ = __builtin_shufflevector(__builtin_bit_cast(v4i_t, Bt[n][0]), __builtin_bit_cast(v4i_t, Bt[n][1]), 0, 1, 2, 3, 4, 5, 6, 7); \
            const v8i_t xa_ = __builtin_shufflevector(__builtin_bit_cast(v4i_t, At[m][0]), __builtin_bit_cast(v4i_t, At[m][1]), 0, 1, 2, 3, 4, 5, 6, 7); \
            asm volatile("v_mfma_scale_f32_16x16x128_f8f6f4 %0, %1, %2, %0, %3, %3 op_sel_hi:[0,0,0]" : "+v"(acc[ai][bj][m][n]) : "v"(wa_), "v"(xa_), "v"(f8scale)); } \
        else { _Pragma("unroll") for (int k = 0; k < 2; ++k) acc[ai][bj][m][n] = __builtin_amdgcn_mfma_f32_16x16x32_bf16(Bt[n][k], At[m][k], acc[ai][bj][m][n], 0, 0, 0); } } \
        __builtin_amdgcn_s_setprio(0); } while (0)
#define PG8_WAIT_V(n) asm volatile("s_waitcnt vmcnt(" #n ")" ::: "memory")
#define PG8_WAIT_L(n) asm volatile("s_waitcnt lgkmcnt(" #n ")" ::: "memory")
#define PG8_BAR __builtin_amdgcn_s_barrier()
#define PG8_SCHED __builtin_amdgcn_sched_barrier(0)
    Unit cur, nxt; int ui = 0;
    if (!S.next(0, cur)) return;
    f32x4 acc[2][2][4][2];
#pragma unroll
    for (int a = 0; a < 2; ++a)
#pragma unroll
        for (int b = 0; b < 2; ++b)
#pragma unroll
            for (int m = 0; m < 4; ++m)
#pragma unroll
                for (int n = 0; n < 2; ++n) acc[a][b][m][n] = (f32x4){0.f, 0.f, 0.f, 0.f};
    bf16x8 At[4][2], B0[2][2], B1[2][2];
    const char* cA; const char* cB; int nt; S.ptrs(cur, cA, cB, nt);
    PG8_STAGE(PG8_SB(0, 0), cB, voffB); PG8_STAGE(PG8_SB(0, 1), cB + hstepB, voffB); PG8_STAGE(PG8_SA(0, 0), cA, voffA); PG8_STAGE(PG8_SA(0, 1), cA + hstepA, voffA);
    if (wr == 1) PG8_BAR;
    PG8_WAIT_V(2); PG8_BAR;
    PG8_STAGE(PG8_SB(1, 0), cB + kstep, voffB); PG8_STAGE(PG8_SA(1, 0), cA + kstep, voffA); PG8_STAGE(PG8_SB(1, 1), cB + hstepB + kstep, voffB);
    PG8_WAIT_V(6); PG8_BAR;
    for (;;) {
        const bool has_next = S.next(ui + 1, nxt);
        const char* nA = cA; const char* nB = cB; int nnt = nt; if (has_next) S.ptrs(nxt, nA, nB, nnt);
        for (int t = 0; t < nt; t += 2) {
            const bool last = (t == nt - 2);
            const char* a1 = cA + (size_t)(t + 1) * kstep;
            const char* a2 = last ? nA : cA + (size_t)(t + 2) * kstep; const char* b2 = last ? nB : cB + (size_t)(t + 2) * kstep;
            const char* a3 = a2 + kstep; const char* b3 = b2 + kstep;
            PG8_LDB(B0, 0, 0); PG8_LDB(B1, 0, 1); PG8_SCHED; PG8_LDA(At, 0, 0); PG8_STAGE(PG8_SA(1, 1), a1 + hstepA, voffA);
            PG8_WAIT_V(8); PG8_WAIT_L(0); PG8_BAR; PG8_MMA(0, 0, At, B0); PG8_MMA(0, 1, At, B1); PG8_BAR; PG8_SCHED;
            PG8_LDA(At, 0, 1); PG8_STAGE(PG8_SB(0, 0), b2, voffB); PG8_STAGE(PG8_SB(0, 1), b2 + hstepB, voffB); PG8_STAGE(PG8_SA(0, 0), a2, voffA);
            PG8_WAIT_V(8); PG8_WAIT_L(0); PG8_BAR; PG8_MMA(1, 0, At, B0); PG8_MMA(1, 1, At, B1); PG8_BAR; PG8_SCHED;
            PG8_LDB(B0, 1, 0); PG8_LDB(B1, 1, 1); PG8_SCHED; PG8_LDA(At, 1, 0); PG8_STAGE(PG8_SA(0, 1), a2 + hstepA, voffA);
            PG8_WAIT_V(8); PG8_WAIT_L(0); PG8_BAR; PG8_MMA(0, 0, At, B0); PG8_MMA(0, 1, At, B1); PG8_BAR; PG8_SCHED;
            PG8_LDA(At, 1, 1); PG8_STAGE(PG8_SB(1, 0), b3, voffB); PG8_STAGE(PG8_SB(1, 1), b3 + hstepB, voffB); PG8_STAGE(PG8_SA(1, 0), a3, voffA);
            PG8_WAIT_V(8); PG8_WAIT_L(0); PG8_BAR; PG8_MMA(1, 0, At, B0); PG8_MMA(1, 1, At, B1); PG8_BAR; PG8_SCHED;
        }
        if (wr == 0) PG8_BAR;
        if constexpr (F8) asm volatile("s_nop 15\n\ts_nop 15" ::: "memory");
        E(acc, cur, wr, wc, fr, fq);
        if (!has_next) break;
#pragma unroll
        for (int a = 0; a < 2; ++a)
#pragma unroll
            for (int b = 0; b < 2; ++b)
#pragma unroll
                for (int m = 0; m < 4; ++m)
#pragma unroll
                    for (int n = 0; n < 2; ++n) acc[a][b][m][n] = (f32x4){0.f, 0.f, 0.f, 0.f};
        cur = nxt; cA = nA; cB = nB; nt = nnt; ++ui;
        if (wr == 1) PG8_BAR;
    }
    PG8_WAIT_V(0);
    PG8_BAR;
#undef PG8_SA
#undef PG8_SB
#undef PG8_STAGE
#undef PG8_LDA
#undef PG8_LDB
#undef PG8_MMA
#undef PG8_WAIT_V
#undef PG8_WAIT_L
#undef PG8_BAR
#undef PG8_SCHED
}
}
namespace att {
constexpr int NW = 8, QBLK = 32, KVBLK = 64;
#define SBAR() __builtin_amdgcn_sched_barrier(0)
__device__ __forceinline__ int crow(int r, int hi) { return (r & 3) + 8 * (r >> 2) + 4 * hi; }
__device__ __forceinline__ unsigned cvtpk(float lo, float hi) { unsigned r; asm volatile("v_cvt_pk_bf16_f32 %0, %1, %2" : "=v"(r) : "v"(lo), "v"(hi)); return r; }

struct Args {
    const bf16* Q; int ldq;
    const bf16* KV; int ld;
    int kc0, kc1, vc;
    bf16* O; int ldo;
    int o8;
    int n0, n1, row0, row1;
    float C, thr;
    int qrope, qpos0;
    float sinkl2; int has_sink;
    int wpos0;
    const float* T; int r0, kr0;
};

__device__ __forceinline__ void partialSM(f32x16& p0, f32x16& p1, float& m_reg, float& mn, float& alpha, const float C, const float thr) {
    float pmax = p0[0];
#pragma unroll
    for (int r = 1; r < 16; ++r) pmax = fmaxf(pmax, p0[r]);
#pragma unroll
    for (int r = 0; r < 16; ++r) pmax = fmaxf(pmax, p1[r]);
    { auto rr = __builtin_amdgcn_permlane32_swap(__float_as_uint(pmax), __float_as_uint(pmax), false, false);
      pmax = fmaxf(__uint_as_float(rr[0]), __uint_as_float(rr[1])); }
    if (__builtin_expect(__all(pmax - m_reg <= thr), 1)) { mn = m_reg; alpha = 1.f; }
    else { mn = fmaxf(m_reg, pmax); alpha = __builtin_amdgcn_exp2f((m_reg - mn) * C); m_reg = mn; }
    const float mnC = -mn * C;
#pragma unroll
    for (int r = 0; r < 16; ++r) p0[r] = fmaf(p0[r], C, mnC);
#pragma unroll
    for (int r = 0; r < 16; ++r) p1[r] = fmaf(p1[r], C, mnC);
#pragma unroll
    for (int r = 0; r < 16; ++r) p0[r] = __builtin_amdgcn_exp2f(p0[r]);
}
__device__ __forceinline__ void finishSM(f32x16& p0, f32x16& p1, float alpha, float& l_reg, bf16x8& pa0, bf16x8& pa1, bf16x8& pa2, bf16x8& pa3) {
#pragma unroll
    for (int r = 0; r < 16; ++r) p1[r] = __builtin_amdgcn_exp2f(p1[r]);
    float ps = 0;
#pragma unroll
    for (int r = 0; r < 16; ++r) ps += p0[r];
#pragma unroll
    for (int r = 0; r < 16; ++r) ps += p1[r];
    { auto rr = __builtin_amdgcn_permlane32_swap(__float_as_uint(ps), __float_as_uint(ps), false, false);
      ps = __uint_as_float(rr[0]) + __uint_as_float(rr[1]); }
    l_reg = l_reg * alpha + ps;
#define PK4(P, BASE, OUT) do { unsigned a0 = cvtpk(P[BASE + 0], P[BASE + 1]), a1 = cvtpk(P[BASE + 2], P[BASE + 3]);   \
    unsigned b0 = cvtpk(P[BASE + 4], P[BASE + 5]), b1 = cvtpk(P[BASE + 6], P[BASE + 7]);                              \
    auto r0 = __builtin_amdgcn_permlane32_swap(a0, b0, false, false); auto r1 = __builtin_amdgcn_permlane32_swap(a1, b1, false, false); \
    u32x4 w = {r0[0], r1[0], r0[1], r1[1]}; OUT = *reinterpret_cast<bf16x8*>(&w); } while (0)
    PK4(p0, 0, pa0); PK4(p0, 8, pa1); PK4(p1, 0, pa2); PK4(p1, 8, pa3);
#undef PK4
}
template <int DK> __device__ __forceinline__ int kswz(int row, int ch) { return row * (DK * 2) + ((ch ^ (row & 7)) << 4); }
template <int DK, int QREG> __device__ __forceinline__ void qkt(f32x16& p0, f32x16& p1, const LAS char* Ks, const bf16x8* qr, const LAS char* qx, int r32, int hi) {
    p0 = f32x16{}; p1 = f32x16{};
#pragma unroll
    for (int d0 = 0; d0 < DK / 16; ++d0) { const int ch = d0 * 2 + hi;
        const bf16x8 b0 = *(const LAS bf16x8*)(Ks + kswz<DK>(r32, ch));
        const bf16x8 b1 = *(const LAS bf16x8*)(Ks + kswz<DK>(32 + r32, ch));
        bf16x8 q; if constexpr (true) { if (d0 < QREG) q = qr[d0 < QREG ? d0 : 0]; else q = *(const LAS bf16x8*)(qx + (d0 - QREG) * 1024); }
        p0 = __builtin_amdgcn_mfma_f32_32x32x16_bf16(b0, q, p0, 0, 0, 0);
        p1 = __builtin_amdgcn_mfma_f32_32x32x16_bf16(b1, q, p1, 0, 0, 0); }
}
template <int NCB> __device__ __forceinline__ int v_st(int k, int c) { const int kk = (k & ~0xC) | ((k & 4) << 1) | ((k & 8) >> 1); return ((kk >> 3) * NCB + (c >> 5)) * 512 + ((kk & 7) * 32 + (c & 31)) * 2; }
__device__ __forceinline__ int v_rd_base(int lane) { return ((lane & 3) << 3) | (((lane >> 2) & 3) << 6) | (((lane >> 4) & 1) << 5) | (((lane >> 5) & 1) << 8); }
template <int OFF> __device__ __forceinline__ s16x4 tr_read(int vb) { s16x4 r; asm volatile("ds_read_b64_tr_b16 %0, %1 offset:%2" : "=&v"(r) : "v"(vb), "i"(OFF) : "memory"); return r; }
template <int D0, int NCB> __device__ __forceinline__ void pv_one(f32x16& od, int vb, bf16x8 pa0, bf16x8 pa1, bf16x8 pa2, bf16x8 pa3) {
#define VOFF(ks, half) (D0 * 512 + (ks) * (2 * NCB * 512) + (half) * (NCB * 512))
    const s16x4 l0 = tr_read<VOFF(0, 0)>(vb), h0 = tr_read<VOFF(0, 1)>(vb), l1 = tr_read<VOFF(1, 0)>(vb), h1 = tr_read<VOFF(1, 1)>(vb);
    const s16x4 l2 = tr_read<VOFF(2, 0)>(vb), h2 = tr_read<VOFF(2, 1)>(vb), l3 = tr_read<VOFF(3, 0)>(vb), h3 = tr_read<VOFF(3, 1)>(vb);
#undef VOFF
    asm volatile("s_waitcnt lgkmcnt(0)" ::: "memory"); SBAR();
#define PK(L, H) (bf16x8){L[0], L[1], L[2], L[3], H[0], H[1], H[2], H[3]}
    od = __builtin_amdgcn_mfma_f32_32x32x16_bf16(pa0, PK(l0, h0), od, 0, 0, 0);
    od = __builtin_amdgcn_mfma_f32_32x32x16_bf16(pa1, PK(l1, h1), od, 0, 0, 0);
    od = __builtin_amdgcn_mfma_f32_32x32x16_bf16(pa2, PK(l2, h2), od, 0, 0, 0);
    od = __builtin_amdgcn_mfma_f32_32x32x16_bf16(pa3, PK(l3, h3), od, 0, 0, 0);
#undef PK
}
template <int NCB> __device__ __forceinline__ void pv_all(f32x16* o, int vb, bf16x8 pa0, bf16x8 pa1, bf16x8 pa2, bf16x8 pa3) {
    pv_one<0, NCB>(o[0], vb, pa0, pa1, pa2, pa3); pv_one<1, NCB>(o[1], vb, pa0, pa1, pa2, pa3);
    if constexpr (NCB == 4) { pv_one<2, NCB>(o[2], vb, pa0, pa1, pa2, pa3); pv_one<3, NCB>(o[3], vb, pa0, pa1, pa2, pa3); }
}

template <int MODE> __device__ __forceinline__ void apply_mask(f32x16& p0, f32x16& p1, const Args& a, int j, int wid, int r32, int hi) {
    if constexpr (MODE == 1) {
        if (j < a.n0) return;
        const int kp0 = a.wpos0 + 64 * (j - a.n0), qw0 = a.qpos0 + wid * 32;
        if (kp0 + 63 - qw0 <= 128 && qw0 + 31 - kp0 <= 128) return;
        const int dd0 = kp0 - (qw0 + r32) + 4 * hi + 128;
#pragma unroll
        for (int r = 0; r < 16; ++r) { const int dd = dd0 + (r & 3) + 8 * (r >> 2);
            p0[r] = ((unsigned)dd <= 256u) ? p0[r] : -1e30f; p1[r] = ((unsigned)(dd + 32) <= 256u) ? p1[r] : -1e30f; }
    } else if constexpr (MODE == 2) {
        if (j < a.n0) return;
        const int kr = a.kr0 + (j - a.n0), qr = a.r0 + (wid >> 1);
        int rs = qr - 4; rs = rs < 0 ? 0 : (rs > 56 ? 56 : rs);
        if (kr < rs || kr >= rs + 8) {
#pragma unroll
            for (int r = 0; r < 16; ++r) { p0[r] = -1e30f; p1[r] = -1e30f; }
            return; }
        const int dr = kr - qr + 7, qc = (wid & 1) * 32 + r32;
        const float* tb = a.T + ((size_t)(dr * 64 + qc)) * 64 + 4 * hi;
#pragma unroll
        for (int g = 0; g < 4; ++g) { const f32x4 t0 = *(const f32x4*)(tb + 8 * g), t1 = *(const f32x4*)(tb + 32 + 8 * g);
#pragma unroll
            for (int i = 0; i < 4; ++i) { p0[4 * g + i] += t0[i]; p1[4 * g + i] += t1[i]; }
            asm volatile("" ::: "memory"); }
    }
}

template <int DK, int DV, int MODE, int SDEPTH>
__device__ __forceinline__ void attn_unit(const Args& a, LAS char* lds, const int tid) {
    constexpr int NKC = DK / 8, NVC = DV / 8, KPT = DK / 64, VPT = DV / 64, NCB = DV / 32, ND0 = DK / 16, QREG = (ND0 > 8 ? 4 : ND0);
    constexpr int SHM_K = 64 * DK * 2, SHM_V = 64 * DV * 2;
    const int wid = __builtin_amdgcn_readfirstlane(tid >> 6), lane = tid & 63, r32 = lane & 31, hi = lane >> 5;
    LAS char* V_lds = lds; LAS char* K_lds = lds + 2 * SHM_V;
    LAS float* ws = (LAS float*)(lds + 2 * SHM_V + 2 * SHM_K) + wid * 64; LAS float* li_l = ws; LAS float* al_l = ws + 32;
    LAS char* qx = lds + 2 * SHM_V + 2 * SHM_K + NW * 256 + wid * ((ND0 - QREG) * 1024) + lane * 16;
    float m_reg = -1e30f, l_reg = 0; f32x16 o[NCB]; bf16x8 qr[ND0];
#pragma unroll
    for (int d = 0; d < NCB; ++d) o[d] = f32x16{};
    const bf16* Qw = a.Q + (long)(wid * QBLK + r32) * a.ldq + hi * 8;
#pragma unroll
    for (int d0 = 0; d0 < ND0; ++d0) qr[d0] = *(const bf16x8*)(Qw + d0 * 16);
    if constexpr (DK == 192) {
        if (a.qrope) {
            const int t = a.qpos0 + wid * QBLK + r32; const float prow = (float)(t >> 6), pcol = (float)(t & 63);
#pragma unroll
            for (int dd = 0; dd < 2; ++dd) {
                bf16x8 x1 = qr[8 + dd], x2 = qr[10 + dd]; const float pos = dd ? pcol : prow;
#pragma unroll
                for (int e = 0; e < 8; ++e) { const float inv = __builtin_amdgcn_exp2f(-(float)(hi * 8 + e) * (13.287712379549449f / 16.0f)); const float ang = pos * inv;
                    const float c = __cosf(ang), s = __sinf(ang); const float f1 = bf2f((unsigned short)x1[e]), f2 = bf2f((unsigned short)x2[e]);
                    x1[e] = (short)f2bf(f1 * c - f2 * s); x2[e] = (short)f2bf(f1 * s + f2 * c); }
                qr[8 + dd] = x1; qr[10 + dd] = x2; }
        }
#pragma unroll
        for (int d0 = QREG; d0 < ND0; ++d0) *(LAS bf16x8*)(qx + (d0 - QREG) * 1024) = qr[d0];
        asm volatile("s_waitcnt lgkmcnt(0)" ::: "memory");
    }
    int koff[KPT], klds[KPT], voff[VPT], vlds[VPT];
#pragma unroll
    for (int i = 0; i < KPT; ++i) { const int q = tid + 512 * i, row = q / NKC, ch = q % NKC; koff[i] = row * a.ld + (ch < 16 ? a.kc0 + 8 * ch : a.kc1 + 8 * (ch - 16)); klds[i] = kswz<DK>(row, ch); }
#pragma unroll
    for (int i = 0; i < VPT; ++i) { const int q = tid + 512 * i, row = q / NVC, ch = q % NVC; voff[i] = row * a.ld + a.vc + 8 * ch; vlds[i] = v_st<NCB>(row, 8 * ch); }
    const int vb0 = (int)(uintptr_t)V_lds + v_rd_base(lane);
    bf16x8 sk[SDEPTH][KPT], sv[SDEPTH][VPT];
    const int NT = a.n0 + a.n1;
#define TROW(j) ((j) < a.n0 ? a.row0 + 64 * (j) : a.row1 + 64 * ((j) - a.n0))
#define SLOAD(i, j) do { const bf16* _b = a.KV + (long)TROW(j) * a.ld; \
    _Pragma("unroll") for (int _k = 0; _k < VPT; ++_k) sv[i][_k] = *(const bf16x8*)(_b + voff[_k]); \
    _Pragma("unroll") for (int _k = 0; _k < KPT; ++_k) sk[i][_k] = *(const bf16x8*)(_b + koff[_k]); } while (0)
#define SWRITE(b, i) do { \
    _Pragma("unroll") for (int _k = 0; _k < VPT; ++_k) *(LAS bf16x8*)(V_lds + (b) * SHM_V + vlds[_k]) = sv[i][_k]; \
    _Pragma("unroll") for (int _k = 0; _k < KPT; ++_k) *(LAS bf16x8*)(K_lds + (b) * SHM_K + klds[_k]) = sk[i][_k]; } while (0)
#define SWAIT() do { if constexpr (SDEPTH == 2) asm volatile("s_waitcnt vmcnt(%0)" :: "n"(KPT + VPT) : "memory"); else asm volatile("s_waitcnt vmcnt(0)" ::: "memory"); } while (0)
#define RESC(al) do { if (__any((al) < 1.f)) { if (hi == 0) al_l[r32] = (al); asm volatile("s_waitcnt lgkmcnt(0)" ::: "memory"); \
    _Pragma("unroll") for (int d = 0; d < NCB; ++d) _Pragma("unroll") for (int r = 0; r < 16; ++r) o[d][r] *= al_l[crow(r, hi)]; } } while (0)
    f32x16 pA0, pA1, pB0, pB1; float mnA, mnB, alA, alB; bf16x8 pa0, pa1, pa2, pa3;
    constexpr int SE = 0, SO = SDEPTH - 1;
    SLOAD(SE, 0); asm volatile("s_waitcnt vmcnt(0)" ::: "memory"); SWRITE(0, SE); __syncthreads();
    qkt<DK, QREG>(pA0, pA1, K_lds, qr, qx, r32, hi); apply_mask<MODE>(pA0, pA1, a, 0, wid, r32, hi); partialSM(pA0, pA1, m_reg, mnA, alA, a.C, a.thr);
    SLOAD(SO, 1); if constexpr (SDEPTH == 2) { if (2 < NT) SLOAD(SE, 2); }
    SWAIT(); SWRITE(1, SO); __syncthreads();
    for (int j = 1; j + 1 < NT; j += 2) {
        SBAR(); qkt<DK, QREG>(pB0, pB1, K_lds + SHM_K, qr, qx, r32, hi);
        finishSM(pA0, pA1, alA, l_reg, pa0, pa1, pa2, pa3); SBAR();
        SLOAD(SO, j + SDEPTH); SBAR();
        pv_all<NCB>(o, vb0, pa0, pa1, pa2, pa3); if constexpr (MODE != 0) SBAR(); apply_mask<MODE>(pB0, pB1, a, j, wid, r32, hi); if constexpr (MODE != 0) SBAR(); partialSM(pB0, pB1, m_reg, mnB, alB, a.C, a.thr);
        __syncthreads(); SWAIT(); SWRITE(0, SE);
        RESC(alB); __syncthreads();
        SBAR(); qkt<DK, QREG>(pA0, pA1, K_lds, qr, qx, r32, hi);
        finishSM(pB0, pB1, alB, l_reg, pa0, pa1, pa2, pa3); SBAR();
        if (SDEPTH == 1 || j + 3 < NT) SLOAD(SE, j + 1 + SDEPTH); SBAR();
        pv_all<NCB>(o, vb0 + SHM_V, pa0, pa1, pa2, pa3); if constexpr (MODE != 0) SBAR(); apply_mask<MODE>(pA0, pA1, a, j + 1, wid, r32, hi); if constexpr (MODE != 0) SBAR(); partialSM(pA0, pA1, m_reg, mnA, alA, a.C, a.thr);
        __syncthreads(); SWAIT(); SWRITE(1, SO);
        RESC(alA); __syncthreads();
    }
    SBAR(); qkt<DK, QREG>(pB0, pB1, K_lds + SHM_K, qr, qx, r32, hi);
    finishSM(pA0, pA1, alA, l_reg, pa0, pa1, pa2, pa3); SBAR();
    pv_all<NCB>(o, vb0, pa0, pa1, pa2, pa3); if constexpr (MODE != 0) SBAR(); apply_mask<MODE>(pB0, pB1, a, NT - 1, wid, r32, hi); if constexpr (MODE != 0) SBAR(); partialSM(pB0, pB1, m_reg, mnB, alB, a.C, a.thr);
    __syncthreads(); RESC(alB);
    finishSM(pB0, pB1, alB, l_reg, pa0, pa1, pa2, pa3); SBAR();
    pv_all<NCB>(o, vb0 + SHM_V, pa0, pa1, pa2, pa3);
    if constexpr (MODE == 1) { if (a.has_sink) l_reg += __builtin_amdgcn_exp2f(a.sinkl2 - m_reg * a.C); }
    if (hi == 0) li_l[r32] = l_reg; asm volatile("s_waitcnt lgkmcnt(0)" ::: "memory");
    float rli[16];
#pragma unroll
    for (int r = 0; r < 16; ++r) rli[r] = __builtin_amdgcn_rcpf(li_l[crow(r, hi)]);
    bf16* Ow = a.O + (long)(wid * QBLK) * a.ldo;
#pragma unroll
    for (int r = 0; r < 16; ++r) { const int orow = crow(r, hi);
#pragma unroll
        for (int d0 = 0; d0 < NCB; ++d0) { const float ov = o[d0][r] * rli[r];
            if (a.o8) ((unsigned char*)a.O)[(long)(wid * QBLK + orow) * a.ldo + d0 * 32 + r32] = (unsigned char)(__builtin_amdgcn_cvt_pk_fp8_f32(ov, ov, 0, false) & 0xff);
            else Ow[(long)orow * a.ldo + d0 * 32 + r32] = f2bf(ov); } }
    __syncthreads();
#undef TROW
#undef SLOAD
#undef SWRITE
#undef SWAIT
#undef RESC
}
#undef SBAR
}
constexpr int DM = 2048, NBATCH = 4, SEQ = 4096, NCTX = 256, DEPTH = 2;
constexpr int ML = NBATCH * SEQ, MC = NBATCH * NCTX, MT = ML + MC;
constexpr int INW = 3904, UW = 4096, QW = 1856;
constexpr int MODW = 6 * DM;
constexpr float LN_EPS = 1e-5f, RMS_EPS = 1e-6f;
constexpr float ALPHA = 1.4142135623730951f;
constexpr float LOG2E = 1.4426950408889634f;
constexpr float A_SCALE = 0.07216878364870323f, B_SCALE = 0.125f, C_SCALE = 0.08838834764831845f, D_SCALE = 0.08838834764831845f;
constexpr int U_CQ = 0, U_CKV = 384, U_KR = 512, U_BQ = 576, U_BK = 1088, U_BV = 1216, U_CQQ = 1344, U_CK = 1856, U_CV = 2368, U_DQ = 2880, U_DK = 3392, U_DV = 3648;
constexpr int QA_Q = 0, QA_KV = 768, QA_KR = 1792;

#ifndef F8_OUT
#define F8_OUT 1
#endif
#ifndef F8_MERGE
#define F8_MERGE 1
#endif
constexpr size_t MiB = 1u << 20;
constexpr size_t WS_CTL = 0, CTL_ZERO_BYTES = 1 * MiB;
constexpr size_t WS_MOD = 1 * MiB;
constexpr size_t WS_CTAB = 2 * MiB;
constexpr size_t WS_SUBK = 4 * MiB;
constexpr size_t WS_WUP = 5 * MiB;
constexpr size_t WS_WIN = 9 * MiB;
constexpr size_t WS_WC = 41 * MiB;
constexpr size_t WS_WO = 121 * MiB;
constexpr size_t WS_WPQ = 137 * MiB;
constexpr size_t WS_PU = 153 * MiB;
constexpr size_t WS_PV = 281 * MiB;
constexpr size_t WS_BUFA = 409 * MiB;
constexpr size_t WS_BUFB = 477 * MiB;
constexpr size_t WS_UREG = 545 * MiB;
constexpr size_t WS_QKVA = 681 * MiB;
constexpr size_t WS_OQP = 743 * MiB;
constexpr size_t WS_XRES = 811 * MiB;
constexpr size_t WS_EIDX = 947 * MiB;
constexpr size_t WS_EG = 956 * MiB;
constexpr size_t WS_MODP = 965 * MiB;
constexpr size_t WS_SCU = 973 * MiB, WS_SCV = WS_SCU + 2 * 16384 * 4;
constexpr size_t WS_DBG = 973 * MiB + 512 * 1024;
constexpr size_t WS_H8 = 974 * MiB;
constexpr size_t WS_END = 1008 * MiB;
constexpr size_t STASH_WG = 131072, P_WG = 262144, WS_STASH = WS_UREG, WS_P = WS_UREG + 32 * MiB, WS_CP = WS_UREG + 96 * MiB;
constexpr int CW_TMO = 0, CW_BAR = 4096;

constexpr int NWAVES = 8;
constexpr int RING_OFF = 0, RING_BYTES = 155648;
constexpr int LDSCTL_OFF = RING_BYTES, MISC_OFF = LDSCTL_OFF + 320;
constexpr int LDS_BYTES = 157696;

#define RLX_AGENT __ATOMIC_RELAXED, __HIP_MEMORY_SCOPE_AGENT
#define LDS_WAIT() asm volatile("s_waitcnt lgkmcnt(0)" ::: "memory")
#define VM_WAIT() asm volatile("s_waitcnt vmcnt(0)" ::: "memory")

#define XB_TMO      128
#define XB_XCNT(j)  (256  + 64 * (j))
#define XB_XSUB(j)  (1280 + 64 * (j))
#define XB_XGEN(j)  (2304 + 64 * (j))
#define XB_TOP      3328
#define XB_TOPGEN   3392
#define XCD_BAR_WORDS 3456
#define XB_SPIN_CAP (1u << 22)
__device__ __forceinline__ unsigned xb_ld(unsigned* p)              { return __hip_atomic_load(p, __ATOMIC_RELAXED, __HIP_MEMORY_SCOPE_AGENT); }
__device__ __forceinline__ unsigned xb_add(unsigned* p, unsigned v) { return __hip_atomic_fetch_add(p, v, __ATOMIC_RELAXED, __HIP_MEMORY_SCOPE_AGENT); }
__device__ __forceinline__ unsigned xb_xcc_id() { return (unsigned)__builtin_amdgcn_s_getreg((3 << 11) | 20) & 0xFu; }
#define XB_SPIN(cond, bar) do { unsigned _sp = 0; while (cond) { __builtin_amdgcn_s_sleep(1); \
    if ((++_sp & 255u) == 0u) { if (xb_ld(&(bar)[XB_TMO])) break; if (_sp > XB_SPIN_CAP) { atomicAdd(&(bar)[XB_TMO], 1u); break; } } } } while (0)
struct XcdBarrier { unsigned* bar; unsigned x; volatile LAS unsigned* st; };
__device__ __forceinline__ XcdBarrier xcd_barrier_post(unsigned* bar, volatile LAS unsigned* st) {
    XcdBarrier b; b.bar = bar; b.x = xb_xcc_id(); b.st = st;
    if (threadIdx.x == 0) (void)xb_add(&bar[XB_XCNT(b.x)], 1u);
    return b;
}
__device__ __forceinline__ void xcd_barrier_complete(unsigned* bar, unsigned x, unsigned& nloc, unsigned& nx) {
    const unsigned G = gridDim.x * gridDim.y * gridDim.z;
    unsigned sum, cnt, mine, sp = 0u;
    for (;;) {
        sum = 0u; cnt = 0u; mine = 0u;
#pragma unroll
        for (unsigned j = 0; j < 16; ++j) { const unsigned c = xb_ld(&bar[XB_XCNT(j)]); sum += c; cnt += (c > 0u) ? 1u : 0u; mine = (j == x) ? c : mine; }
        if (sum == G) break;
        __builtin_amdgcn_s_sleep(1);
        if ((++sp & 255u) == 0u) { if (xb_ld(&bar[XB_TMO])) break; if (sp > XB_SPIN_CAP) { atomicAdd(&bar[XB_TMO], 1u); break; } }
    }
    nloc = mine > 0u ? mine : 1u; nx = cnt > 0u ? cnt : 1u;
}
__device__ __forceinline__ void xcd_barrier(const XcdBarrier& b) {
    asm volatile("s_waitcnt vmcnt(0)" ::: "memory");
    __syncthreads();
    if (threadIdx.x == 0) {
        unsigned* bar = b.bar;
        __builtin_amdgcn_s_waitcnt(0);
        unsigned nloc = b.st[0], nx = b.st[1];
        if (nloc == 0u) { xcd_barrier_complete(bar, b.x, nloc, nx); b.st[0] = nloc; b.st[1] = nx; }
        const unsigned old = xb_add(&bar[XB_XSUB(b.x)], 1u);
        const unsigned gen = old / nloc;
        if (old + 1u == (gen + 1u) * nloc) {
            __builtin_amdgcn_fence(__ATOMIC_RELEASE, "agent");
            asm volatile("s_waitcnt vmcnt(0)" ::: "memory");
            const unsigned og = xb_add(&bar[XB_TOP], 1u);
            const unsigned tg = og / nx;
            if (og + 1u == (tg + 1u) * nx) xb_add(&bar[XB_TOPGEN], 1u);
            else XB_SPIN(xb_ld(&bar[XB_TOPGEN]) == tg, bar);
            __builtin_amdgcn_fence(__ATOMIC_ACQUIRE, "agent");
            xb_add(&bar[XB_XGEN(b.x)], 1u);
            asm volatile("s_waitcnt vmcnt(0)" ::: "memory");
        } else {
            XB_SPIN(xb_ld(&bar[XB_XGEN(b.x)]) == gen, bar);
            __builtin_amdgcn_fence(__ATOMIC_ACQUIRE, "agent");
            asm volatile("s_waitcnt vmcnt(0)" ::: "memory");
        }
    }
    __syncthreads();
}

struct In {
    const float *x, *c, *ctx, *c_ctx, *w_ada, *b_ada, *w_in, *a_q_norm, *a_kv_norm, *a_w_uq, *a_w_ukv, *b_sink, *c_rpb, *d_q_norm, *d_k_norm,
                *w_branch, *w_gate, *b_gate, *w_out, *ln1_g, *ln1_b, *ln2_g, *ln2_b, *peer_w_q, *peer_sub_keys, *peer_u, *peer_v;
};
struct Args { In in; float* out; unsigned char* ws; int ph_lo, ph_hi, li, pad; };
struct Frame { LAS unsigned char* lds; int tid, lane, wave, vcu, G; GAS unsigned char* ws; };
template <class T> __device__ __forceinline__ T* G(T* p) { return (T*)(GAS T*)p; }
typedef const __attribute__((address_space(4))) Args& KA;
typedef const __attribute__((address_space(4))) Args* KAP;
__device__ __forceinline__ KAP kargs() { KAP p = (KAP)__builtin_amdgcn_kernarg_segment_ptr(); asm volatile("" : "+s"(p)); return p; }

__device__ __forceinline__ float wave_sum(float v) {
#pragma unroll
    for (int o = 1; o < 64; o <<= 1) v += __shfl_xor(v, o);
    return v;
}
__device__ __forceinline__ unsigned pk2(float lo, float hi) { return cvt_pk_bf16(lo, hi); }
__device__ __forceinline__ float silu_f(float v) { return v / (1.0f + __expf(-v)); }

__device__ __forceinline__ void p0_transpose_item(const float* W, int ldw, int nblk, bf16* dst, int dpitch, int row_off, int col_off, const float* gain, LAS float* scr, int item, int lane, int f8) {
    const int kb = item / nblk, nb = item % nblk, k0 = 64 * kb, n0 = 32 * nb;
#pragma unroll 8
    for (int i = 0; i < 32; ++i) { const int kk = 2 * i + (lane >> 5); float v = W[(size_t)(k0 + kk) * ldw + n0 + (lane & 31)]; if (gain) v *= gain[k0 + kk]; scr[kk * 33 + (lane & 31)] = v; }
    LDS_WAIT(); asm volatile("" ::: "memory");
    const int c = lane & 7;
#pragma unroll
    for (int j = 0; j < 4; ++j) { const int n = (lane >> 3) + 8 * j; const LAS float* s = scr + (8 * c) * 33 + n;
        if (f8) {
            int w0 = __builtin_amdgcn_cvt_pk_fp8_f32(s[0 * 33] * 64.f, s[1 * 33] * 64.f, 0, false); w0 = __builtin_amdgcn_cvt_pk_fp8_f32(s[2 * 33] * 64.f, s[3 * 33] * 64.f, w0, true);
            int w1 = __builtin_amdgcn_cvt_pk_fp8_f32(s[4 * 33] * 64.f, s[5 * 33] * 64.f, 0, false); w1 = __builtin_amdgcn_cvt_pk_fp8_f32(s[6 * 33] * 64.f, s[7 * 33] * 64.f, w1, true);
            *(GAS u32x2*)((GAS unsigned char*)dst + (size_t)(row_off + n0 + n) * dpitch + col_off + k0 + 8 * c) = (u32x2){(unsigned)w0, (unsigned)w1}; }
        else { u32x4 o; o.x = pk2(s[0 * 33], s[1 * 33]); o.y = pk2(s[2 * 33], s[3 * 33]); o.z = pk2(s[4 * 33], s[5 * 33]); o.w = pk2(s[6 * 33], s[7 * 33]);
        *(GAS u32x4*)(dst + (size_t)(row_off + n0 + n) * dpitch + col_off + k0 + 8 * c) = o; } }
    LDS_WAIT(); asm volatile("" ::: "memory");
}
struct TJob { const float* W; int K, N; bf16* dst; int dpitch, row_off, col_off; const float* gain; int f8; };
__device__ __forceinline__ int tjob_get(KA A, int job, TJob& t) {
    const int l = job / 13, j = job % 13; GAS unsigned char* ws = (GAS unsigned char*)A.ws; t.gain = nullptr; t.row_off = 0; t.col_off = 0; t.f8 = 0;
    if (j == 0) { t.W = G(A.in.w_in) + (size_t)l * DM * INW; t.K = DM; t.N = INW; t.dst = (bf16*)(ws + WS_WIN) + (size_t)l * UW * DM; t.dpitch = DM; }
    else if (j <= 4) { const int z = j - 1; t.W = G(A.in.w_gate) + ((size_t)l * 4 + z) * DM * DM; t.K = DM; t.N = DM; t.dst = F8_MERGE ? (bf16*)((unsigned char*)(ws + WS_WC) + ((size_t)l * 4 + z) * DM * 2560) : (bf16*)(ws + WS_WC) + ((size_t)l * 4 + z) * DM * 2560; t.dpitch = 2560; t.f8 = F8_MERGE; }
    else if (j <= 8) { const int z = j - 5; t.W = G(A.in.w_branch) + ((size_t)l * 4 + z) * 512 * DM; t.K = 512; t.N = DM; t.dst = F8_MERGE ? (bf16*)((unsigned char*)(ws + WS_WC) + ((size_t)l * 4 + z) * DM * 2560) : (bf16*)(ws + WS_WC) + ((size_t)l * 4 + z) * DM * 2560; t.dpitch = 2560; t.col_off = 2048; t.f8 = F8_MERGE; }
    else if (j == 9) { t.W = G(A.in.w_out) + (size_t)l * DM * DM; t.K = DM; t.N = DM; t.dst = (bf16*)((unsigned char*)(ws + WS_WO) + (size_t)l * DM * DM); t.dpitch = DM; t.f8 = F8_OUT; }
    else if (j == 10) { t.W = G(A.in.peer_w_q) + (size_t)l * DM * DM; t.K = DM; t.N = DM; t.dst = (bf16*)(ws + WS_WPQ) + (size_t)l * DM * DM; t.dpitch = DM; }
    else if (j == 11) { t.W = G(A.in.a_w_uq) + (size_t)l * 384 * 768; t.K = 384; t.N = 768; t.dst = (bf16*)(ws + WS_WUP) + (size_t)l * 1792 * 512; t.dpitch = 512; t.gain = G(A.in.a_q_norm) + l * 384; }
    else { t.W = G(A.in.a_w_ukv) + (size_t)l * 128 * 1024; t.K = 128; t.N = 1024; t.dst = (bf16*)(ws + WS_WUP) + (size_t)l * 1792 * 512; t.dpitch = 512; t.row_off = 768; t.col_off = 384; t.gain = G(A.in.a_kv_norm) + l * 128; }
    return (t.K / 64) * (t.N / 32);
}
__device__ __forceinline__ void p0_prologue(const Frame& F, KA A) {
    GAS unsigned char* ws = F.ws;
    const int gw = F.vcu * NWAVES + F.wave, NGW = F.G * NWAVES;
    const long gt = (long)gw * 64 + F.lane, NGT = (long)NGW * 64;
    {
        float* modp = (float*)(ws + WS_MODP);
        for (int it = gw; it < 2 * 16 * 48; it += NGW) {
            const int l = it / 768, ks = (it % 768) / 48, cg = it % 48, n = cg * 256 + F.lane * 4;
            const float* w = G(A.in.w_ada) + ((size_t)l * DM + ks * 128) * MODW + n;
            f32x4 acc[5];
#pragma unroll
            for (int r = 0; r < 5; ++r) acc[r] = (f32x4){0.f, 0.f, 0.f, 0.f};
#pragma unroll 8
            for (int k = 0; k < 128; ++k) {
                const f32x4 wv = *(const f32x4*)(w + (size_t)k * MODW);
                const int kk = ks * 128 + k;
#pragma unroll
                for (int r = 0; r < 5; ++r) { const float cv = (r < 4) ? G(A.in.c)[r * DM + kk] : G(A.in.c_ctx)[kk]; acc[r] += wv * silu_f(cv); }
            }
#pragma unroll
            for (int r = 0; r < 5; ++r) *(f32x4*)(modp + (((size_t)ks * 2 + l) * 5 + r) * MODW + n) = acc[r];
        }
    }
    {
        LAS float* scr = (LAS float*)(F.lds + RING_OFF + F.wave * 16384);
        int base = 0;
        for (int job = 0; job < 26; ++job) {
            TJob t; const int ni = tjob_get(A, job, t);
            int first = gw - (base % NGW); if (first < 0) first += NGW;
            for (int i = first; i < ni; i += NGW) p0_transpose_item(t.W, t.N, t.N / 32, t.dst, t.dpitch, t.row_off, t.col_off, t.gain, scr, i, F.lane, t.f8);
            base += ni;
        }
    }
    for (long i = gt; i < 2L * 192 * 2048 / 8; i += NGT) { const int l = (int)(i / (192 * 256)), r = (int)(i % (192 * 256)); *(u32x4*)((bf16*)(ws + WS_WIN) + ((size_t)l * UW + 3904) * DM + (size_t)r * 8) = (u32x4){0u, 0u, 0u, 0u}; }
    for (long i = gt; i < 2L * 768 * 16; i += NGT) { const int l = (int)(i / (768 * 16)), r = (int)(i % (768 * 16)), row = r / 16, c8 = r % 16; *(u32x4*)((bf16*)(ws + WS_WUP) + ((size_t)l * 1792 + row) * 512 + 384 + c8 * 8) = (u32x4){0u, 0u, 0u, 0u}; }
    for (long i = gt; i < 2L * 1024 * 48; i += NGT) { const int l = (int)(i / (1024 * 48)), r = (int)(i % (1024 * 48)), row = r / 48, c8 = r % 48; *(u32x4*)((bf16*)(ws + WS_WUP) + ((size_t)l * 1792 + 768 + row) * 512 + c8 * 8) = (u32x4){0u, 0u, 0u, 0u}; }
    {
        const long n_sk = 2L * 8 * 2 * 128 * 128 / 8;
        for (long i = gt; i < n_sk; i += NGT) {
            const float* src = G(A.in.peer_sub_keys); bf16* dst = (bf16*)(ws + WS_SUBK);
            const f32x4 a = *(const f32x4*)(src + i * 8), b = *(const f32x4*)(src + i * 8 + 4);
            u32x4 o; o.x = pk2(a[0], a[1]); o.y = pk2(a[2], a[3]); o.z = pk2(b[0], b[1]); o.w = pk2(b[2], b[3]);
            *(u32x4*)(dst + i * 8) = o;
        }
        for (int r = gw; r < 4 * 16384; r += NGW) {
            const bool isu = r < 2 * 16384; const int row = isu ? r : r - 2 * 16384;
            const float* src = (isu ? G(A.in.peer_u) : G(A.in.peer_v)) + (size_t)row * 2048 + F.lane * 4;
            f32x4 v[8]; float am = 0.f;
#pragma unroll
            for (int q = 0; q < 8; ++q) { v[q] = __builtin_nontemporal_load((const f32x4*)(src + q * 256));
                am = fmaxf(am, fmaxf(fmaxf(__builtin_fabsf(v[q][0]), __builtin_fabsf(v[q][1])), fmaxf(__builtin_fabsf(v[q][2]), __builtin_fabsf(v[q][3])))); }
#pragma unroll
            for (int o = 1; o < 64; o <<= 1) am = fmaxf(am, __shfl_xor(am, o));
            const float S = am > 0.f ? 6.0f / am : 1.0f;
            unsigned short* dst = (unsigned short*)(ws + (isu ? WS_PU : WS_PV)) + (size_t)row * 512 + F.lane;
#pragma unroll
            for (int q = 0; q < 8; ++q) { const f32x4 a = v[q] * S;
                unsigned w = __builtin_amdgcn_cvt_scalef32_pk_fp4_f32(0u, a[0], a[1], 1.0f, 0); w = __builtin_amdgcn_cvt_scalef32_pk_fp4_f32(w, a[2], a[3], 1.0f, 1);
                dst[q * 64] = (unsigned short)(w & 0xffffu); }
            if (F.lane == 0) ((float*)(ws + (isu ? WS_SCU : WS_SCV)))[row] = am > 0.f ? am * (1.0f / 6.0f) : 1.0f;
        }
    }
    {
        float* ct = (float*)(ws + WS_CTAB);
        for (long i = gt; i < 2L * 4 * 15 * 64 * 64; i += NGT) {
            const int kc = (int)(i & 63), qc = (int)((i >> 6) & 63), r = (int)(i >> 12), dr = r % 15, lh = r / 15;
            int cs = qc - 8; cs = cs < 0 ? 0 : (cs > 48 ? 48 : cs);
            int co = kc - qc + 15; co = co < 0 ? 0 : (co > 30 ? 30 : co);
            ct[i] = (kc >= cs && kc < cs + 16) ? G(A.in.c_rpb)[((size_t)lh * 15 + dr) * 31 + co] * (1.0f / C_SCALE) : -1e30f;
        }
    }
}
__device__ __forceinline__ void p1_modreduce(const Frame& F, KA A) {
    const long gt = ((long)F.vcu * NWAVES + F.wave) * 64 + F.lane, NGT = (long)F.G * NWAVES * 64;
    const float* modp = (const float*)(F.ws + WS_MODP); float* mod = (float*)(F.ws + WS_MOD);
    for (long i = gt; i < 2L * 5 * MODW; i += NGT) { const int n = (int)(i % MODW), l = (int)(i / (5 * MODW));
        float s = G(A.in.b_ada)[l * MODW + n];
#pragma unroll
        for (int ks = 0; ks < 16; ++ks) s += modp[(size_t)ks * 2 * 5 * MODW + i];
        mod[i] = s; }
}
__device__ __forceinline__ void p2_modulate0(const Frame& F, KA A) {
    const int gw = F.vcu * NWAVES + F.wave, NGW = F.G * NWAVES;
    const float* mod = (const float*)(F.ws + WS_MOD); bf16* H = (bf16*)(F.ws + WS_BUFA);
    for (int row = gw; row < MT; row += NGW) {
        const float* xr = row < ML ? G(A.in.x) + (size_t)row * DM : G(A.in.ctx) + (size_t)(row - ML) * DM;
        const float* mr = mod + (size_t)(row < ML ? (row >> 12) : 4) * MODW;
#pragma unroll
        for (int j = 0; j < 4; ++j) { const int c = j * 512 + F.lane * 8;
            const f32x4 a = *(const f32x4*)(xr + c), b = *(const f32x4*)(xr + c + 4);
            const f32x4 sh0 = *(const f32x4*)(mr + c), sh1 = *(const f32x4*)(mr + c + 4), sc0 = *(const f32x4*)(mr + DM + c), sc1 = *(const f32x4*)(mr + DM + c + 4);
            const f32x4 y0 = a * (sc0 + 1.0f) + sh0, y1 = b * (sc1 + 1.0f) + sh1;
            u32x4 o; o.x = pk2(y0[0], y0[1]); o.y = pk2(y0[2], y0[3]); o.z = pk2(y1[0], y1[1]); o.w = pk2(y1[2], y1[3]);
            *(u32x4*)(H + (size_t)row * DM + c) = o;
            if (F8_MERGE) { int w0 = __builtin_amdgcn_cvt_pk_fp8_f32(y0[0], y0[1], 0, false); w0 = __builtin_amdgcn_cvt_pk_fp8_f32(y0[2], y0[3], w0, true);
                int w1 = __builtin_amdgcn_cvt_pk_fp8_f32(y1[0], y1[1], 0, false); w1 = __builtin_amdgcn_cvt_pk_fp8_f32(y1[2], y1[3], w1, true);
                *(u32x2*)((unsigned char*)(F.ws + WS_H8) + (size_t)row * DM + c) = (u32x2){(unsigned)w0, (unsigned)w1}; } }
    }
}
__device__ __forceinline__ void rope_pair(float& x1, float& x2, float ang) { const float c = __cosf(ang), s = __sinf(ang); const float y1 = x1 * c - x2 * s, y2 = x1 * s + x2 * c; x1 = y1; x2 = y2; }
__device__ __forceinline__ void enorm_phase(const Frame& F, KA A, int l) {
    const int gw = F.vcu * NWAVES + F.wave, NGW = F.G * NWAVES, lane = F.lane;
    bf16* U = (bf16*)(F.ws + WS_UREG); bf16* QK = (bf16*)(F.ws + WS_QKVA);
    const float* gq = G(A.in.d_q_norm) + l * 128; const float* gk = G(A.in.d_k_norm) + l * 128;
    const float L2T = 13.287712379549449f;
    for (int row = gw; row < MT; row += NGW) {
        bf16* u = U + (size_t)row * UW;
        const bool lat = row < ML; const int t = row & 4095;
        const float prow = lat ? (float)(t >> 6) : 0.f, pcol = lat ? (float)(t & 63) : 0.f;
        { unsigned w[3]; float ss = 0.f;
#pragma unroll
          for (int i = 0; i < 3; ++i) { w[i] = ((const unsigned*)(u + U_CQ))[lane + 64 * i]; const float a = bflo(w[i]), b = bfhi(w[i]); ss += a * a + b * b; }
          const float rstd = rsqrtf(wave_sum(ss) * (1.0f / 384.0f) + RMS_EPS);
#pragma unroll
          for (int i = 0; i < 3; ++i) ((unsigned*)(u + U_CQ))[lane + 64 * i] = pk2(bflo(w[i]) * rstd, bfhi(w[i]) * rstd); }
        { const unsigned w = ((const unsigned*)(u + U_CKV))[lane]; const float a = bflo(w), b = bfhi(w);
          const float rstd = rsqrtf(wave_sum(a * a + b * b) * (1.0f / 128.0f) + RMS_EPS);
          ((unsigned*)(u + U_CKV))[lane] = pk2(a * rstd, b * rstd); }
        const int j64 = lane & 31;
        const float ang64 = ((j64 < 16) ? prow : pcol) * __builtin_amdgcn_exp2f(-(float)(j64 & 15) * (L2T / 16.0f));
        if (lane < 32) { float x1 = bf2f(u[U_KR + lane]), x2 = bf2f(u[U_KR + 32 + lane]); rope_pair(x1, x2, ang64);
            bf16* o = QK + (size_t)row * QW + QA_KR; o[lane] = f2bf(x1); o[32 + lane] = f2bf(x2); }
#pragma unroll
        for (int i = 0; i < 4; ++i) { const int p = lane + 64 * i, hd = p >> 5; bf16* q = u + U_BQ + hd * 64;
            float x1 = bf2f(q[j64]), x2 = bf2f(q[32 + j64]); rope_pair(x1, x2, ang64); q[j64] = f2bf(x1); q[32 + j64] = f2bf(x2); }
        { const int hd = lane >> 5; bf16* q = u + U_BK + hd * 64;
          float x1 = bf2f(q[j64]), x2 = bf2f(q[32 + j64]); rope_pair(x1, x2, ang64); q[j64] = f2bf(x1); q[32 + j64] = f2bf(x2); }
        const float ang128 = ((lane < 32) ? prow : pcol) * __builtin_amdgcn_exp2f(-(float)(lane & 31) * (L2T / 32.0f));
        const float gq1 = gq[lane], gq2 = gq[64 + lane], gk1 = gk[lane], gk2 = gk[64 + lane];
#pragma unroll
        for (int hd = 0; hd < 4; ++hd) { bf16* q = u + U_DQ + hd * 128; float x1 = bf2f(q[lane]), x2 = bf2f(q[64 + lane]);
            const float rstd = rsqrtf(wave_sum(x1 * x1 + x2 * x2) * (1.0f / 128.0f) + RMS_EPS);
            x1 = x1 * rstd * gq1; x2 = x2 * rstd * gq2; rope_pair(x1, x2, ang128); q[lane] = f2bf(x1); q[64 + lane] = f2bf(x2); }
#pragma unroll
        for (int hd = 0; hd < 2; ++hd) { bf16* q = u + U_DK + hd * 128; float x1 = bf2f(q[lane]), x2 = bf2f(q[64 + lane]);
            const float rstd = rsqrtf(wave_sum(x1 * x1 + x2 * x2) * (1.0f / 128.0f) + RMS_EPS);
            x1 = x1 * rstd * gk1; x2 = x2 * rstd * gk2; rope_pair(x1, x2, ang128); q[lane] = f2bf(x1); q[64 + lane] = f2bf(x2); }
    }
}
__device__ __forceinline__ void ln1_phase(const Frame& F, KA A, int l, int nrows, bf16* HF) {
    const int gw = F.vcu * NWAVES + F.wave, NGW = F.G * NWAVES, lane = F.lane;
    float* Y = (float*)(F.ws + WS_UREG); const float* mod = (const float*)(F.ws + WS_MOD) + (size_t)l * 5 * MODW;
    const float* g = G(A.in.ln1_g) + l * DM; const float* b = G(A.in.ln1_b) + l * DM;
    for (int row = gw; row < nrows; row += NGW) {
        float* y = Y + (size_t)row * DM; const float* mr = mod + (size_t)(row < ML ? (row >> 12) : 4) * MODW;
        f32x4 v[8]; float s = 0.f;
#pragma unroll
        for (int j = 0; j < 4; ++j) { const int c = j * 512 + lane * 8; v[2 * j] = *(const f32x4*)(y + c); v[2 * j + 1] = *(const f32x4*)(y + c + 4); }
#pragma unroll
        for (int j = 0; j < 8; ++j) s += (v[j][0] + v[j][1]) + (v[j][2] + v[j][3]);
        const float mean = wave_sum(s) * (1.0f / DM); float q = 0.f;
#pragma unroll
        for (int j = 0; j < 8; ++j) { v[j] = v[j] - mean; q += (v[j][0] * v[j][0] + v[j][1] * v[j][1]) + (v[j][2] * v[j][2] + v[j][3] * v[j][3]); }
        const float rstd = rsqrtf(wave_sum(q) * (1.0f / DM) + LN_EPS);
#pragma unroll
        for (int j = 0; j < 4; ++j) { const int c = j * 512 + lane * 8;
            const f32x4 x0 = v[2 * j] * rstd * *(const f32x4*)(g + c) + *(const f32x4*)(b + c), x1 = v[2 * j + 1] * rstd * *(const f32x4*)(g + c + 4) + *(const f32x4*)(b + c + 4);
            *(f32x4*)(y + c) = x0; *(f32x4*)(y + c + 4) = x1;
            const f32x4 h0 = x0 * (*(const f32x4*)(mr + 4 * DM + c) + 1.0f) + *(const f32x4*)(mr + 3 * DM + c), h1 = x1 * (*(const f32x4*)(mr + 4 * DM + c + 4) + 1.0f) + *(const f32x4*)(mr + 3 * DM + c + 4);
            u32x4 o; o.x = pk2(h0[0], h0[1]); o.y = pk2(h0[2], h0[3]); o.z = pk2(h1[0], h1[1]); o.w = pk2(h1[2], h1[3]);
            *(u32x4*)(HF + (size_t)row * DM + c) = o; }
    }
}
namespace peer {
__device__ __forceinline__ unsigned okey(float f) { const unsigned u = __float_as_uint(f); return (u & 0x80000000u) ? ~u : (u | 0x80000000u); }
__device__ __forceinline__ float ikey(unsigned k) { const unsigned u = (k & 0x80000000u) ? (k & 0x7fffffffu) : ~k; return __uint_as_float(u); }
#define CE_DESC(a, b) do { const unsigned _mx = (a) > (b) ? (a) : (b), _mn = (a) > (b) ? (b) : (a); (a) = _mx; (b) = _mn; } while (0)
#define CE_ASC(a, b)  do { const unsigned _mx = (a) > (b) ? (a) : (b), _mn = (a) > (b) ? (b) : (a); (a) = _mn; (b) = _mx; } while (0)
__device__ __forceinline__ void sort16_desc(unsigned (&k)[16]) {
#pragma unroll
    for (int size = 2; size <= 16; size <<= 1)
#pragma unroll
        for (int stride = size >> 1; stride > 0; stride >>= 1)
#pragma unroll
            for (int i = 0; i < 16; ++i) { const int p = i ^ stride; if (p > i) { if ((i & size) == 0) CE_DESC(k[i], k[p]); else CE_ASC(k[i], k[p]); } }
}
__device__ __forceinline__ void merge16_desc(unsigned (&a)[16], const unsigned (&b)[16]) {
#pragma unroll
    for (int i = 0; i < 16; ++i) a[i] = a[i] > b[15 - i] ? a[i] : b[15 - i];
#pragma unroll
    for (int stride = 8; stride > 0; stride >>= 1)
#pragma unroll
        for (int i = 0; i < 16; ++i) { const int p = i ^ stride; if (p > i) CE_DESC(a[i], a[p]); }
}
constexpr int slot_x(int s) { int n = 0; for (int x = 0; x < 16; ++x) for (int y = 0; y < 16; ++y) if ((x + 1) * (y + 1) <= 16) { if (n == s) return x; ++n; } return -1; }
constexpr int slot_y(int s) { int n = 0; for (int x = 0; x < 16; ++x) for (int y = 0; y < 16; ++y) if ((x + 1) * (y + 1) <= 16) { if (n == s) return y; ++n; } return -1; }
template <int S> struct Slot { static constexpr int x = slot_x(S), y = slot_y(S); };
template <int S> __device__ __forceinline__ void cand_one(unsigned (&c)[64], const float (&v0)[16], const float (&v1)[16], const unsigned (&i0)[16], const unsigned (&i1)[16], LAS unsigned short* tbl) {
    if constexpr (Slot<S>::x >= 0) { c[S] = (okey(v0[Slot<S>::x] + v1[Slot<S>::y]) & ~63u) | (unsigned)(63 - S); tbl[S] = (unsigned short)(i0[Slot<S>::x] * 128u + i1[Slot<S>::y]); }
    else c[S] = 0u;
}
template <int... S> __device__ __forceinline__ void cand_all(unsigned (&c)[64], const float (&v0)[16], const float (&v1)[16], const unsigned (&i0)[16], const unsigned (&i1)[16], LAS unsigned short* tbl, std::integer_sequence<int, S...>) {
    (cand_one<S>(c, v0, v1, i0, i1, tbl), ...);
}
__device__ __forceinline__ void topk_item(const bf16* QP, const bf16* SK, int* EIDX, float* EG, int tok0, int h, LAS unsigned short* tblw, int lane) {
    const int r32 = lane & 31, hi = lane >> 5;
    const bf16* qrow = QP + (size_t)(tok0 + r32) * DM + h * 256 + hi * 8;
    unsigned L[2][16];
#pragma unroll
    for (int p = 0; p < 2; ++p) {
        f32x16 acc[4];
#pragma unroll
        for (int kb = 0; kb < 4; ++kb) acc[kb] = f32x16{};
        const bf16* skp = SK + ((size_t)(h * 2 + p) * 128 + r32) * 128 + hi * 8;
#pragma unroll 2
        for (int d0 = 0; d0 < 8; ++d0) { const bf16x8 bq = *(const bf16x8*)(qrow + p * 128 + d0 * 16);
#pragma unroll
            for (int kb = 0; kb < 4; ++kb) { const bf16x8 ak = *(const bf16x8*)(skp + (size_t)kb * 32 * 128 + d0 * 16); acc[kb] = __builtin_amdgcn_mfma_f32_32x32x16_bf16(ak, bq, acc[kb], 0, 0, 0); } }
        unsigned g[4][16];
#pragma unroll
        for (int kb = 0; kb < 4; ++kb) {
#pragma unroll
            for (int r = 0; r < 16; ++r) g[kb][r] = (okey(acc[kb][r]) & ~127u) | (unsigned)(127 - (32 * kb + (r & 3) + 8 * (r >> 2) + 4 * hi));
            sort16_desc(g[kb]); }
        merge16_desc(g[0], g[1]); merge16_desc(g[2], g[3]); merge16_desc(g[0], g[2]);
        unsigned o[16];
#pragma unroll
        for (int i = 0; i < 16; ++i) o[i] = (unsigned)__shfl_xor((int)g[0][i], 32);
        merge16_desc(g[0], o);
#pragma unroll
        for (int i = 0; i < 16; ++i) L[p][i] = g[0][i];
    }
    float v0[16], v1[16]; unsigned i0[16], i1[16];
#pragma unroll
    for (int i = 0; i < 16; ++i) { v0[i] = ikey(L[0][i] & ~127u); v1[i] = ikey(L[1][i] & ~127u); i0[i] = 127u - (L[0][i] & 127u); i1[i] = 127u - (L[1][i] & 127u); }
    LAS unsigned short* tbl = tblw + lane * 66;
    unsigned c[64];
    cand_all(c, v0, v1, i0, i1, tbl, std::make_integer_sequence<int, 64>{});
    unsigned c0[16], c1[16], c2[16], c3[16];
#pragma unroll
    for (int i = 0; i < 16; ++i) { c0[i] = c[i]; c1[i] = c[16 + i]; c2[i] = c[32 + i]; c3[i] = c[48 + i]; }
    sort16_desc(c0); sort16_desc(c1); sort16_desc(c2); sort16_desc(c3);
    merge16_desc(c0, c1); merge16_desc(c2, c3); merge16_desc(c0, c2);
    LDS_WAIT(); asm volatile("" ::: "memory");
    float best[16]; int eid[16]; float sum = 0.f;
    const float mx = ikey(c0[0] & ~63u);
#pragma unroll
    for (int i = 0; i < 16; ++i) { const unsigned s = 63u - (c0[i] & 63u); eid[i] = (int)tbl[s]; best[i] = __expf(ikey(c0[i] & ~63u) - mx); sum += best[i]; }
    const float inv = 1.0f / sum;
    if (hi == 0) {
        int* ep = EIDX + (size_t)(tok0 + r32) * 128 + h * 16; float* gp = EG + (size_t)(tok0 + r32) * 128 + h * 16;
#pragma unroll
        for (int i = 0; i < 16; ++i) { ep[i] = eid[i]; gp[i] = best[i] * inv; }
    }
    LDS_WAIT(); asm volatile("" ::: "memory");
}
}
namespace p4 {
constexpr int L_SE = 0, L_SG = 4 * 128 * 2, L_WAVE = L_SG + 4 * 128 * 4;
__device__ __forceinline__ float rowsum16(float d) {
    d += __int_as_float(__builtin_amdgcn_update_dpp(__float_as_int(d), __float_as_int(d), 0x128, 0xF, 0xF, false));
    d += __int_as_float(__builtin_amdgcn_update_dpp(__float_as_int(d), __float_as_int(d), 0x124, 0xF, 0xF, false));
    d += __int_as_float(__builtin_amdgcn_update_dpp(__float_as_int(d), __float_as_int(d), 0x122, 0xF, 0xF, false));
    d += __int_as_float(__builtin_amdgcn_update_dpp(__float_as_int(d), __float_as_int(d), 0x121, 0xF, 0xF, false));
    return d;
}
__device__ __forceinline__ f32x2 cvt4(unsigned w, int t) {
    return t == 0 ? __builtin_amdgcn_cvt_scalef32_pk_f32_fp4(w, 1.0f, 0) : (t == 1 ? __builtin_amdgcn_cvt_scalef32_pk_f32_fp4(w, 1.0f, 1) : (t == 2 ? __builtin_amdgcn_cvt_scalef32_pk_f32_fp4(w, 1.0f, 2) : __builtin_amdgcn_cvt_scalef32_pk_f32_fp4(w, 1.0f, 3)));
}
struct Row { u32x4 p[4]; float sc; };
__device__ __forceinline__ void load_row(Row& r, const unsigned char* tab_l, const float* sct, int e) {
    __builtin_amdgcn_sched_barrier(0);
    const unsigned char* g = tab_l + (size_t)(unsigned)e * 1024;
#pragma unroll
    for (int j = 0; j < 4; ++j) r.p[j] = *(const u32x4*)(g + j * 256);
    r.sc = sct[e];
    __builtin_amdgcn_sched_barrier(0);
}
__device__ __forceinline__ float dot128(const f32x2 (&h)[64], const Row& r) {
    f32x2 a = {0.f, 0.f}, b = {0.f, 0.f};
#pragma unroll
    for (int j = 0; j < 4; ++j)
#pragma unroll
        for (int q = 0; q < 4; ++q) { const unsigned w = r.p[j][q];
            a = __builtin_elementwise_fma(h[(j * 4 + q) * 4 + 0], cvt4(w, 0), a); b = __builtin_elementwise_fma(h[(j * 4 + q) * 4 + 1], cvt4(w, 1), b);
            a = __builtin_elementwise_fma(h[(j * 4 + q) * 4 + 2], cvt4(w, 2), a); b = __builtin_elementwise_fma(h[(j * 4 + q) * 4 + 3], cvt4(w, 3), b); }
    return (a.x + a.y) + (b.x + b.y);
}
__device__ __forceinline__ void axpy128(f32x2 (&acc)[64], const float w, const Row& r) {
    const f32x2 ww = {w, w};
#pragma unroll
    for (int j = 0; j < 4; ++j)
#pragma unroll
        for (int q = 0; q < 4; ++q) { const unsigned x = r.p[j][q];
#pragma unroll
            for (int t = 0; t < 4; ++t) acc[(j * 4 + q) * 4 + t] = __builtin_elementwise_fma(ww, cvt4(x, t), acc[(j * 4 + q) * 4 + t]); }
}
__device__ __forceinline__ float gelu_as(float v) {
    const float av = __builtin_fabsf(v), t = __builtin_amdgcn_rcpf(av * 0.2316418882f + 1.0f);
    float q = t * 0.5307027145f + (-0.7265760135f); q = q * t + 0.7107068705f; q = q * t + (-0.142248368f); q = q * t + 0.127414796f; q = q * t;
    const float e = __builtin_amdgcn_exp2f((v * v) * (-0.72134752044f)); const float m = v * (q * e); return v < 0.f ? m : v - m;
}
}

__device__ __forceinline__ void pexp4_phase(const Frame& F, KA A, int l, int ntok, const bf16* HF, float* outp, bf16* Hnext) {
    using namespace p4;
    const unsigned char* PU8 = (const unsigned char*)(F.ws + WS_PU) + (size_t)l * 16384 * 1024; const unsigned char* PV8 = (const unsigned char*)(F.ws + WS_PV) + (size_t)l * 16384 * 1024;
    const float* SCU = (const float*)(F.ws + WS_SCU) + l * 16384; const float* SCV = (const float*)(F.ws + WS_SCV) + l * 16384;
    const int* EIDX = (const int*)(F.ws + WS_EIDX); const float* EG = (const float*)(F.ws + WS_EG);
    float* X1 = (float*)(F.ws + WS_UREG); const float* mod = (const float*)(F.ws + WS_MOD);
    const float* g2 = G(A.in.ln2_g) + l * DM; const float* b2 = G(A.in.ln2_b) + l * DM;
    LAS unsigned char* wl = F.lds + RING_OFF + F.wave * L_WAVE;
    LAS unsigned short* se = (LAS unsigned short*)(wl + L_SE); LAS float* sg = (LAS float*)(wl + L_SG);
    const int gw = F.vcu * NWAVES + F.wave, NW = F.G * NWAVES;
    const int nfull = ntok / (NW * 4), nrem = ntok - nfull * NW * 4, nsplit = (nrem + NW - 1) / NW;
    for (int pass = 0; pass < nfull + nsplit; ++pass) {
        int lane = F.lane; asm volatile("" : "+v"(lane));
        const int qd = lane >> 4, l16 = lane & 15;
        const bool split = pass >= nfull;
        int tokw[4];
#pragma unroll
        for (int k = 0; k < 4; ++k) tokw[k] = split ? ((k == 0 && (pass - nfull) * NW + gw < nrem) ? nfull * NW * 4 + (pass - nfull) * NW + gw : -1) : pass * NW * 4 + gw * 4 + k;
        if (split && tokw[0] < 0) continue;
#pragma unroll
        for (int k = 0; k < 4; ++k) if (tokw[k] >= 0) {
            unsigned k0 = ((unsigned)EIDX[(size_t)tokw[k] * 128 + lane] << 7) | (unsigned)lane, k1 = ((unsigned)EIDX[(size_t)tokw[k] * 128 + 64 + lane] << 7) | (unsigned)(64 + lane);
#pragma unroll
            for (int size = 2; size <= 128; size <<= 1)
#pragma unroll
                for (int stride = size >> 1; stride > 0; stride >>= 1) {
                    if (stride == 64) { const unsigned lo = k0 < k1 ? k0 : k1, hi = k0 < k1 ? k1 : k0; k0 = lo; k1 = hi; }
                    else {
                        const unsigned p0 = (unsigned)__shfl_xor((int)k0, stride), p1 = (unsigned)__shfl_xor((int)k1, stride);
                        const bool lower = (lane & stride) == 0;
                        const bool up0 = (lane & size) == 0 || size == 128 || size == 64;
                        const bool up1 = size == 128 ? true : (size == 64 ? false : (lane & size) == 0);
                        k0 = (lower == up0) ? (k0 < p0 ? k0 : p0) : (k0 < p0 ? p0 : k0);
                        k1 = (lower == up1) ? (k1 < p1 ? k1 : p1) : (k1 < p1 ? p1 : k1);
                    }
                }
            se[k * 128 + lane] = (unsigned short)(k0 >> 7); se[k * 128 + 64 + lane] = (unsigned short)(k1 >> 7);
            sg[k * 128 + lane] = EG[(size_t)tokw[k] * 128 + (k0 & 127u)]; sg[k * 128 + 64 + lane] = EG[(size_t)tokw[k] * 128 + (k1 & 127u)];
        }
        LDS_WAIT(); asm volatile("s_waitcnt vmcnt(0)" ::: "memory");
        const int tok = split ? tokw[0] : (qd == 0 ? tokw[0] : (qd == 1 ? tokw[1] : (qd == 2 ? tokw[2] : tokw[3])));
        const int lbase = split ? 32 * qd : 128 * qd;
        const int nsteps = split ? 32 : 128;
        LAS const unsigned short* seq = se + lbase; LAS float* sgq = sg + lbase;
#ifndef P4_NO_U
        {
            f32x2 h[64];
#pragma unroll
            for (int j = 0; j < 4; ++j) { const bf16* hp = HF + (size_t)tok * DM + j * 512 + l16 * 32;
#pragma unroll
                for (int q = 0; q < 4; ++q) { const u32x4 a = *(const u32x4*)(hp + q * 8);
#pragma unroll
                    for (int t = 0; t < 4; ++t) h[(j * 4 + q) * 4 + t] = (f32x2){bflo(a[t]), bfhi(a[t])}; } }
            const unsigned char* tab_l = PU8 + l16 * 16;
            p4::Row ra, rb;
            int ea = seq[0], eb = seq[1];
            p4::load_row(ra, tab_l, SCU, ea);
            for (int i = 0; i < nsteps; i += 2) {
                p4::load_row(rb, tab_l, SCU, eb);
                const float sva = SCV[ea]; ea = seq[i + 2 < nsteps ? i + 2 : nsteps - 1];
                { const float gate = sgq[i]; const float d = p4::rowsum16(p4::dot128(h, ra)) * ra.sc; sgq[i] = p4::gelu_as(d) * gate * sva; }
                p4::load_row(ra, tab_l, SCU, ea);
                const float svb = SCV[eb]; eb = seq[i + 3 < nsteps ? i + 3 : nsteps - 1];
                { const float gate = sgq[i + 1]; const float d = p4::rowsum16(p4::dot128(h, rb)) * rb.sc; sgq[i + 1] = p4::gelu_as(d) * gate * svb; }
            }
        }
#endif
        LDS_WAIT(); asm volatile("s_waitcnt vmcnt(0)" ::: "memory");
#ifndef P4_NO_V
        {
            f32x2 acc[64];
#pragma unroll
            for (int k = 0; k < 64; ++k) acc[k] = (f32x2){0.f, 0.f};
            const unsigned char* tab_l = PV8 + l16 * 16;
            p4::Row ra, rb;
            int ea = seq[0], eb = seq[1];
            p4::load_row(ra, tab_l, SCV, ea);
            for (int i = 0; i < nsteps; i += 2) {
                p4::load_row(rb, tab_l, SCV, eb);
                ea = seq[i + 2 < nsteps ? i + 2 : nsteps - 1];
                p4::axpy128(acc, sgq[i], ra);
                p4::load_row(ra, tab_l, SCV, ea);
                eb = seq[i + 3 < nsteps ? i + 3 : nsteps - 1];
                p4::axpy128(acc, sgq[i + 1], rb);
            }
            asm volatile("s_waitcnt vmcnt(0)" ::: "memory");
#ifndef P4_NO_SPLITC
            if (split) {
#pragma unroll
                for (int k = 0; k < 64; ++k) {
                    { auto r0 = __builtin_amdgcn_permlane16_swap(__float_as_uint(acc[k].x), __float_as_uint(acc[k].x), false, false); acc[k].x = __uint_as_float(r0[0]) + __uint_as_float(r0[1]);
                      auto r1 = __builtin_amdgcn_permlane16_swap(__float_as_uint(acc[k].y), __float_as_uint(acc[k].y), false, false); acc[k].y = __uint_as_float(r1[0]) + __uint_as_float(r1[1]); }
                    { auto r0 = __builtin_amdgcn_permlane32_swap(__float_as_uint(acc[k].x), __float_as_uint(acc[k].x), false, false); acc[k].x = __uint_as_float(r0[0]) + __uint_as_float(r0[1]);
                      auto r1 = __builtin_amdgcn_permlane32_swap(__float_as_uint(acc[k].y), __float_as_uint(acc[k].y), false, false); acc[k].y = __uint_as_float(r1[0]) + __uint_as_float(r1[1]); }
                }
            }
#endif
#ifdef P4_NO_LN2
            for (int k = 0; k < 64; ++k) *(f32x2*)(outp + (size_t)tok * DM + k * 32 + l16 * 2) = acc[k];
#else
            const int bidx = tok < ML ? (tok >> 12) : 4;
            const float* mr = mod + ((size_t)l * 5 + bidx) * MODW; const float* mn = mod + ((size_t)(l + 1 < DEPTH ? l + 1 : l) * 5 + bidx) * MODW; float* x1 = X1 + (size_t)tok * DM;
            if (!split || qd == 0) {
                float s1 = 0.f, s2 = 0.f; int lq = l16; asm volatile("" : "+v"(lq));
                GAS float* px = (GAS float*)x1 + lq * 32; const GAS float* pg = (const GAS float*)mr + 5 * DM + lq * 32;
#pragma unroll
                for (int j = 0; j < 4; ++j) {
#pragma unroll
                    for (int k = 0; k < 8; ++k) { const f32x4 xa = *(const GAS f32x4*)(px + k * 4), ga = *(const GAS f32x4*)(pg + k * 4);
                        const f32x2 a0 = acc[(j * 4 + (k >> 1)) * 4 + (k & 1) * 2], a1 = acc[(j * 4 + (k >> 1)) * 4 + (k & 1) * 2 + 1];
                        const f32x4 v = (f32x4){ALPHA * xa[0] + ga[0] * a0.x, ALPHA * xa[1] + ga[1] * a0.y, ALPHA * xa[2] + ga[2] * a1.x, ALPHA * xa[3] + ga[3] * a1.y};
                        s1 += (v[0] + v[1]) + (v[2] + v[3]); s2 += (v[0] * v[0] + v[1] * v[1]) + (v[2] * v[2] + v[3] * v[3]);
                        *(GAS f32x4*)(px + k * 4) = v; asm volatile("" : "+v"(s1), "+v"(s2) :: "memory"); }
                    px += 512; pg += 512; asm volatile("" : "+v"(px), "+v"(pg)); }
                const float mean = p4::rowsum16(s1) * (1.0f / DM); const float var = p4::rowsum16(s2) * (1.0f / DM) - mean * mean;
                const float rstd = rsqrtf((var > 0.f ? var : 0.f) + LN_EPS);
                asm volatile("s_waitcnt vmcnt(0)" ::: "memory");
                const int co = lq * 32;
#pragma unroll 1
                for (int jj = 0; jj < 8; ++jj) {
                    u32x4 o0, o1; const int cj = (jj >> 1) * 512 + co + (jj & 1) * 16;
#pragma unroll
                    for (int q = 0; q < 4; ++q) { const int c = cj + q * 4; const f32x4 v = *(const f32x4*)(x1 + c), ga = *(const f32x4*)(g2 + c), ba = *(const f32x4*)(b2 + c);
                        const f32x4 y = (v - mean) * rstd * ga + ba;
                        *(f32x4*)(outp + (size_t)tok * DM + c) = y;
                        if (Hnext) { const f32x4 z = y * (*(const f32x4*)(mn + DM + c) + 1.0f) + *(const f32x4*)(mn + c); const unsigned w0 = pk2(z[0], z[1]), w1 = pk2(z[2], z[3]);
                            if (q == 0) { o0.x = w0; o0.y = w1; } else if (q == 1) { o0.z = w0; o0.w = w1; } else if (q == 2) { o1.x = w0; o1.y = w1; } else { o1.z = w0; o1.w = w1; } } }
                    if (Hnext) { bf16* hp = Hnext + (size_t)tok * DM + cj; *(u32x4*)hp = o0; *(u32x4*)(hp + 8) = o1;
                        if (F8_MERGE) { u32x4 q8;
#pragma unroll
                            for (int q = 0; q < 4; ++q) { const unsigned wa = q < 2 ? (q == 0 ? o0.x : o0.z) : (q == 2 ? o1.x : o1.z), wb = q < 2 ? (q == 0 ? o0.y : o0.w) : (q == 2 ? o1.y : o1.w);
                                int w = __builtin_amdgcn_cvt_pk_fp8_f32(bflo(wa), bfhi(wa), 0, false); w = __builtin_amdgcn_cvt_pk_fp8_f32(bflo(wb), bfhi(wb), w, true); q8[q] = (unsigned)w; }
                            *(u32x4*)((unsigned char*)(F.ws + WS_H8) + (size_t)tok * DM + cj) = q8; } }
                }
            }
#endif
        }
#endif
        LDS_WAIT(); asm volatile("s_waitcnt vmcnt(0)" ::: "memory");
    }
}
__device__ __forceinline__ float gelu_exact(float v) { return 0.5f * v * (1.0f + erff(v * 0.70710678118654752f)); }
__device__ __forceinline__ float reduce16(float (&p)[16], int lane) {
    float q[8], r[4], s[2];
    { const bool up = lane & 1;
#pragma unroll
      for (int k = 0; k < 8; ++k) { const float send = up ? p[2 * k] : p[2 * k + 1], keep = up ? p[2 * k + 1] : p[2 * k]; q[k] = keep + __shfl_xor(send, 1); } }
    { const bool up = lane & 2;
#pragma unroll
      for (int k = 0; k < 4; ++k) { const float send = up ? q[2 * k] : q[2 * k + 1], keep = up ? q[2 * k + 1] : q[2 * k]; r[k] = keep + __shfl_xor(send, 2); } }
    { const bool up = lane & 4;
#pragma unroll
      for (int k = 0; k < 2; ++k) { const float send = up ? r[2 * k] : r[2 * k + 1], keep = up ? r[2 * k + 1] : r[2 * k]; s[k] = keep + __shfl_xor(send, 4); } }
    float t;
    { const bool up = lane & 8; const float send = up ? s[0] : s[1], keep = up ? s[1] : s[0]; t = keep + __shfl_xor(send, 8); }
    t += __shfl_xor(t, 16); t += __shfl_xor(t, 32);
    return t;
}
__device__ __forceinline__ void pexp_phase(const Frame& F, KA A, int l, int ntok, const bf16* HF, float* outp, bf16* Hnext) {
    const int gw = F.vcu * NWAVES + F.wave, NGW = F.G * NWAVES, lane = F.lane;
    const bf16* PU = (const bf16*)(F.ws + WS_PU) + (size_t)l * 16384 * DM; const bf16* PV = (const bf16*)(F.ws + WS_PV) + (size_t)l * 16384 * DM;
    const int* EIDX = (const int*)(F.ws + WS_EIDX); const float* EG = (const float*)(F.ws + WS_EG);
    const float* X1 = (const float*)(F.ws + WS_UREG); const float* mod = (const float*)(F.ws + WS_MOD);
    const float* g2 = G(A.in.ln2_g) + l * DM; const float* b2 = G(A.in.ln2_b) + l * DM;
    for (int tok = gw; tok < ntok; tok += NGW) {
        float h[32], acc[32];
#pragma unroll
        for (int j = 0; j < 4; ++j) { const bf16x8 v = *(const bf16x8*)(HF + (size_t)tok * DM + j * 512 + lane * 8);
#pragma unroll
            for (int e = 0; e < 8; ++e) { h[j * 8 + e] = bf2f((unsigned short)v[e]); acc[j * 8 + e] = 0.f; } }
#pragma unroll 1
        for (int sb = 0; sb < 32; ++sb) {
            const int my_e = EIDX[(size_t)tok * 128 + sb * 4 + (lane & 3)]; const float my_g = EG[(size_t)tok * 128 + sb * 4 + (lane & 3)];
            const int e0 = __builtin_amdgcn_readlane(my_e, 0), e1 = __builtin_amdgcn_readlane(my_e, 1), e2 = __builtin_amdgcn_readlane(my_e, 2), e3 = __builtin_amdgcn_readlane(my_e, 3);
            float part[4];
#pragma unroll
            for (int i = 0; i < 4; ++i) {
                const int e = i == 0 ? e0 : (i == 1 ? e1 : (i == 2 ? e2 : e3)); const bf16* ur = PU + (size_t)e * DM + lane * 8; float d = 0.f;
#pragma unroll
                for (int j = 0; j < 4; ++j) { const u32x4 w = *(const u32x4*)(ur + j * 512);
                    d += h[j * 8 + 0] * bflo(w.x) + h[j * 8 + 1] * bfhi(w.x) + h[j * 8 + 2] * bflo(w.y) + h[j * 8 + 3] * bfhi(w.y)
                       + h[j * 8 + 4] * bflo(w.z) + h[j * 8 + 5] * bfhi(w.z) + h[j * 8 + 6] * bflo(w.w) + h[j * 8 + 7] * bfhi(w.w); }
                part[i] = d;
            }
            float dot;
            { const bool u1 = lane & 1, u2 = lane & 2;
              const float q0 = (u1 ? part[1] : part[0]) + __shfl_xor(u1 ? part[0] : part[1], 1);
              const float q1 = (u1 ? part[3] : part[2]) + __shfl_xor(u1 ? part[2] : part[3], 1);
              dot = (u2 ? q1 : q0) + __shfl_xor(u2 ? q0 : q1, 2);
              dot += __shfl_xor(dot, 4); dot += __shfl_xor(dot, 8); dot += __shfl_xor(dot, 16); dot += __shfl_xor(dot, 32); }
            const float act = gelu_exact(dot) * my_g;
#pragma unroll
            for (int i = 0; i < 4; ++i) {
                const int e = i == 0 ? e0 : (i == 1 ? e1 : (i == 2 ? e2 : e3)); const float w = __uint_as_float(__builtin_amdgcn_readlane(__float_as_uint(act), i));
                const bf16* vr = PV + (size_t)e * DM + lane * 8;
#pragma unroll
                for (int j = 0; j < 4; ++j) { const u32x4 x = *(const u32x4*)(vr + j * 512);
                    acc[j * 8 + 0] += w * bflo(x.x); acc[j * 8 + 1] += w * bfhi(x.x); acc[j * 8 + 2] += w * bflo(x.y); acc[j * 8 + 3] += w * bfhi(x.y);
                    acc[j * 8 + 4] += w * bflo(x.z); acc[j * 8 + 5] += w * bfhi(x.z); acc[j * 8 + 6] += w * bflo(x.w); acc[j * 8 + 7] += w * bfhi(x.w); }
            }
        }
        const int bidx = tok < ML ? (tok >> 12) : 4;
        const float* mr = mod + ((size_t)l * 5 + bidx) * MODW; const float* x1 = X1 + (size_t)tok * DM;
        float s = 0.f;
#pragma unroll
        for (int j = 0; j < 4; ++j) { const int c = j * 512 + lane * 8;
            const f32x4 xa = *(const f32x4*)(x1 + c), xb = *(const f32x4*)(x1 + c + 4), ga = *(const f32x4*)(mr + 5 * DM + c), gb = *(const f32x4*)(mr + 5 * DM + c + 4);
#pragma unroll
            for (int e = 0; e < 4; ++e) { acc[j * 8 + e] = ALPHA * xa[e] + ga[e] * acc[j * 8 + e]; acc[j * 8 + 4 + e] = ALPHA * xb[e] + gb[e] * acc[j * 8 + 4 + e]; s += acc[j * 8 + e] + acc[j * 8 + 4 + e]; } }
        const float mean = wave_sum(s) * (1.0f / DM); float q = 0.f;
#pragma unroll
        for (int k = 0; k < 32; ++k) { acc[k] -= mean; q += acc[k] * acc[k]; }
        const float rstd = rsqrtf(wave_sum(q) * (1.0f / DM) + LN_EPS);
        const float* mn = mod + ((size_t)(l + 1 < DEPTH ? l + 1 : l) * 5 + bidx) * MODW;
#pragma unroll
        for (int j = 0; j < 4; ++j) { const int c = j * 512 + lane * 8;
            const f32x4 ga = *(const f32x4*)(g2 + c), gb = *(const f32x4*)(g2 + c + 4), ba = *(const f32x4*)(b2 + c), bb = *(const f32x4*)(b2 + c + 4);
            f32x4 ya, yb;
#pragma unroll
            for (int e = 0; e < 4; ++e) { ya[e] = acc[j * 8 + e] * rstd * ga[e] + ba[e]; yb[e] = acc[j * 8 + 4 + e] * rstd * gb[e] + bb[e]; }
            *(f32x4*)(outp + (size_t)tok * DM + c) = ya; *(f32x4*)(outp + (size_t)tok * DM + c + 4) = yb;
            if (Hnext) { const f32x4 sa = *(const f32x4*)(mn + DM + c), sb = *(const f32x4*)(mn + DM + c + 4), ha = *(const f32x4*)(mn + c), hb = *(const f32x4*)(mn + c + 4);
                const f32x4 za = ya * (sa + 1.0f) + ha, zb = yb * (sb + 1.0f) + hb;
                u32x4 o; o.x = pk2(za[0], za[1]); o.y = pk2(za[2], za[3]); o.z = pk2(zb[0], zb[1]); o.w = pk2(zb[2], zb[3]);
                *(u32x4*)(Hnext + (size_t)tok * DM + c) = o; }
        }
    }
}

#ifndef SD_A
#define SD_A 1
#endif
#ifndef SD_D
#define SD_D 1
#endif
#ifndef SD_B
#define SD_B 2
#endif
#ifndef SD_C
#define SD_C 1
#endif
#ifndef ATT_MASK
#define ATT_MASK 15
#endif
template <int TYPE> __device__ __forceinline__ att::Args make_att_args(const Frame& F, KA A, int l, int idx, bool ctxq) {
    const bf16* U = (const bf16*)(F.ws + WS_UREG); const bf16* QK = (const bf16*)(F.ws + WS_QKVA); bf16* O = (bf16*)(F.ws + WS_OQP);
    constexpr int NH = (TYPE == 2) ? 8 : 4;
    int b, h, qb;
    if (ctxq) { b = idx / NH; h = idx % NH; qb = 0; } else { b = idx / (NH * 16); h = (idx >> 4) % NH; qb = idx & 15; }
    const int row = ctxq ? ML + b * NCTX : b * SEQ + qb * 256;
    att::Args a{};
    a.ldo = DM; a.qpos0 = qb * 256; a.o8 = F8_MERGE;
    if (ctxq) { a.n0 = 4; a.row0 = ML + b * NCTX; a.n1 = 0; a.row1 = 0; }
    if constexpr (TYPE == 0) {
        a.Q = QK + (size_t)row * QW + QA_Q + h * 192; a.ldq = QW; a.KV = QK; a.ld = QW; a.kc0 = QA_KV + h * 256; a.kc1 = QA_KR; a.vc = QA_KV + h * 256 + 128;
        a.O = F8_MERGE ? (bf16*)((unsigned char*)O + (size_t)row * DM + h * 128) : O + (size_t)row * DM + h * 128; a.C = A_SCALE * LOG2E; a.thr = 8.0f / A_SCALE; a.qrope = ctxq ? 0 : 1;
        if (!ctxq) { a.n0 = 64; a.row0 = b * SEQ; a.n1 = 4; a.row1 = ML + b * NCTX; }
    } else if constexpr (TYPE == 1) {
        const int kvh = h >> 1;
        a.Q = U + (size_t)row * UW + U_DQ + h * 128; a.ldq = UW; a.KV = U; a.ld = UW; a.kc0 = U_DK + kvh * 128; a.kc1 = 0; a.vc = U_DV + kvh * 128;
        a.O = F8_MERGE ? (bf16*)((unsigned char*)O + (size_t)row * DM + 1536 + h * 128) : O + (size_t)row * DM + 1536 + h * 128; a.C = D_SCALE * LOG2E; a.thr = 8.0f / D_SCALE;
        if (!ctxq) { a.n0 = 64; a.row0 = b * SEQ; a.n1 = 4; a.row1 = ML + b * NCTX; }
    } else if constexpr (TYPE == 2) {
        const int kvh = h >> 2;
        a.Q = U + (size_t)row * UW + U_BQ + h * 64; a.ldq = UW; a.KV = U; a.ld = UW; a.kc0 = U_BK + kvh * 64; a.kc1 = 0; a.vc = U_BV + kvh * 64;
        a.O = F8_MERGE ? (bf16*)((unsigned char*)O + (size_t)row * DM + 512 + h * 64) : O + (size_t)row * DM + 512 + h * 64; a.C = B_SCALE * LOG2E; a.thr = 8.0f / B_SCALE; a.has_sink = 1; a.sinkl2 = G(A.in.b_sink)[l * 8 + h] * LOG2E;
        if (!ctxq) { int ws = qb * 256 - 128; ws = ws < 0 ? 0 : ws; int we = qb * 256 + 384; we = we > SEQ ? SEQ : we;
            a.n0 = 4; a.row0 = ML + b * NCTX; a.n1 = (we - ws) / 64; a.row1 = b * SEQ + ws; a.wpos0 = ws; }
    } else {
        a.Q = U + (size_t)row * UW + U_CQQ + h * 128; a.ldq = UW; a.KV = U; a.ld = UW; a.kc0 = U_CK + h * 128; a.kc1 = 0; a.vc = U_CV + h * 128;
        a.O = F8_MERGE ? (bf16*)((unsigned char*)O + (size_t)row * DM + 1024 + h * 128) : O + (size_t)row * DM + 1024 + h * 128; a.C = C_SCALE * LOG2E; a.thr = 8.0f / C_SCALE;
        a.T = (const float*)(F.ws + WS_CTAB) + (size_t)((l * 4 + h) * 15) * 4096;
        if (!ctxq) { const int r0 = qb * 4; int kr0 = r0 - 4; kr0 = kr0 < 0 ? 0 : (kr0 > 56 ? 56 : kr0); int ke = r0 + 3 - 4; ke = ke < 0 ? 0 : (ke > 56 ? 56 : ke); ke += 7; const int nr = ke - kr0 + 1;
            a.n0 = 4; a.row0 = ML + b * NCTX; a.n1 = nr + (nr & 1); a.row1 = b * SEQ + kr0 * 64; a.r0 = r0; a.kr0 = kr0; }
    }
    return a;
}
#define AF() Frame F = F0; asm volatile("" : "+v"(F.tid), "+v"(F.lane), "+s"(F.wave), "+s"(F.vcu), "+s"(F.G), "+s"(F.ws), "+s"(F.lds)); LAS char* lds = (LAS char*)(F.lds + RING_OFF); const int v = F.vcu
__device__ __forceinline__ void att_phase(const Frame& F0, int l) {
    if (F0.vcu >= 256) return;
    const bool cx = (l + 1 < DEPTH);
    if (ATT_MASK & 1) { AF(); KA A = *kargs(); const int n = 1 + ((cx && v < 16) ? 1 : 0);
        for (int k = 0; k < n; ++k) { const att::Args a = make_att_args<0>(F, A, l, k ? v : v, k != 0); att::attn_unit<192, 128, 0, SD_A>(a, lds, F.tid); } }
    if (ATT_MASK & 2) { AF(); KA A = *kargs(); const int n = 1 + ((cx && v >= 16 && v < 32) ? 1 : 0);
        for (int k = 0; k < n; ++k) { const att::Args a = make_att_args<1>(F, A, l, k ? v - 16 : v, k != 0); att::attn_unit<128, 128, 0, SD_D>(a, lds, F.tid); } }
    if (ATT_MASK & 4) { AF(); KA A = *kargs(); const int n = 2 + ((cx && v >= 48 && v < 80) ? 1 : 0);
        for (int k = 0; k < n; ++k) { const att::Args a = make_att_args<2>(F, A, l, k == 2 ? v - 48 : 2 * v + k, k == 2); att::attn_unit<64, 64, 1, SD_B>(a, lds, F.tid); } }
    if (ATT_MASK & 8) { AF(); KA A = *kargs(); const int n = 1 + ((cx && v >= 32 && v < 48) ? 1 : 0);
        for (int k = 0; k < n; ++k) { const att::Args a = make_att_args<3>(F, A, l, k ? v - 32 : v, k != 0); att::attn_unit<128, 128, 2, SD_C>(a, lds, F.tid); } }
}

__device__ __forceinline__ void merge_ctx_reduce(const Frame& F, bf16* S, const char* CP) {
    const int T = F.vcu; if (T >= 32) return;
    const int tid = F.tid, wid = tid >> 6, lane = tid & 63, wr = wid >> 2, wc = wid & 3, fr = lane & 15, fq = lane >> 4;
    const int pm = 64 + (T >> 3), pn = T & 7; const int row0 = pm * 256 + wr * 64 + fr, col0 = pn * 256 + wc * 32 + 8 * fq;
    for (int si = 0; si < 16; ++si) {
        f32x4 v0 = {0.f, 0.f, 0.f, 0.f}, v1 = v0;
#pragma unroll
        for (int z = 0; z < 4; ++z) { const char* p = CP + (size_t)(T * 4 + z) * 262144 + ((size_t)(si * 2) * 512 + tid) * 16; v0 += *(const f32x4*)p; v1 += *(const f32x4*)(p + 8192); }
        const int ai = si >> 3, m = (si >> 1) & 3, bj = si & 1;
        if (F8_OUT) { int w0 = __builtin_amdgcn_cvt_pk_fp8_f32(v0[0], v0[1], 0, false); w0 = __builtin_amdgcn_cvt_pk_fp8_f32(v0[2], v0[3], w0, true);
            int w1 = __builtin_amdgcn_cvt_pk_fp8_f32(v1[0], v1[1], 0, false); w1 = __builtin_amdgcn_cvt_pk_fp8_f32(v1[2], v1[3], w1, true);
            *(u32x2*)((unsigned char*)S + (size_t)(row0 + ai * 128 + m * 16) * 2048 + col0 + bj * 128) = (u32x2){(unsigned)w0, (unsigned)w1}; }
        else { u32x4 w; w.x = cvt_pk_bf16(v0[0], v0[1]); w.y = cvt_pk_bf16(v0[2], v0[3]); w.z = cvt_pk_bf16(v1[0], v1[1]); w.w = cvt_pk_bf16(v1[2], v1[3]);
        *(u32x4*)(S + (size_t)(row0 + ai * 128 + m * 16) * 2048 + col0 + bj * 128) = w; }
    }
}

constexpr int N_PHASES = 3 + 10 * DEPTH;
#ifndef MK_N_LAUNCHES
#define MK_N_LAUNCHES 1
#endif
static_assert(MK_N_LAUNCHES == 1, "the merge phase carries a grid barrier of its own (context tiles): single-launch builds only");
__global__ void __launch_bounds__(NWAVES * 64, 2) mk_fwd(Args args) {
    extern __shared__ __attribute__((aligned(16))) unsigned char lds_raw[];
    Frame F;
    F.lds = (LAS unsigned char*)lds_raw; F.tid = threadIdx.x; F.lane = F.tid & 63; F.wave = __builtin_amdgcn_readfirstlane(F.tid >> 6);
    F.G = gridDim.x; { const int bx = blockIdx.x; F.vcu = (F.G % 8 == 0) ? (bx % 8) * (F.G / 8) + bx / 8 : bx; }
    GAS unsigned char* ws; int lo, hi, li;
    { KAP ap = kargs(); ws = (GAS unsigned char*)ap->ws; lo = ap->ph_lo; hi = ap->ph_hi; li = ap->li; }
    F.ws = ws;
    for (int u = F.tid; u < (LDS_BYTES - LDSCTL_OFF) / 4; u += NWAVES * 64) ((LAS unsigned*)(F.lds + LDSCTL_OFF))[u] = 0u;
    __syncthreads();
    volatile LAS unsigned* MISC = (volatile LAS unsigned*)(F.lds + MISC_OFF);
    XcdBarrier bar = xcd_barrier_post((unsigned*)(ws + WS_CTL) + CW_BAR + li * XCD_BAR_WORDS, MISC + 8);
#ifndef PHASE_MASK
#define PHASE_MASK 0x1fff
#endif
#define INR(k) (lo <= (k) && (k) < hi)
#define IN(k) ((((PHASE_MASK) >> ((k) < 3 ? (k) : 3 + ((k) - 3) % 10)) & 1) && INR(k))
#define SEAM(k) do { if (INR(k) && INR((k) + 1)) xcd_barrier(bar); } while (0)
#ifndef PROBE_DUP
#define PROBE_DUP 0
#endif
#ifndef PROBE_REP
#define PROBE_REP 1
#endif
#define KIND(k) ((k) < 3 ? (k) : 3 + ((k) - 3) % 10)
#define REP(k) for (int rep_ = 0, nrep_ = 1 + ((((PROBE_DUP) >> KIND(k)) & 1) ? PROBE_REP : 0); rep_ < nrep_; ++rep_, (rep_ < nrep_ ? xcd_barrier(bar) : (void)0))
#define PF() Frame Fp = F; int bx = blockIdx.x; asm volatile("" : "+v"(Fp.tid), "+v"(Fp.lane), "+s"(Fp.wave), "+s"(Fp.vcu), "+s"(Fp.G), "+s"(Fp.ws), "+s"(Fp.lds), "+s"(bx)); GAS unsigned char* ws = Fp.ws; (void)bx; (void)ws
    if (IN(0)) REP(0) { PF(); p0_prologue(Fp, *kargs()); } SEAM(0);
    if (IN(1)) REP(1) { PF(); p1_modreduce(Fp, *kargs()); } SEAM(1);
    if (IN(2)) REP(2) { PF(); p2_modulate0(Fp, *kargs()); } SEAM(2);
    for (int l = 0; l < DEPTH; ++l) {
        const int pb = 3 + 10 * l; const bool last = (l + 1 == DEPTH);
        const size_t offH = (l & 1) ? WS_BUFB : WS_BUFA, offS = (l & 1) ? WS_BUFA : WS_BUFB;
        const int nPl = last ? 64 : 68, nrows = last ? ML : MT;
        if (IN(pb + 0)) REP(pb + 0) {
            PF(); bf16* Hb = (bf16*)(ws + offH);
            pg8::PlainSched S{(const char*)Hb, (const char*)((bf16*)(ws + WS_WIN) + (size_t)l * UW * DM), DM, DM, DM, 68, 16, Fp.G, bx, 2};
            pg8::EpiBf16 E{(bf16*)(ws + WS_UREG), UW};
            pg8::gemm_phase(Fp.lds + RING_OFF, S, E, DM, DM, Fp.tid);
        } SEAM(pb + 0);
        if (IN(pb + 1)) REP(pb + 1) { PF(); enorm_phase(Fp, *kargs(), l); } SEAM(pb + 1);
        if (IN(pb + 2)) REP(pb + 2) { PF();
            pg8::PlainSched S{(const char*)(ws + WS_UREG), (const char*)((bf16*)(ws + WS_WUP) + (size_t)l * 1792 * 512), UW, 512, 512, 68, 7, Fp.G, bx, 2};
            pg8::EpiBf16 E{(bf16*)(ws + WS_QKVA), QW};
            pg8::gemm_phase(Fp.lds + RING_OFF, S, E, UW, 512, Fp.tid);
        } SEAM(pb + 2);
        if (IN(pb + 3)) REP(pb + 3) { PF(); att_phase(Fp, l); } SEAM(pb + 3);
        if (IN(pb + 4)) REP(pb + 4) { PF(); bf16* Hb = (bf16*)(ws + offH); bf16* Sb = (bf16*)(ws + offS);
            pg8::MergeSched S{F8_MERGE ? (const char*)(ws + WS_H8) : (const char*)Hb, (const char*)(ws + WS_OQP), F8_MERGE ? (const char*)(ws + WS_WC) + (size_t)l * 4 * DM * 2560 : (const char*)((bf16*)(ws + WS_WC) + (size_t)l * 4 * DM * 2560), nPl, Fp.G, bx, F8_MERGE ? 1 : 2};
            pg8::EpiMerge E{Sb, G(kargs()->in.b_gate) + (size_t)l * 4 * DM, (char*)(ws + WS_STASH) + (size_t)bx * STASH_WG, (char*)(ws + WS_P) + (size_t)bx * P_WG, (char*)(ws + WS_CP), Fp.tid, F8_OUT};
            pg8::gemm_phase<pg8::EpiMerge, pg8::MergeSched, F8_MERGE != 0>(Fp.lds + RING_OFF, S, E, DM, 2560, Fp.tid);
            if (nPl > 64) { xcd_barrier(bar); merge_ctx_reduce(Fp, Sb, (const char*)(ws + WS_CP)); }
        } SEAM(pb + 4);
        if (IN(pb + 5)) REP(pb + 5) { PF(); bf16* Sb = (bf16*)(ws + offS);
            pg8::PlainSched S{(const char*)Sb, F8_OUT ? (const char*)(ws + WS_WO) + (size_t)l * DM * DM : (const char*)((bf16*)(ws + WS_WO) + (size_t)l * DM * DM), DM, DM, DM, nPl, 8, Fp.G, bx, F8_OUT ? 1 : 2};
            KAP ap = kargs();
            pg8::EpiOut E{(float*)(ws + WS_UREG), l == 0 ? G(ap->in.x) : (const float*)(ws + WS_XRES), l == 0 ? G(ap->in.ctx) : (const float*)(ws + WS_XRES) + (size_t)ML * DM,
                          (const float*)(ws + WS_MOD) + (size_t)l * 5 * MODW, ALPHA};
            pg8::gemm_phase<pg8::EpiOut, pg8::PlainSched, F8_OUT != 0>(Fp.lds + RING_OFF, S, E, DM, DM, Fp.tid);
        } SEAM(pb + 5);
        if (IN(pb + 6)) REP(pb + 6) { PF(); ln1_phase(Fp, *kargs(), l, nrows, (bf16*)(ws + offH)); } SEAM(pb + 6);
        if (IN(pb + 7)) REP(pb + 7) { PF(); bf16* Hb = (bf16*)(ws + offH);
            pg8::PlainSched S{(const char*)Hb, (const char*)((bf16*)(ws + WS_WPQ) + (size_t)l * DM * DM), DM, DM, DM, nPl, 8, Fp.G, bx, 2};
            pg8::EpiBf16 E{(bf16*)(ws + WS_OQP), DM};
            pg8::gemm_phase(Fp.lds + RING_OFF, S, E, DM, DM, Fp.tid);
        } SEAM(pb + 7);
        if (IN(pb + 8)) REP(pb + 8) { PF();
            const int gw = Fp.vcu * NWAVES + Fp.wave, NGW = Fp.G * NWAVES;
            LAS unsigned short* tblw = (LAS unsigned short*)(Fp.lds + RING_OFF) + Fp.wave * (64 * 66);
            for (int it = gw; it < (nrows / 32) * 8; it += NGW)
                peer::topk_item((const bf16*)(ws + WS_OQP), (const bf16*)(ws + WS_SUBK) + (size_t)l * 8 * 2 * 128 * 128, (int*)(ws + WS_EIDX), (float*)(ws + WS_EG), (it >> 3) * 32, it & 7, tblw, Fp.lane);
        } SEAM(pb + 8);
        if (IN(pb + 9)) REP(pb + 9) { PF(); pexp4_phase(Fp, *kargs(), l, nrows, (bf16*)(ws + offH), last ? G(kargs()->out) : (float*)(ws + WS_XRES), last ? nullptr : (bf16*)(ws + offS)); } SEAM(pb + 9);
    }
#undef IN
#undef INR
#undef SEAM
}

extern "C" void kernel_launch(void* const* d_in, const int* in_sizes, int n_in, void* d_out, int out_size, void* d_ws, size_t ws_size, hipStream_t stream) {
    static int grid = 0;
    if (grid == 0) {
        if (n_in != 27 || out_size != ML * DM || ws_size < WS_END) { fprintf(stderr, "kernel_launch: unexpected shapes (n_in %d out %d ws %zu, need ws >= %zu)\n", n_in, out_size, ws_size, (size_t)WS_END); grid = -1; return; }
        int dev = 0, cus = 0, per_cu = 0;
        if (hipGetDevice(&dev) != hipSuccess || hipDeviceGetAttribute(&cus, hipDeviceAttributeMultiprocessorCount, dev) != hipSuccess) { grid = -1; return; }
        if (hipFuncSetAttribute((const void*)mk_fwd, hipFuncAttributeMaxDynamicSharedMemorySize, LDS_BYTES) != hipSuccess) { fprintf(stderr, "kernel_launch: hipFuncSetAttribute failed\n"); grid = -1; return; }
        if (hipOccupancyMaxActiveBlocksPerMultiprocessor(&per_cu, (const void*)mk_fwd, NWAVES * 64, LDS_BYTES) != hipSuccess || per_cu < 1) { fprintf(stderr, "kernel_launch: occupancy query says %d\n", per_cu); }
        (void)hipGetLastError();
        grid = cus < 256 ? cus : 256;
    }
    if (grid < 0) return;
    (void)hipMemsetAsync((char*)d_ws + WS_CTL, 0, CTL_ZERO_BYTES, stream);
    Args a{};
    const float** ip = (const float**)&a.in;
    for (int i = 0; i < 27; ++i) ip[i] = (const float*)d_in[i];
    a.out = (float*)d_out; a.ws = (unsigned char*)d_ws;
    for (int li = 0; li < MK_N_LAUNCHES; ++li) {
        a.ph_lo = (MK_N_LAUNCHES == 1) ? 0 : li; a.ph_hi = (MK_N_LAUNCHES == 1) ? N_PHASES : li + 1; a.li = li; a.pad = 0;
        hipLaunchKernelGGL(mk_fwd, dim3(grid), dim3(NWAVES * 64), LDS_BYTES, stream, a);
    }
}
```

```cpp
#include <hip/hip_runtime.h>
#include <cstdio>
#include <cstdint>
#include <utility>

#define GAS __attribute__((address_space(1)))
#define LAS __attribute__((address_space(3)))
typedef unsigned short bf16;
typedef short bf16x8 __attribute__((ext_vector_type(8)));
typedef short s16x4 __attribute__((ext_vector_type(4)));
typedef float f32x2 __attribute__((ext_vector_type(2)));
typedef float f32x4 __attribute__((ext_vector_type(4)));
typedef float f32x16 __attribute__((ext_vector_type(16)));
typedef unsigned u32x2 __attribute__((ext_vector_type(2)));
typedef unsigned u32x4 __attribute__((ext_vector_type(4)));
typedef GAS unsigned gu32;

__device__ __forceinline__ unsigned cvt_pk_bf16(float lo, float hi) { unsigned r; asm volatile("v_cvt_pk_bf16_f32 %0, %1, %2" : "=v"(r) : "v"(lo), "v"(hi)); return r; }
__device__ __forceinline__ float bf2f(unsigned short b) { return __uint_as_float(((unsigned)b) << 16); }
__device__ __forceinline__ float bflo(unsigned w) { return __uint_as_float(w << 16); }
__device__ __forceinline__ float bfhi(unsigned w) { return __uint_as_float(w & 0xffff0000u); }
__device__ __forceinline__ unsigned short f2bf(float f) { return (unsigned short)(cvt_pk_bf16(f, 0.f) & 0xffffu); }

namespace pg8 {
constexpr int BM = 256, BK = 64, HALF = 128, HTB = HALF * BK * 2  , STAGE_BYTES = 8 * HTB, NXCD = 8, WGM = 8;
__host__ __device__ __forceinline__ int lds_byte(int r, int c) { const int st = (r >> 4) * 2 + (c >> 5), rr = r & 15, cc = c & 31, ob = rr * 64 + cc * 2; return st * 1024 + (ob ^ (((ob >> 9) & 1) << 5)); }
__host__ __device__ __forceinline__ void stage_rc(int b, int& R, int& C) { const int st = b / 1024, sb = b % 1024, swz = sb ^ (((sb >> 9) & 1) << 5); R = (st >> 1) * 16 + swz / 64; C = (st & 1) * 32 + (swz % 64) / 2; }
__host__ __device__ __forceinline__ int perm32(int rho) { const int n = rho >> 4, i = rho & 15; return 8 * (i >> 2) + 4 * n + (i & 3); }

struct Unit { int pm, pn, z, aux; };

__device__ __forceinline__ void tile_of(int L, int nM, int nN, int& pm, int& pn) {
    const int nwg = nM * nN; int wgid = L;
    { const int q = nwg / NXCD, r = nwg % NXCD, xcd = wgid % NXCD, off = wgid / NXCD; wgid = (xcd < r ? xcd * (q + 1) : r * (q + 1) + (xcd - r) * q) + off; }
    const int nig = WGM * nN, gid = wgid / nig, fm = gid * WGM, gsz = (nM - fm) < WGM ? (nM - fm) : WGM;
    pm = fm + ((wgid % nig) % gsz); pn = (wgid % nig) / gsz;
}
struct PlainSched {
    const char* A; const char* B; int lda, ldb, K, nM, nN, G, c, esz;
    __device__ __forceinline__ bool next(int i, Unit& u) const { const long L = (long)i * G + c; if (L >= (long)nM * nN) return false; tile_of((int)L, nM, nN, u.pm, u.pn); u.z = 0; u.aux = 0; return true; }
    __device__ __forceinline__ void ptrs(const Unit& u, const char*& a, const char*& b, int& nt) const { a = A + (size_t)u.pm * BM * lda * esz; b = B + (size_t)u.pn * BM * ldb * esz; nt = K * esz / 128; }
};
struct MergeSched {
    const char* H; const char* O; const char* W; int nM, G, c, esz;
    __device__ __forceinline__ bool next(int i, Unit& u) const {
        const int ngl = (512 - c + G - 1) / G;
        if (i < 8 * ngl) { tile_of((i >> 3) * G + c, 64, 8, u.pm, u.pn); u.z = i & 7; u.aux = 0; return true; }
        if (nM <= 64) return false;
        const int t = i - 8 * ngl, j = c + (t >> 1) * G; if (j >= 128) return false;
        const int T = j >> 2; u.pm = 64 + (T >> 3); u.pn = T & 7; u.z = 8 + (j & 3) * 2 + (t & 1); u.aux = j; return true;
    }
    __device__ __forceinline__ void ptrs(const Unit& u, const char*& a, const char*& b, int& nt) const {
        const int z = (u.z & 7) >> 1, kind = u.z & 1;
        a = (kind ? H : O + (size_t)z * 512 * esz) + (size_t)u.pm * BM * 2048 * esz;
        b = W + ((size_t)z * 2048 * 2560 + (size_t)u.pn * BM * 2560 + (kind ? 0 : 2048)) * esz;
        nt = (kind ? 2048 : 512) * esz / 128;
    }
};

struct EpiBf16 {
    static constexpr bool PERM = true;
    bf16* O; int ldc;
    __device__ __forceinline__ void operator()(const f32x4 (&acc)[2][2][4][2], const Unit& u, int wr, int wc, int fr, int fq) const {
        const int row0 = u.pm * BM + wr * 64 + fr, col0 = u.pn * BM + wc * 32 + 8 * fq;
#pragma unroll
        for (int ai = 0; ai < 2; ++ai)
#pragma unroll
            for (int m = 0; m < 4; ++m) { bf16* rowp = O + (size_t)(row0 + ai * HALF + m * 16) * ldc + col0;
#pragma unroll
                for (int bj = 0; bj < 2; ++bj) { const f32x4 v0 = acc[ai][bj][m][0], v1 = acc[ai][bj][m][1];
                    u32x4 w; w.x = cvt_pk_bf16(v0[0], v0[1]); w.y = cvt_pk_bf16(v0[2], v0[3]); w.z = cvt_pk_bf16(v1[0], v1[1]); w.w = cvt_pk_bf16(v1[2], v1[3]);
                    *(u32x4*)(rowp + bj * HALF) = w; } }
    }
};
struct EpiMerge {
    static constexpr bool PERM = true;
    bf16* S; const float* bgate; char* stash; char* P; char* CP; int tid; int s8;
    __device__ __forceinline__ void operator()(const f32x4 (&acc)[2][2][4][2], const Unit& u, int wr, int wc, int fr, int fq) const {
        const int z = (u.z & 7) >> 1, kind = u.z & 1; const bool cx = u.z >= 8; int tl = tid; asm volatile("" : "+v"(tl));
        GAS char* sp = (GAS char*)stash + (size_t)tl * 16;
        if (kind == 0) {
#pragma unroll
            for (int ai = 0; ai < 2; ++ai)
#pragma unroll
                for (int m = 0; m < 4; ++m)
#pragma unroll
                    for (int bj = 0; bj < 2; ++bj) { const f32x4 v0 = acc[ai][bj][m][0], v1 = acc[ai][bj][m][1];
                        u32x4 w; w.x = cvt_pk_bf16(v0[0], v0[1]); w.y = cvt_pk_bf16(v0[2], v0[3]); w.z = cvt_pk_bf16(v1[0], v1[1]); w.w = cvt_pk_bf16(v1[2], v1[3]);
                        *(GAS u32x4*)sp = w; sp += 8192; asm volatile("" : "+v"(sp)); }
            return;
        }
        GAS char* pq = (cx ? (GAS char*)CP + (size_t)u.aux * 262144 : (GAS char*)P) + (size_t)tl * 16;
        const int row0 = u.pm * BM + wr * 64 + fr, col0 = u.pn * BM + wc * 32 + 8 * fq;
        const float* bz = bgate + z * 2048 + col0;
        f32x4 bv[2][2];
#pragma unroll
        for (int bj = 0; bj < 2; ++bj)
#pragma unroll
            for (int n = 0; n < 2; ++n) bv[bj][n] = *(const f32x4*)(bz + bj * HALF + 4 * n);
        GAS bf16* rowp = (GAS bf16*)S + (size_t)row0 * 2048 + col0; GAS unsigned char* rowp8 = (GAS unsigned char*)S + (size_t)row0 * 2048 + col0;
#pragma unroll
        for (int ai = 0; ai < 2; ++ai)
#pragma unroll
            for (int m = 0; m < 4; ++m) {
#pragma unroll
                for (int bj = 0; bj < 2; ++bj) {
                    const u32x4 sw = *(const GAS u32x4*)sp; sp += 8192; asm volatile("" : "+v"(sp));
                    f32x4 v0 = acc[ai][bj][m][0] + bv[bj][0], v1 = acc[ai][bj][m][1] + bv[bj][1];
#pragma unroll
                    for (int j = 0; j < 4; ++j) { v0[j] = __builtin_amdgcn_rcpf(1.0f + __builtin_amdgcn_exp2f(-1.4426950408889634f * v0[j])); v1[j] = __builtin_amdgcn_rcpf(1.0f + __builtin_amdgcn_exp2f(-1.4426950408889634f * v1[j])); }
                    v0[0] *= bflo(sw.x); v0[1] *= bfhi(sw.x); v0[2] *= bflo(sw.y); v0[3] *= bfhi(sw.y);
                    v1[0] *= bflo(sw.z); v1[1] *= bfhi(sw.z); v1[2] *= bflo(sw.w); v1[3] *= bfhi(sw.w);
                    if (z > 0 && !cx) { v0 += *(const GAS f32x4*)pq; v1 += *(const GAS f32x4*)(pq + 8192); }
                    if (z < 3 || cx) { *(GAS f32x4*)pq = v0; *(GAS f32x4*)(pq + 8192) = v1; }
                    else if (s8) { int w0 = __builtin_amdgcn_cvt_pk_fp8_f32(v0[0], v0[1], 0, false); w0 = __builtin_amdgcn_cvt_pk_fp8_f32(v0[2], v0[3], w0, true);
                        int w1 = __builtin_amdgcn_cvt_pk_fp8_f32(v1[0], v1[1], 0, false); w1 = __builtin_amdgcn_cvt_pk_fp8_f32(v1[2], v1[3], w1, true);
                        *(GAS u32x2*)(rowp8 + bj * HALF) = (u32x2){(unsigned)w0, (unsigned)w1}; }
                    else { u32x4 w; w.x = cvt_pk_bf16(v0[0], v0[1]); w.y = cvt_pk_bf16(v0[2], v0[3]); w.z = cvt_pk_bf16(v1[0], v1[1]); w.w = cvt_pk_bf16(v1[2], v1[3]);
                        *(GAS u32x4*)(rowp + bj * HALF) = w; }
                    pq += 16384; asm volatile("" : "+v"(pq));
                }
                rowp += (m == 3 ? (size_t)(HALF - 48) : (size_t)16) * 2048; rowp8 += (m == 3 ? (size_t)(HALF - 48) : (size_t)16) * 2048; asm volatile("" : "+v"(rowp), "+v"(rowp8));
                asm volatile("" ::: "memory"); }
    }
};
struct EpiOut {
    static constexpr bool PERM = false;
    float* Y; const float* xlat; const float* xctx; const float* mod_l; float alpha;
    __device__ __forceinline__ void operator()(const f32x4 (&acc)[2][2][4][2], const Unit& u, int wr, int wc, int fr, int fq) const {
        asm volatile("" : "+v"(fr), "+v"(fq));
        const int row0 = u.pm * BM + wr * 64 + fr, col0 = u.pn * BM + wc * 32 + 4 * fq;
        const float* xb = (u.pm < 64) ? xlat + (size_t)row0 * 2048 : xctx + (size_t)(row0 - 16384) * 2048;
        const float* ga = mod_l + (size_t)((u.pm < 64) ? (u.pm >> 4) : 4) * 12288 + 2 * 2048 + col0;
        f32x4 gv[2][2];
#pragma unroll
        for (int bj = 0; bj < 2; ++bj)
#pragma unroll
            for (int n = 0; n < 2; ++n) gv[bj][n] = *(const f32x4*)(ga + bj * HALF + n * 16);
#pragma unroll
        for (int ai = 0; ai < 2; ++ai)
#pragma unroll
            for (int m = 0; m < 4; ++m) { const size_t ro = (size_t)(ai * HALF + m * 16) * 2048 + col0; float* yp = Y + (size_t)row0 * 2048 + ro;
#pragma unroll
                for (int bj = 0; bj < 2; ++bj)
#pragma unroll
                    for (int n = 0; n < 2; ++n) { const f32x4 xv = *(const f32x4*)(xb + ro + bj * HALF + n * 16); *(f32x4*)(yp + bj * HALF + n * 16) = xv * alpha + gv[bj][n] * acc[ai][bj][m][n]; } }
    }
};

typedef int v8i_t __attribute__((ext_vector_type(8)));
typedef int v4i_t __attribute__((ext_vector_type(4)));
template <class Epi, class Sched, bool F8 = false>
__device__ __forceinline__ void gemm_phase(LAS unsigned char* lds, const Sched& S, const Epi& E, const int lda, const int ldb, const int tid) {
    constexpr int ESZ = F8 ? 1 : 2;
    int f8scale = 0x7c7c7c7c; asm volatile("" : "+v"(f8scale));
    const int wid = __builtin_amdgcn_readfirstlane(tid >> 6), lane = tid & 63, wr = wid >> 2, wc = wid & 3, fr = lane & 15, fq = lane >> 4;
    unsigned voffA[2], voffB[2];
#pragma unroll
    for (int i = 0; i < 2; ++i) { int R, C; stage_rc(tid * 16 + i * 8192, R, C); const int Rb = Epi::PERM ? ((R & ~31) + perm32(R & 31)) : R;
        voffA[i] = (unsigned)(R * lda * ESZ + C * 2); voffB[i] = (unsigned)(Rb * ldb * ESZ + C * 2); }
    const size_t kstep = (size_t)(BK * 2);
    const size_t hstepA = (size_t)HALF * lda * ESZ, hstepB = (size_t)HALF * ldb * ESZ;
    const unsigned ldsw = (unsigned)wid * 1024u;
    const int aoff = lds_byte(wr * 64 + fr, fq * 8), boff = lds_byte(wc * 32 + fr, fq * 8);
#define PG8_SA(b, h) (((b) * 2 + (h)) * HTB)
#define PG8_SB(b, h) ((4 + (b) * 2 + (h)) * HTB)
#define PG8_STAGE(bufoff, gbase, voff) do { _Pragma("unroll") for (int _i = 0; _i < 2; ++_i) \
        __builtin_amdgcn_global_load_lds((const unsigned*)((const char*)(gbase) + (voff)[_i]), (LAS unsigned*)(lds + (bufoff) + ldsw + _i * 8192), 16, 0, 0); } while (0)
#define PG8_LDA(dst, b, h) do { _Pragma("unroll") for (int m = 0; m < 4; ++m) _Pragma("unroll") for (int k = 0; k < 2; ++k) dst[m][k] = *(const LAS bf16x8*)(lds + PG8_SA(b, h) + aoff + m * 2048 + k * 1024); } while (0)
#define PG8_LDB(dst, b, h) do { _Pragma("unroll") for (int n = 0; n < 2; ++n) _Pragma("unroll") for (int k = 0; k < 2; ++k) dst[n][k] = *(const LAS bf16x8*)(lds + PG8_SB(b, h) + boff + n * 2048 + k * 1024); } while (0)
#define PG8_MMA(ai, bj, At, Bt) do { __builtin_amdgcn_s_setprio(1); _Pragma("unroll") for (int m = 0; m < 4; ++m) _Pragma("unroll") for (int n = 0; n < 2; ++n) { \
        if constexpr (F8) { const v8i_t wa_ = __builtin_shufflevector(__builtin_bit_cast(v4i_t, Bt[n][0]), __builtin_bit_cast(v4i_t, Bt[n][1]), 0, 1, 2, 3, 4, 5, 6, 7); \
            const v8i_t xa_ = __builtin_shufflevector(__builtin_bit_cast(v4i_t, At[m][0]), __builtin_bit_cast(v4i_t, At[m][1]), 0, 1, 2, 3, 4, 5, 6, 7); \
            asm volatile("v_mfma_scale_f32_16x16x128_f8f6f4 %0, %1, %2, %0, %3, %3 op_sel_hi:[0,0,0]" : "+v"(acc[ai][bj][m][n]) : "v"(wa_), "v"(xa_), "v"(f8scale)); } \
        else { _Pragma("unroll") for (int k = 0; k < 2; ++k) acc[ai][bj][m][n] = __builtin_amdgcn_mfma_f32_16x16x32_bf16(Bt[n][k], At[m][k], acc[ai][bj][m][n], 0, 0, 0); } } \
        __builtin_amdgcn_s_setprio(0); } while (0)
#define PG8_WAIT_V(n) asm volatile("s_waitcnt vmcnt(" #n ")" ::: "memory")
#define PG8_WAIT_L(n) asm volatile("s_waitcnt lgkmcnt(" #n ")" ::: "memory")
#define PG8_BAR __builtin_amdgcn_s_barrier()
#define PG8_SCHED __builtin_amdgcn_sched_barrier(0)
    Unit cur, nxt; int ui = 0;
    if (!S.next(0, cur)) return;
    f32x4 acc[2][2][4][2];
#pragma unroll
    for (int a = 0; a < 2; ++a)
#pragma unroll
        for (int b = 0; b < 2; ++b)
#pragma unroll
            for (int m = 0; m < 4; ++m)
#pragma unroll
                for (int n = 0; n < 2; ++n) acc[a][b][m][n] = (f32x4){0.f, 0.f, 0.f, 0.f};
    bf16x8 At[4][2], B0[2][2], B1[2][2];
    const char* cA; const char* cB; int nt; S.ptrs(cur, cA, cB, nt);
    PG8_STAGE(PG8_SB(0, 0), cB, voffB); PG8_STAGE(PG8_SB(0, 1), cB + hstepB, voffB); PG8_STAGE(PG8_SA(0, 0), cA, voffA); PG8_STAGE(PG8_SA(0, 1), cA + hstepA, voffA);
    if (wr == 1) PG8_BAR;
    PG8_WAIT_V(2); PG8_BAR;
    PG8_STAGE(PG8_SB(1, 0), cB + kstep, voffB); PG8_STAGE(PG8_SA(1, 0), cA + kstep, voffA); PG8_STAGE(PG8_SB(1, 1), cB + hstepB + kstep, voffB);
    PG8_WAIT_V(6); PG8_BAR;
    for (;;) {
        const bool has_next = S.next(ui + 1, nxt);
        const char* nA = cA; const char* nB = cB; int nnt = nt; if (has_next) S.ptrs(nxt, nA, nB, nnt);
        for (int t = 0; t < nt; t += 2) {
            const bool last = (t == nt - 2);
            const char* a1 = cA + (size_t)(t + 1) * kstep;
            const char* a2 = last ? nA : cA + (size_t)(t + 2) * kstep; const char* b2 = last ? nB : cB + (size_t)(t + 2) * kstep;
            const char* a3 = a2 + kstep; const char* b3 = b2 + kstep;
            PG8_LDB(B0, 0, 0); PG8_LDB(B1, 0, 1); PG8_SCHED; PG8_LDA(At, 0, 0); PG8_STAGE(PG8_SA(1, 1), a1 + hstepA, voffA);
            PG8_WAIT_V(8); PG8_WAIT_L(0); PG8_BAR; PG8_MMA(0, 0, At, B0); PG8_MMA(0, 1, At, B1); PG8_BAR; PG8_SCHED;
            PG8_LDA(At, 0, 1); PG8_STAGE(PG8_SB(0, 0), b2, voffB); PG8_STAGE(PG8_SB(0, 1), b2 + hstepB, voffB); PG8_STAGE(PG8_SA(0, 0), a2, voffA);
            PG8_WAIT_V(8); PG8_WAIT_L(0); PG8_BAR; PG8_MMA(1, 0, At, B0); PG8_MMA(1, 1, At, B1); PG8_BAR; PG8_SCHED;
            PG8_LDB(B0, 1, 0); PG8_LDB(B1, 1, 1); PG8_SCHED; PG8_LDA(At, 1, 0); PG8_STAGE(PG8_SA(0, 1), a2 + hstepA, voffA);
            PG8_WAIT_V(8); PG8_WAIT_L(0); PG8_BAR; PG8_MMA(0, 0, At, B0); PG8_MMA(0, 1, At, B1); PG8_BAR; PG8_SCHED;
            PG8_LDA(At, 1, 1); PG8_STAGE(PG8_SB(1, 0), b3, voffB); PG8_STAGE(PG8_SB(1, 1), b3 + hstepB, voffB); PG8_STAGE(PG8_SA(1, 0), a3, voffA);
            PG8_WAIT_V(8); PG8_WAIT_L(0); PG8_BAR; PG8_MMA(1, 0, At, B0); PG8_MMA(1, 1, At, B1); PG8_BAR; PG8_SCHED;
        }
        if (wr == 0) PG8_BAR;
        if constexpr (F8) asm volatile("s_nop 15\n\ts_nop 15" ::: "memory");
        E(acc, cur, wr, wc, fr, fq);
        if (!has_next) break;
#pragma unroll
        for (int a = 0; a < 2; ++a)
#pragma unroll
            for (int b = 0; b < 2; ++b)
#pragma unroll
                for (int m = 0; m < 4; ++m)
#pragma unroll
                    for (int n = 0; n < 2; ++n) acc[a][b][m][n] = (f32x4){0.f, 0.f, 0.f, 0.f};
        cur = nxt; cA = nA; cB = nB; nt = nnt; ++ui;
        if (wr == 1) PG8_BAR;
    }
    PG8_WAIT_V(0);
    PG8_BAR;
#undef PG8_SA
#undef PG8_SB
#undef PG8_STAGE
#undef PG8_LDA
#undef PG8_LDB
#undef PG8_MMA
#undef PG8_WAIT_V
#undef PG8_WAIT_L
#undef PG8_BAR
#undef PG8_SCHED
}
}
namespace att {
constexpr int NW = 8, QBLK = 32, KVBLK = 64;
#define SBAR() __builtin_amdgcn_sched_barrier(0)
__device__ __forceinline__ int crow(int r, int hi) { return (r & 3) + 8 * (r >> 2) + 4 * hi; }
__device__ __forceinline__ unsigned cvtpk(float lo, float hi) { unsigned r; asm volatile("v_cvt_pk_bf16_f32 %0, %1, %2" : "=v"(r) : "v"(lo), "v"(hi)); return r; }

struct Args {
    const bf16* Q; int ldq;
    const bf16* KV; int ld;
    int kc0, kc1, vc;
    bf16* O; int ldo;
    int o8;
    int n0, n1, row0, row1;
    float C, thr;
    int qrope, qpos0;
    float sinkl2; int has_sink;
    int wpos0;
    const float* T; int r0, kr0;
};

__device__ __forceinline__ void partialSM(f32x16& p0, f32x16& p1, float& m_reg, float& mn, float& alpha, const float C, const float thr) {
    float pmax = p0[0];
#pragma unroll
    for (int r = 1; r < 16; ++r) pmax = fmaxf(pmax, p0[r]);
#pragma unroll
    for (int r = 0; r < 16; ++r) pmax = fmaxf(pmax, p1[r]);
    { auto rr = __builtin_amdgcn_permlane32_swap(__float_as_uint(pmax), __float_as_uint(pmax), false, false);
      pmax = fmaxf(__uint_as_float(rr[0]), __uint_as_float(rr[1])); }
    if (__builtin_expect(__all(pmax - m_reg <= thr), 1)) { mn = m_reg; alpha = 1.f; }
    else { mn = fmaxf(m_reg, pmax); alpha = __builtin_amdgcn_exp2f((m_reg - mn) * C); m_reg = mn; }
    const float mnC = -mn * C;
#pragma unroll
    for (int r = 0; r < 16; ++r) p0[r] = fmaf(p0[r], C, mnC);
#pragma unroll
    for (int r = 0; r < 16; ++r) p1[r] = fmaf(p1[r], C, mnC);
#pragma unroll
    for (int r = 0; r < 16; ++r) p0[r] = __builtin_amdgcn_exp2f(p0[r]);
}
__device__ __forceinline__ void finishSM(f32x16& p0, f32x16& p1, float alpha, float& l_reg, bf16x8& pa0, bf16x8& pa1, bf16x8& pa2, bf16x8& pa3) {
#pragma unroll
    for (int r = 0; r < 16; ++r) p1[r] = __builtin_amdgcn_exp2f(p1[r]);
    float ps = 0;
#pragma unroll
    for (int r = 0; r < 16; ++r) ps += p0[r];
#pragma unroll
    for (int r = 0; r < 16; ++r) ps += p1[r];
    { auto rr = __builtin_amdgcn_permlane32_swap(__float_as_uint(ps), __float_as_uint(ps), false, false);
      ps = __uint_as_float(rr[0]) + __uint_as_float(rr[1]); }
    l_reg = l_reg * alpha + ps;
#define PK4(P, BASE, OUT) do { unsigned a0 = cvtpk(P[BASE + 0], P[BASE + 1]), a1 = cvtpk(P[BASE + 2], P[BASE + 3]);   \
    unsigned b0 = cvtpk(P[BASE + 4], P[BASE + 5]), b1 = cvtpk(P[BASE + 6], P[BASE + 7]);                              \
    auto r0 = __builtin_amdgcn_permlane32_swap(a0, b0, false, false); auto r1 = __builtin_amdgcn_permlane32_swap(a1, b1, false, false); \
    u32x4 w = {r0[0], r1[0], r0[1], r1[1]}; OUT = *reinterpret_cast<bf16x8*>(&w); } while (0)
    PK4(p0, 0, pa0); PK4(p0, 8, pa1); PK4(p1, 0, pa2); PK4(p1, 8, pa3);
#undef PK4
}
template <int DK> __device__ __forceinline__ int kswz(int row, int ch) { return row * (DK * 2) + ((ch ^ (row & 7)) << 4); }
template <int DK, int QREG> __device__ __forceinline__ void qkt(f32x16& p0, f32x16& p1, const LAS char* Ks, const bf16x8* qr, const LAS char* qx, int r32, int hi) {
    p0 = f32x16{}; p1 = f32x16{};
#pragma unroll
    for (int d0 = 0; d0 < DK / 16; ++d0) { const int ch = d0 * 2 + hi;
        const bf16x8 b0 = *(const LAS bf16x8*)(Ks + kswz<DK>(r32, ch));
        const bf16x8 b1 = *(const LAS bf16x8*)(Ks + kswz<DK>(32 + r32, ch));
        bf16x8 q; if constexpr (true) { if (d0 < QREG) q = qr[d0 < QREG ? d0 : 0]; else q = *(const LAS bf16x8*)(qx + (d0 - QREG) * 1024); }
        p0 = __builtin_amdgcn_mfma_f32_32x32x16_bf16(b0, q, p0, 0, 0, 0);
        p1 = __builtin_amdgcn_mfma_f32_32x32x16_bf16(b1, q, p1, 0, 0, 0); }
}
template <int NCB> __device__ __forceinline__ int v_st(int k, int c) { const int kk = (k & ~0xC) | ((k & 4) << 1) | ((k & 8) >> 1); return ((kk >> 3) * NCB + (c >> 5)) * 512 + ((kk & 7) * 32 + (c & 31)) * 2; }
__device__ __forceinline__ int v_rd_base(int lane) { return ((lane & 3) << 3) | (((lane >> 2) & 3) << 6) | (((lane >> 4) & 1) << 5) | (((lane >> 5) & 1) << 8); }
template <int OFF> __device__ __forceinline__ s16x4 tr_read(int vb) { s16x4 r; asm volatile("ds_read_b64_tr_b16 %0, %1 offset:%2" : "=&v"(r) : "v"(vb), "i"(OFF) : "memory"); return r; }
template <int D0, int NCB> __device__ __forceinline__ void pv_one(f32x16& od, int vb, bf16x8 pa0, bf16x8 pa1, bf16x8 pa2, bf16x8 pa3) {
#define VOFF(ks, half) (D0 * 512 + (ks) * (2 * NCB * 512) + (half) * (NCB * 512))
    const s16x4 l0 = tr_read<VOFF(0, 0)>(vb), h0 = tr_read<VOFF(0, 1)>(vb), l1 = tr_read<VOFF(1, 0)>(vb), h1 = tr_read<VOFF(1, 1)>(vb);
    const s16x4 l2 = tr_read<VOFF(2, 0)>(vb), h2 = tr_read<VOFF(2, 1)>(vb), l3 = tr_read<VOFF(3, 0)>(vb), h3 = tr_read<VOFF(3, 1)>(vb);
#undef VOFF
    asm volatile("s_waitcnt lgkmcnt(0)" ::: "memory"); SBAR();
#define PK(L, H) (bf16x8){L[0], L[1], L[2], L[3], H[0], H[1], H[2], H[3]}
    od = __builtin_amdgcn_mfma_f32_32x32x16_bf16(pa0, PK(l0, h0), od, 0, 0, 0);
    od = __builtin_amdgcn_mfma_f32_32x32x16_bf16(pa1, PK(l1, h1), od, 0, 0, 0);
    od = __builtin_amdgcn_mfma_f32_32x32x16_bf16(pa2, PK(l2, h2), od, 0, 0, 0);
    od = __builtin_amdgcn_mfma_f32_32x32x16_bf16(pa3, PK(l3, h3), od, 0, 0, 0);
#undef PK
}
template <int NCB> __device__ __forceinline__ void pv_all(f32x16* o, int vb, bf16x8 pa0, bf16x8 pa1, bf16x8 pa2, bf16x8 pa3) {
    pv_one<0, NCB>(o[0], vb, pa0, pa1, pa2, pa3); pv_one<1, NCB>(o[1], vb, pa0, pa1, pa2, pa3);
    if constexpr (NCB == 4) { pv_one<2, NCB>(o[2], vb, pa0, pa1, pa2, pa3); pv_one<3, NCB>(o[3], vb, pa0, pa1, pa2, pa3); }
}

template <int MODE> __device__ __forceinline__ void apply_mask(f32x16& p0, f32x16& p1, const Args& a, int j, int wid, int r32, int hi) {
    if constexpr (MODE == 1) {
        if (j < a.n0) return;
        const int kp0 = a.wpos0 + 64 * (j - a.n0), qw0 = a.qpos0 + wid * 32;
        if (kp0 + 63 - qw0 <= 128 && qw0 + 31 - kp0 <= 128) return;
        const int dd0 = kp0 - (qw0 + r32) + 4 * hi + 128;
#pragma unroll
        for (int r = 0; r < 16; ++r) { const int dd = dd0 + (r & 3) + 8 * (r >> 2);
            p0[r] = ((unsigned)dd <= 256u) ? p0[r] : -1e30f; p1[r] = ((unsigned)(dd + 32) <= 256u) ? p1[r] : -1e30f; }
    } else if constexpr (MODE == 2) {
        if (j < a.n0) return;
        const int kr = a.kr0 + (j - a.n0), qr = a.r0 + (wid >> 1);
        int rs = qr - 4; rs = rs < 0 ? 0 : (rs > 56 ? 56 : rs);
        if (kr < rs || kr >= rs + 8) {
#pragma unroll
            for (int r = 0; r < 16; ++r) { p0[r] = -1e30f; p1[r] = -1e30f; }
            return; }
        const int dr = kr - qr + 7, qc = (wid & 1) * 32 + r32;
        const float* tb = a.T + ((size_t)(dr * 64 + qc)) * 64 + 4 * hi;
#pragma unroll
        for (int g = 0; g < 4; ++g) { const f32x4 t0 = *(const f32x4*)(tb + 8 * g), t1 = *(const f32x4*)(tb + 32 + 8 * g);
#pragma unroll
            for (int i = 0; i < 4; ++i) { p0[4 * g + i] += t0[i]; p1[4 * g + i] += t1[i]; }
            asm volatile("" ::: "memory"); }
    }
}

template <int DK, int DV, int MODE, int SDEPTH>
__device__ __forceinline__ void attn_unit(const Args& a, LAS char* lds, const int tid) {
    constexpr int NKC = DK / 8, NVC = DV / 8, KPT = DK / 64, VPT = DV / 64, NCB = DV / 32, ND0 = DK / 16, QREG = (ND0 > 8 ? 4 : ND0);
    constexpr int SHM_K = 64 * DK * 2, SHM_V = 64 * DV * 2;
    const int wid = __builtin_amdgcn_readfirstlane(tid >> 6), lane = tid & 63, r32 = lane & 31, hi = lane >> 5;
    LAS char* V_lds = lds; LAS char* K_lds = lds + 2 * SHM_V;
    LAS float* ws = (LAS float*)(lds + 2 * SHM_V + 2 * SHM_K) + wid * 64; LAS float* li_l = ws; LAS float* al_l = ws + 32;
    LAS char* qx = lds + 2 * SHM_V + 2 * SHM_K + NW * 256 + wid * ((ND0 - QREG) * 1024) + lane * 16;
    float m_reg = -1e30f, l_reg = 0; f32x16 o[NCB]; bf16x8 qr[ND0];
#pragma unroll
    for (int d = 0; d < NCB; ++d) o[d] = f32x16{};
    const bf16* Qw = a.Q + (long)(wid * QBLK + r32) * a.ldq + hi * 8;
#pragma unroll
    for (int d0 = 0; d0 < ND0; ++d0) qr[d0] = *(const bf16x8*)(Qw + d0 * 16);
    if constexpr (DK == 192) {
        if (a.qrope) {
            const int t = a.qpos0 + wid * QBLK + r32; const float prow = (float)(t >> 6), pcol = (float)(t & 63);
#pragma unroll
            for (int dd = 0; dd < 2; ++dd) {
                bf16x8 x1 = qr[8 + dd], x2 = qr[10 + dd]; const float pos = dd ? pcol : prow;
#pragma unroll
                for (int e = 0; e < 8; ++e) { const float inv = __builtin_amdgcn_exp2f(-(float)(hi * 8 + e) * (13.287712379549449f / 16.0f)); const float ang = pos * inv;
                    const float c = __cosf(ang), s = __sinf(ang); const float f1 = bf2f((unsigned short)x1[e]), f2 = bf2f((unsigned short)x2[e]);
                    x1[e] = (short)f2bf(f1 * c - f2 * s); x2[e] = (short)f2bf(f1 * s + f2 * c); }
                qr[8 + dd] = x1; qr[10 + dd] = x2; }
        }
#pragma unroll
        for (int d0 = QREG; d0 < ND0; ++d0) *(LAS bf16x8*)(qx + (d0 - QREG) * 1024) = qr[d0];
        asm volatile("s_waitcnt lgkmcnt(0)" ::: "memory");
    }
    int koff[KPT], klds[KPT], voff[VPT], vlds[VPT];
#pragma unroll
    for (int i = 0; i < KPT; ++i) { const int q = tid + 512 * i, row = q / NKC, ch = q % NKC; koff[i] = row * a.ld + (ch < 16 ? a.kc0 + 8 * ch : a.kc1 + 8 * (ch - 16)); klds[i] = kswz<DK>(row, ch); }
#pragma unroll
    for (int i = 0; i < VPT; ++i) { const int q = tid + 512 * i, row = q / NVC, ch = q % NVC; voff[i] = row * a.ld + a.vc + 8 * ch; vlds[i] = v_st<NCB>(row, 8 * ch); }
    const int vb0 = (int)(uintptr_t)V_lds + v_rd_base(lane);
    bf16x8 sk[SDEPTH][KPT], sv[SDEPTH][VPT];
    const int NT = a.n0 + a.n1;
#define TROW(j) ((j) < a.n0 ? a.row0 + 64 * (j) : a.row1 + 64 * ((j) - a.n0))
#define SLOAD(i, j) do { const bf16* _b = a.KV + (long)TROW(j) * a.ld; \
    _Pragma("unroll") for (int _k = 0; _k < VPT; ++_k) sv[i][_k] = *(const bf16x8*)(_b + voff[_k]); \
    _Pragma("unroll") for (int _k = 0; _k < KPT; ++_k) sk[i][_k] = *(const bf16x8*)(_b + koff[_k]); } while (0)
#define SWRITE(b, i) do { \
    _Pragma("unroll") for (int _k = 0; _k < VPT; ++_k) *(LAS bf16x8*)(V_lds + (b) * SHM_V + vlds[_k]) = sv[i][_k]; \
    _Pragma("unroll") for (int _k = 0; _k < KPT; ++_k) *(LAS bf16x8*)(K_lds + (b) * SHM_K + klds[_k]) = sk[i][_k]; } while (0)
#define SWAIT() do { if constexpr (SDEPTH == 2) asm volatile("s_waitcnt vmcnt(%0)" :: "n"(KPT + VPT) : "memory"); else asm volatile("s_waitcnt vmcnt(0)" ::: "memory"); } while (0)
#define RESC(al) do { if (__any((al) < 1.f)) { if (hi == 0) al_l[r32] = (al); asm volatile("s_waitcnt lgkmcnt(0)" ::: "memory"); \
    _Pragma("unroll") for (int d = 0; d < NCB; ++d) _Pragma("unroll") for (int r = 0; r < 16; ++r) o[d][r] *= al_l[crow(r, hi)]; } } while (0)
    f32x16 pA0, pA1, pB0, pB1; float mnA, mnB, alA, alB; bf16x8 pa0, pa1, pa2, pa3;
    constexpr int SE = 0, SO = SDEPTH - 1;
    SLOAD(SE, 0); asm volatile("s_waitcnt vmcnt(0)" ::: "memory"); SWRITE(0, SE); __syncthreads();
    qkt<DK, QREG>(pA0, pA1, K_lds, qr, qx, r32, hi); apply_mask<MODE>(pA0, pA1, a, 0, wid, r32, hi); partialSM(pA0, pA1, m_reg, mnA, alA, a.C, a.thr);
    SLOAD(SO, 1); if constexpr (SDEPTH == 2) { if (2 < NT) SLOAD(SE, 2); }
    SWAIT(); SWRITE(1, SO); __syncthreads();
    for (int j = 1; j + 1 < NT; j += 2) {
        SBAR(); qkt<DK, QREG>(pB0, pB1, K_lds + SHM_K, qr, qx, r32, hi);
        finishSM(pA0, pA1, alA, l_reg, pa0, pa1, pa2, pa3); SBAR();
        SLOAD(SO, j + SDEPTH); SBAR();
        pv_all<NCB>(o, vb0, pa0, pa1, pa2, pa3); if constexpr (MODE != 0) SBAR(); apply_mask<MODE>(pB0, pB1, a, j, wid, r32, hi); if constexpr (MODE != 0) SBAR(); partialSM(pB0, pB1, m_reg, mnB, alB, a.C, a.thr);
        __syncthreads(); SWAIT(); SWRITE(0, SE);
        RESC(alB); __syncthreads();
        SBAR(); qkt<DK, QREG>(pA0, pA1, K_lds, qr, qx, r32, hi);
        finishSM(pB0, pB1, alB, l_reg, pa0, pa1, pa2, pa3); SBAR();
        if (SDEPTH == 1 || j + 3 < NT) SLOAD(SE, j + 1 + SDEPTH); SBAR();
        pv_all<NCB>(o, vb0 + SHM_V, pa0, pa1, pa2, pa3); if constexpr (MODE != 0) SBAR(); apply_mask<MODE>(pA0, pA1, a, j + 1, wid, r32, hi); if constexpr (MODE != 0) SBAR(); partialSM(pA0, pA1, m_reg, mnA, alA, a.C, a.thr);
        __syncthreads(); SWAIT(); SWRITE(1, SO);
        RESC(alA); __syncthreads();
    }
    SBAR(); qkt<DK, QREG>(pB0, pB1, K_lds + SHM_K, qr, qx, r32, hi);
    finishSM(pA0, pA1, alA, l_reg, pa0, pa1, pa2, pa3); SBAR();
    pv_all<NCB>(o, vb0, pa0, pa1, pa2, pa3); if constexpr (MODE != 0) SBAR(); apply_mask<MODE>(pB0, pB1, a, NT - 1, wid, r32, hi); if constexpr (MODE != 0) SBAR(); partialSM(pB0, pB1, m_reg, mnB, alB, a.C, a.thr);
    __syncthreads(); RESC(alB);
    finishSM(pB0, pB1, alB, l_reg, pa0, pa1, pa2, pa3); SBAR();
    pv_all<NCB>(o, vb0 + SHM_V, pa0, pa1, pa2, pa3);
    if constexpr (MODE == 1) { if (a.has_sink) l_reg += __builtin_amdgcn_exp2f(a.sinkl2 - m_reg * a.C); }
    if (hi == 0) li_l[r32] = l_reg; asm volatile("s_waitcnt lgkmcnt(0)" ::: "memory");
    float rli[16];
#pragma unroll
    for (int r = 0; r < 16; ++r) rli[r] = __builtin_amdgcn_rcpf(li_l[crow(r, hi)]);
    bf16* Ow = a.O + (long)(wid * QBLK) * a.ldo;
#pragma unroll
    for (int r = 0; r < 16; ++r) { const int orow = crow(r, hi);
#pragma unroll
        for (int d0 = 0; d0 < NCB; ++d0) { const float ov = o[d0][r] * rli[r];
            if (a.o8) ((unsigned char*)a.O)[(long)(wid * QBLK + orow) * a.ldo + d0 * 32 + r32] = (unsigned char)(__builtin_amdgcn_cvt_pk_fp8_f32(ov, ov, 0, false) & 0xff);
            else Ow[(long)orow * a.ldo + d0 * 32 + r32] = f2bf(ov); } }
    __syncthreads();
#undef TROW
#undef SLOAD
#undef SWRITE
#undef SWAIT
#undef RESC
}
#undef SBAR
}
constexpr int DM = 2048, NBATCH = 4, SEQ = 4096, NCTX = 256, DEPTH = 2;
constexpr int ML = NBATCH * SEQ, MC = NBATCH * NCTX, MT = ML + MC;
constexpr int INW = 3904, UW = 4096, QW = 1856;
constexpr int MODW = 6 * DM;
constexpr float LN_EPS = 1e-5f, RMS_EPS = 1e-6f;
constexpr float ALPHA = 1.4142135623730951f;
constexpr float LOG2E = 1.4426950408889634f;
constexpr float A_SCALE = 0.07216878364870323f, B_SCALE = 0.125f, C_SCALE = 0.08838834764831845f, D_SCALE = 0.08838834764831845f;
constexpr int U_CQ = 0, U_CKV = 384, U_KR = 512, U_BQ = 576, U_BK = 1088, U_BV = 1216, U_CQQ = 1344, U_CK = 1856, U_CV = 2368, U_DQ = 2880, U_DK = 3392, U_DV = 3648;
constexpr int QA_Q = 0, QA_KV = 768, QA_KR = 1792;

#ifndef F8_OUT
#define F8_OUT 1
#endif
#ifndef F8_PQ
#define F8_PQ 0
#endif
#ifndef F8_IN
#define F8_IN 1
#endif
#ifndef F8_MERGE
#define F8_MERGE 1
#endif
constexpr size_t MiB = 1u << 20;
constexpr size_t WS_CTL = 0, CTL_ZERO_BYTES = 1 * MiB;
constexpr size_t WS_MOD = 1 * MiB;
constexpr size_t WS_CTAB = 2 * MiB;
constexpr size_t WS_SUBK = 4 * MiB;
constexpr size_t WS_WUP = 5 * MiB;
constexpr size_t WS_WIN = 9 * MiB;
constexpr size_t WS_WC = 41 * MiB;
constexpr size_t WS_WO = 121 * MiB;
constexpr size_t WS_WPQ = 137 * MiB;
constexpr size_t WS_PU = 153 * MiB;
constexpr size_t WS_PV = 281 * MiB;
constexpr size_t WS_BUFA = 409 * MiB;
constexpr size_t WS_BUFB = 477 * MiB;
constexpr size_t WS_UREG = 545 * MiB;
constexpr size_t WS_QKVA = 681 * MiB;
constexpr size_t WS_OQP = 743 * MiB;
constexpr size_t WS_XRES = 811 * MiB;
constexpr size_t WS_EIDX = 947 * MiB;
constexpr size_t WS_EG = 956 * MiB;
constexpr size_t WS_MODP = 965 * MiB;
constexpr size_t WS_SCU = 973 * MiB, WS_SCV = WS_SCU + 2 * 16384 * 4;
constexpr size_t WS_DBG = 973 * MiB + 512 * 1024;
constexpr size_t WS_H8 = 974 * MiB;
constexpr size_t WS_END = 1008 * MiB;
constexpr size_t STASH_WG = 131072, P_WG = 262144, WS_STASH = WS_UREG, WS_P = WS_UREG + 32 * MiB, WS_CP = WS_UREG + 96 * MiB;
constexpr int CW_TMO = 0, CW_BAR = 4096;

constexpr int NWAVES = 8;
constexpr int RING_OFF = 0, RING_BYTES = 155648;
constexpr int LDSCTL_OFF = RING_BYTES, MISC_OFF = LDSCTL_OFF + 320;
constexpr int LDS_BYTES = 157696;

#define RLX_AGENT __ATOMIC_RELAXED, __HIP_MEMORY_SCOPE_AGENT
#define LDS_WAIT() asm volatile("s_waitcnt lgkmcnt(0)" ::: "memory")
#define VM_WAIT() asm volatile("s_waitcnt vmcnt(0)" ::: "memory")

#define XB_TMO      128
#define XB_XCNT(j)  (256  + 64 * (j))
#define XB_XSUB(j)  (1280 + 64 * (j))
#define XB_XGEN(j)  (2304 + 64 * (j))
#define XB_TOP      3328
#define XB_TOPGEN   3392
#define XCD_BAR_WORDS 3456
#define XB_SPIN_CAP (1u << 22)
__device__ __forceinline__ unsigned xb_ld(unsigned* p)              { return __hip_atomic_load(p, __ATOMIC_RELAXED, __HIP_MEMORY_SCOPE_AGENT); }
__device__ __forceinline__ unsigned xb_add(unsigned* p, unsigned v) { return __hip_atomic_fetch_add(p, v, __ATOMIC_RELAXED, __HIP_MEMORY_SCOPE_AGENT); }
__device__ __forceinline__ unsigned xb_xcc_id() { return (unsigned)__builtin_amdgcn_s_getreg((3 << 11) | 20) & 0xFu; }
#define XB_SPIN(cond, bar) do { unsigned _sp = 0; while (cond) { __builtin_amdgcn_s_sleep(1); \
    if ((++_sp & 255u) == 0u) { if (xb_ld(&(bar)[XB_TMO])) break; if (_sp > XB_SPIN_CAP) { atomicAdd(&(bar)[XB_TMO], 1u); break; } } } } while (0)
struct XcdBarrier { unsigned* bar; unsigned x; volatile LAS unsigned* st; };
__device__ __forceinline__ XcdBarrier xcd_barrier_post(unsigned* bar, volatile LAS unsigned* st) {
    XcdBarrier b; b.bar = bar; b.x = xb_xcc_id(); b.st = st;
    if (threadIdx.x == 0) (void)xb_add(&bar[XB_XCNT(b.x)], 1u);
    return b;
}
__device__ __forceinline__ void xcd_barrier_complete(unsigned* bar, unsigned x, unsigned& nloc, unsigned& nx) {
    const unsigned G = gridDim.x * gridDim.y * gridDim.z;
    unsigned sum, cnt, mine, sp = 0u;
    for (;;) {
        sum = 0u; cnt = 0u; mine = 0u;
#pragma unroll
        for (unsigned j = 0; j < 16; ++j) { const unsigned c = xb_ld(&bar[XB_XCNT(j)]); sum += c; cnt += (c > 0u) ? 1u : 0u; mine = (j == x) ? c : mine; }
        if (sum == G) break;
        __builtin_amdgcn_s_sleep(1);
        if ((++sp & 255u) == 0u) { if (xb_ld(&bar[XB_TMO])) break; if (sp > XB_SPIN_CAP) { atomicAdd(&bar[XB_TMO], 1u); break; } }
    }
    nloc = mine > 0u ? mine : 1u; nx = cnt > 0u ? cnt : 1u;
}
__device__ __forceinline__ void xcd_barrier(const XcdBarrier& b) {
    asm volatile("s_waitcnt vmcnt(0)" ::: "memory");
    __syncthreads();
    if (threadIdx.x == 0) {
        unsigned* bar = b.bar;
        __builtin_amdgcn_s_waitcnt(0);
        unsigned nloc = b.st[0], nx = b.st[1];
        if (nloc == 0u) { xcd_barrier_complete(bar, b.x, nloc, nx); b.st[0] = nloc; b.st[1] = nx; }
        const unsigned old = xb_add(&bar[XB_XSUB(b.x)], 1u);
        const unsigned gen = old / nloc;
        if (old + 1u == (gen + 1u) * nloc) {
            __builtin_amdgcn_fence(__ATOMIC_RELEASE, "agent");
            asm volatile("s_waitcnt vmcnt(0)" ::: "memory");
            const unsigned og = xb_add(&bar[XB_TOP], 1u);
            const unsigned tg = og / nx;
            if (og + 1u == (tg + 1u) * nx) xb_add(&bar[XB_TOPGEN], 1u);
            else XB_SPIN(xb_ld(&bar[XB_TOPGEN]) == tg, bar);
            __builtin_amdgcn_fence(__ATOMIC_ACQUIRE, "agent");
            xb_add(&bar[XB_XGEN(b.x)], 1u);
            asm volatile("s_waitcnt vmcnt(0)" ::: "memory");
        } else {
            XB_SPIN(xb_ld(&bar[XB_XGEN(b.x)]) == gen, bar);
            __builtin_amdgcn_fence(__ATOMIC_ACQUIRE, "agent");
            asm volatile("s_waitcnt vmcnt(0)" ::: "memory");
        }
    }
    __syncthreads();
}

struct In {
    const float *x, *c, *ctx, *c_ctx, *w_ada, *b_ada, *w_in, *a_q_norm, *a_kv_norm, *a_w_uq, *a_w_ukv, *b_sink, *c_rpb, *d_q_norm, *d_k_norm,
                *w_branch, *w_gate, *b_gate, *w_out, *ln1_g, *ln1_b, *ln2_g, *ln2_b, *peer_w_q, *peer_sub_keys, *peer_u, *peer_v;
};
struct Args { In in; float* out; unsigned char* ws; int ph_lo, ph_hi, li, pad; };
struct Frame { LAS unsigned char* lds; int tid, lane, wave, vcu, G; GAS unsigned char* ws; };
template <class T> __device__ __forceinline__ T* G(T* p) { return (T*)(GAS T*)p; }
typedef const __attribute__((address_space(4))) Args& KA;
typedef const __attribute__((address_space(4))) Args* KAP;
__device__ __forceinline__ KAP kargs() { KAP p = (KAP)__builtin_amdgcn_kernarg_segment_ptr(); asm volatile("" : "+s"(p)); return p; }

__device__ __forceinline__ float wave_sum(float v) {
#pragma unroll
    for (int o = 1; o < 64; o <<= 1) v += __shfl_xor(v, o);
    return v;
}
__device__ __forceinline__ unsigned pk2(float lo, float hi) { return cvt_pk_bf16(lo, hi); }
__device__ __forceinline__ float silu_f(float v) { return v / (1.0f + __expf(-v)); }

__device__ __forceinline__ void p0_transpose_item(const float* W, int ldw, int nblk, bf16* dst, int dpitch, int row_off, int col_off, const float* gain, LAS float* scr, int item, int lane, int f8) {
    const int kb = item / nblk, nb = item % nblk, k0 = 64 * kb, n0 = 32 * nb;
#pragma unroll 8
    for (int i = 0; i < 32; ++i) { const int kk = 2 * i + (lane >> 5); float v = W[(size_t)(k0 + kk) * ldw + n0 + (lane & 31)]; if (gain) v *= gain[k0 + kk]; scr[kk * 33 + (lane & 31)] = v; }
    LDS_WAIT(); asm volatile("" ::: "memory");
    const int c = lane & 7;
#pragma unroll
    for (int j = 0; j < 4; ++j) { const int n = (lane >> 3) + 8 * j; const LAS float* s = scr + (8 * c) * 33 + n;
        if (f8) {
            int w0 = __builtin_amdgcn_cvt_pk_fp8_f32(s[0 * 33] * 64.f, s[1 * 33] * 64.f, 0, false); w0 = __builtin_amdgcn_cvt_pk_fp8_f32(s[2 * 33] * 64.f, s[3 * 33] * 64.f, w0, true);
            int w1 = __builtin_amdgcn_cvt_pk_fp8_f32(s[4 * 33] * 64.f, s[5 * 33] * 64.f, 0, false); w1 = __builtin_amdgcn_cvt_pk_fp8_f32(s[6 * 33] * 64.f, s[7 * 33] * 64.f, w1, true);
            *(GAS u32x2*)((GAS unsigned char*)dst + (size_t)(row_off + n0 + n) * dpitch + col_off + k0 + 8 * c) = (u32x2){(unsigned)w0, (unsigned)w1}; }
        else { u32x4 o; o.x = pk2(s[0 * 33], s[1 * 33]); o.y = pk2(s[2 * 33], s[3 * 33]); o.z = pk2(s[4 * 33], s[5 * 33]); o.w = pk2(s[6 * 33], s[7 * 33]);
        *(GAS u32x4*)(dst + (size_t)(row_off + n0 + n) * dpitch + col_off + k0 + 8 * c) = o; } }
    LDS_WAIT(); asm volatile("" ::: "memory");
}
struct TJob { const float* W; int K, N; bf16* dst; int dpitch, row_off, col_off; const float* gain; int f8; };
__device__ __forceinline__ int tjob_get(KA A, int job, TJob& t) {
    const int l = job / 13, j = job % 13; GAS unsigned char* ws = (GAS unsigned char*)A.ws; t.gain = nullptr; t.row_off = 0; t.col_off = 0; t.f8 = 0;
    if (j == 0) { t.W = G(A.in.w_in) + (size_t)l * DM * INW; t.K = DM; t.N = INW; t.dst = F8_IN ? (bf16*)((unsigned char*)(ws + WS_WIN) + (size_t)l * UW * DM) : (bf16*)(ws + WS_WIN) + (size_t)l * UW * DM; t.dpitch = DM; t.f8 = F8_IN; }
    else if (j <= 4) { const int z = j - 1; t.W = G(A.in.w_gate) + ((size_t)l * 4 + z) * DM * DM; t.K = DM; t.N = DM; t.dst = F8_MERGE ? (bf16*)((unsigned char*)(ws + WS_WC) + ((size_t)l * 4 + z) * DM * 2560) : (bf16*)(ws + WS_WC) + ((size_t)l * 4 + z) * DM * 2560; t.dpitch = 2560; t.f8 = F8_MERGE; }
    else if (j <= 8) { const int z = j - 5; t.W = G(A.in.w_branch) + ((size_t)l * 4 + z) * 512 * DM; t.K = 512; t.N = DM; t.dst = F8_MERGE ? (bf16*)((unsigned char*)(ws + WS_WC) + ((size_t)l * 4 + z) * DM * 2560) : (bf16*)(ws + WS_WC) + ((size_t)l * 4 + z) * DM * 2560; t.dpitch = 2560; t.col_off = 2048; t.f8 = F8_MERGE; }
    else if (j == 9) { t.W = G(A.in.w_out) + (size_t)l * DM * DM; t.K = DM; t.N = DM; t.dst = (bf16*)((unsigned char*)(ws + WS_WO) + (size_t)l * DM * DM); t.dpitch = DM; t.f8 = F8_OUT; }
    else if (j == 10) { t.W = G(A.in.peer_w_q) + (size_t)l * DM * DM; t.K = DM; t.N = DM; t.dst = F8_PQ ? (bf16*)((unsigned char*)(ws + WS_WPQ) + (size_t)l * DM * DM) : (bf16*)(ws + WS_WPQ) + (size_t)l * DM * DM; t.dpitch = DM; t.f8 = F8_PQ; }
    else if (j == 11) { t.W = G(A.in.a_w_uq) + (size_t)l * 384 * 768; t.K = 384; t.N = 768; t.dst = (bf16*)(ws + WS_WUP) + (size_t)l * 1792 * 512; t.dpitch = 512; t.gain = G(A.in.a_q_norm) + l * 384; }
    else { t.W = G(A.in.a_w_ukv) + (size_t)l * 128 * 1024; t.K = 128; t.N = 1024; t.dst = (bf16*)(ws + WS_WUP) + (size_t)l * 1792 * 512; t.dpitch = 512; t.row_off = 768; t.col_off = 384; t.gain = G(A.in.a_kv_norm) + l * 128; }
    return (t.K / 64) * (t.N / 32);
}
__device__ __forceinline__ void p0_prologue(const Frame& F, KA A) {
    GAS unsigned char* ws = F.ws;
    const int gw = F.vcu * NWAVES + F.wave, NGW = F.G * NWAVES;
    const long gt = (long)gw * 64 + F.lane, NGT = (long)NGW * 64;
    {
        float* modp = (float*)(ws + WS_MODP);
        for (int it = gw; it < 2 * 16 * 48; it += NGW) {
            const int l = it / 768, ks = (it % 768) / 48, cg = it % 48, n = cg * 256 + F.lane * 4;
            const float* w = G(A.in.w_ada) + ((size_t)l * DM + ks * 128) * MODW + n;
            f32x4 acc[5];
#pragma unroll
            for (int r = 0; r < 5; ++r) acc[r] = (f32x4){0.f, 0.f, 0.f, 0.f};
#pragma unroll 8
            for (int k = 0; k < 128; ++k) {
                const f32x4 wv = *(const f32x4*)(w + (size_t)k * MODW);
                const int kk = ks * 128 + k;
#pragma unroll
                for (int r = 0; r < 5; ++r) { const float cv = (r < 4) ? G(A.in.c)[r * DM + kk] : G(A.in.c_ctx)[kk]; acc[r] += wv * silu_f(cv); }
            }
#pragma unroll
            for (int r = 0; r < 5; ++r) *(f32x4*)(modp + (((size_t)ks * 2 + l) * 5 + r) * MODW + n) = acc[r];
        }
    }
    {
        LAS float* scr = (LAS float*)(F.lds + RING_OFF + F.wave * 16384);
        int base = 0;
        for (int job = 0; job < 26; ++job) {
            TJob t; const int ni = tjob_get(A, job, t);
            int first = gw - (base % NGW); if (first < 0) first += NGW;
            for (int i = first; i < ni; i += NGW) p0_transpose_item(t.W, t.N, t.N / 32, t.dst, t.dpitch, t.row_off, t.col_off, t.gain, scr, i, F.lane, t.f8);
            base += ni;
        }
    }
    for (long i = gt; i < 2L * 192 * 2048 / 8; i += NGT) { const int l = (int)(i / (192 * 256)), r = (int)(i % (192 * 256));
        if (F8_IN) { if (r < 192 * 128) *(u32x4*)((unsigned char*)(ws + WS_WIN) + ((size_t)l * UW + 3904) * DM + (size_t)r * 16) = (u32x4){0u, 0u, 0u, 0u}; }
        else *(u32x4*)((bf16*)(ws + WS_WIN) + ((size_t)l * UW + 3904) * DM + (size_t)r * 8) = (u32x4){0u, 0u, 0u, 0u}; }
    for (long i = gt; i < 2L * 768 * 16; i += NGT) { const int l = (int)(i / (768 * 16)), r = (int)(i % (768 * 16)), row = r / 16, c8 = r % 16; *(u32x4*)((bf16*)(ws + WS_WUP) + ((size_t)l * 1792 + row) * 512 + 384 + c8 * 8) = (u32x4){0u, 0u, 0u, 0u}; }
    for (long i = gt; i < 2L * 1024 * 48; i += NGT) { const int l = (int)(i / (1024 * 48)), r = (int)(i % (1024 * 48)), row = r / 48, c8 = r % 48; *(u32x4*)((bf16*)(ws + WS_WUP) + ((size_t)l * 1792 + 768 + row) * 512 + c8 * 8) = (u32x4){0u, 0u, 0u, 0u}; }
    {
        const long n_sk = 2L * 8 * 2 * 128 * 128 / 8;
        for (long i = gt; i < n_sk; i += NGT) {
            const float* src = G(A.in.peer_sub_keys); bf16* dst = (bf16*)(ws + WS_SUBK);
            const f32x4 a = *(const f32x4*)(src + i * 8), b = *(const f32x4*)(src + i * 8 + 4);
            u32x4 o; o.x = pk2(a[0], a[1]); o.y = pk2(a[2], a[3]); o.z = pk2(b[0], b[1]); o.w = pk2(b[2], b[3]);
            *(u32x4*)(dst + i * 8) = o;
        }
        for (int r = gw; r < 4 * 16384; r += NGW) {
            const bool isu = r < 2 * 16384; const int row = isu ? r : r - 2 * 16384;
            const float* src = (isu ? G(A.in.peer_u) : G(A.in.peer_v)) + (size_t)row * 2048 + F.lane * 4;
            f32x4 v[8]; float am = 0.f;
#pragma unroll
            for (int q = 0; q < 8; ++q) { v[q] = __builtin_nontemporal_load((const f32x4*)(src + q * 256));
                am = fmaxf(am, fmaxf(fmaxf(__builtin_fabsf(v[q][0]), __builtin_fabsf(v[q][1])), fmaxf(__builtin_fabsf(v[q][2]), __builtin_fabsf(v[q][3])))); }
#pragma unroll
            for (int o = 1; o < 64; o <<= 1) am = fmaxf(am, __shfl_xor(am, o));
            const float S = am > 0.f ? 6.0f / am : 1.0f;
            unsigned short* dst = (unsigned short*)(ws + (isu ? WS_PU : WS_PV)) + (size_t)row * 512 + F.lane;
#pragma unroll
            for (int q = 0; q < 8; ++q) { const f32x4 a = v[q] * S;
                unsigned w = __builtin_amdgcn_cvt_scalef32_pk_fp4_f32(0u, a[0], a[1], 1.0f, 0); w = __builtin_amdgcn_cvt_scalef32_pk_fp4_f32(w, a[2], a[3], 1.0f, 1);
                dst[q * 64] = (unsigned short)(w & 0xffffu); }
            if (F.lane == 0) ((float*)(ws + (isu ? WS_SCU : WS_SCV)))[row] = am > 0.f ? am * (1.0f / 6.0f) : 1.0f;
        }
    }
    {
        float* ct = (float*)(ws + WS_CTAB);
        for (long i = gt; i < 2L * 4 * 15 * 64 * 64; i += NGT) {
            const int kc = (int)(i & 63), qc = (int)((i >> 6) & 63), r = (int)(i >> 12), dr = r % 15, lh = r / 15;
            int cs = qc - 8; cs = cs < 0 ? 0 : (cs > 48 ? 48 : cs);
            int co = kc - qc + 15; co = co < 0 ? 0 : (co > 30 ? 30 : co);
            ct[i] = (kc >= cs && kc < cs + 16) ? G(A.in.c_rpb)[((size_t)lh * 15 + dr) * 31 + co] * (1.0f / C_SCALE) : -1e30f;
        }
    }
}
__device__ __forceinline__ void p1_modreduce(const Frame& F, KA A) {
    const long gt = ((long)F.vcu * NWAVES + F.wave) * 64 + F.lane, NGT = (long)F.G * NWAVES * 64;
    const float* modp = (const float*)(F.ws + WS_MODP); float* mod = (float*)(F.ws + WS_MOD);
    for (long i = gt; i < 2L * 5 * MODW; i += NGT) { const int n = (int)(i % MODW), l = (int)(i / (5 * MODW));
        float s = G(A.in.b_ada)[l * MODW + n];
#pragma unroll
        for (int ks = 0; ks < 16; ++ks) s += modp[(size_t)ks * 2 * 5 * MODW + i];
        mod[i] = s; }
}
__device__ __forceinline__ void p2_modulate0(const Frame& F, KA A) {
    const int gw = F.vcu * NWAVES + F.wave, NGW = F.G * NWAVES;
    const float* mod = (const float*)(F.ws + WS_MOD); bf16* H = (bf16*)(F.ws + WS_BUFA);
    for (int row = gw; row < MT; row += NGW) {
        const float* xr = row < ML ? G(A.in.x) + (size_t)row * DM : G(A.in.ctx) + (size_t)(row - ML) * DM;
        const float* mr = mod + (size_t)(row < ML ? (row >> 12) : 4) * MODW;
        f32x4 xa[4], xb[4], sa[4], sb[4], ca[4], cb[4];
#pragma unroll
        for (int j = 0; j < 4; ++j) { const int c = j * 512 + F.lane * 8; xa[j] = *(const f32x4*)(xr + c); xb[j] = *(const f32x4*)(xr + c + 4);
            sa[j] = *(const f32x4*)(mr + c); sb[j] = *(const f32x4*)(mr + c + 4); ca[j] = *(const f32x4*)(mr + DM + c); cb[j] = *(const f32x4*)(mr + DM + c + 4); }
        asm volatile("" ::: "memory");
#pragma unroll
        for (int j = 0; j < 4; ++j) { const int c = j * 512 + F.lane * 8;
            const f32x4 y0 = xa[j] * (ca[j] + 1.0f) + sa[j], y1 = xb[j] * (cb[j] + 1.0f) + sb[j];
            u32x4 o; o.x = pk2(y0[0], y0[1]); o.y = pk2(y0[2], y0[3]); o.z = pk2(y1[0], y1[1]); o.w = pk2(y1[2], y1[3]);
            *(u32x4*)(H + (size_t)row * DM + c) = o;
            if (F8_MERGE) { int w0 = __builtin_amdgcn_cvt_pk_fp8_f32(y0[0], y0[1], 0, false); w0 = __builtin_amdgcn_cvt_pk_fp8_f32(y0[2], y0[3], w0, true);
                int w1 = __builtin_amdgcn_cvt_pk_fp8_f32(y1[0], y1[1], 0, false); w1 = __builtin_amdgcn_cvt_pk_fp8_f32(y1[2], y1[3], w1, true);
                *(u32x2*)((unsigned char*)(F.ws + WS_H8) + (size_t)row * DM + c) = (u32x2){(unsigned)w0, (unsigned)w1}; } }
    }
}
__device__ __forceinline__ void rope_pair(float& x1, float& x2, float ang) { const float c = __cosf(ang), s = __sinf(ang); const float y1 = x1 * c - x2 * s, y2 = x1 * s + x2 * c; x1 = y1; x2 = y2; }
__device__ __forceinline__ void enorm_phase(const Frame& F, KA A, int l) {
    const int gw = F.vcu * NWAVES + F.wave, NGW = F.G * NWAVES, lane = F.lane;
    bf16* U = (bf16*)(F.ws + WS_UREG); bf16* QK = (bf16*)(F.ws + WS_QKVA);
    const float* gq = G(A.in.d_q_norm) + l * 128; const float* gk = G(A.in.d_k_norm) + l * 128;
    const float L2T = 13.287712379549449f;
    for (int row = gw; row < MT; row += NGW) {
        bf16* u = U + (size_t)row * UW;
        const bool lat = row < ML; const int t = row & 4095;
        const float prow = lat ? (float)(t >> 6) : 0.f, pcol = lat ? (float)(t & 63) : 0.f;
        const int j64 = lane & 31, hq = lane >> 5;
        unsigned wcq[3];
#pragma unroll
        for (int i = 0; i < 3; ++i) wcq[i] = ((const unsigned*)(u + U_CQ))[lane + 64 * i];
        const unsigned wkv = ((const unsigned*)(u + U_CKV))[lane];
        float kr1 = bf2f(u[U_KR + j64]), kr2 = bf2f(u[U_KR + 32 + j64]);
        float bq1[4], bq2[4];
#pragma unroll
        for (int i = 0; i < 4; ++i) { const bf16* q = u + U_BQ + (hq + 2 * i) * 64; bq1[i] = bf2f(q[j64]); bq2[i] = bf2f(q[32 + j64]); }
        float bk1 = bf2f(u[U_BK + hq * 64 + j64]), bk2 = bf2f(u[U_BK + hq * 64 + 32 + j64]);
        float dq1[4], dq2[4], dk1[2], dk2[2];
#pragma unroll
        for (int hd = 0; hd < 4; ++hd) { dq1[hd] = bf2f(u[U_DQ + hd * 128 + lane]); dq2[hd] = bf2f(u[U_DQ + hd * 128 + 64 + lane]); }
#pragma unroll
        for (int hd = 0; hd < 2; ++hd) { dk1[hd] = bf2f(u[U_DK + hd * 128 + lane]); dk2[hd] = bf2f(u[U_DK + hd * 128 + 64 + lane]); }
        const float gq1 = gq[lane], gq2 = gq[64 + lane], gk1 = gk[lane], gk2 = gk[64 + lane];
        asm volatile("" ::: "memory");
        float ss = 0.f;
#pragma unroll
        for (int i = 0; i < 3; ++i) { const float a = bflo(wcq[i]), b = bfhi(wcq[i]); ss += a * a + b * b; }
        const float rq = rsqrtf(wave_sum(ss) * (1.0f / 384.0f) + RMS_EPS);
        const float va = bflo(wkv), vb = bfhi(wkv);
        const float rkv = rsqrtf(wave_sum(va * va + vb * vb) * (1.0f / 128.0f) + RMS_EPS);
        const float ang64 = ((j64 < 16) ? prow : pcol) * __builtin_amdgcn_exp2f(-(float)(j64 & 15) * (L2T / 16.0f));
        const float ang128 = ((lane < 32) ? prow : pcol) * __builtin_amdgcn_exp2f(-(float)(lane & 31) * (L2T / 32.0f));
        rope_pair(kr1, kr2, ang64);
#pragma unroll
        for (int i = 0; i < 4; ++i) rope_pair(bq1[i], bq2[i], ang64);
        rope_pair(bk1, bk2, ang64);
#pragma unroll
        for (int hd = 0; hd < 4; ++hd) { const float rstd = rsqrtf(wave_sum(dq1[hd] * dq1[hd] + dq2[hd] * dq2[hd]) * (1.0f / 128.0f) + RMS_EPS);
            dq1[hd] = dq1[hd] * rstd * gq1; dq2[hd] = dq2[hd] * rstd * gq2; rope_pair(dq1[hd], dq2[hd], ang128); }
#pragma unroll
        for (int hd = 0; hd < 2; ++hd) { const float rstd = rsqrtf(wave_sum(dk1[hd] * dk1[hd] + dk2[hd] * dk2[hd]) * (1.0f / 128.0f) + RMS_EPS);
            dk1[hd] = dk1[hd] * rstd * gk1; dk2[hd] = dk2[hd] * rstd * gk2; rope_pair(dk1[hd], dk2[hd], ang128); }
#pragma unroll
        for (int i = 0; i < 3; ++i) ((unsigned*)(u + U_CQ))[lane + 64 * i] = pk2(bflo(wcq[i]) * rq, bfhi(wcq[i]) * rq);
        ((unsigned*)(u + U_CKV))[lane] = pk2(va * rkv, vb * rkv);
        if (lane < 32) { bf16* o = QK + (size_t)row * QW + QA_KR; o[lane] = f2bf(kr1); o[32 + lane] = f2bf(kr2); }
#pragma unroll
        for (int i = 0; i < 4; ++i) { bf16* q = u + U_BQ + (hq + 2 * i) * 64; q[j64] = f2bf(bq1[i]); q[32 + j64] = f2bf(bq2[i]); }
        { bf16* q = u + U_BK + hq * 64; q[j64] = f2bf(bk1); q[32 + j64] = f2bf(bk2); }
#pragma unroll
        for (int hd = 0; hd < 4; ++hd) { bf16* q = u + U_DQ + hd * 128; q[lane] = f2bf(dq1[hd]); q[64 + lane] = f2bf(dq2[hd]); }
#pragma unroll
        for (int hd = 0; hd < 2; ++hd) { bf16* q = u + U_DK + hd * 128; q[lane] = f2bf(dk1[hd]); q[64 + lane] = f2bf(dk2[hd]); }
    }
}
__device__ __forceinline__ void ln1_phase(const Frame& F, KA A, int l, int nrows, bf16* HF) {
    const int gw = F.vcu * NWAVES + F.wave, NGW = F.G * NWAVES, lane = F.lane;
    float* Y = (float*)(F.ws + WS_UREG); const float* mod = (const float*)(F.ws + WS_MOD) + (size_t)l * 5 * MODW;
    const float* g = G(A.in.ln1_g) + l * DM; const float* b = G(A.in.ln1_b) + l * DM;
    for (int row = gw; row < nrows; row += NGW) {
        float* y = Y + (size_t)row * DM; const float* mr = mod + (size_t)(row < ML ? (row >> 12) : 4) * MODW;
        f32x4 v[8], gg[8], bb[8], sc[8], sh[8]; float s = 0.f;
#pragma unroll
        for (int j = 0; j < 4; ++j) { const int c = j * 512 + lane * 8; v[2 * j] = *(const f32x4*)(y + c); v[2 * j + 1] = *(const f32x4*)(y + c + 4);
            gg[2 * j] = *(const f32x4*)(g + c); gg[2 * j + 1] = *(const f32x4*)(g + c + 4); bb[2 * j] = *(const f32x4*)(b + c); bb[2 * j + 1] = *(const f32x4*)(b + c + 4);
            sc[2 * j] = *(const f32x4*)(mr + 4 * DM + c); sc[2 * j + 1] = *(const f32x4*)(mr + 4 * DM + c + 4); sh[2 * j] = *(const f32x4*)(mr + 3 * DM + c); sh[2 * j + 1] = *(const f32x4*)(mr + 3 * DM + c + 4); }
        asm volatile("" ::: "memory");
#pragma unroll
        for (int j = 0; j < 8; ++j) s += (v[j][0] + v[j][1]) + (v[j][2] + v[j][3]);
        const float mean = wave_sum(s) * (1.0f / DM); float q = 0.f;
#pragma unroll
        for (int j = 0; j < 8; ++j) { v[j] = v[j] - mean; q += (v[j][0] * v[j][0] + v[j][1] * v[j][1]) + (v[j][2] * v[j][2] + v[j][3] * v[j][3]); }
        const float rstd = rsqrtf(wave_sum(q) * (1.0f / DM) + LN_EPS);
#pragma unroll
        for (int j = 0; j < 4; ++j) { const int c = j * 512 + lane * 8;
            const f32x4 x0 = v[2 * j] * rstd * gg[2 * j] + bb[2 * j], x1 = v[2 * j + 1] * rstd * gg[2 * j + 1] + bb[2 * j + 1];
            *(f32x4*)(y + c) = x0; *(f32x4*)(y + c + 4) = x1;
            const f32x4 h0 = x0 * (sc[2 * j] + 1.0f) + sh[2 * j], h1 = x1 * (sc[2 * j + 1] + 1.0f) + sh[2 * j + 1];
            u32x4 o; o.x = pk2(h0[0], h0[1]); o.y = pk2(h0[2], h0[3]); o.z = pk2(h1[0], h1[1]); o.w = pk2(h1[2], h1[3]);
            *(u32x4*)(HF + (size_t)row * DM + c) = o;
            if (F8_PQ) { int w0 = __builtin_amdgcn_cvt_pk_fp8_f32(h0[0], h0[1], 0, false); w0 = __builtin_amdgcn_cvt_pk_fp8_f32(h0[2], h0[3], w0, true);
                int w1 = __builtin_amdgcn_cvt_pk_fp8_f32(h1[0], h1[1], 0, false); w1 = __builtin_amdgcn_cvt_pk_fp8_f32(h1[2], h1[3], w1, true);
                *(u32x2*)((unsigned char*)(F.ws + WS_H8) + (size_t)row * DM + c) = (u32x2){(unsigned)w0, (unsigned)w1}; } }
    }
}
namespace peer {
__device__ __forceinline__ unsigned okey(float f) { const unsigned u = __float_as_uint(f); return (u & 0x80000000u) ? ~u : (u | 0x80000000u); }
__device__ __forceinline__ float ikey(unsigned k) { const unsigned u = (k & 0x80000000u) ? (k & 0x7fffffffu) : ~k; return __uint_as_float(u); }
#define CE_DESC(a, b) do { const unsigned _mx = (a) > (b) ? (a) : (b), _mn = (a) > (b) ? (b) : (a); (a) = _mx; (b) = _mn; } while (0)
#define CE_ASC(a, b)  do { const unsigned _mx = (a) > (b) ? (a) : (b), _mn = (a) > (b) ? (b) : (a); (a) = _mn; (b) = _mx; } while (0)
__device__ __forceinline__ void sort16_desc(unsigned (&k)[16]) {
#pragma unroll
    for (int size = 2; size <= 16; size <<= 1)
#pragma unroll
        for (int stride = size >> 1; stride > 0; stride >>= 1)
#pragma unroll
            for (int i = 0; i < 16; ++i) { const int p = i ^ stride; if (p > i) { if ((i & size) == 0) CE_DESC(k[i], k[p]); else CE_ASC(k[i], k[p]); } }
}
__device__ __forceinline__ void merge16_desc(unsigned (&a)[16], const unsigned (&b)[16]) {
#pragma unroll
    for (int i = 0; i < 16; ++i) a[i] = a[i] > b[15 - i] ? a[i] : b[15 - i];
#pragma unroll
    for (int stride = 8; stride > 0; stride >>= 1)
#pragma unroll
        for (int i = 0; i < 16; ++i) { const int p = i ^ stride; if (p > i) CE_DESC(a[i], a[p]); }
}
constexpr int slot_x(int s) { int n = 0; for (int x = 0; x < 16; ++x) for (int y = 0; y < 16; ++y) if ((x + 1) * (y + 1) <= 16) { if (n == s) return x; ++n; } return -1; }
constexpr int slot_y(int s) { int n = 0; for (int x = 0; x < 16; ++x) for (int y = 0; y < 16; ++y) if ((x + 1) * (y + 1) <= 16) { if (n == s) return y; ++n; } return -1; }
template <int S> struct Slot { static constexpr int x = slot_x(S), y = slot_y(S); };
template <int S> __device__ __forceinline__ void cand_one(unsigned (&c)[64], const float (&v0)[16], const float (&v1)[16], const unsigned (&i0)[16], const unsigned (&i1)[16], LAS unsigned short* tbl) {
    if constexpr (Slot<S>::x >= 0) { c[S] = (okey(v0[Slot<S>::x] + v1[Slot<S>::y]) & ~63u) | (unsigned)(63 - S); tbl[S] = (unsigned short)(i0[Slot<S>::x] * 128u + i1[Slot<S>::y]); }
    else c[S] = 0u;
}
template <int... S> __device__ __forceinline__ void cand_all(unsigned (&c)[64], const float (&v0)[16], const float (&v1)[16], const unsigned (&i0)[16], const unsigned (&i1)[16], LAS unsigned short* tbl, std::integer_sequence<int, S...>) {
    (cand_one<S>(c, v0, v1, i0, i1, tbl), ...);
}
__device__ __forceinline__ void topk_item(const bf16* QP, const bf16* SK, int* EIDX, float* EG, int tok0, int h, LAS unsigned short* tblw, int lane) {
    const int r32 = lane & 31, hi = lane >> 5;
    const bf16* qrow = QP + (size_t)(tok0 + r32) * DM + h * 256 + hi * 8;
    unsigned L[2][16];
#pragma unroll
    for (int p = 0; p < 2; ++p) {
        f32x16 acc[4];
#pragma unroll
        for (int kb = 0; kb < 4; ++kb) acc[kb] = f32x16{};
        const bf16* skp = SK + ((size_t)(h * 2 + p) * 128 + r32) * 128 + hi * 8;
#pragma unroll 2
        for (int d0 = 0; d0 < 8; ++d0) { const bf16x8 bq = *(const bf16x8*)(qrow + p * 128 + d0 * 16);
#pragma unroll
            for (int kb = 0; kb < 4; ++kb) { const bf16x8 ak = *(const bf16x8*)(skp + (size_t)kb * 32 * 128 + d0 * 16); acc[kb] = __builtin_amdgcn_mfma_f32_32x32x16_bf16(ak, bq, acc[kb], 0, 0, 0); } }
        unsigned g[4][16];
#pragma unroll
        for (int kb = 0; kb < 4; ++kb) {
#pragma unroll
            for (int r = 0; r < 16; ++r) g[kb][r] = (okey(acc[kb][r]) & ~127u) | (unsigned)(127 - (32 * kb + (r & 3) + 8 * (r >> 2) + 4 * hi));
            sort16_desc(g[kb]); }
        merge16_desc(g[0], g[1]); merge16_desc(g[2], g[3]); merge16_desc(g[0], g[2]);
        unsigned o[16];
#pragma unroll
        for (int i = 0; i < 16; ++i) o[i] = (unsigned)__shfl_xor((int)g[0][i], 32);
        merge16_desc(g[0], o);
#pragma unroll
        for (int i = 0; i < 16; ++i) L[p][i] = g[0][i];
    }
    float v0[16], v1[16]; unsigned i0[16], i1[16];
#pragma unroll
    for (int i = 0; i < 16; ++i) { v0[i] = ikey(L[0][i] & ~127u); v1[i] = ikey(L[1][i] & ~127u); i0[i] = 127u - (L[0][i] & 127u); i1[i] = 127u - (L[1][i] & 127u); }
    LAS unsigned short* tbl = tblw + lane * 66;
    unsigned c[64];
    cand_all(c, v0, v1, i0, i1, tbl, std::make_integer_sequence<int, 64>{});
    unsigned c0[16], c1[16], c2[16], c3[16];
#pragma unroll
    for (int i = 0; i < 16; ++i) { c0[i] = c[i]; c1[i] = c[16 + i]; c2[i] = c[32 + i]; c3[i] = c[48 + i]; }
    sort16_desc(c0); sort16_desc(c1); sort16_desc(c2); sort16_desc(c3);
    merge16_desc(c0, c1); merge16_desc(c2, c3); merge16_desc(c0, c2);
    LDS_WAIT(); asm volatile("" ::: "memory");
    float best[16]; int eid[16]; float sum = 0.f;
    const float mx = ikey(c0[0] & ~63u);
#pragma unroll
    for (int i = 0; i < 16; ++i) { const unsigned s = 63u - (c0[i] & 63u); eid[i] = (int)tbl[s]; best[i] = __expf(ikey(c0[i] & ~63u) - mx); sum += best[i]; }
    const float inv = 1.0f / sum;
    if (hi == 0) {
        int* ep = EIDX + (size_t)(tok0 + r32) * 128 + h * 16; float* gp = EG + (size_t)(tok0 + r32) * 128 + h * 16;
#pragma unroll
        for (int i = 0; i < 16; ++i) { ep[i] = eid[i]; gp[i] = best[i] * inv; }
    }
    LDS_WAIT(); asm volatile("" ::: "memory");
}
}
namespace p4 {
constexpr int L_SE = 0, L_SG = 4 * 128 * 2, L_WAVE = L_SG + 4 * 128 * 4;
__device__ __forceinline__ float rowsum16(float d) {
    d += __int_as_float(__builtin_amdgcn_update_dpp(__float_as_int(d), __float_as_int(d), 0x128, 0xF, 0xF, false));
    d += __int_as_float(__builtin_amdgcn_update_dpp(__float_as_int(d), __float_as_int(d), 0x124, 0xF, 0xF, false));
    d += __int_as_float(__builtin_amdgcn_update_dpp(__float_as_int(d), __float_as_int(d), 0x122, 0xF, 0xF, false));
    d += __int_as_float(__builtin_amdgcn_update_dpp(__float_as_int(d), __float_as_int(d), 0x121, 0xF, 0xF, false));
    return d;
}
__device__ __forceinline__ f32x2 cvt4(unsigned w, int t) {
    return t == 0 ? __builtin_amdgcn_cvt_scalef32_pk_f32_fp4(w, 1.0f, 0) : (t == 1 ? __builtin_amdgcn_cvt_scalef32_pk_f32_fp4(w, 1.0f, 1) : (t == 2 ? __builtin_amdgcn_cvt_scalef32_pk_f32_fp4(w, 1.0f, 2) : __builtin_amdgcn_cvt_scalef32_pk_f32_fp4(w, 1.0f, 3)));
}
struct Row { u32x4 p[4]; float sc; };
__device__ __forceinline__ void load_row(Row& r, const unsigned char* tab_l, const float* sct, int e) {
    __builtin_amdgcn_sched_barrier(0);
    const unsigned char* g = tab_l + (size_t)(unsigned)e * 1024;
#pragma unroll
    for (int j = 0; j < 4; ++j) r.p[j] = *(const u32x4*)(g + j * 256);
    r.sc = sct[e];
    __builtin_amdgcn_sched_barrier(0);
}
__device__ __forceinline__ float dot128(const f32x2 (&h)[64], const Row& r) {
    f32x2 a = {0.f, 0.f}, b = {0.f, 0.f};
#pragma unroll
    for (int j = 0; j < 4; ++j)
#pragma unroll
        for (int q = 0; q < 4; ++q) { const unsigned w = r.p[j][q];
            a = __builtin_elementwise_fma(h[(j * 4 + q) * 4 + 0], cvt4(w, 0), a); b = __builtin_elementwise_fma(h[(j * 4 + q) * 4 + 1], cvt4(w, 1), b);
            a = __builtin_elementwise_fma(h[(j * 4 + q) * 4 + 2], cvt4(w, 2), a); b = __builtin_elementwise_fma(h[(j * 4 + q) * 4 + 3], cvt4(w, 3), b); }
    return (a.x + a.y) + (b.x + b.y);
}
__device__ __forceinline__ void axpy128(f32x2 (&acc)[64], const float w, const Row& r) {
    const f32x2 ww = {w, w};
#pragma unroll
    for (int j = 0; j < 4; ++j)
#pragma unroll
        for (int q = 0; q < 4; ++q) { const unsigned x = r.p[j][q];
#pragma unroll
            for (int t = 0; t < 4; ++t) acc[(j * 4 + q) * 4 + t] = __builtin_elementwise_fma(ww, cvt4(x, t), acc[(j * 4 + q) * 4 + t]); }
}
__device__ __forceinline__ float gelu_as(float v) {
    const float av = __builtin_fabsf(v), t = __builtin_amdgcn_rcpf(av * 0.2316418882f + 1.0f);
    float q = t * 0.5307027145f + (-0.7265760135f); q = q * t + 0.7107068705f; q = q * t + (-0.142248368f); q = q * t + 0.127414796f; q = q * t;
    const float e = __builtin_amdgcn_exp2f((v * v) * (-0.72134752044f)); const float m = v * (q * e); return v < 0.f ? m : v - m;
}
}

__device__ __forceinline__ void pexp4_phase(const Frame& F, KA A, int l, int ntok, const bf16* HF, float* outp, bf16* Hnext) {
    using namespace p4;
    const unsigned char* PU8 = (const unsigned char*)(F.ws + WS_PU) + (size_t)l * 16384 * 1024; const unsigned char* PV8 = (const unsigned char*)(F.ws + WS_PV) + (size_t)l * 16384 * 1024;
    const float* SCU = (const float*)(F.ws + WS_SCU) + l * 16384; const float* SCV = (const float*)(F.ws + WS_SCV) + l * 16384;
    const int* EIDX = (const int*)(F.ws + WS_EIDX); const float* EG = (const float*)(F.ws + WS_EG);
    float* X1 = (float*)(F.ws + WS_UREG); const float* mod = (const float*)(F.ws + WS_MOD);
    const float* g2 = G(A.in.ln2_g) + l * DM; const float* b2 = G(A.in.ln2_b) + l * DM;
    LAS unsigned char* wl = F.lds + RING_OFF + F.wave * L_WAVE;
    LAS unsigned short* se = (LAS unsigned short*)(wl + L_SE); LAS float* sg = (LAS float*)(wl + L_SG);
    const int gw = F.vcu * NWAVES + F.wave, NW = F.G * NWAVES;
    const int nfull = ntok / (NW * 4), nrem = ntok - nfull * NW * 4, nsplit = (nrem + NW - 1) / NW;
    for (int pass = 0; pass < nfull + nsplit; ++pass) {
        int lane = F.lane; asm volatile("" : "+v"(lane));
        const int qd = lane >> 4, l16 = lane & 15;
        const bool split = pass >= nfull;
        int tokw[4];
#pragma unroll
        for (int k = 0; k < 4; ++k) tokw[k] = split ? ((k == 0 && (pass - nfull) * NW + gw < nrem) ? nfull * NW * 4 + (pass - nfull) * NW + gw : -1) : pass * NW * 4 + gw * 4 + k;
        if (split && tokw[0] < 0) continue;
#pragma unroll
        for (int k = 0; k < 4; ++k) if (tokw[k] >= 0) {
            unsigned k0 = ((unsigned)EIDX[(size_t)tokw[k] * 128 + lane] << 7) | (unsigned)lane, k1 = ((unsigned)EIDX[(size_t)tokw[k] * 128 + 64 + lane] << 7) | (unsigned)(64 + lane);
#pragma unroll
            for (int size = 2; size <= 128; size <<= 1)
#pragma unroll
                for (int stride = size >> 1; stride > 0; stride >>= 1) {
                    if (stride == 64) { const unsigned lo = k0 < k1 ? k0 : k1, hi = k0 < k1 ? k1 : k0; k0 = lo; k1 = hi; }
                    else {
                        const unsigned p0 = (unsigned)__shfl_xor((int)k0, stride), p1 = (unsigned)__shfl_xor((int)k1, stride);
                        const bool lower = (lane & stride) == 0;
                        const bool up0 = (lane & size) == 0 || size == 128 || size == 64;
                        const bool up1 = size == 128 ? true : (size == 64 ? false : (lane & size) == 0);
                        k0 = (lower == up0) ? (k0 < p0 ? k0 : p0) : (k0 < p0 ? p0 : k0);
                        k1 = (lower == up1) ? (k1 < p1 ? k1 : p1) : (k1 < p1 ? p1 : k1);
                    }
                }
            se[k * 128 + lane] = (unsigned short)(k0 >> 7); se[k * 128 + 64 + lane] = (unsigned short)(k1 >> 7);
            sg[k * 128 + lane] = EG[(size_t)tokw[k] * 128 + (k0 & 127u)]; sg[k * 128 + 64 + lane] = EG[(size_t)tokw[k] * 128 + (k1 & 127u)];
        }
        LDS_WAIT(); asm volatile("s_waitcnt vmcnt(0)" ::: "memory");
        const int tok = split ? tokw[0] : (qd == 0 ? tokw[0] : (qd == 1 ? tokw[1] : (qd == 2 ? tokw[2] : tokw[3])));
        const int lbase = split ? 32 * qd : 128 * qd;
        const int nsteps = split ? 32 : 128;
        LAS const unsigned short* seq = se + lbase; LAS float* sgq = sg + lbase;
#ifndef P4_NO_U
        {
            f32x2 h[64];
#pragma unroll
            for (int j = 0; j < 4; ++j) { const bf16* hp = HF + (size_t)tok * DM + j * 512 + l16 * 32;
#pragma unroll
                for (int q = 0; q < 4; ++q) { const u32x4 a = *(const u32x4*)(hp + q * 8);
#pragma unroll
                    for (int t = 0; t < 4; ++t) h[(j * 4 + q) * 4 + t] = (f32x2){bflo(a[t]), bfhi(a[t])}; } }
            const unsigned char* tab_l = PU8 + l16 * 16;
            p4::Row ra, rb;
            int ea = seq[0], eb = seq[1];
            p4::load_row(ra, tab_l, SCU, ea);
#ifdef PROBE_U2
            for (int i = 0; i < nsteps; i += 2) {
                p4::load_row(rb, tab_l, SCU, eb); ea = seq[i + 2 < nsteps ? i + 2 : nsteps - 1];
                { const float d = p4::rowsum16(p4::dot128(h, ra)) * ra.sc; if (d == 123456.78f) sgq[i] = d; }
                p4::load_row(ra, tab_l, SCU, ea); eb = seq[i + 3 < nsteps ? i + 3 : nsteps - 1];
                { const float d = p4::rowsum16(p4::dot128(h, rb)) * rb.sc; if (d == 123456.78f) sgq[i + 1] = d; }
            }
            ea = seq[0]; eb = seq[1]; p4::load_row(ra, tab_l, SCU, ea);
#endif
            for (int i = 0; i < nsteps; i += 2) {
                p4::load_row(rb, tab_l, SCU, eb);
                const float sva = SCV[ea]; ea = seq[i + 2 < nsteps ? i + 2 : nsteps - 1];
                { const float gate = sgq[i]; const float d = p4::rowsum16(p4::dot128(h, ra)) * ra.sc; sgq[i] = p4::gelu_as(d) * gate * sva; }
                p4::load_row(ra, tab_l, SCU, ea);
                const float svb = SCV[eb]; eb = seq[i + 3 < nsteps ? i + 3 : nsteps - 1];
                { const float gate = sgq[i + 1]; const float d = p4::rowsum16(p4::dot128(h, rb)) * rb.sc; sgq[i + 1] = p4::gelu_as(d) * gate * svb; }
            }
        }
#endif
        LDS_WAIT(); asm volatile("s_waitcnt vmcnt(0)" ::: "memory");
#ifndef P4_NO_V
        {
            f32x2 acc[64];
#pragma unroll
            for (int k = 0; k < 64; ++k) acc[k] = (f32x2){0.f, 0.f};
            const unsigned char* tab_l = PV8 + l16 * 16;
            p4::Row ra, rb;
            int ea = seq[0], eb = seq[1];
            p4::load_row(ra, tab_l, SCV, ea);
#ifdef PROBE_V2
            for (int rep_ = 0; rep_ < 2; ++rep_) {
            if (rep_) { for (int k = 0; k < 64; ++k) acc[k] = (f32x2){0.f, 0.f}; ea = seq[0]; eb = seq[1]; p4::load_row(ra, tab_l, SCV, ea); }
#endif
            for (int i = 0; i < nsteps; i += 2) {
                p4::load_row(rb, tab_l, SCV, eb);
                ea = seq[i + 2 < nsteps ? i + 2 : nsteps - 1];
                p4::axpy128(acc, sgq[i], ra);
                p4::load_row(ra, tab_l, SCV, ea);
                eb = seq[i + 3 < nsteps ? i + 3 : nsteps - 1];
                p4::axpy128(acc, sgq[i + 1], rb);
            }
#ifdef PROBE_V2
            }
#endif
            asm volatile("s_waitcnt vmcnt(0)" ::: "memory");
#ifndef P4_NO_SPLITC
            if (split) {
#pragma unroll
                for (int k = 0; k < 64; ++k) {
                    { auto r0 = __builtin_amdgcn_permlane16_swap(__float_as_uint(acc[k].x), __float_as_uint(acc[k].x), false, false); acc[k].x = __uint_as_float(r0[0]) + __uint_as_float(r0[1]);
                      auto r1 = __builtin_amdgcn_permlane16_swap(__float_as_uint(acc[k].y), __float_as_uint(acc[k].y), false, false); acc[k].y = __uint_as_float(r1[0]) + __uint_as_float(r1[1]); }
                    { auto r0 = __builtin_amdgcn_permlane32_swap(__float_as_uint(acc[k].x), __float_as_uint(acc[k].x), false, false); acc[k].x = __uint_as_float(r0[0]) + __uint_as_float(r0[1]);
                      auto r1 = __builtin_amdgcn_permlane32_swap(__float_as_uint(acc[k].y), __float_as_uint(acc[k].y), false, false); acc[k].y = __uint_as_float(r1[0]) + __uint_as_float(r1[1]); }
                }
            }
#endif
#ifdef P4_NO_LN2
            for (int k = 0; k < 64; ++k) *(f32x2*)(outp + (size_t)tok * DM + k * 32 + l16 * 2) = acc[k];
#else
            const int bidx = tok < ML ? (tok >> 12) : 4;
            const float* mr = mod + ((size_t)l * 5 + bidx) * MODW; const float* mn = mod + ((size_t)(l + 1 < DEPTH ? l + 1 : l) * 5 + bidx) * MODW; float* x1 = X1 + (size_t)tok * DM;
            if (!split || qd == 0) {
                float s1 = 0.f, s2 = 0.f; int lq = l16; asm volatile("" : "+v"(lq));
                GAS float* px = (GAS float*)x1 + lq * 32; const GAS float* pg = (const GAS float*)mr + 5 * DM + lq * 32;
#pragma unroll
                for (int j = 0; j < 4; ++j) {
#pragma unroll
                    for (int k = 0; k < 8; ++k) { const f32x4 xa = *(const GAS f32x4*)(px + k * 4), ga = *(const GAS f32x4*)(pg + k * 4);
                        const f32x2 a0 = acc[(j * 4 + (k >> 1)) * 4 + (k & 1) * 2], a1 = acc[(j * 4 + (k >> 1)) * 4 + (k & 1) * 2 + 1];
                        const f32x4 v = (f32x4){ALPHA * xa[0] + ga[0] * a0.x, ALPHA * xa[1] + ga[1] * a0.y, ALPHA * xa[2] + ga[2] * a1.x, ALPHA * xa[3] + ga[3] * a1.y};
                        s1 += (v[0] + v[1]) + (v[2] + v[3]); s2 += (v[0] * v[0] + v[1] * v[1]) + (v[2] * v[2] + v[3] * v[3]);
                        *(GAS f32x4*)(px + k * 4) = v; if ((k & 3) == 3) asm volatile("" : "+v"(s1), "+v"(s2) :: "memory"); }
                    px += 512; pg += 512; asm volatile("" : "+v"(px), "+v"(pg)); }
                const float mean = p4::rowsum16(s1) * (1.0f / DM); const float var = p4::rowsum16(s2) * (1.0f / DM) - mean * mean;
                const float rstd = rsqrtf((var > 0.f ? var : 0.f) + LN_EPS);
                asm volatile("s_waitcnt vmcnt(0)" ::: "memory");
                const int co = lq * 32;
#pragma unroll 2
                for (int jj = 0; jj < 8; ++jj) {
                    u32x4 o0, o1; const int cj = (jj >> 1) * 512 + co + (jj & 1) * 16;
#pragma unroll
                    for (int q = 0; q < 4; ++q) { const int c = cj + q * 4; const f32x4 v = *(const f32x4*)(x1 + c), ga = *(const f32x4*)(g2 + c), ba = *(const f32x4*)(b2 + c);
                        const f32x4 y = (v - mean) * rstd * ga + ba;
                        *(f32x4*)(outp + (size_t)tok * DM + c) = y;
                        if (Hnext) { const f32x4 z = y * (*(const f32x4*)(mn + DM + c) + 1.0f) + *(const f32x4*)(mn + c); const unsigned w0 = pk2(z[0], z[1]), w1 = pk2(z[2], z[3]);
                            if (q == 0) { o0.x = w0; o0.y = w1; } else if (q == 1) { o0.z = w0; o0.w = w1; } else if (q == 2) { o1.x = w0; o1.y = w1; } else { o1.z = w0; o1.w = w1; } } }
                    if (Hnext) { bf16* hp = Hnext + (size_t)tok * DM + cj; *(u32x4*)hp = o0; *(u32x4*)(hp + 8) = o1;
                        if (F8_MERGE) { u32x4 q8;
#pragma unroll
                            for (int q = 0; q < 4; ++q) { const unsigned wa = q < 2 ? (q == 0 ? o0.x : o0.z) : (q == 2 ? o1.x : o1.z), wb = q < 2 ? (q == 0 ? o0.y : o0.w) : (q == 2 ? o1.y : o1.w);
                                int w = __builtin_amdgcn_cvt_pk_fp8_f32(bflo(wa), bfhi(wa), 0, false); w = __builtin_amdgcn_cvt_pk_fp8_f32(bflo(wb), bfhi(wb), w, true); q8[q] = (unsigned)w; }
                            *(u32x4*)((unsigned char*)(F.ws + WS_H8) + (size_t)tok * DM + cj) = q8; } }
                }
            }
#endif
        }
#endif
        LDS_WAIT(); asm volatile("s_waitcnt vmcnt(0)" ::: "memory");
    }
}
__device__ __forceinline__ float gelu_exact(float v) { return 0.5f * v * (1.0f + erff(v * 0.70710678118654752f)); }
__device__ __forceinline__ float reduce16(float (&p)[16], int lane) {
    float q[8], r[4], s[2];
    { const bool up = lane & 1;
#pragma unroll
      for (int k = 0; k < 8; ++k) { const float send = up ? p[2 * k] : p[2 * k + 1], keep = up ? p[2 * k + 1] : p[2 * k]; q[k] = keep + __shfl_xor(send, 1); } }
    { const bool up = lane & 2;
#pragma unroll
      for (int k = 0; k < 4; ++k) { const float send = up ? q[2 * k] : q[2 * k + 1], keep = up ? q[2 * k + 1] : q[2 * k]; r[k] = keep + __shfl_xor(send, 2); } }
    { const bool up = lane & 4;
#pragma unroll
      for (int k = 0; k < 2; ++k) { const float send = up ? r[2 * k] : r[2 * k + 1], keep = up ? r[2 * k + 1] : r[2 * k]; s[k] = keep + __shfl_xor(send, 4); } }
    float t;
    { const bool up = lane & 8; const float send = up ? s[0] : s[1], keep = up ? s[1] : s[0]; t = keep + __shfl_xor(send, 8); }
    t += __shfl_xor(t, 16); t += __shfl_xor(t, 32);
    return t;
}
__device__ __forceinline__ void pexp_phase(const Frame& F, KA A, int l, int ntok, const bf16* HF, float* outp, bf16* Hnext) {
    const int gw = F.vcu * NWAVES + F.wave, NGW = F.G * NWAVES, lane = F.lane;
    const bf16* PU = (const bf16*)(F.ws + WS_PU) + (size_t)l * 16384 * DM; const bf16* PV = (const bf16*)(F.ws + WS_PV) + (size_t)l * 16384 * DM;
    const int* EIDX = (const int*)(F.ws + WS_EIDX); const float* EG = (const float*)(F.ws + WS_EG);
    const float* X1 = (const float*)(F.ws + WS_UREG); const float* mod = (const float*)(F.ws + WS_MOD);
    const float* g2 = G(A.in.ln2_g) + l * DM; const float* b2 = G(A.in.ln2_b) + l * DM;
    for (int tok = gw; tok < ntok; tok += NGW) {
        float h[32], acc[32];
#pragma unroll
        for (int j = 0; j < 4; ++j) { const bf16x8 v = *(const bf16x8*)(HF + (size_t)tok * DM + j * 512 + lane * 8);
#pragma unroll
            for (int e = 0; e < 8; ++e) { h[j * 8 + e] = bf2f((unsigned short)v[e]); acc[j * 8 + e] = 0.f; } }
#pragma unroll 1
        for (int sb = 0; sb < 32; ++sb) {
            const int my_e = EIDX[(size_t)tok * 128 + sb * 4 + (lane & 3)]; const float my_g = EG[(size_t)tok * 128 + sb * 4 + (lane & 3)];
            const int e0 = __builtin_amdgcn_readlane(my_e, 0), e1 = __builtin_amdgcn_readlane(my_e, 1), e2 = __builtin_amdgcn_readlane(my_e, 2), e3 = __builtin_amdgcn_readlane(my_e, 3);
            float part[4];
#pragma unroll
            for (int i = 0; i < 4; ++i) {
                const int e = i == 0 ? e0 : (i == 1 ? e1 : (i == 2 ? e2 : e3)); const bf16* ur = PU + (size_t)e * DM + lane * 8; float d = 0.f;
#pragma unroll
                for (int j = 0; j < 4; ++j) { const u32x4 w = *(const u32x4*)(ur + j * 512);
                    d += h[j * 8 + 0] * bflo(w.x) + h[j * 8 + 1] * bfhi(w.x) + h[j * 8 + 2] * bflo(w.y) + h[j * 8 + 3] * bfhi(w.y)
                       + h[j * 8 + 4] * bflo(w.z) + h[j * 8 + 5] * bfhi(w.z) + h[j * 8 + 6] * bflo(w.w) + h[j * 8 + 7] * bfhi(w.w); }
                part[i] = d;
            }
            float dot;
            { const bool u1 = lane & 1, u2 = lane & 2;
              const float q0 = (u1 ? part[1] : part[0]) + __shfl_xor(u1 ? part[0] : part[1], 1);
              const float q1 = (u1 ? part[3] : part[2]) + __shfl_xor(u1 ? part[2] : part[3], 1);
              dot = (u2 ? q1 : q0) + __shfl_xor(u2 ? q0 : q1, 2);
              dot += __shfl_xor(dot, 4); dot += __shfl_xor(dot, 8); dot += __shfl_xor(dot, 16); dot += __shfl_xor(dot, 32); }
            const float act = gelu_exact(dot) * my_g;
#pragma unroll
            for (int i = 0; i < 4; ++i) {
                const int e = i == 0 ? e0 : (i == 1 ? e1 : (i == 2 ? e2 : e3)); const float w = __uint_as_float(__builtin_amdgcn_readlane(__float_as_uint(act), i));
                const bf16* vr = PV + (size_t)e * DM + lane * 8;
#pragma unroll
                for (int j = 0; j < 4; ++j) { const u32x4 x = *(const u32x4*)(vr + j * 512);
                    acc[j * 8 + 0] += w * bflo(x.x); acc[j * 8 + 1] += w * bfhi(x.x); acc[j * 8 + 2] += w * bflo(x.y); acc[j * 8 + 3] += w * bfhi(x.y);
                    acc[j * 8 + 4] += w * bflo(x.z); acc[j * 8 + 5] += w * bfhi(x.z); acc[j * 8 + 6] += w * bflo(x.w); acc[j * 8 + 7] += w * bfhi(x.w); }
            }
        }
        const int bidx = tok < ML ? (tok >> 12) : 4;
        const float* mr = mod + ((size_t)l * 5 + bidx) * MODW; const float* x1 = X1 + (size_t)tok * DM;
        float s = 0.f;
#pragma unroll
        for (int j = 0; j < 4; ++j) { const int c = j * 512 + lane * 8;
            const f32x4 xa = *(const f32x4*)(x1 + c), xb = *(const f32x4*)(x1 + c + 4), ga = *(const f32x4*)(mr + 5 * DM + c), gb = *(const f32x4*)(mr + 5 * DM + c + 4);
#pragma unroll
            for (int e = 0; e < 4; ++e) { acc[j * 8 + e] = ALPHA * xa[e] + ga[e] * acc[j * 8 + e]; acc[j * 8 + 4 + e] = ALPHA * xb[e] + gb[e] * acc[j * 8 + 4 + e]; s += acc[j * 8 + e] + acc[j * 8 + 4 + e]; } }
        const float mean = wave_sum(s) * (1.0f / DM); float q = 0.f;
#pragma unroll
        for (int k = 0; k < 32; ++k) { acc[k] -= mean; q += acc[k] * acc[k]; }
        const float rstd = rsqrtf(wave_sum(q) * (1.0f / DM) + LN_EPS);
        const float* mn = mod + ((size_t)(l + 1 < DEPTH ? l + 1 : l) * 5 + bidx) * MODW;
#pragma unroll
        for (int j = 0; j < 4; ++j) { const int c = j * 512 + lane * 8;
            const f32x4 ga = *(const f32x4*)(g2 + c), gb = *(const f32x4*)(g2 + c + 4), ba = *(const f32x4*)(b2 + c), bb = *(const f32x4*)(b2 + c + 4);
            f32x4 ya, yb;
#pragma unroll
            for (int e = 0; e < 4; ++e) { ya[e] = acc[j * 8 + e] * rstd * ga[e] + ba[e]; yb[e] = acc[j * 8 + 4 + e] * rstd * gb[e] + bb[e]; }
            *(f32x4*)(outp + (size_t)tok * DM + c) = ya; *(f32x4*)(outp + (size_t)tok * DM + c + 4) = yb;
            if (Hnext) { const f32x4 sa = *(const f32x4*)(mn + DM + c), sb = *(const f32x4*)(mn + DM + c + 4), ha = *(const f32x4*)(mn + c), hb = *(const f32x4*)(mn + c + 4);
                const f32x4 za = ya * (sa + 1.0f) + ha, zb = yb * (sb + 1.0f) + hb;
                u32x4 o; o.x = pk2(za[0], za[1]); o.y = pk2(za[2], za[3]); o.z = pk2(zb[0], zb[1]); o.w = pk2(zb[2], zb[3]);
                *(u32x4*)(Hnext + (size_t)tok * DM + c) = o; }
        }
    }
}

#ifndef SD_A
#define SD_A 1
#endif
#ifndef SD_D
#define SD_D 1
#endif
#ifndef SD_B
#define SD_B 2
#endif
#ifndef SD_C
#define SD_C 1
#endif
#ifndef ATT_MASK
#define ATT_MASK 15
#endif
template <int TYPE> __device__ __forceinline__ att::Args make_att_args(const Frame& F, KA A, int l, int idx, bool ctxq) {
    const bf16* U = (const bf16*)(F.ws + WS_UREG); const bf16* QK = (const bf16*)(F.ws + WS_QKVA); bf16* O = (bf16*)(F.ws + WS_OQP);
    constexpr int NH = (TYPE == 2) ? 8 : 4;
    int b, h, qb;
    if (ctxq) { b = idx / NH; h = idx % NH; qb = 0; } else { b = idx / (NH * 16); h = (idx >> 4) % NH; qb = idx & 15; }
    const int row = ctxq ? ML + b * NCTX : b * SEQ + qb * 256;
    att::Args a{};
    a.ldo = DM; a.qpos0 = qb * 256; a.o8 = F8_MERGE;
    if (ctxq) { a.n0 = 4; a.row0 = ML + b * NCTX; a.n1 = 0; a.row1 = 0; }
    if constexpr (TYPE == 0) {
        a.Q = QK + (size_t)row * QW + QA_Q + h * 192; a.ldq = QW; a.KV = QK; a.ld = QW; a.kc0 = QA_KV + h * 256; a.kc1 = QA_KR; a.vc = QA_KV + h * 256 + 128;
        a.O = F8_MERGE ? (bf16*)((unsigned char*)O + (size_t)row * DM + h * 128) : O + (size_t)row * DM + h * 128; a.C = A_SCALE * LOG2E; a.thr = 8.0f / A_SCALE; a.qrope = ctxq ? 0 : 1;
        if (!ctxq) { a.n0 = 64; a.row0 = b * SEQ; a.n1 = 4; a.row1 = ML + b * NCTX; }
    } else if constexpr (TYPE == 1) {
        const int kvh = h >> 1;
        a.Q = U + (size_t)row * UW + U_DQ + h * 128; a.ldq = UW; a.KV = U; a.ld = UW; a.kc0 = U_DK + kvh * 128; a.kc1 = 0; a.vc = U_DV + kvh * 128;
        a.O = F8_MERGE ? (bf16*)((unsigned char*)O + (size_t)row * DM + 1536 + h * 128) : O + (size_t)row * DM + 1536 + h * 128; a.C = D_SCALE * LOG2E; a.thr = 8.0f / D_SCALE;
        if (!ctxq) { a.n0 = 64; a.row0 = b * SEQ; a.n1 = 4; a.row1 = ML + b * NCTX; }
    } else if constexpr (TYPE == 2) {
        const int kvh = h >> 2;
        a.Q = U + (size_t)row * UW + U_BQ + h * 64; a.ldq = UW; a.KV = U; a.ld = UW; a.kc0 = U_BK + kvh * 64; a.kc1 = 0; a.vc = U_BV + kvh * 64;
        a.O = F8_MERGE ? (bf16*)((unsigned char*)O + (size_t)row * DM + 512 + h * 64) : O + (size_t)row * DM + 512 + h * 64; a.C = B_SCALE * LOG2E; a.thr = 8.0f / B_SCALE; a.has_sink = 1; a.sinkl2 = G(A.in.b_sink)[l * 8 + h] * LOG2E;
        if (!ctxq) { int ws = qb * 256 - 128; ws = ws < 0 ? 0 : ws; int we = qb * 256 + 384; we = we > SEQ ? SEQ : we;
            a.n0 = 4; a.row0 = ML + b * NCTX; a.n1 = (we - ws) / 64; a.row1 = b * SEQ + ws; a.wpos0 = ws; }
    } else {
        a.Q = U + (size_t)row * UW + U_CQQ + h * 128; a.ldq = UW; a.KV = U; a.ld = UW; a.kc0 = U_CK + h * 128; a.kc1 = 0; a.vc = U_CV + h * 128;
        a.O = F8_MERGE ? (bf16*)((unsigned char*)O + (size_t)row * DM + 1024 + h * 128) : O + (size_t)row * DM + 1024 + h * 128; a.C = C_SCALE * LOG2E; a.thr = 8.0f / C_SCALE;
        a.T = (const float*)(F.ws + WS_CTAB) + (size_t)((l * 4 + h) * 15) * 4096;
        if (!ctxq) { const int r0 = qb * 4; int kr0 = r0 - 4; kr0 = kr0 < 0 ? 0 : (kr0 > 56 ? 56 : kr0); int ke = r0 + 3 - 4; ke = ke < 0 ? 0 : (ke > 56 ? 56 : ke); ke += 7; const int nr = ke - kr0 + 1;
            a.n0 = 4; a.row0 = ML + b * NCTX; a.n1 = nr + (nr & 1); a.row1 = b * SEQ + kr0 * 64; a.r0 = r0; a.kr0 = kr0; }
    }
    return a;
}
#define AF() Frame F = F0; asm volatile("" : "+v"(F.tid), "+v"(F.lane), "+s"(F.wave), "+s"(F.vcu), "+s"(F.G), "+s"(F.ws), "+s"(F.lds)); LAS char* lds = (LAS char*)(F.lds + RING_OFF); const int v = F.vcu
__device__ __forceinline__ void att_phase(const Frame& F0, int l) {
    if (F0.vcu >= 256) return;
    const bool cx = (l + 1 < DEPTH);
    if (ATT_MASK & 1) { AF(); KA A = *kargs(); const int n = 1 + ((cx && v < 16) ? 1 : 0);
        for (int k = 0; k < n; ++k) { const att::Args a = make_att_args<0>(F, A, l, k ? v : v, k != 0); att::attn_unit<192, 128, 0, SD_A>(a, lds, F.tid); } }
    if (ATT_MASK & 2) { AF(); KA A = *kargs(); const int n = 1 + ((cx && v >= 16 && v < 32) ? 1 : 0);
        for (int k = 0; k < n; ++k) { const att::Args a = make_att_args<1>(F, A, l, k ? v - 16 : v, k != 0); att::attn_unit<128, 128, 0, SD_D>(a, lds, F.tid); } }
    if (ATT_MASK & 4) { AF(); KA A = *kargs(); const int n = 2 + ((cx && v >= 48 && v < 80) ? 1 : 0);
        for (int k = 0; k < n; ++k) { const att::Args a = make_att_args<2>(F, A, l, k == 2 ? v - 48 : 2 * v + k, k == 2); att::attn_unit<64, 64, 1, SD_B>(a, lds, F.tid); } }
    if (ATT_MASK & 8) { AF(); KA A = *kargs(); const int n = 1 + ((cx && v >= 32 && v < 48) ? 1 : 0);
        for (int k = 0; k < n; ++k) { const att::Args a = make_att_args<3>(F, A, l, k ? v - 32 : v, k != 0); att::attn_unit<128, 128, 2, SD_C>(a, lds, F.tid); } }
}

__device__ __forceinline__ void merge_ctx_reduce(const Frame& F, bf16* S, const char* CP) {
    const int T = F.vcu; if (T >= 32) return;
    const int tid = F.tid, wid = tid >> 6, lane = tid & 63, wr = wid >> 2, wc = wid & 3, fr = lane & 15, fq = lane >> 4;
    const int pm = 64 + (T >> 3), pn = T & 7; const int row0 = pm * 256 + wr * 64 + fr, col0 = pn * 256 + wc * 32 + 8 * fq;
    for (int si = 0; si < 16; ++si) {
        f32x4 v0 = {0.f, 0.f, 0.f, 0.f}, v1 = v0;
#pragma unroll
        for (int z = 0; z < 4; ++z) { const char* p = CP + (size_t)(T * 4 + z) * 262144 + ((size_t)(si * 2) * 512 + tid) * 16; v0 += *(const f32x4*)p; v1 += *(const f32x4*)(p + 8192); }
        const int ai = si >> 3, m = (si >> 1) & 3, bj = si & 1;
        if (F8_OUT) { int w0 = __builtin_amdgcn_cvt_pk_fp8_f32(v0[0], v0[1], 0, false); w0 = __builtin_amdgcn_cvt_pk_fp8_f32(v0[2], v0[3], w0, true);
            int w1 = __builtin_amdgcn_cvt_pk_fp8_f32(v1[0], v1[1], 0, false); w1 = __builtin_amdgcn_cvt_pk_fp8_f32(v1[2], v1[3], w1, true);
            *(u32x2*)((unsigned char*)S + (size_t)(row0 + ai * 128 + m * 16) * 2048 + col0 + bj * 128) = (u32x2){(unsigned)w0, (unsigned)w1}; }
        else { u32x4 w; w.x = cvt_pk_bf16(v0[0], v0[1]); w.y = cvt_pk_bf16(v0[2], v0[3]); w.z = cvt_pk_bf16(v1[0], v1[1]); w.w = cvt_pk_bf16(v1[2], v1[3]);
        *(u32x4*)(S + (size_t)(row0 + ai * 128 + m * 16) * 2048 + col0 + bj * 128) = w; }
    }
}

constexpr int N_PHASES = 3 + 10 * DEPTH;
#ifndef MK_N_LAUNCHES
#define MK_N_LAUNCHES 1
#endif
static_assert(MK_N_LAUNCHES == 1, "the merge phase carries a grid barrier of its own (context tiles): single-launch builds only");
__global__ void __launch_bounds__(NWAVES * 64, 2) mk_fwd(Args args) {
    extern __shared__ __attribute__((aligned(16))) unsigned char lds_raw[];
    Frame F;
    F.lds = (LAS unsigned char*)lds_raw; F.tid = threadIdx.x; F.lane = F.tid & 63; F.wave = __builtin_amdgcn_readfirstlane(F.tid >> 6);
    F.G = gridDim.x; { const int bx = blockIdx.x; F.vcu = (F.G % 8 == 0) ? (bx % 8) * (F.G / 8) + bx / 8 : bx; }
    GAS unsigned char* ws; int lo, hi, li;
    { KAP ap = kargs(); ws = (GAS unsigned char*)ap->ws; lo = ap->ph_lo; hi = ap->ph_hi; li = ap->li; }
    F.ws = ws;
    for (int u = F.tid; u < (LDS_BYTES - LDSCTL_OFF) / 4; u += NWAVES * 64) ((LAS unsigned*)(F.lds + LDSCTL_OFF))[u] = 0u;
    __syncthreads();
    volatile LAS unsigned* MISC = (volatile LAS unsigned*)(F.lds + MISC_OFF);
    XcdBarrier bar = xcd_barrier_post((unsigned*)(ws + WS_CTL) + CW_BAR + li * XCD_BAR_WORDS, MISC + 8);
#ifndef PHASE_MASK
#define PHASE_MASK 0x1fff
#endif
#define INR(k) (lo <= (k) && (k) < hi)
#define IN(k) ((((PHASE_MASK) >> ((k) < 3 ? (k) : 3 + ((k) - 3) % 10)) & 1) && INR(k))
#define SEAM(k) do { if (INR(k) && INR((k) + 1)) xcd_barrier(bar); } while (0)
#ifndef PROBE_DUP
#define PROBE_DUP 0
#endif
#ifndef PROBE_REP
#define PROBE_REP 1
#endif
#define KIND(k) ((k) < 3 ? (k) : 3 + ((k) - 3) % 10)
#define REP(k) for (int rep_ = 0, nrep_ = 1 + ((((PROBE_DUP) >> KIND(k)) & 1) ? PROBE_REP : 0); rep_ < nrep_; ++rep_, (rep_ < nrep_ ? xcd_barrier(bar) : (void)0))
#define PF() Frame Fp = F; int bx = blockIdx.x; asm volatile("" : "+v"(Fp.tid), "+v"(Fp.lane), "+s"(Fp.wave), "+s"(Fp.vcu), "+s"(Fp.G), "+s"(Fp.ws), "+s"(Fp.lds), "+s"(bx)); GAS unsigned char* ws = Fp.ws; (void)bx; (void)ws
    if (IN(0)) REP(0) { PF(); p0_prologue(Fp, *kargs()); } SEAM(0);
    if (IN(1)) REP(1) { PF(); p1_modreduce(Fp, *kargs()); } SEAM(1);
    if (IN(2)) REP(2) { PF(); p2_modulate0(Fp, *kargs()); } SEAM(2);
    for (int l = 0; l < DEPTH; ++l) {
        const int pb = 3 + 10 * l; const bool last = (l + 1 == DEPTH);
        const size_t offH = (l & 1) ? WS_BUFB : WS_BUFA, offS = (l & 1) ? WS_BUFA : WS_BUFB;
        const int nPl = last ? 64 : 68, nrows = last ? ML : MT;
        if (IN(pb + 0)) REP(pb + 0) {
            PF(); bf16* Hb = (bf16*)(ws + offH);
            pg8::PlainSched S{F8_IN ? (const char*)(ws + WS_H8) : (const char*)Hb, F8_IN ? (const char*)(ws + WS_WIN) + (size_t)l * UW * DM : (const char*)((bf16*)(ws + WS_WIN) + (size_t)l * UW * DM), DM, DM, DM, 68, 16, Fp.G, bx, F8_IN ? 1 : 2};
            pg8::EpiBf16 E{(bf16*)(ws + WS_UREG), UW};
            pg8::gemm_phase<pg8::EpiBf16, pg8::PlainSched, F8_IN != 0>(Fp.lds + RING_OFF, S, E, DM, DM, Fp.tid);
        } SEAM(pb + 0);
        if (IN(pb + 1)) REP(pb + 1) { PF(); enorm_phase(Fp, *kargs(), l); } SEAM(pb + 1);
        if (IN(pb + 2)) REP(pb + 2) { PF();
            pg8::PlainSched S{(const char*)(ws + WS_UREG), (const char*)((bf16*)(ws + WS_WUP) + (size_t)l * 1792 * 512), UW, 512, 512, 68, 7, Fp.G, bx, 2};
            pg8::EpiBf16 E{(bf16*)(ws + WS_QKVA), QW};
            pg8::gemm_phase(Fp.lds + RING_OFF, S, E, UW, 512, Fp.tid);
        } SEAM(pb + 2);
        if (IN(pb + 3)) REP(pb + 3) { PF(); att_phase(Fp, l); } SEAM(pb + 3);
        if (IN(pb + 4)) REP(pb + 4) { PF(); bf16* Hb = (bf16*)(ws + offH); bf16* Sb = (bf16*)(ws + offS);
            pg8::MergeSched S{F8_MERGE ? (const char*)(ws + WS_H8) : (const char*)Hb, (const char*)(ws + WS_OQP), F8_MERGE ? (const char*)(ws + WS_WC) + (size_t)l * 4 * DM * 2560 : (const char*)((bf16*)(ws + WS_WC) + (size_t)l * 4 * DM * 2560), nPl, Fp.G, bx, F8_MERGE ? 1 : 2};
            pg8::EpiMerge E{Sb, G(kargs()->in.b_gate) + (size_t)l * 4 * DM, (char*)(ws + WS_STASH) + (size_t)bx * STASH_WG, (char*)(ws + WS_P) + (size_t)bx * P_WG, (char*)(ws + WS_CP), Fp.tid, F8_OUT};
            pg8::gemm_phase<pg8::EpiMerge, pg8::MergeSched, F8_MERGE != 0>(Fp.lds + RING_OFF, S, E, DM, 2560, Fp.tid);
            if (nPl > 64) { xcd_barrier(bar); merge_ctx_reduce(Fp, Sb, (const char*)(ws + WS_CP)); }
        } SEAM(pb + 4);
        if (IN(pb + 5)) REP(pb + 5) { PF(); bf16* Sb = (bf16*)(ws + offS);
            pg8::PlainSched S{(const char*)Sb, F8_OUT ? (const char*)(ws + WS_WO) + (size_t)l * DM * DM : (const char*)((bf16*)(ws + WS_WO) + (size_t)l * DM * DM), DM, DM, DM, nPl, 8, Fp.G, bx, F8_OUT ? 1 : 2};
            KAP ap = kargs();
            pg8::EpiOut E{(float*)(ws + WS_UREG), l == 0 ? G(ap->in.x) : (const float*)(ws + WS_XRES), l == 0 ? G(ap->in.ctx) : (const float*)(ws + WS_XRES) + (size_t)ML * DM,
                          (const float*)(ws + WS_MOD) + (size_t)l * 5 * MODW, ALPHA};
            pg8::gemm_phase<pg8::EpiOut, pg8::PlainSched, F8_OUT != 0>(Fp.lds + RING_OFF, S, E, DM, DM, Fp.tid);
        } SEAM(pb + 5);
        if (IN(pb + 6)) REP(pb + 6) { PF(); ln1_phase(Fp, *kargs(), l, nrows, (bf16*)(ws + offH)); } SEAM(pb + 6);
        if (IN(pb + 7)) REP(pb + 7) { PF(); bf16* Hb = (bf16*)(ws + offH);
            pg8::PlainSched S{F8_PQ ? (const char*)(ws + WS_H8) : (const char*)Hb, F8_PQ ? (const char*)(ws + WS_WPQ) + (size_t)l * DM * DM : (const char*)((bf16*)(ws + WS_WPQ) + (size_t)l * DM * DM), DM, DM, DM, nPl, 8, Fp.G, bx, F8_PQ ? 1 : 2};
            pg8::EpiBf16 E{(bf16*)(ws + WS_OQP), DM};
            pg8::gemm_phase<pg8::EpiBf16, pg8::PlainSched, F8_PQ != 0>(Fp.lds + RING_OFF, S, E, DM, DM, Fp.tid);
        } SEAM(pb + 7);
        if (IN(pb + 8)) REP(pb + 8) { PF();
            const int gw = Fp.vcu * NWAVES + Fp.wave, NGW = Fp.G * NWAVES;
            LAS unsigned short* tblw = (LAS unsigned short*)(Fp.lds + RING_OFF) + Fp.wave * (64 * 66);
            for (int it = gw; it < (nrows / 32) * 8; it += NGW)
                peer::topk_item((const bf16*)(ws + WS_OQP), (const bf16*)(ws + WS_SUBK) + (size_t)l * 8 * 2 * 128 * 128, (int*)(ws + WS_EIDX), (float*)(ws + WS_EG), (it >> 3) * 32, it & 7, tblw, Fp.lane);
        } SEAM(pb + 8);
        if (IN(pb + 9)) REP(pb + 9) { PF(); pexp4_phase(Fp, *kargs(), l, nrows, (bf16*)(ws + offH), last ? G(kargs()->out) : (float*)(ws + WS_XRES), last ? nullptr : (bf16*)(ws + offS)); } SEAM(pb + 9);
    }
#undef IN
#undef INR
#undef SEAM
}

extern "C" void kernel_launch(void* const* d_in, const int* in_sizes, int n_in, void* d_out, int out_size, void* d_ws, size_t ws_size, hipStream_t stream) {
    static int grid = 0;
    if (grid == 0) {
        if (n_in != 27 || out_size != ML * DM || ws_size < WS_END) { fprintf(stderr, "kernel_launch: unexpected shapes (n_in %d out %d ws %zu, need ws >= %zu)\n", n_in, out_size, ws_size, (size_t)WS_END); grid = -1; return; }
        int dev = 0, cus = 0, per_cu = 0;
        if (hipGetDevice(&dev) != hipSuccess || hipDeviceGetAttribute(&cus, hipDeviceAttributeMultiprocessorCount, dev) != hipSuccess) { grid = -1; return; }
        if (hipFuncSetAttribute((const void*)mk_fwd, hipFuncAttributeMaxDynamicSharedMemorySize, LDS_BYTES) != hipSuccess) { fprintf(stderr, "kernel_launch: hipFuncSetAttribute failed\n"); grid = -1; return; }
        if (hipOccupancyMaxActiveBlocksPerMultiprocessor(&per_cu, (const void*)mk_fwd, NWAVES * 64, LDS_BYTES) != hipSuccess || per_cu < 1) { fprintf(stderr, "kernel_launch: occupancy query says %d\n", per_cu); }
        (void)hipGetLastError();
        grid = cus < 256 ? cus : 256;
    }
    if (grid < 0) return;
    (void)hipMemsetAsync((char*)d_ws + WS_CTL, 0, CTL_ZERO_BYTES, stream);
    Args a{};
    const float** ip = (const float**)&a.in;
    for (int i = 0; i < 27; ++i) ip[i] = (const float*)d_in[i];
    a.out = (float*)d_out; a.ws = (unsigned char*)d_ws;
    for (int li = 0; li < MK_N_LAUNCHES; ++li) {
        a.ph_lo = (MK_N_LAUNCHES == 1) ? 0 : li; a.ph_hi = (MK_N_LAUNCHES == 1) ? N_PHASES : li + 1; a.li = li; a.pad = 0;
        hipLaunchKernelGGL(mk_fwd, dim3(grid), dim3(NWAVES * 64), LDS_BYTES, stream, a);
    }
}
```

```cpp
#include <hip/hip_runtime.h>
#include <cstdio>
#include <cstdint>
#include <utility>

#define GAS __attribute__((address_space(1)))
#define LAS __attribute__((address_space(3)))
typedef unsigned short bf16;
typedef short bf16x8 __attribute__((ext_vector_type(8)));
typedef short s16x4 __attribute__((ext_vector_type(4)));
typedef float f32x2 __attribute__((ext_vector_type(2)));
typedef float f32x4 __attribute__((ext_vector_type(4)));
typedef float f32x16 __attribute__((ext_vector_type(16)));
typedef unsigned u32x2 __attribute__((ext_vector_type(2)));
typedef unsigned u32x4 __attribute__((ext_vector_type(4)));
typedef GAS unsigned gu32;

__device__ __forceinline__ unsigned cvt_pk_bf16(float lo, float hi) { unsigned r; asm volatile("v_cvt_pk_bf16_f32 %0, %1, %2" : "=v"(r) : "v"(lo), "v"(hi)); return r; }
__device__ __forceinline__ float bf2f(unsigned short b) { return __uint_as_float(((unsigned)b) << 16); }
__device__ __forceinline__ float bflo(unsigned w) { return __uint_as_float(w << 16); }
__device__ __forceinline__ float bfhi(unsigned w) { return __uint_as_float(w & 0xffff0000u); }
__device__ __forceinline__ unsigned short f2bf(float f) { return (unsigned short)(cvt_pk_bf16(f, 0.f) & 0xffffu); }

namespace pg8 {
constexpr int BM = 256, BK = 64, HALF = 128, HTB = HALF * BK * 2  , STAGE_BYTES = 8 * HTB, NXCD = 8, WGM = 8;
__host__ __device__ __forceinline__ int lds_byte(int r, int c) { const int st = (r >> 4) * 2 + (c >> 5), rr = r & 15, cc = c & 31, ob = rr * 64 + cc * 2; return st * 1024 + (ob ^ (((ob >> 9) & 1) << 5)); }
__host__ __device__ __forceinline__ void stage_rc(int b, int& R, int& C) { const int st = b / 1024, sb = b % 1024, swz = sb ^ (((sb >> 9) & 1) << 5); R = (st >> 1) * 16 + swz / 64; C = (st & 1) * 32 + (swz % 64) / 2; }
__host__ __device__ __forceinline__ int perm32(int rho) { const int n = rho >> 4, i = rho & 15; return 8 * (i >> 2) + 4 * n + (i & 3); }

struct Unit { int pm, pn, z, aux; };

__device__ __forceinline__ void tile_of(int L, int nM, int nN, int& pm, int& pn) {
    const int nwg = nM * nN; int wgid = L;
    { const int q = nwg / NXCD, r = nwg % NXCD, xcd = wgid % NXCD, off = wgid / NXCD; wgid = (xcd < r ? xcd * (q + 1) : r * (q + 1) + (xcd - r) * q) + off; }
    const int nig = WGM * nN, gid = wgid / nig, fm = gid * WGM, gsz = (nM - fm) < WGM ? (nM - fm) : WGM;
    pm = fm + ((wgid % nig) % gsz); pn = (wgid % nig) / gsz;
}
struct PlainSched {
    const char* A; const char* B; int lda, ldb, K, nM, nN, G, c, esz;
    __device__ __forceinline__ bool next(int i, Unit& u) const { const long L = (long)i * G + c; if (L >= (long)nM * nN) return false; tile_of((int)L, nM, nN, u.pm, u.pn); u.z = 0; u.aux = 0; return true; }
    __device__ __forceinline__ void ptrs(const Unit& u, const char*& a, const char*& b, int& nt) const { a = A + (size_t)u.pm * BM * lda * esz; b = B + (size_t)u.pn * BM * ldb * esz; nt = K * esz / 128; }
};
struct AupSched {
    const char* A; const char* B; int lda, G, c;
    __device__ __forceinline__ bool next(int i, Unit& u) const { const long L = (long)i * G + c; if (L >= 68L * 7) return false; tile_of((int)L, 68, 7, u.pm, u.pn); u.z = 0; u.aux = 0; return true; }
    __device__ __forceinline__ void ptrs(const Unit& u, const char*& a, const char*& b, int& nt) const { const int ko = u.pn < 3 ? 0 : 384;
        a = A + ((size_t)u.pm * BM * lda + ko) * 2; b = B + ((size_t)u.pn * BM * 512 + ko) * 2; nt = u.pn < 3 ? 6 : 2; }
};
struct MergeSched {
    const char* H; const char* O; const char* W; int nM, G, c, esz;
    __device__ __forceinline__ bool next(int i, Unit& u) const {
        const int ngl = (512 - c + G - 1) / G;
        if (i < 8 * ngl) { tile_of((i >> 3) * G + c, 64, 8, u.pm, u.pn); u.z = i & 7; u.aux = 0; return true; }
        if (nM <= 64) return false;
        const int t = i - 8 * ngl, j = c + (t >> 1) * G; if (j >= 128) return false;
        const int T = j >> 2; u.pm = 64 + (T >> 3); u.pn = T & 7; u.z = 8 + (j & 3) * 2 + (t & 1); u.aux = j; return true;
    }
    __device__ __forceinline__ void ptrs(const Unit& u, const char*& a, const char*& b, int& nt) const {
        const int z = (u.z & 7) >> 1, kind = u.z & 1;
        a = (kind ? H : O + (size_t)z * 512 * esz) + (size_t)u.pm * BM * 2048 * esz;
        b = W + ((size_t)z * 2048 * 2560 + (size_t)u.pn * BM * 2560 + (kind ? 0 : 2048)) * esz;
        nt = (kind ? 2048 : 512) * esz / 128;
    }
};

struct EpiBf16 {
    static constexpr bool PERM = true;
    bf16* O; int ldc;
    __device__ __forceinline__ void operator()(const f32x4 (&acc)[2][2][4][2], const Unit& u, int wr, int wc, int fr, int fq) const {
        const int row0 = u.pm * BM + wr * 64 + fr, col0 = u.pn * BM + wc * 32 + 8 * fq;
#pragma unroll
        for (int ai = 0; ai < 2; ++ai)
#pragma unroll
            for (int m = 0; m < 4; ++m) { bf16* rowp = O + (size_t)(row0 + ai * HALF + m * 16) * ldc + col0;
#pragma unroll
                for (int bj = 0; bj < 2; ++bj) { const f32x4 v0 = acc[ai][bj][m][0], v1 = acc[ai][bj][m][1];
                    u32x4 w; w.x = cvt_pk_bf16(v0[0], v0[1]); w.y = cvt_pk_bf16(v0[2], v0[3]); w.z = cvt_pk_bf16(v1[0], v1[1]); w.w = cvt_pk_bf16(v1[2], v1[3]);
                    *(u32x4*)(rowp + bj * HALF) = w; } }
    }
};
#ifndef EPIM_GROUPS
#define EPIM_GROUPS 2
#endif
#ifndef STASH_F8
#define STASH_F8 1
#endif
constexpr int STASH_B = STASH_F8 ? 8 : 16;
struct EpiMerge {
    static constexpr bool PERM = true;
    bf16* S; const float* bgate; char* stash; char* P; char* CP; int tid; int s8;
    __device__ __forceinline__ void operator()(const f32x4 (&acc)[2][2][4][2], const Unit& u, int wr, int wc, int fr, int fq) const {
        const int z = (u.z & 7) >> 1, kind = u.z & 1; const bool cx = u.z >= 8; int tl = tid; asm volatile("" : "+v"(tl));
        GAS char* sp = (GAS char*)stash + (size_t)tl * STASH_B;
        if (kind == 0) {
#pragma unroll
            for (int ai = 0; ai < 2; ++ai)
#pragma unroll
                for (int m = 0; m < 4; ++m)
#pragma unroll
                    for (int bj = 0; bj < 2; ++bj) { const f32x4 v0 = acc[ai][bj][m][0], v1 = acc[ai][bj][m][1];
                        if (STASH_F8) { int w0 = __builtin_amdgcn_cvt_pk_fp8_f32(v0[0], v0[1], 0, false); w0 = __builtin_amdgcn_cvt_pk_fp8_f32(v0[2], v0[3], w0, true);
                            int w1 = __builtin_amdgcn_cvt_pk_fp8_f32(v1[0], v1[1], 0, false); w1 = __builtin_amdgcn_cvt_pk_fp8_f32(v1[2], v1[3], w1, true);
                            *(GAS u32x2*)sp = (u32x2){(unsigned)w0, (unsigned)w1}; }
                        else { u32x4 w; w.x = cvt_pk_bf16(v0[0], v0[1]); w.y = cvt_pk_bf16(v0[2], v0[3]); w.z = cvt_pk_bf16(v1[0], v1[1]); w.w = cvt_pk_bf16(v1[2], v1[3]);
                            *(GAS u32x4*)sp = w; }
                        sp += 512 * STASH_B; asm volatile("" : "+v"(sp)); }
            return;
        }
        GAS char* pq = (cx ? (GAS char*)CP + (size_t)u.aux * 262144 : (GAS char*)P) + (size_t)tl * 16; GAS char* pr = pq;
        const int row0 = u.pm * BM + wr * 64 + fr, col0 = u.pn * BM + wc * 32 + 8 * fq;
        const float* bz = bgate + z * 2048 + col0;
        f32x4 bv[2][2];
#pragma unroll
        for (int bj = 0; bj < 2; ++bj)
#pragma unroll
            for (int n = 0; n < 2; ++n) bv[bj][n] = *(const f32x4*)(bz + bj * HALF + 4 * n);
        GAS bf16* rowp = (GAS bf16*)S + (size_t)row0 * 2048 + col0; GAS unsigned char* rowp8 = (GAS unsigned char*)S + (size_t)row0 * 2048 + col0;
        const bool rd = z > 0 && !cx;
#pragma unroll
        for (int aq = 0; aq < EPIM_GROUPS; ++aq) { constexpr int NI = 16 / EPIM_GROUPS, NM = NI / 2;
            u32x4 sw[STASH_F8 ? 1 : NI], pw[NI]; u32x2 sw8[STASH_F8 ? NI : 1];
#pragma unroll
            for (int i = 0; i < NI; ++i) { if (STASH_F8) sw8[STASH_F8 ? i : 0] = *(const GAS u32x2*)sp; else sw[STASH_F8 ? 0 : i] = *(const GAS u32x4*)sp; sp += 512 * STASH_B; asm volatile("" : "+v"(sp)); }
            if (rd) {
#pragma unroll
                for (int i = 0; i < NI; ++i) { pw[i] = *(const GAS u32x4*)pr; pr += 8192; asm volatile("" : "+v"(pr)); } }
            asm volatile("" ::: "memory");
#pragma unroll
            for (int mm = 0; mm < NM; ++mm) { const int ai = (aq * NM + mm) >> 2, m = (aq * NM + mm) & 3;
#pragma unroll
                for (int bj = 0; bj < 2; ++bj) { const int i = mm * 2 + bj;
                    f32x4 v0 = acc[ai][bj][m][0] + bv[bj][0], v1 = acc[ai][bj][m][1] + bv[bj][1];
#pragma unroll
                    for (int j = 0; j < 4; ++j) { v0[j] = __builtin_amdgcn_rcpf(1.0f + __builtin_amdgcn_exp2f(-1.4426950408889634f * v0[j])); v1[j] = __builtin_amdgcn_rcpf(1.0f + __builtin_amdgcn_exp2f(-1.4426950408889634f * v1[j])); }
                    if (STASH_F8) { const u32x2 q_ = sw8[STASH_F8 ? i : 0]; const f32x2 a_ = __builtin_amdgcn_cvt_pk_f32_fp8((int)q_.x, false), b_ = __builtin_amdgcn_cvt_pk_f32_fp8((int)q_.x, true),
                            c_ = __builtin_amdgcn_cvt_pk_f32_fp8((int)q_.y, false), d_ = __builtin_amdgcn_cvt_pk_f32_fp8((int)q_.y, true);
                        v0[0] *= a_.x; v0[1] *= a_.y; v0[2] *= b_.x; v0[3] *= b_.y; v1[0] *= c_.x; v1[1] *= c_.y; v1[2] *= d_.x; v1[3] *= d_.y; }
                    else { const u32x4 q_ = sw[STASH_F8 ? 0 : i];
                        v0[0] *= bflo(q_.x); v0[1] *= bfhi(q_.x); v0[2] *= bflo(q_.y); v0[3] *= bfhi(q_.y);
                        v1[0] *= bflo(q_.z); v1[1] *= bfhi(q_.z); v1[2] *= bflo(q_.w); v1[3] *= bfhi(q_.w); }
                    if (rd) { v0[0] += bflo(pw[i].x); v0[1] += bfhi(pw[i].x); v0[2] += bflo(pw[i].y); v0[3] += bfhi(pw[i].y);
                              v1[0] += bflo(pw[i].z); v1[1] += bfhi(pw[i].z); v1[2] += bflo(pw[i].w); v1[3] += bfhi(pw[i].w); }
                    if (cx) { *(GAS f32x4*)pq = v0; *(GAS f32x4*)(pq + 8192) = v1; pq += 16384; asm volatile("" : "+v"(pq)); }
                    else if (z < 3) { u32x4 w; w.x = cvt_pk_bf16(v0[0], v0[1]); w.y = cvt_pk_bf16(v0[2], v0[3]); w.z = cvt_pk_bf16(v1[0], v1[1]); w.w = cvt_pk_bf16(v1[2], v1[3]);
                        *(GAS u32x4*)pq = w; pq += 8192; asm volatile("" : "+v"(pq)); }
                    else if (s8) { int w0 = __builtin_amdgcn_cvt_pk_fp8_f32(v0[0], v0[1], 0, false); w0 = __builtin_amdgcn_cvt_pk_fp8_f32(v0[2], v0[3], w0, true);
                        int w1 = __builtin_amdgcn_cvt_pk_fp8_f32(v1[0], v1[1], 0, false); w1 = __builtin_amdgcn_cvt_pk_fp8_f32(v1[2], v1[3], w1, true);
                        *(GAS u32x2*)(rowp8 + bj * HALF) = (u32x2){(unsigned)w0, (unsigned)w1}; }
                    else { u32x4 w; w.x = cvt_pk_bf16(v0[0], v0[1]); w.y = cvt_pk_bf16(v0[2], v0[3]); w.z = cvt_pk_bf16(v1[0], v1[1]); w.w = cvt_pk_bf16(v1[2], v1[3]);
                        *(GAS u32x4*)(rowp + bj * HALF) = w; }
                }
                rowp += (m == 3 ? (size_t)(HALF - 48) : (size_t)16) * 2048; rowp8 += (m == 3 ? (size_t)(HALF - 48) : (size_t)16) * 2048; asm volatile("" : "+v"(rowp), "+v"(rowp8)); }
            asm volatile("" ::: "memory"); }
    }
};
#ifndef EPIO_GROUPS
#define EPIO_GROUPS 2
#endif
struct EpiOut {
    static constexpr bool PERM = true;
    bf16* Y; const float* xlat; const float* xctx; const float* mod_l; float alpha; int xbf;
    __device__ __forceinline__ void operator()(const f32x4 (&acc)[2][2][4][2], const Unit& u, int wr, int wc, int fr, int fq) const {
        asm volatile("" : "+v"(fr), "+v"(fq));
        const int row0 = u.pm * BM + wr * 64 + fr, col0 = u.pn * BM + wc * 32 + 8 * fq;
        const float* xb = (u.pm < 64) ? xlat + (size_t)row0 * 2048 : xctx + (size_t)(row0 - 16384) * 2048;
        const bf16* xh = (u.pm < 64) ? (const bf16*)xlat + (size_t)row0 * 2048 : (const bf16*)xctx + (size_t)(row0 - 16384) * 2048;
        const float* ga = mod_l + (size_t)((u.pm < 64) ? (u.pm >> 4) : 4) * 12288 + 2 * 2048 + col0;
        f32x4 gv[2][2];
#pragma unroll
        for (int bj = 0; bj < 2; ++bj)
#pragma unroll
            for (int n = 0; n < 2; ++n) gv[bj][n] = *(const f32x4*)(ga + bj * HALF + n * 4);
#pragma unroll
        for (int aq = 0; aq < EPIO_GROUPS; ++aq) { constexpr int NM = 8 / EPIO_GROUPS;
            f32x4 xv[NM][2][2];
#pragma unroll
            for (int mm = 0; mm < NM; ++mm) { const int ai = (aq * NM + mm) >> 2, m = (aq * NM + mm) & 3; const size_t ro = (size_t)(ai * HALF + m * 16) * 2048 + col0;
#pragma unroll
                for (int bj = 0; bj < 2; ++bj)
                    { if (xbf) { const u32x4 w_ = *(const u32x4*)(xh + ro + bj * HALF); xv[mm][bj][0] = (f32x4){__uint_as_float(w_.x), __uint_as_float(w_.y), __uint_as_float(w_.z), __uint_as_float(w_.w)}; }
                      else {
#pragma unroll
                        for (int n = 0; n < 2; ++n) xv[mm][bj][n] = *(const f32x4*)(xb + ro + bj * HALF + n * 4); } } }
            asm volatile("" ::: "memory");
#pragma unroll
            for (int mm = 0; mm < NM; ++mm) { const int ai = (aq * NM + mm) >> 2, m = (aq * NM + mm) & 3; const size_t ro = (size_t)(ai * HALF + m * 16) * 2048 + col0; bf16* yp = Y + (size_t)row0 * 2048 + ro;
#pragma unroll
                for (int bj = 0; bj < 2; ++bj) { f32x4 x0 = xv[mm][bj][0], x1 = xv[mm][bj][1];
                    if (xbf) { const unsigned a_ = __float_as_uint(x0[0]), b_ = __float_as_uint(x0[1]), c_ = __float_as_uint(x0[2]), d_ = __float_as_uint(x0[3]); x0 = (f32x4){bflo(a_), bfhi(a_), bflo(b_), bfhi(b_)}; x1 = (f32x4){bflo(c_), bfhi(c_), bflo(d_), bfhi(d_)}; }
                    const f32x4 v0 = x0 * alpha + gv[bj][0] * acc[ai][bj][m][0], v1 = x1 * alpha + gv[bj][1] * acc[ai][bj][m][1];
                    u32x4 w; w.x = cvt_pk_bf16(v0[0], v0[1]); w.y = cvt_pk_bf16(v0[2], v0[3]); w.z = cvt_pk_bf16(v1[0], v1[1]); w.w = cvt_pk_bf16(v1[2], v1[3]);
                    *(u32x4*)(yp + bj * HALF) = w; } }
            asm volatile("" ::: "memory"); }
    }
};

typedef int v8i_t __attribute__((ext_vector_type(8)));
typedef int v4i_t __attribute__((ext_vector_type(4)));
template <class Epi, class Sched, bool F8 = false>
__device__ __forceinline__ void gemm_phase(LAS unsigned char* lds, const Sched& S, const Epi& E, const int lda, const int ldb, const int tid) {
    constexpr int ESZ = F8 ? 1 : 2;
    int f8scale = 0x7c7c7c7c; asm volatile("" : "+v"(f8scale));
    const int wid = __builtin_amdgcn_readfirstlane(tid >> 6), lane = tid & 63, wr = wid >> 2, wc = wid & 3, fr = lane & 15, fq = lane >> 4;
    unsigned voffA[2], voffB[2];
#pragma unroll
    for (int i = 0; i < 2; ++i) { int R, C; stage_rc(tid * 16 + i * 8192, R, C); const int Rb = Epi::PERM ? ((R & ~31) + perm32(R & 31)) : R;
        voffA[i] = (unsigned)(R * lda * ESZ + C * 2); voffB[i] = (unsigned)(Rb * ldb * ESZ + C * 2); }
    const size_t kstep = (size_t)(BK * 2);
    const size_t hstepA = (size_t)HALF * lda * ESZ, hstepB = (size_t)HALF * ldb * ESZ;
    const unsigned ldsw = (unsigned)wid * 1024u;
    const int aoff = lds_byte(wr * 64 + fr, fq * 8), boff = lds_byte(wc * 32 + fr, fq * 8);
#define PG8_SA(b, h) (((b) * 2 + (h)) * HTB)
#define PG8_SB(b, h) ((4 + (b) * 2 + (h)) * HTB)
#define PG8_STAGE(bufoff, gbase, voff) do { _Pragma("unroll") for (int _i = 0; _i < 2; ++_i) \
        __builtin_amdgcn_global_load_lds((const unsigned*)((const char*)(gbase) + (voff)[_i]), (LAS unsigned*)(lds + (bufoff) + ldsw + _i * 8192), 16, 0, 0); } while (0)
#define PG8_LDA(dst, b, h) do { _Pragma("unroll") for (int m = 0; m < 4; ++m) _Pragma("unroll") for (int k = 0; k < 2; ++k) dst[m][k] = *(const LAS bf16x8*)(lds + PG8_SA(b, h) + aoff + m * 2048 + k * 1024); } while (0)
#define PG8_LDB(dst, b, h) do { _Pragma("unroll") for (int n = 0; n < 2; ++n) _Pragma("unroll") for (int k = 0; k < 2; ++k) dst[n][k] = *(const LAS bf16x8*)(lds + PG8_SB(b, h) + boff + n * 2048 + k * 1024); } while (0)
#define PG8_MMA(ai, bj, At, Bt) do { __builtin_amdgcn_s_setprio(1); _Pragma("unroll") for (int m = 0; m < 4; ++m) _Pragma("unroll") for (int n = 0; n < 2; ++n) { \
        if constexpr (F8) { const v8i_t wa_ = __builtin_shufflevector(__builtin_bit_cast(v4i_t, Bt[n][0]), __builtin_bit_cast(v4i_t, Bt[n][1]), 0, 1, 2, 3, 4, 5, 6, 7); \
            const v8i_t xa_ = __builtin_shufflevector(__builtin_bit_cast(v4i_t, At[m][0]), __builtin_bit_cast(v4i_t, At[m][1]), 0, 1, 2, 3, 4, 5, 6, 7); \
            asm volatile("v_mfma_scale_f32_16x16x128_f8f6f4 %0, %1, %2, %0, %3, %3 op_sel_hi:[0,0,0]" : "+v"(acc[ai][bj][m][n]) : "v"(wa_), "v"(xa_), "v"(f8scale)); } \
        else { _Pragma("unroll") for (int k = 0; k < 2; ++k) acc[ai][bj][m][n] = __builtin_amdgcn_mfma_f32_16x16x32_bf16(Bt[n][k], At[m][k], acc[ai][bj][m][n], 0, 0, 0); } } \
        __builtin_amdgcn_s_setprio(0); } while (0)
#define PG8_WAIT_V(n) asm volatile("s_waitcnt vmcnt(" #n ")" ::: "memory")
#define PG8_WAIT_L(n) asm volatile("s_waitcnt lgkmcnt(" #n ")" ::: "memory")
#define PG8_BAR __builtin_amdgcn_s_barrier()
#define PG8_SCHED __builtin_amdgcn_sched_barrier(0)
    Unit cur, nxt; int ui = 0;
    if (!S.next(0, cur)) return;
    f32x4 acc[2][2][4][2];
#pragma unroll
    for (int a = 0; a < 2; ++a)
#pragma unroll
        for (int b = 0; b < 2; ++b)
#pragma unroll
            for (int m = 0; m < 4; ++m)
#pragma unroll
                for (int n = 0; n < 2; ++n) acc[a][b][m][n] = (f32x4){0.f, 0.f, 0.f, 0.f};
    bf16x8 At[4][2], B0[2][2], B1[2][2];
    const char* cA; const char* cB; int nt; S.ptrs(cur, cA, cB, nt);
    PG8_STAGE(PG8_SB(0, 0), cB, voffB); PG8_STAGE(PG8_SB(0, 1), cB + hstepB, voffB); PG8_STAGE(PG8_SA(0, 0), cA, voffA); PG8_STAGE(PG8_SA(0, 1), cA + hstepA, voffA);
    if (wr == 1) PG8_BAR;
    PG8_WAIT_V(2); PG8_BAR;
    PG8_STAGE(PG8_SB(1, 0), cB + kstep, voffB); PG8_STAGE(PG8_SA(1, 0), cA + kstep, voffA); PG8_STAGE(PG8_SB(1, 1), cB + hstepB + kstep, voffB);
    PG8_WAIT_V(6); PG8_BAR;
    for (;;) {
        const bool has_next = S.next(ui + 1, nxt);
        const char* nA = cA; const char* nB = cB; int nnt = nt; if (has_next) S.ptrs(nxt, nA, nB, nnt);
        for (int t = 0; t < nt; t += 2) {
            const bool last = (t == nt - 2);
            const char* a1 = cA + (size_t)(t + 1) * kstep;
            const char* a2 = last ? nA : cA + (size_t)(t + 2) * kstep; const char* b2 = last ? nB : cB + (size_t)(t + 2) * kstep;
            const char* a3 = a2 + kstep; const char* b3 = b2 + kstep;
            PG8_LDB(B0, 0, 0); PG8_LDB(B1, 0, 1); PG8_SCHED; PG8_LDA(At, 0, 0); PG8_STAGE(PG8_SA(1, 1), a1 + hstepA, voffA);
            PG8_WAIT_V(8); PG8_WAIT_L(0); PG8_BAR; PG8_MMA(0, 0, At, B0); PG8_MMA(0, 1, At, B1); PG8_BAR; PG8_SCHED;
            PG8_LDA(At, 0, 1); PG8_STAGE(PG8_SB(0, 0), b2, voffB); PG8_STAGE(PG8_SB(0, 1), b2 + hstepB, voffB); PG8_STAGE(PG8_SA(0, 0), a2, voffA);
            PG8_WAIT_V(8); PG8_WAIT_L(0); PG8_BAR; PG8_MMA(1, 0, At, B0); PG8_MMA(1, 1, At, B1); PG8_BAR; PG8_SCHED;
            PG8_LDB(B0, 1, 0); PG8_LDB(B1, 1, 1); PG8_SCHED; PG8_LDA(At, 1, 0); PG8_STAGE(PG8_SA(0, 1), a2 + hstepA, voffA);
            PG8_WAIT_V(8); PG8_WAIT_L(0); PG8_BAR; PG8_MMA(0, 0, At, B0); PG8_MMA(0, 1, At, B1); PG8_BAR; PG8_SCHED;
            PG8_LDA(At, 1, 1); PG8_STAGE(PG8_SB(1, 0), b3, voffB); PG8_STAGE(PG8_SB(1, 1), b3 + hstepB, voffB); PG8_STAGE(PG8_SA(1, 0), a3, voffA);
            PG8_WAIT_V(8); PG8_WAIT_L(0); PG8_BAR; PG8_MMA(1, 0, At, B0); PG8_MMA(1, 1, At, B1); PG8_BAR; PG8_SCHED;
        }
        if (wr == 0) PG8_BAR;
        if constexpr (F8) asm volatile("s_nop 15\n\ts_nop 15" ::: "memory");
        E(acc, cur, wr, wc, fr, fq);
        if (!has_next) break;
#pragma unroll
        for (int a = 0; a < 2; ++a)
#pragma unroll
            for (int b = 0; b < 2; ++b)
#pragma unroll
                for (int m = 0; m < 4; ++m)
#pragma unroll
                    for (int n = 0; n < 2; ++n) acc[a][b][m][n] = (f32x4){0.f, 0.f, 0.f, 0.f};
        cur = nxt; cA = nA; cB = nB; nt = nnt; ++ui;
        if (wr == 1) PG8_BAR;
    }
    PG8_WAIT_V(0);
    PG8_BAR;
#undef PG8_SA
#undef PG8_SB
#undef PG8_STAGE
#undef PG8_LDA
#undef PG8_LDB
#undef PG8_MMA
#undef PG8_WAIT_V
#undef PG8_WAIT_L
#undef PG8_BAR
#undef PG8_SCHED
}
}
#ifndef CT_GROUP
#define CT_GROUP 4
#endif
namespace att {
constexpr int NW = 8, QBLK = 32, KVBLK = 64;
#define SBAR() __builtin_amdgcn_sched_barrier(0)
__device__ __forceinline__ int crow(int r, int hi) { return (r & 3) + 8 * (r >> 2) + 4 * hi; }
__device__ __forceinline__ unsigned cvtpk(float lo, float hi) { unsigned r; asm volatile("v_cvt_pk_bf16_f32 %0, %1, %2" : "=v"(r) : "v"(lo), "v"(hi)); return r; }

struct Args {
    const bf16* Q; int ldq;
    const bf16* KV; int ld;
    int kc0, kc1, vc;
    bf16* O; int ldo;
    int o8;
    int n0, n1, row0, row1;
    float C, thr;
    int qrope, qpos0;
    float sinkl2; int has_sink;
    int wpos0;
    const float* T; int r0, kr0;
};

__device__ __forceinline__ void partialSM(f32x16& p0, f32x16& p1, float& m_reg, float& mn, float& alpha, const float C, const float thr) {
    float pmax = p0[0];
#pragma unroll
    for (int r = 1; r < 16; ++r) pmax = fmaxf(pmax, p0[r]);
#pragma unroll
    for (int r = 0; r < 16; ++r) pmax = fmaxf(pmax, p1[r]);
    { auto rr = __builtin_amdgcn_permlane32_swap(__float_as_uint(pmax), __float_as_uint(pmax), false, false);
      pmax = fmaxf(__uint_as_float(rr[0]), __uint_as_float(rr[1])); }
    if (__builtin_expect(__all(pmax - m_reg <= thr), 1)) { mn = m_reg; alpha = 1.f; }
    else { mn = fmaxf(m_reg, pmax); alpha = __builtin_amdgcn_exp2f((m_reg - mn) * C); m_reg = mn; }
    const float mnC = -mn * C;
#pragma unroll
    for (int r = 0; r < 16; ++r) p0[r] = fmaf(p0[r], C, mnC);
#pragma unroll
    for (int r = 0; r < 16; ++r) p1[r] = fmaf(p1[r], C, mnC);
#pragma unroll
    for (int r = 0; r < 16; ++r) p0[r] = __builtin_amdgcn_exp2f(p0[r]);
}
__device__ __forceinline__ void finishSM(f32x16& p0, f32x16& p1, float alpha, float& l_reg, bf16x8& pa0, bf16x8& pa1, bf16x8& pa2, bf16x8& pa3) {
#pragma unroll
    for (int r = 0; r < 16; ++r) p1[r] = __builtin_amdgcn_exp2f(p1[r]);
    float ps = 0;
#pragma unroll
    for (int r = 0; r < 16; ++r) ps += p0[r];
#pragma unroll
    for (int r = 0; r < 16; ++r) ps += p1[r];
    { auto rr = __builtin_amdgcn_permlane32_swap(__float_as_uint(ps), __float_as_uint(ps), false, false);
      ps = __uint_as_float(rr[0]) + __uint_as_float(rr[1]); }
    l_reg = l_reg * alpha + ps;
#define PK4(P, BASE, OUT) do { unsigned a0 = cvtpk(P[BASE + 0], P[BASE + 1]), a1 = cvtpk(P[BASE + 2], P[BASE + 3]);   \
    unsigned b0 = cvtpk(P[BASE + 4], P[BASE + 5]), b1 = cvtpk(P[BASE + 6], P[BASE + 7]);                              \
    auto r0 = __builtin_amdgcn_permlane32_swap(a0, b0, false, false); auto r1 = __builtin_amdgcn_permlane32_swap(a1, b1, false, false); \
    u32x4 w = {r0[0], r1[0], r0[1], r1[1]}; OUT = *reinterpret_cast<bf16x8*>(&w); } while (0)
    PK4(p0, 0, pa0); PK4(p0, 8, pa1); PK4(p1, 0, pa2); PK4(p1, 8, pa3);
#undef PK4
}
template <int DK> __device__ __forceinline__ int kswz(int row, int ch) { return row * (DK * 2) + ((ch ^ (row & 7)) << 4); }
template <int DK, int QREG> __device__ __forceinline__ void qkt(f32x16& p0, f32x16& p1, const LAS char* Ks, const bf16x8* qr, const LAS char* qx, int r32, int hi) {
    p0 = f32x16{}; p1 = f32x16{};
#pragma unroll
    for (int d0 = 0; d0 < DK / 16; ++d0) { const int ch = d0 * 2 + hi;
        const bf16x8 b0 = *(const LAS bf16x8*)(Ks + kswz<DK>(r32, ch));
        const bf16x8 b1 = *(const LAS bf16x8*)(Ks + kswz<DK>(32 + r32, ch));
        bf16x8 q; if constexpr (true) { if (d0 < QREG) q = qr[d0 < QREG ? d0 : 0]; else q = *(const LAS bf16x8*)(qx + (d0 - QREG) * 1024); }
        p0 = __builtin_amdgcn_mfma_f32_32x32x16_bf16(b0, q, p0, 0, 0, 0);
        p1 = __builtin_amdgcn_mfma_f32_32x32x16_bf16(b1, q, p1, 0, 0, 0); }
}
template <int NCB> __device__ __forceinline__ int v_st(int k, int c) { const int kk = (k & ~0xC) | ((k & 4) << 1) | ((k & 8) >> 1); return ((kk >> 3) * NCB + (c >> 5)) * 512 + ((kk & 7) * 32 + (c & 31)) * 2; }
__device__ __forceinline__ int v_rd_base(int lane) { return ((lane & 3) << 3) | (((lane >> 2) & 3) << 6) | (((lane >> 4) & 1) << 5) | (((lane >> 5) & 1) << 8); }
template <int OFF> __device__ __forceinline__ s16x4 tr_read(int vb) { s16x4 r; asm volatile("ds_read_b64_tr_b16 %0, %1 offset:%2" : "=&v"(r) : "v"(vb), "i"(OFF) : "memory"); return r; }
template <int D0, int NCB> __device__ __forceinline__ void pv_one(f32x16& od, int vb, bf16x8 pa0, bf16x8 pa1, bf16x8 pa2, bf16x8 pa3) {
#define VOFF(ks, half) (D0 * 512 + (ks) * (2 * NCB * 512) + (half) * (NCB * 512))
    const s16x4 l0 = tr_read<VOFF(0, 0)>(vb), h0 = tr_read<VOFF(0, 1)>(vb), l1 = tr_read<VOFF(1, 0)>(vb), h1 = tr_read<VOFF(1, 1)>(vb);
    const s16x4 l2 = tr_read<VOFF(2, 0)>(vb), h2 = tr_read<VOFF(2, 1)>(vb), l3 = tr_read<VOFF(3, 0)>(vb), h3 = tr_read<VOFF(3, 1)>(vb);
#undef VOFF
    asm volatile("s_waitcnt lgkmcnt(0)" ::: "memory"); SBAR();
#define PK(L, H) (bf16x8){L[0], L[1], L[2], L[3], H[0], H[1], H[2], H[3]}
    od = __builtin_amdgcn_mfma_f32_32x32x16_bf16(pa0, PK(l0, h0), od, 0, 0, 0);
    od = __builtin_amdgcn_mfma_f32_32x32x16_bf16(pa1, PK(l1, h1), od, 0, 0, 0);
    od = __builtin_amdgcn_mfma_f32_32x32x16_bf16(pa2, PK(l2, h2), od, 0, 0, 0);
    od = __builtin_amdgcn_mfma_f32_32x32x16_bf16(pa3, PK(l3, h3), od, 0, 0, 0);
#undef PK
}
template <int NCB> __device__ __forceinline__ void pv_all(f32x16* o, int vb, bf16x8 pa0, bf16x8 pa1, bf16x8 pa2, bf16x8 pa3) {
    pv_one<0, NCB>(o[0], vb, pa0, pa1, pa2, pa3); pv_one<1, NCB>(o[1], vb, pa0, pa1, pa2, pa3);
    if constexpr (NCB == 4) { pv_one<2, NCB>(o[2], vb, pa0, pa1, pa2, pa3); pv_one<3, NCB>(o[3], vb, pa0, pa1, pa2, pa3); }
}

template <int MODE> __device__ __forceinline__ void apply_mask(f32x16& p0, f32x16& p1, const Args& a, int j, int wid, int r32, int hi) {
    if constexpr (MODE == 1) {
        if (j < a.n0) return;
        const int kp0 = a.wpos0 + 64 * (j - a.n0), qw0 = a.qpos0 + wid * 32;
        if (kp0 + 63 - qw0 <= 128 && qw0 + 31 - kp0 <= 128) return;
        const int dd0 = kp0 - (qw0 + r32) + 4 * hi + 128;
#pragma unroll
        for (int r = 0; r < 16; ++r) { const int dd = dd0 + (r & 3) + 8 * (r >> 2);
            p0[r] = ((unsigned)dd <= 256u) ? p0[r] : -1e30f; p1[r] = ((unsigned)(dd + 32) <= 256u) ? p1[r] : -1e30f; }
    } else if constexpr (MODE == 2) {
        if (j < a.n0) return;
        const int kr = a.kr0 + (j - a.n0), qr = a.r0 + (wid >> 1);
        int rs = qr - 4; rs = rs < 0 ? 0 : (rs > 56 ? 56 : rs);
        if (kr < rs || kr >= rs + 8) {
#pragma unroll
            for (int r = 0; r < 16; ++r) { p0[r] = -1e30f; p1[r] = -1e30f; }
            return; }
        const int dr = kr - qr + 7, qc = (wid & 1) * 32 + r32;
        const float* tb = a.T + ((size_t)(dr * 64 + qc)) * 64 + 4 * hi;
#pragma unroll
        for (int gg = 0; gg < 4; gg += CT_GROUP) {
            f32x4 t0[CT_GROUP], t1[CT_GROUP];
#pragma unroll
            for (int g = 0; g < CT_GROUP; ++g) { t0[g] = *(const f32x4*)(tb + 8 * (gg + g)); t1[g] = *(const f32x4*)(tb + 32 + 8 * (gg + g)); }
#pragma unroll
            for (int g = 0; g < CT_GROUP; ++g)
#pragma unroll
                for (int i = 0; i < 4; ++i) { p0[4 * (gg + g) + i] += t0[g][i]; p1[4 * (gg + g) + i] += t1[g][i]; }
            asm volatile("" ::: "memory"); }
    }
}

template <int DK, int DV, int MODE, int SDEPTH>
__device__ __forceinline__ void attn_unit(const Args& a, LAS char* lds, const int tid) {
    constexpr int NKC = DK / 8, NVC = DV / 8, KPT = DK / 64, VPT = DV / 64, NCB = DV / 32, ND0 = DK / 16, QREG = (ND0 > 8 ? 6 : ND0);
    constexpr int SHM_K = 64 * DK * 2, SHM_V = 64 * DV * 2;
    const int wid = __builtin_amdgcn_readfirstlane(tid >> 6), lane = tid & 63, r32 = lane & 31, hi = lane >> 5;
    LAS char* V_lds = lds; LAS char* K_lds = lds + 2 * SHM_V;
    LAS float* ws = (LAS float*)(lds + 2 * SHM_V + 2 * SHM_K) + wid * 64; LAS float* li_l = ws; LAS float* al_l = ws + 32;
    LAS char* qx = lds + 2 * SHM_V + 2 * SHM_K + NW * 256 + wid * ((ND0 - QREG) * 1024) + lane * 16;
    float m_reg = -1e30f, l_reg = 0; f32x16 o[NCB]; bf16x8 qr[ND0];
#pragma unroll
    for (int d = 0; d < NCB; ++d) o[d] = f32x16{};
    const bf16* Qw = a.Q + (long)(wid * QBLK + r32) * a.ldq + hi * 8;
#pragma unroll
    for (int d0 = 0; d0 < ND0; ++d0) qr[d0] = *(const bf16x8*)(Qw + d0 * 16);
    if constexpr (DK == 192) {
        if (a.qrope) {
            const int t = a.qpos0 + wid * QBLK + r32; const float prow = (float)(t >> 6), pcol = (float)(t & 63);
#pragma unroll
            for (int dd = 0; dd < 2; ++dd) {
                bf16x8 x1 = qr[8 + dd], x2 = qr[10 + dd]; const float pos = dd ? pcol : prow;
#pragma unroll
                for (int e = 0; e < 8; ++e) { const float inv = __builtin_amdgcn_exp2f(-(float)(hi * 8 + e) * (13.287712379549449f / 16.0f)); const float ang = pos * inv;
                    const float c = __cosf(ang), s = __sinf(ang); const float f1 = bf2f((unsigned short)x1[e]), f2 = bf2f((unsigned short)x2[e]);
                    x1[e] = (short)f2bf(f1 * c - f2 * s); x2[e] = (short)f2bf(f1 * s + f2 * c); }
                qr[8 + dd] = x1; qr[10 + dd] = x2; }
        }
#pragma unroll
        for (int d0 = QREG; d0 < ND0; ++d0) *(LAS bf16x8*)(qx + (d0 - QREG) * 1024) = qr[d0];
        asm volatile("s_waitcnt lgkmcnt(0)" ::: "memory");
    }
    int koff[KPT], klds[KPT], voff[VPT], vlds[VPT];
#pragma unroll
    for (int i = 0; i < KPT; ++i) { const int q = tid + 512 * i, row = q / NKC, ch = q % NKC; koff[i] = row * a.ld + (ch < 16 ? a.kc0 + 8 * ch : a.kc1 + 8 * (ch - 16)); klds[i] = kswz<DK>(row, ch); }
#pragma unroll
    for (int i = 0; i < VPT; ++i) { const int q = tid + 512 * i, row = q / NVC, ch = q % NVC; voff[i] = row * a.ld + a.vc + 8 * ch; vlds[i] = v_st<NCB>(row, 8 * ch); }
    const int vb0 = (int)(uintptr_t)V_lds + v_rd_base(lane);
    bf16x8 sk[SDEPTH][KPT], sv[SDEPTH][VPT];
    const int NT = a.n0 + a.n1;
#define TROW(j) ((j) < a.n0 ? a.row0 + 64 * (j) : a.row1 + 64 * ((j) - a.n0))
#define SLOAD(i, j) do { const bf16* _b = a.KV + (long)TROW(j) * a.ld; \
    _Pragma("unroll") for (int _k = 0; _k < VPT; ++_k) sv[i][_k] = *(const bf16x8*)(_b + voff[_k]); \
    _Pragma("unroll") for (int _k = 0; _k < KPT; ++_k) sk[i][_k] = *(const bf16x8*)(_b + koff[_k]); } while (0)
#define SWRITE(b, i) do { \
    _Pragma("unroll") for (int _k = 0; _k < VPT; ++_k) *(LAS bf16x8*)(V_lds + (b) * SHM_V + vlds[_k]) = sv[i][_k]; \
    _Pragma("unroll") for (int _k = 0; _k < KPT; ++_k) *(LAS bf16x8*)(K_lds + (b) * SHM_K + klds[_k]) = sk[i][_k]; } while (0)
#define SWAIT() do { if constexpr (SDEPTH == 2) asm volatile("s_waitcnt vmcnt(%0)" :: "n"(KPT + VPT) : "memory"); else asm volatile("s_waitcnt vmcnt(0)" ::: "memory"); } while (0)
#define RESC(al) do { if (__any((al) < 1.f)) { if (hi == 0) al_l[r32] = (al); asm volatile("s_waitcnt lgkmcnt(0)" ::: "memory"); \
    _Pragma("unroll") for (int d = 0; d < NCB; ++d) _Pragma("unroll") for (int r = 0; r < 16; ++r) o[d][r] *= al_l[crow(r, hi)]; } } while (0)
    f32x16 pA0, pA1, pB0, pB1; float mnA, mnB, alA, alB; bf16x8 pa0, pa1, pa2, pa3;
    constexpr int SE = 0, SO = SDEPTH - 1;
    SLOAD(SE, 0); asm volatile("s_waitcnt vmcnt(0)" ::: "memory"); SWRITE(0, SE); __syncthreads();
    qkt<DK, QREG>(pA0, pA1, K_lds, qr, qx, r32, hi); apply_mask<MODE>(pA0, pA1, a, 0, wid, r32, hi); partialSM(pA0, pA1, m_reg, mnA, alA, a.C, a.thr);
    SLOAD(SO, 1); if constexpr (SDEPTH == 2) { if (2 < NT) SLOAD(SE, 2); }
    SWAIT(); SWRITE(1, SO); __syncthreads();
    for (int j = 1; j + 1 < NT; j += 2) {
        SBAR(); qkt<DK, QREG>(pB0, pB1, K_lds + SHM_K, qr, qx, r32, hi);
        finishSM(pA0, pA1, alA, l_reg, pa0, pa1, pa2, pa3); SBAR();
        SLOAD(SO, j + SDEPTH); SBAR();
        pv_all<NCB>(o, vb0, pa0, pa1, pa2, pa3); if constexpr (MODE != 0) SBAR(); apply_mask<MODE>(pB0, pB1, a, j, wid, r32, hi); if constexpr (MODE != 0) SBAR(); partialSM(pB0, pB1, m_reg, mnB, alB, a.C, a.thr);
        __syncthreads(); SWAIT(); SWRITE(0, SE);
        RESC(alB); __syncthreads();
        SBAR(); qkt<DK, QREG>(pA0, pA1, K_lds, qr, qx, r32, hi);
        finishSM(pB0, pB1, alB, l_reg, pa0, pa1, pa2, pa3); SBAR();
        if (SDEPTH == 1 || j + 3 < NT) SLOAD(SE, j + 1 + SDEPTH); SBAR();
        pv_all<NCB>(o, vb0 + SHM_V, pa0, pa1, pa2, pa3); if constexpr (MODE != 0) SBAR(); apply_mask<MODE>(pA0, pA1, a, j + 1, wid, r32, hi); if constexpr (MODE != 0) SBAR(); partialSM(pA0, pA1, m_reg, mnA, alA, a.C, a.thr);
        __syncthreads(); SWAIT(); SWRITE(1, SO);
        RESC(alA); __syncthreads();
    }
    SBAR(); qkt<DK, QREG>(pB0, pB1, K_lds + SHM_K, qr, qx, r32, hi);
    finishSM(pA0, pA1, alA, l_reg, pa0, pa1, pa2, pa3); SBAR();
    pv_all<NCB>(o, vb0, pa0, pa1, pa2, pa3); if constexpr (MODE != 0) SBAR(); apply_mask<MODE>(pB0, pB1, a, NT - 1, wid, r32, hi); if constexpr (MODE != 0) SBAR(); partialSM(pB0, pB1, m_reg, mnB, alB, a.C, a.thr);
    __syncthreads(); RESC(alB);
    finishSM(pB0, pB1, alB, l_reg, pa0, pa1, pa2, pa3); SBAR();
    pv_all<NCB>(o, vb0 + SHM_V, pa0, pa1, pa2, pa3);
    if constexpr (MODE == 1) { if (a.has_sink) l_reg += __builtin_amdgcn_exp2f(a.sinkl2 - m_reg * a.C); }
    if (hi == 0) li_l[r32] = l_reg; asm volatile("s_waitcnt lgkmcnt(0)" ::: "memory");
    float rli[16];
#pragma unroll
    for (int r = 0; r < 16; ++r) rli[r] = __builtin_amdgcn_rcpf(li_l[crow(r, hi)]);
    bf16* Ow = a.O + (long)(wid * QBLK) * a.ldo;
#pragma unroll
    for (int r = 0; r < 16; ++r) { const int orow = crow(r, hi);
#pragma unroll
        for (int d0 = 0; d0 < NCB; ++d0) { const float ov = o[d0][r] * rli[r];
            if (a.o8) ((unsigned char*)a.O)[(long)(wid * QBLK + orow) * a.ldo + d0 * 32 + r32] = (unsigned char)(__builtin_amdgcn_cvt_pk_fp8_f32(ov, ov, 0, false) & 0xff);
            else Ow[(long)orow * a.ldo + d0 * 32 + r32] = f2bf(ov); } }
    __syncthreads();
#undef TROW
#undef SLOAD
#undef SWRITE
#undef SWAIT
#undef RESC
}
#undef SBAR
}
constexpr int DM = 2048, NBATCH = 4, SEQ = 4096, NCTX = 256, DEPTH = 2;
constexpr int ML = NBATCH * SEQ, MC = NBATCH * NCTX, MT = ML + MC;
constexpr int INW = 3904, UW = 4096, QW = 1856;
constexpr int MODW = 6 * DM;
constexpr float LN_EPS = 1e-5f, RMS_EPS = 1e-6f;
constexpr float ALPHA = 1.4142135623730951f;
constexpr float LOG2E = 1.4426950408889634f;
constexpr float A_SCALE = 0.07216878364870323f, B_SCALE = 0.125f, C_SCALE = 0.08838834764831845f, D_SCALE = 0.08838834764831845f;
constexpr int U_CQ = 0, U_CKV = 384, U_KR = 512, U_BQ = 576, U_BK = 1088, U_BV = 1216, U_CQQ = 1344, U_CK = 1856, U_CV = 2368, U_DQ = 2880, U_DK = 3392, U_DV = 3648;
constexpr int QA_Q = 0, QA_KV = 768, QA_KR = 1792;

#ifndef U4_STEP_SIGMA
#define U4_STEP_SIGMA 0.34f
#endif
#ifndef F8_OUT
#define F8_OUT 1
#endif
#ifndef F8_PQ
#define F8_PQ 0
#endif
#ifndef F8_IN
#define F8_IN 1
#endif
#ifndef F8_MERGE
#define F8_MERGE 1
#endif
constexpr size_t MiB = 1u << 20;
constexpr size_t WS_CTL = 0, CTL_ZERO_BYTES = 1 * MiB;
constexpr size_t WS_MOD = 1 * MiB;
constexpr size_t WS_CTAB = 2 * MiB;
constexpr size_t WS_SUBK = 4 * MiB;
constexpr size_t WS_WUP = 5 * MiB;
constexpr size_t WS_WIN = 9 * MiB;
constexpr size_t WS_WC = 41 * MiB;
constexpr size_t WS_WO = 121 * MiB;
constexpr size_t WS_WPQ = 137 * MiB;
constexpr size_t WS_PU = 153 * MiB;
constexpr size_t WS_PV = 281 * MiB;
constexpr size_t WS_BUFA = 409 * MiB;
constexpr size_t WS_BUFB = 477 * MiB;
constexpr size_t WS_UREG = 545 * MiB;
constexpr size_t WS_QKVA = 681 * MiB;
constexpr size_t WS_OQP = 743 * MiB;
constexpr size_t WS_XRES = 811 * MiB;
constexpr size_t WS_EIDX = 947 * MiB;
constexpr size_t WS_EG = 956 * MiB;
constexpr size_t WS_MODP = 965 * MiB;
constexpr size_t WS_SCU = 973 * MiB, WS_SCV = WS_SCU + 2 * 16384 * 4;
constexpr size_t WS_DBG = 973 * MiB + 512 * 1024;
constexpr size_t WS_LNS = 973 * MiB + 840 * 1024;
constexpr size_t WS_HQS = 973 * MiB + 768 * 1024;
constexpr size_t WS_H8 = 974 * MiB;
constexpr size_t WS_END = 1008 * MiB;
constexpr size_t STASH_WG = 131072, P_WG = 262144, WS_STASH = WS_UREG, WS_P = WS_UREG + 32 * MiB, WS_CP = WS_UREG + 96 * MiB;
constexpr int CW_TMO = 0, CW_BAR = 4096;

constexpr int NWAVES = 8;
constexpr int RING_OFF = 0, RING_BYTES = 155648;
constexpr int LDSCTL_OFF = RING_BYTES, MISC_OFF = LDSCTL_OFF + 320;
constexpr int LDS_BYTES = 157696;

#define RLX_AGENT __ATOMIC_RELAXED, __HIP_MEMORY_SCOPE_AGENT
#define LDS_WAIT() asm volatile("s_waitcnt lgkmcnt(0)" ::: "memory")
#define VM_WAIT() asm volatile("s_waitcnt vmcnt(0)" ::: "memory")

#define XB_TMO      128
#define XB_XCNT(j)  (256  + 64 * (j))
#define XB_XSUB(j)  (1280 + 64 * (j))
#define XB_XGEN(j)  (2304 + 64 * (j))
#define XB_TOP      3328
#define XB_TOPGEN   3392
#define XCD_BAR_WORDS 3456
#define XB_SPIN_CAP (1u << 22)
__device__ __forceinline__ unsigned xb_ld(unsigned* p)              { return __hip_atomic_load(p, __ATOMIC_RELAXED, __HIP_MEMORY_SCOPE_AGENT); }
__device__ __forceinline__ unsigned xb_add(unsigned* p, unsigned v) { return __hip_atomic_fetch_add(p, v, __ATOMIC_RELAXED, __HIP_MEMORY_SCOPE_AGENT); }
__device__ __forceinline__ unsigned xb_xcc_id() { return (unsigned)__builtin_amdgcn_s_getreg((3 << 11) | 20) & 0xFu; }
#define XB_SPIN(cond, bar) do { unsigned _sp = 0; while (cond) { __builtin_amdgcn_s_sleep(1); \
    if ((++_sp & 255u) == 0u) { if (xb_ld(&(bar)[XB_TMO])) break; if (_sp > XB_SPIN_CAP) { atomicAdd(&(bar)[XB_TMO], 1u); break; } } } } while (0)
struct XcdBarrier { unsigned* bar; unsigned x; volatile LAS unsigned* st; };
__device__ __forceinline__ XcdBarrier xcd_barrier_post(unsigned* bar, volatile LAS unsigned* st) {
    XcdBarrier b; b.bar = bar; b.x = xb_xcc_id(); b.st = st;
    if (threadIdx.x == 0) (void)xb_add(&bar[XB_XCNT(b.x)], 1u);
    return b;
}
__device__ __forceinline__ void xcd_barrier_complete(unsigned* bar, unsigned x, unsigned& nloc, unsigned& nx) {
    const unsigned G = gridDim.x * gridDim.y * gridDim.z;
    unsigned sum, cnt, mine, sp = 0u;
    for (;;) {
        sum = 0u; cnt = 0u; mine = 0u;
#pragma unroll
        for (unsigned j = 0; j < 16; ++j) { const unsigned c = xb_ld(&bar[XB_XCNT(j)]); sum += c; cnt += (c > 0u) ? 1u : 0u; mine = (j == x) ? c : mine; }
        if (sum == G) break;
        __builtin_amdgcn_s_sleep(1);
        if ((++sp & 255u) == 0u) { if (xb_ld(&bar[XB_TMO])) break; if (sp > XB_SPIN_CAP) { atomicAdd(&bar[XB_TMO], 1u); break; } }
    }
    nloc = mine > 0u ? mine : 1u; nx = cnt > 0u ? cnt : 1u;
}
__device__ __forceinline__ void xcd_barrier(const XcdBarrier& b) {
    asm volatile("s_waitcnt vmcnt(0)" ::: "memory");
    __syncthreads();
    if (threadIdx.x == 0) {
        unsigned* bar = b.bar;
        __builtin_amdgcn_s_waitcnt(0);
        unsigned nloc = b.st[0], nx = b.st[1];
        if (nloc == 0u) { xcd_barrier_complete(bar, b.x, nloc, nx); b.st[0] = nloc; b.st[1] = nx; }
        const unsigned old = xb_add(&bar[XB_XSUB(b.x)], 1u);
        const unsigned gen = old / nloc;
        if (old + 1u == (gen + 1u) * nloc) {
            __builtin_amdgcn_fence(__ATOMIC_RELEASE, "agent");
            asm volatile("s_waitcnt vmcnt(0)" ::: "memory");
            const unsigned og = xb_add(&bar[XB_TOP], 1u);
            const unsigned tg = og / nx;
            if (og + 1u == (tg + 1u) * nx) xb_add(&bar[XB_TOPGEN], 1u);
            else XB_SPIN(xb_ld(&bar[XB_TOPGEN]) == tg, bar);
            __builtin_amdgcn_fence(__ATOMIC_ACQUIRE, "agent");
            xb_add(&bar[XB_XGEN(b.x)], 1u);
            asm volatile("s_waitcnt vmcnt(0)" ::: "memory");
        } else {
            XB_SPIN(xb_ld(&bar[XB_XGEN(b.x)]) == gen, bar);
            __builtin_amdgcn_fence(__ATOMIC_ACQUIRE, "agent");
            asm volatile("s_waitcnt vmcnt(0)" ::: "memory");
        }
    }
    __syncthreads();
}

struct In {
    const float *x, *c, *ctx, *c_ctx, *w_ada, *b_ada, *w_in, *a_q_norm, *a_kv_norm, *a_w_uq, *a_w_ukv, *b_sink, *c_rpb, *d_q_norm, *d_k_norm,
                *w_branch, *w_gate, *b_gate, *w_out, *ln1_g, *ln1_b, *ln2_g, *ln2_b, *peer_w_q, *peer_sub_keys, *peer_u, *peer_v;
};
struct Args { In in; float* out; unsigned char* ws; int ph_lo, ph_hi, li, pad; };
struct Frame { LAS unsigned char* lds; int tid, lane, wave, vcu, G; GAS unsigned char* ws; };
template <class T> __device__ __forceinline__ T* G(T* p) { return (T*)(GAS T*)p; }
typedef const __attribute__((address_space(4))) Args& KA;
typedef const __attribute__((address_space(4))) Args* KAP;
__device__ __forceinline__ KAP kargs() { KAP p = (KAP)__builtin_amdgcn_kernarg_segment_ptr(); asm volatile("" : "+s"(p)); return p; }

__device__ __forceinline__ float wave_sum(float v) {
#pragma unroll
    for (int o = 1; o < 64; o <<= 1) v += __shfl_xor(v, o);
    return v;
}
__device__ __forceinline__ unsigned pk2(float lo, float hi) { return cvt_pk_bf16(lo, hi); }
__device__ __forceinline__ float silu_f(float v) { return v / (1.0f + __expf(-v)); }

__device__ __forceinline__ void p0_transpose_item(const float* W, int ldw, int nblk, bf16* dst, int dpitch, int row_off, int col_off, const float* gain, LAS float* scr, int item, int lane, int f8) {
    const int kb = item / nblk, nb = item % nblk, k0 = 64 * kb, n0 = 32 * nb;
    {
        f32x4 v[8]; const float* wp = W + (size_t)(k0 + (lane >> 3)) * ldw + n0 + (lane & 7) * 4;
#pragma unroll
        for (int i = 0; i < 8; ++i) v[i] = *(const f32x4*)(wp + (size_t)(8 * i) * ldw);
        if (gain) {
#pragma unroll
            for (int i = 0; i < 8; ++i) v[i] *= gain[k0 + (lane >> 3) + 8 * i]; }
        LAS float* sp = scr + (lane >> 3) * 33 + (lane & 7) * 4;
#pragma unroll
        for (int i = 0; i < 8; ++i) { sp[i * 8 * 33 + 0] = v[i][0]; sp[i * 8 * 33 + 1] = v[i][1]; sp[i * 8 * 33 + 2] = v[i][2]; sp[i * 8 * 33 + 3] = v[i][3]; }
    }
    LDS_WAIT(); asm volatile("" ::: "memory");
    const int c = lane & 7;
#pragma unroll
    for (int j = 0; j < 4; ++j) { const int n = (lane >> 3) + 8 * j; const LAS float* s = scr + (8 * c) * 33 + n;
        if (f8) {
            int w0 = __builtin_amdgcn_cvt_pk_fp8_f32(s[0 * 33] * 64.f, s[1 * 33] * 64.f, 0, false); w0 = __builtin_amdgcn_cvt_pk_fp8_f32(s[2 * 33] * 64.f, s[3 * 33] * 64.f, w0, true);
            int w1 = __builtin_amdgcn_cvt_pk_fp8_f32(s[4 * 33] * 64.f, s[5 * 33] * 64.f, 0, false); w1 = __builtin_amdgcn_cvt_pk_fp8_f32(s[6 * 33] * 64.f, s[7 * 33] * 64.f, w1, true);
            *(GAS u32x2*)((GAS unsigned char*)dst + (size_t)(row_off + n0 + n) * dpitch + col_off + k0 + 8 * c) = (u32x2){(unsigned)w0, (unsigned)w1}; }
        else { u32x4 o; o.x = pk2(s[0 * 33], s[1 * 33]); o.y = pk2(s[2 * 33], s[3 * 33]); o.z = pk2(s[4 * 33], s[5 * 33]); o.w = pk2(s[6 * 33], s[7 * 33]);
        *(GAS u32x4*)(dst + (size_t)(row_off + n0 + n) * dpitch + col_off + k0 + 8 * c) = o; } }
    LDS_WAIT(); asm volatile("" ::: "memory");
}
struct TJob { const float* W; int K, N; bf16* dst; int dpitch, row_off, col_off; const float* gain; int f8; };
__device__ __forceinline__ int tjob_get(KA A, int job, TJob& t) {
    const int l = job / 13, j = job % 13; GAS unsigned char* ws = (GAS unsigned char*)A.ws; t.gain = nullptr; t.row_off = 0; t.col_off = 0; t.f8 = 0;
    if (j == 0) { t.W = G(A.in.w_in) + (size_t)l * DM * INW; t.K = DM; t.N = INW; t.dst = F8_IN ? (bf16*)((unsigned char*)(ws + WS_WIN) + (size_t)l * UW * DM) : (bf16*)(ws + WS_WIN) + (size_t)l * UW * DM; t.dpitch = DM; t.f8 = F8_IN; }
    else if (j <= 4) { const int z = j - 1; t.W = G(A.in.w_gate) + ((size_t)l * 4 + z) * DM * DM; t.K = DM; t.N = DM; t.dst = F8_MERGE ? (bf16*)((unsigned char*)(ws + WS_WC) + ((size_t)l * 4 + z) * DM * 2560) : (bf16*)(ws + WS_WC) + ((size_t)l * 4 + z) * DM * 2560; t.dpitch = 2560; t.f8 = F8_MERGE; }
    else if (j <= 8) { const int z = j - 5; t.W = G(A.in.w_branch) + ((size_t)l * 4 + z) * 512 * DM; t.K = 512; t.N = DM; t.dst = F8_MERGE ? (bf16*)((unsigned char*)(ws + WS_WC) + ((size_t)l * 4 + z) * DM * 2560) : (bf16*)(ws + WS_WC) + ((size_t)l * 4 + z) * DM * 2560; t.dpitch = 2560; t.col_off = 2048; t.f8 = F8_MERGE; }
    else if (j == 9) { t.W = G(A.in.w_out) + (size_t)l * DM * DM; t.K = DM; t.N = DM; t.dst = (bf16*)((unsigned char*)(ws + WS_WO) + (size_t)l * DM * DM); t.dpitch = DM; t.f8 = F8_OUT; }
    else if (j == 10) { t.W = G(A.in.peer_w_q) + (size_t)l * DM * DM; t.K = DM; t.N = DM; t.dst = F8_PQ ? (bf16*)((unsigned char*)(ws + WS_WPQ) + (size_t)l * DM * DM) : (bf16*)(ws + WS_WPQ) + (size_t)l * DM * DM; t.dpitch = DM; t.f8 = F8_PQ; }
    else if (j == 11) { t.W = G(A.in.a_w_uq) + (size_t)l * 384 * 768; t.K = 384; t.N = 768; t.dst = (bf16*)(ws + WS_WUP) + (size_t)l * 1792 * 512; t.dpitch = 512; t.gain = G(A.in.a_q_norm) + l * 384; }
    else { t.W = G(A.in.a_w_ukv) + (size_t)l * 128 * 1024; t.K = 128; t.N = 1024; t.dst = (bf16*)(ws + WS_WUP) + (size_t)l * 1792 * 512; t.dpitch = 512; t.row_off = 768; t.col_off = 384; t.gain = G(A.in.a_kv_norm) + l * 128; }
    return (t.K / 64) * (t.N / 32);
}
__device__ __forceinline__ void p0_prologue(const Frame& F, KA A) {
    GAS unsigned char* ws = F.ws;
    const int gw = F.vcu * NWAVES + F.wave, NGW = F.G * NWAVES;
    const long gt = (long)gw * 64 + F.lane, NGT = (long)NGW * 64;
    {
        float* modp = (float*)(ws + WS_MODP);
        for (int it = gw; it < 2 * 16 * 48; it += NGW) {
            const int l = it / 768, ks = (it % 768) / 48, cg = it % 48, n = cg * 256 + F.lane * 4;
            const float* w = G(A.in.w_ada) + ((size_t)l * DM + ks * 128) * MODW + n;
            f32x4 acc[5];
#pragma unroll
            for (int r = 0; r < 5; ++r) acc[r] = (f32x4){0.f, 0.f, 0.f, 0.f};
#pragma unroll 8
            for (int k = 0; k < 128; ++k) {
                const f32x4 wv = *(const f32x4*)(w + (size_t)k * MODW);
                const int kk = ks * 128 + k;
#pragma unroll
                for (int r = 0; r < 5; ++r) { const float cv = (r < 4) ? G(A.in.c)[r * DM + kk] : G(A.in.c_ctx)[kk]; acc[r] += wv * silu_f(cv); }
            }
#pragma unroll
            for (int r = 0; r < 5; ++r) *(f32x4*)(modp + (((size_t)ks * 2 + l) * 5 + r) * MODW + n) = acc[r];
        }
    }
    {
        LAS float* scr = (LAS float*)(F.lds + RING_OFF + F.wave * 16384);
        int base = 0;
        for (int job = 0; job < 26; ++job) {
            TJob t; const int ni = tjob_get(A, job, t);
            int first = gw - (base % NGW); if (first < 0) first += NGW;
            for (int i = first; i < ni; i += NGW) p0_transpose_item(t.W, t.N, t.N / 32, t.dst, t.dpitch, t.row_off, t.col_off, t.gain, scr, i, F.lane, t.f8);
            base += ni;
        }
    }
    for (long i = gt; i < 2L * 192 * 2048 / 8; i += NGT) { const int l = (int)(i / (192 * 256)), r = (int)(i % (192 * 256));
        if (F8_IN) { if (r < 192 * 128) *(u32x4*)((unsigned char*)(ws + WS_WIN) + ((size_t)l * UW + 3904) * DM + (size_t)r * 16) = (u32x4){0u, 0u, 0u, 0u}; }
        else *(u32x4*)((bf16*)(ws + WS_WIN) + ((size_t)l * UW + 3904) * DM + (size_t)r * 8) = (u32x4){0u, 0u, 0u, 0u}; }
    for (long i = gt; i < 2L * 768 * 16; i += NGT) { const int l = (int)(i / (768 * 16)), r = (int)(i % (768 * 16)), row = r / 16, c8 = r % 16; *(u32x4*)((bf16*)(ws + WS_WUP) + ((size_t)l * 1792 + row) * 512 + 384 + c8 * 8) = (u32x4){0u, 0u, 0u, 0u}; }
    for (long i = gt; i < 2L * 1024 * 48; i += NGT) { const int l = (int)(i / (1024 * 48)), r = (int)(i % (1024 * 48)), row = r / 48, c8 = r % 48; *(u32x4*)((bf16*)(ws + WS_WUP) + ((size_t)l * 1792 + 768 + row) * 512 + c8 * 8) = (u32x4){0u, 0u, 0u, 0u}; }
    {
        const long n_sk = 2L * 8 * 2 * 128 * 128 / 8;
        for (long i = gt; i < n_sk; i += NGT) {
            const float* src = G(A.in.peer_sub_keys); bf16* dst = (bf16*)(ws + WS_SUBK);
            const f32x4 a = *(const f32x4*)(src + i * 8), b = *(const f32x4*)(src + i * 8 + 4);
            u32x4 o; o.x = pk2(a[0], a[1]); o.y = pk2(a[2], a[3]); o.z = pk2(b[0], b[1]); o.w = pk2(b[2], b[3]);
            *(u32x4*)(dst + i * 8) = o;
        }
        for (int r = gw; r < 4 * 16384; r += NGW) {
            const bool isu = r < 2 * 16384; const int row = isu ? r : r - 2 * 16384;
            const float* src = (isu ? G(A.in.peer_u) + (size_t)row * 2048 + F.lane * 8 : G(A.in.peer_v) + (size_t)row * 2048 + F.lane * 4);
            f32x4 v[8]; float am = 0.f;
#pragma unroll
            for (int q = 0; q < 8; ++q) { v[q] = *(const f32x4*)(src + (isu ? (q >> 1) * 512 + (q & 1) * 4 : q * 256));
                am = fmaxf(am, fmaxf(fmaxf(__builtin_fabsf(v[q][0]), __builtin_fabsf(v[q][1])), fmaxf(__builtin_fabsf(v[q][2]), __builtin_fabsf(v[q][3])))); }
#pragma unroll
            for (int o = 1; o < 64; o <<= 1) am = fmaxf(am, __shfl_xor(am, o));
            if (isu) {
                float ss = 0.f;
#pragma unroll
                for (int q = 0; q < 8; ++q) ss += (v[q][0] * v[q][0] + v[q][1] * v[q][1]) + (v[q][2] * v[q][2] + v[q][3] * v[q][3]);
#pragma unroll
                for (int o = 1; o < 64; o <<= 1) ss += __shfl_xor(ss, o);
                float step = am * (1.0f / 7.0f); const float st2 = U4_STEP_SIGMA * sqrtf(ss * (1.0f / 2048.0f));
                if (st2 < step) step = st2;
                const float S = step > 0.f ? 1.0f / step : 1.0f;
                unsigned* dst = (unsigned*)(ws + WS_PU) + (size_t)row * 256 + F.lane;
#pragma unroll
                for (int q = 0; q < 4; ++q) { unsigned w = 0u;
#pragma unroll
                    for (int b = 0; b < 4; ++b) { int lo = (int)__builtin_rintf(v[2 * q][b] * S), hi = (int)__builtin_rintf(v[2 * q + 1][b] * S);
                        lo = lo < -7 ? -7 : (lo > 7 ? 7 : lo); hi = hi < -7 ? -7 : (hi > 7 ? 7 : hi);
                        w |= ((unsigned)((lo + 8) & 15) | ((unsigned)(hi & 15) << 4)) << (8 * b); }
                    dst[q * 64] = w; }
                if (F.lane == 0) ((float*)(ws + WS_SCU))[row] = step > 0.f ? step : 1.0f;
            } else {
                const float S = am > 0.f ? 6.0f / am : 1.0f;
                unsigned short* dst = (unsigned short*)(ws + WS_PV) + (size_t)row * 512 + F.lane;
#pragma unroll
                for (int q = 0; q < 8; ++q) { const f32x4 a = v[q] * S;
                    unsigned w = __builtin_amdgcn_cvt_scalef32_pk_fp4_f32(0u, a[0], a[1], 1.0f, 0); w = __builtin_amdgcn_cvt_scalef32_pk_fp4_f32(w, a[2], a[3], 1.0f, 1);
                    dst[q * 64] = (unsigned short)(w & 0xffffu); }
                if (F.lane == 0) ((float*)(ws + WS_SCV))[row] = am > 0.f ? am * (1.0f / 6.0f) : 1.0f;
            }
        }
    }
    {
        float* ct = (float*)(ws + WS_CTAB);
        for (long i = gt; i < 2L * 4 * 15 * 64 * 64; i += NGT) {
            const int kc = (int)(i & 63), qc = (int)((i >> 6) & 63), r = (int)(i >> 12), dr = r % 15, lh = r / 15;
            int cs = qc - 8; cs = cs < 0 ? 0 : (cs > 48 ? 48 : cs);
            int co = kc - qc + 15; co = co < 0 ? 0 : (co > 30 ? 30 : co);
            ct[i] = (kc >= cs && kc < cs + 16) ? G(A.in.c_rpb)[((size_t)lh * 15 + dr) * 31 + co] * (1.0f / C_SCALE) : -1e30f;
        }
    }
}
__device__ __forceinline__ void p1_modreduce(const Frame& F, KA A) {
    const long gt = ((long)F.vcu * NWAVES + F.wave) * 64 + F.lane, NGT = (long)F.G * NWAVES * 64;
    const float* modp = (const float*)(F.ws + WS_MODP); float* mod = (float*)(F.ws + WS_MOD);
    for (long i = gt; i < 2L * 5 * MODW; i += NGT) { const int n = (int)(i % MODW), l = (int)(i / (5 * MODW));
        float s = G(A.in.b_ada)[l * MODW + n];
#pragma unroll
        for (int ks = 0; ks < 16; ++ks) s += modp[(size_t)ks * 2 * 5 * MODW + i];
        mod[i] = s; }
}
__device__ __forceinline__ void p2_modulate0(const Frame& F, KA A) {
    const int gw = F.vcu * NWAVES + F.wave, NGW = F.G * NWAVES;
    const float* mod = (const float*)(F.ws + WS_MOD); bf16* H = (bf16*)(F.ws + WS_BUFA);
    for (int row = gw; row < MT; row += NGW) {
        const float* xr = row < ML ? G(A.in.x) + (size_t)row * DM : G(A.in.ctx) + (size_t)(row - ML) * DM;
        const float* mr = mod + (size_t)(row < ML ? (row >> 12) : 4) * MODW;
        f32x4 xa[4], xb[4], sa[4], sb[4], ca[4], cb[4];
#pragma unroll
        for (int j = 0; j < 4; ++j) { const int c = j * 512 + F.lane * 8; xa[j] = *(const f32x4*)(xr + c); xb[j] = *(const f32x4*)(xr + c + 4);
            sa[j] = *(const f32x4*)(mr + c); sb[j] = *(const f32x4*)(mr + c + 4); ca[j] = *(const f32x4*)(mr + DM + c); cb[j] = *(const f32x4*)(mr + DM + c + 4); }
        asm volatile("" ::: "memory");
#pragma unroll
        for (int j = 0; j < 4; ++j) { const int c = j * 512 + F.lane * 8;
            const f32x4 y0 = xa[j] * (ca[j] + 1.0f) + sa[j], y1 = xb[j] * (cb[j] + 1.0f) + sb[j];
            u32x4 o; o.x = pk2(y0[0], y0[1]); o.y = pk2(y0[2], y0[3]); o.z = pk2(y1[0], y1[1]); o.w = pk2(y1[2], y1[3]);
            if (!(F8_IN && F8_MERGE)) *(u32x4*)(H + (size_t)row * DM + c) = o;
            if (F8_MERGE) { int w0 = __builtin_amdgcn_cvt_pk_fp8_f32(y0[0], y0[1], 0, false); w0 = __builtin_amdgcn_cvt_pk_fp8_f32(y0[2], y0[3], w0, true);
                int w1 = __builtin_amdgcn_cvt_pk_fp8_f32(y1[0], y1[1], 0, false); w1 = __builtin_amdgcn_cvt_pk_fp8_f32(y1[2], y1[3], w1, true);
                *(u32x2*)((unsigned char*)(F.ws + WS_H8) + (size_t)row * DM + c) = (u32x2){(unsigned)w0, (unsigned)w1}; } }
    }
}
__device__ __forceinline__ void rope_pair(float& x1, float& x2, float ang) { const float c = __cosf(ang), s = __sinf(ang); const float y1 = x1 * c - x2 * s, y2 = x1 * s + x2 * c; x1 = y1; x2 = y2; }
__device__ __forceinline__ void enorm_phase(const Frame& F, KA A, int l) {
    const int gw = F.vcu * NWAVES + F.wave, NGW = F.G * NWAVES, lane = F.lane;
    bf16* U = (bf16*)(F.ws + WS_UREG); bf16* QK = (bf16*)(F.ws + WS_QKVA);
    const float* gq = G(A.in.d_q_norm) + l * 128; const float* gk = G(A.in.d_k_norm) + l * 128;
    const float L2T = 13.287712379549449f;
    for (int row = gw; row < MT; row += NGW) {
        bf16* u = U + (size_t)row * UW;
        const bool lat = row < ML; const int t = row & 4095;
        const float prow = lat ? (float)(t >> 6) : 0.f, pcol = lat ? (float)(t & 63) : 0.f;
        const int j64 = lane & 31, hq = lane >> 5;
        unsigned wcq[3];
#pragma unroll
        for (int i = 0; i < 3; ++i) wcq[i] = ((const unsigned*)(u + U_CQ))[lane + 64 * i];
        const unsigned wkv = ((const unsigned*)(u + U_CKV))[lane];
        float kr1 = bf2f(u[U_KR + j64]), kr2 = bf2f(u[U_KR + 32 + j64]);
        float bq1[4], bq2[4];
#pragma unroll
        for (int i = 0; i < 4; ++i) { const bf16* q = u + U_BQ + (hq + 2 * i) * 64; bq1[i] = bf2f(q[j64]); bq2[i] = bf2f(q[32 + j64]); }
        float bk1 = bf2f(u[U_BK + hq * 64 + j64]), bk2 = bf2f(u[U_BK + hq * 64 + 32 + j64]);
        float dq1[4], dq2[4], dk1[2], dk2[2];
#pragma unroll
        for (int hd = 0; hd < 4; ++hd) { dq1[hd] = bf2f(u[U_DQ + hd * 128 + lane]); dq2[hd] = bf2f(u[U_DQ + hd * 128 + 64 + lane]); }
#pragma unroll
        for (int hd = 0; hd < 2; ++hd) { dk1[hd] = bf2f(u[U_DK + hd * 128 + lane]); dk2[hd] = bf2f(u[U_DK + hd * 128 + 64 + lane]); }
        const float gq1 = gq[lane], gq2 = gq[64 + lane], gk1 = gk[lane], gk2 = gk[64 + lane];
        asm volatile("" ::: "memory");
        float ss = 0.f;
#pragma unroll
        for (int i = 0; i < 3; ++i) { const float a = bflo(wcq[i]), b = bfhi(wcq[i]); ss += a * a + b * b; }
        const float rq = rsqrtf(wave_sum(ss) * (1.0f / 384.0f) + RMS_EPS);
        const float va = bflo(wkv), vb = bfhi(wkv);
        const float rkv = rsqrtf(wave_sum(va * va + vb * vb) * (1.0f / 128.0f) + RMS_EPS);
        const float ang64 = ((j64 < 16) ? prow : pcol) * __builtin_amdgcn_exp2f(-(float)(j64 & 15) * (L2T / 16.0f));
        const float ang128 = ((lane < 32) ? prow : pcol) * __builtin_amdgcn_exp2f(-(float)(lane & 31) * (L2T / 32.0f));
        rope_pair(kr1, kr2, ang64);
#pragma unroll
        for (int i = 0; i < 4; ++i) rope_pair(bq1[i], bq2[i], ang64);
        rope_pair(bk1, bk2, ang64);
#pragma unroll
        for (int hd = 0; hd < 4; ++hd) { const float rstd = rsqrtf(wave_sum(dq1[hd] * dq1[hd] + dq2[hd] * dq2[hd]) * (1.0f / 128.0f) + RMS_EPS);
            dq1[hd] = dq1[hd] * rstd * gq1; dq2[hd] = dq2[hd] * rstd * gq2; rope_pair(dq1[hd], dq2[hd], ang128); }
#pragma unroll
        for (int hd = 0; hd < 2; ++hd) { const float rstd = rsqrtf(wave_sum(dk1[hd] * dk1[hd] + dk2[hd] * dk2[hd]) * (1.0f / 128.0f) + RMS_EPS);
            dk1[hd] = dk1[hd] * rstd * gk1; dk2[hd] = dk2[hd] * rstd * gk2; rope_pair(dk1[hd], dk2[hd], ang128); }
#pragma unroll
        for (int i = 0; i < 3; ++i) ((unsigned*)(u + U_CQ))[lane + 64 * i] = pk2(bflo(wcq[i]) * rq, bfhi(wcq[i]) * rq);
        ((unsigned*)(u + U_CKV))[lane] = pk2(va * rkv, vb * rkv);
        if (lane < 32) { bf16* o = QK + (size_t)row * QW + QA_KR; o[lane] = f2bf(kr1); o[32 + lane] = f2bf(kr2); }
#pragma unroll
        for (int i = 0; i < 4; ++i) { bf16* q = u + U_BQ + (hq + 2 * i) * 64; q[j64] = f2bf(bq1[i]); q[32 + j64] = f2bf(bq2[i]); }
        { bf16* q = u + U_BK + hq * 64; q[j64] = f2bf(bk1); q[32 + j64] = f2bf(bk2); }
#pragma unroll
        for (int hd = 0; hd < 4; ++hd) { bf16* q = u + U_DQ + hd * 128; q[lane] = f2bf(dq1[hd]); q[64 + lane] = f2bf(dq2[hd]); }
#pragma unroll
        for (int hd = 0; hd < 2; ++hd) { bf16* q = u + U_DK + hd * 128; q[lane] = f2bf(dk1[hd]); q[64 + lane] = f2bf(dk2[hd]); }
    }
}
__device__ __forceinline__ void ln1_phase(const Frame& F, KA A, int l, int nrows, bf16* HF) {
    const int gw = F.vcu * NWAVES + F.wave, NGW = F.G * NWAVES, lane = F.lane;
    const bf16* Y = (const bf16*)(F.ws + WS_UREG); const float* mod = (const float*)(F.ws + WS_MOD) + (size_t)l * 5 * MODW;
    const float* g = G(A.in.ln1_g) + l * DM; const float* b = G(A.in.ln1_b) + l * DM;
    for (int row = gw; row < nrows; row += NGW) {
        const bf16* y = Y + (size_t)row * DM; const float* mr = mod + (size_t)(row < ML ? (row >> 12) : 4) * MODW;
        f32x4 v[8], gg[8], bb[8], sc[8], sh[8]; u32x4 yw[4]; float s = 0.f;
#pragma unroll
        for (int j = 0; j < 4; ++j) { const int c = j * 512 + lane * 8; yw[j] = *(const u32x4*)(y + c);
            gg[2 * j] = *(const f32x4*)(g + c); gg[2 * j + 1] = *(const f32x4*)(g + c + 4); bb[2 * j] = *(const f32x4*)(b + c); bb[2 * j + 1] = *(const f32x4*)(b + c + 4);
            sc[2 * j] = *(const f32x4*)(mr + 4 * DM + c); sc[2 * j + 1] = *(const f32x4*)(mr + 4 * DM + c + 4); sh[2 * j] = *(const f32x4*)(mr + 3 * DM + c); sh[2 * j + 1] = *(const f32x4*)(mr + 3 * DM + c + 4); }
        asm volatile("" ::: "memory");
#pragma unroll
        for (int j = 0; j < 4; ++j) { v[2 * j] = (f32x4){bflo(yw[j].x), bfhi(yw[j].x), bflo(yw[j].y), bfhi(yw[j].y)}; v[2 * j + 1] = (f32x4){bflo(yw[j].z), bfhi(yw[j].z), bflo(yw[j].w), bfhi(yw[j].w)}; }
#pragma unroll
        for (int j = 0; j < 8; ++j) s += (v[j][0] + v[j][1]) + (v[j][2] + v[j][3]);
        const float mean = wave_sum(s) * (1.0f / DM); float q = 0.f;
#pragma unroll
        for (int j = 0; j < 8; ++j) { v[j] = v[j] - mean; q += (v[j][0] * v[j][0] + v[j][1] * v[j][1]) + (v[j][2] * v[j][2] + v[j][3] * v[j][3]); }
        const float rstd = rsqrtf(wave_sum(q) * (1.0f / DM) + LN_EPS);
        if (lane == 0) *(f32x2*)((float*)(F.ws + WS_LNS) + 2 * (size_t)row) = (f32x2){mean, rstd};
        float am = 0.f;
#pragma unroll
        for (int j = 0; j < 4; ++j) { const int c = j * 512 + lane * 8;
            const f32x4 x0 = v[2 * j] * rstd * gg[2 * j] + bb[2 * j], x1 = v[2 * j + 1] * rstd * gg[2 * j + 1] + bb[2 * j + 1];
            const f32x4 h0 = x0 * (sc[2 * j] + 1.0f) + sh[2 * j], h1 = x1 * (sc[2 * j + 1] + 1.0f) + sh[2 * j + 1];
            u32x4 o; o.x = pk2(h0[0], h0[1]); o.y = pk2(h0[2], h0[3]); o.z = pk2(h1[0], h1[1]); o.w = pk2(h1[2], h1[3]);
            *(u32x4*)(HF + (size_t)row * DM + c) = o;
            v[2 * j] = h0; v[2 * j + 1] = h1;
#pragma unroll
            for (int e = 0; e < 4; ++e) am = fmaxf(am, fmaxf(__builtin_fabsf(h0[e]), __builtin_fabsf(h1[e]))); }
#pragma unroll
        for (int o = 1; o < 64; o <<= 1) am = fmaxf(am, __shfl_xor(am, o));
        const float qs = am > 0.f ? 127.0f / am : 0.f;
#pragma unroll
        for (int j = 0; j < 4; ++j) { const int c = j * 512 + lane * 8; unsigned w0 = 0u, w1 = 0u;
#pragma unroll
            for (int e = 0; e < 4; ++e) { w0 |= ((unsigned)(int)__builtin_rintf(v[2 * j][e] * qs) & 255u) << (8 * e); w1 |= ((unsigned)(int)__builtin_rintf(v[2 * j + 1][e] * qs) & 255u) << (8 * e); }
            *(u32x2*)((unsigned char*)(F.ws + WS_H8) + (size_t)row * DM + c) = (u32x2){w0, w1}; }
        if (lane == 0) ((float*)(F.ws + WS_HQS))[row] = am * (1.0f / 127.0f);
    }
}
namespace peer {
__device__ __forceinline__ unsigned okey(float f) { const unsigned u = __float_as_uint(f); return (u & 0x80000000u) ? ~u : (u | 0x80000000u); }
__device__ __forceinline__ float ikey(unsigned k) { const unsigned u = (k & 0x80000000u) ? (k & 0x7fffffffu) : ~k; return __uint_as_float(u); }
#define CE_DESC(a, b) do { const unsigned _mx = (a) > (b) ? (a) : (b), _mn = (a) > (b) ? (b) : (a); (a) = _mx; (b) = _mn; } while (0)
#define CE_ASC(a, b)  do { const unsigned _mx = (a) > (b) ? (a) : (b), _mn = (a) > (b) ? (b) : (a); (a) = _mn; (b) = _mx; } while (0)
__device__ __forceinline__ void sort16_desc(unsigned (&k)[16]) {
#pragma unroll
    for (int size = 2; size <= 16; size <<= 1)
#pragma unroll
        for (int stride = size >> 1; stride > 0; stride >>= 1)
#pragma unroll
            for (int i = 0; i < 16; ++i) { const int p = i ^ stride; if (p > i) { if ((i & size) == 0) CE_DESC(k[i], k[p]); else CE_ASC(k[i], k[p]); } }
}
__device__ __forceinline__ void merge16_desc(unsigned (&a)[16], const unsigned (&b)[16]) {
#pragma unroll
    for (int i = 0; i < 16; ++i) a[i] = a[i] > b[15 - i] ? a[i] : b[15 - i];
#pragma unroll
    for (int stride = 8; stride > 0; stride >>= 1)
#pragma unroll
        for (int i = 0; i < 16; ++i) { const int p = i ^ stride; if (p > i) CE_DESC(a[i], a[p]); }
}
constexpr int slot_x(int s) { int n = 0; for (int x = 0; x < 16; ++x) for (int y = 0; y < 16; ++y) if ((x + 1) * (y + 1) <= 16) { if (n == s) return x; ++n; } return -1; }
constexpr int slot_y(int s) { int n = 0; for (int x = 0; x < 16; ++x) for (int y = 0; y < 16; ++y) if ((x + 1) * (y + 1) <= 16) { if (n == s) return y; ++n; } return -1; }
template <int S> struct Slot { static constexpr int x = slot_x(S), y = slot_y(S); };
template <int S> __device__ __forceinline__ void cand_one(unsigned (&c)[64], const float (&v0)[16], const float (&v1)[16], const unsigned (&i0)[16], const unsigned (&i1)[16], LAS unsigned short* tbl) {
    if constexpr (Slot<S>::x >= 0) { c[S] = (okey(v0[Slot<S>::x] + v1[Slot<S>::y]) & ~63u) | (unsigned)(63 - S); tbl[S] = (unsigned short)(i0[Slot<S>::x] * 128u + i1[Slot<S>::y]); }
    else c[S] = 0u;
}
template <int... S> __device__ __forceinline__ void cand_all(unsigned (&c)[64], const float (&v0)[16], const float (&v1)[16], const unsigned (&i0)[16], const unsigned (&i1)[16], LAS unsigned short* tbl, std::integer_sequence<int, S...>) {
    (cand_one<S>(c, v0, v1, i0, i1, tbl), ...);
}
#ifndef TOPK_SEC
#define TOPK_SEC -1
#endif
#define TSEC(n) do { if (TOPK_SEC >= 0) { __builtin_amdgcn_sched_barrier(0); const unsigned long long tn_ = __builtin_amdgcn_s_memrealtime(); if (TOPK_SEC == (n) && lane == 0 && acc_w) *acc_w += (unsigned)(tn_ - tsec_); tsec_ = tn_; __builtin_amdgcn_sched_barrier(0); } } while (0)
__device__ __forceinline__ void topk_item(const bf16* QP, const LAS unsigned char* sklds, int* EIDX, float* EG, int tok0, int h, LAS unsigned short* tblw, int lane, volatile LAS unsigned* acc_w = nullptr) {
    unsigned long long tsec_ = TOPK_SEC >= 0 ? __builtin_amdgcn_s_memrealtime() : 0ull;
    const int r32 = lane & 31, hi = lane >> 5;
    const bf16* qrow = QP + (size_t)(tok0 + r32) * DM + h * 256 + hi * 8;
    unsigned L[2][16];
    bf16x8 bqa[2][8];
#pragma unroll
    for (int p = 0; p < 2; ++p)
#pragma unroll
        for (int d0 = 0; d0 < 8; ++d0) bqa[p][d0] = *(const bf16x8*)(qrow + p * 128 + d0 * 16);
#pragma unroll
    for (int p = 0; p < 2; ++p) {
        const LAS unsigned char* skp = sklds + p * 32768 + r32 * 256;
        unsigned g0[16];
#pragma unroll
        for (int i = 0; i < 16; ++i) g0[i] = 0u;
#pragma unroll 1
        for (int kb = 0; kb < 4; ++kb) {
            f32x16 acc = f32x16{};
#pragma unroll
            for (int d0 = 0; d0 < 8; ++d0) { const bf16x8 ak = *(const LAS bf16x8*)(skp + kb * 8192 + (((2 * d0 + hi) ^ (r32 & 7)) << 4)); acc = __builtin_amdgcn_mfma_f32_32x32x16_bf16(ak, bqa[p][d0], acc, 0, 0, 0); }
            unsigned g[16]; const unsigned kbase = (unsigned)(127 - 32 * kb - 4 * hi);
#pragma unroll
            for (int r = 0; r < 16; ++r) g[r] = (okey(acc[r]) & ~127u) | (kbase - (unsigned)((r & 3) + 8 * (r >> 2)));
            sort16_desc(g);
            merge16_desc(g0, g);
        }
        LDS_WAIT(); asm volatile("" ::: "memory"); TSEC(0);
        unsigned (&gA)[16] = g0;
        unsigned o[16];
#pragma unroll
        for (int i = 0; i < 16; ++i) o[i] = (unsigned)__shfl_xor((int)gA[i], 32);
        merge16_desc(gA, o);
#pragma unroll
        for (int i = 0; i < 16; ++i) L[p][i] = gA[i];
        TSEC(1);
    }
    float v0[16], v1[16]; unsigned i0[16], i1[16];
#pragma unroll
    for (int i = 0; i < 16; ++i) { v0[i] = ikey(L[0][i] & ~127u); v1[i] = ikey(L[1][i] & ~127u); i0[i] = 127u - (L[0][i] & 127u); i1[i] = 127u - (L[1][i] & 127u); }
    LAS unsigned short* tbl = tblw + lane * 66;
    unsigned c[64];
    cand_all(c, v0, v1, i0, i1, tbl, std::make_integer_sequence<int, 64>{});
    unsigned c0[16], c1[16], c2[16], c3[16];
#pragma unroll
    for (int i = 0; i < 16; ++i) { c0[i] = c[i]; c1[i] = c[16 + i]; c2[i] = c[32 + i]; c3[i] = c[48 + i]; }
    sort16_desc(c0); sort16_desc(c1); sort16_desc(c2); sort16_desc(c3);
    merge16_desc(c0, c1); merge16_desc(c2, c3); merge16_desc(c0, c2);
    LDS_WAIT(); asm volatile("" ::: "memory"); TSEC(2);
    float best[16]; int eid[16]; float sum = 0.f;
    const float mx = ikey(c0[0] & ~63u);
#pragma unroll
    for (int i = 0; i < 16; ++i) { const unsigned s = 63u - (c0[i] & 63u); eid[i] = (int)tbl[s]; best[i] = __expf(ikey(c0[i] & ~63u) - mx); sum += best[i]; }
    const float inv = 1.0f / sum;
    if (hi == 0) {
        int* ep = EIDX + (size_t)(tok0 + r32) * 128 + h * 16; float* gp = EG + (size_t)(tok0 + r32) * 128 + h * 16;
#pragma unroll
        for (int i = 0; i < 4; ++i) { *(pg8::v4i_t*)(ep + 4 * i) = (pg8::v4i_t){eid[4 * i], eid[4 * i + 1], eid[4 * i + 2], eid[4 * i + 3]}; *(f32x4*)(gp + 4 * i) = (f32x4){best[4 * i] * inv, best[4 * i + 1] * inv, best[4 * i + 2] * inv, best[4 * i + 3] * inv}; }
    }
    LDS_WAIT(); asm volatile("" ::: "memory"); TSEC(3);
}
}
namespace p4 {
constexpr int L_SE = 0, L_SG = 4 * 128 * 2, L_WAVE = L_SG + 4 * 128 * 4;
constexpr int L_PAR = 8 * L_WAVE;
__device__ __forceinline__ float rowsum16(float d) {
    d += __int_as_float(__builtin_amdgcn_update_dpp(__float_as_int(d), __float_as_int(d), 0x128, 0xF, 0xF, false));
    d += __int_as_float(__builtin_amdgcn_update_dpp(__float_as_int(d), __float_as_int(d), 0x124, 0xF, 0xF, false));
    d += __int_as_float(__builtin_amdgcn_update_dpp(__float_as_int(d), __float_as_int(d), 0x122, 0xF, 0xF, false));
    d += __int_as_float(__builtin_amdgcn_update_dpp(__float_as_int(d), __float_as_int(d), 0x121, 0xF, 0xF, false));
    return d;
}
__device__ __forceinline__ f32x2 cvt4(unsigned w, int t) {
    return t == 0 ? __builtin_amdgcn_cvt_scalef32_pk_f32_fp4(w, 1.0f, 0) : (t == 1 ? __builtin_amdgcn_cvt_scalef32_pk_f32_fp4(w, 1.0f, 1) : (t == 2 ? __builtin_amdgcn_cvt_scalef32_pk_f32_fp4(w, 1.0f, 2) : __builtin_amdgcn_cvt_scalef32_pk_f32_fp4(w, 1.0f, 3)));
}
struct Row { u32x4 p[4]; float sc, sc2; };
template <bool TWO> __device__ __forceinline__ void load_row(Row& r, const unsigned char* tab_l, const float* sct, const float* sct2, int e) {
    __builtin_amdgcn_sched_barrier(0);
    const unsigned char* g = tab_l + (size_t)(unsigned)e * 1024;
#pragma unroll
    for (int j = 0; j < 4; ++j) r.p[j] = *(const u32x4*)(g + j * 256);
    if constexpr (TWO) { r.sc = sct[e]; r.sc2 = sct2[e]; }
    __builtin_amdgcn_sched_barrier(0);
}
__device__ __forceinline__ float dot128(const f32x2 (&h)[64], const Row& r) {
    f32x2 a = {0.f, 0.f}, b = {0.f, 0.f};
#pragma unroll
    for (int j = 0; j < 4; ++j)
#pragma unroll
        for (int q = 0; q < 4; ++q) { const unsigned w = r.p[j][q];
            a = __builtin_elementwise_fma(h[(j * 4 + q) * 4 + 0], cvt4(w, 0), a); b = __builtin_elementwise_fma(h[(j * 4 + q) * 4 + 1], cvt4(w, 1), b);
            a = __builtin_elementwise_fma(h[(j * 4 + q) * 4 + 2], cvt4(w, 2), a); b = __builtin_elementwise_fma(h[(j * 4 + q) * 4 + 3], cvt4(w, 3), b); }
    return (a.x + a.y) + (b.x + b.y);
}
__device__ __forceinline__ void axpy128(f32x2 (&acc)[64], const float w, const Row& r) {
    const f32x2 ww = {w, w};
#pragma unroll
    for (int j = 0; j < 4; ++j)
#pragma unroll
        for (int q = 0; q < 4; ++q) { const unsigned x = r.p[j][q];
#pragma unroll
            for (int t = 0; t < 4; ++t) acc[(j * 4 + q) * 4 + t] = __builtin_elementwise_fma(ww, cvt4(x, t), acc[(j * 4 + q) * 4 + t]); }
}
__device__ __forceinline__ float gelu_as(float v) {
    const float av = __builtin_fabsf(v), t = __builtin_amdgcn_rcpf(av * 0.2316418882f + 1.0f);
    float q = t * 0.5307027145f + (-0.7265760135f); q = q * t + 0.7107068705f; q = q * t + (-0.142248368f); q = q * t + 0.127414796f; q = q * t;
    const float e = __builtin_amdgcn_exp2f((v * v) * (-0.72134752044f)); const float m = v * (q * e); return v < 0.f ? m : v - m;
}
}

__device__ __forceinline__ void pexp4_phase(const Frame& F, KA A, int l, int ntok, const bf16* HF, float* outp, bf16* Hnext) {
    using namespace p4;
    const unsigned char* PU8 = (const unsigned char*)(F.ws + WS_PU) + (size_t)l * 16384 * 1024; const unsigned char* PV8 = (const unsigned char*)(F.ws + WS_PV) + (size_t)l * 16384 * 1024;
    const float* SCU = (const float*)(F.ws + WS_SCU) + l * 16384; const float* SCV = (const float*)(F.ws + WS_SCV) + l * 16384;
    const int* EIDX = (const int*)(F.ws + WS_EIDX); const float* EG = (const float*)(F.ws + WS_EG);
    float* X1 = (float*)(F.ws + WS_UREG); const float* mod = (const float*)(F.ws + WS_MOD);
    const float* g2 = G(A.in.ln2_g) + l * DM; const float* b2 = G(A.in.ln2_b) + l * DM;
    LAS unsigned char* wl = F.lds + RING_OFF + F.wave * L_WAVE;
    LAS unsigned short* se = (LAS unsigned short*)(wl + L_SE); LAS float* sg = (LAS float*)(wl + L_SG);
    const int gw = F.vcu * NWAVES + F.wave, NW = F.G * NWAVES;
    const int nfull = ntok / (NW * 4), nrem = ntok - nfull * NW * 4, nsplit = (nrem + NW - 1) / NW;
#ifndef PEXP_SEC
#define PEXP_SEC -1
#endif
#define PSEC(n) do { if (PEXP_SEC >= 0) { const unsigned long long tn_ = __builtin_amdgcn_s_memrealtime(); if (PEXP_SEC == (n) && F.wave == 0 && F.lane == 0) *(volatile LAS unsigned*)(F.lds + MISC_OFF + 256) += (unsigned)(tn_ - tsec_); tsec_ = tn_; } } while (0)
    for (int pass = 0; pass < nfull + nsplit; ++pass) {
        unsigned long long tsec_ = PEXP_SEC >= 0 ? __builtin_amdgcn_s_memrealtime() : 0ull;
        {
            __syncthreads();
            int t0 = pass < nfull ? pass * NW * 4 + F.vcu * 32 : nfull * NW * 4 + (pass - nfull) * NW + F.vcu * NWAVES; t0 = t0 < ntok ? t0 : ntok - 1;
            const int bi = t0 < ML ? (t0 >> 12) : 4;
            const float* mrb = mod + ((size_t)l * 5 + bi) * MODW; const float* mnb = mod + ((size_t)(l + 1 < DEPTH ? l + 1 : l) * 5 + bi) * MODW;
            const int c4 = F.tid, slot = ((c4 >> 7) * 8 + (c4 & 7)) * 16 + ((c4 >> 3) & 15);
            const f32x4 a0 = *(const f32x4*)(g2 + 4 * c4), a1 = *(const f32x4*)(b2 + 4 * c4), a2 = *(const f32x4*)(mrb + 5 * DM + 4 * c4), a3 = *(const f32x4*)(mnb + 4 * c4), a4 = *(const f32x4*)(mnb + DM + 4 * c4);
            const f32x4 a5 = *(const f32x4*)(G(A.in.ln1_g) + l * DM + 4 * c4), a6 = *(const f32x4*)(G(A.in.ln1_b) + l * DM + 4 * c4);
            LAS f32x4* P = (LAS f32x4*)(F.lds + RING_OFF + L_PAR);
            P[slot] = a0; P[512 + slot] = a1; P[1024 + slot] = a2; P[1536 + slot] = a3; P[2048 + slot] = a4; P[2560 + slot] = a5; P[3072 + slot] = a6;
        }
        int lane = F.lane; asm volatile("" : "+v"(lane));
        const int qd = lane >> 4, l16 = lane & 15;
        const bool split = pass >= nfull;
        int tokw[4];
#pragma unroll
        for (int k = 0; k < 4; ++k) tokw[k] = split ? ((k == 0 && (pass - nfull) * NW + gw < nrem) ? nfull * NW * 4 + (pass - nfull) * NW + gw : -1) : pass * NW * 4 + gw * 4 + k;
        const bool idle = split && tokw[0] < 0;
        if (idle) tokw[0] = 0;
        unsigned k0[4], k1[4];
#pragma unroll
        for (int k = 0; k < 4; ++k) { const int tk = tokw[k] >= 0 ? tokw[k] : tokw[0];
            k0[k] = ((unsigned)EIDX[(size_t)tk * 128 + lane] << 7) | (unsigned)lane; k1[k] = ((unsigned)EIDX[(size_t)tk * 128 + 64 + lane] << 7) | (unsigned)(64 + lane); }
#pragma unroll
        for (int k = 0; k < 4; ++k) {
#pragma unroll
            for (int size = 2; size <= 128; size <<= 1)
#pragma unroll
                for (int stride = size >> 1; stride > 0; stride >>= 1) {
                    if (stride == 64) { const unsigned lo = k0[k] < k1[k] ? k0[k] : k1[k], hi = k0[k] < k1[k] ? k1[k] : k0[k]; k0[k] = lo; k1[k] = hi; }
                    else {
                        const unsigned p0 = (unsigned)__shfl_xor((int)k0[k], stride), p1 = (unsigned)__shfl_xor((int)k1[k], stride);
                        const bool lower = (lane & stride) == 0;
                        const bool up0 = (lane & size) == 0 || size == 128 || size == 64;
                        const bool up1 = size == 128 ? true : (size == 64 ? false : (lane & size) == 0);
                        k0[k] = (lower == up0) ? (k0[k] < p0 ? k0[k] : p0) : (k0[k] < p0 ? p0 : k0[k]);
                        k1[k] = (lower == up1) ? (k1[k] < p1 ? k1[k] : p1) : (k1[k] < p1 ? p1 : k1[k]);
                    }
                }
        }
#pragma unroll
        for (int k = 0; k < 4; ++k) { const int tk = tokw[k] >= 0 ? tokw[k] : tokw[0];
            se[k * 128 + lane] = (unsigned short)(k0[k] >> 7); se[k * 128 + 64 + lane] = (unsigned short)(k1[k] >> 7);
            sg[k * 128 + lane] = EG[(size_t)tk * 128 + (k0[k] & 127u)]; sg[k * 128 + 64 + lane] = EG[(size_t)tk * 128 + (k1[k] & 127u)]; }
        LDS_WAIT(); asm volatile("s_waitcnt vmcnt(0)" ::: "memory");
        __syncthreads();
        if (idle) continue;
        PSEC(0);
        const int tok = split ? tokw[0] : (qd == 0 ? tokw[0] : (qd == 1 ? tokw[1] : (qd == 2 ? tokw[2] : tokw[3])));
        const int lbase = split ? 32 * qd : 128 * qd;
        const int nsteps = split ? 32 : 128;
        LAS const unsigned short* seq = se + lbase; LAS float* sgq = sg + lbase;
#ifndef P4_NO_U
        {
            int hq[32]; int slo = 0;
            { const unsigned char* hp = (const unsigned char*)(F.ws + WS_H8) + (size_t)tok * DM + l16 * 32;
#pragma unroll
              for (int k = 0; k < 8; ++k) { const u32x4 t_ = *(const u32x4*)(hp + (k >> 1) * 512 + (k & 1) * 16); hq[4 * k] = (int)t_.x; hq[4 * k + 1] = (int)t_.y; hq[4 * k + 2] = (int)t_.z; hq[4 * k + 3] = (int)t_.w; } }
            const float ts = ((const float*)(F.ws + WS_HQS))[tok];
#pragma unroll
            for (int k = 0; k < 16; ++k) slo = __builtin_amdgcn_sdot4(0x01010101, hq[2 * k], slo, false);
            const float slo8 = (float)(8 * slo);
            const unsigned char* tab_l = PU8 + l16 * 16;
            p4::Row r0, r1, r2, r3;
            p4::load_row<true>(r0, tab_l, SCU, SCV, seq[0]); p4::load_row<true>(r1, tab_l, SCU, SCV, seq[1]); p4::load_row<true>(r2, tab_l, SCU, SCV, seq[2]);
            int en = seq[3];
#define USTEP(R, I) do { int a_ = 0, b_ = 0; _Pragma("unroll") for (int j_ = 0; j_ < 4; ++j_) _Pragma("unroll") for (int q_ = 0; q_ < 4; ++q_) { const unsigned w_ = R.p[j_][q_]; \
                a_ = __builtin_amdgcn_sdot4((int)(w_ & 0x0f0f0f0fu), hq[(j_ * 4 + q_) * 2], a_, false); b_ = __builtin_amdgcn_sdot4((int)(w_ & 0xf0f0f0f0u), hq[(j_ * 4 + q_) * 2 + 1], b_, false); } \
                const float gate = sgq[I]; const float d = p4::rowsum16(((float)a_ - slo8) + (float)b_ * 0.0625f) * (R.sc * ts); sgq[I] = p4::gelu_as(d) * gate * R.sc2; } while (0)
#define NXT(K) seq[i + (K) < nsteps ? i + (K) : nsteps - 1]
            for (int i = 0; i < nsteps; i += 4) {
                p4::load_row<true>(r3, tab_l, SCU, SCV, en); en = NXT(4); USTEP(r0, i);
                p4::load_row<true>(r0, tab_l, SCU, SCV, en); en = NXT(5); USTEP(r1, i + 1);
                p4::load_row<true>(r1, tab_l, SCU, SCV, en); en = NXT(6); USTEP(r2, i + 2);
                p4::load_row<true>(r2, tab_l, SCU, SCV, en); en = NXT(7); USTEP(r3, i + 3);
            }
#undef USTEP
        }
#endif
        LDS_WAIT(); asm volatile("s_waitcnt vmcnt(0)" ::: "memory"); PSEC(1);
#ifndef P4_NO_V
        {
            f32x2 acc[64];
#pragma unroll
            for (int k = 0; k < 64; ++k) acc[k] = (f32x2){0.f, 0.f};
            const unsigned char* tab_l = PV8 + l16 * 16;
            p4::Row r0, r1, r2, r3;
            p4::load_row<false>(r0, tab_l, nullptr, nullptr, seq[0]); p4::load_row<false>(r1, tab_l, nullptr, nullptr, seq[1]); p4::load_row<false>(r2, tab_l, nullptr, nullptr, seq[2]);
            int en = seq[3];
            for (int i = 0; i < nsteps; i += 4) {
                p4::load_row<false>(r3, tab_l, nullptr, nullptr, en); en = NXT(4); p4::axpy128(acc, sgq[i], r0);
                p4::load_row<false>(r0, tab_l, nullptr, nullptr, en); en = NXT(5); p4::axpy128(acc, sgq[i + 1], r1);
                p4::load_row<false>(r1, tab_l, nullptr, nullptr, en); en = NXT(6); p4::axpy128(acc, sgq[i + 2], r2);
                p4::load_row<false>(r2, tab_l, nullptr, nullptr, en); en = NXT(7); p4::axpy128(acc, sgq[i + 3], r3);
            }
#undef NXT
            asm volatile("s_waitcnt vmcnt(0)" ::: "memory"); PSEC(2);
#ifndef P4_NO_SPLITC
            if (split) {
#pragma unroll
                for (int k = 0; k < 64; ++k) {
                    { auto r0 = __builtin_amdgcn_permlane16_swap(__float_as_uint(acc[k].x), __float_as_uint(acc[k].x), false, false); acc[k].x = __uint_as_float(r0[0]) + __uint_as_float(r0[1]);
                      auto r1 = __builtin_amdgcn_permlane16_swap(__float_as_uint(acc[k].y), __float_as_uint(acc[k].y), false, false); acc[k].y = __uint_as_float(r1[0]) + __uint_as_float(r1[1]); }
                    { auto r0 = __builtin_amdgcn_permlane32_swap(__float_as_uint(acc[k].x), __float_as_uint(acc[k].x), false, false); acc[k].x = __uint_as_float(r0[0]) + __uint_as_float(r0[1]);
                      auto r1 = __builtin_amdgcn_permlane32_swap(__float_as_uint(acc[k].y), __float_as_uint(acc[k].y), false, false); acc[k].y = __uint_as_float(r1[0]) + __uint_as_float(r1[1]); }
                }
            }
#endif
#ifdef P4_NO_LN2
            for (int k = 0; k < 64; ++k) *(f32x2*)(outp + (size_t)tok * DM + k * 32 + l16 * 2) = acc[k];
#else
            const bf16* y1 = (const bf16*)(F.ws + WS_UREG) + (size_t)tok * DM;
            if (!split || qd == 0) {
                float s1 = 0.f, s2 = 0.f; int lq = l16; asm volatile("" : "+v"(lq));
                LAS const f32x4* P = (LAS const f32x4*)(F.lds + RING_OFF + L_PAR) + lq;
                const f32x2 st1 = *(const f32x2*)((const float*)(F.ws + WS_LNS) + 2 * (size_t)tok);
                { const GAS bf16* py = (const GAS bf16*)y1 + lq * 32;
#pragma unroll
                  for (int j = 0; j < 4; ++j) {
                    u32x4 yw[4];
#pragma unroll
                    for (int k = 0; k < 4; ++k) yw[k] = *(const GAS u32x4*)(py + k * 8);
#pragma unroll
                    for (int k = 0; k < 8; ++k) { const int slot = (j * 8 + k) * 16; const f32x4 ga = P[1024 + slot], g1 = P[2560 + slot], b1 = P[3072 + slot]; const int idx = (j * 4 + (k >> 1)) * 4 + (k & 1) * 2;
                        const unsigned wa = (k & 1) ? yw[k >> 1].z : yw[k >> 1].x, wb = (k & 1) ? yw[k >> 1].w : yw[k >> 1].y;
                        const f32x4 xa = ((f32x4){bflo(wa), bfhi(wa), bflo(wb), bfhi(wb)} - st1.x) * st1.y * g1 + b1;
                        const f32x2 a0 = acc[idx], a1 = acc[idx + 1];
                        const f32x4 v = (f32x4){ALPHA * xa[0] + ga[0] * a0.x, ALPHA * xa[1] + ga[1] * a0.y, ALPHA * xa[2] + ga[2] * a1.x, ALPHA * xa[3] + ga[3] * a1.y};
                        s1 += (v[0] + v[1]) + (v[2] + v[3]); s2 += (v[0] * v[0] + v[1] * v[1]) + (v[2] * v[2] + v[3] * v[3]);
                        acc[idx] = (f32x2){v[0], v[1]}; acc[idx + 1] = (f32x2){v[2], v[3]}; }
                    py += 512; asm volatile("" : "+v"(py)); if (j & 1) asm volatile("" : "+v"(s1), "+v"(s2) :: "memory"); }
                }
                const float mean = p4::rowsum16(s1) * (1.0f / DM); const float var = p4::rowsum16(s2) * (1.0f / DM) - mean * mean;
                const float rstd = rsqrtf((var > 0.f ? var : 0.f) + LN_EPS);
                GAS float* po = Hnext ? (GAS float*)((GAS bf16*)outp + (size_t)tok * DM + lq * 32) : (GAS float*)outp + (size_t)tok * DM + lq * 32; GAS bf16* ph = (GAS bf16*)Hnext + (size_t)tok * DM + lq * 32; GAS unsigned char* p8 = (GAS unsigned char*)(F.ws + WS_H8) + (size_t)tok * DM + lq * 32;
#pragma unroll
                for (int j = 0; j < 4; ++j) {
#pragma unroll
                    for (int hf = 0; hf < 2; ++hf) { u32x4 o0, o1;
#pragma unroll
                        for (int q = 0; q < 4; ++q) { const int k = 4 * hf + q, idx = (j * 4 + (k >> 1)) * 4 + (k & 1) * 2, slot = (j * 8 + k) * 16;
                            const f32x4 v = (f32x4){acc[idx].x, acc[idx].y, acc[idx + 1].x, acc[idx + 1].y}; const f32x4 ga = P[slot], ba = P[512 + slot];
                            const f32x4 y = (v - mean) * rstd * ga + ba;
                            if (Hnext) *(GAS u32x2*)((GAS bf16*)po + k * 4) = (u32x2){pk2(y[0], y[1]), pk2(y[2], y[3])};
                            else *(GAS f32x4*)(po + k * 4) = y;
                            if (Hnext) { const f32x4 z = y * (P[2048 + slot] + 1.0f) + P[1536 + slot]; const unsigned w0 = pk2(z[0], z[1]), w1 = pk2(z[2], z[3]);
                                if (q == 0) { o0.x = w0; o0.y = w1; } else if (q == 1) { o0.z = w0; o0.w = w1; } else if (q == 2) { o1.x = w0; o1.y = w1; } else { o1.z = w0; o1.w = w1; } } }
                        if (Hnext) { if (!(F8_IN && F8_MERGE)) { *(GAS u32x4*)(ph + hf * 16) = o0; *(GAS u32x4*)(ph + hf * 16 + 8) = o1; }
                            if (F8_MERGE) { u32x4 q8;
#pragma unroll
                                for (int q = 0; q < 4; ++q) { const unsigned wa = q < 2 ? (q == 0 ? o0.x : o0.z) : (q == 2 ? o1.x : o1.z), wb = q < 2 ? (q == 0 ? o0.y : o0.w) : (q == 2 ? o1.y : o1.w);
                                    int w = __builtin_amdgcn_cvt_pk_fp8_f32(bflo(wa), bfhi(wa), 0, false); w = __builtin_amdgcn_cvt_pk_fp8_f32(bflo(wb), bfhi(wb), w, true); q8[q] = (unsigned)w; }
                                *(GAS u32x4*)(p8 + hf * 16) = q8; } }
                        asm volatile("" ::: "memory"); }
                    po += Hnext ? 256 : 512; ph += 512; p8 += 512; asm volatile("" : "+v"(po), "+v"(ph), "+v"(p8)); }
            }
#endif
        }
#endif
        LDS_WAIT(); asm volatile("s_waitcnt vmcnt(0)" ::: "memory"); PSEC(3);
    }
}
__device__ __forceinline__ float gelu_exact(float v) { return 0.5f * v * (1.0f + erff(v * 0.70710678118654752f)); }
__device__ __forceinline__ float reduce16(float (&p)[16], int lane) {
    float q[8], r[4], s[2];
    { const bool up = lane & 1;
#pragma unroll
      for (int k = 0; k < 8; ++k) { const float send = up ? p[2 * k] : p[2 * k + 1], keep = up ? p[2 * k + 1] : p[2 * k]; q[k] = keep + __shfl_xor(send, 1); } }
    { const bool up = lane & 2;
#pragma unroll
      for (int k = 0; k < 4; ++k) { const float send = up ? q[2 * k] : q[2 * k + 1], keep = up ? q[2 * k + 1] : q[2 * k]; r[k] = keep + __shfl_xor(send, 2); } }
    { const bool up = lane & 4;
#pragma unroll
      for (int k = 0; k < 2; ++k) { const float send = up ? r[2 * k] : r[2 * k + 1], keep = up ? r[2 * k + 1] : r[2 * k]; s[k] = keep + __shfl_xor(send, 4); } }
    float t;
    { const bool up = lane & 8; const float send = up ? s[0] : s[1], keep = up ? s[1] : s[0]; t = keep + __shfl_xor(send, 8); }
    t += __shfl_xor(t, 16); t += __shfl_xor(t, 32);
    return t;
}
__device__ __forceinline__ void pexp_phase(const Frame& F, KA A, int l, int ntok, const bf16* HF, float* outp, bf16* Hnext) {
    const int gw = F.vcu * NWAVES + F.wave, NGW = F.G * NWAVES, lane = F.lane;
    const bf16* PU = (const bf16*)(F.ws + WS_PU) + (size_t)l * 16384 * DM; const bf16* PV = (const bf16*)(F.ws + WS_PV) + (size_t)l * 16384 * DM;
    const int* EIDX = (const int*)(F.ws + WS_EIDX); const float* EG = (const float*)(F.ws + WS_EG);
    const float* X1 = (const float*)(F.ws + WS_UREG); const float* mod = (const float*)(F.ws + WS_MOD);
    const float* g2 = G(A.in.ln2_g) + l * DM; const float* b2 = G(A.in.ln2_b) + l * DM;
    for (int tok = gw; tok < ntok; tok += NGW) {
        float h[32], acc[32];
#pragma unroll
        for (int j = 0; j < 4; ++j) { const bf16x8 v = *(const bf16x8*)(HF + (size_t)tok * DM + j * 512 + lane * 8);
#pragma unroll
            for (int e = 0; e < 8; ++e) { h[j * 8 + e] = bf2f((unsigned short)v[e]); acc[j * 8 + e] = 0.f; } }
#pragma unroll 1
        for (int sb = 0; sb < 32; ++sb) {
            const int my_e = EIDX[(size_t)tok * 128 + sb * 4 + (lane & 3)]; const float my_g = EG[(size_t)tok * 128 + sb * 4 + (lane & 3)];
            const int e0 = __builtin_amdgcn_readlane(my_e, 0), e1 = __builtin_amdgcn_readlane(my_e, 1), e2 = __builtin_amdgcn_readlane(my_e, 2), e3 = __builtin_amdgcn_readlane(my_e, 3);
            float part[4];
#pragma unroll
            for (int i = 0; i < 4; ++i) {
                const int e = i == 0 ? e0 : (i == 1 ? e1 : (i == 2 ? e2 : e3)); const bf16* ur = PU + (size_t)e * DM + lane * 8; float d = 0.f;
#pragma unroll
                for (int j = 0; j < 4; ++j) { const u32x4 w = *(const u32x4*)(ur + j * 512);
                    d += h[j * 8 + 0] * bflo(w.x) + h[j * 8 + 1] * bfhi(w.x) + h[j * 8 + 2] * bflo(w.y) + h[j * 8 + 3] * bfhi(w.y)
                       + h[j * 8 + 4] * bflo(w.z) + h[j * 8 + 5] * bfhi(w.z) + h[j * 8 + 6] * bflo(w.w) + h[j * 8 + 7] * bfhi(w.w); }
                part[i] = d;
            }
            float dot;
            { const bool u1 = lane & 1, u2 = lane & 2;
              const float q0 = (u1 ? part[1] : part[0]) + __shfl_xor(u1 ? part[0] : part[1], 1);
              const float q1 = (u1 ? part[3] : part[2]) + __shfl_xor(u1 ? part[2] : part[3], 1);
              dot = (u2 ? q1 : q0) + __shfl_xor(u2 ? q0 : q1, 2);
              dot += __shfl_xor(dot, 4); dot += __shfl_xor(dot, 8); dot += __shfl_xor(dot, 16); dot += __shfl_xor(dot, 32); }
            const float act = gelu_exact(dot) * my_g;
#pragma unroll
            for (int i = 0; i < 4; ++i) {
                const int e = i == 0 ? e0 : (i == 1 ? e1 : (i == 2 ? e2 : e3)); const float w = __uint_as_float(__builtin_amdgcn_readlane(__float_as_uint(act), i));
                const bf16* vr = PV + (size_t)e * DM + lane * 8;
#pragma unroll
                for (int j = 0; j < 4; ++j) { const u32x4 x = *(const u32x4*)(vr + j * 512);
                    acc[j * 8 + 0] += w * bflo(x.x); acc[j * 8 + 1] += w * bfhi(x.x); acc[j * 8 + 2] += w * bflo(x.y); acc[j * 8 + 3] += w * bfhi(x.y);
                    acc[j * 8 + 4] += w * bflo(x.z); acc[j * 8 + 5] += w * bfhi(x.z); acc[j * 8 + 6] += w * bflo(x.w); acc[j * 8 + 7] += w * bfhi(x.w); }
            }
        }
        const int bidx = tok < ML ? (tok >> 12) : 4;
        const float* mr = mod + ((size_t)l * 5 + bidx) * MODW; const float* x1 = X1 + (size_t)tok * DM;
        float s = 0.f;
#pragma unroll
        for (int j = 0; j < 4; ++j) { const int c = j * 512 + lane * 8;
            const f32x4 xa = *(const f32x4*)(x1 + c), xb = *(const f32x4*)(x1 + c + 4), ga = *(const f32x4*)(mr + 5 * DM + c), gb = *(const f32x4*)(mr + 5 * DM + c + 4);
#pragma unroll
            for (int e = 0; e < 4; ++e) { acc[j * 8 + e] = ALPHA * xa[e] + ga[e] * acc[j * 8 + e]; acc[j * 8 + 4 + e] = ALPHA * xb[e] + gb[e] * acc[j * 8 + 4 + e]; s += acc[j * 8 + e] + acc[j * 8 + 4 + e]; } }
        const float mean = wave_sum(s) * (1.0f / DM); float q = 0.f;
#pragma unroll
        for (int k = 0; k < 32; ++k) { acc[k] -= mean; q += acc[k] * acc[k]; }
        const float rstd = rsqrtf(wave_sum(q) * (1.0f / DM) + LN_EPS);
        const float* mn = mod + ((size_t)(l + 1 < DEPTH ? l + 1 : l) * 5 + bidx) * MODW;
#pragma unroll
        for (int j = 0; j < 4; ++j) { const int c = j * 512 + lane * 8;
            const f32x4 ga = *(const f32x4*)(g2 + c), gb = *(const f32x4*)(g2 + c + 4), ba = *(const f32x4*)(b2 + c), bb = *(const f32x4*)(b2 + c + 4);
            f32x4 ya, yb;
#pragma unroll
            for (int e = 0; e < 4; ++e) { ya[e] = acc[j * 8 + e] * rstd * ga[e] + ba[e]; yb[e] = acc[j * 8 + 4 + e] * rstd * gb[e] + bb[e]; }
            *(f32x4*)(outp + (size_t)tok * DM + c) = ya; *(f32x4*)(outp + (size_t)tok * DM + c + 4) = yb;
            if (Hnext) { const f32x4 sa = *(const f32x4*)(mn + DM + c), sb = *(const f32x4*)(mn + DM + c + 4), ha = *(const f32x4*)(mn + c), hb = *(const f32x4*)(mn + c + 4);
                const f32x4 za = ya * (sa + 1.0f) + ha, zb = yb * (sb + 1.0f) + hb;
                u32x4 o; o.x = pk2(za[0], za[1]); o.y = pk2(za[2], za[3]); o.z = pk2(zb[0], zb[1]); o.w = pk2(zb[2], zb[3]);
                *(u32x4*)(Hnext + (size_t)tok * DM + c) = o; }
        }
    }
}

#ifndef PROBE_ATT
#define PROBE_ATT 15
#endif
#ifndef SD_A
#define SD_A 1
#endif
#ifndef SD_D
#define SD_D 2
#endif
#ifndef SD_B
#define SD_B 2
#endif
#ifndef SD_C
#define SD_C 1
#endif
#ifndef ATT_MASK
#define ATT_MASK 15
#endif
template <int TYPE> __device__ __forceinline__ att::Args make_att_args(const Frame& F, KA A, int l, int idx, bool ctxq) {
    const bf16* U = (const bf16*)(F.ws + WS_UREG); const bf16* QK = (const bf16*)(F.ws + WS_QKVA); bf16* O = (bf16*)(F.ws + WS_OQP);
    constexpr int NH = (TYPE == 2) ? 8 : 4;
    int b, h, qb;
    if (ctxq) { b = idx / NH; h = idx % NH; qb = 0; } else { b = idx / (NH * 16); h = (idx >> 4) % NH; qb = idx & 15; }
    const int row = ctxq ? ML + b * NCTX : b * SEQ + qb * 256;
    att::Args a{};
    a.ldo = DM; a.qpos0 = qb * 256; a.o8 = F8_MERGE;
    if (ctxq) { a.n0 = 4; a.row0 = ML + b * NCTX; a.n1 = 0; a.row1 = 0; }
    if constexpr (TYPE == 0) {
        a.Q = QK + (size_t)row * QW + QA_Q + h * 192; a.ldq = QW; a.KV = QK; a.ld = QW; a.kc0 = QA_KV + h * 256; a.kc1 = QA_KR; a.vc = QA_KV + h * 256 + 128;
        a.O = F8_MERGE ? (bf16*)((unsigned char*)O + (size_t)row * DM + h * 128) : O + (size_t)row * DM + h * 128; a.C = A_SCALE * LOG2E; a.thr = 8.0f / A_SCALE; a.qrope = ctxq ? 0 : 1;
        if (!ctxq) { a.n0 = 64; a.row0 = b * SEQ; a.n1 = 4; a.row1 = ML + b * NCTX; }
    } else if constexpr (TYPE == 1) {
        const int kvh = h >> 1;
        a.Q = U + (size_t)row * UW + U_DQ + h * 128; a.ldq = UW; a.KV = U; a.ld = UW; a.kc0 = U_DK + kvh * 128; a.kc1 = 0; a.vc = U_DV + kvh * 128;
        a.O = F8_MERGE ? (bf16*)((unsigned char*)O + (size_t)row * DM + 1536 + h * 128) : O + (size_t)row * DM + 1536 + h * 128; a.C = D_SCALE * LOG2E; a.thr = 8.0f / D_SCALE;
        if (!ctxq) { a.n0 = 64; a.row0 = b * SEQ; a.n1 = 4; a.row1 = ML + b * NCTX; }
    } else if constexpr (TYPE == 2) {
        const int kvh = h >> 2;
        a.Q = U + (size_t)row * UW + U_BQ + h * 64; a.ldq = UW; a.KV = U; a.ld = UW; a.kc0 = U_BK + kvh * 64; a.kc1 = 0; a.vc = U_BV + kvh * 64;
        a.O = F8_MERGE ? (bf16*)((unsigned char*)O + (size_t)row * DM + 512 + h * 64) : O + (size_t)row * DM + 512 + h * 64; a.C = B_SCALE * LOG2E; a.thr = 8.0f / B_SCALE; a.has_sink = 1; a.sinkl2 = G(A.in.b_sink)[l * 8 + h] * LOG2E;
        if (!ctxq) { int ws = qb * 256 - 128; ws = ws < 0 ? 0 : ws; int we = qb * 256 + 384; we = we > SEQ ? SEQ : we;
            a.n0 = 4; a.row0 = ML + b * NCTX; a.n1 = (we - ws) / 64; a.row1 = b * SEQ + ws; a.wpos0 = ws; }
    } else {
        a.Q = U + (size_t)row * UW + U_CQQ + h * 128; a.ldq = UW; a.KV = U; a.ld = UW; a.kc0 = U_CK + h * 128; a.kc1 = 0; a.vc = U_CV + h * 128;
        a.O = F8_MERGE ? (bf16*)((unsigned char*)O + (size_t)row * DM + 1024 + h * 128) : O + (size_t)row * DM + 1024 + h * 128; a.C = C_SCALE * LOG2E; a.thr = 8.0f / C_SCALE;
        a.T = (const float*)(F.ws + WS_CTAB) + (size_t)((l * 4 + h) * 15) * 4096;
        if (!ctxq) { const int r0 = qb * 4; int kr0 = r0 - 4; kr0 = kr0 < 0 ? 0 : (kr0 > 56 ? 56 : kr0); int ke = r0 + 3 - 4; ke = ke < 0 ? 0 : (ke > 56 ? 56 : ke); ke += 7; const int nr = ke - kr0 + 1;
            a.n0 = 4; a.row0 = ML + b * NCTX; a.n1 = nr + (nr & 1); a.row1 = b * SEQ + kr0 * 64; a.r0 = r0; a.kr0 = kr0; }
    }
    return a;
}
#define AF() Frame F = F0; asm volatile("" : "+v"(F.tid), "+v"(F.lane), "+s"(F.wave), "+s"(F.vcu), "+s"(F.G), "+s"(F.ws), "+s"(F.lds)); LAS char* lds = (LAS char*)(F.lds + RING_OFF); const int v = F.vcu
__device__ __forceinline__ void att_phase(const Frame& F0, int l, int am = 15) {
    if (F0.vcu >= 256) return;
    const bool cx = (l + 1 < DEPTH);
    if ((ATT_MASK & 1) && (am & 1)) { AF(); KA A = *kargs(); const int n = 1 + ((cx && v < 16) ? 1 : 0);
        for (int k = 0; k < n; ++k) { const att::Args a = make_att_args<0>(F, A, l, k ? v : v, k != 0); att::attn_unit<192, 128, 0, SD_A>(a, lds, F.tid); } }
    if ((ATT_MASK & 2) && (am & 2)) { AF(); KA A = *kargs(); const int n = 1 + ((cx && v >= 16 && v < 32) ? 1 : 0);
        for (int k = 0; k < n; ++k) { const att::Args a = make_att_args<1>(F, A, l, k ? v - 16 : v, k != 0); att::attn_unit<128, 128, 0, SD_D>(a, lds, F.tid); } }
    if ((ATT_MASK & 4) && (am & 4)) { AF(); KA A = *kargs(); const int n = 2 + ((cx && v >= 48 && v < 80) ? 1 : 0);
        for (int k = 0; k < n; ++k) { const att::Args a = make_att_args<2>(F, A, l, k == 2 ? v - 48 : 2 * v + k, k == 2); att::attn_unit<64, 64, 1, SD_B>(a, lds, F.tid); } }
    if ((ATT_MASK & 8) && (am & 8)) { AF(); KA A = *kargs(); const int n = 1 + ((cx && v >= 32 && v < 48) ? 1 : 0);
        for (int k = 0; k < n; ++k) { const att::Args a = make_att_args<3>(F, A, l, k ? v - 32 : v, k != 0); att::attn_unit<128, 128, 2, SD_C>(a, lds, F.tid); } }
}

__device__ __forceinline__ void merge_ctx_reduce(const Frame& F, bf16* S, const char* CP) {
    const int tid = F.tid, wid = tid >> 6, lane = tid & 63, wr = wid >> 2, wc = wid & 3, fr = lane & 15, fq = lane >> 4;
    for (int pr = F.vcu; pr < 512; pr += F.G) {
        const int T = pr >> 4, si = pr & 15;
        const int pm = 64 + (T >> 3), pn = T & 7; const int row0 = pm * 256 + wr * 64 + fr, col0 = pn * 256 + wc * 32 + 8 * fq;
        f32x4 a[4], b[4];
#pragma unroll
        for (int z = 0; z < 4; ++z) { const char* p = CP + (size_t)(T * 4 + z) * 262144 + ((size_t)(si * 2) * 512 + tid) * 16; a[z] = *(const f32x4*)p; b[z] = *(const f32x4*)(p + 8192); }
        const f32x4 v0 = (a[0] + a[1]) + (a[2] + a[3]), v1 = (b[0] + b[1]) + (b[2] + b[3]);
        const int ai = si >> 3, m = (si >> 1) & 3, bj = si & 1;
        if (F8_OUT) { int w0 = __builtin_amdgcn_cvt_pk_fp8_f32(v0[0], v0[1], 0, false); w0 = __builtin_amdgcn_cvt_pk_fp8_f32(v0[2], v0[3], w0, true);
            int w1 = __builtin_amdgcn_cvt_pk_fp8_f32(v1[0], v1[1], 0, false); w1 = __builtin_amdgcn_cvt_pk_fp8_f32(v1[2], v1[3], w1, true);
            *(u32x2*)((unsigned char*)S + (size_t)(row0 + ai * 128 + m * 16) * 2048 + col0 + bj * 128) = (u32x2){(unsigned)w0, (unsigned)w1}; }
        else { u32x4 w; w.x = cvt_pk_bf16(v0[0], v0[1]); w.y = cvt_pk_bf16(v0[2], v0[3]); w.z = cvt_pk_bf16(v1[0], v1[1]); w.w = cvt_pk_bf16(v1[2], v1[3]);
        *(u32x4*)(S + (size_t)(row0 + ai * 128 + m * 16) * 2048 + col0 + bj * 128) = w; }
    }
}

constexpr int N_PHASES = 3 + 10 * DEPTH;
#ifndef MK_N_LAUNCHES
#define MK_N_LAUNCHES 1
#endif
static_assert(MK_N_LAUNCHES == 1, "the merge phase carries a grid barrier of its own (context tiles): single-launch builds only");
__global__ void __launch_bounds__(NWAVES * 64, 2) mk_fwd(Args args) {
    extern __shared__ __attribute__((aligned(16))) unsigned char lds_raw[];
    Frame F;
    F.lds = (LAS unsigned char*)lds_raw; F.tid = threadIdx.x; F.lane = F.tid & 63; F.wave = __builtin_amdgcn_readfirstlane(F.tid >> 6);
    F.G = gridDim.x; { const int bx = blockIdx.x; F.vcu = (F.G % 8 == 0) ? (bx % 8) * (F.G / 8) + bx / 8 : bx; }
    GAS unsigned char* ws; int lo, hi, li;
    { KAP ap = kargs(); ws = (GAS unsigned char*)ap->ws; lo = ap->ph_lo; hi = ap->ph_hi; li = ap->li; }
    F.ws = ws;
    for (int u = F.tid; u < (LDS_BYTES - LDSCTL_OFF) / 4; u += NWAVES * 64) ((LAS unsigned*)(F.lds + LDSCTL_OFF))[u] = 0u;
    __syncthreads();
    volatile LAS unsigned* MISC = (volatile LAS unsigned*)(F.lds + MISC_OFF);
    XcdBarrier bar = xcd_barrier_post((unsigned*)(ws + WS_CTL) + CW_BAR + li * XCD_BAR_WORDS, MISC + 8);
#ifndef PHASE_MASK
#define PHASE_MASK 0x1fff
#endif
#define INR(k) (lo <= (k) && (k) < hi)
#define IN(k) ((((PHASE_MASK) >> ((k) < 3 ? (k) : 3 + ((k) - 3) % 10)) & 1) && INR(k))
#ifndef SPIN_MASK
#define SPIN_MASK 0
#endif
#ifndef SPIN_MUL
#define SPIN_MUL 1
#endif
    unsigned long long tprev_ = SPIN_MASK ? __builtin_amdgcn_s_memrealtime() : 0ull, spin_ = 0ull;
#define SEAM(k) do { if (INR(k) && INR((k) + 1)) xcd_barrier(bar); if (SPIN_MASK) { const unsigned long long tn_ = __builtin_amdgcn_s_memrealtime(); if (((SPIN_MASK) >> KIND(k)) & 1) spin_ += tn_ - tprev_; tprev_ = tn_; } } while (0)
#ifndef PROBE_DUP
#define PROBE_DUP 0
#endif
#ifndef PROBE_REP
#define PROBE_REP 1
#endif
#define KIND(k) ((k) < 3 ? (k) : 3 + ((k) - 3) % 10)
#define REP(k) for (int rep_ = 0, nrep_ = 1 + ((((PROBE_DUP) >> KIND(k)) & 1) ? PROBE_REP : 0); rep_ < nrep_; ++rep_, (rep_ < nrep_ ? xcd_barrier(bar) : (void)0))
#define PF() Frame Fp = F; int bx = blockIdx.x; asm volatile("" : "+v"(Fp.tid), "+v"(Fp.lane), "+s"(Fp.wave), "+s"(Fp.vcu), "+s"(Fp.G), "+s"(Fp.ws), "+s"(Fp.lds), "+s"(bx)); GAS unsigned char* ws = Fp.ws; (void)bx; (void)ws
    if (IN(0)) REP(0) { PF(); p0_prologue(Fp, *kargs()); } SEAM(0);
    if (IN(1)) REP(1) { PF(); p1_modreduce(Fp, *kargs()); } SEAM(1);
#ifdef PROBE_BAR
    for (int pbi = 0; pbi < PROBE_BAR; ++pbi) xcd_barrier(bar);
#endif
    if (IN(2)) REP(2) { PF(); p2_modulate0(Fp, *kargs()); } SEAM(2);
    for (int l = 0; l < DEPTH; ++l) {
        const int pb = 3 + 10 * l; const bool last = (l + 1 == DEPTH);
        const size_t offH = (l & 1) ? WS_BUFB : WS_BUFA, offS = (l & 1) ? WS_BUFA : WS_BUFB;
        const int nPl = last ? 64 : 68, nrows = last ? ML : MT;
        if (IN(pb + 0)) REP(pb + 0) {
            PF(); bf16* Hb = (bf16*)(ws + offH);
            pg8::PlainSched S{F8_IN ? (const char*)(ws + WS_H8) : (const char*)Hb, F8_IN ? (const char*)(ws + WS_WIN) + (size_t)l * UW * DM : (const char*)((bf16*)(ws + WS_WIN) + (size_t)l * UW * DM), DM, DM, DM, 68, 16, Fp.G, bx, F8_IN ? 1 : 2};
            pg8::EpiBf16 E{(bf16*)(ws + WS_UREG), UW};
            pg8::gemm_phase<pg8::EpiBf16, pg8::PlainSched, F8_IN != 0>(Fp.lds + RING_OFF, S, E, DM, DM, Fp.tid);
        } SEAM(pb + 0);
        if (IN(pb + 1)) REP(pb + 1) { PF(); enorm_phase(Fp, *kargs(), l); } SEAM(pb + 1);
        if (IN(pb + 2)) REP(pb + 2) { PF();
            pg8::AupSched S{(const char*)(ws + WS_UREG), (const char*)((bf16*)(ws + WS_WUP) + (size_t)l * 1792 * 512), UW, Fp.G, bx};
            pg8::EpiBf16 E{(bf16*)(ws + WS_QKVA), QW};
            pg8::gemm_phase(Fp.lds + RING_OFF, S, E, UW, 512, Fp.tid);
        } SEAM(pb + 2);
        if (IN(pb + 3)) REP(pb + 3) { PF(); att_phase(Fp, l, rep_ ? PROBE_ATT : 15); } SEAM(pb + 3);
        if (IN(pb + 4)) REP(pb + 4) { PF(); bf16* Hb = (bf16*)(ws + offH); bf16* Sb = (bf16*)(ws + offS);
            pg8::MergeSched S{F8_MERGE ? (const char*)(ws + WS_H8) : (const char*)Hb, (const char*)(ws + WS_OQP), F8_MERGE ? (const char*)(ws + WS_WC) + (size_t)l * 4 * DM * 2560 : (const char*)((bf16*)(ws + WS_WC) + (size_t)l * 4 * DM * 2560), nPl, Fp.G, bx, F8_MERGE ? 1 : 2};
            pg8::EpiMerge E{Sb, G(kargs()->in.b_gate) + (size_t)l * 4 * DM, (char*)(ws + WS_STASH) + (size_t)bx * STASH_WG, (char*)(ws + WS_P) + (size_t)bx * P_WG, (char*)(ws + WS_CP), Fp.tid, F8_OUT};
            pg8::gemm_phase<pg8::EpiMerge, pg8::MergeSched, F8_MERGE != 0>(Fp.lds + RING_OFF, S, E, DM, 2560, Fp.tid);
            if (nPl > 64) { xcd_barrier(bar); merge_ctx_reduce(Fp, Sb, (const char*)(ws + WS_CP)); }
        } SEAM(pb + 4);
        if (IN(pb + 5)) REP(pb + 5) { PF(); bf16* Sb = (bf16*)(ws + offS);
            pg8::PlainSched S{(const char*)Sb, F8_OUT ? (const char*)(ws + WS_WO) + (size_t)l * DM * DM : (const char*)((bf16*)(ws + WS_WO) + (size_t)l * DM * DM), DM, DM, DM, nPl, 8, Fp.G, bx, F8_OUT ? 1 : 2};
            KAP ap = kargs();
            pg8::EpiOut E{(bf16*)(ws + WS_UREG), l == 0 ? G(ap->in.x) : (const float*)(ws + WS_XRES), l == 0 ? G(ap->in.ctx) : (const float*)((const bf16*)(ws + WS_XRES) + (size_t)ML * DM),
                          (const float*)(ws + WS_MOD) + (size_t)l * 5 * MODW, ALPHA, l != 0};
            pg8::gemm_phase<pg8::EpiOut, pg8::PlainSched, F8_OUT != 0>(Fp.lds + RING_OFF, S, E, DM, DM, Fp.tid);
        } SEAM(pb + 5);
        if (IN(pb + 6)) REP(pb + 6) { PF(); ln1_phase(Fp, *kargs(), l, nrows, (bf16*)(ws + offH)); } SEAM(pb + 6);
        if (IN(pb + 7)) REP(pb + 7) { PF(); bf16* Hb = (bf16*)(ws + offH);
            pg8::PlainSched S{F8_PQ ? (const char*)(ws + WS_H8) : (const char*)Hb, F8_PQ ? (const char*)(ws + WS_WPQ) + (size_t)l * DM * DM : (const char*)((bf16*)(ws + WS_WPQ) + (size_t)l * DM * DM), DM, DM, DM, nPl, 8, Fp.G, bx, F8_PQ ? 1 : 2};
            pg8::EpiBf16 E{(bf16*)(ws + WS_OQP), DM};
            pg8::gemm_phase<pg8::EpiBf16, pg8::PlainSched, F8_PQ != 0>(Fp.lds + RING_OFF, S, E, DM, DM, Fp.tid);
        } SEAM(pb + 7);
        if (IN(pb + 8)) REP(pb + 8) { PF();
            const int nhb = Fp.G >> 3;
            if (Fp.vcu < nhb * 8) {
                const int h = Fp.vcu & 7, hb = Fp.vcu >> 3;
                LAS unsigned short* tblw = (LAS unsigned short*)(Fp.lds + RING_OFF) + Fp.wave * (64 * 66);
                LAS unsigned char* sklds = Fp.lds + RING_OFF + NWAVES * (64 * 66 * 2);
                const bf16* SKh = (const bf16*)(ws + WS_SUBK) + ((size_t)l * 8 + h) * 2 * 128 * 128;
#pragma unroll
                for (int i = 0; i < 8; ++i) { const int idx = Fp.tid + 512 * i, row = (idx >> 4) & 127, ch = idx & 15;
                    *(LAS u32x4*)(sklds + (idx >> 11) * 32768 + row * 256 + ((ch ^ (row & 7)) << 4)) = *(const u32x4*)(SKh + (size_t)idx * 8); }
                __syncthreads();
                for (int tg = hb * 8 + Fp.wave; tg < nrows / 32; tg += nhb * 8)
                    peer::topk_item((const bf16*)(ws + WS_OQP), sklds, (int*)(ws + WS_EIDX), (float*)(ws + WS_EG), tg * 32, h, tblw, Fp.lane, (TOPK_SEC >= 0 && Fp.wave == 0) ? (volatile LAS unsigned*)(Fp.lds + MISC_OFF + 256) : nullptr);
            }
        } SEAM(pb + 8);
        if (IN(pb + 9)) REP(pb + 9) { PF(); pexp4_phase(Fp, *kargs(), l, nrows, (bf16*)(ws + offH), last ? G(kargs()->out) : (float*)(ws + WS_XRES), last ? nullptr : (bf16*)(ws + offS)); } SEAM(pb + 9);
    }
    if (PEXP_SEC >= 0 || TOPK_SEC >= 0) { __syncthreads(); spin_ += *(volatile LAS unsigned*)(F.lds + MISC_OFF + 256); }
    if (SPIN_MASK || PEXP_SEC >= 0 || TOPK_SEC >= 0) { const unsigned long long tend_ = __builtin_amdgcn_s_memrealtime() + spin_ * SPIN_MUL; while (__builtin_amdgcn_s_memrealtime() < tend_) __builtin_amdgcn_s_sleep(8); }
#undef IN
#undef INR
#undef SEAM
}

extern "C" void kernel_launch(void* const* d_in, const int* in_sizes, int n_in, void* d_out, int out_size, void* d_ws, size_t ws_size, hipStream_t stream) {
    static int grid = 0;
    if (grid == 0) {
        if (n_in != 27 || out_size != ML * DM || ws_size < WS_END) { fprintf(stderr, "kernel_launch: unexpected shapes (n_in %d out %d ws %zu, need ws >= %zu)\n", n_in, out_size, ws_size, (size_t)WS_END); grid = -1; return; }
        int dev = 0, cus = 0, per_cu = 0;
        if (hipGetDevice(&dev) != hipSuccess || hipDeviceGetAttribute(&cus, hipDeviceAttributeMultiprocessorCount, dev) != hipSuccess) { grid = -1; return; }
        if (hipFuncSetAttribute((const void*)mk_fwd, hipFuncAttributeMaxDynamicSharedMemorySize, LDS_BYTES) != hipSuccess) { fprintf(stderr, "kernel_launch: hipFuncSetAttribute failed\n"); grid = -1; return; }
        if (hipOccupancyMaxActiveBlocksPerMultiprocessor(&per_cu, (const void*)mk_fwd, NWAVES * 64, LDS_BYTES) != hipSuccess || per_cu < 1) { fprintf(stderr, "kernel_launch: occupancy query says %d\n", per_cu); }
        (void)hipGetLastError();
        grid = cus < 256 ? cus : 256;
    }
    if (grid < 0) return;
    (void)hipMemsetAsync((char*)d_ws + WS_CTL, 0, CTL_ZERO_BYTES, stream);
    Args a{};
    const float** ip = (const float**)&a.in;
    for (int i = 0; i < 27; ++i) ip[i] = (const float*)d_in[i];
    a.out = (float*)d_out; a.ws = (unsigned char*)d_ws;
    for (int li = 0; li < MK_N_LAUNCHES; ++li) {
        a.ph_lo = (MK_N_LAUNCHES == 1) ? 0 : li; a.ph_hi = (MK_N_LAUNCHES == 1) ? N_PHASES : li + 1; a.li = li; a.pad = 0;
        hipLaunchKernelGGL(mk_fwd, dim3(grid), dim3(NWAVES * 64), LDS_BYTES, stream, a);
    }
}
```

```cpp
#include <hip/hip_runtime.h>
#include <cstdio>
#include <cstdint>
#include <utility>

#define GAS __attribute__((address_space(1)))
#define LAS __attribute__((address_space(3)))
typedef unsigned short bf16;
typedef short bf16x8 __attribute__((ext_vector_type(8)));
typedef short s16x4 __attribute__((ext_vector_type(4)));
typedef float f32x2 __attribute__((ext_vector_type(2)));
typedef float f32x4 __attribute__((ext_vector_type(4)));
typedef float f32x16 __attribute__((ext_vector_type(16)));
typedef unsigned u32x2 __attribute__((ext_vector_type(2)));
typedef unsigned u32x4 __attribute__((ext_vector_type(4)));
typedef GAS unsigned gu32;

__device__ __forceinline__ unsigned cvt_pk_bf16(float lo, float hi) { unsigned r; asm volatile("v_cvt_pk_bf16_f32 %0, %1, %2" : "=v"(r) : "v"(lo), "v"(hi)); return r; }
__device__ __forceinline__ float bf2f(unsigned short b) { return __uint_as_float(((unsigned)b) << 16); }
__device__ __forceinline__ float bflo(unsigned w) { return __uint_as_float(w << 16); }
__device__ __forceinline__ float bfhi(unsigned w) { return __uint_as_float(w & 0xffff0000u); }
__device__ __forceinline__ unsigned short f2bf(float f) { return (unsigned short)(cvt_pk_bf16(f, 0.f) & 0xffffu); }

namespace pg8 {
constexpr int BM = 256, BK = 64, HALF = 128, HTB = HALF * BK * 2  , STAGE_BYTES = 8 * HTB, NXCD = 8, WGM = 4;
__host__ __device__ __forceinline__ int lds_byte(int r, int c) { const int st = (r >> 4) * 2 + (c >> 5), rr = r & 15, cc = c & 31, ob = rr * 64 + cc * 2; return st * 1024 + (ob ^ (((ob >> 9) & 1) << 5)); }
__host__ __device__ __forceinline__ void stage_rc(int b, int& R, int& C) { const int st = b / 1024, sb = b % 1024, swz = sb ^ (((sb >> 9) & 1) << 5); R = (st >> 1) * 16 + swz / 64; C = (st & 1) * 32 + (swz % 64) / 2; }
__host__ __device__ __forceinline__ int perm32(int rho) { const int n = rho >> 4, i = rho & 15; return 8 * (i >> 2) + 4 * n + (i & 3); }

struct Unit { int pm, pn, z, aux; };

__device__ __forceinline__ void tile_of(int L, int nM, int nN, int& pm, int& pn) {
    const int nwg = nM * nN; int wgid = L;
    { const int q = nwg / NXCD, r = nwg % NXCD, xcd = wgid % NXCD, off = wgid / NXCD; wgid = (xcd < r ? xcd * (q + 1) : r * (q + 1) + (xcd - r) * q) + off; }
    const int nig = WGM * nN, gid = wgid / nig, fm = gid * WGM, gsz = (nM - fm) < WGM ? (nM - fm) : WGM;
    pm = fm + ((wgid % nig) % gsz); pn = (wgid % nig) / gsz;
}
struct PlainSched {
    const char* A; const char* B; int lda, ldb, K, nM, nN, G, c, esz;
    __device__ __forceinline__ bool next(int i, Unit& u) const { const long L = (long)i * G + c; if (L >= (long)nM * nN) return false; tile_of((int)L, nM, nN, u.pm, u.pn); u.z = 0; u.aux = 0; return true; }
    __device__ __forceinline__ void ptrs(const Unit& u, const char*& a, const char*& b, int& nt) const { a = A + (size_t)u.pm * BM * lda * esz; b = B + (size_t)u.pn * BM * ldb * esz; nt = K * esz / 128; }
};
struct AupSched {
    const char* A; const char* B; int lda, G, c;
    __device__ __forceinline__ bool next(int i, Unit& u) const { const long L = (long)i * G + c; if (L >= 68L * 7) return false; tile_of((int)L, 68, 7, u.pm, u.pn); u.z = 0; u.aux = 0; return true; }
    __device__ __forceinline__ void ptrs(const Unit& u, const char*& a, const char*& b, int& nt) const { const int ko = u.pn < 3 ? 0 : 384;
        a = A + ((size_t)u.pm * BM * lda + ko) * 2; b = B + ((size_t)u.pn * BM * 512 + ko) * 2; nt = u.pn < 3 ? 6 : 2; }
};
struct MergeSched {
    const char* H; const char* O; const char* W; int nM, G, c, esz;
    __device__ __forceinline__ bool next(int i, Unit& u) const {
        const int ngl = (512 - c + G - 1) / G;
        if (i < 8 * ngl) { tile_of((i >> 3) * G + c, 64, 8, u.pm, u.pn); u.z = i & 7; u.aux = 0; return true; }
        if (nM <= 64) return false;
        const int t = i - 8 * ngl, j = c + (t >> 1) * G; if (j >= 128) return false;
        const int T = j >> 2; u.pm = 64 + (T >> 3); u.pn = T & 7; u.z = 8 + (j & 3) * 2 + (t & 1); u.aux = j; return true;
    }
    __device__ __forceinline__ void ptrs(const Unit& u, const char*& a, const char*& b, int& nt) const {
        const int z = (u.z & 7) >> 1, kind = u.z & 1;
        a = (kind ? H : O + (size_t)z * 512 * esz) + (size_t)u.pm * BM * 2048 * esz;
        b = W + ((size_t)z * 2048 * 2560 + (size_t)u.pn * BM * 2560 + (kind ? 0 : 2048)) * esz;
        nt = (kind ? 2048 : 512) * esz / 128;
    }
};

struct EpiBf16 {
    static constexpr bool PERM = true;
    bf16* O; int ldc;
    __device__ __forceinline__ void operator()(const f32x4 (&acc)[2][2][4][2], const Unit& u, int wr, int wc, int fr, int fq) const {
        const int row0 = u.pm * BM + wr * 64 + fr, col0 = u.pn * BM + wc * 32 + 8 * fq;
#pragma unroll
        for (int ai = 0; ai < 2; ++ai)
#pragma unroll
            for (int m = 0; m < 4; ++m) { bf16* rowp = O + (size_t)(row0 + ai * HALF + m * 16) * ldc + col0;
#pragma unroll
                for (int bj = 0; bj < 2; ++bj) { const f32x4 v0 = acc[ai][bj][m][0], v1 = acc[ai][bj][m][1];
                    u32x4 w; w.x = cvt_pk_bf16(v0[0], v0[1]); w.y = cvt_pk_bf16(v0[2], v0[3]); w.z = cvt_pk_bf16(v1[0], v1[1]); w.w = cvt_pk_bf16(v1[2], v1[3]);
                    *(u32x4*)(rowp + bj * HALF) = w; } }
    }
};
#ifndef EPIM_GROUPS
#define EPIM_GROUPS 2
#endif
#ifndef STASH_F8
#define STASH_F8 1
#endif
constexpr int STASH_B = STASH_F8 ? 8 : 16;
struct EpiMerge {
    static constexpr bool PERM = true;
    bf16* S; const float* bgate; char* stash; char* P; char* CP; int tid; int s8;
    __device__ __forceinline__ void operator()(const f32x4 (&acc)[2][2][4][2], const Unit& u, int wr, int wc, int fr, int fq) const {
        const int z = (u.z & 7) >> 1, kind = u.z & 1; const bool cx = u.z >= 8; int tl = tid; asm volatile("" : "+v"(tl));
        GAS char* sp = (GAS char*)stash + (size_t)tl * STASH_B;
        if (kind == 0) {
#pragma unroll
            for (int ai = 0; ai < 2; ++ai)
#pragma unroll
                for (int m = 0; m < 4; ++m)
#pragma unroll
                    for (int bj = 0; bj < 2; ++bj) { const f32x4 v0 = acc[ai][bj][m][0], v1 = acc[ai][bj][m][1];
                        if (STASH_F8) { int w0 = __builtin_amdgcn_cvt_pk_fp8_f32(v0[0], v0[1], 0, false); w0 = __builtin_amdgcn_cvt_pk_fp8_f32(v0[2], v0[3], w0, true);
                            int w1 = __builtin_amdgcn_cvt_pk_fp8_f32(v1[0], v1[1], 0, false); w1 = __builtin_amdgcn_cvt_pk_fp8_f32(v1[2], v1[3], w1, true);
                            *(GAS u32x2*)sp = (u32x2){(unsigned)w0, (unsigned)w1}; }
                        else { u32x4 w; w.x = cvt_pk_bf16(v0[0], v0[1]); w.y = cvt_pk_bf16(v0[2], v0[3]); w.z = cvt_pk_bf16(v1[0], v1[1]); w.w = cvt_pk_bf16(v1[2], v1[3]);
                            *(GAS u32x4*)sp = w; }
                        sp += 512 * STASH_B; asm volatile("" : "+v"(sp)); }
            return;
        }
        GAS char* pq = (cx ? (GAS char*)CP + (size_t)u.aux * 262144 : (GAS char*)P) + (size_t)tl * 16; GAS char* pr = pq;
        const int row0 = u.pm * BM + wr * 64 + fr, col0 = u.pn * BM + wc * 32 + 8 * fq;
        const float* bz = bgate + z * 2048 + col0;
        f32x4 bv[2][2];
#pragma unroll
        for (int bj = 0; bj < 2; ++bj)
#pragma unroll
            for (int n = 0; n < 2; ++n) bv[bj][n] = *(const f32x4*)(bz + bj * HALF + 4 * n);
        GAS bf16* rowp = (GAS bf16*)S + (size_t)row0 * 2048 + col0; GAS unsigned char* rowp8 = (GAS unsigned char*)S + (size_t)row0 * 2048 + col0;
        const bool rd = z > 0 && !cx;
#pragma unroll
        for (int aq = 0; aq < EPIM_GROUPS; ++aq) { constexpr int NI = 16 / EPIM_GROUPS, NM = NI / 2;
            u32x4 sw[STASH_F8 ? 1 : NI], pw[NI]; u32x2 sw8[STASH_F8 ? NI : 1];
#pragma unroll
            for (int i = 0; i < NI; ++i) { if (STASH_F8) sw8[STASH_F8 ? i : 0] = *(const GAS u32x2*)sp; else sw[STASH_F8 ? 0 : i] = *(const GAS u32x4*)sp; sp += 512 * STASH_B; asm volatile("" : "+v"(sp)); }
            if (rd) {
#pragma unroll
                for (int i = 0; i < NI; ++i) { pw[i] = *(const GAS u32x4*)pr; pr += 8192; asm volatile("" : "+v"(pr)); } }
            asm volatile("" ::: "memory");
#pragma unroll
            for (int mm = 0; mm < NM; ++mm) { const int ai = (aq * NM + mm) >> 2, m = (aq * NM + mm) & 3;
#pragma unroll
                for (int bj = 0; bj < 2; ++bj) { const int i = mm * 2 + bj;
                    f32x4 v0 = acc[ai][bj][m][0] + bv[bj][0], v1 = acc[ai][bj][m][1] + bv[bj][1];
#pragma unroll
                    for (int j = 0; j < 4; ++j) { v0[j] = __builtin_amdgcn_rcpf(1.0f + __builtin_amdgcn_exp2f(-1.4426950408889634f * v0[j])); v1[j] = __builtin_amdgcn_rcpf(1.0f + __builtin_amdgcn_exp2f(-1.4426950408889634f * v1[j])); }
                    if (STASH_F8) { const u32x2 q_ = sw8[STASH_F8 ? i : 0]; const f32x2 a_ = __builtin_amdgcn_cvt_pk_f32_fp8((int)q_.x, false), b_ = __builtin_amdgcn_cvt_pk_f32_fp8((int)q_.x, true),
                            c_ = __builtin_amdgcn_cvt_pk_f32_fp8((int)q_.y, false), d_ = __builtin_amdgcn_cvt_pk_f32_fp8((int)q_.y, true);
                        v0[0] *= a_.x; v0[1] *= a_.y; v0[2] *= b_.x; v0[3] *= b_.y; v1[0] *= c_.x; v1[1] *= c_.y; v1[2] *= d_.x; v1[3] *= d_.y; }
                    else { const u32x4 q_ = sw[STASH_F8 ? 0 : i];
                        v0[0] *= bflo(q_.x); v0[1] *= bfhi(q_.x); v0[2] *= bflo(q_.y); v0[3] *= bfhi(q_.y);
                        v1[0] *= bflo(q_.z); v1[1] *= bfhi(q_.z); v1[2] *= bflo(q_.w); v1[3] *= bfhi(q_.w); }
                    if (rd) { v0[0] += bflo(pw[i].x); v0[1] += bfhi(pw[i].x); v0[2] += bflo(pw[i].y); v0[3] += bfhi(pw[i].y);
                              v1[0] += bflo(pw[i].z); v1[1] += bfhi(pw[i].z); v1[2] += bflo(pw[i].w); v1[3] += bfhi(pw[i].w); }
                    if (cx) { *(GAS f32x4*)pq = v0; *(GAS f32x4*)(pq + 8192) = v1; pq += 16384; asm volatile("" : "+v"(pq)); }
                    else if (z < 3) { u32x4 w; w.x = cvt_pk_bf16(v0[0], v0[1]); w.y = cvt_pk_bf16(v0[2], v0[3]); w.z = cvt_pk_bf16(v1[0], v1[1]); w.w = cvt_pk_bf16(v1[2], v1[3]);
                        *(GAS u32x4*)pq = w; pq += 8192; asm volatile("" : "+v"(pq)); }
                    else if (s8) { int w0 = __builtin_amdgcn_cvt_pk_fp8_f32(v0[0], v0[1], 0, false); w0 = __builtin_amdgcn_cvt_pk_fp8_f32(v0[2], v0[3], w0, true);
                        int w1 = __builtin_amdgcn_cvt_pk_fp8_f32(v1[0], v1[1], 0, false); w1 = __builtin_amdgcn_cvt_pk_fp8_f32(v1[2], v1[3], w1, true);
                        *(GAS u32x2*)(rowp8 + bj * HALF) = (u32x2){(unsigned)w0, (unsigned)w1}; }
                    else { u32x4 w; w.x = cvt_pk_bf16(v0[0], v0[1]); w.y = cvt_pk_bf16(v0[2], v0[3]); w.z = cvt_pk_bf16(v1[0], v1[1]); w.w = cvt_pk_bf16(v1[2], v1[3]);
                        *(GAS u32x4*)(rowp + bj * HALF) = w; }
                }
                rowp += (m == 3 ? (size_t)(HALF - 48) : (size_t)16) * 2048; rowp8 += (m == 3 ? (size_t)(HALF - 48) : (size_t)16) * 2048; asm volatile("" : "+v"(rowp), "+v"(rowp8)); }
            asm volatile("" ::: "memory"); }
    }
};
#ifndef EPIO_GROUPS
#define EPIO_GROUPS 2
#endif
struct EpiOut {
    static constexpr bool PERM = true;
    bf16* Y; const float* xlat; const float* xctx; const float* mod_l; float alpha; int xbf;
    __device__ __forceinline__ void operator()(const f32x4 (&acc)[2][2][4][2], const Unit& u, int wr, int wc, int fr, int fq) const {
        asm volatile("" : "+v"(fr), "+v"(fq));
        const int row0 = u.pm * BM + wr * 64 + fr, col0 = u.pn * BM + wc * 32 + 8 * fq;
        const float* xb = (u.pm < 64) ? xlat + (size_t)row0 * 2048 : xctx + (size_t)(row0 - 16384) * 2048;
        const bf16* xh = (u.pm < 64) ? (const bf16*)xlat + (size_t)row0 * 2048 : (const bf16*)xctx + (size_t)(row0 - 16384) * 2048;
        const float* ga = mod_l + (size_t)((u.pm < 64) ? (u.pm >> 4) : 4) * 12288 + 2 * 2048 + col0;
        f32x4 gv[2][2];
#pragma unroll
        for (int bj = 0; bj < 2; ++bj)
#pragma unroll
            for (int n = 0; n < 2; ++n) gv[bj][n] = *(const f32x4*)(ga + bj * HALF + n * 4);
#pragma unroll
        for (int aq = 0; aq < EPIO_GROUPS; ++aq) { constexpr int NM = 8 / EPIO_GROUPS;
            f32x4 xv[NM][2][2];
#pragma unroll
            for (int mm = 0; mm < NM; ++mm) { const int ai = (aq * NM + mm) >> 2, m = (aq * NM + mm) & 3; const size_t ro = (size_t)(ai * HALF + m * 16) * 2048 + col0;
#pragma unroll
                for (int bj = 0; bj < 2; ++bj)
                    { if (xbf) { const u32x4 w_ = *(const u32x4*)(xh + ro + bj * HALF); xv[mm][bj][0] = (f32x4){__uint_as_float(w_.x), __uint_as_float(w_.y), __uint_as_float(w_.z), __uint_as_float(w_.w)}; }
                      else {
#pragma unroll
                        for (int n = 0; n < 2; ++n) xv[mm][bj][n] = *(const f32x4*)(xb + ro + bj * HALF + n * 4); } } }
            asm volatile("" ::: "memory");
#pragma unroll
            for (int mm = 0; mm < NM; ++mm) { const int ai = (aq * NM + mm) >> 2, m = (aq * NM + mm) & 3; const size_t ro = (size_t)(ai * HALF + m * 16) * 2048 + col0; bf16* yp = Y + (size_t)row0 * 2048 + ro;
#pragma unroll
                for (int bj = 0; bj < 2; ++bj) { f32x4 x0 = xv[mm][bj][0], x1 = xv[mm][bj][1];
                    if (xbf) { const unsigned a_ = __float_as_uint(x0[0]), b_ = __float_as_uint(x0[1]), c_ = __float_as_uint(x0[2]), d_ = __float_as_uint(x0[3]); x0 = (f32x4){bflo(a_), bfhi(a_), bflo(b_), bfhi(b_)}; x1 = (f32x4){bflo(c_), bfhi(c_), bflo(d_), bfhi(d_)}; }
                    const f32x4 v0 = x0 * alpha + gv[bj][0] * acc[ai][bj][m][0], v1 = x1 * alpha + gv[bj][1] * acc[ai][bj][m][1];
                    u32x4 w; w.x = cvt_pk_bf16(v0[0], v0[1]); w.y = cvt_pk_bf16(v0[2], v0[3]); w.z = cvt_pk_bf16(v1[0], v1[1]); w.w = cvt_pk_bf16(v1[2], v1[3]);
                    *(u32x4*)(yp + bj * HALF) = w; } }
            asm volatile("" ::: "memory"); }
    }
};

typedef int v8i_t __attribute__((ext_vector_type(8)));
typedef int v4i_t __attribute__((ext_vector_type(4)));
template <class Epi, class Sched, bool F8 = false>
__device__ __forceinline__ void gemm_phase(LAS unsigned char* lds, const Sched& S, const Epi& E, const int lda, const int ldb, const int tid) {
    constexpr int ESZ = F8 ? 1 : 2;
    int f8scale = 0x7c7c7c7c; asm volatile("" : "+v"(f8scale));
    const int wid = __builtin_amdgcn_readfirstlane(tid >> 6), lane = tid & 63, wr = wid >> 2, wc = wid & 3, fr = lane & 15, fq = lane >> 4;
    unsigned voffA[2], voffB[2];
#pragma unroll
    for (int i = 0; i < 2; ++i) { int R, C; stage_rc(tid * 16 + i * 8192, R, C); const int Rb = Epi::PERM ? ((R & ~31) + perm32(R & 31)) : R;
        voffA[i] = (unsigned)(R * lda * ESZ + C * 2); voffB[i] = (unsigned)(Rb * ldb * ESZ + C * 2); }
    const size_t kstep = (size_t)(BK * 2);
    const size_t hstepA = (size_t)HALF * lda * ESZ, hstepB = (size_t)HALF * ldb * ESZ;
    const unsigned ldsw = (unsigned)wid * 1024u;
    const int aoff = lds_byte(wr * 64 + fr, fq * 8), boff = lds_byte(wc * 32 + fr, fq * 8);
#define PG8_SA(b, h) (((b) * 2 + (h)) * HTB)
#define PG8_SB(b, h) ((4 + (b) * 2 + (h)) * HTB)
#define PG8_STAGE(bufoff, gbase, voff) do { _Pragma("unroll") for (int _i = 0; _i < 2; ++_i) \
        __builtin_amdgcn_global_load_lds((const unsigned*)((const char*)(gbase) + (voff)[_i]), (LAS unsigned*)(lds + (bufoff) + ldsw + _i * 8192), 16, 0, 0); } while (0)
#define PG8_LDA(dst, b, h) do { _Pragma("unroll") for (int m = 0; m < 4; ++m) _Pragma("unroll") for (int k = 0; k < 2; ++k) dst[m][k] = *(const LAS bf16x8*)(lds + PG8_SA(b, h) + aoff + m * 2048 + k * 1024); } while (0)
#define PG8_LDB(dst, b, h) do { _Pragma("unroll") for (int n = 0; n < 2; ++n) _Pragma("unroll") for (int k = 0; k < 2; ++k) dst[n][k] = *(const LAS bf16x8*)(lds + PG8_SB(b, h) + boff + n * 2048 + k * 1024); } while (0)
#define PG8_MMA(ai, bj, At, Bt) do { __builtin_amdgcn_s_setprio(1); _Pragma("unroll") for (int m = 0; m < 4; ++m) _Pragma("unroll") for (int n = 0; n < 2; ++n) { \
        if constexpr (F8) { const v8i_t wa_ = __builtin_shufflevector(__builtin_bit_cast(v4i_t, Bt[n][0]), __builtin_bit_cast(v4i_t, Bt[n][1]), 0, 1, 2, 3, 4, 5, 6, 7); \
            const v8i_t xa_ = __builtin_shufflevector(__builtin_bit_cast(v4i_t, At[m][0]), __builtin_bit_cast(v4i_t, At[m][1]), 0, 1, 2, 3, 4, 5, 6, 7); \
            asm volatile("v_mfma_scale_f32_16x16x128_f8f6f4 %0, %1, %2, %0, %3, %3 op_sel_hi:[0,0,0]" : "+v"(acc[ai][bj][m][n]) : "v"(wa_), "v"(xa_), "v"(f8scale)); } \
        else { _Pragma("unroll") for (int k = 0; k < 2; ++k) acc[ai][bj][m][n] = __builtin_amdgcn_mfma_f32_16x16x32_bf16(Bt[n][k], At[m][k], acc[ai][bj][m][n], 0, 0, 0); } } \
        __builtin_amdgcn_s_setprio(0); } while (0)
#define PG8_WAIT_V(n) asm volatile("s_waitcnt vmcnt(" #n ")" ::: "memory")
#define PG8_WAIT_L(n) asm volatile("s_waitcnt lgkmcnt(" #n ")" ::: "memory")
#define PG8_BAR __builtin_amdgcn_s_barrier()
#define PG8_SCHED __builtin_amdgcn_sched_barrier(0)
    Unit cur, nxt; int ui = 0;
    if (!S.next(0, cur)) return;
    f32x4 acc[2][2][4][2];
#pragma unroll
    for (int a = 0; a < 2; ++a)
#pragma unroll
        for (int b = 0; b < 2; ++b)
#pragma unroll
            for (int m = 0; m < 4; ++m)
#pragma unroll
                for (int n = 0; n < 2; ++n) acc[a][b][m][n] = (f32x4){0.f, 0.f, 0.f, 0.f};
    bf16x8 At[4][2], B0[2][2], B1[2][2];
    const char* cA; const char* cB; int nt; S.ptrs(cur, cA, cB, nt);
    PG8_STAGE(PG8_SB(0, 0), cB, voffB); PG8_STAGE(PG8_SB(0, 1), cB + hstepB, voffB); PG8_STAGE(PG8_SA(0, 0), cA, voffA); PG8_STAGE(PG8_SA(0, 1), cA + hstepA, voffA);
    if (wr == 1) PG8_BAR;
    PG8_WAIT_V(2); PG8_BAR;
    PG8_STAGE(PG8_SB(1, 0), cB + kstep, voffB); PG8_STAGE(PG8_SA(1, 0), cA + kstep, voffA); PG8_STAGE(PG8_SB(1, 1), cB + hstepB + kstep, voffB);
    PG8_WAIT_V(6); PG8_BAR;
    for (;;) {
        const bool has_next = S.next(ui + 1, nxt);
        const char* nA = cA; const char* nB = cB; int nnt = nt; if (has_next) S.ptrs(nxt, nA, nB, nnt);
        for (int t = 0; t < nt; t += 2) {
            const bool last = (t == nt - 2);
            const char* a1 = cA + (size_t)(t + 1) * kstep;
            const char* a2 = last ? nA : cA + (size_t)(t + 2) * kstep; const char* b2 = last ? nB : cB + (size_t)(t + 2) * kstep;
            const char* a3 = a2 + kstep; const char* b3 = b2 + kstep;
            PG8_LDB(B0, 0, 0); PG8_LDB(B1, 0, 1); PG8_SCHED; PG8_LDA(At, 0, 0); PG8_STAGE(PG8_SA(1, 1), a1 + hstepA, voffA);
            PG8_WAIT_V(8); PG8_WAIT_L(0); PG8_BAR; PG8_MMA(0, 0, At, B0); PG8_MMA(0, 1, At, B1); PG8_BAR; PG8_SCHED;
            PG8_LDA(At, 0, 1); PG8_STAGE(PG8_SB(0, 0), b2, voffB); PG8_STAGE(PG8_SB(0, 1), b2 + hstepB, voffB); PG8_STAGE(PG8_SA(0, 0), a2, voffA);
            PG8_WAIT_V(8); PG8_WAIT_L(0); PG8_BAR; PG8_MMA(1, 0, At, B0); PG8_MMA(1, 1, At, B1); PG8_BAR; PG8_SCHED;
            PG8_LDB(B0, 1, 0); PG8_LDB(B1, 1, 1); PG8_SCHED; PG8_LDA(At, 1, 0); PG8_STAGE(PG8_SA(0, 1), a2 + hstepA, voffA);
            PG8_WAIT_V(8); PG8_WAIT_L(0); PG8_BAR; PG8_MMA(0, 0, At, B0); PG8_MMA(0, 1, At, B1); PG8_BAR; PG8_SCHED;
            PG8_LDA(At, 1, 1); PG8_STAGE(PG8_SB(1, 0), b3, voffB); PG8_STAGE(PG8_SB(1, 1), b3 + hstepB, voffB); PG8_STAGE(PG8_SA(1, 0), a3, voffA);
            PG8_WAIT_V(8); PG8_WAIT_L(0); PG8_BAR; PG8_MMA(1, 0, At, B0); PG8_MMA(1, 1, At, B1); PG8_BAR; PG8_SCHED;
        }
        if (wr == 0) PG8_BAR;
        if constexpr (F8) asm volatile("s_nop 15\n\ts_nop 15" ::: "memory");
        E(acc, cur, wr, wc, fr, fq);
        if (!has_next) break;
#pragma unroll
        for (int a = 0; a < 2; ++a)
#pragma unroll
            for (int b = 0; b < 2; ++b)
#pragma unroll
                for (int m = 0; m < 4; ++m)
#pragma unroll
                    for (int n = 0; n < 2; ++n) acc[a][b][m][n] = (f32x4){0.f, 0.f, 0.f, 0.f};
        cur = nxt; cA = nA; cB = nB; nt = nnt; ++ui;
        if (wr == 1) PG8_BAR;
    }
    PG8_WAIT_V(0);
    PG8_BAR;
#undef PG8_SA
#undef PG8_SB
#undef PG8_STAGE
#undef PG8_LDA
#undef PG8_LDB
#undef PG8_MMA
#undef PG8_WAIT_V
#undef PG8_WAIT_L
#undef PG8_BAR
#undef PG8_SCHED
}
}
#ifndef CT_GROUP
#define CT_GROUP 4
#endif
namespace att {
constexpr int NW = 8, QBLK = 32, KVBLK = 64;
#define SBAR() __builtin_amdgcn_sched_barrier(0)
__device__ __forceinline__ int crow(int r, int hi) { return (r & 3) + 8 * (r >> 2) + 4 * hi; }
__device__ __forceinline__ unsigned cvtpk(float lo, float hi) { unsigned r; asm volatile("v_cvt_pk_bf16_f32 %0, %1, %2" : "=v"(r) : "v"(lo), "v"(hi)); return r; }

struct Args {
    const bf16* Q; int ldq;
    const bf16* KV; int ld;
    int kc0, kc1, vc;
    bf16* O; int ldo;
    int o8;
    int n0, n1, row0, row1;
    float C, thr;
    int qrope, qpos0;
    float sinkl2; int has_sink;
    int wpos0;
    const float* T; int r0, kr0;
};

__device__ __forceinline__ void partialSM(f32x16& p0, f32x16& p1, float& m_reg, float& mn, float& alpha, const float C, const float thr) {
    float pmax = p0[0];
#pragma unroll
    for (int r = 1; r < 16; ++r) pmax = fmaxf(pmax, p0[r]);
#pragma unroll
    for (int r = 0; r < 16; ++r) pmax = fmaxf(pmax, p1[r]);
    { auto rr = __builtin_amdgcn_permlane32_swap(__float_as_uint(pmax), __float_as_uint(pmax), false, false);
      pmax = fmaxf(__uint_as_float(rr[0]), __uint_as_float(rr[1])); }
    if (__builtin_expect(__all(pmax - m_reg <= thr), 1)) { mn = m_reg; alpha = 1.f; }
    else { mn = fmaxf(m_reg, pmax); alpha = __builtin_amdgcn_exp2f((m_reg - mn) * C); m_reg = mn; }
    const float mnC = -mn * C;
#pragma unroll
    for (int r = 0; r < 16; ++r) p0[r] = fmaf(p0[r], C, mnC);
#pragma unroll
    for (int r = 0; r < 16; ++r) p1[r] = fmaf(p1[r], C, mnC);
#pragma unroll
    for (int r = 0; r < 16; ++r) p0[r] = __builtin_amdgcn_exp2f(p0[r]);
}
__device__ __forceinline__ void finishSM(f32x16& p0, f32x16& p1, float alpha, float& l_reg, bf16x8& pa0, bf16x8& pa1, bf16x8& pa2, bf16x8& pa3) {
#pragma unroll
    for (int r = 0; r < 16; ++r) p1[r] = __builtin_amdgcn_exp2f(p1[r]);
    float ps = 0;
#pragma unroll
    for (int r = 0; r < 16; ++r) ps += p0[r];
#pragma unroll
    for (int r = 0; r < 16; ++r) ps += p1[r];
    { auto rr = __builtin_amdgcn_permlane32_swap(__float_as_uint(ps), __float_as_uint(ps), false, false);
      ps = __uint_as_float(rr[0]) + __uint_as_float(rr[1]); }
    l_reg = l_reg * alpha + ps;
#define PK4(P, BASE, OUT) do { unsigned a0 = cvtpk(P[BASE + 0], P[BASE + 1]), a1 = cvtpk(P[BASE + 2], P[BASE + 3]);   \
    unsigned b0 = cvtpk(P[BASE + 4], P[BASE + 5]), b1 = cvtpk(P[BASE + 6], P[BASE + 7]);                              \
    auto r0 = __builtin_amdgcn_permlane32_swap(a0, b0, false, false); auto r1 = __builtin_amdgcn_permlane32_swap(a1, b1, false, false); \
    u32x4 w = {r0[0], r1[0], r0[1], r1[1]}; OUT = *reinterpret_cast<bf16x8*>(&w); } while (0)
    PK4(p0, 0, pa0); PK4(p0, 8, pa1); PK4(p1, 0, pa2); PK4(p1, 8, pa3);
#undef PK4
}
template <int DK> __device__ __forceinline__ int kswz(int row, int ch) { return row * (DK * 2) + ((ch ^ (row & 7)) << 4); }
template <int DK, int QREG> __device__ __forceinline__ void qkt(f32x16& p0, f32x16& p1, const LAS char* Ks, const bf16x8* qr, const LAS char* qx, int r32, int hi) {
    p0 = f32x16{}; p1 = f32x16{};
#pragma unroll
    for (int d0 = 0; d0 < DK / 16; ++d0) { const int ch = d0 * 2 + hi;
        const bf16x8 b0 = *(const LAS bf16x8*)(Ks + kswz<DK>(r32, ch));
        const bf16x8 b1 = *(const LAS bf16x8*)(Ks + kswz<DK>(32 + r32, ch));
        bf16x8 q; if constexpr (true) { if (d0 < QREG) q = qr[d0 < QREG ? d0 : 0]; else q = *(const LAS bf16x8*)(qx + (d0 - QREG) * 1024); }
        p0 = __builtin_amdgcn_mfma_f32_32x32x16_bf16(b0, q, p0, 0, 0, 0);
        p1 = __builtin_amdgcn_mfma_f32_32x32x16_bf16(b1, q, p1, 0, 0, 0); }
}
template <int NCB> __device__ __forceinline__ int v_st(int k, int c) { const int kk = (k & ~0xC) | ((k & 4) << 1) | ((k & 8) >> 1); return ((kk >> 3) * NCB + (c >> 5)) * 512 + ((kk & 7) * 32 + (c & 31)) * 2; }
__device__ __forceinline__ int v_rd_base(int lane) { return ((lane & 3) << 3) | (((lane >> 2) & 3) << 6) | (((lane >> 4) & 1) << 5) | (((lane >> 5) & 1) << 8); }
template <int OFF> __device__ __forceinline__ s16x4 tr_read(int vb) { s16x4 r; asm volatile("ds_read_b64_tr_b16 %0, %1 offset:%2" : "=&v"(r) : "v"(vb), "i"(OFF) : "memory"); return r; }
template <int D0, int NCB> __device__ __forceinline__ void pv_one(f32x16& od, int vb, bf16x8 pa0, bf16x8 pa1, bf16x8 pa2, bf16x8 pa3) {
#define VOFF(ks, half) (D0 * 512 + (ks) * (2 * NCB * 512) + (half) * (NCB * 512))
    const s16x4 l0 = tr_read<VOFF(0, 0)>(vb), h0 = tr_read<VOFF(0, 1)>(vb), l1 = tr_read<VOFF(1, 0)>(vb), h1 = tr_read<VOFF(1, 1)>(vb);
    const s16x4 l2 = tr_read<VOFF(2, 0)>(vb), h2 = tr_read<VOFF(2, 1)>(vb), l3 = tr_read<VOFF(3, 0)>(vb), h3 = tr_read<VOFF(3, 1)>(vb);
#undef VOFF
    asm volatile("s_waitcnt lgkmcnt(0)" ::: "memory"); SBAR();
#define PK(L, H) (bf16x8){L[0], L[1], L[2], L[3], H[0], H[1], H[2], H[3]}
    od = __builtin_amdgcn_mfma_f32_32x32x16_bf16(pa0, PK(l0, h0), od, 0, 0, 0);
    od = __builtin_amdgcn_mfma_f32_32x32x16_bf16(pa1, PK(l1, h1), od, 0, 0, 0);
    od = __builtin_amdgcn_mfma_f32_32x32x16_bf16(pa2, PK(l2, h2), od, 0, 0, 0);
    od = __builtin_amdgcn_mfma_f32_32x32x16_bf16(pa3, PK(l3, h3), od, 0, 0, 0);
#undef PK
}
template <int NCB> __device__ __forceinline__ void pv_all(f32x16* o, int vb, bf16x8 pa0, bf16x8 pa1, bf16x8 pa2, bf16x8 pa3) {
    pv_one<0, NCB>(o[0], vb, pa0, pa1, pa2, pa3); pv_one<1, NCB>(o[1], vb, pa0, pa1, pa2, pa3);
    if constexpr (NCB == 4) { pv_one<2, NCB>(o[2], vb, pa0, pa1, pa2, pa3); pv_one<3, NCB>(o[3], vb, pa0, pa1, pa2, pa3); }
}

template <int MODE> __device__ __forceinline__ void apply_mask(f32x16& p0, f32x16& p1, const Args& a, int j, int wid, int r32, int hi) {
    if constexpr (MODE == 1) {
        if (j < a.n0) return;
        const int kp0 = a.wpos0 + 64 * (j - a.n0), qw0 = a.qpos0 + wid * 32;
        if (kp0 + 63 - qw0 <= 128 && qw0 + 31 - kp0 <= 128) return;
        const int dd0 = kp0 - (qw0 + r32) + 4 * hi + 128;
#pragma unroll
        for (int r = 0; r < 16; ++r) { const int dd = dd0 + (r & 3) + 8 * (r >> 2);
            p0[r] = ((unsigned)dd <= 256u) ? p0[r] : -1e30f; p1[r] = ((unsigned)(dd + 32) <= 256u) ? p1[r] : -1e30f; }
    } else if constexpr (MODE == 2) {
        if (j < a.n0) return;
        const int kr = a.kr0 + (j - a.n0), qr = a.r0 + (wid >> 1);
        int rs = qr - 4; rs = rs < 0 ? 0 : (rs > 56 ? 56 : rs);
        if (kr < rs || kr >= rs + 8) {
#pragma unroll
            for (int r = 0; r < 16; ++r) { p0[r] = -1e30f; p1[r] = -1e30f; }
            return; }
        const int dr = kr - qr + 7, qc = (wid & 1) * 32 + r32;
        const float* tb = a.T + ((size_t)(dr * 64 + qc)) * 64 + 4 * hi;
#pragma unroll
        for (int gg = 0; gg < 4; gg += CT_GROUP) {
            f32x4 t0[CT_GROUP], t1[CT_GROUP];
#pragma unroll
            for (int g = 0; g < CT_GROUP; ++g) { t0[g] = *(const f32x4*)(tb + 8 * (gg + g)); t1[g] = *(const f32x4*)(tb + 32 + 8 * (gg + g)); }
#pragma unroll
            for (int g = 0; g < CT_GROUP; ++g)
#pragma unroll
                for (int i = 0; i < 4; ++i) { p0[4 * (gg + g) + i] += t0[g][i]; p1[4 * (gg + g) + i] += t1[g][i]; }
            asm volatile("" ::: "memory"); }
    }
}

template <int DK, int DV, int MODE, int SDEPTH>
__device__ __forceinline__ void attn_unit(const Args& a, LAS char* lds, const int tid) {
    constexpr int NKC = DK / 8, NVC = DV / 8, KPT = DK / 64, VPT = DV / 64, NCB = DV / 32, ND0 = DK / 16, QREG = (ND0 > 8 ? 6 : ND0);
    constexpr int SHM_K = 64 * DK * 2, SHM_V = 64 * DV * 2;
    const int wid = __builtin_amdgcn_readfirstlane(tid >> 6), lane = tid & 63, r32 = lane & 31, hi = lane >> 5;
    LAS char* V_lds = lds; LAS char* K_lds = lds + 2 * SHM_V;
    LAS float* ws = (LAS float*)(lds + 2 * SHM_V + 2 * SHM_K) + wid * 64; LAS float* li_l = ws; LAS float* al_l = ws + 32;
    LAS char* qx = lds + 2 * SHM_V + 2 * SHM_K + NW * 256 + wid * ((ND0 - QREG) * 1024) + lane * 16;
    float m_reg = -1e30f, l_reg = 0; f32x16 o[NCB]; bf16x8 qr[ND0];
#pragma unroll
    for (int d = 0; d < NCB; ++d) o[d] = f32x16{};
    const bf16* Qw = a.Q + (long)(wid * QBLK + r32) * a.ldq + hi * 8;
#pragma unroll
    for (int d0 = 0; d0 < ND0; ++d0) qr[d0] = *(const bf16x8*)(Qw + d0 * 16);
    if constexpr (DK == 192) {
        if (a.qrope) {
            const int t = a.qpos0 + wid * QBLK + r32; const float prow = (float)(t >> 6), pcol = (float)(t & 63);
#pragma unroll
            for (int dd = 0; dd < 2; ++dd) {
                bf16x8 x1 = qr[8 + dd], x2 = qr[10 + dd]; const float pos = dd ? pcol : prow;
#pragma unroll
                for (int e = 0; e < 8; ++e) { const float inv = __builtin_amdgcn_exp2f(-(float)(hi * 8 + e) * (13.287712379549449f / 16.0f)); const float ang = pos * inv;
                    const float c = __cosf(ang), s = __sinf(ang); const float f1 = bf2f((unsigned short)x1[e]), f2 = bf2f((unsigned short)x2[e]);
                    x1[e] = (short)f2bf(f1 * c - f2 * s); x2[e] = (short)f2bf(f1 * s + f2 * c); }
                qr[8 + dd] = x1; qr[10 + dd] = x2; }
        }
#pragma unroll
        for (int d0 = QREG; d0 < ND0; ++d0) *(LAS bf16x8*)(qx + (d0 - QREG) * 1024) = qr[d0];
        asm volatile("s_waitcnt lgkmcnt(0)" ::: "memory");
    }
    int koff[KPT], klds[KPT], voff[VPT], vlds[VPT];
#pragma unroll
    for (int i = 0; i < KPT; ++i) { const int q = tid + 512 * i, row = q / NKC, ch = q % NKC; koff[i] = row * a.ld + (ch < 16 ? a.kc0 + 8 * ch : a.kc1 + 8 * (ch - 16)); klds[i] = kswz<DK>(row, ch); }
#pragma unroll
    for (int i = 0; i < VPT; ++i) { const int q = tid + 512 * i, row = q / NVC, ch = q % NVC; voff[i] = row * a.ld + a.vc + 8 * ch; vlds[i] = v_st<NCB>(row, 8 * ch); }
    const int vb0 = (int)(uintptr_t)V_lds + v_rd_base(lane);
    bf16x8 sk[SDEPTH][KPT], sv[SDEPTH][VPT];
    const int NT = a.n0 + a.n1;
#define TROW(j) ((j) < a.n0 ? a.row0 + 64 * (j) : a.row1 + 64 * ((j) - a.n0))
#define SLOAD(i, j) do { const bf16* _b = a.KV + (long)TROW(j) * a.ld; \
    _Pragma("unroll") for (int _k = 0; _k < VPT; ++_k) sv[i][_k] = *(const bf16x8*)(_b + voff[_k]); \
    _Pragma("unroll") for (int _k = 0; _k < KPT; ++_k) sk[i][_k] = *(const bf16x8*)(_b + koff[_k]); } while (0)
#define SWRITE(b, i) do { \
    _Pragma("unroll") for (int _k = 0; _k < VPT; ++_k) *(LAS bf16x8*)(V_lds + (b) * SHM_V + vlds[_k]) = sv[i][_k]; \
    _Pragma("unroll") for (int _k = 0; _k < KPT; ++_k) *(LAS bf16x8*)(K_lds + (b) * SHM_K + klds[_k]) = sk[i][_k]; } while (0)
#define SWAIT() do { if constexpr (SDEPTH == 2) asm volatile("s_waitcnt vmcnt(%0)" :: "n"(KPT + VPT) : "memory"); else asm volatile("s_waitcnt vmcnt(0)" ::: "memory"); } while (0)
#define RESC(al) do { if (__any((al) < 1.f)) { if (hi == 0) al_l[r32] = (al); asm volatile("s_waitcnt lgkmcnt(0)" ::: "memory"); \
    _Pragma("unroll") for (int d = 0; d < NCB; ++d) _Pragma("unroll") for (int r = 0; r < 16; ++r) o[d][r] *= al_l[crow(r, hi)]; } } while (0)
    f32x16 pA0, pA1, pB0, pB1; float mnA, mnB, alA, alB; bf16x8 pa0, pa1, pa2, pa3;
    constexpr int SE = 0, SO = SDEPTH - 1;
    SLOAD(SE, 0); asm volatile("s_waitcnt vmcnt(0)" ::: "memory"); SWRITE(0, SE); __syncthreads();
    qkt<DK, QREG>(pA0, pA1, K_lds, qr, qx, r32, hi); apply_mask<MODE>(pA0, pA1, a, 0, wid, r32, hi); partialSM(pA0, pA1, m_reg, mnA, alA, a.C, a.thr);
    SLOAD(SO, 1); if constexpr (SDEPTH == 2) { if (2 < NT) SLOAD(SE, 2); }
    SWAIT(); SWRITE(1, SO); __syncthreads();
    for (int j = 1; j + 1 < NT; j += 2) {
        SBAR(); qkt<DK, QREG>(pB0, pB1, K_lds + SHM_K, qr, qx, r32, hi);
        finishSM(pA0, pA1, alA, l_reg, pa0, pa1, pa2, pa3); SBAR();
        SLOAD(SO, j + SDEPTH); SBAR();
        pv_all<NCB>(o, vb0, pa0, pa1, pa2, pa3); if constexpr (MODE != 0) SBAR(); apply_mask<MODE>(pB0, pB1, a, j, wid, r32, hi); if constexpr (MODE != 0) SBAR(); partialSM(pB0, pB1, m_reg, mnB, alB, a.C, a.thr);
        __syncthreads(); SWAIT(); SWRITE(0, SE);
        RESC(alB); __syncthreads();
        SBAR(); qkt<DK, QREG>(pA0, pA1, K_lds, qr, qx, r32, hi);
        finishSM(pB0, pB1, alB, l_reg, pa0, pa1, pa2, pa3); SBAR();
        if (SDEPTH == 1 || j + 3 < NT) SLOAD(SE, j + 1 + SDEPTH); SBAR();
        pv_all<NCB>(o, vb0 + SHM_V, pa0, pa1, pa2, pa3); if constexpr (MODE != 0) SBAR(); apply_mask<MODE>(pA0, pA1, a, j + 1, wid, r32, hi); if constexpr (MODE != 0) SBAR(); partialSM(pA0, pA1, m_reg, mnA, alA, a.C, a.thr);
        __syncthreads(); SWAIT(); SWRITE(1, SO);
        RESC(alA); __syncthreads();
    }
    SBAR(); qkt<DK, QREG>(pB0, pB1, K_lds + SHM_K, qr, qx, r32, hi);
    finishSM(pA0, pA1, alA, l_reg, pa0, pa1, pa2, pa3); SBAR();
    pv_all<NCB>(o, vb0, pa0, pa1, pa2, pa3); if constexpr (MODE != 0) SBAR(); apply_mask<MODE>(pB0, pB1, a, NT - 1, wid, r32, hi); if constexpr (MODE != 0) SBAR(); partialSM(pB0, pB1, m_reg, mnB, alB, a.C, a.thr);
    __syncthreads(); RESC(alB);
    finishSM(pB0, pB1, alB, l_reg, pa0, pa1, pa2, pa3); SBAR();
    pv_all<NCB>(o, vb0 + SHM_V, pa0, pa1, pa2, pa3);
    if constexpr (MODE == 1) { if (a.has_sink) l_reg += __builtin_amdgcn_exp2f(a.sinkl2 - m_reg * a.C); }
    if (hi == 0) li_l[r32] = l_reg; asm volatile("s_waitcnt lgkmcnt(0)" ::: "memory");
    float rli[16];
#pragma unroll
    for (int r = 0; r < 16; ++r) rli[r] = __builtin_amdgcn_rcpf(li_l[crow(r, hi)]);
    bf16* Ow = a.O + (long)(wid * QBLK) * a.ldo;
#pragma unroll
    for (int r = 0; r < 16; ++r) { const int orow = crow(r, hi);
#pragma unroll
        for (int d0 = 0; d0 < NCB; ++d0) { const float ov = o[d0][r] * rli[r];
            if (a.o8) ((unsigned char*)a.O)[(long)(wid * QBLK + orow) * a.ldo + d0 * 32 + r32] = (unsigned char)(__builtin_amdgcn_cvt_pk_fp8_f32(ov, ov, 0, false) & 0xff);
            else Ow[(long)orow * a.ldo + d0 * 32 + r32] = f2bf(ov); } }
    __syncthreads();
#undef TROW
#undef SLOAD
#undef SWRITE
#undef SWAIT
#undef RESC
}
#undef SBAR
}
constexpr int DM = 2048, NBATCH = 4, SEQ = 4096, NCTX = 256, DEPTH = 2;
constexpr int ML = NBATCH * SEQ, MC = NBATCH * NCTX, MT = ML + MC;
constexpr int INW = 3904, UW = 4096, QW = 1856;
constexpr int MODW = 6 * DM;
constexpr float LN_EPS = 1e-5f, RMS_EPS = 1e-6f;
constexpr float ALPHA = 1.4142135623730951f;
constexpr float LOG2E = 1.4426950408889634f;
constexpr float A_SCALE = 0.07216878364870323f, B_SCALE = 0.125f, C_SCALE = 0.08838834764831845f, D_SCALE = 0.08838834764831845f;
constexpr int U_CQ = 0, U_CKV = 384, U_KR = 512, U_BQ = 576, U_BK = 1088, U_BV = 1216, U_CQQ = 1344, U_CK = 1856, U_CV = 2368, U_DQ = 2880, U_DK = 3392, U_DV = 3648;
constexpr int QA_Q = 0, QA_KV = 768, QA_KR = 1792;

#ifndef U4_STEP_SIGMA
#define U4_STEP_SIGMA 0.34f
#endif
#ifndef F8_OUT
#define F8_OUT 1
#endif
#ifndef F8_PQ
#define F8_PQ 0
#endif
#ifndef F8_IN
#define F8_IN 1
#endif
#ifndef F8_MERGE
#define F8_MERGE 1
#endif
constexpr size_t MiB = 1u << 20;
constexpr size_t WS_CTL = 0, CTL_ZERO_BYTES = 1 * MiB;
constexpr size_t WS_MOD = 1 * MiB;
constexpr size_t WS_CTAB = 2 * MiB;
constexpr size_t WS_SUBK = 4 * MiB;
constexpr size_t WS_WUP = 5 * MiB;
constexpr size_t WS_WIN = 9 * MiB;
constexpr size_t WS_WC = 41 * MiB;
constexpr size_t WS_WO = 121 * MiB;
constexpr size_t WS_WPQ = 137 * MiB;
constexpr size_t WS_PU = 153 * MiB;
constexpr size_t WS_PV = 281 * MiB;
constexpr size_t WS_BUFA = 409 * MiB;
constexpr size_t WS_BUFB = 477 * MiB;
constexpr size_t WS_UREG = 545 * MiB;
constexpr size_t WS_QKVA = 681 * MiB;
constexpr size_t WS_OQP = 743 * MiB;
constexpr size_t WS_XRES = 811 * MiB;
constexpr size_t WS_EIDX = 947 * MiB;
constexpr size_t WS_EG = 956 * MiB;
constexpr size_t WS_MODP = 965 * MiB;
constexpr size_t WS_SCU = 973 * MiB, WS_SCV = WS_SCU + 2 * 16384 * 4;
constexpr size_t WS_DBG = 973 * MiB + 512 * 1024;
constexpr size_t WS_LNS = 973 * MiB + 840 * 1024;
constexpr size_t WS_HQS = 973 * MiB + 768 * 1024;
constexpr size_t WS_H8 = 974 * MiB;
constexpr size_t WS_END = 1008 * MiB;
constexpr size_t STASH_WG = 131072, P_WG = 262144, WS_STASH = WS_UREG, WS_P = WS_UREG + 32 * MiB, WS_CP = WS_UREG + 96 * MiB;
constexpr int CW_TMO = 0, CW_BAR = 4096;

constexpr int NWAVES = 8;
constexpr int RING_OFF = 0, RING_BYTES = 155648;
constexpr int LDSCTL_OFF = RING_BYTES, MISC_OFF = LDSCTL_OFF + 320;
constexpr int LDS_BYTES = 157696;

#define RLX_AGENT __ATOMIC_RELAXED, __HIP_MEMORY_SCOPE_AGENT
#define LDS_WAIT() asm volatile("s_waitcnt lgkmcnt(0)" ::: "memory")
#define VM_WAIT() asm volatile("s_waitcnt vmcnt(0)" ::: "memory")

#define XB_TMO      128
#define XB_XCNT(j)  (256  + 64 * (j))
#define XB_XSUB(j)  (1280 + 64 * (j))
#define XB_XGEN(j)  (2304 + 64 * (j))
#define XB_TOP      3328
#define XB_TOPGEN   3392
#define XCD_BAR_WORDS 3456
#define XB_SPIN_CAP (1u << 22)
__device__ __forceinline__ unsigned xb_ld(unsigned* p)              { return __hip_atomic_load(p, __ATOMIC_RELAXED, __HIP_MEMORY_SCOPE_AGENT); }
__device__ __forceinline__ unsigned xb_add(unsigned* p, unsigned v) { return __hip_atomic_fetch_add(p, v, __ATOMIC_RELAXED, __HIP_MEMORY_SCOPE_AGENT); }
__device__ __forceinline__ unsigned xb_xcc_id() { return (unsigned)__builtin_amdgcn_s_getreg((3 << 11) | 20) & 0xFu; }
#define XB_SPIN(cond, bar) do { unsigned _sp = 0; while (cond) { __builtin_amdgcn_s_sleep(1); \
    if ((++_sp & 255u) == 0u) { if (xb_ld(&(bar)[XB_TMO])) break; if (_sp > XB_SPIN_CAP) { atomicAdd(&(bar)[XB_TMO], 1u); break; } } } } while (0)
struct XcdBarrier { unsigned* bar; unsigned x; volatile LAS unsigned* st; };
__device__ __forceinline__ XcdBarrier xcd_barrier_post(unsigned* bar, volatile LAS unsigned* st) {
    XcdBarrier b; b.bar = bar; b.x = xb_xcc_id(); b.st = st;
    if (threadIdx.x == 0) (void)xb_add(&bar[XB_XCNT(b.x)], 1u);
    return b;
}
__device__ __forceinline__ void xcd_barrier_complete(unsigned* bar, unsigned x, unsigned& nloc, unsigned& nx) {
    const unsigned G = gridDim.x * gridDim.y * gridDim.z;
    unsigned sum, cnt, mine, sp = 0u;
    for (;;) {
        sum = 0u; cnt = 0u; mine = 0u;
#pragma unroll
        for (unsigned j = 0; j < 16; ++j) { const unsigned c = xb_ld(&bar[XB_XCNT(j)]); sum += c; cnt += (c > 0u) ? 1u : 0u; mine = (j == x) ? c : mine; }
        if (sum == G) break;
        __builtin_amdgcn_s_sleep(1);
        if ((++sp & 255u) == 0u) { if (xb_ld(&bar[XB_TMO])) break; if (sp > XB_SPIN_CAP) { atomicAdd(&bar[XB_TMO], 1u); break; } }
    }
    nloc = mine > 0u ? mine : 1u; nx = cnt > 0u ? cnt : 1u;
}
__device__ __forceinline__ void xcd_barrier(const XcdBarrier& b) {
    asm volatile("s_waitcnt vmcnt(0)" ::: "memory");
    __syncthreads();
    if (threadIdx.x == 0) {
        unsigned* bar = b.bar;
        __builtin_amdgcn_s_waitcnt(0);
        unsigned nloc = b.st[0], nx = b.st[1];
        if (nloc == 0u) { xcd_barrier_complete(bar, b.x, nloc, nx); b.st[0] = nloc; b.st[1] = nx; }
        const unsigned old = xb_add(&bar[XB_XSUB(b.x)], 1u);
        const unsigned gen = old / nloc;
        if (old + 1u == (gen + 1u) * nloc) {
            __builtin_amdgcn_fence(__ATOMIC_RELEASE, "agent");
            asm volatile("s_waitcnt vmcnt(0)" ::: "memory");
            const unsigned og = xb_add(&bar[XB_TOP], 1u);
            const unsigned tg = og / nx;
            if (og + 1u == (tg + 1u) * nx) xb_add(&bar[XB_TOPGEN], 1u);
            else XB_SPIN(xb_ld(&bar[XB_TOPGEN]) == tg, bar);
            __builtin_amdgcn_fence(__ATOMIC_ACQUIRE, "agent");
            xb_add(&bar[XB_XGEN(b.x)], 1u);
            asm volatile("s_waitcnt vmcnt(0)" ::: "memory");
        } else {
            XB_SPIN(xb_ld(&bar[XB_XGEN(b.x)]) == gen, bar);
            __builtin_amdgcn_fence(__ATOMIC_ACQUIRE, "agent");
            asm volatile("s_waitcnt vmcnt(0)" ::: "memory");
        }
    }
    __syncthreads();
}

struct In {
    const float *x, *c, *ctx, *c_ctx, *w_ada, *b_ada, *w_in, *a_q_norm, *a_kv_norm, *a_w_uq, *a_w_ukv, *b_sink, *c_rpb, *d_q_norm, *d_k_norm,
                *w_branch, *w_gate, *b_gate, *w_out, *ln1_g, *ln1_b, *ln2_g, *ln2_b, *peer_w_q, *peer_sub_keys, *peer_u, *peer_v;
};
struct Args { In in; float* out; unsigned char* ws; int ph_lo, ph_hi, li, pad; };
struct Frame { LAS unsigned char* lds; int tid, lane, wave, vcu, G; GAS unsigned char* ws; };
template <class T> __device__ __forceinline__ T* G(T* p) { return (T*)(GAS T*)p; }
typedef const __attribute__((address_space(4))) Args& KA;
typedef const __attribute__((address_space(4))) Args* KAP;
__device__ __forceinline__ KAP kargs() { KAP p = (KAP)__builtin_amdgcn_kernarg_segment_ptr(); asm volatile("" : "+s"(p)); return p; }

__device__ __forceinline__ float wave_sum(float v) {
#pragma unroll
    for (int o = 1; o < 64; o <<= 1) v += __shfl_xor(v, o);
    return v;
}
__device__ __forceinline__ unsigned pk2(float lo, float hi) { return cvt_pk_bf16(lo, hi); }
__device__ __forceinline__ float silu_f(float v) { return v / (1.0f + __expf(-v)); }

__device__ __forceinline__ void p0_transpose_item(const float* W, int ldw, int nblk, bf16* dst, int dpitch, int row_off, int col_off, const float* gain, LAS float* scr, int item, int lane, int f8) {
    const int kb = item / nblk, nb = item % nblk, k0 = 64 * kb, n0 = 32 * nb;
    {
        f32x4 v[8]; const float* wp = W + (size_t)(k0 + (lane >> 3)) * ldw + n0 + (lane & 7) * 4;
#pragma unroll
        for (int i = 0; i < 8; ++i) v[i] = *(const f32x4*)(wp + (size_t)(8 * i) * ldw);
        if (gain) {
#pragma unroll
            for (int i = 0; i < 8; ++i) v[i] *= gain[k0 + (lane >> 3) + 8 * i]; }
        LAS float* sp = scr + (lane >> 3) * 33 + (lane & 7) * 4;
#pragma unroll
        for (int i = 0; i < 8; ++i) { sp[i * 8 * 33 + 0] = v[i][0]; sp[i * 8 * 33 + 1] = v[i][1]; sp[i * 8 * 33 + 2] = v[i][2]; sp[i * 8 * 33 + 3] = v[i][3]; }
    }
    LDS_WAIT(); asm volatile("" ::: "memory");
    const int c = lane & 7;
#pragma unroll
    for (int j = 0; j < 4; ++j) { const int n = (lane >> 3) + 8 * j; const LAS float* s = scr + (8 * c) * 33 + n;
        if (f8) {
            int w0 = __builtin_amdgcn_cvt_pk_fp8_f32(s[0 * 33] * 64.f, s[1 * 33] * 64.f, 0, false); w0 = __builtin_amdgcn_cvt_pk_fp8_f32(s[2 * 33] * 64.f, s[3 * 33] * 64.f, w0, true);
            int w1 = __builtin_amdgcn_cvt_pk_fp8_f32(s[4 * 33] * 64.f, s[5 * 33] * 64.f, 0, false); w1 = __builtin_amdgcn_cvt_pk_fp8_f32(s[6 * 33] * 64.f, s[7 * 33] * 64.f, w1, true);
            *(GAS u32x2*)((GAS unsigned char*)dst + (size_t)(row_off + n0 + n) * dpitch + col_off + k0 + 8 * c) = (u32x2){(unsigned)w0, (unsigned)w1}; }
        else { u32x4 o; o.x = pk2(s[0 * 33], s[1 * 33]); o.y = pk2(s[2 * 33], s[3 * 33]); o.z = pk2(s[4 * 33], s[5 * 33]); o.w = pk2(s[6 * 33], s[7 * 33]);
        *(GAS u32x4*)(dst + (size_t)(row_off + n0 + n) * dpitch + col_off + k0 + 8 * c) = o; } }
    LDS_WAIT(); asm volatile("" ::: "memory");
}
struct TJob { const float* W; int K, N; bf16* dst; int dpitch, row_off, col_off; const float* gain; int f8; };
__device__ __forceinline__ int tjob_get(KA A, int job, TJob& t) {
    const int l = job / 13, j = job % 13; GAS unsigned char* ws = (GAS unsigned char*)A.ws; t.gain = nullptr; t.row_off = 0; t.col_off = 0; t.f8 = 0;
    if (j == 0) { t.W = G(A.in.w_in) + (size_t)l * DM * INW; t.K = DM; t.N = INW; t.dst = F8_IN ? (bf16*)((unsigned char*)(ws + WS_WIN) + (size_t)l * UW * DM) : (bf16*)(ws + WS_WIN) + (size_t)l * UW * DM; t.dpitch = DM; t.f8 = F8_IN; }
    else if (j <= 4) { const int z = j - 1; t.W = G(A.in.w_gate) + ((size_t)l * 4 + z) * DM * DM; t.K = DM; t.N = DM; t.dst = F8_MERGE ? (bf16*)((unsigned char*)(ws + WS_WC) + ((size_t)l * 4 + z) * DM * 2560) : (bf16*)(ws + WS_WC) + ((size_t)l * 4 + z) * DM * 2560; t.dpitch = 2560; t.f8 = F8_MERGE; }
    else if (j <= 8) { const int z = j - 5; t.W = G(A.in.w_branch) + ((size_t)l * 4 + z) * 512 * DM; t.K = 512; t.N = DM; t.dst = F8_MERGE ? (bf16*)((unsigned char*)(ws + WS_WC) + ((size_t)l * 4 + z) * DM * 2560) : (bf16*)(ws + WS_WC) + ((size_t)l * 4 + z) * DM * 2560; t.dpitch = 2560; t.col_off = 2048; t.f8 = F8_MERGE; }
    else if (j == 9) { t.W = G(A.in.w_out) + (size_t)l * DM * DM; t.K = DM; t.N = DM; t.dst = (bf16*)((unsigned char*)(ws + WS_WO) + (size_t)l * DM * DM); t.dpitch = DM; t.f8 = F8_OUT; }
    else if (j == 10) { t.W = G(A.in.peer_w_q) + (size_t)l * DM * DM; t.K = DM; t.N = DM; t.dst = F8_PQ ? (bf16*)((unsigned char*)(ws + WS_WPQ) + (size_t)l * DM * DM) : (bf16*)(ws + WS_WPQ) + (size_t)l * DM * DM; t.dpitch = DM; t.f8 = F8_PQ; }
    else if (j == 11) { t.W = G(A.in.a_w_uq) + (size_t)l * 384 * 768; t.K = 384; t.N = 768; t.dst = (bf16*)(ws + WS_WUP) + (size_t)l * 1792 * 512; t.dpitch = 512; t.gain = G(A.in.a_q_norm) + l * 384; }
    else { t.W = G(A.in.a_w_ukv) + (size_t)l * 128 * 1024; t.K = 128; t.N = 1024; t.dst = (bf16*)(ws + WS_WUP) + (size_t)l * 1792 * 512; t.dpitch = 512; t.row_off = 768; t.col_off = 384; t.gain = G(A.in.a_kv_norm) + l * 128; }
    return (t.K / 64) * (t.N / 32);
}
__device__ __forceinline__ void p0_prologue(const Frame& F, KA A) {
    GAS unsigned char* ws = F.ws;
    const int gw = F.vcu * NWAVES + F.wave, NGW = F.G * NWAVES;
    const long gt = (long)gw * 64 + F.lane, NGT = (long)NGW * 64;
    {
        float* modp = (float*)(ws + WS_MODP);
        for (int it = gw; it < 2 * 16 * 48; it += NGW) {
            const int l = it / 768, ks = (it % 768) / 48, cg = it % 48, n = cg * 256 + F.lane * 4;
            const float* w = G(A.in.w_ada) + ((size_t)l * DM + ks * 128) * MODW + n;
            f32x4 acc[5];
#pragma unroll
            for (int r = 0; r < 5; ++r) acc[r] = (f32x4){0.f, 0.f, 0.f, 0.f};
#pragma unroll 8
            for (int k = 0; k < 128; ++k) {
                const f32x4 wv = *(const f32x4*)(w + (size_t)k * MODW);
                const int kk = ks * 128 + k;
#pragma unroll
                for (int r = 0; r < 5; ++r) { const float cv = (r < 4) ? G(A.in.c)[r * DM + kk] : G(A.in.c_ctx)[kk]; acc[r] += wv * silu_f(cv); }
            }
#pragma unroll
            for (int r = 0; r < 5; ++r) *(f32x4*)(modp + (((size_t)ks * 2 + l) * 5 + r) * MODW + n) = acc[r];
        }
    }
    {
        LAS float* scr = (LAS float*)(F.lds + RING_OFF + F.wave * 16384);
        int base = 0;
        for (int job = 0; job < 26; ++job) {
            TJob t; const int ni = tjob_get(A, job, t);
            int first = gw - (base % NGW); if (first < 0) first += NGW;
            for (int i = first; i < ni; i += NGW) p0_transpose_item(t.W, t.N, t.N / 32, t.dst, t.dpitch, t.row_off, t.col_off, t.gain, scr, i, F.lane, t.f8);
            base += ni;
        }
    }
    for (long i = gt; i < 2L * 192 * 2048 / 8; i += NGT) { const int l = (int)(i / (192 * 256)), r = (int)(i % (192 * 256));
        if (F8_IN) { if (r < 192 * 128) *(u32x4*)((unsigned char*)(ws + WS_WIN) + ((size_t)l * UW + 3904) * DM + (size_t)r * 16) = (u32x4){0u, 0u, 0u, 0u}; }
        else *(u32x4*)((bf16*)(ws + WS_WIN) + ((size_t)l * UW + 3904) * DM + (size_t)r * 8) = (u32x4){0u, 0u, 0u, 0u}; }
    for (long i = gt; i < 2L * 768 * 16; i += NGT) { const int l = (int)(i / (768 * 16)), r = (int)(i % (768 * 16)), row = r / 16, c8 = r % 16; *(u32x4*)((bf16*)(ws + WS_WUP) + ((size_t)l * 1792 + row) * 512 + 384 + c8 * 8) = (u32x4){0u, 0u, 0u, 0u}; }
    for (long i = gt; i < 2L * 1024 * 48; i += NGT) { const int l = (int)(i / (1024 * 48)), r = (int)(i % (1024 * 48)), row = r / 48, c8 = r % 48; *(u32x4*)((bf16*)(ws + WS_WUP) + ((size_t)l * 1792 + 768 + row) * 512 + c8 * 8) = (u32x4){0u, 0u, 0u, 0u}; }
    {
        const long n_sk = 2L * 8 * 2 * 128 * 128 / 8;
        for (long i = gt; i < n_sk; i += NGT) {
            const float* src = G(A.in.peer_sub_keys); bf16* dst = (bf16*)(ws + WS_SUBK);
            const f32x4 a = *(const f32x4*)(src + i * 8), b = *(const f32x4*)(src + i * 8 + 4);
            u32x4 o; o.x = pk2(a[0], a[1]); o.y = pk2(a[2], a[3]); o.z = pk2(b[0], b[1]); o.w = pk2(b[2], b[3]);
            *(u32x4*)(dst + i * 8) = o;
        }
        for (int r = gw; r < 4 * 16384; r += NGW) {
            const bool isu = r < 2 * 16384; const int row = isu ? r : r - 2 * 16384;
            const float* src = (isu ? G(A.in.peer_u) + (size_t)row * 2048 + F.lane * 8 : G(A.in.peer_v) + (size_t)row * 2048 + F.lane * 4);
            f32x4 v[8]; float am = 0.f;
#pragma unroll
            for (int q = 0; q < 8; ++q) { v[q] = *(const f32x4*)(src + (isu ? (q >> 1) * 512 + (q & 1) * 4 : q * 256));
                am = fmaxf(am, fmaxf(fmaxf(__builtin_fabsf(v[q][0]), __builtin_fabsf(v[q][1])), fmaxf(__builtin_fabsf(v[q][2]), __builtin_fabsf(v[q][3])))); }
#pragma unroll
            for (int o = 1; o < 64; o <<= 1) am = fmaxf(am, __shfl_xor(am, o));
            if (isu) {
                float ss = 0.f;
#pragma unroll
                for (int q = 0; q < 8; ++q) ss += (v[q][0] * v[q][0] + v[q][1] * v[q][1]) + (v[q][2] * v[q][2] + v[q][3] * v[q][3]);
#pragma unroll
                for (int o = 1; o < 64; o <<= 1) ss += __shfl_xor(ss, o);
                float step = am * (1.0f / 7.0f); const float st2 = U4_STEP_SIGMA * sqrtf(ss * (1.0f / 2048.0f));
                if (st2 < step) step = st2;
                const float S = step > 0.f ? 1.0f / step : 1.0f;
                unsigned* dst = (unsigned*)(ws + WS_PU) + (size_t)row * 256 + F.lane;
#pragma unroll
                for (int q = 0; q < 4; ++q) { unsigned w = 0u;
#pragma unroll
                    for (int b = 0; b < 4; ++b) { int lo = (int)__builtin_rintf(v[2 * q][b] * S), hi = (int)__builtin_rintf(v[2 * q + 1][b] * S);
                        lo = lo < -7 ? -7 : (lo > 7 ? 7 : lo); hi = hi < -7 ? -7 : (hi > 7 ? 7 : hi);
                        w |= ((unsigned)((lo + 8) & 15) | ((unsigned)(hi & 15) << 4)) << (8 * b); }
                    dst[q * 64] = w; }
                if (F.lane == 0) ((float*)(ws + WS_SCU))[row] = step > 0.f ? step : 1.0f;
            } else {
                const float S = am > 0.f ? 6.0f / am : 1.0f;
                unsigned short* dst = (unsigned short*)(ws + WS_PV) + (size_t)row * 512 + F.lane;
#pragma unroll
                for (int q = 0; q < 8; ++q) { const f32x4 a = v[q] * S;
                    unsigned w = __builtin_amdgcn_cvt_scalef32_pk_fp4_f32(0u, a[0], a[1], 1.0f, 0); w = __builtin_amdgcn_cvt_scalef32_pk_fp4_f32(w, a[2], a[3], 1.0f, 1);
                    dst[q * 64] = (unsigned short)(w & 0xffffu); }
                if (F.lane == 0) ((float*)(ws + WS_SCV))[row] = am > 0.f ? am * (1.0f / 6.0f) : 1.0f;
            }
        }
    }
    {
        float* ct = (float*)(ws + WS_CTAB);
        for (long i = gt; i < 2L * 4 * 15 * 64 * 64; i += NGT) {
            const int kc = (int)(i & 63), qc = (int)((i >> 6) & 63), r = (int)(i >> 12), dr = r % 15, lh = r / 15;
            int cs = qc - 8; cs = cs < 0 ? 0 : (cs > 48 ? 48 : cs);
            int co = kc - qc + 15; co = co < 0 ? 0 : (co > 30 ? 30 : co);
            ct[i] = (kc >= cs && kc < cs + 16) ? G(A.in.c_rpb)[((size_t)lh * 15 + dr) * 31 + co] * (1.0f / C_SCALE) : -1e30f;
        }
    }
}
__device__ __forceinline__ void p1_modreduce(const Frame& F, KA A) {
    const long gt = ((long)F.vcu * NWAVES + F.wave) * 64 + F.lane, NGT = (long)F.G * NWAVES * 64;
    const float* modp = (const float*)(F.ws + WS_MODP); float* mod = (float*)(F.ws + WS_MOD);
    for (long i = gt; i < 2L * 5 * MODW; i += NGT) { const int n = (int)(i % MODW), l = (int)(i / (5 * MODW));
        float s = G(A.in.b_ada)[l * MODW + n];
#pragma unroll
        for (int ks = 0; ks < 16; ++ks) s += modp[(size_t)ks * 2 * 5 * MODW + i];
        mod[i] = s; }
}
__device__ __forceinline__ void p2_modulate0(const Frame& F, KA A) {
    const int gw = F.vcu * NWAVES + F.wave, NGW = F.G * NWAVES;
    const float* mod = (const float*)(F.ws + WS_MOD); bf16* H = (bf16*)(F.ws + WS_BUFA);
    for (int row = gw; row < MT; row += NGW) {
        const float* xr = row < ML ? G(A.in.x) + (size_t)row * DM : G(A.in.ctx) + (size_t)(row - ML) * DM;
        const float* mr = mod + (size_t)(row < ML ? (row >> 12) : 4) * MODW;
        f32x4 xa[4], xb[4], sa[4], sb[4], ca[4], cb[4];
#pragma unroll
        for (int j = 0; j < 4; ++j) { const int c = j * 512 + F.lane * 8; xa[j] = *(const f32x4*)(xr + c); xb[j] = *(const f32x4*)(xr + c + 4);
            sa[j] = *(const f32x4*)(mr + c); sb[j] = *(const f32x4*)(mr + c + 4); ca[j] = *(const f32x4*)(mr + DM + c); cb[j] = *(const f32x4*)(mr + DM + c + 4); }
        asm volatile("" ::: "memory");
#pragma unroll
        for (int j = 0; j < 4; ++j) { const int c = j * 512 + F.lane * 8;
            const f32x4 y0 = xa[j] * (ca[j] + 1.0f) + sa[j], y1 = xb[j] * (cb[j] + 1.0f) + sb[j];
            u32x4 o; o.x = pk2(y0[0], y0[1]); o.y = pk2(y0[2], y0[3]); o.z = pk2(y1[0], y1[1]); o.w = pk2(y1[2], y1[3]);
            if (!(F8_IN && F8_MERGE)) *(u32x4*)(H + (size_t)row * DM + c) = o;
            if (F8_MERGE) { int w0 = __builtin_amdgcn_cvt_pk_fp8_f32(y0[0], y0[1], 0, false); w0 = __builtin_amdgcn_cvt_pk_fp8_f32(y0[2], y0[3], w0, true);
                int w1 = __builtin_amdgcn_cvt_pk_fp8_f32(y1[0], y1[1], 0, false); w1 = __builtin_amdgcn_cvt_pk_fp8_f32(y1[2], y1[3], w1, true);
                *(u32x2*)((unsigned char*)(F.ws + WS_H8) + (size_t)row * DM + c) = (u32x2){(unsigned)w0, (unsigned)w1}; } }
    }
}
__device__ __forceinline__ void rope_pair(float& x1, float& x2, float ang) { const float c = __cosf(ang), s = __sinf(ang); const float y1 = x1 * c - x2 * s, y2 = x1 * s + x2 * c; x1 = y1; x2 = y2; }
__device__ __forceinline__ void enorm_phase(const Frame& F, KA A, int l) {
    const int gw = F.vcu * NWAVES + F.wave, NGW = F.G * NWAVES, lane = F.lane;
    bf16* U = (bf16*)(F.ws + WS_UREG); bf16* QK = (bf16*)(F.ws + WS_QKVA);
    const float* gq = G(A.in.d_q_norm) + l * 128; const float* gk = G(A.in.d_k_norm) + l * 128;
    const float L2T = 13.287712379549449f;
    for (int row = gw; row < MT; row += NGW) {
        bf16* u = U + (size_t)row * UW;
        const bool lat = row < ML; const int t = row & 4095;
        const float prow = lat ? (float)(t >> 6) : 0.f, pcol = lat ? (float)(t & 63) : 0.f;
        const int j64 = lane & 31, hq = lane >> 5;
        unsigned wcq[3];
#pragma unroll
        for (int i = 0; i < 3; ++i) wcq[i] = ((const unsigned*)(u + U_CQ))[lane + 64 * i];
        const unsigned wkv = ((const unsigned*)(u + U_CKV))[lane];
        float kr1 = bf2f(u[U_KR + j64]), kr2 = bf2f(u[U_KR + 32 + j64]);
        float bq1[4], bq2[4];
#pragma unroll
        for (int i = 0; i < 4; ++i) { const bf16* q = u + U_BQ + (hq + 2 * i) * 64; bq1[i] = bf2f(q[j64]); bq2[i] = bf2f(q[32 + j64]); }
        float bk1 = bf2f(u[U_BK + hq * 64 + j64]), bk2 = bf2f(u[U_BK + hq * 64 + 32 + j64]);
        float dq1[4], dq2[4], dk1[2], dk2[2];
#pragma unroll
        for (int hd = 0; hd < 4; ++hd) { dq1[hd] = bf2f(u[U_DQ + hd * 128 + lane]); dq2[hd] = bf2f(u[U_DQ + hd * 128 + 64 + lane]); }
#pragma unroll
        for (int hd = 0; hd < 2; ++hd) { dk1[hd] = bf2f(u[U_DK + hd * 128 + lane]); dk2[hd] = bf2f(u[U_DK + hd * 128 + 64 + lane]); }
        const float gq1 = gq[lane], gq2 = gq[64 + lane], gk1 = gk[lane], gk2 = gk[64 + lane];
        asm volatile("" ::: "memory");
        float ss = 0.f;
#pragma unroll
        for (int i = 0; i < 3; ++i) { const float a = bflo(wcq[i]), b = bfhi(wcq[i]); ss += a * a + b * b; }
        const float rq = rsqrtf(wave_sum(ss) * (1.0f / 384.0f) + RMS_EPS);
        const float va = bflo(wkv), vb = bfhi(wkv);
        const float rkv = rsqrtf(wave_sum(va * va + vb * vb) * (1.0f / 128.0f) + RMS_EPS);
        const float ang64 = ((j64 < 16) ? prow : pcol) * __builtin_amdgcn_exp2f(-(float)(j64 & 15) * (L2T / 16.0f));
        const float ang128 = ((lane < 32) ? prow : pcol) * __builtin_amdgcn_exp2f(-(float)(lane & 31) * (L2T / 32.0f));
        rope_pair(kr1, kr2, ang64);
#pragma unroll
        for (int i = 0; i < 4; ++i) rope_pair(bq1[i], bq2[i], ang64);
        rope_pair(bk1, bk2, ang64);
#pragma unroll
        for (int hd = 0; hd < 4; ++hd) { const float rstd = rsqrtf(wave_sum(dq1[hd] * dq1[hd] + dq2[hd] * dq2[hd]) * (1.0f / 128.0f) + RMS_EPS);
            dq1[hd] = dq1[hd] * rstd * gq1; dq2[hd] = dq2[hd] * rstd * gq2; rope_pair(dq1[hd], dq2[hd], ang128); }
#pragma unroll
        for (int hd = 0; hd < 2; ++hd) { const float rstd = rsqrtf(wave_sum(dk1[hd] * dk1[hd] + dk2[hd] * dk2[hd]) * (1.0f / 128.0f) + RMS_EPS);
            dk1[hd] = dk1[hd] * rstd * gk1; dk2[hd] = dk2[hd] * rstd * gk2; rope_pair(dk1[hd], dk2[hd], ang128); }
#pragma unroll
        for (int i = 0; i < 3; ++i) ((unsigned*)(u + U_CQ))[lane + 64 * i] = pk2(bflo(wcq[i]) * rq, bfhi(wcq[i]) * rq);
        ((unsigned*)(u + U_CKV))[lane] = pk2(va * rkv, vb * rkv);
        if (lane < 32) { bf16* o = QK + (size_t)row * QW + QA_KR; o[lane] = f2bf(kr1); o[32 + lane] = f2bf(kr2); }
#pragma unroll
        for (int i = 0; i < 4; ++i) { bf16* q = u + U_BQ + (hq + 2 * i) * 64; q[j64] = f2bf(bq1[i]); q[32 + j64] = f2bf(bq2[i]); }
        { bf16* q = u + U_BK + hq * 64; q[j64] = f2bf(bk1); q[32 + j64] = f2bf(bk2); }
#pragma unroll
        for (int hd = 0; hd < 4; ++hd) { bf16* q = u + U_DQ + hd * 128; q[lane] = f2bf(dq1[hd]); q[64 + lane] = f2bf(dq2[hd]); }
#pragma unroll
        for (int hd = 0; hd < 2; ++hd) { bf16* q = u + U_DK + hd * 128; q[lane] = f2bf(dk1[hd]); q[64 + lane] = f2bf(dk2[hd]); }
    }
}
__device__ __forceinline__ void ln1_phase(const Frame& F, KA A, int l, int nrows, bf16* HF) {
    const int gw = F.vcu * NWAVES + F.wave, NGW = F.G * NWAVES, lane = F.lane;
    const bf16* Y = (const bf16*)(F.ws + WS_UREG); const float* mod = (const float*)(F.ws + WS_MOD) + (size_t)l * 5 * MODW;
    const float* g = G(A.in.ln1_g) + l * DM; const float* b = G(A.in.ln1_b) + l * DM;
    for (int row = gw; row < nrows; row += NGW) {
        const bf16* y = Y + (size_t)row * DM; const float* mr = mod + (size_t)(row < ML ? (row >> 12) : 4) * MODW;
        f32x4 v[8], gg[8], bb[8], sc[8], sh[8]; u32x4 yw[4]; float s = 0.f;
#pragma unroll
        for (int j = 0; j < 4; ++j) { const int c = j * 512 + lane * 8; yw[j] = *(const u32x4*)(y + c);
            gg[2 * j] = *(const f32x4*)(g + c); gg[2 * j + 1] = *(const f32x4*)(g + c + 4); bb[2 * j] = *(const f32x4*)(b + c); bb[2 * j + 1] = *(const f32x4*)(b + c + 4);
            sc[2 * j] = *(const f32x4*)(mr + 4 * DM + c); sc[2 * j + 1] = *(const f32x4*)(mr + 4 * DM + c + 4); sh[2 * j] = *(const f32x4*)(mr + 3 * DM + c); sh[2 * j + 1] = *(const f32x4*)(mr + 3 * DM + c + 4); }
        asm volatile("" ::: "memory");
#pragma unroll
        for (int j = 0; j < 4; ++j) { v[2 * j] = (f32x4){bflo(yw[j].x), bfhi(yw[j].x), bflo(yw[j].y), bfhi(yw[j].y)}; v[2 * j + 1] = (f32x4){bflo(yw[j].z), bfhi(yw[j].z), bflo(yw[j].w), bfhi(yw[j].w)}; }
#pragma unroll
        for (int j = 0; j < 8; ++j) s += (v[j][0] + v[j][1]) + (v[j][2] + v[j][3]);
        const float mean = wave_sum(s) * (1.0f / DM); float q = 0.f;
#pragma unroll
        for (int j = 0; j < 8; ++j) { v[j] = v[j] - mean; q += (v[j][0] * v[j][0] + v[j][1] * v[j][1]) + (v[j][2] * v[j][2] + v[j][3] * v[j][3]); }
        const float rstd = rsqrtf(wave_sum(q) * (1.0f / DM) + LN_EPS);
        if (lane == 0) *(f32x2*)((float*)(F.ws + WS_LNS) + 2 * (size_t)row) = (f32x2){mean, rstd};
        float am = 0.f;
#pragma unroll
        for (int j = 0; j < 4; ++j) { const int c = j * 512 + lane * 8;
            const f32x4 x0 = v[2 * j] * rstd * gg[2 * j] + bb[2 * j], x1 = v[2 * j + 1] * rstd * gg[2 * j + 1] + bb[2 * j + 1];
            const f32x4 h0 = x0 * (sc[2 * j] + 1.0f) + sh[2 * j], h1 = x1 * (sc[2 * j + 1] + 1.0f) + sh[2 * j + 1];
            u32x4 o; o.x = pk2(h0[0], h0[1]); o.y = pk2(h0[2], h0[3]); o.z = pk2(h1[0], h1[1]); o.w = pk2(h1[2], h1[3]);
            *(u32x4*)(HF + (size_t)row * DM + c) = o;
            v[2 * j] = h0; v[2 * j + 1] = h1;
#pragma unroll
            for (int e = 0; e < 4; ++e) am = fmaxf(am, fmaxf(__builtin_fabsf(h0[e]), __builtin_fabsf(h1[e]))); }
#pragma unroll
        for (int o = 1; o < 64; o <<= 1) am = fmaxf(am, __shfl_xor(am, o));
        const float qs = am > 0.f ? 127.0f / am : 0.f;
#pragma unroll
        for (int j = 0; j < 4; ++j) { const int c = j * 512 + lane * 8; unsigned w0 = 0u, w1 = 0u;
#pragma unroll
            for (int e = 0; e < 4; ++e) { w0 |= ((unsigned)(int)__builtin_rintf(v[2 * j][e] * qs) & 255u) << (8 * e); w1 |= ((unsigned)(int)__builtin_rintf(v[2 * j + 1][e] * qs) & 255u) << (8 * e); }
            *(u32x2*)((unsigned char*)(F.ws + WS_H8) + (size_t)row * DM + c) = (u32x2){w0, w1}; }
        if (lane == 0) ((float*)(F.ws + WS_HQS))[row] = am * (1.0f / 127.0f);
    }
}
namespace peer {
__device__ __forceinline__ unsigned okey(float f) { const unsigned u = __float_as_uint(f); return (u & 0x80000000u) ? ~u : (u | 0x80000000u); }
__device__ __forceinline__ float ikey(unsigned k) { const unsigned u = (k & 0x80000000u) ? (k & 0x7fffffffu) : ~k; return __uint_as_float(u); }
#define CE_DESC(a, b) do { const unsigned _mx = (a) > (b) ? (a) : (b), _mn = (a) > (b) ? (b) : (a); (a) = _mx; (b) = _mn; } while (0)
#define CE_ASC(a, b)  do { const unsigned _mx = (a) > (b) ? (a) : (b), _mn = (a) > (b) ? (b) : (a); (a) = _mn; (b) = _mx; } while (0)
__device__ __forceinline__ void sort16_desc(unsigned (&k)[16]) {
#pragma unroll
    for (int size = 2; size <= 16; size <<= 1)
#pragma unroll
        for (int stride = size >> 1; stride > 0; stride >>= 1)
#pragma unroll
            for (int i = 0; i < 16; ++i) { const int p = i ^ stride; if (p > i) { if ((i & size) == 0) CE_DESC(k[i], k[p]); else CE_ASC(k[i], k[p]); } }
}
__device__ __forceinline__ void merge16_desc(unsigned (&a)[16], const unsigned (&b)[16]) {
#pragma unroll
    for (int i = 0; i < 16; ++i) a[i] = a[i] > b[15 - i] ? a[i] : b[15 - i];
#pragma unroll
    for (int stride = 8; stride > 0; stride >>= 1)
#pragma unroll
        for (int i = 0; i < 16; ++i) { const int p = i ^ stride; if (p > i) CE_DESC(a[i], a[p]); }
}
constexpr int slot_x(int s) { int n = 0; for (int x = 0; x < 16; ++x) for (int y = 0; y < 16; ++y) if ((x + 1) * (y + 1) <= 16) { if (n == s) return x; ++n; } return -1; }
constexpr int slot_y(int s) { int n = 0; for (int x = 0; x < 16; ++x) for (int y = 0; y < 16; ++y) if ((x + 1) * (y + 1) <= 16) { if (n == s) return y; ++n; } return -1; }
template <int S> struct Slot { static constexpr int x = slot_x(S), y = slot_y(S); };
template <int S> __device__ __forceinline__ void cand_one(unsigned (&c)[64], const float (&v0)[16], const float (&v1)[16], const unsigned (&i0)[16], const unsigned (&i1)[16], LAS unsigned short* tbl) {
    if constexpr (Slot<S>::x >= 0) { c[S] = (okey(v0[Slot<S>::x] + v1[Slot<S>::y]) & ~63u) | (unsigned)(63 - S); tbl[S] = (unsigned short)(i0[Slot<S>::x] * 128u + i1[Slot<S>::y]); }
    else c[S] = 0u;
}
template <int... S> __device__ __forceinline__ void cand_all(unsigned (&c)[64], const float (&v0)[16], const float (&v1)[16], const unsigned (&i0)[16], const unsigned (&i1)[16], LAS unsigned short* tbl, std::integer_sequence<int, S...>) {
    (cand_one<S>(c, v0, v1, i0, i1, tbl), ...);
}
#ifndef TOPK_SEC
#define TOPK_SEC -1
#endif
#define TSEC(n) do { if (TOPK_SEC >= 0) { __builtin_amdgcn_sched_barrier(0); const unsigned long long tn_ = __builtin_amdgcn_s_memrealtime(); if (TOPK_SEC == (n) && lane == 0 && acc_w) *acc_w += (unsigned)(tn_ - tsec_); tsec_ = tn_; __builtin_amdgcn_sched_barrier(0); } } while (0)
__device__ __forceinline__ void topk_item(const bf16* QP, const LAS unsigned char* sklds, int* EIDX, float* EG, int tok0, int h, LAS unsigned short* tblw, int lane, volatile LAS unsigned* acc_w = nullptr) {
    unsigned long long tsec_ = TOPK_SEC >= 0 ? __builtin_amdgcn_s_memrealtime() : 0ull;
    const int r32 = lane & 31, hi = lane >> 5;
    const bf16* qrow = QP + (size_t)(tok0 + r32) * DM + h * 256 + hi * 8;
    unsigned L[2][16];
    bf16x8 bqa[2][8];
#pragma unroll
    for (int p = 0; p < 2; ++p)
#pragma unroll
        for (int d0 = 0; d0 < 8; ++d0) bqa[p][d0] = *(const bf16x8*)(qrow + p * 128 + d0 * 16);
#pragma unroll
    for (int p = 0; p < 2; ++p) {
        const LAS unsigned char* skp = sklds + p * 32768 + r32 * 256;
        unsigned g0[16];
#pragma unroll
        for (int i = 0; i < 16; ++i) g0[i] = 0u;
#pragma unroll 1
        for (int kb = 0; kb < 4; ++kb) {
            f32x16 acc = f32x16{};
#pragma unroll
            for (int d0 = 0; d0 < 8; ++d0) { const bf16x8 ak = *(const LAS bf16x8*)(skp + kb * 8192 + (((2 * d0 + hi) ^ (r32 & 7)) << 4)); acc = __builtin_amdgcn_mfma_f32_32x32x16_bf16(ak, bqa[p][d0], acc, 0, 0, 0); }
            unsigned g[16]; const unsigned kbase = (unsigned)(127 - 32 * kb - 4 * hi);
#pragma unroll
            for (int r = 0; r < 16; ++r) g[r] = (okey(acc[r]) & ~127u) | (kbase - (unsigned)((r & 3) + 8 * (r >> 2)));
            sort16_desc(g);
            merge16_desc(g0, g);
        }
        LDS_WAIT(); asm volatile("" ::: "memory"); TSEC(0);
        unsigned (&gA)[16] = g0;
        unsigned o[16];
#pragma unroll
        for (int i = 0; i < 16; ++i) o[i] = (unsigned)__shfl_xor((int)gA[i], 32);
        merge16_desc(gA, o);
#pragma unroll
        for (int i = 0; i < 16; ++i) L[p][i] = gA[i];
        TSEC(1);
    }
    float v0[16], v1[16]; unsigned i0[16], i1[16];
#pragma unroll
    for (int i = 0; i < 16; ++i) { v0[i] = ikey(L[0][i] & ~127u); v1[i] = ikey(L[1][i] & ~127u); i0[i] = 127u - (L[0][i] & 127u); i1[i] = 127u - (L[1][i] & 127u); }
    LAS unsigned short* tbl = tblw + lane * 66;
    unsigned c[64];
    cand_all(c, v0, v1, i0, i1, tbl, std::make_integer_sequence<int, 64>{});
    unsigned c0[16], c1[16], c2[16], c3[16];
#pragma unroll
    for (int i = 0; i < 16; ++i) { c0[i] = c[i]; c1[i] = c[16 + i]; c2[i] = c[32 + i]; c3[i] = c[48 + i]; }
    sort16_desc(c0); sort16_desc(c1); sort16_desc(c2); sort16_desc(c3);
    merge16_desc(c0, c1); merge16_desc(c2, c3); merge16_desc(c0, c2);
    LDS_WAIT(); asm volatile("" ::: "memory"); TSEC(2);
    float best[16]; int eid[16]; float sum = 0.f;
    const float mx = ikey(c0[0] & ~63u);
#pragma unroll
    for (int i = 0; i < 16; ++i) { const unsigned s = 63u - (c0[i] & 63u); eid[i] = (int)tbl[s]; best[i] = __expf(ikey(c0[i] & ~63u) - mx); sum += best[i]; }
    const float inv = 1.0f / sum;
    if (hi == 0) {
        int* ep = EIDX + (size_t)(tok0 + r32) * 128 + h * 16; float* gp = EG + (size_t)(tok0 + r32) * 128 + h * 16;
#pragma unroll
        for (int i = 0; i < 4; ++i) { *(pg8::v4i_t*)(ep + 4 * i) = (pg8::v4i_t){eid[4 * i], eid[4 * i + 1], eid[4 * i + 2], eid[4 * i + 3]}; *(f32x4*)(gp + 4 * i) = (f32x4){best[4 * i] * inv, best[4 * i + 1] * inv, best[4 * i + 2] * inv, best[4 * i + 3] * inv}; }
    }
    LDS_WAIT(); asm volatile("" ::: "memory"); TSEC(3);
}
}
namespace p4 {
constexpr int L_SE = 0, L_SG = 4 * 128 * 2, L_WAVE = L_SG + 4 * 128 * 4;
constexpr int L_PAR = 8 * L_WAVE;
__device__ __forceinline__ float rowsum16(float d) {
    d += __int_as_float(__builtin_amdgcn_update_dpp(__float_as_int(d), __float_as_int(d), 0x128, 0xF, 0xF, false));
    d += __int_as_float(__builtin_amdgcn_update_dpp(__float_as_int(d), __float_as_int(d), 0x124, 0xF, 0xF, false));
    d += __int_as_float(__builtin_amdgcn_update_dpp(__float_as_int(d), __float_as_int(d), 0x122, 0xF, 0xF, false));
    d += __int_as_float(__builtin_amdgcn_update_dpp(__float_as_int(d), __float_as_int(d), 0x121, 0xF, 0xF, false));
    return d;
}
__device__ __forceinline__ f32x2 cvt4(unsigned w, int t) {
    return t == 0 ? __builtin_amdgcn_cvt_scalef32_pk_f32_fp4(w, 1.0f, 0) : (t == 1 ? __builtin_amdgcn_cvt_scalef32_pk_f32_fp4(w, 1.0f, 1) : (t == 2 ? __builtin_amdgcn_cvt_scalef32_pk_f32_fp4(w, 1.0f, 2) : __builtin_amdgcn_cvt_scalef32_pk_f32_fp4(w, 1.0f, 3)));
}
struct Row { u32x4 p[4]; float sc, sc2; };
template <bool TWO> __device__ __forceinline__ void load_row(Row& r, const unsigned char* tab_l, const float* sct, const float* sct2, int e) {
    __builtin_amdgcn_sched_barrier(0);
    const unsigned char* g = tab_l + (size_t)(unsigned)e * 1024;
#pragma unroll
    for (int j = 0; j < 4; ++j) r.p[j] = *(const u32x4*)(g + j * 256);
    if constexpr (TWO) { r.sc = sct[e]; r.sc2 = sct2[e]; }
    __builtin_amdgcn_sched_barrier(0);
}
__device__ __forceinline__ float dot128(const f32x2 (&h)[64], const Row& r) {
    f32x2 a = {0.f, 0.f}, b = {0.f, 0.f};
#pragma unroll
    for (int j = 0; j < 4; ++j)
#pragma unroll
        for (int q = 0; q < 4; ++q) { const unsigned w = r.p[j][q];
            a = __builtin_elementwise_fma(h[(j * 4 + q) * 4 + 0], cvt4(w, 0), a); b = __builtin_elementwise_fma(h[(j * 4 + q) * 4 + 1], cvt4(w, 1), b);
            a = __builtin_elementwise_fma(h[(j * 4 + q) * 4 + 2], cvt4(w, 2), a); b = __builtin_elementwise_fma(h[(j * 4 + q) * 4 + 3], cvt4(w, 3), b); }
    return (a.x + a.y) + (b.x + b.y);
}
__device__ __forceinline__ void axpy128(f32x2 (&acc)[64], const float w, const Row& r) {
    const f32x2 ww = {w, w};
#pragma unroll
    for (int j = 0; j < 4; ++j)
#pragma unroll
        for (int q = 0; q < 4; ++q) { const unsigned x = r.p[j][q];
#pragma unroll
            for (int t = 0; t < 4; ++t) acc[(j * 4 + q) * 4 + t] = __builtin_elementwise_fma(ww, cvt4(x, t), acc[(j * 4 + q) * 4 + t]); }
}
__device__ __forceinline__ float gelu_as(float v) {
    const float av = __builtin_fabsf(v), t = __builtin_amdgcn_rcpf(av * 0.2316418882f + 1.0f);
    float q = t * 0.5307027145f + (-0.7265760135f); q = q * t + 0.7107068705f; q = q * t + (-0.142248368f); q = q * t + 0.127414796f; q = q * t;
    const float e = __builtin_amdgcn_exp2f((v * v) * (-0.72134752044f)); const float m = v * (q * e); return v < 0.f ? m : v - m;
}
}

__device__ __forceinline__ void pexp4_phase(const Frame& F, KA A, int l, int ntok, const bf16* HF, float* outp, bf16* Hnext) {
    using namespace p4;
    const unsigned char* PU8 = (const unsigned char*)(F.ws + WS_PU) + (size_t)l * 16384 * 1024; const unsigned char* PV8 = (const unsigned char*)(F.ws + WS_PV) + (size_t)l * 16384 * 1024;
    const float* SCU = (const float*)(F.ws + WS_SCU) + l * 16384; const float* SCV = (const float*)(F.ws + WS_SCV) + l * 16384;
    const int* EIDX = (const int*)(F.ws + WS_EIDX); const float* EG = (const float*)(F.ws + WS_EG);
    float* X1 = (float*)(F.ws + WS_UREG); const float* mod = (const float*)(F.ws + WS_MOD);
    const float* g2 = G(A.in.ln2_g) + l * DM; const float* b2 = G(A.in.ln2_b) + l * DM;
    LAS unsigned char* wl = F.lds + RING_OFF + F.wave * L_WAVE;
    LAS unsigned short* se = (LAS unsigned short*)(wl + L_SE); LAS float* sg = (LAS float*)(wl + L_SG);
    const int gw = F.vcu * NWAVES + F.wave, NW = F.G * NWAVES;
    const int nfull = ntok / (NW * 4), nrem = ntok - nfull * NW * 4, nsplit = (nrem + NW - 1) / NW;
#ifndef PEXP_SEC
#define PEXP_SEC -1
#endif
#define PSEC(n) do { if (PEXP_SEC >= 0) { const unsigned long long tn_ = __builtin_amdgcn_s_memrealtime(); if (PEXP_SEC == (n) && F.wave == 0 && F.lane == 0) *(volatile LAS unsigned*)(F.lds + MISC_OFF + 256) += (unsigned)(tn_ - tsec_); tsec_ = tn_; } } while (0)
    for (int pass = 0; pass < nfull + nsplit; ++pass) {
        unsigned long long tsec_ = PEXP_SEC >= 0 ? __builtin_amdgcn_s_memrealtime() : 0ull;
        {
            __syncthreads();
            int t0 = pass < nfull ? pass * NW * 4 + F.vcu * 32 : nfull * NW * 4 + (pass - nfull) * NW + F.vcu * NWAVES; t0 = t0 < ntok ? t0 : ntok - 1;
            const int bi = t0 < ML ? (t0 >> 12) : 4;
            const float* mrb = mod + ((size_t)l * 5 + bi) * MODW; const float* mnb = mod + ((size_t)(l + 1 < DEPTH ? l + 1 : l) * 5 + bi) * MODW;
            const int c4 = F.tid, slot = ((c4 >> 7) * 8 + (c4 & 7)) * 16 + ((c4 >> 3) & 15);
            const f32x4 a0 = *(const f32x4*)(g2 + 4 * c4), a1 = *(const f32x4*)(b2 + 4 * c4), a2 = *(const f32x4*)(mrb + 5 * DM + 4 * c4), a3 = *(const f32x4*)(mnb + 4 * c4), a4 = *(const f32x4*)(mnb + DM + 4 * c4);
            const f32x4 a5 = *(const f32x4*)(G(A.in.ln1_g) + l * DM + 4 * c4), a6 = *(const f32x4*)(G(A.in.ln1_b) + l * DM + 4 * c4);
            LAS f32x4* P = (LAS f32x4*)(F.lds + RING_OFF + L_PAR);
            P[slot] = a0; P[512 + slot] = a1; P[1024 + slot] = a2; P[1536 + slot] = a3; P[2048 + slot] = a4; P[2560 + slot] = a5; P[3072 + slot] = a6;
        }
        int lane = F.lane; asm volatile("" : "+v"(lane));
        const int qd = lane >> 4, l16 = lane & 15;
        const bool split = pass >= nfull;
        int tokw[4];
#pragma unroll
        for (int k = 0; k < 4; ++k) tokw[k] = split ? ((k == 0 && (pass - nfull) * NW + gw < nrem) ? nfull * NW * 4 + (pass - nfull) * NW + gw : -1) : pass * NW * 4 + gw * 4 + k;
        const bool idle = split && tokw[0] < 0;
        if (idle) tokw[0] = 0;
        unsigned k0[4], k1[4];
#pragma unroll
        for (int k = 0; k < 4; ++k) { const int tk = tokw[k] >= 0 ? tokw[k] : tokw[0];
            k0[k] = ((unsigned)EIDX[(size_t)tk * 128 + lane] << 7) | (unsigned)lane; k1[k] = ((unsigned)EIDX[(size_t)tk * 128 + 64 + lane] << 7) | (unsigned)(64 + lane); }
#pragma unroll
        for (int k = 0; k < 4; ++k) {
#pragma unroll
            for (int size = 2; size <= 128; size <<= 1)
#pragma unroll
                for (int stride = size >> 1; stride > 0; stride >>= 1) {
                    if (stride == 64) { const unsigned lo = k0[k] < k1[k] ? k0[k] : k1[k], hi = k0[k] < k1[k] ? k1[k] : k0[k]; k0[k] = lo; k1[k] = hi; }
                    else {
                        const unsigned p0 = (unsigned)__shfl_xor((int)k0[k], stride), p1 = (unsigned)__shfl_xor((int)k1[k], stride);
                        const bool lower = (lane & stride) == 0;
                        const bool up0 = (lane & size) == 0 || size == 128 || size == 64;
                        const bool up1 = size == 128 ? true : (size == 64 ? false : (lane & size) == 0);
                        k0[k] = (lower == up0) ? (k0[k] < p0 ? k0[k] : p0) : (k0[k] < p0 ? p0 : k0[k]);
                        k1[k] = (lower == up1) ? (k1[k] < p1 ? k1[k] : p1) : (k1[k] < p1 ? p1 : k1[k]);
                    }
                }
        }
#pragma unroll
        for (int k = 0; k < 4; ++k) { const int tk = tokw[k] >= 0 ? tokw[k] : tokw[0];
            se[k * 128 + lane] = (unsigned short)(k0[k] >> 7); se[k * 128 + 64 + lane] = (unsigned short)(k1[k] >> 7);
            sg[k * 128 + lane] = EG[(size_t)tk * 128 + (k0[k] & 127u)]; sg[k * 128 + 64 + lane] = EG[(size_t)tk * 128 + (k1[k] & 127u)]; }
        LDS_WAIT(); asm volatile("s_waitcnt vmcnt(0)" ::: "memory");
        __syncthreads();
        if (idle) continue;
        PSEC(0);
        const int tok = split ? tokw[0] : (qd == 0 ? tokw[0] : (qd == 1 ? tokw[1] : (qd == 2 ? tokw[2] : tokw[3])));
        const int lbase = split ? 32 * qd : 128 * qd;
        const int nsteps = split ? 32 : 128;
        LAS const unsigned short* seq = se + lbase; LAS float* sgq = sg + lbase;
#ifndef P4_NO_U
        {
            int hq[32]; int slo = 0;
            { const unsigned char* hp = (const unsigned char*)(F.ws + WS_H8) + (size_t)tok * DM + l16 * 32;
#pragma unroll
              for (int k = 0; k < 8; ++k) { const u32x4 t_ = *(const u32x4*)(hp + (k >> 1) * 512 + (k & 1) * 16); hq[4 * k] = (int)t_.x; hq[4 * k + 1] = (int)t_.y; hq[4 * k + 2] = (int)t_.z; hq[4 * k + 3] = (int)t_.w; } }
            const float ts = ((const float*)(F.ws + WS_HQS))[tok];
#pragma unroll
            for (int k = 0; k < 16; ++k) slo = __builtin_amdgcn_sdot4(0x01010101, hq[2 * k], slo, false);
            const float slo8 = (float)(8 * slo);
            const unsigned char* tab_l = PU8 + l16 * 16;
            p4::Row r0, r1, r2, r3;
            p4::load_row<true>(r0, tab_l, SCU, SCV, seq[0]); p4::load_row<true>(r1, tab_l, SCU, SCV, seq[1]); p4::load_row<true>(r2, tab_l, SCU, SCV, seq[2]);
            int en = seq[3];
#define USTEP(R, I) do { int a_ = 0, b_ = 0; _Pragma("unroll") for (int j_ = 0; j_ < 4; ++j_) _Pragma("unroll") for (int q_ = 0; q_ < 4; ++q_) { const unsigned w_ = R.p[j_][q_]; \
                a_ = __builtin_amdgcn_sdot4((int)(w_ & 0x0f0f0f0fu), hq[(j_ * 4 + q_) * 2], a_, false); b_ = __builtin_amdgcn_sdot4((int)(w_ & 0xf0f0f0f0u), hq[(j_ * 4 + q_) * 2 + 1], b_, false); } \
                const float gate = sgq[I]; const float d = p4::rowsum16(((float)a_ - slo8) + (float)b_ * 0.0625f) * (R.sc * ts); sgq[I] = p4::gelu_as(d) * gate * R.sc2; } while (0)
#define NXT(K) seq[i + (K) < nsteps ? i + (K) : nsteps - 1]
            for (int i = 0; i < nsteps; i += 4) {
                p4::load_row<true>(r3, tab_l, SCU, SCV, en); en = NXT(4); USTEP(r0, i);
                p4::load_row<true>(r0, tab_l, SCU, SCV, en); en = NXT(5); USTEP(r1, i + 1);
                p4::load_row<true>(r1, tab_l, SCU, SCV, en); en = NXT(6); USTEP(r2, i + 2);
                p4::load_row<true>(r2, tab_l, SCU, SCV, en); en = NXT(7); USTEP(r3, i + 3);
            }
#undef USTEP
        }
#endif
        LDS_WAIT(); asm volatile("s_waitcnt vmcnt(0)" ::: "memory"); PSEC(1);
#ifndef P4_NO_V
        {
            f32x2 acc[64];
#pragma unroll
            for (int k = 0; k < 64; ++k) acc[k] = (f32x2){0.f, 0.f};
            const unsigned char* tab_l = PV8 + l16 * 16;
            p4::Row r0, r1, r2, r3;
            p4::load_row<false>(r0, tab_l, nullptr, nullptr, seq[0]); p4::load_row<false>(r1, tab_l, nullptr, nullptr, seq[1]); p4::load_row<false>(r2, tab_l, nullptr, nullptr, seq[2]);
            int en = seq[3];
            for (int i = 0; i < nsteps; i += 4) {
                p4::load_row<false>(r3, tab_l, nullptr, nullptr, en); en = NXT(4); p4::axpy128(acc, sgq[i], r0);
                p4::load_row<false>(r0, tab_l, nullptr, nullptr, en); en = NXT(5); p4::axpy128(acc, sgq[i + 1], r1);
                p4::load_row<false>(r1, tab_l, nullptr, nullptr, en); en = NXT(6); p4::axpy128(acc, sgq[i + 2], r2);
                p4::load_row<false>(r2, tab_l, nullptr, nullptr, en); en = NXT(7); p4::axpy128(acc, sgq[i + 3], r3);
            }
#undef NXT
            asm volatile("s_waitcnt vmcnt(0)" ::: "memory"); PSEC(2);
#ifndef P4_NO_SPLITC
            if (split) {
#pragma unroll
                for (int k = 0; k < 64; ++k) {
                    { auto r0 = __builtin_amdgcn_permlane16_swap(__float_as_uint(acc[k].x), __float_as_uint(acc[k].x), false, false); acc[k].x = __uint_as_float(r0[0]) + __uint_as_float(r0[1]);
                      auto r1 = __builtin_amdgcn_permlane16_swap(__float_as_uint(acc[k].y), __float_as_uint(acc[k].y), false, false); acc[k].y = __uint_as_float(r1[0]) + __uint_as_float(r1[1]); }
                    { auto r0 = __builtin_amdgcn_permlane32_swap(__float_as_uint(acc[k].x), __float_as_uint(acc[k].x), false, false); acc[k].x = __uint_as_float(r0[0]) + __uint_as_float(r0[1]);
                      auto r1 = __builtin_amdgcn_permlane32_swap(__float_as_uint(acc[k].y), __float_as_uint(acc[k].y), false, false); acc[k].y = __uint_as_float(r1[0]) + __uint_as_float(r1[1]); }
                }
            }
#endif
#ifdef P4_NO_LN2
            for (int k = 0; k < 64; ++k) *(f32x2*)(outp + (size_t)tok * DM + k * 32 + l16 * 2) = acc[k];
#else
            const bf16* y1 = (const bf16*)(F.ws + WS_UREG) + (size_t)tok * DM;
            if (!split || qd == 0) {
                float s1 = 0.f, s2 = 0.f; int lq = l16; asm volatile("" : "+v"(lq));
                LAS const f32x4* P = (LAS const f32x4*)(F.lds + RING_OFF + L_PAR) + lq;
                const f32x2 st1 = *(const f32x2*)((const float*)(F.ws + WS_LNS) + 2 * (size_t)tok);
                { const GAS bf16* py = (const GAS bf16*)y1 + lq * 32;
#pragma unroll
                  for (int j = 0; j < 4; ++j) {
                    u32x4 yw[4];
#pragma unroll
                    for (int k = 0; k < 4; ++k) yw[k] = *(const GAS u32x4*)(py + k * 8);
#pragma unroll
                    for (int k = 0; k < 8; ++k) { const int slot = (j * 8 + k) * 16; const f32x4 ga = P[1024 + slot], g1 = P[2560 + slot], b1 = P[3072 + slot]; const int idx = (j * 4 + (k >> 1)) * 4 + (k & 1) * 2;
                        const unsigned wa = (k & 1) ? yw[k >> 1].z : yw[k >> 1].x, wb = (k & 1) ? yw[k >> 1].w : yw[k >> 1].y;
                        const f32x4 xa = ((f32x4){bflo(wa), bfhi(wa), bflo(wb), bfhi(wb)} - st1.x) * st1.y * g1 + b1;
                        const f32x2 a0 = acc[idx], a1 = acc[idx + 1];
                        const f32x4 v = (f32x4){ALPHA * xa[0] + ga[0] * a0.x, ALPHA * xa[1] + ga[1] * a0.y, ALPHA * xa[2] + ga[2] * a1.x, ALPHA * xa[3] + ga[3] * a1.y};
                        s1 += (v[0] + v[1]) + (v[2] + v[3]); s2 += (v[0] * v[0] + v[1] * v[1]) + (v[2] * v[2] + v[3] * v[3]);
                        acc[idx] = (f32x2){v[0], v[1]}; acc[idx + 1] = (f32x2){v[2], v[3]}; }
                    py += 512; asm volatile("" : "+v"(py)); if (j & 1) asm volatile("" : "+v"(s1), "+v"(s2) :: "memory"); }
                }
                const float mean = p4::rowsum16(s1) * (1.0f / DM); const float var = p4::rowsum16(s2) * (1.0f / DM) - mean * mean;
                const float rstd = rsqrtf((var > 0.f ? var : 0.f) + LN_EPS);
                GAS float* po = Hnext ? (GAS float*)((GAS bf16*)outp + (size_t)tok * DM + lq * 32) : (GAS float*)outp + (size_t)tok * DM + lq * 32; GAS bf16* ph = (GAS bf16*)Hnext + (size_t)tok * DM + lq * 32; GAS unsigned char* p8 = (GAS unsigned char*)(F.ws + WS_H8) + (size_t)tok * DM + lq * 32;
#pragma unroll
                for (int j = 0; j < 4; ++j) {
#pragma unroll
                    for (int hf = 0; hf < 2; ++hf) { u32x4 o0, o1;
#pragma unroll
                        for (int q = 0; q < 4; ++q) { const int k = 4 * hf + q, idx = (j * 4 + (k >> 1)) * 4 + (k & 1) * 2, slot = (j * 8 + k) * 16;
                            const f32x4 v = (f32x4){acc[idx].x, acc[idx].y, acc[idx + 1].x, acc[idx + 1].y}; const f32x4 ga = P[slot], ba = P[512 + slot];
                            const f32x4 y = (v - mean) * rstd * ga + ba;
                            if (Hnext) *(GAS u32x2*)((GAS bf16*)po + k * 4) = (u32x2){pk2(y[0], y[1]), pk2(y[2], y[3])};
                            else *(GAS f32x4*)(po + k * 4) = y;
                            if (Hnext) { const f32x4 z = y * (P[2048 + slot] + 1.0f) + P[1536 + slot]; const unsigned w0 = pk2(z[0], z[1]), w1 = pk2(z[2], z[3]);
                                if (q == 0) { o0.x = w0; o0.y = w1; } else if (q == 1) { o0.z = w0; o0.w = w1; } else if (q == 2) { o1.x = w0; o1.y = w1; } else { o1.z = w0; o1.w = w1; } } }
                        if (Hnext) { if (!(F8_IN && F8_MERGE)) { *(GAS u32x4*)(ph + hf * 16) = o0; *(GAS u32x4*)(ph + hf * 16 + 8) = o1; }
                            if (F8_MERGE) { u32x4 q8;
#pragma unroll
                                for (int q = 0; q < 4; ++q) { const unsigned wa = q < 2 ? (q == 0 ? o0.x : o0.z) : (q == 2 ? o1.x : o1.z), wb = q < 2 ? (q == 0 ? o0.y : o0.w) : (q == 2 ? o1.y : o1.w);
                                    int w = __builtin_amdgcn_cvt_pk_fp8_f32(bflo(wa), bfhi(wa), 0, false); w = __builtin_amdgcn_cvt_pk_fp8_f32(bflo(wb), bfhi(wb), w, true); q8[q] = (unsigned)w; }
                                *(GAS u32x4*)(p8 + hf * 16) = q8; } }
                        asm volatile("" ::: "memory"); }
                    po += Hnext ? 256 : 512; ph += 512; p8 += 512; asm volatile("" : "+v"(po), "+v"(ph), "+v"(p8)); }
            }
#endif
        }
#endif
        LDS_WAIT(); asm volatile("s_waitcnt vmcnt(0)" ::: "memory"); PSEC(3);
    }
}
__device__ __forceinline__ float gelu_exact(float v) { return 0.5f * v * (1.0f + erff(v * 0.70710678118654752f)); }
__device__ __forceinline__ float reduce16(float (&p)[16], int lane) {
    float q[8], r[4], s[2];
    { const bool up = lane & 1;
#pragma unroll
      for (int k = 0; k < 8; ++k) { const float send = up ? p[2 * k] : p[2 * k + 1], keep = up ? p[2 * k + 1] : p[2 * k]; q[k] = keep + __shfl_xor(send, 1); } }
    { const bool up = lane & 2;
#pragma unroll
      for (int k = 0; k < 4; ++k) { const float send = up ? q[2 * k] : q[2 * k + 1], keep = up ? q[2 * k + 1] : q[2 * k]; r[k] = keep + __shfl_xor(send, 2); } }
    { const bool up = lane & 4;
#pragma unroll
      for (int k = 0; k < 2; ++k) { const float send = up ? r[2 * k] : r[2 * k + 1], keep = up ? r[2 * k + 1] : r[2 * k]; s[k] = keep + __shfl_xor(send, 4); } }
    float t;
    { const bool up = lane & 8; const float send = up ? s[0] : s[1], keep = up ? s[1] : s[0]; t = keep + __shfl_xor(send, 8); }
    t += __shfl_xor(t, 16); t += __shfl_xor(t, 32);
    return t;
}
__device__ __forceinline__ void pexp_phase(const Frame& F, KA A, int l, int ntok, const bf16* HF, float* outp, bf16* Hnext) {
    const int gw = F.vcu * NWAVES + F.wave, NGW = F.G * NWAVES, lane = F.lane;
    const bf16* PU = (const bf16*)(F.ws + WS_PU) + (size_t)l * 16384 * DM; const bf16* PV = (const bf16*)(F.ws + WS_PV) + (size_t)l * 16384 * DM;
    const int* EIDX = (const int*)(F.ws + WS_EIDX); const float* EG = (const float*)(F.ws + WS_EG);
    const float* X1 = (const float*)(F.ws + WS_UREG); const float* mod = (const float*)(F.ws + WS_MOD);
    const float* g2 = G(A.in.ln2_g) + l * DM; const float* b2 = G(A.in.ln2_b) + l * DM;
    for (int tok = gw; tok < ntok; tok += NGW) {
        float h[32], acc[32];
#pragma unroll
        for (int j = 0; j < 4; ++j) { const bf16x8 v = *(const bf16x8*)(HF + (size_t)tok * DM + j * 512 + lane * 8);
#pragma unroll
            for (int e = 0; e < 8; ++e) { h[j * 8 + e] = bf2f((unsigned short)v[e]); acc[j * 8 + e] = 0.f; } }
#pragma unroll 1
        for (int sb = 0; sb < 32; ++sb) {
            const int my_e = EIDX[(size_t)tok * 128 + sb * 4 + (lane & 3)]; const float my_g = EG[(size_t)tok * 128 + sb * 4 + (lane & 3)];
            const int e0 = __builtin_amdgcn_readlane(my_e, 0), e1 = __builtin_amdgcn_readlane(my_e, 1), e2 = __builtin_amdgcn_readlane(my_e, 2), e3 = __builtin_amdgcn_readlane(my_e, 3);
            float part[4];
#pragma unroll
            for (int i = 0; i < 4; ++i) {
                const int e = i == 0 ? e0 : (i == 1 ? e1 : (i == 2 ? e2 : e3)); const bf16* ur = PU + (size_t)e * DM + lane * 8; float d = 0.f;
#pragma unroll
                for (int j = 0; j < 4; ++j) { const u32x4 w = *(const u32x4*)(ur + j * 512);
                    d += h[j * 8 + 0] * bflo(w.x) + h[j * 8 + 1] * bfhi(w.x) + h[j * 8 + 2] * bflo(w.y) + h[j * 8 + 3] * bfhi(w.y)
                       + h[j * 8 + 4] * bflo(w.z) + h[j * 8 + 5] * bfhi(w.z) + h[j * 8 + 6] * bflo(w.w) + h[j * 8 + 7] * bfhi(w.w); }
                part[i] = d;
            }
            float dot;
            { const bool u1 = lane & 1, u2 = lane & 2;
              const float q0 = (u1 ? part[1] : part[0]) + __shfl_xor(u1 ? part[0] : part[1], 1);
              const float q1 = (u1 ? part[3] : part[2]) + __shfl_xor(u1 ? part[2] : part[3], 1);
              dot = (u2 ? q1 : q0) + __shfl_xor(u2 ? q0 : q1, 2);
              dot += __shfl_xor(dot, 4); dot += __shfl_xor(dot, 8); dot += __shfl_xor(dot, 16); dot += __shfl_xor(dot, 32); }
            const float act = gelu_exact(dot) * my_g;
#pragma unroll
            for (int i = 0; i < 4; ++i) {
                const int e = i == 0 ? e0 : (i == 1 ? e1 : (i == 2 ? e2 : e3)); const float w = __uint_as_float(__builtin_amdgcn_readlane(__float_as_uint(act), i));
                const bf16* vr = PV + (size_t)e * DM + lane * 8;
#pragma unroll
                for (int j = 0; j < 4; ++j) { const u32x4 x = *(const u32x4*)(vr + j * 512);
                    acc[j * 8 + 0] += w * bflo(x.x); acc[j * 8 + 1] += w * bfhi(x.x); acc[j * 8 + 2] += w * bflo(x.y); acc[j * 8 + 3] += w * bfhi(x.y);
                    acc[j * 8 + 4] += w * bflo(x.z); acc[j * 8 + 5] += w * bfhi(x.z); acc[j * 8 + 6] += w * bflo(x.w); acc[j * 8 + 7] += w * bfhi(x.w); }
            }
        }
        const int bidx = tok < ML ? (tok >> 12) : 4;
        const float* mr = mod + ((size_t)l * 5 + bidx) * MODW; const float* x1 = X1 + (size_t)tok * DM;
        float s = 0.f;
#pragma unroll
        for (int j = 0; j < 4; ++j) { const int c = j * 512 + lane * 8;
            const f32x4 xa = *(const f32x4*)(x1 + c), xb = *(const f32x4*)(x1 + c + 4), ga = *(const f32x4*)(mr + 5 * DM + c), gb = *(const f32x4*)(mr + 5 * DM + c + 4);
#pragma unroll
            for (int e = 0; e < 4; ++e) { acc[j * 8 + e] = ALPHA * xa[e] + ga[e] * acc[j * 8 + e]; acc[j * 8 + 4 + e] = ALPHA * xb[e] + gb[e] * acc[j * 8 + 4 + e]; s += acc[j * 8 + e] + acc[j * 8 + 4 + e]; } }
        const float mean = wave_sum(s) * (1.0f / DM); float q = 0.f;
#pragma unroll
        for (int k = 0; k < 32; ++k) { acc[k] -= mean; q += acc[k] * acc[k]; }
        const float rstd = rsqrtf(wave_sum(q) * (1.0f / DM) + LN_EPS);
        const float* mn = mod + ((size_t)(l + 1 < DEPTH ? l + 1 : l) * 5 + bidx) * MODW;
#pragma unroll
        for (int j = 0; j < 4; ++j) { const int c = j * 512 + lane * 8;
            const f32x4 ga = *(const f32x4*)(g2 + c), gb = *(const f32x4*)(g2 + c + 4), ba = *(const f32x4*)(b2 + c), bb = *(const f32x4*)(b2 + c + 4);
            f32x4 ya, yb;
#pragma unroll
            for (int e = 0; e < 4; ++e) { ya[e] = acc[j * 8 + e] * rstd * ga[e] + ba[e]; yb[e] = acc[j * 8 + 4 + e] * rstd * gb[e] + bb[e]; }
            *(f32x4*)(outp + (size_t)tok * DM + c) = ya; *(f32x4*)(outp + (size_t)tok * DM + c + 4) = yb;
            if (Hnext) { const f32x4 sa = *(const f32x4*)(mn + DM + c), sb = *(const f32x4*)(mn + DM + c + 4), ha = *(const f32x4*)(mn + c), hb = *(const f32x4*)(mn + c + 4);
                const f32x4 za = ya * (sa + 1.0f) + ha, zb = yb * (sb + 1.0f) + hb;
                u32x4 o; o.x = pk2(za[0], za[1]); o.y = pk2(za[2], za[3]); o.z = pk2(zb[0], zb[1]); o.w = pk2(zb[2], zb[3]);
                *(u32x4*)(Hnext + (size_t)tok * DM + c) = o; }
        }
    }
}

#ifndef PROBE_ATT
#define PROBE_ATT 15
#endif
#ifndef SD_A
#define SD_A 1
#endif
#ifndef SD_D
#define SD_D 2
#endif
#ifndef SD_B
#define SD_B 2
#endif
#ifndef SD_C
#define SD_C 1
#endif
#ifndef ATT_MASK
#define ATT_MASK 15
#endif
template <int TYPE> __device__ __forceinline__ att::Args make_att_args(const Frame& F, KA A, int l, int idx, bool ctxq) {
    const bf16* U = (const bf16*)(F.ws + WS_UREG); const bf16* QK = (const bf16*)(F.ws + WS_QKVA); bf16* O = (bf16*)(F.ws + WS_OQP);
    constexpr int NH = (TYPE == 2) ? 8 : 4;
    int b, h, qb;
    if (ctxq) { b = idx / NH; h = idx % NH; qb = 0; } else { b = idx / (NH * 16); h = (idx >> 4) % NH; qb = idx & 15; }
    const int row = ctxq ? ML + b * NCTX : b * SEQ + qb * 256;
    att::Args a{};
    a.ldo = DM; a.qpos0 = qb * 256; a.o8 = F8_MERGE;
    if (ctxq) { a.n0 = 4; a.row0 = ML + b * NCTX; a.n1 = 0; a.row1 = 0; }
    if constexpr (TYPE == 0) {
        a.Q = QK + (size_t)row * QW + QA_Q + h * 192; a.ldq = QW; a.KV = QK; a.ld = QW; a.kc0 = QA_KV + h * 256; a.kc1 = QA_KR; a.vc = QA_KV + h * 256 + 128;
        a.O = F8_MERGE ? (bf16*)((unsigned char*)O + (size_t)row * DM + h * 128) : O + (size_t)row * DM + h * 128; a.C = A_SCALE * LOG2E; a.thr = 8.0f / A_SCALE; a.qrope = ctxq ? 0 : 1;
        if (!ctxq) { a.n0 = 64; a.row0 = b * SEQ; a.n1 = 4; a.row1 = ML + b * NCTX; }
    } else if constexpr (TYPE == 1) {
        const int kvh = h >> 1;
        a.Q = U + (size_t)row * UW + U_DQ + h * 128; a.ldq = UW; a.KV = U; a.ld = UW; a.kc0 = U_DK + kvh * 128; a.kc1 = 0; a.vc = U_DV + kvh * 128;
        a.O = F8_MERGE ? (bf16*)((unsigned char*)O + (size_t)row * DM + 1536 + h * 128) : O + (size_t)row * DM + 1536 + h * 128; a.C = D_SCALE * LOG2E; a.thr = 8.0f / D_SCALE;
        if (!ctxq) { a.n0 = 64; a.row0 = b * SEQ; a.n1 = 4; a.row1 = ML + b * NCTX; }
    } else if constexpr (TYPE == 2) {
        const int kvh = h >> 2;
        a.Q = U + (size_t)row * UW + U_BQ + h * 64; a.ldq = UW; a.KV = U; a.ld = UW; a.kc0 = U_BK + kvh * 64; a.kc1 = 0; a.vc = U_BV + kvh * 64;
        a.O = F8_MERGE ? (bf16*)((unsigned char*)O + (size_t)row * DM + 512 + h * 64) : O + (size_t)row * DM + 512 + h * 64; a.C = B_SCALE * LOG2E; a.thr = 8.0f / B_SCALE; a.has_sink = 1; a.sinkl2 = G(A.in.b_sink)[l * 8 + h] * LOG2E;
        if (!ctxq) { int ws = qb * 256 - 128; ws = ws < 0 ? 0 : ws; int we = qb * 256 + 384; we = we > SEQ ? SEQ : we;
            a.n0 = 4; a.row0 = ML + b * NCTX; a.n1 = (we - ws) / 64; a.row1 = b * SEQ + ws; a.wpos0 = ws; }
    } else {
        a.Q = U + (size_t)row * UW + U_CQQ + h * 128; a.ldq = UW; a.KV = U; a.ld = UW; a.kc0 = U_CK + h * 128; a.kc1 = 0; a.vc = U_CV + h * 128;
        a.O = F8_MERGE ? (bf16*)((unsigned char*)O + (size_t)row * DM + 1024 + h * 128) : O + (size_t)row * DM + 1024 + h * 128; a.C = C_SCALE * LOG2E; a.thr = 8.0f / C_SCALE;
        a.T = (const float*)(F.ws + WS_CTAB) + (size_t)((l * 4 + h) * 15) * 4096;
        if (!ctxq) { const int r0 = qb * 4; int kr0 = r0 - 4; kr0 = kr0 < 0 ? 0 : (kr0 > 56 ? 56 : kr0); int ke = r0 + 3 - 4; ke = ke < 0 ? 0 : (ke > 56 ? 56 : ke); ke += 7; const int nr = ke - kr0 + 1;
            a.n0 = 4; a.row0 = ML + b * NCTX; a.n1 = nr + (nr & 1); a.row1 = b * SEQ + kr0 * 64; a.r0 = r0; a.kr0 = kr0; }
    }
    return a;
}
#define AF() Frame F = F0; asm volatile("" : "+v"(F.tid), "+v"(F.lane), "+s"(F.wave), "+s"(F.vcu), "+s"(F.G), "+s"(F.ws), "+s"(F.lds)); LAS char* lds = (LAS char*)(F.lds + RING_OFF); const int v = F.vcu
__device__ __forceinline__ void att_phase(const Frame& F0, int l, int am = 15) {
    if (F0.vcu >= 256) return;
    const bool cx = (l + 1 < DEPTH);
    if ((ATT_MASK & 1) && (am & 1)) { AF(); KA A = *kargs(); const int n = 1 + ((cx && v < 16) ? 1 : 0);
        for (int k = 0; k < n; ++k) { const att::Args a = make_att_args<0>(F, A, l, k ? v : v, k != 0); att::attn_unit<192, 128, 0, SD_A>(a, lds, F.tid); } }
    if ((ATT_MASK & 2) && (am & 2)) { AF(); KA A = *kargs(); const int n = 1 + ((cx && v >= 16 && v < 32) ? 1 : 0);
        for (int k = 0; k < n; ++k) { const att::Args a = make_att_args<1>(F, A, l, k ? v - 16 : v, k != 0); att::attn_unit<128, 128, 0, SD_D>(a, lds, F.tid); } }
    if ((ATT_MASK & 4) && (am & 4)) { AF(); KA A = *kargs(); const int n = 2 + ((cx && v >= 48 && v < 80) ? 1 : 0);
        for (int k = 0; k < n; ++k) { const att::Args a = make_att_args<2>(F, A, l, k == 2 ? v - 48 : 2 * v + k, k == 2); att::attn_unit<64, 64, 1, SD_B>(a, lds, F.tid); } }
    if ((ATT_MASK & 8) && (am & 8)) { AF(); KA A = *kargs(); const int n = 1 + ((cx && v >= 32 && v < 48) ? 1 : 0);
        for (int k = 0; k < n; ++k) { const att::Args a = make_att_args<3>(F, A, l, k ? v - 32 : v, k != 0); att::attn_unit<128, 128, 2, SD_C>(a, lds, F.tid); } }
}

__device__ __forceinline__ void merge_ctx_reduce(const Frame& F, bf16* S, const char* CP) {
    const int tid = F.tid, wid = tid >> 6, lane = tid & 63, wr = wid >> 2, wc = wid & 3, fr = lane & 15, fq = lane >> 4;
    for (int pr = F.vcu; pr < 512; pr += F.G) {
        const int T = pr >> 4, si = pr & 15;
        const int pm = 64 + (T >> 3), pn = T & 7; const int row0 = pm * 256 + wr * 64 + fr, col0 = pn * 256 + wc * 32 + 8 * fq;
        f32x4 a[4], b[4];
#pragma unroll
        for (int z = 0; z < 4; ++z) { const char* p = CP + (size_t)(T * 4 + z) * 262144 + ((size_t)(si * 2) * 512 + tid) * 16; a[z] = *(const f32x4*)p; b[z] = *(const f32x4*)(p + 8192); }
        const f32x4 v0 = (a[0] + a[1]) + (a[2] + a[3]), v1 = (b[0] + b[1]) + (b[2] + b[3]);
        const int ai = si >> 3, m = (si >> 1) & 3, bj = si & 1;
        if (F8_OUT) { int w0 = __builtin_amdgcn_cvt_pk_fp8_f32(v0[0], v0[1], 0, false); w0 = __builtin_amdgcn_cvt_pk_fp8_f32(v0[2], v0[3], w0, true);
            int w1 = __builtin_amdgcn_cvt_pk_fp8_f32(v1[0], v1[1], 0, false); w1 = __builtin_amdgcn_cvt_pk_fp8_f32(v1[2], v1[3], w1, true);
            *(u32x2*)((unsigned char*)S + (size_t)(row0 + ai * 128 + m * 16) * 2048 + col0 + bj * 128) = (u32x2){(unsigned)w0, (unsigned)w1}; }
        else { u32x4 w; w.x = cvt_pk_bf16(v0[0], v0[1]); w.y = cvt_pk_bf16(v0[2], v0[3]); w.z = cvt_pk_bf16(v1[0], v1[1]); w.w = cvt_pk_bf16(v1[2], v1[3]);
        *(u32x4*)(S + (size_t)(row0 + ai * 128 + m * 16) * 2048 + col0 + bj * 128) = w; }
    }
}

constexpr int N_PHASES = 3 + 10 * DEPTH;
#ifndef MK_N_LAUNCHES
#define MK_N_LAUNCHES 1
#endif
static_assert(MK_N_LAUNCHES == 1, "the merge phase carries a grid barrier of its own (context tiles): single-launch builds only");
__global__ void __launch_bounds__(NWAVES * 64, 2) mk_fwd(Args args) {
    extern __shared__ __attribute__((aligned(16))) unsigned char lds_raw[];
    Frame F;
    F.lds = (LAS unsigned char*)lds_raw; F.tid = threadIdx.x; F.lane = F.tid & 63; F.wave = __builtin_amdgcn_readfirstlane(F.tid >> 6);
    F.G = gridDim.x; { const int bx = blockIdx.x; F.vcu = (F.G % 8 == 0) ? (bx % 8) * (F.G / 8) + bx / 8 : bx; }
    GAS unsigned char* ws; int lo, hi, li;
    { KAP ap = kargs(); ws = (GAS unsigned char*)ap->ws; lo = ap->ph_lo; hi = ap->ph_hi; li = ap->li; }
    F.ws = ws;
    for (int u = F.tid; u < (LDS_BYTES - LDSCTL_OFF) / 4; u += NWAVES * 64) ((LAS unsigned*)(F.lds + LDSCTL_OFF))[u] = 0u;
    __syncthreads();
    volatile LAS unsigned* MISC = (volatile LAS unsigned*)(F.lds + MISC_OFF);
    XcdBarrier bar = xcd_barrier_post((unsigned*)(ws + WS_CTL) + CW_BAR + li * XCD_BAR_WORDS, MISC + 8);
#ifndef PHASE_MASK
#define PHASE_MASK 0x1fff
#endif
#define INR(k) (lo <= (k) && (k) < hi)
#define IN(k) ((((PHASE_MASK) >> ((k) < 3 ? (k) : 3 + ((k) - 3) % 10)) & 1) && INR(k))
#ifndef SPIN_MASK
#define SPIN_MASK 0
#endif
#ifndef SPIN_MUL
#define SPIN_MUL 1
#endif
    unsigned long long tprev_ = SPIN_MASK ? __builtin_amdgcn_s_memrealtime() : 0ull, spin_ = 0ull;
#define SEAM(k) do { if (INR(k) && INR((k) + 1)) xcd_barrier(bar); if (SPIN_MASK) { const unsigned long long tn_ = __builtin_amdgcn_s_memrealtime(); if (((SPIN_MASK) >> KIND(k)) & 1) spin_ += tn_ - tprev_; tprev_ = tn_; } } while (0)
#ifndef PROBE_DUP
#define PROBE_DUP 0
#endif
#ifndef PROBE_REP
#define PROBE_REP 1
#endif
#define KIND(k) ((k) < 3 ? (k) : 3 + ((k) - 3) % 10)
#define REP(k) for (int rep_ = 0, nrep_ = 1 + ((((PROBE_DUP) >> KIND(k)) & 1) ? PROBE_REP : 0); rep_ < nrep_; ++rep_, (rep_ < nrep_ ? xcd_barrier(bar) : (void)0))
#define PF() Frame Fp = F; int bx = blockIdx.x; asm volatile("" : "+v"(Fp.tid), "+v"(Fp.lane), "+s"(Fp.wave), "+s"(Fp.vcu), "+s"(Fp.G), "+s"(Fp.ws), "+s"(Fp.lds), "+s"(bx)); GAS unsigned char* ws = Fp.ws; (void)bx; (void)ws
    if (IN(0)) REP(0) { PF(); p0_prologue(Fp, *kargs()); } SEAM(0);
    if (IN(1)) REP(1) { PF(); p1_modreduce(Fp, *kargs()); } SEAM(1);
#ifdef PROBE_BAR
    for (int pbi = 0; pbi < PROBE_BAR; ++pbi) xcd_barrier(bar);
#endif
    if (IN(2)) REP(2) { PF(); p2_modulate0(Fp, *kargs()); } SEAM(2);
    for (int l = 0; l < DEPTH; ++l) {
        const int pb = 3 + 10 * l; const bool last = (l + 1 == DEPTH);
        const size_t offH = (l & 1) ? WS_BUFB : WS_BUFA, offS = (l & 1) ? WS_BUFA : WS_BUFB;
        const int nPl = last ? 64 : 68, nrows = last ? ML : MT;
        if (IN(pb + 0)) REP(pb + 0) {
            PF(); bf16* Hb = (bf16*)(ws + offH);
            pg8::PlainSched S{F8_IN ? (const char*)(ws + WS_H8) : (const char*)Hb, F8_IN ? (const char*)(ws + WS_WIN) + (size_t)l * UW * DM : (const char*)((bf16*)(ws + WS_WIN) + (size_t)l * UW * DM), DM, DM, DM, 68, 16, Fp.G, bx, F8_IN ? 1 : 2};
            pg8::EpiBf16 E{(bf16*)(ws + WS_UREG), UW};
            pg8::gemm_phase<pg8::EpiBf16, pg8::PlainSched, F8_IN != 0>(Fp.lds + RING_OFF, S, E, DM, DM, Fp.tid);
        } SEAM(pb + 0);
        if (IN(pb + 1)) REP(pb + 1) { PF(); enorm_phase(Fp, *kargs(), l); } SEAM(pb + 1);
        if (IN(pb + 2)) REP(pb + 2) { PF();
            pg8::AupSched S{(const char*)(ws + WS_UREG), (const char*)((bf16*)(ws + WS_WUP) + (size_t)l * 1792 * 512), UW, Fp.G, bx};
            pg8::EpiBf16 E{(bf16*)(ws + WS_QKVA), QW};
            pg8::gemm_phase(Fp.lds + RING_OFF, S, E, UW, 512, Fp.tid);
        } SEAM(pb + 2);
        if (IN(pb + 3)) REP(pb + 3) { PF(); att_phase(Fp, l, rep_ ? PROBE_ATT : 15); } SEAM(pb + 3);
        if (IN(pb + 4)) REP(pb + 4) { PF(); bf16* Hb = (bf16*)(ws + offH); bf16* Sb = (bf16*)(ws + offS);
            pg8::MergeSched S{F8_MERGE ? (const char*)(ws + WS_H8) : (const char*)Hb, (const char*)(ws + WS_OQP), F8_MERGE ? (const char*)(ws + WS_WC) + (size_t)l * 4 * DM * 2560 : (const char*)((bf16*)(ws + WS_WC) + (size_t)l * 4 * DM * 2560), nPl, Fp.G, bx, F8_MERGE ? 1 : 2};
            pg8::EpiMerge E{Sb, G(kargs()->in.b_gate) + (size_t)l * 4 * DM, (char*)(ws + WS_STASH) + (size_t)bx * STASH_WG, (char*)(ws + WS_P) + (size_t)bx * P_WG, (char*)(ws + WS_CP), Fp.tid, F8_OUT};
            pg8::gemm_phase<pg8::EpiMerge, pg8::MergeSched, F8_MERGE != 0>(Fp.lds + RING_OFF, S, E, DM, 2560, Fp.tid);
            if (nPl > 64) { xcd_barrier(bar); merge_ctx_reduce(Fp, Sb, (const char*)(ws + WS_CP)); }
        } SEAM(pb + 4);
        if (IN(pb + 5)) REP(pb + 5) { PF(); bf16* Sb = (bf16*)(ws + offS);
            pg8::PlainSched S{(const char*)Sb, F8_OUT ? (const char*)(ws + WS_WO) + (size_t)l * DM * DM : (const char*)((bf16*)(ws + WS_WO) + (size_t)l * DM * DM), DM, DM, DM, nPl, 8, Fp.G, bx, F8_OUT ? 1 : 2};
            KAP ap = kargs();
            pg8::EpiOut E{(bf16*)(ws + WS_UREG), l == 0 ? G(ap->in.x) : (const float*)(ws + WS_XRES), l == 0 ? G(ap->in.ctx) : (const float*)((const bf16*)(ws + WS_XRES) + (size_t)ML * DM),
                          (const float*)(ws + WS_MOD) + (size_t)l * 5 * MODW, ALPHA, l != 0};
            pg8::gemm_phase<pg8::EpiOut, pg8::PlainSched, F8_OUT != 0>(Fp.lds + RING_OFF, S, E, DM, DM, Fp.tid);
        } SEAM(pb + 5);
        if (IN(pb + 6)) REP(pb + 6) { PF(); ln1_phase(Fp, *kargs(), l, nrows, (bf16*)(ws + offH)); } SEAM(pb + 6);
        if (IN(pb + 7)) REP(pb + 7) { PF(); bf16* Hb = (bf16*)(ws + offH);
            pg8::PlainSched S{F8_PQ ? (const char*)(ws + WS_H8) : (const char*)Hb, F8_PQ ? (const char*)(ws + WS_WPQ) + (size_t)l * DM * DM : (const char*)((bf16*)(ws + WS_WPQ) + (size_t)l * DM * DM), DM, DM, DM, nPl, 8, Fp.G, bx, F8_PQ ? 1 : 2};
            pg8::EpiBf16 E{(bf16*)(ws + WS_OQP), DM};
            pg8::gemm_phase<pg8::EpiBf16, pg8::PlainSched, F8_PQ != 0>(Fp.lds + RING_OFF, S, E, DM, DM, Fp.tid);
        } SEAM(pb + 7);
        if (IN(pb + 8)) REP(pb + 8) { PF();
            const int nhb = Fp.G >> 3;
            if (Fp.vcu < nhb * 8) {
                const int h = Fp.vcu & 7, hb = Fp.vcu >> 3;
                LAS unsigned short* tblw = (LAS unsigned short*)(Fp.lds + RING_OFF) + Fp.wave * (64 * 66);
                LAS unsigned char* sklds = Fp.lds + RING_OFF + NWAVES * (64 * 66 * 2);
                const bf16* SKh = (const bf16*)(ws + WS_SUBK) + ((size_t)l * 8 + h) * 2 * 128 * 128;
#pragma unroll
                for (int i = 0; i < 8; ++i) { const int idx = Fp.tid + 512 * i, row = (idx >> 4) & 127, ch = idx & 15;
                    *(LAS u32x4*)(sklds + (idx >> 11) * 32768 + row * 256 + ((ch ^ (row & 7)) << 4)) = *(const u32x4*)(SKh + (size_t)idx * 8); }
                __syncthreads();
                for (int tg = hb * 8 + Fp.wave; tg < nrows / 32; tg += nhb * 8)
                    peer::topk_item((const bf16*)(ws + WS_OQP), sklds, (int*)(ws + WS_EIDX), (float*)(ws + WS_EG), tg * 32, h, tblw, Fp.lane, (TOPK_SEC >= 0 && Fp.wave == 0) ? (volatile LAS unsigned*)(Fp.lds + MISC_OFF + 256) : nullptr);
            }
        } SEAM(pb + 8);
        if (IN(pb + 9)) REP(pb + 9) { PF(); pexp4_phase(Fp, *kargs(), l, nrows, (bf16*)(ws + offH), last ? G(kargs()->out) : (float*)(ws + WS_XRES), last ? nullptr : (bf16*)(ws + offS)); } SEAM(pb + 9);
    }
    if (PEXP_SEC >= 0 || TOPK_SEC >= 0) { __syncthreads(); spin_ += *(volatile LAS unsigned*)(F.lds + MISC_OFF + 256); }
    if (SPIN_MASK || PEXP_SEC >= 0 || TOPK_SEC >= 0) { const unsigned long long tend_ = __builtin_amdgcn_s_memrealtime() + spin_ * SPIN_MUL; while (__builtin_amdgcn_s_memrealtime() < tend_) __builtin_amdgcn_s_sleep(8); }
#undef IN
#undef INR
#undef SEAM
}

extern "C" void kernel_launch(void* const* d_in, const int* in_sizes, int n_in, void* d_out, int out_size, void* d_ws, size_t ws_size, hipStream_t stream) {
    static int grid = 0;
    if (grid == 0) {
        if (n_in != 27 || out_size != ML * DM || ws_size < WS_END) { fprintf(stderr, "kernel_launch: unexpected shapes (n_in %d out %d ws %zu, need ws >= %zu)\n", n_in, out_size, ws_size, (size_t)WS_END); grid = -1; return; }
        int dev = 0, cus = 0, per_cu = 0;
        if (hipGetDevice(&dev) != hipSuccess || hipDeviceGetAttribute(&cus, hipDeviceAttributeMultiprocessorCount, dev) != hipSuccess) { grid = -1; return; }
        if (hipFuncSetAttribute((const void*)mk_fwd, hipFuncAttributeMaxDynamicSharedMemorySize, LDS_BYTES) != hipSuccess) { fprintf(stderr, "kernel_launch: hipFuncSetAttribute failed\n"); grid = -1; return; }
        if (hipOccupancyMaxActiveBlocksPerMultiprocessor(&per_cu, (const void*)mk_fwd, NWAVES * 64, LDS_BYTES) != hipSuccess || per_cu < 1) { fprintf(stderr, "kernel_launch: occupancy query says %d\n", per_cu); }
        (void)hipGetLastError();
        grid = cus < 256 ? cus : 256;
    }
    if (grid < 0) return;
    (void)hipMemsetAsync((char*)d_ws + WS_CTL, 0, CTL_ZERO_BYTES, stream);
    Args a{};
    const float** ip = (const float**)&a.in;
    for (int i = 0; i < 27; ++i) ip[i] = (const float*)d_in[i];
    a.out = (float*)d_out; a.ws = (unsigned char*)d_ws;
    for (int li = 0; li < MK_N_LAUNCHES; ++li) {
        a.ph_lo = (MK_N_LAUNCHES == 1) ? 0 : li; a.ph_hi = (MK_N_LAUNCHES == 1) ? N_PHASES : li + 1; a.li = li; a.pad = 0;
        hipLaunchKernelGGL(mk_fwd, dim3(grid), dim3(NWAVES * 64), LDS_BYTES, stream, a);
    }
}
```
